# Optimizing an MI355X kernel written in HIP

```python
import math
import jax, jax.numpy as jnp
from jax import lax
import numpy as np

D_MODEL = 2048
BATCH = 2
SEQ = 4096
DEPTH = 2

GRID_W = 64
CTX_LEN = 256
N_GROUPS = 4
GROUP_W = D_MODEL // N_GROUPS
MIX_W = N_GROUPS * GROUP_W
NORM_EPS = 1e-6
RW_HEAD = 64
RW_HEADS = GROUP_W // RW_HEAD
RW_DECAY_RANK = 64
RW_ICLR_RANK = 64
RW_GATE_RANK = 128
RW_DECAY_SCALE = math.exp(-0.5)
RW_GN_EPS = 64e-5
RW_COLS = 3 * GROUP_W + RW_DECAY_RANK + RW_ICLR_RANK + RW_GATE_RANK
ML_HEAD = 128
ML_HEADS = GROUP_W // ML_HEAD
ML_CHUNK = 64
ML_COLS = 4 * GROUP_W + 4 * ML_HEADS
GD_HEAD = 128
GD_HEADS = GROUP_W // GD_HEAD
GD_CHUNK = 64
GD_CONV = 3
GD_COLS = 4 * GROUP_W + 4 * GD_HEADS
AT_HEAD = 128
AT_Q_HEADS = GROUP_W // AT_HEAD
AT_KV_HEADS = 2
AT_BLOCK = 128
ROPE_THETA = 10000.0
AT_COLS = (AT_Q_HEADS + 2 * AT_KV_HEADS) * AT_HEAD
N_IN = RW_COLS + ML_COLS + GD_COLS + AT_COLS
N_EXPERTS = 16
EC_FACTOR = 2
EXPERT_FF = D_MODEL

kernel_name = 'hybrid_parallel_heads_ec_moe_dit'


def split_sizes(a, sizes):
    cuts = [int(s) for s in np.cumsum(sizes)[:-1]]
    return jnp.split(a, cuts, axis=-1)


def rms_norm(x, g, eps=NORM_EPS):
    xf = x.astype(jnp.float32)
    y = xf * lax.rsqrt(jnp.mean(xf * xf, axis=-1, keepdims=True) + eps)
    return (y * g.astype(jnp.float32)).astype(x.dtype)


def l2_normalize(x, eps=1e-6):
    xf = x.astype(jnp.float32)
    return (xf * lax.rsqrt(jnp.sum(xf * xf, axis=-1, keepdims=True) + eps)).astype(x.dtype)


def to_heads(x, n):
    b, l, w = x.shape
    return x.reshape(b, l, n, w // n).transpose(0, 2, 1, 3)


def from_heads(x):
    b, n, l, d = x.shape
    return x.transpose(0, 2, 1, 3).reshape(b, l, n * d)


def shift_mix(x, mu):
    prev = jnp.pad(x[:, :-1], ((0, 0), (1, 0), (0, 0)))
    nxt = jnp.pad(x[:, 1:], ((0, 0), (0, 1), (0, 0)))
    return x + mu[0] * (prev - x) + mu[1] * (nxt - x)


def centred_conv(x, w):
    k = w.shape[0]
    pad = k // 2
    n = x.shape[1]
    xp = jnp.pad(x, ((0, 0), (pad, pad), (0, 0)))
    return sum(xp[:, j:j + n] * w[j] for j in range(k))


def rope_half(x, ang):
    h = x.shape[-1] // 2
    x1, x2 = x[..., :h], x[..., h:]
    cs, sn = jnp.cos(ang), jnp.sin(ang)
    return jnp.concatenate([x1 * cs - x2 * sn, x2 * cs + x1 * sn], axis=-1).astype(x.dtype)


def rope_2d(x, ang_r, ang_c):
    h = x.shape[-1] // 2
    return jnp.concatenate([rope_half(x[..., :h], ang_r), rope_half(x[..., h:], ang_c)], axis=-1)


def prefix_then_latent(run, ctx_args, lat_args, init):
    y_c, state = run(ctx_args, init)
    y_l, _ = run(lat_args, state)
    return y_c, y_l


def bidirectional(run, ctx_fwd, lat_fwd, ctx_bwd, lat_bwd, init):
    flip = lambda args: tuple(jnp.flip(a, axis=2) for a in args)
    yc_f, yl_f = prefix_then_latent(run, ctx_fwd, lat_fwd, init)
    yc_b, yl_b = prefix_then_latent(run, flip(ctx_bwd), flip(lat_bwd), init)
    return yc_f + jnp.flip(yc_b, axis=2), yl_f + jnp.flip(yl_b, axis=2)


def rwkv_run(args, s0):
    xs = tuple(jnp.moveaxis(a.astype(jnp.float32), 2, 0) for a in args)

    def step(s, inp):
        r, lw, kt, v, kk, a = inp
        sk = jnp.einsum('bhvk,bhk->bhv', s, kk)
        s = s * jnp.exp(lw)[:, :, None, :] - sk[..., None] * (kk * a)[:, :, None, :] + v[..., None] * kt[:, :, None, :]
        return s, jnp.einsum('bhvk,bhk->bhv', s, r)

    s, ys = lax.scan(step, s0, xs)
    return jnp.moveaxis(ys, 0, 2), s


def rwkv_prep(pp, p):
    pp = shift_mix(pp, p['rw_mu'])
    r, k, v, wd, ad, gd = split_sizes(pp, [GROUP_W, GROUP_W, GROUP_W, RW_DECAY_RANK, RW_ICLR_RANK, RW_GATE_RANK])
    g = jax.nn.sigmoid(gd) @ p['rw_g_up']
    kk = from_heads(l2_normalize(to_heads(k * p['rw_k_k'], RW_HEADS)))
    per_dir = []
    for d in range(2):
        logw = -RW_DECAY_SCALE * jax.nn.sigmoid(p['rw_w0'][d] + jnp.tanh(wd) @ p['rw_w_up'][d])
        a = jax.nn.sigmoid(p['rw_a0'][d] + ad @ p['rw_a_up'][d])
        kt = k * (1.0 + (a - 1.0) * p['rw_k_a'])
        per_dir.append((logw, a, kt))
    return r, v, kk, g, per_dir


def rwkv_group(pc, pl, p):
    prep_c, prep_l = rwkv_prep(pc, p), rwkv_prep(pl, p)

    def args(prep, d):
        r, v, kk, _, per_dir = prep
        logw, a, kt = per_dir[d]
        return tuple(to_heads(t, RW_HEADS) for t in (r, logw, kt, v, kk, a))

    s0 = jnp.zeros((pl.shape[0], RW_HEADS, RW_HEAD, RW_HEAD), jnp.float32)
    yc, yl = bidirectional(rwkv_run, args(prep_c, 0), args(prep_l, 0), args(prep_c, 1), args(prep_l, 1), s0)

    def post(y, prep):
        r, v, _, g, per_dir = prep
        y = y.transpose(0, 2, 1, 3)
        mean = jnp.mean(y, axis=-1, keepdims=True)
        var = jnp.mean(jnp.square(y - mean), axis=-1, keepdims=True)
        y = ((y - mean) * lax.rsqrt(var + RW_GN_EPS)).reshape(y.shape[0], y.shape[1], GROUP_W)
        y = y * p['rw_ln_w'] + p['rw_ln_b']
        bh = lambda t: t.reshape(t.shape[0], t.shape[1], RW_HEADS, RW_HEAD)
        bonus = sum(jnp.sum(bh(r) * bh(kt) * p['rw_r_k'], axis=-1, keepdims=True) * bh(v) for _, _, kt in per_dir)
        return ((y + bonus.reshape(y.shape)) * g).astype(pl.dtype)

    return post(yc, prep_c), post(yl, prep_l)


def mlstm_run(args, state):
    q, k, v, li, lf = (a.astype(jnp.float32) for a in args)
    b, h, n, d = q.shape
    nc = n // ML_CHUNK

    def chunks(a):
        return jnp.moveaxis(a.reshape(a.shape[:2] + (nc, ML_CHUNK) + a.shape[3:]), 2, 0)

    tri = jnp.tril(jnp.ones((ML_CHUNK, ML_CHUNK), dtype=bool))

    def step(carry, inp):
        cm, nv, m = carry
        qc, kc, vc, ic, fc = inp
        bcum = jnp.cumsum(fc, axis=-1)
        dlog = jnp.where(tri, bcum[..., :, None] - bcum[..., None, :] + ic[..., None, :], -jnp.inf)
        inter = bcum + m[..., None]
        mt = jnp.maximum(inter, jnp.max(dlog, axis=-1))
        s = jnp.einsum('bhtd,bhsd->bhts', qc, kc) * jnp.exp(dlog - mt[..., None])
        wi = jnp.exp(inter - mt)
        num = jnp.einsum('bhts,bhse->bhte', s, vc) + wi[..., None] * jnp.einsum('bhed,bhtd->bhte', cm, qc)
        den = jnp.sum(s, axis=-1) + wi * jnp.einsum('bhd,bhtd->bht', nv, qc)
        out = num / jnp.maximum(jnp.abs(den), jnp.exp(-mt))[..., None]
        m_new = mt[..., -1]
        wk = jnp.exp(bcum[..., -1:] - bcum + ic - m_new[..., None])
        dc = jnp.exp(bcum[..., -1] + m - m_new)
        cm = dc[..., None, None] * cm + jnp.einsum('bhs,bhse,bhsd->bhed', wk, vc, kc)
        nv = dc[..., None] * nv + jnp.einsum('bhs,bhsd->bhd', wk, kc)
        return (cm, nv, m_new), out

    state, outs = lax.scan(step, state, tuple(chunks(a) for a in (q, k, v, li, lf)))
    return jnp.moveaxis(outs, 0, 2).reshape(b, h, n, d), state


def mlstm_prep(pp, p):
    q, k, v, o, gts = split_sizes(pp, [GROUP_W, GROUP_W, GROUP_W, GROUP_W, 4 * ML_HEADS])
    qh, kh, vh = to_heads(q, ML_HEADS), to_heads(k, ML_HEADS) * ML_HEAD ** -0.5, to_heads(v, ML_HEADS)
    gh = jnp.swapaxes(gts, 1, 2)
    dirs = []
    for d in range(2):
        li = gh[:, d * ML_HEADS:(d + 1) * ML_HEADS] + p['ml_ib'][d][:, None]
        lf = jax.nn.log_sigmoid(gh[:, (2 + d) * ML_HEADS:(3 + d) * ML_HEADS] + p['ml_fb'][d][:, None])
        dirs.append((qh, kh, vh, li, lf))
    return dirs, o


def mlstm_group(pc, pl, p):
    (dc, oc), (dl, ol) = mlstm_prep(pc, p), mlstm_prep(pl, p)
    b = pl.shape[0]
    init = (jnp.zeros((b, ML_HEADS, ML_HEAD, ML_HEAD), jnp.float32),
            jnp.zeros((b, ML_HEADS, ML_HEAD), jnp.float32),
            jnp.zeros((b, ML_HEADS), jnp.float32))
    hc, hl = bidirectional(mlstm_run, dc[0], dl[0], dc[1], dl[1], init)

    def post(hh, o):
        y = hh.transpose(0, 2, 1, 3)
        mean = jnp.mean(y, axis=-1, keepdims=True)
        var = jnp.mean(jnp.square(y - mean), axis=-1, keepdims=True)
        y = ((y - mean) * lax.rsqrt(var + NORM_EPS)).reshape(y.shape[0], y.shape[1], GROUP_W) * p['ml_norm_g']
        return (y * jax.nn.sigmoid(o)).astype(o.dtype)

    return post(hc, oc), post(hl, ol)


def gdn_run(args, state):
    q, k, v, lg, beta = (a.astype(jnp.float32) for a in args)
    b, h, n, _ = q.shape
    dv = v.shape[-1]
    nc, c = n // GD_CHUNK, GD_CHUNK
    blk = lambda a: a.reshape(a.shape[:2] + (nc, c) + a.shape[3:])
    q, k, v, lg, beta = blk(q), blk(k), blk(v), blk(lg), blk(beta)
    gc = jnp.cumsum(lg, axis=-1)
    incl = jnp.tril(jnp.ones((c, c), dtype=bool))
    strict = jnp.tril(jnp.ones((c, c), dtype=bool), k=-1)
    decay = jnp.exp(jnp.where(incl, gc[..., :, None] - gc[..., None, :], -jnp.inf))
    kb = k * beta[..., None]
    a_low = jnp.where(strict, jnp.einsum('bhnid,bhnjd->bhnij', kb, k) * decay, 0.0)
    rhs = jnp.concatenate([v * beta[..., None], kb * jnp.exp(gc)[..., None]], axis=-1)
    sol = lax.linalg.triangular_solve(a_low, rhs, left_side=True, lower=True, unit_diagonal=True)
    u, w = sol[..., :dv], sol[..., dv:]
    attn = jnp.einsum('bhnid,bhnjd->bhnij', q, k) * decay
    qg = q * jnp.exp(gc)[..., None]
    kd = k * jnp.exp(gc[..., -1:] - gc)[..., None]
    gl = jnp.exp(gc[..., -1])

    def step(s, inp):
        uc, wc, qc, kc, ac, glc = inp
        v_new = uc - jnp.einsum('bhld,bhde->bhle', wc, s)
        out = jnp.einsum('bhld,bhde->bhle', qc, s) + jnp.einsum('bhij,bhje->bhie', ac, v_new)
        s = s * glc[..., None, None] + jnp.einsum('bhld,bhle->bhde', kc, v_new)
        return s, out

    xs = tuple(jnp.moveaxis(a, 2, 0) for a in (u, w, qg, kd, attn, gl))
    state, outs = lax.scan(step, state, xs)
    return jnp.moveaxis(outs, 0, 2).reshape(b, h, n, dv), state


def gdn_prep(pp, p):
    qkv, g, gts = split_sizes(pp, [3 * GROUP_W, GROUP_W, 4 * GD_HEADS])
    qkv = jax.nn.silu(centred_conv(qkv, p['gd_conv']))
    q, k, v = split_sizes(qkv, [GROUP_W, GROUP_W, GROUP_W])
    qh = l2_normalize(to_heads(q, GD_HEADS)) * GD_HEAD ** -0.5
    kh = l2_normalize(to_heads(k, GD_HEADS))
    vh = to_heads(v, GD_HEADS)
    gh = jnp.swapaxes(gts, 1, 2)
    dirs = []
    for d in range(2):
        lg = -jnp.exp(p['gd_a_log'][d])[:, None] * jax.nn.softplus(
            gh[:, d * GD_HEADS:(d + 1) * GD_HEADS] + p['gd_dt_bias'][d][:, None])
        beta = jax.nn.sigmoid(gh[:, (2 + d) * GD_HEADS:(3 + d) * GD_HEADS])
        dirs.append((qh, kh, vh, lg, beta))
    return dirs, g


def gdn_group(pc, pl, p):
    (dc, gc_), (dl, gl_) = gdn_prep(pc, p), gdn_prep(pl, p)
    s0 = jnp.zeros((pl.shape[0], GD_HEADS, GD_HEAD, GD_HEAD), jnp.float32)
    oc, ol = bidirectional(gdn_run, dc[0], dl[0], dc[1], dl[1], s0)

    def post(oh, g):
        gh = g.reshape(g.shape[0], g.shape[1], GD_HEADS, GD_HEAD)
        y = rms_norm(oh.transpose(0, 2, 1, 3), p['gd_norm_g']) * jax.nn.silu(gh)
        return y.reshape(g.shape).astype(g.dtype)

    return post(oc, gc_), post(ol, gl_)


def gqa(q, k, v):
    b, hq, lq, d = q.shape
    hkv = k.shape[1]
    qg = q.reshape(b, hkv, hq // hkv, lq, d)
    s = jnp.einsum('bkgqd,bksd->bkgqs', qg, k).astype(jnp.float32) * d ** -0.5
    pr = jax.nn.softmax(s, axis=-1).astype(v.dtype)
    return jnp.einsum('bkgqs,bksd->bkgqd', pr, v).reshape(b, hq, lq, d)


def blocked_gqa(q, k, v):
    b, hq, n, d = q.shape
    nb = n // AT_BLOCK
    qb = jnp.moveaxis(q.reshape(b, hq, nb, AT_BLOCK, d), 2, 0)
    ob = lax.map(lambda blk: gqa(blk, k, v), qb)
    return jnp.moveaxis(ob, 0, 2).reshape(b, hq, n, d)


def attn_group(pc, pl, p, ang_r, ang_c, need_ctx):
    sizes = [AT_Q_HEADS * AT_HEAD, AT_KV_HEADS * AT_HEAD, AT_KV_HEADS * AT_HEAD]
    qc, kc, vc = split_sizes(pc, sizes)
    ql, kl, vl = split_sizes(pl, sizes)
    kc = rms_norm(to_heads(kc, AT_KV_HEADS), p['at_k_norm'])
    vc = to_heads(vc, AT_KV_HEADS)
    ql = rope_2d(rms_norm(to_heads(ql, AT_Q_HEADS), p['at_q_norm']), ang_r, ang_c)
    kl = rope_2d(rms_norm(to_heads(kl, AT_KV_HEADS), p['at_k_norm']), ang_r, ang_c)
    vl = to_heads(vl, AT_KV_HEADS)
    k_all = jnp.concatenate([kc, kl], axis=2)
    v_all = jnp.concatenate([vc, vl], axis=2)
    out_l = from_heads(blocked_gqa(ql, k_all, v_all))
    if not need_ctx:
        return None, out_l
    qc = rms_norm(to_heads(qc, AT_Q_HEADS), p['at_q_norm'])
    return from_heads(gqa(qc, kc, vc)), out_l


def token_mixer(hc, hl, p, ang_r, ang_c, need_ctx):
    pc = hc @ p['w_in']
    pl = hl @ p['w_in']
    sizes = [RW_COLS, ML_COLS, GD_COLS, AT_COLS]
    ac, bc, cc, dc = split_sizes(pc, sizes)
    al, bl, cl, dl = split_sizes(pl, sizes)
    oa = rwkv_group(ac, al, p)
    ob = mlstm_group(bc, bl, p)
    oc = gdn_group(cc, cl, p)
    od = attn_group(dc, dl, p, ang_r, ang_c, need_ctx)
    yl = jnp.concatenate([oa[1], ob[1], oc[1], od[1]], axis=-1) @ p['w_out']
    if not need_ctx:
        return None, yl
    yc = jnp.concatenate([oa[0], ob[0], oc[0], od[0]], axis=-1) @ p['w_out']
    return yc, yl


def expert_choice_ffn(h, w_router, w1, w3, w2):
    b, l, _ = h.shape
    cap = EC_FACTOR * l // N_EXPERTS
    aff = jax.nn.softmax(jnp.einsum('bld,de->ble', h, w_router).astype(jnp.float32), axis=-1)
    gate, idx = lax.top_k(jnp.swapaxes(aff, 1, 2), cap)
    bidx = jnp.arange(b)[:, None, None]
    xs = h[bidx, idx]
    hid = jax.nn.silu(jnp.einsum('becd,edf->becf', xs, w1)) * jnp.einsum('becd,edf->becf', xs, w3)
    y = jnp.einsum('becf,efd->becd', hid, w2) * gate[..., None].astype(h.dtype)
    return jnp.zeros_like(h).at[bidx, idx].add(y)


def modulation(cond, p):
    return jnp.split(jax.nn.silu(cond) @ p['ada_w'] + p['ada_b'], 6, axis=-1)


def modulate(x, g, shift, scale):
    return rms_norm(x, g) * (1.0 + scale) + shift


def trunk_layer(xl, xc, c, c_ctx, p, ang_r, ang_c, last):
    ml = [t[:, None, :] for t in modulation(c, p)]
    mc = modulation(c_ctx, p)
    hl = modulate(xl, p['norm1_g'], ml[0], ml[1])
    hc = modulate(xc, p['norm1_g'], mc[0], mc[1])
    yc, yl = token_mixer(hc, hl, p, ang_r, ang_c, not last)
    xl = xl + ml[2] * yl
    xl = xl + ml[5] * expert_choice_ffn(modulate(xl, p['norm2_g'], ml[3], ml[4]),
                                        p['w_router'], p['w_exp1'], p['w_exp3'], p['w_exp2'])
    if not last:
        xc = xc + mc[2] * yc
        xc = xc + mc[5] * expert_choice_ffn(modulate(xc, p['norm2_g'], mc[3], mc[4]),
                                            p['w_router'], p['w_exp1'], p['w_exp3'], p['w_exp2'])
    return xl, xc


def setup_inputs(seed: int = 0) -> dict:
    key = jax.random.key(seed)

    def nrm(i, shape, scale):
        return jax.random.normal(jax.random.fold_in(key, i), shape, jnp.float32) * scale

    def uni(i, shape, lo, hi):
        return jax.random.uniform(jax.random.fold_in(key, i), shape, jnp.float32, lo, hi)

    d = D_MODEL
    dt = jnp.exp(uni(26, (DEPTH, 2, GD_HEADS), math.log(1e-3), math.log(1e-1)))
    return {
        'x': nrm(0, (BATCH, SEQ, d), 1.0),
        'c': nrm(1, (BATCH, d), 1.0),
        'ctx': nrm(2, (BATCH, CTX_LEN, d), 1.0),
        'c_ctx': nrm(3, (d,), 1.0),
        'ada_w': nrm(4, (DEPTH, d, 6 * d), 0.5 * d ** -0.5),
        'ada_b': nrm(5, (DEPTH, 6 * d), 0.01),
        'norm1_g': 1.0 + nrm(6, (DEPTH, d), 0.02),
        'norm2_g': 1.0 + nrm(7, (DEPTH, d), 0.02),
        'w_in': nrm(8, (DEPTH, d, N_IN), d ** -0.5),
        'w_out': nrm(9, (DEPTH, MIX_W, d), MIX_W ** -0.5),
        'rw_mu': uni(10, (DEPTH, 2, RW_COLS), 0.0, 0.5),
        'rw_w0': nrm(11, (DEPTH, 2, GROUP_W), 0.5),
        'rw_w_up': nrm(12, (DEPTH, 2, RW_DECAY_RANK, GROUP_W), 0.1),
        'rw_a0': nrm(13, (DEPTH, 2, GROUP_W), 0.5),
        'rw_a_up': nrm(14, (DEPTH, 2, RW_ICLR_RANK, GROUP_W), 0.1),
        'rw_g_up': nrm(15, (DEPTH, RW_GATE_RANK, GROUP_W), RW_GATE_RANK ** -0.5),
        'rw_k_k': 0.85 + nrm(16, (DEPTH, GROUP_W), 0.05),
        'rw_k_a': 1.0 + nrm(17, (DEPTH, GROUP_W), 0.05),
        'rw_r_k': nrm(18, (DEPTH, RW_HEADS, RW_HEAD), 0.1),
        'rw_ln_w': 1.0 + nrm(19, (DEPTH, GROUP_W), 0.02),
        'rw_ln_b': nrm(20, (DEPTH, GROUP_W), 0.01),
        'ml_ib': nrm(21, (DEPTH, 2, ML_HEADS), 0.1),
        'ml_fb': jnp.linspace(3.0, 6.0, ML_HEADS, dtype=jnp.float32) + nrm(22, (DEPTH, 2, ML_HEADS), 0.1),
        'ml_norm_g': 1.0 + nrm(23, (DEPTH, GROUP_W), 0.02),
        'gd_conv': nrm(24, (DEPTH, GD_CONV, 3 * GROUP_W), GD_CONV ** -0.5),
        'gd_a_log': jnp.log(uni(25, (DEPTH, 2, GD_HEADS), 1.0, 16.0)),
        'gd_dt_bias': dt + jnp.log(-jnp.expm1(-dt)),
        'gd_norm_g': 1.0 + nrm(27, (DEPTH, GD_HEAD), 0.02),
        'at_q_norm': 1.0 + nrm(28, (DEPTH, AT_HEAD), 0.02),
        'at_k_norm': 1.0 + nrm(29, (DEPTH, AT_HEAD), 0.02),
        'w_router': nrm(30, (DEPTH, d, N_EXPERTS), d ** -0.5),
        'w_exp1': nrm(31, (DEPTH, N_EXPERTS, d, EXPERT_FF), d ** -0.5),
        'w_exp3': nrm(32, (DEPTH, N_EXPERTS, d, EXPERT_FF), d ** -0.5),
        'w_exp2': nrm(33, (DEPTH, N_EXPERTS, EXPERT_FF, d), EXPERT_FF ** -0.5),
        'final_g': 1.0 + nrm(34, (d,), 0.02),
    }


def reference(x, c, ctx, c_ctx, ada_w, ada_b, norm1_g, norm2_g, w_in, w_out,
              rw_mu, rw_w0, rw_w_up, rw_a0, rw_a_up, rw_g_up, rw_k_k, rw_k_a, rw_r_k, rw_ln_w, rw_ln_b,
              ml_ib, ml_fb, ml_norm_g, gd_conv, gd_a_log, gd_dt_bias, gd_norm_g,
              at_q_norm, at_k_norm, w_router, w_exp1, w_exp3, w_exp2, final_g):
    n_lat = x.shape[1]
    ROWS = n_lat // GRID_W
    row = jnp.broadcast_to(jnp.arange(ROWS)[:, None], (ROWS, GRID_W)).reshape(-1).astype(jnp.float32)
    col = jnp.broadcast_to(jnp.arange(GRID_W)[None, :], (ROWS, GRID_W)).reshape(-1).astype(jnp.float32)
    axis_dim = AT_HEAD // 2
    inv_freq = ROPE_THETA ** (-jnp.arange(0, axis_dim, 2, dtype=jnp.float32) / axis_dim)
    ang_r = row[:, None] * inv_freq[None, :]
    ang_c = col[:, None] * inv_freq[None, :]
    xl, xc = x, ctx
    for layer in range(DEPTH):
        p = {
            'ada_w': ada_w[layer], 'ada_b': ada_b[layer],
            'norm1_g': norm1_g[layer], 'norm2_g': norm2_g[layer],
            'w_in': w_in[layer], 'w_out': w_out[layer],
            'rw_mu': rw_mu[layer], 'rw_w0': rw_w0[layer], 'rw_w_up': rw_w_up[layer],
            'rw_a0': rw_a0[layer], 'rw_a_up': rw_a_up[layer], 'rw_g_up': rw_g_up[layer],
            'rw_k_k': rw_k_k[layer], 'rw_k_a': rw_k_a[layer], 'rw_r_k': rw_r_k[layer],
            'rw_ln_w': rw_ln_w[layer], 'rw_ln_b': rw_ln_b[layer],
            'ml_ib': ml_ib[layer], 'ml_fb': ml_fb[layer], 'ml_norm_g': ml_norm_g[layer],
            'gd_conv': gd_conv[layer], 'gd_a_log': gd_a_log[layer], 'gd_dt_bias': gd_dt_bias[layer],
            'gd_norm_g': gd_norm_g[layer],
            'at_q_norm': at_q_norm[layer], 'at_k_norm': at_k_norm[layer],
            'w_router': w_router[layer], 'w_exp1': w_exp1[layer], 'w_exp3': w_exp3[layer],
            'w_exp2': w_exp2[layer],
        }
        xl, xc = trunk_layer(xl, xc, c, c_ctx, p, ang_r, ang_c, layer == DEPTH - 1)
    return rms_norm(xl, final_g)
```

```cpp
#include <hip/hip_runtime.h>

#ifndef CFG_D_MODEL
#define CFG_D_MODEL 2048
#define CFG_SEQ 4096
#define CFG_GRID_W 64
#define CFG_CTX 256
#define CFG_RW_HEAD 64
#define CFG_RW_DR 64
#define CFG_RW_IR 64
#define CFG_RW_GR 128
#define CFG_ML_HEAD 128
#define CFG_CHUNK 64
#define CFG_GD_HEAD 128
#define CFG_AT_HEAD 128
#define CFG_AT_KVH 2
#define CFG_NE 16
#endif

constexpr int D_MODEL = CFG_D_MODEL, BATCH = 2, SEQ = CFG_SEQ, DEPTH = 2, GRID_W = CFG_GRID_W, CTX = CFG_CTX;
constexpr int TOK = CTX + SEQ, MROWS = BATCH * TOK, GROUP_W = D_MODEL / 4;
constexpr int RW_HEAD = CFG_RW_HEAD, RW_HEADS = GROUP_W / RW_HEAD, RW_DR = CFG_RW_DR, RW_IR = CFG_RW_IR, RW_GR = CFG_RW_GR;
constexpr int RW_COLS = 3 * GROUP_W + RW_DR + RW_IR + RW_GR, RW_LR = RW_DR + RW_IR + RW_GR;
constexpr int ML_HEAD = CFG_ML_HEAD, ML_HEADS = GROUP_W / ML_HEAD, CHUNK = CFG_CHUNK, ML_COLS = 4 * GROUP_W + 4 * ML_HEADS;
constexpr int GD_HEAD = CFG_GD_HEAD, GD_HEADS = GROUP_W / GD_HEAD, GD_COLS = 4 * GROUP_W + 4 * GD_HEADS;
constexpr int AT_HEAD = CFG_AT_HEAD, AT_QH = GROUP_W / AT_HEAD, AT_KVH = CFG_AT_KVH, AT_COLS = (AT_QH + 2 * AT_KVH) * AT_HEAD;
constexpr int N_IN = RW_COLS + ML_COLS + GD_COLS + AT_COLS;
constexpr int RW_OFF = 0, ML_OFF = RW_COLS, GD_OFF = ML_OFF + ML_COLS, AT_OFF = GD_OFF + GD_COLS;
constexpr int LDP = (N_IN + 255) / 256 * 256;
constexpr int NE = CFG_NE, CAPL = 2 * SEQ / NE, CAPC = 2 * CTX / NE;
constexpr int NSLOT_L = BATCH * CAPL, NSLOT_C = BATCH * CAPC;
constexpr int NSLOT = (NSLOT_L + NSLOT_C + 255) / 256 * 256;
constexpr int NCHUNK = TOK / CHUNK, ML_CH = BATCH * ML_HEADS * 2, GD_CH = BATCH * GD_HEADS * 2, RW_CH = BATCH * RW_HEADS * 2;
constexpr float NORM_EPS = 1e-6f, RW_GN_EPS = 64e-5f, RW_DECAY_SCALE = 0.6065306597126334f;
static_assert(ML_HEADS == GD_HEADS, "heads");

typedef unsigned short u16;

#ifdef CPU_TEST
#include <cmath>
#include <cstdint>
#include <cstring>
#define HD inline
#else
#define HD __device__ __forceinline__
#endif

struct Params {
    const float *x, *c, *ctx, *c_ctx, *ada_w, *ada_b, *norm1_g, *norm2_g, *w_in, *w_out;
    const float *rw_mu, *rw_w0, *rw_w_up, *rw_a0, *rw_a_up, *rw_g_up, *rw_k_k, *rw_k_a, *rw_r_k, *rw_ln_w, *rw_ln_b;
    const float *ml_ib, *ml_fb, *ml_norm_g, *gd_conv, *gd_a_log, *gd_dt_bias, *gd_norm_g, *at_q_norm, *at_k_norm;
    const float *w_router, *w_exp1, *w_exp3, *w_exp2, *final_g;
    float* out;
    unsigned* bar;
    float *modp, *mod;
    u16 *wt_in, *wt_out, *w13t, *w2t;
    float* xres;
    u16* h;
    float* P;
    float *rw_r, *rw_k, *rw_v, *rw_lr, *rw_kk, *rw_g, *rw_ew, *rw_kka, *rw_kt, *rw_y;
    float *ml_bcum, *ml_g, *ml_gmax, *ml_bl, *ml_gm, *ml_min, *ml_dC, *ml_dn, *ml_S, *ml_hh;
    float *gd_q, *gd_k, *gd_v, *gd_gc, *gd_beta, *gd_A, *gd_attn, *gd_u, *gd_w, *gd_o;
    u16 *at_q, *at_k, *at_v;
    u16* mix;
    float* aff; int* inv;
    int* sel_row; float* sel_gate;
    u16 *xs, *hid; float* yexp;
};

struct Exec { int gid, ngroups, gl; };

template <int G> HD float group_sum(float v) {
#ifndef CPU_TEST
#pragma unroll
    for (int o = G / 2; o > 0; o >>= 1) v += __shfl_xor(v, o, 64);
#endif
    return v;
}
template <int G> HD float group_max(float v) {
#ifndef CPU_TEST
#pragma unroll
    for (int o = G / 2; o > 0; o >>= 1) v = fmaxf(v, __shfl_xor(v, o, 64));
#endif
    return v;
}

HD u16 f2bf(float f) { unsigned u; memcpy(&u, &f, 4); u += 0x7FFFu + ((u >> 16) & 1u); return (u16)(u >> 16); }
HD float bf2f(u16 b) { unsigned u = ((unsigned)b) << 16; float f; memcpy(&f, &u, 4); return f; }
HD float sigmoidf_(float x) { return 1.f / (1.f + expf(-x)); }
HD float siluf_(float x) { return x / (1.f + expf(-x)); }
HD float softplusf_(float x) { return x > 20.f ? x : log1pf(expf(x)); }
HD float logsigmoidf_(float x) { return x < 0.f ? x - log1pf(expf(x)) : -log1pf(expf(-x)); }

HD int row_b(int R) { return R / TOK; }
HD int row_s(int R) { return R % TOK; }
HD bool row_ctx(int R) { return row_s(R) < CTX; }
HD int mod_sel(int R) { return row_ctx(R) ? 2 : row_b(R); }
HD int seq_s(int d, int p) { return d == 0 ? p : (p < CTX ? CTX - 1 - p : TOK - 1 - (p - CTX)); }
HD const float* modv(const Params& p, int layer, int sel, int k) { return p.mod + ((size_t)(layer * 3 + sel) * 6 + k) * D_MODEL; }

constexpr int MOD_KS = 16;
HD void ph_mod_partial(const Params& p, Exec e) {
    const int n = DEPTH * MOD_KS * 6 * D_MODEL;
    for (int it = e.gid; it < n; it += e.ngroups) {
        const int col = it % (6 * D_MODEL), ks = (it / (6 * D_MODEL)) % MOD_KS, l = it / (6 * D_MODEL * MOD_KS);
        const float* w = p.ada_w + (size_t)l * D_MODEL * 6 * D_MODEL + col;
        float a0 = 0.f, a1 = 0.f, a2 = 0.f;
        const int k0 = ks * (D_MODEL / MOD_KS);
        for (int k = k0; k < k0 + D_MODEL / MOD_KS; ++k) {
            const float wv = w[(size_t)k * 6 * D_MODEL];
            a0 += siluf_(p.c[k]) * wv; a1 += siluf_(p.c[D_MODEL + k]) * wv; a2 += siluf_(p.c_ctx[k]) * wv;
        }
        float* o = p.modp + ((size_t)(l * MOD_KS + ks) * 3) * 6 * D_MODEL + col;
        o[0] = a0; o[6 * D_MODEL] = a1; o[2 * 6 * D_MODEL] = a2;
    }
}
HD void ph_mod_final(const Params& p, Exec e) {
    const int n = DEPTH * 3 * 6 * D_MODEL;
    for (int it = e.gid; it < n; it += e.ngroups) {
        const int col = it % (6 * D_MODEL), sel = (it / (6 * D_MODEL)) % 3, l = it / (6 * D_MODEL * 3);
        float a = p.ada_b[l * 6 * D_MODEL + col];
        for (int ks = 0; ks < MOD_KS; ++ks) a += p.modp[((size_t)(l * MOD_KS + ks) * 3 + sel) * 6 * D_MODEL + col];
        p.mod[(size_t)(l * 3 + sel) * 6 * D_MODEL + col] = a;
    }
}

HD float resid_in(const Params& p, int layer, int R, int c) {
    if (layer == 0) { const int b = row_b(R), s = row_s(R);
        return s < CTX ? p.ctx[((size_t)b * CTX + s) * D_MODEL + c] : p.x[((size_t)b * SEQ + (s - CTX)) * D_MODEL + c]; }
    float v = p.xres[(size_t)R * D_MODEL + c];
    const float m5 = modv(p, layer - 1, mod_sel(R), 5)[c];
    float acc = 0.f;
    for (int ex = 0; ex < NE; ++ex) { const int j = p.inv[(size_t)R * NE + ex]; if (j >= 0) acc += p.yexp[((size_t)ex * NSLOT + j) * D_MODEL + c]; }
    return v + m5 * acc;
}
template <int G> HD void ph_norm1(const Params& p, int layer, Exec e) {
    for (int R = e.gid; R < MROWS; R += e.ngroups) {
        float ss = 0.f;
        for (int c = e.gl; c < D_MODEL; c += G) { const float v = resid_in(p, layer, R, c); p.xres[(size_t)R * D_MODEL + c] = v; ss += v * v; }
        ss = group_sum<G>(ss);
        const float rstd = 1.f / sqrtf(ss / D_MODEL + NORM_EPS);
        const int sel = mod_sel(R); const float *m0 = modv(p, layer, sel, 0), *m1 = modv(p, layer, sel, 1), *g = p.norm1_g + layer * D_MODEL;
        for (int c = e.gl; c < D_MODEL; c += G) { const float v = p.xres[(size_t)R * D_MODEL + c];
            p.h[(size_t)R * D_MODEL + c] = f2bf(v * rstd * g[c] * (1.f + m1[c]) + m0[c]); }
    }
}
template <int G> HD void ph_final(const Params& p, Exec e) {
    for (int i = e.gid; i < BATCH * SEQ; i += e.ngroups) {
        const int b = i / SEQ, t = i % SEQ, R = b * TOK + CTX + t;
        float ss = 0.f;
        for (int c = e.gl; c < D_MODEL; c += G) { const float v = resid_in(p, DEPTH, R, c); ss += v * v; }
        ss = group_sum<G>(ss);
        const float rstd = 1.f / sqrtf(ss / D_MODEL + NORM_EPS);
        for (int c = e.gl; c < D_MODEL; c += G) p.out[(size_t)i * D_MODEL + c] = resid_in(p, DEPTH, R, c) * rstd * p.final_g[c];
    }
}
template <int G> HD void ph_norm2(const Params& p, int layer, Exec e) {
    const bool last = layer == DEPTH - 1;
    for (int R = e.gid; R < MROWS; R += e.ngroups) {
        if (last && row_ctx(R)) continue;
        float ss = 0.f;
        for (int c = e.gl; c < D_MODEL; c += G) { const float v = p.xres[(size_t)R * D_MODEL + c]; ss += v * v; }
        ss = group_sum<G>(ss);
        const float rstd = 1.f / sqrtf(ss / D_MODEL + NORM_EPS);
        const int sel = mod_sel(R); const float *m3 = modv(p, layer, sel, 3), *m4 = modv(p, layer, sel, 4), *g = p.norm2_g + layer * D_MODEL;
        const float* wr = p.w_router + (size_t)layer * D_MODEL * NE;
        float lg[NE];
#pragma unroll
        for (int ex = 0; ex < NE; ++ex) lg[ex] = 0.f;
        for (int c = e.gl; c < D_MODEL; c += G) { const float v = p.xres[(size_t)R * D_MODEL + c];
            const float hv = v * rstd * g[c] * (1.f + m4[c]) + m3[c];
            p.h[(size_t)R * D_MODEL + c] = f2bf(hv);
#pragma unroll
            for (int ex = 0; ex < NE; ++ex) lg[ex] += hv * wr[c * NE + ex]; }
        float mx = -1e30f;
#pragma unroll
        for (int ex = 0; ex < NE; ++ex) { lg[ex] = group_sum<G>(lg[ex]); mx = fmaxf(mx, lg[ex]); }
        float sum = 0.f;
#pragma unroll
        for (int ex = 0; ex < NE; ++ex) { lg[ex] = expf(lg[ex] - mx); sum += lg[ex]; }
        if (e.gl == 0) {
#pragma unroll
            for (int ex = 0; ex < NE; ++ex) p.aff[(size_t)R * NE + ex] = lg[ex] / sum; }
    }
}
HD void ph_topk(const Params& p, int layer, Exec e) {
    const bool last = layer == DEPTH - 1;
    const int nl = BATCH * NE * SEQ, nc = last ? 0 : BATCH * NE * CTX, npad = NE * (NSLOT - NSLOT_L - (last ? 0 : NSLOT_C));
    for (int it = e.gid; it < nl + nc + npad; it += e.ngroups) {
        if (it >= nl + nc) { const int q = it - nl - nc, per = npad / NE, ex = q / per, j = NSLOT - per + q % per;
            p.sel_row[ex * NSLOT + j] = 0; p.sel_gate[ex * NSLOT + j] = 0.f; continue; }
        int seg, b, ex, t, L, base, cap, jbase;
        if (it < nl) { seg = 0; t = it % SEQ; ex = (it / SEQ) % NE; b = it / (SEQ * NE); L = SEQ; base = b * TOK + CTX; cap = CAPL; jbase = b * CAPL; }
        else { const int q = it - nl; seg = 1; t = q % CTX; ex = (q / CTX) % NE; b = q / (CTX * NE); L = CTX; base = b * TOK; cap = CAPC; jbase = NSLOT_L + b * CAPC; }
        (void)seg;
        const float a = p.aff[(size_t)(base + t) * NE + ex];
        int rank = 0;
        for (int u = 0; u < L; ++u) { const float au = p.aff[(size_t)(base + u) * NE + ex]; rank += (au > a || (au == a && u < t)) ? 1 : 0; }
        if (rank < cap) { const int j = jbase + rank; p.sel_row[ex * NSLOT + j] = base + t; p.sel_gate[ex * NSLOT + j] = a; p.inv[(size_t)(base + t) * NE + ex] = j; }
        else p.inv[(size_t)(base + t) * NE + ex] = -1;
    }
}
template <int G> HD void ph_gather(const Params& p, int layer, Exec e) {
    const bool last = layer == DEPTH - 1;
    const int nj = last ? NSLOT_L : NSLOT;
    for (int it = e.gid; it < NE * nj; it += e.ngroups) {
        const int ex = it / nj, j = it % nj, R = p.sel_row[ex * NSLOT + j];
        const uint4* s = (const uint4*)(p.h + (size_t)R * D_MODEL); uint4* d = (uint4*)(p.xs + ((size_t)ex * NSLOT + j) * D_MODEL);
        for (int c = e.gl; c < D_MODEL / 8; c += G) d[c] = s[c];
    }
}

template <int G> HD void ph_rw_prep1(const Params& p, int layer, Exec e) {
    const float* mu = p.rw_mu + (size_t)layer * 2 * RW_COLS;
    for (int R = e.gid; R < MROWS; R += e.ngroups) {
        const int s = row_s(R); const bool hp = (s != 0 && s != CTX), hn = (s != CTX - 1 && s != TOK - 1);
        const float* pr = p.P + (size_t)R * LDP + RW_OFF;
        for (int c = e.gl; c < RW_COLS; c += G) {
            const float v = pr[c], pv = hp ? pr[c - LDP] : 0.f, nv = hn ? pr[c + LDP] : 0.f;
            const float pp = v + mu[c] * (pv - v) + mu[RW_COLS + c] * (nv - v);
            if (c < GROUP_W) p.rw_r[(size_t)R * GROUP_W + c] = pp;
            else if (c < 2 * GROUP_W) p.rw_k[(size_t)R * GROUP_W + c - GROUP_W] = pp;
            else if (c < 3 * GROUP_W) p.rw_v[(size_t)R * GROUP_W + c - 2 * GROUP_W] = pp;
            else { const int q = c - 3 * GROUP_W; float o;
                if (q < RW_DR) o = tanhf(pp); else if (q < RW_DR + RW_IR) o = pp; else o = sigmoidf_(pp);
                p.rw_lr[(size_t)R * RW_LR + q] = o; }
        }
    }
}
template <int G> HD void ph_rw_prep2(const Params& p, int layer, Exec e) {
    static_assert(G <= RW_HEAD, "G");
    const float *gup = p.rw_g_up + (size_t)layer * RW_GR * GROUP_W, *kk_w = p.rw_k_k + layer * GROUP_W, *ka_w = p.rw_k_a + layer * GROUP_W;
    for (int R = e.gid; R < MROWS; R += e.ngroups) {
        const float* lr = p.rw_lr + (size_t)R * RW_LR; const float* kr = p.rw_k + (size_t)R * GROUP_W;
        for (int hh = 0; hh < RW_HEADS; ++hh) {
            float ss = 0.f;
            for (int j = hh * RW_HEAD + e.gl; j < (hh + 1) * RW_HEAD; j += G) { const float xk = kr[j] * kk_w[j]; ss += xk * xk; }
            ss = group_sum<G>(ss);
            const float rn = 1.f / sqrtf(ss + 1e-6f);
            for (int j = hh * RW_HEAD + e.gl; j < (hh + 1) * RW_HEAD; j += G) {
                const float kv = kr[j], kkv = kv * kk_w[j] * rn;
                p.rw_kk[(size_t)R * GROUP_W + j] = kkv;
                float g = 0.f;
                for (int i = 0; i < RW_GR; ++i) g += lr[RW_DR + RW_IR + i] * gup[i * GROUP_W + j];
                p.rw_g[(size_t)R * GROUP_W + j] = g;
                for (int d = 0; d < 2; ++d) {
                    const float *wup = p.rw_w_up + ((size_t)(layer * 2 + d) * RW_DR) * GROUP_W, *aup = p.rw_a_up + ((size_t)(layer * 2 + d) * RW_IR) * GROUP_W;
                    float wl = p.rw_w0[(layer * 2 + d) * GROUP_W + j], al = p.rw_a0[(layer * 2 + d) * GROUP_W + j];
                    for (int i = 0; i < RW_DR; ++i) wl += lr[i] * wup[i * GROUP_W + j];
                    for (int i = 0; i < RW_IR; ++i) al += lr[RW_DR + i] * aup[i * GROUP_W + j];
                    const float logw = -RW_DECAY_SCALE * sigmoidf_(wl), a = sigmoidf_(al);
                    const size_t o = ((size_t)d * MROWS + R) * GROUP_W + j;
                    p.rw_ew[o] = expf(logw); p.rw_kka[o] = kkv * a; p.rw_kt[o] = kv * (1.f + (a - 1.f) * ka_w[j]);
                }
            }
        }
    }
}
template <int G> HD void ph_rw_scan(const Params& p, Exec e) {
    constexpr int KPL = RW_HEAD / G;
    for (int it = e.gid; it < RW_CH * RW_HEAD; it += e.ngroups) {
        const int i = it % RW_HEAD, ch = it / RW_HEAD, d = ch % 2, hh = (ch / 2) % RW_HEADS, b = ch / (2 * RW_HEADS);
        float S[KPL];
#pragma unroll
        for (int q = 0; q < KPL; ++q) S[q] = 0.f;
        const int k0 = hh * RW_HEAD + e.gl * KPL;
        for (int pos = 0; pos < TOK; ++pos) {
            const int R = b * TOK + seq_s(d, pos);
            const size_t o1 = (size_t)R * GROUP_W + k0, o2 = ((size_t)d * MROWS + R) * GROUP_W + k0;
            const float vv = p.rw_v[(size_t)R * GROUP_W + hh * RW_HEAD + i];
            float sk = 0.f;
#pragma unroll
            for (int q = 0; q < KPL; ++q) sk += S[q] * p.rw_kk[o1 + q];
            sk = group_sum<G>(sk);
            float y = 0.f;
#pragma unroll
            for (int q = 0; q < KPL; ++q) { S[q] = S[q] * p.rw_ew[o2 + q] - sk * p.rw_kka[o2 + q] + vv * p.rw_kt[o2 + q]; y += S[q] * p.rw_r[o1 + q]; }
            y = group_sum<G>(y);
            if (e.gl == 0) p.rw_y[((size_t)d * MROWS + R) * GROUP_W + hh * RW_HEAD + i] = y;
        }
    }
}
template <int G> HD void ph_rw_post(const Params& p, int layer, Exec e) {
    static_assert(G <= RW_HEAD, "G");
    const float *lw = p.rw_ln_w + layer * GROUP_W, *lb = p.rw_ln_b + layer * GROUP_W, *rk = p.rw_r_k + layer * GROUP_W;
    for (int it = e.gid; it < MROWS * RW_HEADS; it += e.ngroups) {
        const int R = it / RW_HEADS, hh = it % RW_HEADS; const size_t o = (size_t)R * GROUP_W + hh * RW_HEAD, o2 = (size_t)MROWS * GROUP_W;
        float s1 = 0.f, bon = 0.f;
        for (int j = e.gl; j < RW_HEAD; j += G) { s1 += p.rw_y[o + j] + p.rw_y[o2 + o + j];
            bon += p.rw_r[o + j] * (p.rw_kt[o + j] + p.rw_kt[o2 + o + j]) * rk[hh * RW_HEAD + j]; }
        s1 = group_sum<G>(s1); bon = group_sum<G>(bon);
        const float mean = s1 / RW_HEAD;
        float s2 = 0.f;
        for (int j = e.gl; j < RW_HEAD; j += G) { const float dlt = p.rw_y[o + j] + p.rw_y[o2 + o + j] - mean; s2 += dlt * dlt; }
        s2 = group_sum<G>(s2);
        const float rstd = 1.f / sqrtf(s2 / RW_HEAD + RW_GN_EPS);
        for (int j = e.gl; j < RW_HEAD; j += G) { const float y = (p.rw_y[o + j] + p.rw_y[o2 + o + j] - mean) * rstd * lw[hh * RW_HEAD + j] + lb[hh * RW_HEAD + j];
            p.mix[(size_t)R * D_MODEL + hh * RW_HEAD + j] = f2bf((y + bon * p.rw_v[o + j]) * p.rw_g[o + j]); }
    }
}

HD void ml_chain(int ch, int& b, int& hh, int& d) { d = ch % 2; hh = (ch / 2) % ML_HEADS; b = ch / (2 * ML_HEADS); }
HD void ph_ml_g1(const Params& p, int layer, Exec e) {
    for (int it = e.gid; it < ML_CH * NCHUNK; it += e.ngroups) {
        const int ch = it / NCHUNK, n = it % NCHUNK; int b, hh, d; ml_chain(ch, b, hh, d);
        const float ib = p.ml_ib[(layer * 2 + d) * ML_HEADS + hh], fb = p.ml_fb[(layer * 2 + d) * ML_HEADS + hh];
        float bc = 0.f, gm = -1e30f;
        for (int t = 0; t < CHUNK; ++t) { const int pos = n * CHUNK + t, R = b * TOK + seq_s(d, pos);
            const float* g = p.P + (size_t)R * LDP + ML_OFF + 4 * GROUP_W;
            const float li = g[d * ML_HEADS + hh] + ib, lf = logsigmoidf_(g[(2 + d) * ML_HEADS + hh] + fb);
            bc += lf; const float gv = li - bc; gm = fmaxf(gm, gv);
            p.ml_bcum[(size_t)ch * TOK + pos] = bc; p.ml_g[(size_t)ch * TOK + pos] = gv; p.ml_gmax[(size_t)ch * TOK + pos] = gm; }
        p.ml_bl[ch * NCHUNK + n] = bc; p.ml_gm[ch * NCHUNK + n] = gm;
    }
}
HD void ph_ml_g2(const Params& p, Exec e) {
    for (int ch = e.gid; ch < ML_CH; ch += e.ngroups) { float m = 0.f;
        for (int n = 0; n < NCHUNK; ++n) { p.ml_min[ch * NCHUNK + n] = m; m = p.ml_bl[ch * NCHUNK + n] + fmaxf(m, p.ml_gm[ch * NCHUNK + n]); } }
}
HD void ph_ml_dC(const Params& p, Exec e) {
    const float ksc = 1.f / sqrtf((float)ML_HEAD);
    const int n1 = ML_CH * NCHUNK * ML_HEAD * ML_HEAD, n2 = ML_CH * NCHUNK * ML_HEAD;
    for (int it = e.gid; it < n1 + n2; it += e.ngroups) {
        const bool isn = it >= n1; const int q = isn ? it - n1 : it;
        const int dd = q % ML_HEAD, ee = isn ? 0 : (q / ML_HEAD) % ML_HEAD, cn = isn ? q / ML_HEAD : q / (ML_HEAD * ML_HEAD), n = cn % NCHUNK, ch = cn / NCHUNK;
        int b, hh, d; ml_chain(ch, b, hh, d);
        const float min_ = p.ml_min[cn], bl = p.ml_bl[cn], mnew = bl + fmaxf(min_, p.ml_gm[cn]);
        float acc = 0.f;
        for (int s = 0; s < CHUNK; ++s) { const int pos = n * CHUNK + s, R = b * TOK + seq_s(d, pos);
            const float wk = expf(bl + p.ml_g[(size_t)ch * TOK + pos] - mnew);
            const float* pr = p.P + (size_t)R * LDP + ML_OFF + hh * ML_HEAD;
            const float kv = pr[GROUP_W + dd] * ksc;
            acc += isn ? wk * kv : wk * kv * pr[2 * GROUP_W + ee]; }
        if (isn) p.ml_dn[(size_t)cn * ML_HEAD + dd] = acc; else p.ml_dC[((size_t)cn * ML_HEAD + ee) * ML_HEAD + dd] = acc;
    }
}
HD void ph_ml_prefix(const Params& p, Exec e) {
    const int n1 = ML_CH * ML_HEAD * ML_HEAD, n2 = ML_CH * ML_HEAD;
    for (int it = e.gid; it < n1 + n2; it += e.ngroups) {
        const bool isn = it >= n1; const int q = isn ? it - n1 : it, per = isn ? ML_HEAD : ML_HEAD * ML_HEAD, ch = q / per, el = q % per;
        float* arr = isn ? p.ml_dn : p.ml_dC; float st = 0.f;
        for (int n = 0; n < NCHUNK; ++n) { const int cn = ch * NCHUNK + n;
            const float min_ = p.ml_min[cn], bl = p.ml_bl[cn], mnew = bl + fmaxf(min_, p.ml_gm[cn]), dc = expf(bl + min_ - mnew);
            const size_t o = (size_t)cn * per + el; const float inc = arr[o]; arr[o] = st; st = dc * st + inc; }
    }
}
HD void ph_ml_S(const Params& p, Exec e) {
    const float ksc = 1.f / sqrtf((float)ML_HEAD);
    for (int it = e.gid; it < ML_CH * NCHUNK * CHUNK * CHUNK; it += e.ngroups) {
        const int s = it % CHUNK, t = (it / CHUNK) % CHUNK, cn = it / (CHUNK * CHUNK), n = cn % NCHUNK, ch = cn / NCHUNK;
        float v = 0.f;
        if (s <= t) { int b, hh, d; ml_chain(ch, b, hh, d);
            const int pt = n * CHUNK + t, ps = n * CHUNK + s, Rt = b * TOK + seq_s(d, pt), Rs = b * TOK + seq_s(d, ps);
            const float* qr = p.P + (size_t)Rt * LDP + ML_OFF + hh * ML_HEAD; const float* kr = p.P + (size_t)Rs * LDP + ML_OFF + GROUP_W + hh * ML_HEAD;
            float dot = 0.f; for (int k = 0; k < ML_HEAD; ++k) dot += qr[k] * kr[k];
            const float bt = p.ml_bcum[(size_t)ch * TOK + pt], mt = bt + fmaxf(p.ml_min[cn], p.ml_gmax[(size_t)ch * TOK + pt]);
            v = dot * ksc * expf(bt + p.ml_g[(size_t)ch * TOK + ps] - mt); }
        p.ml_S[it] = v;
    }
}
HD void ph_ml_out(const Params& p, Exec e) {
    for (int it = e.gid; it < ML_CH * NCHUNK * CHUNK * ML_HEAD; it += e.ngroups) {
        const int ee = it % ML_HEAD, t = (it / ML_HEAD) % CHUNK, cn = it / (ML_HEAD * CHUNK), n = cn % NCHUNK, ch = cn / NCHUNK;
        int b, hh, d; ml_chain(ch, b, hh, d);
        const int pt = n * CHUNK + t, Rt = b * TOK + seq_s(d, pt);
        const float bt = p.ml_bcum[(size_t)ch * TOK + pt], min_ = p.ml_min[cn], mt = bt + fmaxf(min_, p.ml_gmax[(size_t)ch * TOK + pt]), wi = expf(bt + min_ - mt);
        const float* Sr = p.ml_S + ((size_t)cn * CHUNK + t) * CHUNK;
        float num = 0.f, den = 0.f;
        for (int s = 0; s <= t; ++s) { const int Rs = b * TOK + seq_s(d, n * CHUNK + s); const float sv = Sr[s];
            num += sv * p.P[(size_t)Rs * LDP + ML_OFF + 2 * GROUP_W + hh * ML_HEAD + ee]; den += sv; }
        const float* qr = p.P + (size_t)Rt * LDP + ML_OFF + hh * ML_HEAD;
        const float* Cr = p.ml_dC + ((size_t)cn * ML_HEAD + ee) * ML_HEAD; const float* nr = p.ml_dn + (size_t)cn * ML_HEAD;
        float cq = 0.f, nq = 0.f;
        for (int k = 0; k < ML_HEAD; ++k) { cq += Cr[k] * qr[k]; nq += nr[k] * qr[k]; }
        num += wi * cq; den += wi * nq;
        p.ml_hh[((size_t)d * MROWS + Rt) * GROUP_W + hh * ML_HEAD + ee] = num / fmaxf(fabsf(den), expf(-mt));
    }
}
template <int G> HD void ph_ml_post(const Params& p, int layer, Exec e) {
    const float* ng = p.ml_norm_g + layer * GROUP_W;
    for (int it = e.gid; it < MROWS * ML_HEADS; it += e.ngroups) {
        const int R = it / ML_HEADS, hh = it % ML_HEADS; const size_t o = (size_t)R * GROUP_W + hh * ML_HEAD, o2 = (size_t)MROWS * GROUP_W;
        float s1 = 0.f;
        for (int j = e.gl; j < ML_HEAD; j += G) s1 += p.ml_hh[o + j] + p.ml_hh[o2 + o + j];
        s1 = group_sum<G>(s1); const float mean = s1 / ML_HEAD;
        float s2 = 0.f;
        for (int j = e.gl; j < ML_HEAD; j += G) { const float dlt = p.ml_hh[o + j] + p.ml_hh[o2 + o + j] - mean; s2 += dlt * dlt; }
        s2 = group_sum<G>(s2); const float rstd = 1.f / sqrtf(s2 / ML_HEAD + NORM_EPS);
        for (int j = e.gl; j < ML_HEAD; j += G) { const float y = (p.ml_hh[o + j] + p.ml_hh[o2 + o + j] - mean) * rstd * ng[hh * ML_HEAD + j];
            const float og = p.P[(size_t)R * LDP + ML_OFF + 3 * GROUP_W + hh * ML_HEAD + j];
            p.mix[(size_t)R * D_MODEL + GROUP_W + hh * ML_HEAD + j] = f2bf(y * sigmoidf_(og)); }
    }
}

HD float gd_conv_silu(const Params& p, int layer, int R, int c) {
    const int s = row_s(R); const float* pr = p.P + (size_t)R * LDP + GD_OFF + c; const float* cw = p.gd_conv + (size_t)layer * 3 * 3 * GROUP_W + c;
    float v = pr[0] * cw[3 * GROUP_W];
    if (s != 0 && s != CTX) v += pr[-LDP] * cw[0];
    if (s != CTX - 1 && s != TOK - 1) v += pr[LDP] * cw[2 * 3 * GROUP_W];
    return siluf_(v);
}
template <int G> HD void ph_gd_prep(const Params& p, int layer, Exec e) {
    const float qsc = 1.f / sqrtf((float)GD_HEAD);
    for (int it = e.gid; it < MROWS * GD_HEADS; it += e.ngroups) {
        const int R = it / GD_HEADS, hh = it % GD_HEADS;
        float sq = 0.f, sk = 0.f;
        for (int j = e.gl; j < GD_HEAD; j += G) { const float a = gd_conv_silu(p, layer, R, hh * GD_HEAD + j), b2 = gd_conv_silu(p, layer, R, GROUP_W + hh * GD_HEAD + j); sq += a * a; sk += b2 * b2; }
        sq = group_sum<G>(sq); sk = group_sum<G>(sk);
        const float rq = qsc / sqrtf(sq + 1e-6f), rk = 1.f / sqrtf(sk + 1e-6f);
        for (int j = e.gl; j < GD_HEAD; j += G) { const size_t o = (size_t)R * GROUP_W + hh * GD_HEAD + j;
            p.gd_q[o] = gd_conv_silu(p, layer, R, hh * GD_HEAD + j) * rq; p.gd_k[o] = gd_conv_silu(p, layer, R, GROUP_W + hh * GD_HEAD + j) * rk;
            p.gd_v[o] = gd_conv_silu(p, layer, R, 2 * GROUP_W + hh * GD_HEAD + j); }
    }
}
HD void ph_gd_gates(const Params& p, int layer, Exec e) {
    for (int it = e.gid; it < GD_CH * NCHUNK; it += e.ngroups) {
        const int ch = it / NCHUNK, n = it % NCHUNK; int b, hh, d; ml_chain(ch, b, hh, d);
        const float al = expf(p.gd_a_log[(layer * 2 + d) * GD_HEADS + hh]), dtb = p.gd_dt_bias[(layer * 2 + d) * GD_HEADS + hh];
        float gc = 0.f;
        for (int t = 0; t < CHUNK; ++t) { const int pos = n * CHUNK + t, R = b * TOK + seq_s(d, pos);
            const float* g = p.P + (size_t)R * LDP + GD_OFF + 4 * GROUP_W;
            gc += -al * softplusf_(g[d * GD_HEADS + hh] + dtb);
            p.gd_gc[(size_t)ch * TOK + pos] = gc; p.gd_beta[(size_t)ch * TOK + pos] = sigmoidf_(g[(2 + d) * GD_HEADS + hh]); }
    }
}
HD void ph_gd_A(const Params& p, Exec e) {
    for (int it = e.gid; it < GD_CH * NCHUNK * CHUNK * CHUNK; it += e.ngroups) {
        const int j = it % CHUNK, i = (it / CHUNK) % CHUNK, cn = it / (CHUNK * CHUNK), n = cn % NCHUNK, ch = cn / NCHUNK;
        float a = 0.f, at = 0.f;
        if (j <= i) { int b, hh, d; ml_chain(ch, b, hh, d);
            const int pi = n * CHUNK + i, pj = n * CHUNK + j, Ri = b * TOK + seq_s(d, pi), Rj = b * TOK + seq_s(d, pj);
            const float *ki = p.gd_k + (size_t)Ri * GROUP_W + hh * GD_HEAD, *kj = p.gd_k + (size_t)Rj * GROUP_W + hh * GD_HEAD, *qi = p.gd_q + (size_t)Ri * GROUP_W + hh * GD_HEAD;
            float kk = 0.f, qk = 0.f; for (int k = 0; k < GD_HEAD; ++k) { kk += ki[k] * kj[k]; qk += qi[k] * kj[k]; }
            const float dec = expf(p.gd_gc[(size_t)ch * TOK + pi] - p.gd_gc[(size_t)ch * TOK + pj]);
            at = qk * dec; if (j < i) a = p.gd_beta[(size_t)ch * TOK + pi] * kk * dec; }
        p.gd_A[it] = a; p.gd_attn[it] = at;
    }
}
HD void ph_gd_solve(const Params& p, Exec e) {
    for (int it = e.gid; it < GD_CH * NCHUNK * 2 * GD_HEAD; it += e.ngroups) {
        const int c = it % (2 * GD_HEAD), cn = it / (2 * GD_HEAD), n = cn % NCHUNK, ch = cn / NCHUNK; int b, hh, d; ml_chain(ch, b, hh, d);
        const bool isw = c >= GD_HEAD; const int cc = isw ? c - GD_HEAD : c;
        float* sol = (isw ? p.gd_w : p.gd_u) + (size_t)cn * CHUNK * GD_HEAD + cc;
        const float* A = p.gd_A + (size_t)cn * CHUNK * CHUNK;
        for (int i = 0; i < CHUNK; ++i) { const int pi = n * CHUNK + i, Ri = b * TOK + seq_s(d, pi);
            const float beta = p.gd_beta[(size_t)ch * TOK + pi];
            float acc = isw ? p.gd_k[(size_t)Ri * GROUP_W + hh * GD_HEAD + cc] * beta * expf(p.gd_gc[(size_t)ch * TOK + pi]) : p.gd_v[(size_t)Ri * GROUP_W + hh * GD_HEAD + cc] * beta;
            for (int j = 0; j < i; ++j) acc -= A[i * CHUNK + j] * sol[(size_t)j * GD_HEAD];
            sol[(size_t)i * GD_HEAD] = acc; }
    }
}
constexpr int GD_EC = 16, GD_NCB = GD_HEAD / GD_EC, GD_SCAN_SMEM = (GD_HEAD + CHUNK) * GD_EC;
#ifdef CPU_TEST
#define BLOCK_SYNC()
#define BLOCK_FOR(i, n) for (int i = 0; i < (n); ++i)
#else
#define BLOCK_SYNC() __syncthreads()
#define BLOCK_FOR(i, n) for (int i = tid; i < (n); i += nthr)
#endif
HD void ph_gd_scan_unit(const Params& p, int unit, int tid, int nthr, float* smem) {
    (void)tid; (void)nthr;
    const int cb = unit % GD_NCB, ch = unit / GD_NCB, e0 = cb * GD_EC; int b, hh, d; ml_chain(ch, b, hh, d);
    float* S = smem; float* vn = smem + GD_HEAD * GD_EC;
    BLOCK_FOR(i, GD_HEAD * GD_EC) S[i] = 0.f;
    BLOCK_SYNC();
    for (int n = 0; n < NCHUNK; ++n) {
        const int cn = ch * NCHUNK + n; const float* gcp = p.gd_gc + (size_t)ch * TOK + n * CHUNK;
        const float* U = p.gd_u + (size_t)cn * CHUNK * GD_HEAD; const float* W = p.gd_w + (size_t)cn * CHUNK * GD_HEAD; const float* AT = p.gd_attn + (size_t)cn * CHUNK * CHUNK;
        BLOCK_FOR(i, CHUNK * GD_EC) { const int t = i / GD_EC, ee = i % GD_EC; float acc = U[t * GD_HEAD + e0 + ee];
            for (int k = 0; k < GD_HEAD; ++k) acc -= W[t * GD_HEAD + k] * S[k * GD_EC + ee];
            vn[t * GD_EC + ee] = acc; }
        BLOCK_SYNC();
        BLOCK_FOR(i, CHUNK * GD_EC) { const int t = i / GD_EC, ee = i % GD_EC, Rt = b * TOK + seq_s(d, n * CHUNK + t);
            const float* qr = p.gd_q + (size_t)Rt * GROUP_W + hh * GD_HEAD; const float eg = expf(gcp[t]);
            float acc = 0.f;
            for (int k = 0; k < GD_HEAD; ++k) acc += qr[k] * S[k * GD_EC + ee];
            acc *= eg;
            for (int j = 0; j <= t; ++j) acc += AT[t * CHUNK + j] * vn[j * GD_EC + ee];
            p.gd_o[((size_t)d * MROWS + Rt) * GROUP_W + hh * GD_HEAD + e0 + ee] = acc; }
        BLOCK_SYNC();
        BLOCK_FOR(i, GD_HEAD * GD_EC) { const int k = i / GD_EC, ee = i % GD_EC; const float gl = gcp[CHUNK - 1];
            float acc = S[i] * expf(gl);
            for (int t = 0; t < CHUNK; ++t) { const int Rt = b * TOK + seq_s(d, n * CHUNK + t);
                acc += p.gd_k[(size_t)Rt * GROUP_W + hh * GD_HEAD + k] * expf(gl - gcp[t]) * vn[t * GD_EC + ee]; }
            S[i] = acc; }
        BLOCK_SYNC();
    }
}
template <int G> HD void ph_gd_post(const Params& p, int layer, Exec e) {
    const float* ng = p.gd_norm_g + layer * GD_HEAD;
    for (int it = e.gid; it < MROWS * GD_HEADS; it += e.ngroups) {
        const int R = it / GD_HEADS, hh = it % GD_HEADS; const size_t o = (size_t)R * GROUP_W + hh * GD_HEAD, o2 = (size_t)MROWS * GROUP_W;
        float ss = 0.f;
        for (int j = e.gl; j < GD_HEAD; j += G) { const float v = p.gd_o[o + j] + p.gd_o[o2 + o + j]; ss += v * v; }
        ss = group_sum<G>(ss); const float rstd = 1.f / sqrtf(ss / GD_HEAD + NORM_EPS);
        for (int j = e.gl; j < GD_HEAD; j += G) { const float v = (p.gd_o[o + j] + p.gd_o[o2 + o + j]) * rstd * ng[j];
            const float g = p.P[(size_t)R * LDP + GD_OFF + 3 * GROUP_W + hh * GD_HEAD + j];
            p.mix[(size_t)R * D_MODEL + 2 * GROUP_W + hh * GD_HEAD + j] = f2bf(v * siluf_(g)); }
    }
}

template <int G> HD void ph_at_prep(const Params& p, int layer, Exec e) {
    constexpr int NHS = AT_QH + 2 * AT_KVH, HALF = AT_HEAD / 2, QTR = AT_HEAD / 4;
    for (int it = e.gid; it < MROWS * NHS; it += e.ngroups) {
        const int R = it / NHS, hs = it % NHS, b = row_b(R), s = row_s(R);
        const float* pr = p.P + (size_t)R * LDP + AT_OFF + hs * AT_HEAD;
        u16* dst; const float* g = nullptr;
        if (hs < AT_QH) { dst = p.at_q + (((size_t)b * AT_QH + hs) * TOK + s) * AT_HEAD; g = p.at_q_norm + layer * AT_HEAD; }
        else if (hs < AT_QH + AT_KVH) { dst = p.at_k + (((size_t)b * AT_KVH + hs - AT_QH) * TOK + s) * AT_HEAD; g = p.at_k_norm + layer * AT_HEAD; }
        else dst = p.at_v + (((size_t)b * AT_KVH + hs - AT_QH - AT_KVH) * TOK + s) * AT_HEAD;
        if (!g) { for (int j = e.gl; j < AT_HEAD; j += G) dst[j] = f2bf(pr[j]); continue; }
        float ss = 0.f;
        for (int j = e.gl; j < AT_HEAD; j += G) ss += pr[j] * pr[j];
        ss = group_sum<G>(ss); const float rstd = 1.f / sqrtf(ss / AT_HEAD + NORM_EPS);
        if (s < CTX) { for (int j = e.gl; j < AT_HEAD; j += G) dst[j] = f2bf(pr[j] * rstd * g[j]); continue; }
        const int t = s - CTX; const float posr = (float)(t / GRID_W), posc = (float)(t % GRID_W);
        for (int j = e.gl; j < AT_HEAD; j += G) {
            const int half = j / HALF, jj = j % HALF, fi = jj % QTR; const bool second = jj >= QTR;
            const float ang = (half ? posc : posr) * powf(10000.f, -(float)(2 * fi) / (float)HALF);
            const float cs = cosf(ang), sn = sinf(ang);
            const int jp = second ? j - QTR : j + QTR;
            const float own = pr[j] * rstd * g[j], oth = pr[jp] * rstd * g[jp];
            dst[j] = f2bf(second ? own * cs + oth * sn : own * cs - oth * sn);
        }
    }
}

#include <cstdio>
#include <cstddef>
static_assert(D_MODEL == 2048 && CTX == 256 && SEQ % 256 == 0 && AT_HEAD == 128, "GPU part is written for the full configuration");

#define XB_TMO      128
#define XB_XCNT(j)  (256  + 64 * (j))
#define XB_XSUB(j)  (1280 + 64 * (j))
#define XB_XGEN(j)  (2304 + 64 * (j))
#define XB_TOP      3328
#define XB_TOPGEN   3392
#define XCD_BAR_WORDS 3456
#define XB_SPIN_CAP (1u << 24)
#define LAS __attribute__((address_space(3)))
__device__ __forceinline__ unsigned xb_ld(unsigned* p)              { return __hip_atomic_load(p, __ATOMIC_RELAXED, __HIP_MEMORY_SCOPE_AGENT); }
__device__ __forceinline__ unsigned xb_add(unsigned* p, unsigned v) { return __hip_atomic_fetch_add(p, v, __ATOMIC_RELAXED, __HIP_MEMORY_SCOPE_AGENT); }
__device__ __forceinline__ unsigned xb_xcc_id() { return (unsigned)__builtin_amdgcn_s_getreg((3 << 11) | 20) & 0xFu; }
#define XB_SPIN(cond, bar) do { unsigned _sp = 0; while (cond) { __builtin_amdgcn_s_sleep(1); \
    if ((++_sp & 255u) == 0u) { if (xb_ld(&(bar)[XB_TMO])) break; if (_sp > XB_SPIN_CAP) { atomicAdd(&(bar)[XB_TMO], 1u); break; } } } } while (0)
struct XcdBarrier { unsigned* bar; unsigned x; volatile LAS unsigned* st; };
__device__ __forceinline__ XcdBarrier xcd_barrier_post(unsigned* bar, volatile LAS unsigned* st) {
    XcdBarrier b; b.bar = bar; b.x = xb_xcc_id(); b.st = st;
    if (threadIdx.x == 0) (void)xb_add(&bar[XB_XCNT(b.x)], 1u);
    return b;
}
__device__ __forceinline__ void xcd_barrier_complete(unsigned* bar, unsigned x, unsigned& nloc, unsigned& nx) {
    const unsigned G = gridDim.x * gridDim.y * gridDim.z;
    unsigned sum, cnt, mine, sp = 0u;
    for (;;) {
        sum = 0u; cnt = 0u; mine = 0u;
#pragma unroll
        for (unsigned j = 0; j < 16; ++j) { const unsigned c = xb_ld(&bar[XB_XCNT(j)]); sum += c; cnt += (c > 0u) ? 1u : 0u; mine = (j == x) ? c : mine; }
        if (sum == G) break;
        __builtin_amdgcn_s_sleep(1);
        if ((++sp & 255u) == 0u) { if (xb_ld(&bar[XB_TMO])) break; if (sp > XB_SPIN_CAP) { atomicAdd(&bar[XB_TMO], 1u); break; } }
    }
    nloc = mine > 0u ? mine : 1u; nx = cnt > 0u ? cnt : 1u;
}
__device__ __forceinline__ void xcd_barrier(const XcdBarrier& b) {
    asm volatile("s_waitcnt vmcnt(0)" ::: "memory");
    __syncthreads();
    if (threadIdx.x == 0) {
        unsigned* bar = b.bar;
        __builtin_amdgcn_s_waitcnt(0);
        unsigned nloc = b.st[0], nx = b.st[1];
        if (nloc == 0u) { xcd_barrier_complete(bar, b.x, nloc, nx); b.st[0] = nloc; b.st[1] = nx; }
        const unsigned old = xb_add(&bar[XB_XSUB(b.x)], 1u);
        const unsigned gen = old / nloc;
        if (old + 1u == (gen + 1u) * nloc) {
            __builtin_amdgcn_fence(__ATOMIC_RELEASE, "agent");
            asm volatile("s_waitcnt vmcnt(0)" ::: "memory");
            const unsigned og = xb_add(&bar[XB_TOP], 1u);
            const unsigned tg = og / nx;
            if (og + 1u == (tg + 1u) * nx) xb_add(&bar[XB_TOPGEN], 1u);
            else XB_SPIN(xb_ld(&bar[XB_TOPGEN]) == tg, bar);
            __builtin_amdgcn_fence(__ATOMIC_ACQUIRE, "agent");
            xb_add(&bar[XB_XGEN(b.x)], 1u);
            asm volatile("s_waitcnt vmcnt(0)" ::: "memory");
        } else {
            XB_SPIN(xb_ld(&bar[XB_XGEN(b.x)]) == gen, bar);
            __builtin_amdgcn_fence(__ATOMIC_ACQUIRE, "agent");
            asm volatile("s_waitcnt vmcnt(0)" ::: "memory");
        }
    }
    __syncthreads();
}

namespace pg8 {
#define PG8_LAS __attribute__((address_space(3)))
typedef unsigned short bf16_t;
typedef short bf16x8 __attribute__((ext_vector_type(8)));
typedef float f32x4 __attribute__((ext_vector_type(4)));
typedef unsigned u32x4 __attribute__((ext_vector_type(4)));
constexpr int BM = 256, BK = 64, HALF = 128, HTB = HALF * BK * 2  , STAGE_BYTES = 8 * HTB, NXCD = 8, WGM = 8;

__host__ __device__ __forceinline__ int lds_byte(int r, int c) { const int st = (r >> 4) * 2 + (c >> 5), rr = r & 15, cc = c & 31, ob = rr * 64 + cc * 2; return st * 1024 + (ob ^ (((ob >> 9) & 1) << 5)); }
__host__ __device__ __forceinline__ void stage_rc(int b, int& R, int& C) { const int st = b / 1024, sb = b % 1024, swz = sb ^ (((sb >> 9) & 1) << 5); R = (st >> 1) * 16 + swz / 64; C = (st & 1) * 32 + (swz % 64) / 2; }
__host__ __device__ __forceinline__ int perm32(int rho) { const int n = rho >> 4, i = rho & 15; return 8 * (i >> 2) + 4 * n + (i & 3); }

struct Unit { int pm, pn; };
struct Gemm { const bf16_t* A; const bf16_t* Bt; int M, N, K; };

struct StaticOrder {
    int nM, nN, nwg, G, c;
    __host__ __device__ void init(int M, int N, int G_, int c_) { nM = M / BM; nN = N / BM; nwg = nM * nN; G = G_; c = c_; }
    __host__ __device__ bool next(int i, Unit& u) const {
        const long L = (long)i * G + c; if (L >= nwg) return false;
        int wgid = (int)L; { const int q = nwg / NXCD, r = nwg % NXCD, xcd = wgid % NXCD, off = wgid / NXCD; wgid = (xcd < r ? xcd * (q + 1) : r * (q + 1) + (xcd - r) * q) + off; }
        const int nig = WGM * nN, gid = wgid / nig, fm = gid * WGM, gsz = (nM - fm) < WGM ? (nM - fm) : WGM;
        u.pm = fm + ((wgid % nig) % gsz); u.pn = (wgid % nig) / gsz; return true;
    }
    __device__ __forceinline__ void a_ready(const Unit&) const {}
    __device__ __forceinline__ void done(const Unit&) const {}
};
__device__ __forceinline__ unsigned cvt_pk_bf16(float lo, float hi) { unsigned r; asm volatile("v_cvt_pk_bf16_f32 %0, %1, %2" : "=v"(r) : "v"(lo), "v"(hi)); return r; }
typedef unsigned u32x2v __attribute__((ext_vector_type(2)));

struct TileOrder {
    int nI, nJ, nwg, G, c, latent_only;
    __device__ void init(int nI_, int nJ_, int G_, int c_, int lat) { nI = nI_; nJ = nJ_; nwg = nI * nJ; G = G_; c = c_; latent_only = lat; }
    __device__ bool next(int i, Unit& u) const { const long L = (long)i * G + c; if (L >= nwg) return false;
        const int ii = (int)(L % nI), j = (int)(L / nI); u.pm = latent_only ? (ii / (SEQ / 256)) * (TOK / 256) + 1 + ii % (SEQ / 256) : ii; u.pn = j; return true; }
    __device__ __forceinline__ void a_ready(const Unit&) const {}
    __device__ __forceinline__ void done(const Unit&) const {}
};
struct GroupedOrder {
    int nI, nJ, tilesA, nwg, G, c;
    __device__ void init(int nI_, int nJ_, int tilesA_, int G_, int c_) { nI = nI_; nJ = nJ_; tilesA = tilesA_; nwg = NE * nI * nJ; G = G_; c = c_; }
    __device__ bool next(int i, Unit& u) const { const long L = (long)i * G + c; if (L >= nwg) return false;
        const int e = (int)(L / (nI * nJ)), r = (int)(L % (nI * nJ)), j = r / nI, ii = r % nI; u.pm = e * tilesA + ii; u.pn = e * nJ + j; return true; }
    __device__ __forceinline__ void a_ready(const Unit&) const {}
    __device__ __forceinline__ void done(const Unit&) const {}
};

struct EpiF32 {
    static constexpr bool PERM = false, AFTER_DRAIN = false;
    float* C; int ldc;
    __device__ __forceinline__ void operator()(const f32x4 (&acc)[2][2][4][2], const Unit& u, int wr, int wc, int fr, int fq) const {
        const int row0 = u.pm * BM + wr * 64 + fr, col0 = u.pn * BM + wc * 32 + 4 * fq;
#pragma unroll
        for (int ai = 0; ai < 2; ++ai)
#pragma unroll
            for (int m = 0; m < 4; ++m) { float* rowp = C + (size_t)(row0 + ai * HALF + m * 16) * ldc + col0;
#pragma unroll
                for (int bj = 0; bj < 2; ++bj)
#pragma unroll
                    for (int n = 0; n < 2; ++n) *(f32x4*)(rowp + bj * HALF + n * 16) = acc[ai][bj][m][n]; }
    }
};
struct EpiResid {
    static constexpr bool PERM = false, AFTER_DRAIN = false;
    float* X; const float* modl;
    __device__ __forceinline__ void operator()(const f32x4 (&acc)[2][2][4][2], const Unit& u, int wr, int wc, int fr, int fq) const {
        const int row0 = u.pm * BM + wr * 64 + fr, col0 = u.pn * BM + wc * 32 + 4 * fq;
        const int tb = TOK / 256, sel = (u.pm % tb == 0) ? 2 : u.pm / tb;
        const float* gate = modl + ((size_t)sel * 6 + 2) * D_MODEL + col0;
        f32x4 gv[2][2];
#pragma unroll
        for (int bj = 0; bj < 2; ++bj)
#pragma unroll
            for (int n = 0; n < 2; ++n) gv[bj][n] = *(const f32x4*)(gate + bj * HALF + n * 16);
#pragma unroll
        for (int ai = 0; ai < 2; ++ai)
#pragma unroll
            for (int m = 0; m < 4; ++m) { float* rowp = X + (size_t)(row0 + ai * HALF + m * 16) * D_MODEL + col0;
#pragma unroll
                for (int bj = 0; bj < 2; ++bj)
#pragma unroll
                    for (int n = 0; n < 2; ++n) { f32x4* q = (f32x4*)(rowp + bj * HALF + n * 16); *q = *q + gv[bj][n] * acc[ai][bj][m][n]; } }
    }
};
struct EpiSwiGLU {
    static constexpr bool PERM = false, AFTER_DRAIN = false;
    bf16_t* H; int nJ;
    __device__ __forceinline__ void operator()(const f32x4 (&acc)[2][2][4][2], const Unit& u, int wr, int wc, int fr, int fq) const {
        const int row0 = u.pm * BM + wr * 64 + fr, col0 = (u.pn % nJ) * HALF + wc * 32 + 4 * fq;
#pragma unroll
        for (int ai = 0; ai < 2; ++ai)
#pragma unroll
            for (int m = 0; m < 4; ++m) { bf16_t* rowp = H + (size_t)(row0 + ai * HALF + m * 16) * D_MODEL + col0;
#pragma unroll
                for (int n = 0; n < 2; ++n) { const f32x4 a = acc[ai][0][m][n], b = acc[ai][1][m][n]; float o[4];
#pragma unroll
                    for (int q = 0; q < 4; ++q) o[q] = a[q] / (1.f + __expf(-a[q])) * b[q];
                    u32x2v w; w.x = cvt_pk_bf16(o[0], o[1]); w.y = cvt_pk_bf16(o[2], o[3]); *(u32x2v*)(rowp + n * 16) = w; } }
    }
};
struct EpiGate {
    static constexpr bool PERM = false, AFTER_DRAIN = false;
    float* Y; const float* gate; int nJ;
    __device__ __forceinline__ void operator()(const f32x4 (&acc)[2][2][4][2], const Unit& u, int wr, int wc, int fr, int fq) const {
        const int row0 = u.pm * BM + wr * 64 + fr, col0 = (u.pn % nJ) * BM + wc * 32 + 4 * fq;
#pragma unroll
        for (int ai = 0; ai < 2; ++ai)
#pragma unroll
            for (int m = 0; m < 4; ++m) { const int r = row0 + ai * HALF + m * 16; const float gt = gate[r]; float* rowp = Y + (size_t)r * D_MODEL + col0;
#pragma unroll
                for (int bj = 0; bj < 2; ++bj)
#pragma unroll
                    for (int n = 0; n < 2; ++n) *(f32x4*)(rowp + bj * HALF + n * 16) = acc[ai][bj][m][n] * gt; }
    }
};
template <class Epi, class Sched>
__device__ __forceinline__ void gemm_phase(PG8_LAS unsigned char* lds, const Gemm g, const Sched& S, const Epi& E) {
    const int tid = threadIdx.x, wid = __builtin_amdgcn_readfirstlane(tid >> 6), lane = tid & 63, wr = wid >> 2, wc = wid & 3, fr = lane & 15, fq = lane >> 4;
    const int K = g.K, nt = K / BK;
    unsigned voffA[2], voffB[2];
#pragma unroll
    for (int i = 0; i < 2; ++i) { int R, C; stage_rc(tid * 16 + i * 8192, R, C); const int Rb = Epi::PERM ? ((R & ~31) + perm32(R & 31)) : R;
        voffA[i] = (unsigned)(R * K + C) * 2u; voffB[i] = (unsigned)(Rb * K + C) * 2u; }
    const size_t kstep = (size_t)(BK * 2);
    const size_t hstep = (size_t)HALF * K * 2;
    const size_t tstep = 2 * hstep;
    const unsigned ldsw = (unsigned)wid * 1024u;
    const int aoff = lds_byte(wr * 64 + fr, fq * 8), boff = lds_byte(wc * 32 + fr, fq * 8);
#define PG8_SA(b, h) (((b) * 2 + (h)) * HTB)
#define PG8_SB(b, h) ((4 + (b) * 2 + (h)) * HTB)
#define PG8_STAGE(bufoff, gbase, voff) do { _Pragma("unroll") for (int _i = 0; _i < 2; ++_i) \
        __builtin_amdgcn_global_load_lds((const unsigned*)((const char*)(gbase) + (voff)[_i]), (PG8_LAS unsigned*)(lds + (bufoff) + ldsw + _i * 8192), 16, 0, 0); } while (0)
#define PG8_LDA(dst, b, h) do { _Pragma("unroll") for (int m = 0; m < 4; ++m) _Pragma("unroll") for (int k = 0; k < 2; ++k) dst[m][k] = *(const PG8_LAS bf16x8*)(lds + PG8_SA(b, h) + aoff + m * 2048 + k * 1024); } while (0)
#define PG8_LDB(dst, b, h) do { _Pragma("unroll") for (int n = 0; n < 2; ++n) _Pragma("unroll") for (int k = 0; k < 2; ++k) dst[n][k] = *(const PG8_LAS bf16x8*)(lds + PG8_SB(b, h) + boff + n * 2048 + k * 1024); } while (0)
#define PG8_MMA(ai, bj, At, Bt) do { __builtin_amdgcn_s_setprio(1); _Pragma("unroll") for (int m = 0; m < 4; ++m) _Pragma("unroll") for (int n = 0; n < 2; ++n) _Pragma("unroll") for (int k = 0; k < 2; ++k) \
        acc[ai][bj][m][n] = __builtin_amdgcn_mfma_f32_16x16x32_bf16(Bt[n][k], At[m][k], acc[ai][bj][m][n], 0, 0, 0); __builtin_amdgcn_s_setprio(0); } while (0)
#define PG8_WAIT_V(n) asm volatile("s_waitcnt vmcnt(" #n ")" ::: "memory")
#define PG8_WAIT_L(n) asm volatile("s_waitcnt lgkmcnt(" #n ")" ::: "memory")
#define PG8_BAR __builtin_amdgcn_s_barrier()
#define PG8_SCHED __builtin_amdgcn_sched_barrier(0)
    Unit cur, nxt; int ui = 0;
    if (!S.next(0, cur)) return;
    f32x4 acc[2][2][4][2];
#pragma unroll
    for (int a = 0; a < 2; ++a)
#pragma unroll
        for (int b = 0; b < 2; ++b)
#pragma unroll
            for (int m = 0; m < 4; ++m)
#pragma unroll
                for (int n = 0; n < 2; ++n) acc[a][b][m][n] = (f32x4){0.f, 0.f, 0.f, 0.f};
    bf16x8 At[4][2], B0[2][2], B1[2][2];
    const char* cA = (const char*)g.A + (size_t)cur.pm * tstep; const char* cB = (const char*)g.Bt + (size_t)cur.pn * tstep;
    S.a_ready(cur);
    PG8_STAGE(PG8_SB(0, 0), cB, voffB); PG8_STAGE(PG8_SA(0, 0), cA, voffA); PG8_STAGE(PG8_SB(0, 1), cB + hstep, voffB); PG8_STAGE(PG8_SA(0, 1), cA + hstep, voffA);
    if (wr == 1) PG8_BAR;
    PG8_WAIT_V(4); PG8_BAR;
    PG8_STAGE(PG8_SB(1, 0), cB + kstep, voffB); PG8_STAGE(PG8_SA(1, 0), cA + kstep, voffA); PG8_STAGE(PG8_SB(1, 1), cB + hstep + kstep, voffB);
    PG8_WAIT_V(6); PG8_BAR;
    for (;;) {
        const bool has_next = S.next(ui + 1, nxt);
        const char* nA = has_next ? (const char*)g.A + (size_t)nxt.pm * tstep : cA; const char* nB = has_next ? (const char*)g.Bt + (size_t)nxt.pn * tstep : cB;
        for (int t = 0; t < nt; t += 2) {
            const bool last = (t == nt - 2);
            const char* a1 = cA + (size_t)(t + 1) * kstep;
            const char* a2 = last ? nA : cA + (size_t)(t + 2) * kstep; const char* b2 = last ? nB : cB + (size_t)(t + 2) * kstep;
            const char* a3 = a2 + kstep; const char* b3 = b2 + kstep;
            if (last && has_next) S.a_ready(nxt);
            PG8_LDB(B0, 0, 0); PG8_SCHED; PG8_LDA(At, 0, 0); PG8_STAGE(PG8_SA(1, 1), a1 + hstep, voffA);
            PG8_WAIT_L(8); PG8_BAR; PG8_WAIT_L(0); PG8_MMA(0, 0, At, B0); PG8_BAR; PG8_SCHED;
            PG8_LDB(B1, 0, 1); PG8_STAGE(PG8_SB(0, 0), b2, voffB);
            PG8_BAR; PG8_WAIT_L(0); PG8_MMA(0, 1, At, B1); PG8_BAR;
            PG8_LDA(At, 0, 1); PG8_STAGE(PG8_SA(0, 0), a2, voffA);
            PG8_BAR; PG8_WAIT_L(0); PG8_MMA(1, 0, At, B0); PG8_BAR; PG8_SCHED;
            PG8_STAGE(PG8_SB(0, 1), b2 + hstep, voffB);
            PG8_WAIT_V(6); PG8_BAR; PG8_MMA(1, 1, At, B1); PG8_BAR;
            PG8_LDB(B0, 1, 0); PG8_SCHED; PG8_LDA(At, 1, 0); PG8_STAGE(PG8_SA(0, 1), a2 + hstep, voffA);
            PG8_WAIT_L(8); PG8_BAR; PG8_WAIT_L(0); PG8_MMA(0, 0, At, B0); PG8_BAR; PG8_SCHED;
            PG8_LDB(B1, 1, 1); PG8_STAGE(PG8_SB(1, 0), b3, voffB);
            PG8_BAR; PG8_WAIT_L(0); PG8_MMA(0, 1, At, B1); PG8_BAR;
            PG8_LDA(At, 1, 1); PG8_STAGE(PG8_SA(1, 0), a3, voffA);
            PG8_BAR; PG8_WAIT_L(0); PG8_MMA(1, 0, At, B0); PG8_BAR; PG8_SCHED;
            PG8_STAGE(PG8_SB(1, 1), b3 + hstep, voffB);
            PG8_WAIT_V(6); PG8_BAR; PG8_MMA(1, 1, At, B1); PG8_BAR;
        }
        if constexpr (!Epi::AFTER_DRAIN) { E(acc, cur, wr, wc, fr, fq); S.done(cur); }
        if (!has_next) break;
#pragma unroll
        for (int a = 0; a < 2; ++a)
#pragma unroll
            for (int b = 0; b < 2; ++b)
#pragma unroll
                for (int m = 0; m < 4; ++m)
#pragma unroll
                    for (int n = 0; n < 2; ++n) acc[a][b][m][n] = (f32x4){0.f, 0.f, 0.f, 0.f};
        cur = nxt; cA = nA; cB = nB; ++ui;
    }
    PG8_WAIT_V(0);
    if (wr == 0) PG8_BAR;
    PG8_BAR;
    if constexpr (Epi::AFTER_DRAIN) { E.fused(acc, cur, wr, wc, fr, fq, lds, wid, lane); S.done(cur); }
#undef PG8_SA
#undef PG8_SB
#undef PG8_STAGE
#undef PG8_LDA
#undef PG8_LDB
#undef PG8_MMA
#undef PG8_WAIT_V
#undef PG8_WAIT_L
#undef PG8_BAR
#undef PG8_SCHED
}
}


namespace att {
using bf16 = unsigned short;
constexpr int   D = 128, NW = 8, QBLK = 32, KVBLK = 64;
constexpr float SCALE = 0.088388347648318440f;
constexpr float THR = 8.f;
constexpr int SDEPTH = 2;
constexpr int LDQ = 128, LDK = 128, LDO = D_MODEL;
constexpr size_t SHM_V = KVBLK * D * 2, SHM_K = KVBLK * D * 2, SHM_ATTN = 2 * SHM_V + 2 * SHM_K + NW * 64 * 4;
using bf16x8 = __attribute__((ext_vector_type(8))) short;
using s16x4  = __attribute__((ext_vector_type(4))) short;
using f32x16 = __attribute__((ext_vector_type(16))) float;
using f32x8  = __attribute__((ext_vector_type(8))) float;
using u32x4  = __attribute__((ext_vector_type(4))) unsigned;
#define KSWZ(row, colB) ((row) * 256 + ((colB) ^ (((row) & 7) << 4)))
#define SBAR() __builtin_amdgcn_sched_barrier(0)
__device__ __forceinline__ int crow(int r, int hi) { return (r & 3) + 8 * (r >> 2) + 4 * hi; }
__device__ __forceinline__ unsigned cvtpk(float lo, float hi) {
  unsigned r; asm volatile("v_cvt_pk_bf16_f32 %0, %1, %2" : "=v"(r) : "v"(lo), "v"(hi)); return r;
}
template <typename TIn> struct Stage;
template <> struct Stage<bf16>  { using T = bf16x8;
  __device__ static __forceinline__ T ld8(const bf16* p) { return *reinterpret_cast<const bf16x8*>(p); }
  __device__ static __forceinline__ bf16x8 tobf(T x) { return x; } };
template <> struct Stage<float> { using T = f32x8;
  __device__ static __forceinline__ T ld8(const float* p) { return *reinterpret_cast<const f32x8*>(p); }
  __device__ static __forceinline__ bf16x8 tobf(T x) {
    u32x4 w = {cvtpk(x[0], x[1]), cvtpk(x[2], x[3]), cvtpk(x[4], x[5]), cvtpk(x[6], x[7])}; return *reinterpret_cast<bf16x8*>(&w); } };

__device__ __forceinline__ void partialSM(f32x16& p0, f32x16& p1, float& m_reg, float& mn, float& alpha) {
  constexpr float C = SCALE * 1.4426950408889634f;
  float pmax = p0[0]; for (int r = 1; r < 16; ++r) pmax = fmaxf(pmax, p0[r]); for (int r = 0; r < 16; ++r) pmax = fmaxf(pmax, p1[r]);
  { auto rr = __builtin_amdgcn_permlane32_swap(__float_as_uint(pmax), __float_as_uint(pmax), false, false);
    pmax = fmaxf(__uint_as_float(rr[0]), __uint_as_float(rr[1])); }
  if (__builtin_expect(__all(pmax - m_reg <= THR / SCALE), 1)) { mn = m_reg; alpha = 1.f; }
  else { mn = fmaxf(m_reg, pmax); alpha = __builtin_amdgcn_exp2f((m_reg - mn) * C); m_reg = mn; }
  float mnC = -mn * C;
  for (int r = 0; r < 16; ++r) p0[r] = fmaf(p0[r], C, mnC); for (int r = 0; r < 16; ++r) p1[r] = fmaf(p1[r], C, mnC);
  for (int r = 0; r < 16; ++r) p0[r] = __builtin_amdgcn_exp2f(p0[r]);
}
__device__ __forceinline__ void finishSM(f32x16& p0, f32x16& p1, float alpha, float& l_reg, bf16x8& pa0, bf16x8& pa1, bf16x8& pa2, bf16x8& pa3) {
  for (int r = 0; r < 16; ++r) p1[r] = __builtin_amdgcn_exp2f(p1[r]);
  float ps = 0; for (int r = 0; r < 16; ++r) ps += p0[r]; for (int r = 0; r < 16; ++r) ps += p1[r];
  { auto rr = __builtin_amdgcn_permlane32_swap(__float_as_uint(ps), __float_as_uint(ps), false, false);
    ps = __uint_as_float(rr[0]) + __uint_as_float(rr[1]); }
  l_reg = l_reg * alpha + ps;
#define PK4(P, BASE, OUT) do { unsigned a0 = cvtpk(P[BASE + 0], P[BASE + 1]), a1 = cvtpk(P[BASE + 2], P[BASE + 3]);   \
    unsigned b0 = cvtpk(P[BASE + 4], P[BASE + 5]), b1 = cvtpk(P[BASE + 6], P[BASE + 7]);                              \
    auto r0 = __builtin_amdgcn_permlane32_swap(a0, b0, false, false); auto r1 = __builtin_amdgcn_permlane32_swap(a1, b1, false, false); \
    u32x4 w = {r0[0], r1[0], r0[1], r1[1]}; OUT = *reinterpret_cast<bf16x8*>(&w); } while (0)
  PK4(p0, 0, pa0); PK4(p0, 8, pa1); PK4(p1, 0, pa2); PK4(p1, 8, pa3);
#undef PK4
}
__device__ __forceinline__ void qkt(f32x16& p0, f32x16& p1, const bf16* Ks, const bf16x8* qr, int r32, int hi) {
  p0 = f32x16{}; p1 = f32x16{};
  for (int d0 = 0; d0 < 8; ++d0) { int cb = (d0 * 16 + hi * 8) * 2;
    bf16x8 b0 = *reinterpret_cast<const bf16x8*>((const char*)Ks + KSWZ(r32, cb));
    bf16x8 b1 = *reinterpret_cast<const bf16x8*>((const char*)Ks + KSWZ(32 + r32, cb));
    p0 = __builtin_amdgcn_mfma_f32_32x32x16_bf16(b0, qr[d0], p0, 0, 0, 0);
    p1 = __builtin_amdgcn_mfma_f32_32x32x16_bf16(b1, qr[d0], p1, 0, 0, 0); }
}
__device__ __forceinline__ int v_st(int k, int c) { const int kk = (k & ~0xC) | ((k & 4) << 1) | ((k & 8) >> 1); return ((kk >> 3) * 4 + (c >> 5)) * 512 + ((kk & 7) * 32 + (c & 31)) * 2; }
__device__ __forceinline__ int v_rd_base(int lane) { return ((lane & 3) << 3) | (((lane >> 2) & 3) << 6) | (((lane >> 4) & 1) << 5) | (((lane >> 5) & 1) << 8); }
constexpr int v_rd_off(int d0, int ks, int half) { return d0 * 512 + ks * 4096 + half * 2048; }
template <int OFF> __device__ __forceinline__ s16x4 tr_read(int vb) {
  s16x4 r; asm volatile("ds_read_b64_tr_b16 %0, %1 offset:%2" : "=&v"(r) : "v"(vb), "i"(OFF) : "memory"); return r;
}
template <int D0> __device__ __forceinline__ void pv_one(f32x16& od, int vb, bf16x8 pa0, bf16x8 pa1, bf16x8 pa2, bf16x8 pa3) {
  const s16x4 l0 = tr_read<v_rd_off(D0, 0, 0)>(vb), h0 = tr_read<v_rd_off(D0, 0, 1)>(vb), l1 = tr_read<v_rd_off(D0, 1, 0)>(vb), h1 = tr_read<v_rd_off(D0, 1, 1)>(vb);
  const s16x4 l2 = tr_read<v_rd_off(D0, 2, 0)>(vb), h2 = tr_read<v_rd_off(D0, 2, 1)>(vb), l3 = tr_read<v_rd_off(D0, 3, 0)>(vb), h3 = tr_read<v_rd_off(D0, 3, 1)>(vb);
  asm volatile("s_waitcnt lgkmcnt(0)" ::: "memory"); SBAR();
#define PK(L, H) (bf16x8){L[0], L[1], L[2], L[3], H[0], H[1], H[2], H[3]}
  od = __builtin_amdgcn_mfma_f32_32x32x16_bf16(pa0, PK(l0, h0), od, 0, 0, 0);
  od = __builtin_amdgcn_mfma_f32_32x32x16_bf16(pa1, PK(l1, h1), od, 0, 0, 0);
  od = __builtin_amdgcn_mfma_f32_32x32x16_bf16(pa2, PK(l2, h2), od, 0, 0, 0);
  od = __builtin_amdgcn_mfma_f32_32x32x16_bf16(pa3, PK(l3, h3), od, 0, 0, 0);
#undef PK
}
__device__ __forceinline__ void pv_d0(f32x16* o, int vb, bf16x8 pa0, bf16x8 pa1, bf16x8 pa2, bf16x8 pa3) {
  pv_one<0>(o[0], vb, pa0, pa1, pa2, pa3); pv_one<1>(o[1], vb, pa0, pa1, pa2, pa3); pv_one<2>(o[2], vb, pa0, pa1, pa2, pa3); pv_one<3>(o[3], vb, pa0, pa1, pa2, pa3);
}

__device__ __forceinline__ void attn_dense_body(const bf16* __restrict__ Qb, const bf16* __restrict__ Kh, const bf16* __restrict__ Vh,
                                                unsigned short* __restrict__ Ob, int seq, char* lds) {
  using St = Stage<bf16>; using SQ = Stage<bf16>; using TQ = bf16;
  const int tid = threadIdx.x, wid = tid >> 6, lane = tid & 63, r32 = lane & 31, hi = lane >> 5;
  bf16* V_lds = (bf16*)lds; bf16* K_lds = (bf16*)(lds + 2 * SHM_V);
  float* ws = (float*)(lds + 2 * SHM_V + 2 * SHM_K) + wid * 64; float* li_l = ws; float* al_l = ws + 32;
  float m_reg = -1e30f, l_reg = 0; f32x16 o[4] = {}; bf16x8 qr[8];
  const TQ* Qw = Qb + (long)(wid * QBLK + r32) * LDQ + hi * 8;
#pragma unroll
  for (int d0 = 0; d0 < 8; ++d0) qr[d0] = SQ::tobf(SQ::ld8(Qw + d0 * 16));
  const int sr = tid >> 4, sc = (tid & 15) * 8, vst0 = v_st(sr, sc), vst1 = v_st(32 + sr, sc);
  const int vb0 = (int)(uintptr_t)V_lds + v_rd_base(lane);
  struct { typename St::T vs0, vs1, ks0, ks1; } sr_[SDEPTH];
#define SLOAD(i, k0) do { sr_[i].vs0 = St::ld8(&Vh[(long)((k0) + sr) * LDK + sc]); sr_[i].vs1 = St::ld8(&Vh[(long)((k0) + 32 + sr) * LDK + sc]); \
    sr_[i].ks0 = St::ld8(&Kh[(long)((k0) + sr) * LDK + sc]); sr_[i].ks1 = St::ld8(&Kh[(long)((k0) + 32 + sr) * LDK + sc]); } while (0)
#define SWRITE(b, i) do { *(bf16x8*)((char*)V_lds + (b) * SHM_V + vst0) = St::tobf(sr_[i].vs0);          \
    *(bf16x8*)((char*)V_lds + (b) * SHM_V + vst1) = St::tobf(sr_[i].vs1); int kc = sc * 2;               \
    *(bf16x8*)((char*)K_lds + (b) * SHM_K + KSWZ(sr, kc)) = St::tobf(sr_[i].ks0);                       \
    *(bf16x8*)((char*)K_lds + (b) * SHM_K + KSWZ(32 + sr, kc)) = St::tobf(sr_[i].ks1); } while (0)
#define SWAIT() do { if constexpr (SDEPTH == 2) asm volatile("s_waitcnt vmcnt(4)" ::: "memory"); else asm volatile("s_waitcnt vmcnt(0)" ::: "memory"); } while (0)
#define RESC(a) do { if (__any((a) < 1.f)) { if (hi == 0) al_l[r32] = (a); asm volatile("s_waitcnt lgkmcnt(0)" ::: "memory"); \
    for (int d = 0; d < 4; ++d) for (int r = 0; r < 16; ++r) o[d][r] *= al_l[crow(r, hi)]; } } while (0)
  f32x16 pA0, pA1, pB0, pB1; float mnA, mnB, alA, alB; bf16x8 pa0, pa1, pa2, pa3; const int NT = seq / KVBLK;
  constexpr int SE = 0, SO = SDEPTH - 1;
  SLOAD(SE, 0); asm volatile("s_waitcnt vmcnt(0)" ::: "memory"); SWRITE(0, SE); __syncthreads();
  qkt(pA0, pA1, K_lds, qr, r32, hi); partialSM(pA0, pA1, m_reg, mnA, alA);
  SLOAD(SO, KVBLK); if constexpr (SDEPTH == 2) { if (2 < NT) SLOAD(SE, 2 * KVBLK); }
  SWAIT(); SWRITE(1, SO); __syncthreads();
  for (int j = 1; j + 1 < NT; j += 2) {
    SBAR(); qkt(pB0, pB1, (bf16*)((char*)K_lds + SHM_K), qr, r32, hi);
    finishSM(pA0, pA1, alA, l_reg, pa0, pa1, pa2, pa3); SBAR();
    SLOAD(SO, (j + SDEPTH) * KVBLK); SBAR();
    pv_d0(o, vb0, pa0, pa1, pa2, pa3); partialSM(pB0, pB1, m_reg, mnB, alB);
    __syncthreads(); SWAIT(); SWRITE(0, SE);
    RESC(alB); __syncthreads();
    SBAR(); qkt(pA0, pA1, K_lds, qr, r32, hi);
    finishSM(pB0, pB1, alB, l_reg, pa0, pa1, pa2, pa3); SBAR();
    if (SDEPTH == 1 || j + 3 < NT) SLOAD(SE, (j + 1 + SDEPTH) * KVBLK); SBAR();
    pv_d0(o, vb0 + (int)SHM_V, pa0, pa1, pa2, pa3); partialSM(pA0, pA1, m_reg, mnA, alA);
    __syncthreads(); SWAIT(); SWRITE(1, SO);
    RESC(alA); __syncthreads();
  }
  SBAR(); qkt(pB0, pB1, (bf16*)((char*)K_lds + SHM_K), qr, r32, hi);
  finishSM(pA0, pA1, alA, l_reg, pa0, pa1, pa2, pa3); SBAR();
  pv_d0(o, vb0, pa0, pa1, pa2, pa3); partialSM(pB0, pB1, m_reg, mnB, alB);
  __syncthreads(); RESC(alB);
  finishSM(pB0, pB1, alB, l_reg, pa0, pa1, pa2, pa3); SBAR();
  pv_d0(o, vb0 + (int)SHM_V, pa0, pa1, pa2, pa3);
  if (hi == 0) li_l[r32] = l_reg; asm volatile("s_waitcnt lgkmcnt(0)" ::: "memory");
  float rli[16];
#pragma unroll
  for (int r = 0; r < 16; ++r) rli[r] = __builtin_amdgcn_rcpf(li_l[crow(r, hi)]);
  unsigned short* Ow = Ob + (long)(wid * QBLK) * LDO;
#pragma unroll
  for (int r = 0; r < 16; ++r) { int orow = crow(r, hi);
    for (int d0 = 0; d0 < 4; ++d0) Ow[(long)orow * LDO + d0 * 32 + r32] = f2bf(o[d0][r] * rli[r]); }
#undef SLOAD
#undef SWRITE
#undef SWAIT
#undef RESC
}
}

__device__ __forceinline__ void cvt_tile(const float* __restrict__ W, int ldw, int nvalid, int k0, int n0, u16* __restrict__ Wt, int rowbase, int rmode, float* lds) {
    const int tid = threadIdx.x;
    for (int idx = tid; idx < 4096; idx += 512) { const int kk = idx >> 6, nn = idx & 63; const int n = n0 + nn;
        lds[kk * 65 + nn] = n < nvalid ? W[(size_t)(k0 + kk) * ldw + n] : 0.f; }
    __syncthreads();
    for (int idx = tid; idx < 1024; idx += 512) { const int nn = idx >> 4, k4 = (idx & 15) * 4; const int n = n0 + nn;
        int row = n;
        if (rmode) row = (n >> 7) * 256 + (n & 127) + (rmode == 2 ? 128 : 0);
        pg8::u32x2v w; w.x = pg8::cvt_pk_bf16(lds[(k4 + 0) * 65 + nn], lds[(k4 + 1) * 65 + nn]); w.y = pg8::cvt_pk_bf16(lds[(k4 + 2) * 65 + nn], lds[(k4 + 3) * 65 + nn]);
        *(pg8::u32x2v*)(Wt + (size_t)(rowbase + row) * D_MODEL + k0 + k4) = w; }
    __syncthreads();
}
__device__ __forceinline__ void ph_convert(const Params& p, float* lds) {
    constexpr int KT = D_MODEL / 64;
    constexpr int T_IN = KT * (LDP / 64), T_OUT = KT * (D_MODEL / 64), T_E = KT * (D_MODEL / 64);
    constexpr int PER_L = T_IN + T_OUT + NE * 3 * T_E, TOTAL = DEPTH * PER_L;
    for (int t = blockIdx.x; t < TOTAL; t += gridDim.x) {
        const int l = t / PER_L; int r = t % PER_L;
        if (r < T_IN) { const int kt = r % KT, nt = r / KT;
            cvt_tile(p.w_in + (size_t)l * D_MODEL * N_IN, N_IN, N_IN, kt * 64, nt * 64, p.wt_in + (size_t)l * LDP * D_MODEL, 0, 0, lds); continue; }
        r -= T_IN;
        if (r < T_OUT) { const int kt = r % KT, nt = r / KT;
            cvt_tile(p.w_out + (size_t)l * D_MODEL * D_MODEL, D_MODEL, D_MODEL, kt * 64, nt * 64, p.wt_out + (size_t)l * D_MODEL * D_MODEL, 0, 0, lds); continue; }
        r -= T_OUT;
        const int e = r / (3 * T_E), which = (r / T_E) % 3, q = r % T_E, kt = q % KT, nt = q / KT;
        const size_t eo = ((size_t)l * NE + e) * D_MODEL * D_MODEL;
        if (which == 0) cvt_tile(p.w_exp1 + eo, D_MODEL, D_MODEL, kt * 64, nt * 64, p.w13t + 2 * eo, 0, 1, lds);
        else if (which == 1) cvt_tile(p.w_exp3 + eo, D_MODEL, D_MODEL, kt * 64, nt * 64, p.w13t + 2 * eo, 0, 2, lds);
        else cvt_tile(p.w_exp2 + eo, D_MODEL, D_MODEL, kt * 64, nt * 64, p.w2t + eo, 0, 0, lds);
    }
}

constexpr int LDS_BYTES = 147456;
constexpr int LDS_MISC = 131072;
constexpr int NPL = 16;
constexpr int NPHASE = 2 + DEPTH * NPL + 1;

struct Args { Params p; int ph_lo, ph_hi; };

template <int G> __device__ __forceinline__ Exec mk_exec() { const int gt = blockIdx.x * 512 + threadIdx.x; return Exec{gt / G, (int)(gridDim.x * 512) / G, gt % G}; }
typedef const __attribute__((address_space(4))) unsigned long long* kq_t;
__device__ __forceinline__ void load_params(Params& p, const __attribute__((address_space(4))) unsigned char* ka) {
    kq_t s = (kq_t)ka; unsigned long long* d = (unsigned long long*)&p;
#pragma unroll
    for (int i = 0; i < (int)(sizeof(Params) / 8); ++i) d[i] = s[i];
}
#define LOADP() Params p; load_params(p, ka)
#define PH(k, ...) do { if (lo <= (k) && (k) < hi) { { LOADP(); __VA_ARGS__; } if ((k) + 1 < hi) xcd_barrier(bar); } } while (0)
#define e1 mk_exec<1>()
#define e16 mk_exec<16>()
#define e64 mk_exec<64>()
#define flds ((float*)lds)
#define glds ((PG8_LAS unsigned char*)lds)
#define G ((int)gridDim.x)
#define c ((int)blockIdx.x)
template <int L> __device__ __forceinline__ void layer_phases(const __attribute__((address_space(4))) unsigned char* ka, int lo, int hi, const XcdBarrier& bar, unsigned char* lds) {
    constexpr int l = L;
        const int b0 = 2 + l * NPL; const bool last = (l == DEPTH - 1);
        PH(b0 + 0, ph_norm1<64>(p, l, e64));
        PH(b0 + 1, { pg8::Gemm g{p.h, p.wt_in + (size_t)l * LDP * D_MODEL, MROWS, LDP, D_MODEL}; pg8::StaticOrder S; S.init(MROWS, LDP, G, c);
                     pg8::EpiF32 E{p.P, LDP}; pg8::gemm_phase<pg8::EpiF32, pg8::StaticOrder>(glds, g, S, E); });
        PH(b0 + 2, ph_rw_prep1<64>(p, l, e64); ph_ml_g1(p, l, e1); ph_gd_prep<64>(p, l, e64); ph_gd_gates(p, l, e1); ph_at_prep<64>(p, l, e64));
        PH(b0 + 3, ph_rw_prep2<64>(p, l, e64); ph_ml_g2(p, e1); ph_gd_A(p, e1));
        PH(b0 + 4, ph_rw_scan<16>(p, e16));
        PH(b0 + 5, ph_ml_dC(p, e1); ph_ml_S(p, e1); ph_gd_solve(p, e1));
        PH(b0 + 6, {
            const int nlat = BATCH * AT_QH * (SEQ / 256), nctx = last ? 0 : BATCH * AT_QH;
            if (c < nlat) { const int u = c;
                const int qb = u % (SEQ / 256), hq = (u / (SEQ / 256)) % AT_QH, b = u / ((SEQ / 256) * AT_QH), s0 = CTX + qb * 256, kvh = hq / (AT_QH / AT_KVH);
                att::attn_dense_body((const att::bf16*)p.at_q + (((size_t)b * AT_QH + hq) * TOK + s0) * AT_HEAD,
                                     (const att::bf16*)p.at_k + ((size_t)b * AT_KVH + kvh) * TOK * AT_HEAD, (const att::bf16*)p.at_v + ((size_t)b * AT_KVH + kvh) * TOK * AT_HEAD,
                                     p.mix + ((size_t)b * TOK + s0) * D_MODEL + 3 * GROUP_W + hq * AT_HEAD, TOK, (char*)lds);
                __syncthreads(); }
            if (c >= G - nctx) { const int u = c - (G - nctx);
                const int hq = u % AT_QH, b = u / AT_QH, kvh = hq / (AT_QH / AT_KVH);
                att::attn_dense_body((const att::bf16*)p.at_q + (((size_t)b * AT_QH + hq) * TOK) * AT_HEAD,
                                     (const att::bf16*)p.at_k + ((size_t)b * AT_KVH + kvh) * TOK * AT_HEAD, (const att::bf16*)p.at_v + ((size_t)b * AT_KVH + kvh) * TOK * AT_HEAD,
                                     p.mix + ((size_t)b * TOK) * D_MODEL + 3 * GROUP_W + hq * AT_HEAD, CTX, (char*)lds);
                __syncthreads(); } });
        PH(b0 + 7, ph_ml_prefix(p, e1); { for (int u = c; u < GD_CH * GD_NCB; u += G) ph_gd_scan_unit(p, u, threadIdx.x, 512, flds); });
        PH(b0 + 8, ph_ml_out(p, e1); ph_rw_post<64>(p, l, e64); ph_gd_post<64>(p, l, e64));
        PH(b0 + 9, ph_ml_post<64>(p, l, e64));
        PH(b0 + 10, { pg8::Gemm g{p.mix, p.wt_out + (size_t)l * D_MODEL * D_MODEL, MROWS, D_MODEL, D_MODEL}; pg8::TileOrder S;
                      S.init(last ? BATCH * SEQ / 256 : MROWS / 256, D_MODEL / 256, G, c, last ? 1 : 0);
                      pg8::EpiResid E{p.xres, p.mod + (size_t)l * 3 * 6 * D_MODEL}; pg8::gemm_phase<pg8::EpiResid, pg8::TileOrder>(glds, g, S, E); });
        PH(b0 + 11, ph_norm2<64>(p, l, e64));
        PH(b0 + 12, ph_topk(p, l, e1));
        PH(b0 + 13, ph_gather<64>(p, l, e64));
        PH(b0 + 14, { pg8::Gemm g{p.xs, p.w13t + (size_t)l * NE * 2 * D_MODEL * D_MODEL, NE * NSLOT, NE * 2 * D_MODEL, D_MODEL}; pg8::GroupedOrder S;
                      S.init(last ? NSLOT_L / 256 : NSLOT / 256, 2 * D_MODEL / 256, NSLOT / 256, G, c);
                      pg8::EpiSwiGLU E{p.hid, 2 * D_MODEL / 256}; pg8::gemm_phase<pg8::EpiSwiGLU, pg8::GroupedOrder>(glds, g, S, E); });
        PH(b0 + 15, { pg8::Gemm g{p.hid, p.w2t + (size_t)l * NE * D_MODEL * D_MODEL, NE * NSLOT, NE * D_MODEL, D_MODEL}; pg8::GroupedOrder S;
                      S.init(last ? NSLOT_L / 256 : NSLOT / 256, D_MODEL / 256, NSLOT / 256, G, c);
                      pg8::EpiGate E{p.yexp, p.sel_gate, D_MODEL / 256}; pg8::gemm_phase<pg8::EpiGate, pg8::GroupedOrder>(glds, g, S, E); });
    }
__global__ void __launch_bounds__(512, 2) mega(Args args) {
    extern __shared__ __attribute__((aligned(16))) unsigned char lds[];
    typedef const __attribute__((address_space(4))) unsigned char* kptr_t;
    const kptr_t ka = (kptr_t)__builtin_amdgcn_kernarg_segment_ptr();
    (void)args;
    const unsigned long long lohi = ((kq_t)ka)[sizeof(Params) / 8]; const int lo = (int)(unsigned)lohi, hi = (int)(unsigned)(lohi >> 32);
    unsigned* barw = (unsigned*)((kq_t)ka)[offsetof(Params, bar) / 8];
    volatile LAS unsigned* misc = (volatile LAS unsigned*)((LAS unsigned char*)lds + LDS_MISC);
    if (threadIdx.x < 4) misc[threadIdx.x] = 0u;
    __syncthreads();
    const bool use_bar = (hi - lo) > 1;
    XcdBarrier bar; bar.bar = barw; bar.x = 0; bar.st = misc;
    if (use_bar) bar = xcd_barrier_post(barw, misc);
    PH(0, ph_convert(p, flds); ph_mod_partial(p, e1));
    PH(1, ph_mod_final(p, e1));
    layer_phases<0>(ka, lo, hi, bar, lds);
    layer_phases<1>(ka, lo, hi, bar, lds);
    static_assert(DEPTH == 2, "depth");
    PH(2 + DEPTH * NPL, ph_final<64>(p, e64));
}
#undef PH
#undef e1
#undef e16
#undef e64
#undef flds
#undef glds
#undef G
#undef c
#undef LOADP

static size_t ws_carve(Params& p, unsigned char* ws) {
    size_t off = 0;
    auto take = [&](size_t bytes) { size_t o = off; off += (bytes + 255) / 256 * 256; return ws ? ws + o : (unsigned char*)nullptr; };
    p.bar = (unsigned*)take(XCD_BAR_WORDS * 4);
    p.modp = (float*)take((size_t)DEPTH * MOD_KS * 3 * 6 * D_MODEL * 4); p.mod = (float*)take((size_t)DEPTH * 3 * 6 * D_MODEL * 4);
    p.wt_in = (u16*)take((size_t)DEPTH * LDP * D_MODEL * 2); p.wt_out = (u16*)take((size_t)DEPTH * D_MODEL * D_MODEL * 2);
    p.w13t = (u16*)take((size_t)DEPTH * NE * 2 * D_MODEL * D_MODEL * 2); p.w2t = (u16*)take((size_t)DEPTH * NE * D_MODEL * D_MODEL * 2);
    p.xres = (float*)take((size_t)MROWS * D_MODEL * 4); p.h = (u16*)take((size_t)MROWS * D_MODEL * 2); p.mix = (u16*)take((size_t)MROWS * D_MODEL * 2);
    p.aff = (float*)take((size_t)MROWS * NE * 4); p.inv = (int*)take((size_t)MROWS * NE * 4);
    p.sel_row = (int*)take((size_t)NE * NSLOT * 4); p.sel_gate = (float*)take((size_t)NE * NSLOT * 4);
    const size_t region = off;
    p.P = (float*)take((size_t)MROWS * LDP * 4);
    const size_t rg = (size_t)MROWS * GROUP_W * 4;
    p.rw_r = (float*)take(rg); p.rw_k = (float*)take(rg); p.rw_v = (float*)take(rg); p.rw_kk = (float*)take(rg); p.rw_g = (float*)take(rg);
    p.rw_lr = (float*)take((size_t)MROWS * RW_LR * 4);
    p.rw_ew = (float*)take(2 * rg); p.rw_kka = (float*)take(2 * rg); p.rw_kt = (float*)take(2 * rg); p.rw_y = (float*)take(2 * rg);
    p.ml_bcum = (float*)take((size_t)ML_CH * TOK * 4); p.ml_g = (float*)take((size_t)ML_CH * TOK * 4); p.ml_gmax = (float*)take((size_t)ML_CH * TOK * 4);
    p.ml_bl = (float*)take((size_t)ML_CH * NCHUNK * 4); p.ml_gm = (float*)take((size_t)ML_CH * NCHUNK * 4); p.ml_min = (float*)take((size_t)ML_CH * NCHUNK * 4);
    p.ml_dC = (float*)take((size_t)ML_CH * NCHUNK * ML_HEAD * ML_HEAD * 4); p.ml_dn = (float*)take((size_t)ML_CH * NCHUNK * ML_HEAD * 4);
    p.ml_S = (float*)take((size_t)ML_CH * NCHUNK * CHUNK * CHUNK * 4); p.ml_hh = (float*)take(2 * rg);
    p.gd_q = (float*)take(rg); p.gd_k = (float*)take(rg); p.gd_v = (float*)take(rg);
    p.gd_gc = (float*)take((size_t)GD_CH * TOK * 4); p.gd_beta = (float*)take((size_t)GD_CH * TOK * 4);
    p.gd_A = (float*)take((size_t)GD_CH * NCHUNK * CHUNK * CHUNK * 4); p.gd_attn = (float*)take((size_t)GD_CH * NCHUNK * CHUNK * CHUNK * 4);
    p.gd_u = (float*)take((size_t)GD_CH * NCHUNK * CHUNK * GD_HEAD * 4); p.gd_w = (float*)take((size_t)GD_CH * NCHUNK * CHUNK * GD_HEAD * 4);
    p.gd_o = (float*)take(2 * rg);
    p.at_q = (u16*)take((size_t)BATCH * AT_QH * TOK * AT_HEAD * 2); p.at_k = (u16*)take((size_t)BATCH * AT_KVH * TOK * AT_HEAD * 2); p.at_v = (u16*)take((size_t)BATCH * AT_KVH * TOK * AT_HEAD * 2);
    const size_t end1 = off;
    off = region;
    p.xs = (u16*)take((size_t)NE * NSLOT * D_MODEL * 2); p.hid = (u16*)take((size_t)NE * NSLOT * D_MODEL * 2); p.yexp = (float*)take((size_t)NE * NSLOT * D_MODEL * 4);
    return end1 > off ? end1 : off;
}

#ifndef MK_PER_PHASE
#define MK_PER_PHASE 0
#endif
extern "C" void kernel_launch(void* const* d_in, const int* in_sizes, int n_in, void* d_out, int out_size, void* d_ws, size_t ws_size, hipStream_t stream) {
    static int grid = 0;
    if (grid == 0) {
        Params q{}; const size_t need = ws_carve(q, nullptr);
        if (n_in != 35 || out_size != BATCH * SEQ * D_MODEL || ws_size < need) {
            fprintf(stderr, "kernel_launch: expected 35 inputs, out %d, ws >= %zu; got n_in %d out %d ws %zu\n", BATCH * SEQ * D_MODEL, need, n_in, out_size, ws_size); grid = -1; return; }
        int dev = 0, cus = 0, per_cu = 0;
        if (hipGetDevice(&dev) != hipSuccess || hipDeviceGetAttribute(&cus, hipDeviceAttributeMultiprocessorCount, dev) != hipSuccess) { grid = -1; return; }
        if (hipFuncSetAttribute((const void*)mega, hipFuncAttributeMaxDynamicSharedMemorySize, LDS_BYTES) != hipSuccess) { fprintf(stderr, "kernel_launch: hipFuncSetAttribute failed\n"); grid = -1; return; }
        if (hipOccupancyMaxActiveBlocksPerMultiprocessor(&per_cu, (const void*)mega, 512, LDS_BYTES) != hipSuccess || per_cu < 1)
            fprintf(stderr, "kernel_launch: occupancy query reports %d workgroups per CU\n", per_cu);
        (void)hipGetLastError();
        if (cus < 160) { fprintf(stderr, "kernel_launch: needs >= 160 CUs\n"); grid = -1; return; }
        grid = cus;
    }
    if (grid < 0) return;
    Args a{};
    Params& p = a.p;
    const float** in = (const float**)&p;
    for (int i = 0; i < 35; ++i) in[i] = (const float*)d_in[i];
    p.out = (float*)d_out;
    (void)ws_carve(p, (unsigned char*)d_ws);
    (void)hipMemsetAsync(p.bar, 0, XCD_BAR_WORDS * 4, stream);
#if MK_PER_PHASE
    for (int k = 0; k < NPHASE; ++k) { a.ph_lo = k; a.ph_hi = k + 1; hipLaunchKernelGGL(mega, dim3(grid), dim3(512), LDS_BYTES, stream, a); }
#else
    a.ph_lo = 0; a.ph_hi = NPHASE;
    hipLaunchKernelGGL(mega, dim3(grid), dim3(512), LDS_BYTES, stream, a);
#endif
    const hipError_t le = hipPeekAtLastError();
    if (le != hipSuccess) fprintf(stderr, "kernel_launch: launch failed: %s\n", hipGetErrorName(le));
}
```

```cpp
#include <hip/hip_runtime.h>

#ifndef CFG_D_MODEL
#define CFG_D_MODEL 2048
#define CFG_SEQ 4096
#define CFG_GRID_W 64
#define CFG_CTX 256
#define CFG_RW_HEAD 64
#define CFG_RW_DR 64
#define CFG_RW_IR 64
#define CFG_RW_GR 128
#define CFG_ML_HEAD 128
#define CFG_CHUNK 64
#define CFG_GD_HEAD 128
#define CFG_AT_HEAD 128
#define CFG_AT_KVH 2
#define CFG_NE 16
#endif

constexpr int D_MODEL = CFG_D_MODEL, BATCH = 2, SEQ = CFG_SEQ, DEPTH = 2, GRID_W = CFG_GRID_W, CTX = CFG_CTX;
constexpr int TOK = CTX + SEQ, MROWS = BATCH * TOK, GROUP_W = D_MODEL / 4;
constexpr int RW_HEAD = CFG_RW_HEAD, RW_HEADS = GROUP_W / RW_HEAD, RW_DR = CFG_RW_DR, RW_IR = CFG_RW_IR, RW_GR = CFG_RW_GR;
constexpr int RW_COLS = 3 * GROUP_W + RW_DR + RW_IR + RW_GR, RW_LR = RW_DR + RW_IR + RW_GR;
constexpr int ML_HEAD = CFG_ML_HEAD, ML_HEADS = GROUP_W / ML_HEAD, CHUNK = CFG_CHUNK, ML_COLS = 4 * GROUP_W + 4 * ML_HEADS;
constexpr int GD_HEAD = CFG_GD_HEAD, GD_HEADS = GROUP_W / GD_HEAD, GD_COLS = 4 * GROUP_W + 4 * GD_HEADS;
constexpr int AT_HEAD = CFG_AT_HEAD, AT_QH = GROUP_W / AT_HEAD, AT_KVH = CFG_AT_KVH, AT_COLS = (AT_QH + 2 * AT_KVH) * AT_HEAD;
constexpr int N_IN = RW_COLS + ML_COLS + GD_COLS + AT_COLS;
constexpr int RW_OFF = 0, ML_OFF = RW_COLS, GD_OFF = ML_OFF + ML_COLS, AT_OFF = GD_OFF + GD_COLS;
constexpr int LDP = (N_IN + 255) / 256 * 256;
constexpr int NE = CFG_NE, CAPL = 2 * SEQ / NE, CAPC = 2 * CTX / NE;
constexpr int NSLOT_L = BATCH * CAPL, NSLOT_C = BATCH * CAPC;
constexpr int NSLOT = (NSLOT_L + NSLOT_C + 255) / 256 * 256;
constexpr int NCHUNK = TOK / CHUNK, ML_CH = BATCH * ML_HEADS * 2, GD_CH = BATCH * GD_HEADS * 2, RW_CH = BATCH * RW_HEADS * 2;
constexpr float NORM_EPS = 1e-6f, RW_GN_EPS = 64e-5f, RW_DECAY_SCALE = 0.6065306597126334f;
static_assert(ML_HEADS == GD_HEADS, "heads");

typedef unsigned short u16;

#ifdef CPU_TEST
#include <cmath>
#include <cstdint>
#include <cstring>
#define HD inline
#else
#define HD __device__ __forceinline__
#endif

struct Params {
    const float *x, *c, *ctx, *c_ctx, *ada_w, *ada_b, *norm1_g, *norm2_g, *w_in, *w_out;
    const float *rw_mu, *rw_w0, *rw_w_up, *rw_a0, *rw_a_up, *rw_g_up, *rw_k_k, *rw_k_a, *rw_r_k, *rw_ln_w, *rw_ln_b;
    const float *ml_ib, *ml_fb, *ml_norm_g, *gd_conv, *gd_a_log, *gd_dt_bias, *gd_norm_g, *at_q_norm, *at_k_norm;
    const float *w_router, *w_exp1, *w_exp3, *w_exp2, *final_g;
    float* out;
    unsigned* bar;
    float *modp, *mod;
    u16 *wt_in, *wt_out, *w13t, *w2t;
    float* xres;
    u16* h;
    float* P;
    float *rw_r, *rw_k, *rw_v, *rw_lr, *rw_kk, *rw_g, *rw_ew, *rw_kka, *rw_kt, *rw_y;
    float *rw_Ma, *rw_T, *rw_Psi, *rw_Y0; u16 *rw_PhiT, *rw_Rh;
    float *ml_bcum, *ml_g, *ml_gmax, *ml_bl, *ml_gm, *ml_min, *ml_dC, *ml_dn, *ml_S, *ml_hh;
    float *gd_q, *gd_k, *gd_v, *gd_gc, *gd_beta, *gd_A, *gd_T, *gd_Psi, *gd_O0, *gd_o; u16 *gd_Phi, *gd_Qh;
    u16 *at_q, *at_k, *at_v;
    u16* mix;
    float* aff; int* inv;
    int* sel_row; float* sel_gate;
    u16 *xs, *hid; float* yexp;
};

struct Exec { int gid, ngroups, gl; };

template <int G> HD float group_sum(float v) {
#ifndef CPU_TEST
#pragma unroll
    for (int o = G / 2; o > 0; o >>= 1) v += __shfl_xor(v, o, 64);
#endif
    return v;
}
template <int G> HD float group_max(float v) {
#ifndef CPU_TEST
#pragma unroll
    for (int o = G / 2; o > 0; o >>= 1) v = fmaxf(v, __shfl_xor(v, o, 64));
#endif
    return v;
}

HD u16 f2bf(float f) { unsigned u; memcpy(&u, &f, 4); u += 0x7FFFu + ((u >> 16) & 1u); return (u16)(u >> 16); }
HD float bf2f(u16 b) { unsigned u = ((unsigned)b) << 16; float f; memcpy(&f, &u, 4); return f; }
HD float sigmoidf_(float x) { return 1.f / (1.f + expf(-x)); }
HD float siluf_(float x) { return x / (1.f + expf(-x)); }
HD float softplusf_(float x) { return x > 20.f ? x : log1pf(expf(x)); }
HD float logsigmoidf_(float x) { return x < 0.f ? x - log1pf(expf(x)) : -log1pf(expf(-x)); }

HD float bf_round(float f) { return bf2f(f2bf(f)); }
#ifndef CPU_TEST
typedef short mma_bf16x8 __attribute__((ext_vector_type(8)));
typedef float mma_f32x16 __attribute__((ext_vector_type(16)));
__device__ __forceinline__ unsigned mma_cvt_pk(float lo, float hi) { unsigned r; asm volatile("v_cvt_pk_bf16_f32 %0, %1, %2" : "=v"(r) : "v"(lo), "v"(hi)); return r; }
#endif
template <int K, class FA, class FB, class FE> HD void wave_mma32(int lane, FA fa, FB fb, FE fe) {
    static_assert(K % 16 == 0, "K");
#ifdef CPU_TEST
    (void)lane;
    for (int m = 0; m < 32; ++m) for (int n = 0; n < 32; ++n) { float acc = 0.f;
        for (int k0 = 0; k0 < K; k0 += 8) { float a8[8], b8[8]; fa(m, k0, a8); fb(n, k0, b8);
            for (int j = 0; j < 8; ++j) acc += bf_round(a8[j]) * bf_round(b8[j]); }
        fe(m, n, acc); }
#else
    const int r = lane & 31, h = lane >> 5;
    mma_f32x16 acc;
#pragma unroll
    for (int q = 0; q < 16; ++q) acc[q] = 0.f;
#pragma unroll
    for (int k0 = 0; k0 < K; k0 += 16) { float a8[8], b8[8]; fa(r, k0 + 8 * h, a8); fb(r, k0 + 8 * h, b8);
        typedef unsigned u4 __attribute__((ext_vector_type(4)));
        u4 aw, bw;
        aw.x = mma_cvt_pk(a8[0], a8[1]); aw.y = mma_cvt_pk(a8[2], a8[3]); aw.z = mma_cvt_pk(a8[4], a8[5]); aw.w = mma_cvt_pk(a8[6], a8[7]);
        bw.x = mma_cvt_pk(b8[0], b8[1]); bw.y = mma_cvt_pk(b8[2], b8[3]); bw.z = mma_cvt_pk(b8[4], b8[5]); bw.w = mma_cvt_pk(b8[6], b8[7]);
        acc = __builtin_amdgcn_mfma_f32_32x32x16_bf16(__builtin_bit_cast(mma_bf16x8, aw), __builtin_bit_cast(mma_bf16x8, bw), acc, 0, 0, 0); }
#pragma unroll
    for (int q = 0; q < 16; ++q) fe((q & 3) + 8 * (q >> 2) + 4 * h, r, acc[q]);
#endif
}
HD void ld8_bf(const u16* p, float (&o)[8]) {
#pragma unroll
    for (int j = 0; j < 8; ++j) o[j] = bf2f(p[j]); }
HD void ld8_f(const float* p, float (&o)[8]) {
#pragma unroll
    for (int j = 0; j < 8; ++j) o[j] = p[j]; }
#ifdef CPU_TEST
#define BLOCK_SYNC()
#define BLOCK_FOR(i, n) for (int i = 0; i < (n); ++i)
#define WAVE_FOR(w, n) for (int w = 0; w < (n); ++w)
#define LANE 0
#define OPAQUE_TID()
#else
#define BLOCK_SYNC() __syncthreads()
#define BLOCK_FOR(i, n) for (int i = tid; i < (n); i += nthr)
#define WAVE_FOR(w, n) _Pragma("unroll 1") for (int w = tid >> 6; w < (n); w += (nthr >> 6))
#define LANE (tid & 63)
#define OPAQUE_TID() asm volatile("" : "+v"(tid))
#endif

HD int row_b(int R) { return R / TOK; }
HD int row_s(int R) { return R % TOK; }
HD bool row_ctx(int R) { return row_s(R) < CTX; }
HD int mod_sel(int R) { return row_ctx(R) ? 2 : row_b(R); }
HD int seq_s(int d, int p) { return d == 0 ? p : (p < CTX ? CTX - 1 - p : TOK - 1 - (p - CTX)); }
HD const float* modv(const Params& p, int layer, int sel, int k) { return p.mod + ((size_t)(layer * 3 + sel) * 6 + k) * D_MODEL; }

constexpr int MOD_KS = 16;
HD void ph_mod_partial(const Params& p, Exec e) {
    const int n = DEPTH * MOD_KS * 6 * D_MODEL;
    for (int it = e.gid; it < n; it += e.ngroups) {
        const int col = it % (6 * D_MODEL), ks = (it / (6 * D_MODEL)) % MOD_KS, l = it / (6 * D_MODEL * MOD_KS);
        const float* w = p.ada_w + (size_t)l * D_MODEL * 6 * D_MODEL + col;
        float a0 = 0.f, a1 = 0.f, a2 = 0.f;
        const int k0 = ks * (D_MODEL / MOD_KS);
        for (int k = k0; k < k0 + D_MODEL / MOD_KS; ++k) {
            const float wv = w[(size_t)k * 6 * D_MODEL];
            a0 += siluf_(p.c[k]) * wv; a1 += siluf_(p.c[D_MODEL + k]) * wv; a2 += siluf_(p.c_ctx[k]) * wv;
        }
        float* o = p.modp + ((size_t)(l * MOD_KS + ks) * 3) * 6 * D_MODEL + col;
        o[0] = a0; o[6 * D_MODEL] = a1; o[2 * 6 * D_MODEL] = a2;
    }
}
HD void ph_mod_final(const Params& p, Exec e) {
    const int n = DEPTH * 3 * 6 * D_MODEL;
    for (int it = e.gid; it < n; it += e.ngroups) {
        const int col = it % (6 * D_MODEL), sel = (it / (6 * D_MODEL)) % 3, l = it / (6 * D_MODEL * 3);
        float a = p.ada_b[l * 6 * D_MODEL + col];
        for (int ks = 0; ks < MOD_KS; ++ks) a += p.modp[((size_t)(l * MOD_KS + ks) * 3 + sel) * 6 * D_MODEL + col];
        p.mod[(size_t)(l * 3 + sel) * 6 * D_MODEL + col] = a;
    }
}

HD float resid_in(const Params& p, int layer, int R, int c) {
    if (layer == 0) { const int b = row_b(R), s = row_s(R);
        return s < CTX ? p.ctx[((size_t)b * CTX + s) * D_MODEL + c] : p.x[((size_t)b * SEQ + (s - CTX)) * D_MODEL + c]; }
    float v = p.xres[(size_t)R * D_MODEL + c];
    const float m5 = modv(p, layer - 1, mod_sel(R), 5)[c];
    float acc = 0.f;
    for (int ex = 0; ex < NE; ++ex) { const int j = p.inv[(size_t)R * NE + ex]; if (j >= 0) acc += p.yexp[((size_t)ex * NSLOT + j) * D_MODEL + c]; }
    return v + m5 * acc;
}
template <int G> HD void ph_norm1(const Params& p, int layer, Exec e) {
    for (int R = e.gid; R < MROWS; R += e.ngroups) {
        float ss = 0.f;
        for (int c = e.gl; c < D_MODEL; c += G) { const float v = resid_in(p, layer, R, c); p.xres[(size_t)R * D_MODEL + c] = v; ss += v * v; }
        ss = group_sum<G>(ss);
        const float rstd = 1.f / sqrtf(ss / D_MODEL + NORM_EPS);
        const int sel = mod_sel(R); const float *m0 = modv(p, layer, sel, 0), *m1 = modv(p, layer, sel, 1), *g = p.norm1_g + layer * D_MODEL;
        for (int c = e.gl; c < D_MODEL; c += G) { const float v = p.xres[(size_t)R * D_MODEL + c];
            p.h[(size_t)R * D_MODEL + c] = f2bf(v * rstd * g[c] * (1.f + m1[c]) + m0[c]); }
    }
}
template <int G> HD void ph_final(const Params& p, Exec e) {
    for (int i = e.gid; i < BATCH * SEQ; i += e.ngroups) {
        const int b = i / SEQ, t = i % SEQ, R = b * TOK + CTX + t;
        float ss = 0.f;
        for (int c = e.gl; c < D_MODEL; c += G) { const float v = resid_in(p, DEPTH, R, c); ss += v * v; }
        ss = group_sum<G>(ss);
        const float rstd = 1.f / sqrtf(ss / D_MODEL + NORM_EPS);
        for (int c = e.gl; c < D_MODEL; c += G) p.out[(size_t)i * D_MODEL + c] = resid_in(p, DEPTH, R, c) * rstd * p.final_g[c];
    }
}
template <int G> HD void ph_norm2(const Params& p, int layer, Exec e) {
    const bool last = layer == DEPTH - 1;
    for (int R = e.gid; R < MROWS; R += e.ngroups) {
        if (last && row_ctx(R)) continue;
        float ss = 0.f;
        for (int c = e.gl; c < D_MODEL; c += G) { const float v = p.xres[(size_t)R * D_MODEL + c]; ss += v * v; }
        ss = group_sum<G>(ss);
        const float rstd = 1.f / sqrtf(ss / D_MODEL + NORM_EPS);
        const int sel = mod_sel(R); const float *m3 = modv(p, layer, sel, 3), *m4 = modv(p, layer, sel, 4), *g = p.norm2_g + layer * D_MODEL;
        const float* wr = p.w_router + (size_t)layer * D_MODEL * NE;
        float lg[NE];
#pragma unroll
        for (int ex = 0; ex < NE; ++ex) lg[ex] = 0.f;
        for (int c = e.gl; c < D_MODEL; c += G) { const float v = p.xres[(size_t)R * D_MODEL + c];
            const float hv = v * rstd * g[c] * (1.f + m4[c]) + m3[c];
            p.h[(size_t)R * D_MODEL + c] = f2bf(hv);
#pragma unroll
            for (int ex = 0; ex < NE; ++ex) lg[ex] += hv * wr[c * NE + ex]; }
        float mx = -1e30f;
#pragma unroll
        for (int ex = 0; ex < NE; ++ex) { lg[ex] = group_sum<G>(lg[ex]); mx = fmaxf(mx, lg[ex]); }
        float sum = 0.f;
#pragma unroll
        for (int ex = 0; ex < NE; ++ex) { lg[ex] = expf(lg[ex] - mx); sum += lg[ex]; }
        if (e.gl == 0) {
#pragma unroll
            for (int ex = 0; ex < NE; ++ex) p.aff[(size_t)R * NE + ex] = lg[ex] / sum; }
    }
}
HD void ph_topk(const Params& p, int layer, Exec e) {
    const bool last = layer == DEPTH - 1;
    const int nl = BATCH * NE * SEQ, nc = last ? 0 : BATCH * NE * CTX, npad = NE * (NSLOT - NSLOT_L - (last ? 0 : NSLOT_C));
    for (int it = e.gid; it < nl + nc + npad; it += e.ngroups) {
        if (it >= nl + nc) { const int q = it - nl - nc, per = npad / NE, ex = q / per, j = NSLOT - per + q % per;
            p.sel_row[ex * NSLOT + j] = 0; p.sel_gate[ex * NSLOT + j] = 0.f; continue; }
        int seg, b, ex, t, L, base, cap, jbase;
        if (it < nl) { seg = 0; t = it % SEQ; ex = (it / SEQ) % NE; b = it / (SEQ * NE); L = SEQ; base = b * TOK + CTX; cap = CAPL; jbase = b * CAPL; }
        else { const int q = it - nl; seg = 1; t = q % CTX; ex = (q / CTX) % NE; b = q / (CTX * NE); L = CTX; base = b * TOK; cap = CAPC; jbase = NSLOT_L + b * CAPC; }
        (void)seg;
        const float a = p.aff[(size_t)(base + t) * NE + ex];
        int rank = 0;
        for (int u = 0; u < L; ++u) { const float au = p.aff[(size_t)(base + u) * NE + ex]; rank += (au > a || (au == a && u < t)) ? 1 : 0; }
        if (rank < cap) { const int j = jbase + rank; p.sel_row[ex * NSLOT + j] = base + t; p.sel_gate[ex * NSLOT + j] = a; p.inv[(size_t)(base + t) * NE + ex] = j; }
        else p.inv[(size_t)(base + t) * NE + ex] = -1;
    }
}
template <int G> HD void ph_gather(const Params& p, int layer, Exec e) {
    const bool last = layer == DEPTH - 1;
    const int nj = last ? NSLOT_L : NSLOT;
    for (int it = e.gid; it < NE * nj; it += e.ngroups) {
        const int ex = it / nj, j = it % nj, R = p.sel_row[ex * NSLOT + j];
        const uint4* s = (const uint4*)(p.h + (size_t)R * D_MODEL); uint4* d = (uint4*)(p.xs + ((size_t)ex * NSLOT + j) * D_MODEL);
        for (int c = e.gl; c < D_MODEL / 8; c += G) d[c] = s[c];
    }
}

template <int G> HD void ph_rw_prep1(const Params& p, int layer, Exec e) {
    const float* mu = p.rw_mu + (size_t)layer * 2 * RW_COLS;
    for (int R = e.gid; R < MROWS; R += e.ngroups) {
        const int s = row_s(R); const bool hp = (s != 0 && s != CTX), hn = (s != CTX - 1 && s != TOK - 1);
        const float* pr = p.P + (size_t)R * LDP + RW_OFF;
        for (int c = e.gl; c < RW_COLS; c += G) {
            const float v = pr[c], pv = hp ? pr[c - LDP] : 0.f, nv = hn ? pr[c + LDP] : 0.f;
            const float pp = v + mu[c] * (pv - v) + mu[RW_COLS + c] * (nv - v);
            if (c < GROUP_W) p.rw_r[(size_t)R * GROUP_W + c] = pp;
            else if (c < 2 * GROUP_W) p.rw_k[(size_t)R * GROUP_W + c - GROUP_W] = pp;
            else if (c < 3 * GROUP_W) p.rw_v[(size_t)R * GROUP_W + c - 2 * GROUP_W] = pp;
            else { const int q = c - 3 * GROUP_W; float o;
                if (q < RW_DR) o = tanhf(pp); else if (q < RW_DR + RW_IR) o = pp; else o = sigmoidf_(pp);
                p.rw_lr[(size_t)R * RW_LR + q] = o; }
        }
    }
}
template <int G> HD void ph_rw_prep2(const Params& p, int layer, Exec e) {
    static_assert(G <= RW_HEAD, "G");
    const float *gup = p.rw_g_up + (size_t)layer * RW_GR * GROUP_W, *kk_w = p.rw_k_k + layer * GROUP_W, *ka_w = p.rw_k_a + layer * GROUP_W;
    for (int R = e.gid; R < MROWS; R += e.ngroups) {
        const float* lr = p.rw_lr + (size_t)R * RW_LR; const float* kr = p.rw_k + (size_t)R * GROUP_W;
        for (int hh = 0; hh < RW_HEADS; ++hh) {
            float ss = 0.f;
            for (int j = hh * RW_HEAD + e.gl; j < (hh + 1) * RW_HEAD; j += G) { const float xk = kr[j] * kk_w[j]; ss += xk * xk; }
            ss = group_sum<G>(ss);
            const float rn = 1.f / sqrtf(ss + 1e-6f);
            for (int j = hh * RW_HEAD + e.gl; j < (hh + 1) * RW_HEAD; j += G) {
                const float kv = kr[j], kkv = kv * kk_w[j] * rn;
                p.rw_kk[(size_t)R * GROUP_W + j] = kkv;
                float g = 0.f;
                for (int i = 0; i < RW_GR; ++i) g += lr[RW_DR + RW_IR + i] * gup[i * GROUP_W + j];
                p.rw_g[(size_t)R * GROUP_W + j] = g;
                for (int d = 0; d < 2; ++d) {
                    const float *wup = p.rw_w_up + ((size_t)(layer * 2 + d) * RW_DR) * GROUP_W, *aup = p.rw_a_up + ((size_t)(layer * 2 + d) * RW_IR) * GROUP_W;
                    float wl = p.rw_w0[(layer * 2 + d) * GROUP_W + j], al = p.rw_a0[(layer * 2 + d) * GROUP_W + j];
                    for (int i = 0; i < RW_DR; ++i) wl += lr[i] * wup[i * GROUP_W + j];
                    for (int i = 0; i < RW_IR; ++i) al += lr[RW_DR + i] * aup[i * GROUP_W + j];
                    const float logw = -RW_DECAY_SCALE * sigmoidf_(wl), a = sigmoidf_(al);
                    const size_t o = ((size_t)d * MROWS + R) * GROUP_W + j;
                    p.rw_ew[o] = logw; p.rw_kka[o] = kkv * a; p.rw_kt[o] = kv * (1.f + (a - 1.f) * ka_w[j]);
                }
            }
        }
    }
}
template <int G> HD void ph_rw_scan(const Params& p, Exec e) {
    constexpr int KPL = RW_HEAD / G;
    for (int it = e.gid; it < RW_CH * RW_HEAD; it += e.ngroups) {
        const int i = it % RW_HEAD, ch = it / RW_HEAD, d = ch % 2, hh = (ch / 2) % RW_HEADS, b = ch / (2 * RW_HEADS);
        float S[KPL];
#pragma unroll
        for (int q = 0; q < KPL; ++q) S[q] = 0.f;
        const int k0 = hh * RW_HEAD + e.gl * KPL;
        for (int pos = 0; pos < TOK; ++pos) {
            const int R = b * TOK + seq_s(d, pos);
            const size_t o1 = (size_t)R * GROUP_W + k0, o2 = ((size_t)d * MROWS + R) * GROUP_W + k0;
            const float vv = p.rw_v[(size_t)R * GROUP_W + hh * RW_HEAD + i];
            float sk = 0.f;
#pragma unroll
            for (int q = 0; q < KPL; ++q) sk += S[q] * p.rw_kk[o1 + q];
            sk = group_sum<G>(sk);
            float y = 0.f;
#pragma unroll
            for (int q = 0; q < KPL; ++q) { S[q] = S[q] * p.rw_ew[o2 + q] - sk * p.rw_kka[o2 + q] + vv * p.rw_kt[o2 + q]; y += S[q] * p.rw_r[o1 + q]; }
            y = group_sum<G>(y);
            if (e.gl == 0) p.rw_y[((size_t)d * MROWS + R) * GROUP_W + hh * RW_HEAD + i] = y;
        }
    }
}

constexpr int RW_N = RW_HEAD, RW_CN = RW_CH * NCHUNK;
static_assert(CHUNK % 32 == 0 && RW_HEAD % 32 == 0, "tile sizes");
HD void rw_chain(int ch, int& b, int& hh, int& d) { d = ch % 2; hh = (ch / 2) % RW_HEADS; b = ch / (2 * RW_HEADS); }
constexpr int RW_C1_SMEM = CHUNK * RW_N * 4 + 2 * CHUNK * RW_N * 2;
HD void ph_rw_c1_unit(const Params& p, int cn, int tid, int nthr, unsigned char* smem) {
    (void)tid; (void)nthr; OPAQUE_TID();
    constexpr int C = CHUNK, N = RW_N;
    const int ch = cn / NCHUNK, n = cn % NCHUNK; int b, hh, d; rw_chain(ch, b, hh, d);
    float* cum = (float*)smem; u16* KKt = (u16*)(cum + C * N); u16* At = KKt + C * N;
    const size_t dofs = (size_t)d * MROWS * GROUP_W;
    BLOCK_FOR(k, N) { float acc = 0.f;
        for (int t = 0; t < C; ++t) { const int R = b * TOK + seq_s(d, n * C + t); acc += p.rw_ew[dofs + (size_t)R * GROUP_W + hh * N + k]; cum[t * N + k] = acc; } }
    BLOCK_SYNC();
    BLOCK_FOR(idx, C * N) { const int t = idx / N, k = idx % N, R = b * TOK + seq_s(d, n * C + t); const size_t o = (size_t)R * GROUP_W + hh * N + k;
        const float cu = cum[idx], cp = cu - p.rw_ew[dofs + o];
        KKt[idx] = f2bf(p.rw_kk[o] * expf(cp)); At[idx] = f2bf(p.rw_kka[dofs + o] * expf(-cu)); }
    BLOCK_SYNC();
    float* Ma = p.rw_Ma + (size_t)cn * C * C;
    WAVE_FOR(w, (C / 32) * (C / 32)) { const int tm = w / (C / 32), tn = w % (C / 32);
        wave_mma32<N>(LANE, [&](int m, int k0, float (&o)[8]) { ld8_bf(KKt + (tm * 32 + m) * N + k0, o); },
                            [&](int nn, int k0, float (&o)[8]) { ld8_bf(At + (tn * 32 + nn) * N + k0, o); },
                            [&](int m, int nn, float acc) { const int t = tm * 32 + m, sx = tn * 32 + nn; Ma[t * C + sx] = sx < t ? acc : 0.f; }); }
    BLOCK_SYNC();
}
constexpr int TS_G = 8, TS_SMEM = TS_G * CHUNK * CHUNK * 4;
HD void ph_tsolve_unit(const float* Mall, float* Tall, int nprob, int unit, int tid, int nthr, unsigned char* smem) {
    (void)tid; (void)nthr; OPAQUE_TID();
    constexpr int C = CHUNK;
    float* Tl = (float*)smem;
    BLOCK_FOR(idx, TS_G * C) { const int w = idx / C, j = idx % C, pr = unit * TS_G + w;
        if (pr < nprob) { const float* M = Mall + (size_t)pr * C * C; float* Tc = Tl + w * C * C; float* To = Tall + (size_t)pr * C * C;
            for (int t = 0; t < C; ++t) { float acc = 0.f;
                if (t == j) acc = 1.f;
                else if (t > j) { for (int sx = j; sx < t; ++sx) acc -= M[t * C + sx] * Tc[sx * C + j]; }
                Tc[t * C + j] = acc; To[t * C + j] = acc; } } }
    BLOCK_SYNC();
}
constexpr int RW_C3_SMEM = CHUNK * RW_N * 4 + 13 * CHUNK * RW_N * 2 + RW_N * 4;
HD void ph_rw_c3_unit(const Params& p, int cn, int tid, int nthr, unsigned char* smem) {
    (void)tid; (void)nthr; OPAQUE_TID();
    constexpr int C = CHUNK, N = RW_N, CN = C * N;
    static_assert(C == N, "c3 buffer aliasing assumes C == N");
    const int ch = cn / NCHUNK, n = cn % NCHUNK; int b, hh, d; rw_chain(ch, b, hh, d);
    float* cum = (float*)smem; u16* mb = (u16*)(cum + CN);
    u16 *KKt = mb, *KKtT = mb + CN, *At = mb + 2 * CN, *KTt = mb + 3 * CN, *Rt = mb + 4 * CN, *ApT = mb + 5 * CN, *KTpT = mb + 6 * CN, *VT = mb + 7 * CN,
        *Tb = mb + 8 * CN, *MkT = mb + 9 * CN, *ZT = mb + 10 * CN, *Na = mb + 11 * CN, *Nk = mb + 12 * CN;
    float* PC = (float*)(mb + 13 * CN);
    u16 *Gm = (u16*)cum, *KKhT = (u16*)cum + CN;
    const size_t dofs = (size_t)d * MROWS * GROUP_W;
    BLOCK_FOR(k, N) { float acc = 0.f;
        for (int t = 0; t < C; ++t) { const int R = b * TOK + seq_s(d, n * C + t); acc += p.rw_ew[dofs + (size_t)R * GROUP_W + hh * N + k]; cum[t * N + k] = acc; }
        PC[k] = expf(acc); }
    BLOCK_SYNC();
    BLOCK_FOR(idx, CN) { const int t = idx / N, k = idx % N, R = b * TOK + seq_s(d, n * C + t); const size_t o = (size_t)R * GROUP_W + hh * N + k;
        const float cu = cum[idx], cp = cu - p.rw_ew[dofs + o], cC = cum[(C - 1) * N + k];
        const float kkv = p.rw_kk[o], kav = p.rw_kka[dofs + o], ktv = p.rw_kt[dofs + o];
        const float e_m = expf(-cu), e_c = expf(cC - cu);
        const u16 kkt = f2bf(kkv * expf(cp));
        KKt[t * N + k] = kkt; KKtT[k * C + t] = kkt; At[t * N + k] = f2bf(kav * e_m); KTt[t * N + k] = f2bf(ktv * e_m); Rt[t * N + k] = f2bf(p.rw_r[o] * expf(cu));
        ApT[k * C + t] = f2bf(kav * e_c); KTpT[k * C + t] = f2bf(ktv * e_c); VT[k * C + t] = f2bf(p.rw_v[o]); }
    BLOCK_FOR(idx, C * C) Tb[idx] = f2bf(p.rw_T[(size_t)cn * C * C + idx]);
    BLOCK_SYNC();
    constexpr int TC = C / 32, TN = N / 32;
    WAVE_FOR(w, 3 * TC * TC) { const int which = w / (TC * TC), tm = (w / TC) % TC, tn = w % TC;
        const u16* Am = which == 0 ? KTt : Rt; const u16* Bm = which == 0 ? KKt : (which == 1 ? At : KTt); u16* Om = which == 0 ? MkT : (which == 1 ? Na : Nk);
        wave_mma32<N>(LANE, [&](int m, int k0, float (&o)[8]) { ld8_bf(Am + (tm * 32 + m) * N + k0, o); },
                            [&](int nn, int k0, float (&o)[8]) { ld8_bf(Bm + (tn * 32 + nn) * N + k0, o); },
                            [&](int m, int nn, float acc) { const int r = tm * 32 + m, cc = tn * 32 + nn; const bool keep = which == 0 ? (cc > r) : (cc <= r);
                                Om[r * C + cc] = f2bf(keep ? acc : 0.f); }); }
    BLOCK_SYNC();
    WAVE_FOR(w, TC * TC + TN * TC) {
        if (w < TC * TC) { const int tm = w / TC, tn = w % TC;
            wave_mma32<C>(LANE, [&](int m, int k0, float (&o)[8]) { ld8_bf(Tb + (tm * 32 + m) * C + k0, o); },
                                [&](int nn, int k0, float (&o)[8]) { ld8_bf(MkT + (tn * 32 + nn) * C + k0, o); },
                                [&](int m, int nn, float acc) { Gm[(tm * 32 + m) * C + tn * 32 + nn] = f2bf(acc); }); }
        else { const int q = w - TC * TC, tm = q / TC, tn = q % TC;
            wave_mma32<C>(LANE, [&](int m, int k0, float (&o)[8]) { ld8_bf(KKtT + (tm * 32 + m) * C + k0, o); },
                                [&](int nn, int k0, float (&o)[8]) { ld8_bf(Tb + (tn * 32 + nn) * C + k0, o); },
                                [&](int m, int nn, float acc) { KKhT[(tm * 32 + m) * C + tn * 32 + nn] = f2bf(acc); }); } }
    BLOCK_SYNC();
    u16* RhG = p.rw_Rh + (size_t)cn * CN; u16* PhiTG = p.rw_PhiT + (size_t)cn * N * N;
    WAVE_FOR(w, TN * TC + TC * TN + TN * TN) {
        if (w < TN * TC) { const int tm = w / TC, tn = w % TC;
            wave_mma32<C>(LANE, [&](int m, int k0, float (&o)[8]) { ld8_bf(VT + (tm * 32 + m) * C + k0, o); },
                                [&](int nn, int k0, float (&o)[8]) { ld8_bf(Gm + (tn * 32 + nn) * C + k0, o); },
                                [&](int m, int nn, float acc) { ZT[(tm * 32 + m) * C + tn * 32 + nn] = f2bf(acc); }); }
        else if (w < TN * TC + TC * TN) { const int q = w - TN * TC, tm = q / TN, tn = q % TN;
            wave_mma32<C>(LANE, [&](int m, int k0, float (&o)[8]) { ld8_bf(Na + (tm * 32 + m) * C + k0, o); },
                                [&](int nn, int k0, float (&o)[8]) { ld8_bf(KKhT + (tn * 32 + nn) * C + k0, o); },
                                [&](int m, int nn, float acc) { const int t = tm * 32 + m, k = tn * 32 + nn; RhG[t * N + k] = f2bf(bf2f(Rt[t * N + k]) - acc); }); }
        else { const int q = w - TN * TC - TC * TN, tm = q / TN, tn = q % TN;
            wave_mma32<C>(LANE, [&](int m, int k0, float (&o)[8]) { ld8_bf(ApT + (tm * 32 + m) * C + k0, o); },
                                [&](int nn, int k0, float (&o)[8]) { ld8_bf(KKhT + (tn * 32 + nn) * C + k0, o); },
                                [&](int m, int nn, float acc) { const int k = tm * 32 + m, k2 = tn * 32 + nn; PhiTG[k * N + k2] = f2bf((k == k2 ? PC[k] : 0.f) - acc); }); } }
    BLOCK_SYNC();
    float* Y0G = p.rw_Y0 + (size_t)cn * CN; float* PsiG = p.rw_Psi + (size_t)cn * N * N;
    WAVE_FOR(w, TC * TN + TN * TN) {
        if (w < TC * TN) { const int tm = w / TN, tn = w % TN;
            wave_mma32<2 * C>(LANE, [&](int m, int k0, float (&o)[8]) { if (k0 < C) ld8_bf(Nk + (tm * 32 + m) * C + k0, o); else { ld8_bf(Na + (tm * 32 + m) * C + k0 - C, o);
#pragma unroll
                                        for (int j = 0; j < 8; ++j) o[j] = -o[j]; } },
                                    [&](int nn, int k0, float (&o)[8]) { if (k0 < C) ld8_bf(VT + (tn * 32 + nn) * C + k0, o); else ld8_bf(ZT + (tn * 32 + nn) * C + k0 - C, o); },
                                    [&](int m, int nn, float acc) { Y0G[(tm * 32 + m) * N + tn * 32 + nn] = acc; }); }
        else { const int q = w - TC * TN, tm = q / TN, tn = q % TN;
            wave_mma32<2 * C>(LANE, [&](int m, int k0, float (&o)[8]) { if (k0 < C) ld8_bf(VT + (tm * 32 + m) * C + k0, o); else { ld8_bf(ZT + (tm * 32 + m) * C + k0 - C, o);
#pragma unroll
                                        for (int j = 0; j < 8; ++j) o[j] = -o[j]; } },
                                    [&](int nn, int k0, float (&o)[8]) { if (k0 < C) ld8_bf(KTpT + (tn * 32 + nn) * C + k0, o); else ld8_bf(ApT + (tn * 32 + nn) * C + k0 - C, o); },
                                    [&](int m, int nn, float acc) { PsiG[(tm * 32 + m) * N + tn * 32 + nn] = acc; }); } }
    BLOCK_SYNC();
}
constexpr int RW_S2_SMEM = 2 * RW_N * RW_N * 2 + RW_N * RW_N * 2 + CHUNK * RW_N * 2 + RW_N * RW_N * 4 + CHUNK * RW_N * 4;
HD void ph_rw_scan2_unit(const Params& p, int ch, int tid, int nthr, unsigned char* smem) {
    (void)tid; (void)nthr; OPAQUE_TID();
    constexpr int C = CHUNK, N = RW_N, TC = C / 32, TN = N / 32;
    int b, hh, d; rw_chain(ch, b, hh, d);
    u16* Sb = (u16*)smem; u16* PhiT = Sb + 2 * N * N; u16* Rh = PhiT + N * N; float* Psi = (float*)(Rh + C * N); float* Y0 = Psi + N * N;
    BLOCK_FOR(i, N * N) Sb[i] = 0;
    for (int n = 0; n < NCHUNK; ++n) {
        const int cn = ch * NCHUNK + n;
        BLOCK_FOR(i, N * N) { PhiT[i] = p.rw_PhiT[(size_t)cn * N * N + i]; Psi[i] = p.rw_Psi[(size_t)cn * N * N + i]; }
        BLOCK_FOR(i, C * N) { Rh[i] = p.rw_Rh[(size_t)cn * C * N + i]; Y0[i] = p.rw_Y0[(size_t)cn * C * N + i]; }
        BLOCK_SYNC();
        const u16* Sc = Sb + (n & 1) * N * N; u16* Sn = Sb + ((n + 1) & 1) * N * N;
        WAVE_FOR(w, TN * TN + TC * TN) {
            if (w < TN * TN) { const int tm = w / TN, tn = w % TN;
                wave_mma32<N>(LANE, [&](int m, int k0, float (&o)[8]) { ld8_bf(Sc + (tm * 32 + m) * N + k0, o); },
                                    [&](int nn, int k0, float (&o)[8]) { ld8_bf(PhiT + (tn * 32 + nn) * N + k0, o); },
                                    [&](int m, int nn, float acc) { const int i = tm * 32 + m, k = tn * 32 + nn; Sn[i * N + k] = f2bf(acc + Psi[i * N + k]); }); }
            else { const int q = w - TN * TN, tm = q / TN, tn = q % TN;
                wave_mma32<N>(LANE, [&](int m, int k0, float (&o)[8]) { ld8_bf(Rh + (tm * 32 + m) * N + k0, o); },
                                    [&](int nn, int k0, float (&o)[8]) { ld8_bf(Sc + (tn * 32 + nn) * N + k0, o); },
                                    [&](int m, int nn, float acc) { const int t = tm * 32 + m, i = tn * 32 + nn, R = b * TOK + seq_s(d, n * C + t);
                                        p.rw_y[((size_t)d * MROWS + R) * GROUP_W + hh * N + i] = acc + Y0[t * N + i]; }); } }
        BLOCK_SYNC();
    }
}
template <int G> HD void ph_rw_post(const Params& p, int layer, Exec e) {
    static_assert(G <= RW_HEAD, "G");
    const float *lw = p.rw_ln_w + layer * GROUP_W, *lb = p.rw_ln_b + layer * GROUP_W, *rk = p.rw_r_k + layer * GROUP_W;
    for (int it = e.gid; it < MROWS * RW_HEADS; it += e.ngroups) {
        const int R = it / RW_HEADS, hh = it % RW_HEADS; const size_t o = (size_t)R * GROUP_W + hh * RW_HEAD, o2 = (size_t)MROWS * GROUP_W;
        float s1 = 0.f, bon = 0.f;
        for (int j = e.gl; j < RW_HEAD; j += G) { s1 += p.rw_y[o + j] + p.rw_y[o2 + o + j];
            bon += p.rw_r[o + j] * (p.rw_kt[o + j] + p.rw_kt[o2 + o + j]) * rk[hh * RW_HEAD + j]; }
        s1 = group_sum<G>(s1); bon = group_sum<G>(bon);
        const float mean = s1 / RW_HEAD;
        float s2 = 0.f;
        for (int j = e.gl; j < RW_HEAD; j += G) { const float dlt = p.rw_y[o + j] + p.rw_y[o2 + o + j] - mean; s2 += dlt * dlt; }
        s2 = group_sum<G>(s2);
        const float rstd = 1.f / sqrtf(s2 / RW_HEAD + RW_GN_EPS);
        for (int j = e.gl; j < RW_HEAD; j += G) { const float y = (p.rw_y[o + j] + p.rw_y[o2 + o + j] - mean) * rstd * lw[hh * RW_HEAD + j] + lb[hh * RW_HEAD + j];
            p.mix[(size_t)R * D_MODEL + hh * RW_HEAD + j] = f2bf((y + bon * p.rw_v[o + j]) * p.rw_g[o + j]); }
    }
}

HD void ml_chain(int ch, int& b, int& hh, int& d) { d = ch % 2; hh = (ch / 2) % ML_HEADS; b = ch / (2 * ML_HEADS); }
HD void ph_ml_g1(const Params& p, int layer, Exec e) {
    for (int it = e.gid; it < ML_CH * NCHUNK; it += e.ngroups) {
        const int ch = it / NCHUNK, n = it % NCHUNK; int b, hh, d; ml_chain(ch, b, hh, d);
        const float ib = p.ml_ib[(layer * 2 + d) * ML_HEADS + hh], fb = p.ml_fb[(layer * 2 + d) * ML_HEADS + hh];
        float bc = 0.f, gm = -1e30f;
        for (int t = 0; t < CHUNK; ++t) { const int pos = n * CHUNK + t, R = b * TOK + seq_s(d, pos);
            const float* g = p.P + (size_t)R * LDP + ML_OFF + 4 * GROUP_W;
            const float li = g[d * ML_HEADS + hh] + ib, lf = logsigmoidf_(g[(2 + d) * ML_HEADS + hh] + fb);
            bc += lf; const float gv = li - bc; gm = fmaxf(gm, gv);
            p.ml_bcum[(size_t)ch * TOK + pos] = bc; p.ml_g[(size_t)ch * TOK + pos] = gv; p.ml_gmax[(size_t)ch * TOK + pos] = gm; }
        p.ml_bl[ch * NCHUNK + n] = bc; p.ml_gm[ch * NCHUNK + n] = gm;
    }
}
HD void ph_ml_g2(const Params& p, Exec e) {
    for (int ch = e.gid; ch < ML_CH; ch += e.ngroups) { float m = 0.f;
        for (int n = 0; n < NCHUNK; ++n) { p.ml_min[ch * NCHUNK + n] = m; m = p.ml_bl[ch * NCHUNK + n] + fmaxf(m, p.ml_gm[ch * NCHUNK + n]); } }
}
HD void ph_ml_dC(const Params& p, Exec e) {
    const float ksc = 1.f / sqrtf((float)ML_HEAD);
    const int n1 = ML_CH * NCHUNK * ML_HEAD * ML_HEAD, n2 = ML_CH * NCHUNK * ML_HEAD;
    for (int it = e.gid; it < n1 + n2; it += e.ngroups) {
        const bool isn = it >= n1; const int q = isn ? it - n1 : it;
        const int dd = q % ML_HEAD, ee = isn ? 0 : (q / ML_HEAD) % ML_HEAD, cn = isn ? q / ML_HEAD : q / (ML_HEAD * ML_HEAD), n = cn % NCHUNK, ch = cn / NCHUNK;
        int b, hh, d; ml_chain(ch, b, hh, d);
        const float min_ = p.ml_min[cn], bl = p.ml_bl[cn], mnew = bl + fmaxf(min_, p.ml_gm[cn]);
        float acc = 0.f;
        for (int s = 0; s < CHUNK; ++s) { const int pos = n * CHUNK + s, R = b * TOK + seq_s(d, pos);
            const float wk = expf(bl + p.ml_g[(size_t)ch * TOK + pos] - mnew);
            const float* pr = p.P + (size_t)R * LDP + ML_OFF + hh * ML_HEAD;
            const float kv = pr[GROUP_W + dd] * ksc;
            acc += isn ? wk * kv : wk * kv * pr[2 * GROUP_W + ee]; }
        if (isn) p.ml_dn[(size_t)cn * ML_HEAD + dd] = acc; else p.ml_dC[((size_t)cn * ML_HEAD + ee) * ML_HEAD + dd] = acc;
    }
}
HD void ph_ml_prefix(const Params& p, Exec e) {
    const int n1 = ML_CH * ML_HEAD * ML_HEAD, n2 = ML_CH * ML_HEAD;
    for (int it = e.gid; it < n1 + n2; it += e.ngroups) {
        const bool isn = it >= n1; const int q = isn ? it - n1 : it, per = isn ? ML_HEAD : ML_HEAD * ML_HEAD, ch = q / per, el = q % per;
        float* arr = isn ? p.ml_dn : p.ml_dC; float st = 0.f;
        for (int n = 0; n < NCHUNK; ++n) { const int cn = ch * NCHUNK + n;
            const float min_ = p.ml_min[cn], bl = p.ml_bl[cn], mnew = bl + fmaxf(min_, p.ml_gm[cn]), dc = expf(bl + min_ - mnew);
            const size_t o = (size_t)cn * per + el; const float inc = arr[o]; arr[o] = st; st = dc * st + inc; }
    }
}
HD void ph_ml_S(const Params& p, Exec e) {
    const float ksc = 1.f / sqrtf((float)ML_HEAD);
    for (int it = e.gid; it < ML_CH * NCHUNK * CHUNK * CHUNK; it += e.ngroups) {
        const int s = it % CHUNK, t = (it / CHUNK) % CHUNK, cn = it / (CHUNK * CHUNK), n = cn % NCHUNK, ch = cn / NCHUNK;
        float v = 0.f;
        if (s <= t) { int b, hh, d; ml_chain(ch, b, hh, d);
            const int pt = n * CHUNK + t, ps = n * CHUNK + s, Rt = b * TOK + seq_s(d, pt), Rs = b * TOK + seq_s(d, ps);
            const float* qr = p.P + (size_t)Rt * LDP + ML_OFF + hh * ML_HEAD; const float* kr = p.P + (size_t)Rs * LDP + ML_OFF + GROUP_W + hh * ML_HEAD;
            float dot = 0.f; for (int k = 0; k < ML_HEAD; ++k) dot += qr[k] * kr[k];
            const float bt = p.ml_bcum[(size_t)ch * TOK + pt], mt = bt + fmaxf(p.ml_min[cn], p.ml_gmax[(size_t)ch * TOK + pt]);
            v = dot * ksc * expf(bt + p.ml_g[(size_t)ch * TOK + ps] - mt); }
        p.ml_S[it] = v;
    }
}
HD void ph_ml_out(const Params& p, Exec e) {
    for (int it = e.gid; it < ML_CH * NCHUNK * CHUNK * ML_HEAD; it += e.ngroups) {
        const int ee = it % ML_HEAD, t = (it / ML_HEAD) % CHUNK, cn = it / (ML_HEAD * CHUNK), n = cn % NCHUNK, ch = cn / NCHUNK;
        int b, hh, d; ml_chain(ch, b, hh, d);
        const int pt = n * CHUNK + t, Rt = b * TOK + seq_s(d, pt);
        const float bt = p.ml_bcum[(size_t)ch * TOK + pt], min_ = p.ml_min[cn], mt = bt + fmaxf(min_, p.ml_gmax[(size_t)ch * TOK + pt]), wi = expf(bt + min_ - mt);
        const float* Sr = p.ml_S + ((size_t)cn * CHUNK + t) * CHUNK;
        float num = 0.f, den = 0.f;
        for (int s = 0; s <= t; ++s) { const int Rs = b * TOK + seq_s(d, n * CHUNK + s); const float sv = Sr[s];
            num += sv * p.P[(size_t)Rs * LDP + ML_OFF + 2 * GROUP_W + hh * ML_HEAD + ee]; den += sv; }
        const float* qr = p.P + (size_t)Rt * LDP + ML_OFF + hh * ML_HEAD;
        const float* Cr = p.ml_dC + ((size_t)cn * ML_HEAD + ee) * ML_HEAD; const float* nr = p.ml_dn + (size_t)cn * ML_HEAD;
        float cq = 0.f, nq = 0.f;
        for (int k = 0; k < ML_HEAD; ++k) { cq += Cr[k] * qr[k]; nq += nr[k] * qr[k]; }
        num += wi * cq; den += wi * nq;
        p.ml_hh[((size_t)d * MROWS + Rt) * GROUP_W + hh * ML_HEAD + ee] = num / fmaxf(fabsf(den), expf(-mt));
    }
}

constexpr int ML_N = ML_HEAD, ML_CN = ML_CH * NCHUNK;
static_assert(ML_HEAD % 32 == 0, "tile");
constexpr int ML_C1_SMEM = 2 * ML_N * CHUNK * 2 + 4 * CHUNK * 4;
HD void ph_ml_c1_unit(const Params& p, int cn, int tid, int nthr, unsigned char* smem) {
    (void)tid; (void)nthr; OPAQUE_TID();
    constexpr int C = CHUNK, N = ML_N, TC = C / 32, TN = N / 32;
    const float ksc = 1.f / sqrtf((float)ML_HEAD);
    const int ch = cn / NCHUNK, n = cn % NCHUNK; int b, hh, d; ml_chain(ch, b, hh, d);
    u16* VwT = (u16*)smem; u16* KT = VwT + N * C; float* wk = (float*)(KT + N * C); float* btv = wk + C; float* gv = btv + C; float* mtv = gv + C;
    const float min_ = p.ml_min[cn], bl = p.ml_bl[cn], mnew = bl + fmaxf(min_, p.ml_gm[cn]);
    BLOCK_FOR(sx, C) { const size_t o = (size_t)ch * TOK + n * C + sx; const float g = p.ml_g[o], bt = p.ml_bcum[o];
        wk[sx] = expf(bl + g - mnew); btv[sx] = bt; gv[sx] = g; mtv[sx] = bt + fmaxf(min_, p.ml_gmax[o]); }
    BLOCK_SYNC();
    BLOCK_FOR(idx, C * N) { const int sx = idx / N, dd = idx % N, R = b * TOK + seq_s(d, n * C + sx); const float* pr = p.P + (size_t)R * LDP + ML_OFF + hh * N;
        VwT[dd * C + sx] = f2bf(wk[sx] * pr[2 * GROUP_W + dd]); KT[dd * C + sx] = f2bf(pr[GROUP_W + dd] * ksc); }
    BLOCK_SYNC();
    WAVE_FOR(w, TN * TN + TC * TC) {
        if (w < TN * TN) { const int tm = w / TN, tn = w % TN;
            wave_mma32<C>(LANE, [&](int m, int k0, float (&o)[8]) { ld8_bf(VwT + (tm * 32 + m) * C + k0, o); },
                                [&](int nn, int k0, float (&o)[8]) { ld8_bf(KT + (tn * 32 + nn) * C + k0, o); },
                                [&](int m, int nn, float acc) { p.ml_dC[((size_t)cn * N + tm * 32 + m) * N + tn * 32 + nn] = acc; }); }
        else { const int q = w - TN * TN, tm = q / TC, tn = q % TC;
            wave_mma32<N>(LANE, [&](int m, int k0, float (&o)[8]) { const int R = b * TOK + seq_s(d, n * C + tm * 32 + m); ld8_f(p.P + (size_t)R * LDP + ML_OFF + hh * N + k0, o); },
                                [&](int nn, int k0, float (&o)[8]) { const int R = b * TOK + seq_s(d, n * C + tn * 32 + nn); ld8_f(p.P + (size_t)R * LDP + ML_OFF + GROUP_W + hh * N + k0, o); },
                                [&](int m, int nn, float acc) { const int t = tm * 32 + m, sx = tn * 32 + nn;
                                    p.ml_S[((size_t)cn * C + t) * C + sx] = sx <= t ? acc * ksc * expf(btv[t] + gv[sx] - mtv[t]) : 0.f; }); } }
    BLOCK_FOR(dd, N) { float acc = 0.f;
        for (int sx = 0; sx < C; ++sx) { const int R = b * TOK + seq_s(d, n * C + sx); acc += wk[sx] * p.P[(size_t)R * LDP + ML_OFF + GROUP_W + hh * N + dd] * ksc; }
        p.ml_dn[(size_t)cn * N + dd] = acc; }
    BLOCK_SYNC();
}
constexpr int ML_C2_SMEM = ML_N * CHUNK * 2 + 3 * CHUNK * 4;
HD void ph_ml_c2_unit(const Params& p, int cn, int tid, int nthr, unsigned char* smem) {
    (void)tid; (void)nthr; OPAQUE_TID();
    constexpr int C = CHUNK, N = ML_N, TC = C / 32, TN = N / 32;
    const int ch = cn / NCHUNK, n = cn % NCHUNK; int b, hh, d; ml_chain(ch, b, hh, d);
    u16* VT = (u16*)smem; float* wi = (float*)(VT + N * C); float* den = wi + C; float* emt = den + C;
    const float min_ = p.ml_min[cn];
    BLOCK_FOR(t, C) { const size_t o = (size_t)ch * TOK + n * C + t; const float bt = p.ml_bcum[o], mt = bt + fmaxf(min_, p.ml_gmax[o]);
        wi[t] = expf(bt + min_ - mt); emt[t] = expf(-mt); }
    BLOCK_FOR(idx, C * N) { const int sx = idx / N, dd = idx % N, R = b * TOK + seq_s(d, n * C + sx);
        VT[dd * C + sx] = f2bf(p.P[(size_t)R * LDP + ML_OFF + 2 * GROUP_W + hh * N + dd]); }
    BLOCK_SYNC();
    BLOCK_FOR(t, C) { const int R = b * TOK + seq_s(d, n * C + t); const float* qr = p.P + (size_t)R * LDP + ML_OFF + hh * N; const float* Sr = p.ml_S + ((size_t)cn * C + t) * C;
        float a = 0.f, nq = 0.f;
        for (int sx = 0; sx <= t; ++sx) a += Sr[sx];
        for (int k = 0; k < N; ++k) nq += p.ml_dn[(size_t)cn * N + k] * qr[k];
        den[t] = a + wi[t] * nq; }
    BLOCK_SYNC();
    WAVE_FOR(w, TC * TN) { const int tm = w / TN, tn = w % TN;
        wave_mma32<C + N>(LANE, [&](int m, int k0, float (&o)[8]) { const int t = tm * 32 + m;
                                    if (k0 < C) ld8_f(p.ml_S + ((size_t)cn * C + t) * C + k0, o);
                                    else { const int R = b * TOK + seq_s(d, n * C + t); ld8_f(p.P + (size_t)R * LDP + ML_OFF + hh * N + k0 - C, o); const float wv = wi[t];
#pragma unroll
                                        for (int j = 0; j < 8; ++j) o[j] *= wv; } },
                                [&](int nn, int k0, float (&o)[8]) { const int ee = tn * 32 + nn;
                                    if (k0 < C) ld8_bf(VT + ee * C + k0, o); else ld8_f(p.ml_dC + ((size_t)cn * N + ee) * N + k0 - C, o); },
                                [&](int m, int nn, float acc) { const int t = tm * 32 + m, ee = tn * 32 + nn, R = b * TOK + seq_s(d, n * C + t);
                                    p.ml_hh[((size_t)d * MROWS + R) * GROUP_W + hh * N + ee] = acc / fmaxf(fabsf(den[t]), emt[t]); }); }
    BLOCK_SYNC();
}
template <int G> HD void ph_ml_post(const Params& p, int layer, Exec e) {
    const float* ng = p.ml_norm_g + layer * GROUP_W;
    for (int it = e.gid; it < MROWS * ML_HEADS; it += e.ngroups) {
        const int R = it / ML_HEADS, hh = it % ML_HEADS; const size_t o = (size_t)R * GROUP_W + hh * ML_HEAD, o2 = (size_t)MROWS * GROUP_W;
        float s1 = 0.f;
        for (int j = e.gl; j < ML_HEAD; j += G) s1 += p.ml_hh[o + j] + p.ml_hh[o2 + o + j];
        s1 = group_sum<G>(s1); const float mean = s1 / ML_HEAD;
        float s2 = 0.f;
        for (int j = e.gl; j < ML_HEAD; j += G) { const float dlt = p.ml_hh[o + j] + p.ml_hh[o2 + o + j] - mean; s2 += dlt * dlt; }
        s2 = group_sum<G>(s2); const float rstd = 1.f / sqrtf(s2 / ML_HEAD + NORM_EPS);
        for (int j = e.gl; j < ML_HEAD; j += G) { const float y = (p.ml_hh[o + j] + p.ml_hh[o2 + o + j] - mean) * rstd * ng[hh * ML_HEAD + j];
            const float og = p.P[(size_t)R * LDP + ML_OFF + 3 * GROUP_W + hh * ML_HEAD + j];
            p.mix[(size_t)R * D_MODEL + GROUP_W + hh * ML_HEAD + j] = f2bf(y * sigmoidf_(og)); }
    }
}

HD float gd_conv_silu(const Params& p, int layer, int R, int c) {
    const int s = row_s(R); const float* pr = p.P + (size_t)R * LDP + GD_OFF + c; const float* cw = p.gd_conv + (size_t)layer * 3 * 3 * GROUP_W + c;
    float v = pr[0] * cw[3 * GROUP_W];
    if (s != 0 && s != CTX) v += pr[-LDP] * cw[0];
    if (s != CTX - 1 && s != TOK - 1) v += pr[LDP] * cw[2 * 3 * GROUP_W];
    return siluf_(v);
}
template <int G> HD void ph_gd_prep(const Params& p, int layer, Exec e) {
    const float qsc = 1.f / sqrtf((float)GD_HEAD);
    for (int it = e.gid; it < MROWS * GD_HEADS; it += e.ngroups) {
        const int R = it / GD_HEADS, hh = it % GD_HEADS;
        float sq = 0.f, sk = 0.f;
        for (int j = e.gl; j < GD_HEAD; j += G) { const float a = gd_conv_silu(p, layer, R, hh * GD_HEAD + j), b2 = gd_conv_silu(p, layer, R, GROUP_W + hh * GD_HEAD + j); sq += a * a; sk += b2 * b2; }
        sq = group_sum<G>(sq); sk = group_sum<G>(sk);
        const float rq = qsc / sqrtf(sq + 1e-6f), rk = 1.f / sqrtf(sk + 1e-6f);
        for (int j = e.gl; j < GD_HEAD; j += G) { const size_t o = (size_t)R * GROUP_W + hh * GD_HEAD + j;
            p.gd_q[o] = gd_conv_silu(p, layer, R, hh * GD_HEAD + j) * rq; p.gd_k[o] = gd_conv_silu(p, layer, R, GROUP_W + hh * GD_HEAD + j) * rk;
            p.gd_v[o] = gd_conv_silu(p, layer, R, 2 * GROUP_W + hh * GD_HEAD + j); }
    }
}
HD void ph_gd_gates(const Params& p, int layer, Exec e) {
    for (int it = e.gid; it < GD_CH * NCHUNK; it += e.ngroups) {
        const int ch = it / NCHUNK, n = it % NCHUNK; int b, hh, d; ml_chain(ch, b, hh, d);
        const float al = expf(p.gd_a_log[(layer * 2 + d) * GD_HEADS + hh]), dtb = p.gd_dt_bias[(layer * 2 + d) * GD_HEADS + hh];
        float gc = 0.f;
        for (int t = 0; t < CHUNK; ++t) { const int pos = n * CHUNK + t, R = b * TOK + seq_s(d, pos);
            const float* g = p.P + (size_t)R * LDP + GD_OFF + 4 * GROUP_W;
            gc += -al * softplusf_(g[d * GD_HEADS + hh] + dtb);
            p.gd_gc[(size_t)ch * TOK + pos] = gc; p.gd_beta[(size_t)ch * TOK + pos] = sigmoidf_(g[(2 + d) * GD_HEADS + hh]); }
    }
}

constexpr int GD_N = GD_HEAD, GD_CN = GD_CH * NCHUNK;
static_assert(GD_HEAD % 32 == 0, "tile");
HD void ph_gd_c1(const Params& p, Exec e) {
    constexpr int C = CHUNK, N = GD_N, TC = C / 32;
    for (int it = e.gid; it < GD_CN * TC * TC; it += e.ngroups) {
        const int cn = it / (TC * TC), tm = (it / TC) % TC, tn = it % TC, ch = cn / NCHUNK, n = cn % NCHUNK; int b, hh, d; ml_chain(ch, b, hh, d);
        wave_mma32<N>(e.gl, [&](int m, int k0, float (&o)[8]) { const int R = b * TOK + seq_s(d, n * C + tm * 32 + m); ld8_f(p.gd_k + (size_t)R * GROUP_W + hh * N + k0, o); },
                            [&](int nn, int k0, float (&o)[8]) { const int R = b * TOK + seq_s(d, n * C + tn * 32 + nn); ld8_f(p.gd_k + (size_t)R * GROUP_W + hh * N + k0, o); },
                            [&](int m, int nn, float acc) { const int i = tm * 32 + m, j = tn * 32 + nn; const size_t o = (size_t)ch * TOK + n * C;
                                p.gd_A[((size_t)cn * C + i) * C + j] = j < i ? p.gd_beta[o + i] * acc * expf(p.gd_gc[o + i] - p.gd_gc[o + j]) : 0.f; });
    }
}
constexpr int GD_C3_SMEM = (5 * GD_N * CHUNK + 2 * CHUNK * CHUNK) * 2 + 2 * CHUNK * 4;
HD void ph_gd_c3_unit(const Params& p, int cn, int tid, int nthr, unsigned char* smem) {
    (void)tid; (void)nthr; OPAQUE_TID();
    constexpr int C = CHUNK, N = GD_N, TC = C / 32, TN = N / 32;
    const int ch = cn / NCHUNK, n = cn % NCHUNK; int b, hh, d; ml_chain(ch, b, hh, d);
    u16 *KbT = (u16*)smem, *VbT = KbT + N * C, *KdT = VbT + N * C, *uT = KdT + N * C, *wT = uT + N * C, *Tb = wT + N * C, *attn = Tb + C * C;
    float* gcs = (float*)(attn + C * C); float* bet = gcs + C;
    BLOCK_FOR(t, C) { const size_t o = (size_t)ch * TOK + n * C + t; gcs[t] = p.gd_gc[o]; bet[t] = p.gd_beta[o]; }
    BLOCK_SYNC();
    BLOCK_FOR(idx, C * N) { const int t = idx / N, dd = idx % N, R = b * TOK + seq_s(d, n * C + t); const size_t o = (size_t)R * GROUP_W + hh * N + dd;
        const float kv = p.gd_k[o], vv = p.gd_v[o];
        KbT[dd * C + t] = f2bf(kv * bet[t] * expf(gcs[t])); VbT[dd * C + t] = f2bf(vv * bet[t]); KdT[dd * C + t] = f2bf(kv * expf(gcs[C - 1] - gcs[t])); }
    BLOCK_FOR(idx, C * C) Tb[idx] = f2bf(p.gd_T[(size_t)cn * C * C + idx]);
    BLOCK_SYNC();
    WAVE_FOR(w, TC * TC + 2 * TN * TC) {
        if (w < TC * TC) { const int tm = w / TC, tn = w % TC;
            wave_mma32<N>(LANE, [&](int m, int k0, float (&o)[8]) { const int R = b * TOK + seq_s(d, n * C + tm * 32 + m); ld8_f(p.gd_q + (size_t)R * GROUP_W + hh * N + k0, o); },
                                [&](int nn, int k0, float (&o)[8]) { const int R = b * TOK + seq_s(d, n * C + tn * 32 + nn); ld8_f(p.gd_k + (size_t)R * GROUP_W + hh * N + k0, o); },
                                [&](int m, int nn, float acc) { const int i = tm * 32 + m, j = tn * 32 + nn; attn[i * C + j] = f2bf(j <= i ? acc * expf(gcs[i] - gcs[j]) : 0.f); }); }
        else { const int q = w - TC * TC, which = q / (TN * TC), tm = (q / TC) % TN, tn = q % TC;
            const u16* Am = which ? KbT : VbT; u16* Om = which ? wT : uT;
            wave_mma32<C>(LANE, [&](int m, int k0, float (&o)[8]) { ld8_bf(Am + (tm * 32 + m) * C + k0, o); },
                                [&](int nn, int k0, float (&o)[8]) { ld8_bf(Tb + (tn * 32 + nn) * C + k0, o); },
                                [&](int m, int nn, float acc) { Om[(tm * 32 + m) * C + tn * 32 + nn] = f2bf(acc); }); } }
    BLOCK_SYNC();
    WAVE_FOR(w, 2 * TC * TN + 2 * TN * TN) {
        if (w < 2 * TC * TN) { const int which = w / (TC * TN), tm = (w / TN) % TC, tn = w % TN;
            const u16* Bm = which ? uT : wT;
            wave_mma32<C>(LANE, [&](int m, int k0, float (&o)[8]) { ld8_bf(attn + (tm * 32 + m) * C + k0, o); },
                                [&](int nn, int k0, float (&o)[8]) { ld8_bf(Bm + (tn * 32 + nn) * C + k0, o); },
                                [&](int m, int nn, float acc) { const int i = tm * 32 + m, dd = tn * 32 + nn;
                                    if (which) p.gd_O0[((size_t)cn * C + i) * N + dd] = acc;
                                    else { const int R = b * TOK + seq_s(d, n * C + i); p.gd_Qh[((size_t)cn * C + i) * N + dd] = f2bf(p.gd_q[(size_t)R * GROUP_W + hh * N + dd] * expf(gcs[i]) - acc); } }); }
        else { const int q = w - 2 * TC * TN, which = q / (TN * TN), tm = (q / TN) % TN, tn = q % TN;
            const u16* Bm = which ? uT : wT;
            wave_mma32<C>(LANE, [&](int m, int k0, float (&o)[8]) { ld8_bf(KdT + (tm * 32 + m) * C + k0, o); },
                                [&](int nn, int k0, float (&o)[8]) { ld8_bf(Bm + (tn * 32 + nn) * C + k0, o); },
                                [&](int m, int nn, float acc) { const int d1 = tm * 32 + m, d2 = tn * 32 + nn;
                                    if (which) p.gd_Psi[((size_t)cn * N + d1) * N + d2] = acc;
                                    else p.gd_Phi[((size_t)cn * N + d1) * N + d2] = f2bf((d1 == d2 ? expf(gcs[C - 1]) : 0.f) - acc); }); } }
    BLOCK_SYNC();
}
constexpr int GD_EB = 32, GD_S2_UNITS = GD_CH * (GD_N / GD_EB);
constexpr int GD_S2_SMEM = (2 * GD_EB * GD_N + GD_N * GD_N + CHUNK * GD_N) * 2 + (GD_N * GD_EB + CHUNK * GD_EB) * 4;
HD void ph_gd_scan2_unit(const Params& p, int unit, int tid, int nthr, unsigned char* smem) {
    (void)tid; (void)nthr; OPAQUE_TID();
    constexpr int C = CHUNK, N = GD_N, EB = GD_EB;
    const int eb = unit % (N / EB), ch = unit / (N / EB), e0 = eb * EB; int b, hh, d; ml_chain(ch, b, hh, d);
    u16* ST = (u16*)smem; u16* Phi = ST + 2 * EB * N; u16* Qh = Phi + N * N; float* Psi = (float*)(Qh + C * N); float* O0 = Psi + N * EB;
    BLOCK_FOR(i, EB * N) ST[i] = 0;
    for (int n = 0; n < NCHUNK; ++n) {
        const int cn = ch * NCHUNK + n;
        BLOCK_FOR(i, N * N) Phi[i] = p.gd_Phi[(size_t)cn * N * N + i];
        BLOCK_FOR(i, C * N) Qh[i] = p.gd_Qh[(size_t)cn * C * N + i];
        BLOCK_FOR(i, N * EB) Psi[i] = p.gd_Psi[((size_t)cn * N + i / EB) * N + e0 + i % EB];
        BLOCK_FOR(i, C * EB) O0[i] = p.gd_O0[((size_t)cn * C + i / EB) * N + e0 + i % EB];
        BLOCK_SYNC();
        const u16* Sc = ST + (n & 1) * EB * N; u16* Sn = ST + ((n + 1) & 1) * EB * N;
        WAVE_FOR(w, N / 32 + C / 32) {
            if (w < N / 32) { const int tm = w;
                wave_mma32<N>(LANE, [&](int m, int k0, float (&o)[8]) { ld8_bf(Phi + (tm * 32 + m) * N + k0, o); },
                                    [&](int nn, int k0, float (&o)[8]) { ld8_bf(Sc + nn * N + k0, o); },
                                    [&](int m, int nn, float acc) { const int d1 = tm * 32 + m; Sn[nn * N + d1] = f2bf(acc + Psi[d1 * EB + nn]); }); }
            else { const int tm = w - N / 32;
                wave_mma32<N>(LANE, [&](int m, int k0, float (&o)[8]) { ld8_bf(Qh + (tm * 32 + m) * N + k0, o); },
                                    [&](int nn, int k0, float (&o)[8]) { ld8_bf(Sc + nn * N + k0, o); },
                                    [&](int m, int nn, float acc) { const int t = tm * 32 + m, R = b * TOK + seq_s(d, n * C + t);
                                        p.gd_o[((size_t)d * MROWS + R) * GROUP_W + hh * N + e0 + nn] = acc + O0[t * EB + nn]; }); } }
        BLOCK_SYNC();
    }
}
template <int G> HD void ph_gd_post(const Params& p, int layer, Exec e) {
    const float* ng = p.gd_norm_g + layer * GD_HEAD;
    for (int it = e.gid; it < MROWS * GD_HEADS; it += e.ngroups) {
        const int R = it / GD_HEADS, hh = it % GD_HEADS; const size_t o = (size_t)R * GROUP_W + hh * GD_HEAD, o2 = (size_t)MROWS * GROUP_W;
        float ss = 0.f;
        for (int j = e.gl; j < GD_HEAD; j += G) { const float v = p.gd_o[o + j] + p.gd_o[o2 + o + j]; ss += v * v; }
        ss = group_sum<G>(ss); const float rstd = 1.f / sqrtf(ss / GD_HEAD + NORM_EPS);
        for (int j = e.gl; j < GD_HEAD; j += G) { const float v = (p.gd_o[o + j] + p.gd_o[o2 + o + j]) * rstd * ng[j];
            const float g = p.P[(size_t)R * LDP + GD_OFF + 3 * GROUP_W + hh * GD_HEAD + j];
            p.mix[(size_t)R * D_MODEL + 2 * GROUP_W + hh * GD_HEAD + j] = f2bf(v * siluf_(g)); }
    }
}

template <int G> HD void ph_at_prep(const Params& p, int layer, Exec e) {
    constexpr int NHS = AT_QH + 2 * AT_KVH, HALF = AT_HEAD / 2, QTR = AT_HEAD / 4;
    for (int it = e.gid; it < MROWS * NHS; it += e.ngroups) {
        const int R = it / NHS, hs = it % NHS, b = row_b(R), s = row_s(R);
        const float* pr = p.P + (size_t)R * LDP + AT_OFF + hs * AT_HEAD;
        u16* dst; const float* g = nullptr;
        if (hs < AT_QH) { dst = p.at_q + (((size_t)b * AT_QH + hs) * TOK + s) * AT_HEAD; g = p.at_q_norm + layer * AT_HEAD; }
        else if (hs < AT_QH + AT_KVH) { dst = p.at_k + (((size_t)b * AT_KVH + hs - AT_QH) * TOK + s) * AT_HEAD; g = p.at_k_norm + layer * AT_HEAD; }
        else dst = p.at_v + (((size_t)b * AT_KVH + hs - AT_QH - AT_KVH) * TOK + s) * AT_HEAD;
        if (!g) { for (int j = e.gl; j < AT_HEAD; j += G) dst[j] = f2bf(pr[j]); continue; }
        float ss = 0.f;
        for (int j = e.gl; j < AT_HEAD; j += G) ss += pr[j] * pr[j];
        ss = group_sum<G>(ss); const float rstd = 1.f / sqrtf(ss / AT_HEAD + NORM_EPS);
        if (s < CTX) { for (int j = e.gl; j < AT_HEAD; j += G) dst[j] = f2bf(pr[j] * rstd * g[j]); continue; }
        const int t = s - CTX; const float posr = (float)(t / GRID_W), posc = (float)(t % GRID_W);
        for (int j = e.gl; j < AT_HEAD; j += G) {
            const int half = j / HALF, jj = j % HALF, fi = jj % QTR; const bool second = jj >= QTR;
            const float ang = (half ? posc : posr) * powf(10000.f, -(float)(2 * fi) / (float)HALF);
            const float cs = cosf(ang), sn = sinf(ang);
            const int jp = second ? j - QTR : j + QTR;
            const float own = pr[j] * rstd * g[j], oth = pr[jp] * rstd * g[jp];
            dst[j] = f2bf(second ? own * cs + oth * sn : own * cs - oth * sn);
        }
    }
}

#include <cstdio>
#include <cstddef>
static_assert(D_MODEL == 2048 && CTX == 256 && SEQ % 256 == 0 && AT_HEAD == 128, "GPU part is written for the full configuration");
static_assert(RW_C3_SMEM <= 131072 && TS_SMEM <= 131072 && RW_S2_SMEM <= 131072 && RW_C1_SMEM <= 131072 && GD_C3_SMEM <= 131072 && GD_S2_SMEM <= 131072 && ML_C1_SMEM <= 131072 && ML_C2_SMEM <= 131072, "LDS");
static_assert(CHUNK == RW_N && GD_N * CHUNK * 2 == CHUNK * CHUNK * 4, "buffer aliasing (Y0 on Ma, Qh on A)");

#define XB_TMO      128
#define XB_XCNT(j)  (256  + 64 * (j))
#define XB_XSUB(j)  (1280 + 64 * (j))
#define XB_XGEN(j)  (2304 + 64 * (j))
#define XB_TOP      3328
#define XB_TOPGEN   3392
#define XCD_BAR_WORDS 3456
#define XB_SPIN_CAP (1u << 24)
#define LAS __attribute__((address_space(3)))
__device__ __forceinline__ unsigned xb_ld(unsigned* p)              { return __hip_atomic_load(p, __ATOMIC_RELAXED, __HIP_MEMORY_SCOPE_AGENT); }
__device__ __forceinline__ unsigned xb_add(unsigned* p, unsigned v) { return __hip_atomic_fetch_add(p, v, __ATOMIC_RELAXED, __HIP_MEMORY_SCOPE_AGENT); }
__device__ __forceinline__ unsigned xb_xcc_id() { return (unsigned)__builtin_amdgcn_s_getreg((3 << 11) | 20) & 0xFu; }
#define XB_SPIN(cond, bar) do { unsigned _sp = 0; while (cond) { __builtin_amdgcn_s_sleep(1); \
    if ((++_sp & 255u) == 0u) { if (xb_ld(&(bar)[XB_TMO])) break; if (_sp > XB_SPIN_CAP) { atomicAdd(&(bar)[XB_TMO], 1u); break; } } } } while (0)
struct XcdBarrier { unsigned* bar; unsigned x; volatile LAS unsigned* st; };
__device__ __forceinline__ XcdBarrier xcd_barrier_post(unsigned* bar, volatile LAS unsigned* st) {
    XcdBarrier b; b.bar = bar; b.x = xb_xcc_id(); b.st = st;
    if (threadIdx.x == 0) (void)xb_add(&bar[XB_XCNT(b.x)], 1u);
    return b;
}
__device__ __forceinline__ void xcd_barrier_complete(unsigned* bar, unsigned x, unsigned& nloc, unsigned& nx) {
    const unsigned G = gridDim.x * gridDim.y * gridDim.z;
    unsigned sum, cnt, mine, sp = 0u;
    for (;;) {
        sum = 0u; cnt = 0u; mine = 0u;
#pragma unroll
        for (unsigned j = 0; j < 16; ++j) { const unsigned c = xb_ld(&bar[XB_XCNT(j)]); sum += c; cnt += (c > 0u) ? 1u : 0u; mine = (j == x) ? c : mine; }
        if (sum == G) break;
        __builtin_amdgcn_s_sleep(1);
        if ((++sp & 255u) == 0u) { if (xb_ld(&bar[XB_TMO])) break; if (sp > XB_SPIN_CAP) { atomicAdd(&bar[XB_TMO], 1u); break; } }
    }
    nloc = mine > 0u ? mine : 1u; nx = cnt > 0u ? cnt : 1u;
}
__device__ __forceinline__ void xcd_barrier(const XcdBarrier& b) {
    asm volatile("s_waitcnt vmcnt(0)" ::: "memory");
    __syncthreads();
    if (threadIdx.x == 0) {
        unsigned* bar = b.bar;
        __builtin_amdgcn_s_waitcnt(0);
        unsigned nloc = b.st[0], nx = b.st[1];
        if (nloc == 0u) { xcd_barrier_complete(bar, b.x, nloc, nx); b.st[0] = nloc; b.st[1] = nx; }
        const unsigned old = xb_add(&bar[XB_XSUB(b.x)], 1u);
        const unsigned gen = old / nloc;
        if (old + 1u == (gen + 1u) * nloc) {
            __builtin_amdgcn_fence(__ATOMIC_RELEASE, "agent");
            asm volatile("s_waitcnt vmcnt(0)" ::: "memory");
            const unsigned og = xb_add(&bar[XB_TOP], 1u);
            const unsigned tg = og / nx;
            if (og + 1u == (tg + 1u) * nx) xb_add(&bar[XB_TOPGEN], 1u);
            else XB_SPIN(xb_ld(&bar[XB_TOPGEN]) == tg, bar);
            __builtin_amdgcn_fence(__ATOMIC_ACQUIRE, "agent");
            xb_add(&bar[XB_XGEN(b.x)], 1u);
            asm volatile("s_waitcnt vmcnt(0)" ::: "memory");
        } else {
            XB_SPIN(xb_ld(&bar[XB_XGEN(b.x)]) == gen, bar);
            __builtin_amdgcn_fence(__ATOMIC_ACQUIRE, "agent");
            asm volatile("s_waitcnt vmcnt(0)" ::: "memory");
        }
    }
    __syncthreads();
}

namespace pg8 {
#define PG8_LAS __attribute__((address_space(3)))
typedef unsigned short bf16_t;
typedef short bf16x8 __attribute__((ext_vector_type(8)));
typedef float f32x4 __attribute__((ext_vector_type(4)));
typedef unsigned u32x4 __attribute__((ext_vector_type(4)));
constexpr int BM = 256, BK = 64, HALF = 128, HTB = HALF * BK * 2  , STAGE_BYTES = 8 * HTB, NXCD = 8, WGM = 8;

__host__ __device__ __forceinline__ int lds_byte(int r, int c) { const int st = (r >> 4) * 2 + (c >> 5), rr = r & 15, cc = c & 31, ob = rr * 64 + cc * 2; return st * 1024 + (ob ^ (((ob >> 9) & 1) << 5)); }
__host__ __device__ __forceinline__ void stage_rc(int b, int& R, int& C) { const int st = b / 1024, sb = b % 1024, swz = sb ^ (((sb >> 9) & 1) << 5); R = (st >> 1) * 16 + swz / 64; C = (st & 1) * 32 + (swz % 64) / 2; }
__host__ __device__ __forceinline__ int perm32(int rho) { const int n = rho >> 4, i = rho & 15; return 8 * (i >> 2) + 4 * n + (i & 3); }

struct Unit { int pm, pn; };
struct Gemm { const bf16_t* A; const bf16_t* Bt; int M, N, K; };

struct StaticOrder {
    int nM, nN, nwg, G, c;
    __host__ __device__ void init(int M, int N, int G_, int c_) { nM = M / BM; nN = N / BM; nwg = nM * nN; G = G_; c = c_; }
    __host__ __device__ bool next(int i, Unit& u) const {
        const long L = (long)i * G + c; if (L >= nwg) return false;
        int wgid = (int)L; { const int q = nwg / NXCD, r = nwg % NXCD, xcd = wgid % NXCD, off = wgid / NXCD; wgid = (xcd < r ? xcd * (q + 1) : r * (q + 1) + (xcd - r) * q) + off; }
        const int nig = WGM * nN, gid = wgid / nig, fm = gid * WGM, gsz = (nM - fm) < WGM ? (nM - fm) : WGM;
        u.pm = fm + ((wgid % nig) % gsz); u.pn = (wgid % nig) / gsz; return true;
    }
    __device__ __forceinline__ void a_ready(const Unit&) const {}
    __device__ __forceinline__ void done(const Unit&) const {}
};
__device__ __forceinline__ unsigned cvt_pk_bf16(float lo, float hi) { unsigned r; asm volatile("v_cvt_pk_bf16_f32 %0, %1, %2" : "=v"(r) : "v"(lo), "v"(hi)); return r; }
typedef unsigned u32x2v __attribute__((ext_vector_type(2)));

struct TileOrder {
    int nI, nJ, nwg, G, c, latent_only;
    __device__ void init(int nI_, int nJ_, int G_, int c_, int lat) { nI = nI_; nJ = nJ_; nwg = nI * nJ; G = G_; c = c_; latent_only = lat; }
    __device__ bool next(int i, Unit& u) const { const long L = (long)i * G + c; if (L >= nwg) return false;
        const int ii = (int)(L % nI), j = (int)(L / nI); u.pm = latent_only ? (ii / (SEQ / 256)) * (TOK / 256) + 1 + ii % (SEQ / 256) : ii; u.pn = j; return true; }
    __device__ __forceinline__ void a_ready(const Unit&) const {}
    __device__ __forceinline__ void done(const Unit&) const {}
};
struct GroupedOrder {
    int nI, nJ, tilesA, nwg, G, c;
    __device__ void init(int nI_, int nJ_, int tilesA_, int G_, int c_) { nI = nI_; nJ = nJ_; tilesA = tilesA_; nwg = NE * nI * nJ; G = G_; c = c_; }
    __device__ bool next(int i, Unit& u) const { const long L = (long)i * G + c; if (L >= nwg) return false;
        const int e = (int)(L / (nI * nJ)), r = (int)(L % (nI * nJ)), j = r / nI, ii = r % nI; u.pm = e * tilesA + ii; u.pn = e * nJ + j; return true; }
    __device__ __forceinline__ void a_ready(const Unit&) const {}
    __device__ __forceinline__ void done(const Unit&) const {}
};

struct EpiF32 {
    static constexpr bool PERM = false, AFTER_DRAIN = false;
    float* C; int ldc;
    __device__ __forceinline__ void operator()(const f32x4 (&acc)[2][2][4][2], const Unit& u, int wr, int wc, int fr, int fq) const {
        const int row0 = u.pm * BM + wr * 64 + fr, col0 = u.pn * BM + wc * 32 + 4 * fq;
#pragma unroll
        for (int ai = 0; ai < 2; ++ai)
#pragma unroll
            for (int m = 0; m < 4; ++m) { float* rowp = C + (size_t)(row0 + ai * HALF + m * 16) * ldc + col0;
#pragma unroll
                for (int bj = 0; bj < 2; ++bj)
#pragma unroll
                    for (int n = 0; n < 2; ++n) *(f32x4*)(rowp + bj * HALF + n * 16) = acc[ai][bj][m][n]; }
    }
};
struct EpiResid {
    static constexpr bool PERM = false, AFTER_DRAIN = false;
    float* X; const float* modl;
    __device__ __forceinline__ void operator()(const f32x4 (&acc)[2][2][4][2], const Unit& u, int wr, int wc, int fr, int fq) const {
        const int row0 = u.pm * BM + wr * 64 + fr, col0 = u.pn * BM + wc * 32 + 4 * fq;
        const int tb = TOK / 256, sel = (u.pm % tb == 0) ? 2 : u.pm / tb;
        const float* gate = modl + ((size_t)sel * 6 + 2) * D_MODEL + col0;
        f32x4 gv[2][2];
#pragma unroll
        for (int bj = 0; bj < 2; ++bj)
#pragma unroll
            for (int n = 0; n < 2; ++n) gv[bj][n] = *(const f32x4*)(gate + bj * HALF + n * 16);
#pragma unroll
        for (int ai = 0; ai < 2; ++ai)
#pragma unroll
            for (int m = 0; m < 4; ++m) { float* rowp = X + (size_t)(row0 + ai * HALF + m * 16) * D_MODEL + col0;
#pragma unroll
                for (int bj = 0; bj < 2; ++bj)
#pragma unroll
                    for (int n = 0; n < 2; ++n) { f32x4* q = (f32x4*)(rowp + bj * HALF + n * 16); *q = *q + gv[bj][n] * acc[ai][bj][m][n]; } }
    }
};
struct EpiSwiGLU {
    static constexpr bool PERM = false, AFTER_DRAIN = false;
    bf16_t* H; int nJ;
    __device__ __forceinline__ void operator()(const f32x4 (&acc)[2][2][4][2], const Unit& u, int wr, int wc, int fr, int fq) const {
        const int row0 = u.pm * BM + wr * 64 + fr, col0 = (u.pn % nJ) * HALF + wc * 32 + 4 * fq;
#pragma unroll
        for (int ai = 0; ai < 2; ++ai)
#pragma unroll
            for (int m = 0; m < 4; ++m) { bf16_t* rowp = H + (size_t)(row0 + ai * HALF + m * 16) * D_MODEL + col0;
#pragma unroll
                for (int n = 0; n < 2; ++n) { const f32x4 a = acc[ai][0][m][n], b = acc[ai][1][m][n]; float o[4];
#pragma unroll
                    for (int q = 0; q < 4; ++q) o[q] = a[q] / (1.f + __expf(-a[q])) * b[q];
                    u32x2v w; w.x = cvt_pk_bf16(o[0], o[1]); w.y = cvt_pk_bf16(o[2], o[3]); *(u32x2v*)(rowp + n * 16) = w; } }
    }
};
struct EpiGate {
    static constexpr bool PERM = false, AFTER_DRAIN = false;
    float* Y; const float* gate; int nJ;
    __device__ __forceinline__ void operator()(const f32x4 (&acc)[2][2][4][2], const Unit& u, int wr, int wc, int fr, int fq) const {
        const int row0 = u.pm * BM + wr * 64 + fr, col0 = (u.pn % nJ) * BM + wc * 32 + 4 * fq;
#pragma unroll
        for (int ai = 0; ai < 2; ++ai)
#pragma unroll
            for (int m = 0; m < 4; ++m) { const int r = row0 + ai * HALF + m * 16; const float gt = gate[r]; float* rowp = Y + (size_t)r * D_MODEL + col0;
#pragma unroll
                for (int bj = 0; bj < 2; ++bj)
#pragma unroll
                    for (int n = 0; n < 2; ++n) *(f32x4*)(rowp + bj * HALF + n * 16) = acc[ai][bj][m][n] * gt; }
    }
};
template <class Epi, class Sched>
__device__ __forceinline__ void gemm_phase(PG8_LAS unsigned char* lds, const Gemm g, const Sched& S, const Epi& E) {
    const int tid = threadIdx.x, wid = __builtin_amdgcn_readfirstlane(tid >> 6), lane = tid & 63, wr = wid >> 2, wc = wid & 3, fr = lane & 15, fq = lane >> 4;
    const int K = g.K, nt = K / BK;
    unsigned voffA[2], voffB[2];
#pragma unroll
    for (int i = 0; i < 2; ++i) { int R, C; stage_rc(tid * 16 + i * 8192, R, C); const int Rb = Epi::PERM ? ((R & ~31) + perm32(R & 31)) : R;
        voffA[i] = (unsigned)(R * K + C) * 2u; voffB[i] = (unsigned)(Rb * K + C) * 2u; }
    const size_t kstep = (size_t)(BK * 2);
    const size_t hstep = (size_t)HALF * K * 2;
    const size_t tstep = 2 * hstep;
    const unsigned ldsw = (unsigned)wid * 1024u;
    const int aoff = lds_byte(wr * 64 + fr, fq * 8), boff = lds_byte(wc * 32 + fr, fq * 8);
#define PG8_SA(b, h) (((b) * 2 + (h)) * HTB)
#define PG8_SB(b, h) ((4 + (b) * 2 + (h)) * HTB)
#define PG8_STAGE(bufoff, gbase, voff) do { _Pragma("unroll") for (int _i = 0; _i < 2; ++_i) \
        __builtin_amdgcn_global_load_lds((const unsigned*)((const char*)(gbase) + (voff)[_i]), (PG8_LAS unsigned*)(lds + (bufoff) + ldsw + _i * 8192), 16, 0, 0); } while (0)
#define PG8_LDA(dst, b, h) do { _Pragma("unroll") for (int m = 0; m < 4; ++m) _Pragma("unroll") for (int k = 0; k < 2; ++k) dst[m][k] = *(const PG8_LAS bf16x8*)(lds + PG8_SA(b, h) + aoff + m * 2048 + k * 1024); } while (0)
#define PG8_LDB(dst, b, h) do { _Pragma("unroll") for (int n = 0; n < 2; ++n) _Pragma("unroll") for (int k = 0; k < 2; ++k) dst[n][k] = *(const PG8_LAS bf16x8*)(lds + PG8_SB(b, h) + boff + n * 2048 + k * 1024); } while (0)
#define PG8_MMA(ai, bj, At, Bt) do { __builtin_amdgcn_s_setprio(1); _Pragma("unroll") for (int m = 0; m < 4; ++m) _Pragma("unroll") for (int n = 0; n < 2; ++n) _Pragma("unroll") for (int k = 0; k < 2; ++k) \
        acc[ai][bj][m][n] = __builtin_amdgcn_mfma_f32_16x16x32_bf16(Bt[n][k], At[m][k], acc[ai][bj][m][n], 0, 0, 0); __builtin_amdgcn_s_setprio(0); } while (0)
#define PG8_WAIT_V(n) asm volatile("s_waitcnt vmcnt(" #n ")" ::: "memory")
#define PG8_WAIT_L(n) asm volatile("s_waitcnt lgkmcnt(" #n ")" ::: "memory")
#define PG8_BAR __builtin_amdgcn_s_barrier()
#define PG8_SCHED __builtin_amdgcn_sched_barrier(0)
    Unit cur, nxt; int ui = 0;
    if (!S.next(0, cur)) return;
    f32x4 acc[2][2][4][2];
#pragma unroll
    for (int a = 0; a < 2; ++a)
#pragma unroll
        for (int b = 0; b < 2; ++b)
#pragma unroll
            for (int m = 0; m < 4; ++m)
#pragma unroll
                for (int n = 0; n < 2; ++n) acc[a][b][m][n] = (f32x4){0.f, 0.f, 0.f, 0.f};
    bf16x8 At[4][2], B0[2][2], B1[2][2];
    const char* cA = (const char*)g.A + (size_t)cur.pm * tstep; const char* cB = (const char*)g.Bt + (size_t)cur.pn * tstep;
    S.a_ready(cur);
    PG8_STAGE(PG8_SB(0, 0), cB, voffB); PG8_STAGE(PG8_SA(0, 0), cA, voffA); PG8_STAGE(PG8_SB(0, 1), cB + hstep, voffB); PG8_STAGE(PG8_SA(0, 1), cA + hstep, voffA);
    if (wr == 1) PG8_BAR;
    PG8_WAIT_V(4); PG8_BAR;
    PG8_STAGE(PG8_SB(1, 0), cB + kstep, voffB); PG8_STAGE(PG8_SA(1, 0), cA + kstep, voffA); PG8_STAGE(PG8_SB(1, 1), cB + hstep + kstep, voffB);
    PG8_WAIT_V(6); PG8_BAR;
    for (;;) {
        const bool has_next = S.next(ui + 1, nxt);
        const char* nA = has_next ? (const char*)g.A + (size_t)nxt.pm * tstep : cA; const char* nB = has_next ? (const char*)g.Bt + (size_t)nxt.pn * tstep : cB;
        for (int t = 0; t < nt; t += 2) {
            const bool last = (t == nt - 2);
            const char* a1 = cA + (size_t)(t + 1) * kstep;
            const char* a2 = last ? nA : cA + (size_t)(t + 2) * kstep; const char* b2 = last ? nB : cB + (size_t)(t + 2) * kstep;
            const char* a3 = a2 + kstep; const char* b3 = b2 + kstep;
            if (last && has_next) S.a_ready(nxt);
            PG8_LDB(B0, 0, 0); PG8_SCHED; PG8_LDA(At, 0, 0); PG8_STAGE(PG8_SA(1, 1), a1 + hstep, voffA);
            PG8_WAIT_L(8); PG8_BAR; PG8_WAIT_L(0); PG8_MMA(0, 0, At, B0); PG8_BAR; PG8_SCHED;
            PG8_LDB(B1, 0, 1); PG8_STAGE(PG8_SB(0, 0), b2, voffB);
            PG8_BAR; PG8_WAIT_L(0); PG8_MMA(0, 1, At, B1); PG8_BAR;
            PG8_LDA(At, 0, 1); PG8_STAGE(PG8_SA(0, 0), a2, voffA);
            PG8_BAR; PG8_WAIT_L(0); PG8_MMA(1, 0, At, B0); PG8_BAR; PG8_SCHED;
            PG8_STAGE(PG8_SB(0, 1), b2 + hstep, voffB);
            PG8_WAIT_V(6); PG8_BAR; PG8_MMA(1, 1, At, B1); PG8_BAR;
            PG8_LDB(B0, 1, 0); PG8_SCHED; PG8_LDA(At, 1, 0); PG8_STAGE(PG8_SA(0, 1), a2 + hstep, voffA);
            PG8_WAIT_L(8); PG8_BAR; PG8_WAIT_L(0); PG8_MMA(0, 0, At, B0); PG8_BAR; PG8_SCHED;
            PG8_LDB(B1, 1, 1); PG8_STAGE(PG8_SB(1, 0), b3, voffB);
            PG8_BAR; PG8_WAIT_L(0); PG8_MMA(0, 1, At, B1); PG8_BAR;
            PG8_LDA(At, 1, 1); PG8_STAGE(PG8_SA(1, 0), a3, voffA);
            PG8_BAR; PG8_WAIT_L(0); PG8_MMA(1, 0, At, B0); PG8_BAR; PG8_SCHED;
            PG8_STAGE(PG8_SB(1, 1), b3 + hstep, voffB);
            PG8_WAIT_V(6); PG8_BAR; PG8_MMA(1, 1, At, B1); PG8_BAR;
        }
        if constexpr (!Epi::AFTER_DRAIN) { E(acc, cur, wr, wc, fr, fq); S.done(cur); }
        if (!has_next) break;
#pragma unroll
        for (int a = 0; a < 2; ++a)
#pragma unroll
            for (int b = 0; b < 2; ++b)
#pragma unroll
                for (int m = 0; m < 4; ++m)
#pragma unroll
                    for (int n = 0; n < 2; ++n) acc[a][b][m][n] = (f32x4){0.f, 0.f, 0.f, 0.f};
        cur = nxt; cA = nA; cB = nB; ++ui;
    }
    PG8_WAIT_V(0);
    if (wr == 0) PG8_BAR;
    PG8_BAR;
    if constexpr (Epi::AFTER_DRAIN) { E.fused(acc, cur, wr, wc, fr, fq, lds, wid, lane); S.done(cur); }
#undef PG8_SA
#undef PG8_SB
#undef PG8_STAGE
#undef PG8_LDA
#undef PG8_LDB
#undef PG8_MMA
#undef PG8_WAIT_V
#undef PG8_WAIT_L
#undef PG8_BAR
#undef PG8_SCHED
}
}


namespace att {
using bf16 = unsigned short;
constexpr int   D = 128, NW = 8, QBLK = 32, KVBLK = 64;
constexpr float SCALE = 0.088388347648318440f;
constexpr float THR = 8.f;
constexpr int SDEPTH = 2;
constexpr int LDQ = 128, LDK = 128, LDO = D_MODEL;
constexpr size_t SHM_V = KVBLK * D * 2, SHM_K = KVBLK * D * 2, SHM_ATTN = 2 * SHM_V + 2 * SHM_K + NW * 64 * 4;
using bf16x8 = __attribute__((ext_vector_type(8))) short;
using s16x4  = __attribute__((ext_vector_type(4))) short;
using f32x16 = __attribute__((ext_vector_type(16))) float;
using f32x8  = __attribute__((ext_vector_type(8))) float;
using u32x4  = __attribute__((ext_vector_type(4))) unsigned;
#define KSWZ(row, colB) ((row) * 256 + ((colB) ^ (((row) & 7) << 4)))
#define SBAR() __builtin_amdgcn_sched_barrier(0)
__device__ __forceinline__ int crow(int r, int hi) { return (r & 3) + 8 * (r >> 2) + 4 * hi; }
__device__ __forceinline__ unsigned cvtpk(float lo, float hi) {
  unsigned r; asm volatile("v_cvt_pk_bf16_f32 %0, %1, %2" : "=v"(r) : "v"(lo), "v"(hi)); return r;
}
template <typename TIn> struct Stage;
template <> struct Stage<bf16>  { using T = bf16x8;
  __device__ static __forceinline__ T ld8(const bf16* p) { return *reinterpret_cast<const bf16x8*>(p); }
  __device__ static __forceinline__ bf16x8 tobf(T x) { return x; } };
template <> struct Stage<float> { using T = f32x8;
  __device__ static __forceinline__ T ld8(const float* p) { return *reinterpret_cast<const f32x8*>(p); }
  __device__ static __forceinline__ bf16x8 tobf(T x) {
    u32x4 w = {cvtpk(x[0], x[1]), cvtpk(x[2], x[3]), cvtpk(x[4], x[5]), cvtpk(x[6], x[7])}; return *reinterpret_cast<bf16x8*>(&w); } };

__device__ __forceinline__ void partialSM(f32x16& p0, f32x16& p1, float& m_reg, float& mn, float& alpha) {
  constexpr float C = SCALE * 1.4426950408889634f;
  float pmax = p0[0]; for (int r = 1; r < 16; ++r) pmax = fmaxf(pmax, p0[r]); for (int r = 0; r < 16; ++r) pmax = fmaxf(pmax, p1[r]);
  { auto rr = __builtin_amdgcn_permlane32_swap(__float_as_uint(pmax), __float_as_uint(pmax), false, false);
    pmax = fmaxf(__uint_as_float(rr[0]), __uint_as_float(rr[1])); }
  if (__builtin_expect(__all(pmax - m_reg <= THR / SCALE), 1)) { mn = m_reg; alpha = 1.f; }
  else { mn = fmaxf(m_reg, pmax); alpha = __builtin_amdgcn_exp2f((m_reg - mn) * C); m_reg = mn; }
  float mnC = -mn * C;
  for (int r = 0; r < 16; ++r) p0[r] = fmaf(p0[r], C, mnC); for (int r = 0; r < 16; ++r) p1[r] = fmaf(p1[r], C, mnC);
  for (int r = 0; r < 16; ++r) p0[r] = __builtin_amdgcn_exp2f(p0[r]);
}
__device__ __forceinline__ void finishSM(f32x16& p0, f32x16& p1, float alpha, float& l_reg, bf16x8& pa0, bf16x8& pa1, bf16x8& pa2, bf16x8& pa3) {
  for (int r = 0; r < 16; ++r) p1[r] = __builtin_amdgcn_exp2f(p1[r]);
  float ps = 0; for (int r = 0; r < 16; ++r) ps += p0[r]; for (int r = 0; r < 16; ++r) ps += p1[r];
  { auto rr = __builtin_amdgcn_permlane32_swap(__float_as_uint(ps), __float_as_uint(ps), false, false);
    ps = __uint_as_float(rr[0]) + __uint_as_float(rr[1]); }
  l_reg = l_reg * alpha + ps;
#define PK4(P, BASE, OUT) do { unsigned a0 = cvtpk(P[BASE + 0], P[BASE + 1]), a1 = cvtpk(P[BASE + 2], P[BASE + 3]);   \
    unsigned b0 = cvtpk(P[BASE + 4], P[BASE + 5]), b1 = cvtpk(P[BASE + 6], P[BASE + 7]);                              \
    auto r0 = __builtin_amdgcn_permlane32_swap(a0, b0, false, false); auto r1 = __builtin_amdgcn_permlane32_swap(a1, b1, false, false); \
    u32x4 w = {r0[0], r1[0], r0[1], r1[1]}; OUT = *reinterpret_cast<bf16x8*>(&w); } while (0)
  PK4(p0, 0, pa0); PK4(p0, 8, pa1); PK4(p1, 0, pa2); PK4(p1, 8, pa3);
#undef PK4
}
__device__ __forceinline__ void qkt(f32x16& p0, f32x16& p1, const bf16* Ks, const bf16x8* qr, int r32, int hi) {
  p0 = f32x16{}; p1 = f32x16{};
  for (int d0 = 0; d0 < 8; ++d0) { int cb = (d0 * 16 + hi * 8) * 2;
    bf16x8 b0 = *reinterpret_cast<const bf16x8*>((const char*)Ks + KSWZ(r32, cb));
    bf16x8 b1 = *reinterpret_cast<const bf16x8*>((const char*)Ks + KSWZ(32 + r32, cb));
    p0 = __builtin_amdgcn_mfma_f32_32x32x16_bf16(b0, qr[d0], p0, 0, 0, 0);
    p1 = __builtin_amdgcn_mfma_f32_32x32x16_bf16(b1, qr[d0], p1, 0, 0, 0); }
}
__device__ __forceinline__ int v_st(int k, int c) { const int kk = (k & ~0xC) | ((k & 4) << 1) | ((k & 8) >> 1); return ((kk >> 3) * 4 + (c >> 5)) * 512 + ((kk & 7) * 32 + (c & 31)) * 2; }
__device__ __forceinline__ int v_rd_base(int lane) { return ((lane & 3) << 3) | (((lane >> 2) & 3) << 6) | (((lane >> 4) & 1) << 5) | (((lane >> 5) & 1) << 8); }
constexpr int v_rd_off(int d0, int ks, int half) { return d0 * 512 + ks * 4096 + half * 2048; }
template <int OFF> __device__ __forceinline__ s16x4 tr_read(int vb) {
  s16x4 r; asm volatile("ds_read_b64_tr_b16 %0, %1 offset:%2" : "=&v"(r) : "v"(vb), "i"(OFF) : "memory"); return r;
}
template <int D0> __device__ __forceinline__ void pv_one(f32x16& od, int vb, bf16x8 pa0, bf16x8 pa1, bf16x8 pa2, bf16x8 pa3) {
  const s16x4 l0 = tr_read<v_rd_off(D0, 0, 0)>(vb), h0 = tr_read<v_rd_off(D0, 0, 1)>(vb), l1 = tr_read<v_rd_off(D0, 1, 0)>(vb), h1 = tr_read<v_rd_off(D0, 1, 1)>(vb);
  const s16x4 l2 = tr_read<v_rd_off(D0, 2, 0)>(vb), h2 = tr_read<v_rd_off(D0, 2, 1)>(vb), l3 = tr_read<v_rd_off(D0, 3, 0)>(vb), h3 = tr_read<v_rd_off(D0, 3, 1)>(vb);
  asm volatile("s_waitcnt lgkmcnt(0)" ::: "memory"); SBAR();
#define PK(L, H) (bf16x8){L[0], L[1], L[2], L[3], H[0], H[1], H[2], H[3]}
  od = __builtin_amdgcn_mfma_f32_32x32x16_bf16(pa0, PK(l0, h0), od, 0, 0, 0);
  od = __builtin_amdgcn_mfma_f32_32x32x16_bf16(pa1, PK(l1, h1), od, 0, 0, 0);
  od = __builtin_amdgcn_mfma_f32_32x32x16_bf16(pa2, PK(l2, h2), od, 0, 0, 0);
  od = __builtin_amdgcn_mfma_f32_32x32x16_bf16(pa3, PK(l3, h3), od, 0, 0, 0);
#undef PK
}
__device__ __forceinline__ void pv_d0(f32x16* o, int vb, bf16x8 pa0, bf16x8 pa1, bf16x8 pa2, bf16x8 pa3) {
  pv_one<0>(o[0], vb, pa0, pa1, pa2, pa3); pv_one<1>(o[1], vb, pa0, pa1, pa2, pa3); pv_one<2>(o[2], vb, pa0, pa1, pa2, pa3); pv_one<3>(o[3], vb, pa0, pa1, pa2, pa3);
}

__device__ __forceinline__ void attn_dense_body(const bf16* __restrict__ Qb, const bf16* __restrict__ Kh, const bf16* __restrict__ Vh,
                                                unsigned short* __restrict__ Ob, int seq, char* lds) {
  using St = Stage<bf16>; using SQ = Stage<bf16>; using TQ = bf16;
  const int tid = threadIdx.x, wid = tid >> 6, lane = tid & 63, r32 = lane & 31, hi = lane >> 5;
  bf16* V_lds = (bf16*)lds; bf16* K_lds = (bf16*)(lds + 2 * SHM_V);
  float* ws = (float*)(lds + 2 * SHM_V + 2 * SHM_K) + wid * 64; float* li_l = ws; float* al_l = ws + 32;
  float m_reg = -1e30f, l_reg = 0; f32x16 o[4] = {}; bf16x8 qr[8];
  const TQ* Qw = Qb + (long)(wid * QBLK + r32) * LDQ + hi * 8;
#pragma unroll
  for (int d0 = 0; d0 < 8; ++d0) qr[d0] = SQ::tobf(SQ::ld8(Qw + d0 * 16));
  const int sr = tid >> 4, sc = (tid & 15) * 8, vst0 = v_st(sr, sc), vst1 = v_st(32 + sr, sc);
  const int vb0 = (int)(uintptr_t)V_lds + v_rd_base(lane);
  struct { typename St::T vs0, vs1, ks0, ks1; } sr_[SDEPTH];
#define SLOAD(i, k0) do { sr_[i].vs0 = St::ld8(&Vh[(long)((k0) + sr) * LDK + sc]); sr_[i].vs1 = St::ld8(&Vh[(long)((k0) + 32 + sr) * LDK + sc]); \
    sr_[i].ks0 = St::ld8(&Kh[(long)((k0) + sr) * LDK + sc]); sr_[i].ks1 = St::ld8(&Kh[(long)((k0) + 32 + sr) * LDK + sc]); } while (0)
#define SWRITE(b, i) do { *(bf16x8*)((char*)V_lds + (b) * SHM_V + vst0) = St::tobf(sr_[i].vs0);          \
    *(bf16x8*)((char*)V_lds + (b) * SHM_V + vst1) = St::tobf(sr_[i].vs1); int kc = sc * 2;               \
    *(bf16x8*)((char*)K_lds + (b) * SHM_K + KSWZ(sr, kc)) = St::tobf(sr_[i].ks0);                       \
    *(bf16x8*)((char*)K_lds + (b) * SHM_K + KSWZ(32 + sr, kc)) = St::tobf(sr_[i].ks1); } while (0)
#define SWAIT() do { if constexpr (SDEPTH == 2) asm volatile("s_waitcnt vmcnt(4)" ::: "memory"); else asm volatile("s_waitcnt vmcnt(0)" ::: "memory"); } while (0)
#define RESC(a) do { if (__any((a) < 1.f)) { if (hi == 0) al_l[r32] = (a); asm volatile("s_waitcnt lgkmcnt(0)" ::: "memory"); \
    for (int d = 0; d < 4; ++d) for (int r = 0; r < 16; ++r) o[d][r] *= al_l[crow(r, hi)]; } } while (0)
  f32x16 pA0, pA1, pB0, pB1; float mnA, mnB, alA, alB; bf16x8 pa0, pa1, pa2, pa3; const int NT = seq / KVBLK;
  constexpr int SE = 0, SO = SDEPTH - 1;
  SLOAD(SE, 0); asm volatile("s_waitcnt vmcnt(0)" ::: "memory"); SWRITE(0, SE); __syncthreads();
  qkt(pA0, pA1, K_lds, qr, r32, hi); partialSM(pA0, pA1, m_reg, mnA, alA);
  SLOAD(SO, KVBLK); if constexpr (SDEPTH == 2) { if (2 < NT) SLOAD(SE, 2 * KVBLK); }
  SWAIT(); SWRITE(1, SO); __syncthreads();
  for (int j = 1; j + 1 < NT; j += 2) {
    SBAR(); qkt(pB0, pB1, (bf16*)((char*)K_lds + SHM_K), qr, r32, hi);
    finishSM(pA0, pA1, alA, l_reg, pa0, pa1, pa2, pa3); SBAR();
    SLOAD(SO, (j + SDEPTH) * KVBLK); SBAR();
    pv_d0(o, vb0, pa0, pa1, pa2, pa3); partialSM(pB0, pB1, m_reg, mnB, alB);
    __syncthreads(); SWAIT(); SWRITE(0, SE);
    RESC(alB); __syncthreads();
    SBAR(); qkt(pA0, pA1, K_lds, qr, r32, hi);
    finishSM(pB0, pB1, alB, l_reg, pa0, pa1, pa2, pa3); SBAR();
    if (SDEPTH == 1 || j + 3 < NT) SLOAD(SE, (j + 1 + SDEPTH) * KVBLK); SBAR();
    pv_d0(o, vb0 + (int)SHM_V, pa0, pa1, pa2, pa3); partialSM(pA0, pA1, m_reg, mnA, alA);
    __syncthreads(); SWAIT(); SWRITE(1, SO);
    RESC(alA); __syncthreads();
  }
  SBAR(); qkt(pB0, pB1, (bf16*)((char*)K_lds + SHM_K), qr, r32, hi);
  finishSM(pA0, pA1, alA, l_reg, pa0, pa1, pa2, pa3); SBAR();
  pv_d0(o, vb0, pa0, pa1, pa2, pa3); partialSM(pB0, pB1, m_reg, mnB, alB);
  __syncthreads(); RESC(alB);
  finishSM(pB0, pB1, alB, l_reg, pa0, pa1, pa2, pa3); SBAR();
  pv_d0(o, vb0 + (int)SHM_V, pa0, pa1, pa2, pa3);
  if (hi == 0) li_l[r32] = l_reg; asm volatile("s_waitcnt lgkmcnt(0)" ::: "memory");
  float rli[16];
#pragma unroll
  for (int r = 0; r < 16; ++r) rli[r] = __builtin_amdgcn_rcpf(li_l[crow(r, hi)]);
  unsigned short* Ow = Ob + (long)(wid * QBLK) * LDO;
#pragma unroll
  for (int r = 0; r < 16; ++r) { int orow = crow(r, hi);
    for (int d0 = 0; d0 < 4; ++d0) Ow[(long)orow * LDO + d0 * 32 + r32] = f2bf(o[d0][r] * rli[r]); }
#undef SLOAD
#undef SWRITE
#undef SWAIT
#undef RESC
}
}

__device__ __forceinline__ void cvt_tile(const float* __restrict__ W, int ldw, int nvalid, int k0, int n0, u16* __restrict__ Wt, int rowbase, int rmode, float* lds) {
    const int tid = threadIdx.x;
    for (int idx = tid; idx < 4096; idx += 512) { const int kk = idx >> 6, nn = idx & 63; const int n = n0 + nn;
        lds[kk * 65 + nn] = n < nvalid ? W[(size_t)(k0 + kk) * ldw + n] : 0.f; }
    __syncthreads();
    for (int idx = tid; idx < 1024; idx += 512) { const int nn = idx >> 4, k4 = (idx & 15) * 4; const int n = n0 + nn;
        int row = n;
        if (rmode) row = (n >> 7) * 256 + (n & 127) + (rmode == 2 ? 128 : 0);
        pg8::u32x2v w; w.x = pg8::cvt_pk_bf16(lds[(k4 + 0) * 65 + nn], lds[(k4 + 1) * 65 + nn]); w.y = pg8::cvt_pk_bf16(lds[(k4 + 2) * 65 + nn], lds[(k4 + 3) * 65 + nn]);
        *(pg8::u32x2v*)(Wt + (size_t)(rowbase + row) * D_MODEL + k0 + k4) = w; }
    __syncthreads();
}
__device__ __forceinline__ void ph_convert(const Params& p, float* lds) {
    constexpr int KT = D_MODEL / 64;
    constexpr int T_IN = KT * (LDP / 64), T_OUT = KT * (D_MODEL / 64), T_E = KT * (D_MODEL / 64);
    constexpr int PER_L = T_IN + T_OUT + NE * 3 * T_E, TOTAL = DEPTH * PER_L;
    for (int t = blockIdx.x; t < TOTAL; t += gridDim.x) {
        const int l = t / PER_L; int r = t % PER_L;
        if (r < T_IN) { const int kt = r % KT, nt = r / KT;
            cvt_tile(p.w_in + (size_t)l * D_MODEL * N_IN, N_IN, N_IN, kt * 64, nt * 64, p.wt_in + (size_t)l * LDP * D_MODEL, 0, 0, lds); continue; }
        r -= T_IN;
        if (r < T_OUT) { const int kt = r % KT, nt = r / KT;
            cvt_tile(p.w_out + (size_t)l * D_MODEL * D_MODEL, D_MODEL, D_MODEL, kt * 64, nt * 64, p.wt_out + (size_t)l * D_MODEL * D_MODEL, 0, 0, lds); continue; }
        r -= T_OUT;
        const int e = r / (3 * T_E), which = (r / T_E) % 3, q = r % T_E, kt = q % KT, nt = q / KT;
        const size_t eo = ((size_t)l * NE + e) * D_MODEL * D_MODEL;
        if (which == 0) cvt_tile(p.w_exp1 + eo, D_MODEL, D_MODEL, kt * 64, nt * 64, p.w13t + 2 * eo, 0, 1, lds);
        else if (which == 1) cvt_tile(p.w_exp3 + eo, D_MODEL, D_MODEL, kt * 64, nt * 64, p.w13t + 2 * eo, 0, 2, lds);
        else cvt_tile(p.w_exp2 + eo, D_MODEL, D_MODEL, kt * 64, nt * 64, p.w2t + eo, 0, 0, lds);
    }
}

constexpr int LDS_BYTES = 147456;
constexpr int LDS_MISC = 131072;
constexpr int NPL = 15;
constexpr int NPHASE = 2 + DEPTH * NPL + 1;

struct Args { Params p; int ph_lo, ph_hi; };

template <int G> __device__ __forceinline__ Exec mk_exec() { const int gt = blockIdx.x * 512 + threadIdx.x; return Exec{gt / G, (int)(gridDim.x * 512) / G, gt % G}; }
typedef const __attribute__((address_space(4))) unsigned long long* kq_t;
__device__ __forceinline__ void load_params(Params& p, const __attribute__((address_space(4))) unsigned char* ka) {
    kq_t s = (kq_t)ka; unsigned long long* d = (unsigned long long*)&p;
#pragma unroll
    for (int i = 0; i < (int)(sizeof(Params) / 8); ++i) d[i] = s[i];
}
#define LOADP() Params p; load_params(p, ka)
#define PH(k, ...) do { if (lo <= (k) && (k) < hi) { { LOADP(); __VA_ARGS__; } if ((k) + 1 < hi) xcd_barrier(bar); } } while (0)
#define e1 mk_exec<1>()
#define e16 mk_exec<16>()
#define e64 mk_exec<64>()
#define flds ((float*)lds)
#define glds ((PG8_LAS unsigned char*)lds)
#define G ((int)gridDim.x)
#define c ((int)blockIdx.x)
template <int L> __device__ __forceinline__ void layer_phases(const __attribute__((address_space(4))) unsigned char* ka, int lo, int hi, const XcdBarrier& bar, unsigned char* lds) {
    constexpr int l = L;
        const int b0 = 2 + l * NPL; const bool last = (l == DEPTH - 1);
        PH(b0 + 0, ph_norm1<64>(p, l, e64));
        PH(b0 + 1, { pg8::Gemm g{p.h, p.wt_in + (size_t)l * LDP * D_MODEL, MROWS, LDP, D_MODEL}; pg8::StaticOrder S; S.init(MROWS, LDP, G, c);
                     pg8::EpiF32 E{p.P, LDP}; pg8::gemm_phase<pg8::EpiF32, pg8::StaticOrder>(glds, g, S, E); });
        PH(b0 + 2, ph_rw_prep1<64>(p, l, e64); ph_ml_g1(p, l, e1); ph_gd_prep<64>(p, l, e64); ph_gd_gates(p, l, e1); ph_at_prep<64>(p, l, e64));
        PH(b0 + 3, ph_rw_prep2<64>(p, l, e64); ph_ml_g2(p, e1); ph_gd_c1(p, e64));
        PH(b0 + 4, { for (int u = c; u < RW_CN; u += G) ph_rw_c1_unit(p, u, threadIdx.x, 512, lds); for (int u = G - 1 - c; u < ML_CN; u += G) ph_ml_c1_unit(p, u, threadIdx.x, 512, lds); });
        PH(b0 + 5, { for (int u = c; u < (RW_CN + TS_G - 1) / TS_G; u += G) ph_tsolve_unit(p.rw_Ma, p.rw_T, RW_CN, u, threadIdx.x, 512, lds);
                     for (int u = G - 1 - c; u < (GD_CN + TS_G - 1) / TS_G; u += G) ph_tsolve_unit(p.gd_A, p.gd_T, GD_CN, u, threadIdx.x, 512, lds); });
        PH(b0 + 6, {
            const int nlat = BATCH * AT_QH * (SEQ / 256), nctx = last ? 0 : BATCH * AT_QH;
            if (c < nlat) { const int u = c;
                const int qb = u % (SEQ / 256), hq = (u / (SEQ / 256)) % AT_QH, b = u / ((SEQ / 256) * AT_QH), s0 = CTX + qb * 256, kvh = hq / (AT_QH / AT_KVH);
                att::attn_dense_body((const att::bf16*)p.at_q + (((size_t)b * AT_QH + hq) * TOK + s0) * AT_HEAD,
                                     (const att::bf16*)p.at_k + ((size_t)b * AT_KVH + kvh) * TOK * AT_HEAD, (const att::bf16*)p.at_v + ((size_t)b * AT_KVH + kvh) * TOK * AT_HEAD,
                                     p.mix + ((size_t)b * TOK + s0) * D_MODEL + 3 * GROUP_W + hq * AT_HEAD, TOK, (char*)lds);
                __syncthreads(); }
            if (c >= G - nctx) { const int u = c - (G - nctx);
                const int hq = u % AT_QH, b = u / AT_QH, kvh = hq / (AT_QH / AT_KVH);
                att::attn_dense_body((const att::bf16*)p.at_q + (((size_t)b * AT_QH + hq) * TOK) * AT_HEAD,
                                     (const att::bf16*)p.at_k + ((size_t)b * AT_KVH + kvh) * TOK * AT_HEAD, (const att::bf16*)p.at_v + ((size_t)b * AT_KVH + kvh) * TOK * AT_HEAD,
                                     p.mix + ((size_t)b * TOK) * D_MODEL + 3 * GROUP_W + hq * AT_HEAD, CTX, (char*)lds);
                __syncthreads(); }
            for (int u = c; u < RW_CN; u += G) ph_rw_c3_unit(p, u, threadIdx.x, 512, lds);
            for (int u = G - 1 - c; u < GD_CN; u += G) ph_gd_c3_unit(p, u, threadIdx.x, 512, lds);
            ph_ml_prefix(p, e1); });
        PH(b0 + 7, { for (int u = c; u < GD_S2_UNITS; u += G) ph_gd_scan2_unit(p, u, threadIdx.x, 512, lds); }
                   { for (int u = G - 1 - c; u < RW_CH; u += G) ph_rw_scan2_unit(p, u, threadIdx.x, 512, lds); }
                   { for (int u = c - GD_S2_UNITS; u < ML_CN; u += G - GD_S2_UNITS - RW_CH) if (u >= 0 && c < G - RW_CH) ph_ml_c2_unit(p, u, threadIdx.x, 512, lds); });
        PH(b0 + 8, ph_rw_post<64>(p, l, e64); ph_gd_post<64>(p, l, e64); ph_ml_post<64>(p, l, e64));
        PH(b0 + 9, { pg8::Gemm g{p.mix, p.wt_out + (size_t)l * D_MODEL * D_MODEL, MROWS, D_MODEL, D_MODEL}; pg8::TileOrder S;
                      S.init(last ? BATCH * SEQ / 256 : MROWS / 256, D_MODEL / 256, G, c, last ? 1 : 0);
                      pg8::EpiResid E{p.xres, p.mod + (size_t)l * 3 * 6 * D_MODEL}; pg8::gemm_phase<pg8::EpiResid, pg8::TileOrder>(glds, g, S, E); });
        PH(b0 + 10, ph_norm2<64>(p, l, e64));
        PH(b0 + 11, ph_topk(p, l, e1));
        PH(b0 + 12, ph_gather<64>(p, l, e64));
        PH(b0 + 13, { pg8::Gemm g{p.xs, p.w13t + (size_t)l * NE * 2 * D_MODEL * D_MODEL, NE * NSLOT, NE * 2 * D_MODEL, D_MODEL}; pg8::GroupedOrder S;
                      S.init(last ? NSLOT_L / 256 : NSLOT / 256, 2 * D_MODEL / 256, NSLOT / 256, G, c);
                      pg8::EpiSwiGLU E{p.hid, 2 * D_MODEL / 256}; pg8::gemm_phase<pg8::EpiSwiGLU, pg8::GroupedOrder>(glds, g, S, E); });
        PH(b0 + 14, { pg8::Gemm g{p.hid, p.w2t + (size_t)l * NE * D_MODEL * D_MODEL, NE * NSLOT, NE * D_MODEL, D_MODEL}; pg8::GroupedOrder S;
                      S.init(last ? NSLOT_L / 256 : NSLOT / 256, D_MODEL / 256, NSLOT / 256, G, c);
                      pg8::EpiGate E{p.yexp, p.sel_gate, D_MODEL / 256}; pg8::gemm_phase<pg8::EpiGate, pg8::GroupedOrder>(glds, g, S, E); });
    }
__global__ void __launch_bounds__(512, 2) mega(Args args) {
    extern __shared__ __attribute__((aligned(16))) unsigned char lds[];
    typedef const __attribute__((address_space(4))) unsigned char* kptr_t;
    const kptr_t ka = (kptr_t)__builtin_amdgcn_kernarg_segment_ptr();
    (void)args;
    const unsigned long long lohi = ((kq_t)ka)[sizeof(Params) / 8]; const int lo = (int)(unsigned)lohi, hi = (int)(unsigned)(lohi >> 32);
    unsigned* barw = (unsigned*)((kq_t)ka)[offsetof(Params, bar) / 8];
    volatile LAS unsigned* misc = (volatile LAS unsigned*)((LAS unsigned char*)lds + LDS_MISC);
    if (threadIdx.x < 4) misc[threadIdx.x] = 0u;
    __syncthreads();
    const bool use_bar = (hi - lo) > 1;
    XcdBarrier bar; bar.bar = barw; bar.x = 0; bar.st = misc;
    if (use_bar) bar = xcd_barrier_post(barw, misc);
    PH(0, ph_convert(p, flds); ph_mod_partial(p, e1));
    PH(1, ph_mod_final(p, e1));
    layer_phases<0>(ka, lo, hi, bar, lds);
    layer_phases<1>(ka, lo, hi, bar, lds);
    static_assert(DEPTH == 2, "depth");
    PH(2 + DEPTH * NPL, ph_final<64>(p, e64));
}
#undef PH
#undef e1
#undef e16
#undef e64
#undef flds
#undef glds
#undef G
#undef c
#undef LOADP

static size_t ws_carve(Params& p, unsigned char* ws) {
    size_t off = 0;
    auto take = [&](size_t bytes) { size_t o = off; off += (bytes + 255) / 256 * 256; return ws ? ws + o : (unsigned char*)nullptr; };
    p.bar = (unsigned*)take(XCD_BAR_WORDS * 4);
    p.modp = (float*)take((size_t)DEPTH * MOD_KS * 3 * 6 * D_MODEL * 4); p.mod = (float*)take((size_t)DEPTH * 3 * 6 * D_MODEL * 4);
    p.wt_in = (u16*)take((size_t)DEPTH * LDP * D_MODEL * 2); p.wt_out = (u16*)take((size_t)DEPTH * D_MODEL * D_MODEL * 2);
    p.w13t = (u16*)take((size_t)DEPTH * NE * 2 * D_MODEL * D_MODEL * 2); p.w2t = (u16*)take((size_t)DEPTH * NE * D_MODEL * D_MODEL * 2);
    p.xres = (float*)take((size_t)MROWS * D_MODEL * 4); p.h = (u16*)take((size_t)MROWS * D_MODEL * 2); p.mix = (u16*)take((size_t)MROWS * D_MODEL * 2);
    p.aff = (float*)take((size_t)MROWS * NE * 4); p.inv = (int*)take((size_t)MROWS * NE * 4);
    p.sel_row = (int*)take((size_t)NE * NSLOT * 4); p.sel_gate = (float*)take((size_t)NE * NSLOT * 4);
    const size_t region = off;
    p.P = (float*)take((size_t)MROWS * LDP * 4);
    const size_t rg = (size_t)MROWS * GROUP_W * 4;
    p.rw_r = (float*)take(rg); p.rw_k = (float*)take(rg); p.rw_v = (float*)take(rg); p.rw_kk = (float*)take(rg); p.rw_g = (float*)take(rg);
    p.rw_lr = (float*)take((size_t)MROWS * RW_LR * 4);
    p.rw_ew = (float*)take(2 * rg); p.rw_kka = (float*)take(2 * rg); p.rw_kt = (float*)take(2 * rg); p.rw_y = (float*)take(2 * rg);
    p.rw_Ma = (float*)take((size_t)RW_CN * CHUNK * CHUNK * 4); p.rw_T = (float*)take((size_t)RW_CN * CHUNK * CHUNK * 4);
    p.rw_Psi = (float*)take((size_t)RW_CN * RW_N * RW_N * 4); p.rw_Y0 = p.rw_Ma;
    p.rw_PhiT = (u16*)take((size_t)RW_CN * RW_N * RW_N * 2); p.rw_Rh = (u16*)take((size_t)RW_CN * CHUNK * RW_N * 2);
    p.ml_bcum = (float*)take((size_t)ML_CH * TOK * 4); p.ml_g = (float*)take((size_t)ML_CH * TOK * 4); p.ml_gmax = (float*)take((size_t)ML_CH * TOK * 4);
    p.ml_bl = (float*)take((size_t)ML_CH * NCHUNK * 4); p.ml_gm = (float*)take((size_t)ML_CH * NCHUNK * 4); p.ml_min = (float*)take((size_t)ML_CH * NCHUNK * 4);
    p.ml_dC = (float*)take((size_t)ML_CH * NCHUNK * ML_HEAD * ML_HEAD * 4); p.ml_dn = (float*)take((size_t)ML_CH * NCHUNK * ML_HEAD * 4);
    p.ml_S = (float*)take((size_t)ML_CH * NCHUNK * CHUNK * CHUNK * 4); p.ml_hh = (float*)take(2 * rg);
    p.gd_q = (float*)take(rg); p.gd_k = (float*)take(rg); p.gd_v = (float*)take(rg);
    p.gd_gc = (float*)take((size_t)GD_CH * TOK * 4); p.gd_beta = (float*)take((size_t)GD_CH * TOK * 4);
    p.gd_A = (float*)take((size_t)GD_CN * CHUNK * CHUNK * 4); p.gd_T = (float*)take((size_t)GD_CN * CHUNK * CHUNK * 4);
    p.gd_Psi = (float*)take((size_t)GD_CN * GD_N * GD_N * 4); p.gd_O0 = (float*)take((size_t)GD_CN * CHUNK * GD_N * 4);
    p.gd_Phi = (u16*)take((size_t)GD_CN * GD_N * GD_N * 2); p.gd_Qh = (u16*)p.gd_A;
    p.gd_o = (float*)take(2 * rg);
    p.at_q = (u16*)take((size_t)BATCH * AT_QH * TOK * AT_HEAD * 2); p.at_k = (u16*)take((size_t)BATCH * AT_KVH * TOK * AT_HEAD * 2); p.at_v = (u16*)take((size_t)BATCH * AT_KVH * TOK * AT_HEAD * 2);
    const size_t end1 = off;
    off = region;
    p.xs = (u16*)take((size_t)NE * NSLOT * D_MODEL * 2); p.hid = (u16*)take((size_t)NE * NSLOT * D_MODEL * 2); p.yexp = (float*)take((size_t)NE * NSLOT * D_MODEL * 4);
    return end1 > off ? end1 : off;
}

#ifndef MK_PER_PHASE
#define MK_PER_PHASE 0
#endif
extern "C" void kernel_launch(void* const* d_in, const int* in_sizes, int n_in, void* d_out, int out_size, void* d_ws, size_t ws_size, hipStream_t stream) {
    static int grid = 0;
    if (grid == 0) {
        Params q{}; const size_t need = ws_carve(q, nullptr);
        if (n_in != 35 || out_size != BATCH * SEQ * D_MODEL || ws_size < need) {
            fprintf(stderr, "kernel_launch: expected 35 inputs, out %d, ws >= %zu; got n_in %d out %d ws %zu\n", BATCH * SEQ * D_MODEL, need, n_in, out_size, ws_size); grid = -1; return; }
        int dev = 0, cus = 0, per_cu = 0;
        if (hipGetDevice(&dev) != hipSuccess || hipDeviceGetAttribute(&cus, hipDeviceAttributeMultiprocessorCount, dev) != hipSuccess) { grid = -1; return; }
        if (hipFuncSetAttribute((const void*)mega, hipFuncAttributeMaxDynamicSharedMemorySize, LDS_BYTES) != hipSuccess) { fprintf(stderr, "kernel_launch: hipFuncSetAttribute failed\n"); grid = -1; return; }
        if (hipOccupancyMaxActiveBlocksPerMultiprocessor(&per_cu, (const void*)mega, 512, LDS_BYTES) != hipSuccess || per_cu < 1)
            fprintf(stderr, "kernel_launch: occupancy query reports %d workgroups per CU\n", per_cu);
        (void)hipGetLastError();
        if (cus < 160) { fprintf(stderr, "kernel_launch: needs >= 160 CUs\n"); grid = -1; return; }
        grid = cus;
    }
    if (grid < 0) return;
    Args a{};
    Params& p = a.p;
    const float** in = (const float**)&p;
    for (int i = 0; i < 35; ++i) in[i] = (const float*)d_in[i];
    p.out = (float*)d_out;
    (void)ws_carve(p, (unsigned char*)d_ws);
    (void)hipMemsetAsync(p.bar, 0, XCD_BAR_WORDS * 4, stream);
#if MK_PER_PHASE
    for (int k = 0; k < NPHASE; ++k) { a.ph_lo = k; a.ph_hi = k + 1; hipLaunchKernelGGL(mega, dim3(grid), dim3(512), LDS_BYTES, stream, a); }
#else
#ifdef MK_PROBE_K
    a.ph_lo = 0; a.ph_hi = MK_PROBE_K;
    hipLaunchKernelGGL(mega, dim3(grid), dim3(512), LDS_BYTES, stream, a);
    (void)hipMemsetAsync(p.bar, 0, XCD_BAR_WORDS * 4, stream);
#endif
    a.ph_lo = 0; a.ph_hi = NPHASE;
    hipLaunchKernelGGL(mega, dim3(grid), dim3(512), LDS_BYTES, stream, a);
#endif
    const hipError_t le = hipPeekAtLastError();
    if (le != hipSuccess) fprintf(stderr, "kernel_launch: launch failed: %s\n", hipGetErrorName(le));
}
```

```cpp
#include <hip/hip_runtime.h>

#ifndef CFG_D_MODEL
#define CFG_D_MODEL 2048
#define CFG_SEQ 4096
#define CFG_GRID_W 64
#define CFG_CTX 256
#define CFG_RW_HEAD 64
#define CFG_RW_DR 64
#define CFG_RW_IR 64
#define CFG_RW_GR 128
#define CFG_ML_HEAD 128
#define CFG_CHUNK 64
#define CFG_GD_HEAD 128
#define CFG_AT_HEAD 128
#define CFG_AT_KVH 2
#define CFG_NE 16
#endif

constexpr int D_MODEL = CFG_D_MODEL, BATCH = 2, SEQ = CFG_SEQ, DEPTH = 2, GRID_W = CFG_GRID_W, CTX = CFG_CTX;
constexpr int TOK = CTX + SEQ, MROWS = BATCH * TOK, GROUP_W = D_MODEL / 4;
constexpr int RW_HEAD = CFG_RW_HEAD, RW_HEADS = GROUP_W / RW_HEAD, RW_DR = CFG_RW_DR, RW_IR = CFG_RW_IR, RW_GR = CFG_RW_GR;
constexpr int RW_COLS = 3 * GROUP_W + RW_DR + RW_IR + RW_GR, RW_LR = RW_DR + RW_IR + RW_GR;
constexpr int ML_HEAD = CFG_ML_HEAD, ML_HEADS = GROUP_W / ML_HEAD, CHUNK = CFG_CHUNK, ML_COLS = 4 * GROUP_W + 4 * ML_HEADS;
constexpr int GD_HEAD = CFG_GD_HEAD, GD_HEADS = GROUP_W / GD_HEAD, GD_COLS = 4 * GROUP_W + 4 * GD_HEADS;
constexpr int AT_HEAD = CFG_AT_HEAD, AT_QH = GROUP_W / AT_HEAD, AT_KVH = CFG_AT_KVH, AT_COLS = (AT_QH + 2 * AT_KVH) * AT_HEAD;
constexpr int N_IN = RW_COLS + ML_COLS + GD_COLS + AT_COLS;
constexpr int RW_OFF = 0, ML_OFF = RW_COLS, GD_OFF = ML_OFF + ML_COLS, AT_OFF = GD_OFF + GD_COLS;
constexpr int LDP = (N_IN + 255) / 256 * 256;
constexpr int NE = CFG_NE, CAPL = 2 * SEQ / NE, CAPC = 2 * CTX / NE;
constexpr int NSLOT_L = BATCH * CAPL, NSLOT_C = BATCH * CAPC;
constexpr int NSLOT = (NSLOT_L + NSLOT_C + 255) / 256 * 256;
constexpr int NCHUNK = TOK / CHUNK, ML_CH = BATCH * ML_HEADS * 2, GD_CH = BATCH * GD_HEADS * 2, RW_CH = BATCH * RW_HEADS * 2;
constexpr float NORM_EPS = 1e-6f, RW_GN_EPS = 64e-5f, RW_DECAY_SCALE = 0.6065306597126334f;
static_assert(ML_HEADS == GD_HEADS, "heads");

typedef unsigned short u16;

#ifdef CPU_TEST
#include <cmath>
#include <cstdint>
#include <cstring>
#define HD inline
#else
#define HD __device__ __forceinline__
#endif

struct Params {
    const float *x, *c, *ctx, *c_ctx, *ada_w, *ada_b, *norm1_g, *norm2_g, *w_in, *w_out;
    const float *rw_mu, *rw_w0, *rw_w_up, *rw_a0, *rw_a_up, *rw_g_up, *rw_k_k, *rw_k_a, *rw_r_k, *rw_ln_w, *rw_ln_b;
    const float *ml_ib, *ml_fb, *ml_norm_g, *gd_conv, *gd_a_log, *gd_dt_bias, *gd_norm_g, *at_q_norm, *at_k_norm;
    const float *w_router, *w_exp1, *w_exp3, *w_exp2, *final_g;
    float* out;
    unsigned* bar;
    float *modp, *mod;
    u16 *wt_in, *wt_out, *w13t, *w2t;
    float* xres;
    u16* h;
    float* P;
    float *rw_r, *rw_k, *rw_v, *rw_lr, *rw_kk, *rw_g, *rw_ew, *rw_kka, *rw_kt, *rw_y;
    float *rw_Ma, *rw_T, *rw_Psi, *rw_Y0; u16 *rw_PhiT, *rw_Rh;
    float *ml_bcum, *ml_g, *ml_gmax, *ml_bl, *ml_gm, *ml_min, *ml_dC, *ml_dn, *ml_S, *ml_hh;
    float *gd_q, *gd_k, *gd_v, *gd_gc, *gd_beta, *gd_A, *gd_T, *gd_Psi, *gd_O0, *gd_o; u16 *gd_Phi, *gd_Qh;
    u16 *at_q, *at_k, *at_v;
    u16* mix;
    float* aff; int* inv;
    int* sel_row; float* sel_gate;
    u16 *xs, *hid; float* yexp;
};

struct Exec { int gid, ngroups, gl; };

template <int G> HD float group_sum(float v) {
#ifndef CPU_TEST
#pragma unroll
    for (int o = G / 2; o > 0; o >>= 1) v += __shfl_xor(v, o, 64);
#endif
    return v;
}
template <int G> HD float group_max(float v) {
#ifndef CPU_TEST
#pragma unroll
    for (int o = G / 2; o > 0; o >>= 1) v = fmaxf(v, __shfl_xor(v, o, 64));
#endif
    return v;
}

template <int G> HD float group_scan_sum(float v, int gl) {
#ifndef CPU_TEST
#pragma unroll
    for (int o = 1; o < G; o <<= 1) { const float t = __shfl_up(v, o, G); if (gl >= o) v += t; }
#endif
    (void)gl; return v;
}
template <int G> HD float group_scan_max(float v, int gl) {
#ifndef CPU_TEST
#pragma unroll
    for (int o = 1; o < G; o <<= 1) { const float t = __shfl_up(v, o, G); if (gl >= o) v = fmaxf(v, t); }
#endif
    (void)gl; return v;
}
template <int G> HD float group_last(float v) {
#ifndef CPU_TEST
    v = __shfl(v, G - 1, G);
#endif
    return v;
}

HD u16 f2bf(float f) { unsigned u; memcpy(&u, &f, 4); u += 0x7FFFu + ((u >> 16) & 1u); return (u16)(u >> 16); }
HD float bf2f(u16 b) { unsigned u = ((unsigned)b) << 16; float f; memcpy(&f, &u, 4); return f; }
HD float sigmoidf_(float x) { return 1.f / (1.f + expf(-x)); }
HD float siluf_(float x) { return x / (1.f + expf(-x)); }
HD float softplusf_(float x) { return x > 20.f ? x : log1pf(expf(x)); }
HD float logsigmoidf_(float x) { return x < 0.f ? x - log1pf(expf(x)) : -log1pf(expf(-x)); }

HD float bf_round(float f) { return bf2f(f2bf(f)); }
#ifndef CPU_TEST
typedef short mma_bf16x8 __attribute__((ext_vector_type(8)));
typedef float mma_f32x16 __attribute__((ext_vector_type(16)));
__device__ __forceinline__ unsigned mma_cvt_pk(float lo, float hi) { unsigned r; asm volatile("v_cvt_pk_bf16_f32 %0, %1, %2" : "=v"(r) : "v"(lo), "v"(hi)); return r; }
#endif
struct Frag {
#ifdef CPU_TEST
    float v[8];
    HD void ld_bf(const u16* p) { for (int j = 0; j < 8; ++j) v[j] = bf2f(p[j]); }
    HD void ld_f(const float* p) { for (int j = 0; j < 8; ++j) v[j] = bf_round(p[j]); }
    HD void ld_f_scaled(const float* p, float w) { for (int j = 0; j < 8; ++j) v[j] = bf_round(p[j] * w); }
    HD void set1(float x) { for (int j = 0; j < 8; ++j) v[j] = bf_round(x); }
    HD void neg() { for (int j = 0; j < 8; ++j) v[j] = -v[j]; }
#else
    typedef unsigned u4 __attribute__((ext_vector_type(4)));
    typedef float f4 __attribute__((ext_vector_type(4)));
    u4 raw;
    HD void ld_bf(const u16* p) { raw = *(const u4*)p; }
    HD void ld_f(const float* p) { const f4 a = *(const f4*)p, b = *(const f4*)(p + 4);
        raw.x = mma_cvt_pk(a.x, a.y); raw.y = mma_cvt_pk(a.z, a.w); raw.z = mma_cvt_pk(b.x, b.y); raw.w = mma_cvt_pk(b.z, b.w); }
    HD void ld_f_scaled(const float* p, float w) { const f4 a = *(const f4*)p * w, b = *(const f4*)(p + 4) * w;
        raw.x = mma_cvt_pk(a.x, a.y); raw.y = mma_cvt_pk(a.z, a.w); raw.z = mma_cvt_pk(b.x, b.y); raw.w = mma_cvt_pk(b.z, b.w); }
    HD void set1(float x) { const unsigned q = mma_cvt_pk(x, x); raw.x = q; raw.y = q; raw.z = q; raw.w = q; }
    HD void neg() { raw.x ^= 0x80008000u; raw.y ^= 0x80008000u; raw.z ^= 0x80008000u; raw.w ^= 0x80008000u; }
#endif
};
#ifdef CPU_TEST
constexpr int MMA_SLOTS = 1024;
#else
constexpr int MMA_SLOTS = 16;
#endif
template <int K, class FA, class FB, class FE> HD void wave_mma32(int lane, FA fa, FB fb, FE fe) {
    static_assert(K % 16 == 0, "K");
#ifdef CPU_TEST
    (void)lane;
    for (int m = 0; m < 32; ++m) for (int n = 0; n < 32; ++n) { float acc = 0.f;
        for (int k0 = 0; k0 < K; k0 += 8) { Frag a8, b8; fa(m, k0, a8); fb(n, k0, b8);
            for (int j = 0; j < 8; ++j) acc += a8.v[j] * b8.v[j]; }
        fe(m, n, acc, m * 32 + n); }
#else
    const int r = lane & 31, h = lane >> 5;
    mma_f32x16 acc;
#pragma unroll
    for (int q = 0; q < 16; ++q) acc[q] = 0.f;
#pragma unroll
    for (int k0 = 0; k0 < K; k0 += 16) { Frag a8, b8; fa(r, k0 + 8 * h, a8); fb(r, k0 + 8 * h, b8);
        acc = __builtin_amdgcn_mfma_f32_32x32x16_bf16(__builtin_bit_cast(mma_bf16x8, a8.raw), __builtin_bit_cast(mma_bf16x8, b8.raw), acc, 0, 0, 0); }
#pragma unroll
    for (int q = 0; q < 16; ++q) fe((q & 3) + 8 * (q >> 2) + 4 * h, r, acc[q], q);
#endif
}
#ifdef CPU_TEST
#define BLOCK_SYNC()
#define BLOCK_FOR(i, n) for (int i = 0; i < (n); ++i)
#define WAVE_FOR(w, n) for (int w = 0; w < (n); ++w)
#define LANE 0
#define OPAQUE_TID()
#else
#define BLOCK_SYNC() __syncthreads()
#define BLOCK_FOR(i, n) for (int i = tid; i < (n); i += nthr)
#define WAVE_FOR(w, n) _Pragma("unroll 1") for (int w = tid >> 6; w < (n); w += (nthr >> 6))
#define LANE (tid & 63)
#define OPAQUE_TID() asm volatile("" : "+v"(tid))
#endif

HD int row_b(int R) { return R / TOK; }
HD int row_s(int R) { return R % TOK; }
HD bool row_ctx(int R) { return row_s(R) < CTX; }
HD int mod_sel(int R) { return row_ctx(R) ? 2 : row_b(R); }
HD int seq_s(int d, int p) { return d == 0 ? p : (p < CTX ? CTX - 1 - p : TOK - 1 - (p - CTX)); }
HD const float* modv(const Params& p, int layer, int sel, int k) { return p.mod + ((size_t)(layer * 3 + sel) * 6 + k) * D_MODEL; }

constexpr int MOD_KS = 16;
HD void ph_mod_partial(const Params& p, Exec e) {
    const int n = DEPTH * MOD_KS * 6 * D_MODEL;
    for (int it = e.gid; it < n; it += e.ngroups) {
        const int col = it % (6 * D_MODEL), ks = (it / (6 * D_MODEL)) % MOD_KS, l = it / (6 * D_MODEL * MOD_KS);
        const float* w = p.ada_w + (size_t)l * D_MODEL * 6 * D_MODEL + col;
        float a0 = 0.f, a1 = 0.f, a2 = 0.f;
        const int k0 = ks * (D_MODEL / MOD_KS);
        for (int k = k0; k < k0 + D_MODEL / MOD_KS; ++k) {
            const float wv = w[(size_t)k * 6 * D_MODEL];
            a0 += siluf_(p.c[k]) * wv; a1 += siluf_(p.c[D_MODEL + k]) * wv; a2 += siluf_(p.c_ctx[k]) * wv;
        }
        float* o = p.modp + ((size_t)(l * MOD_KS + ks) * 3) * 6 * D_MODEL + col;
        o[0] = a0; o[6 * D_MODEL] = a1; o[2 * 6 * D_MODEL] = a2;
    }
}
HD void ph_mod_final(const Params& p, Exec e) {
    const int n = DEPTH * 3 * 6 * D_MODEL;
    for (int it = e.gid; it < n; it += e.ngroups) {
        const int col = it % (6 * D_MODEL), sel = (it / (6 * D_MODEL)) % 3, l = it / (6 * D_MODEL * 3);
        float a = p.ada_b[l * 6 * D_MODEL + col];
        for (int ks = 0; ks < MOD_KS; ++ks) a += p.modp[((size_t)(l * MOD_KS + ks) * 3 + sel) * 6 * D_MODEL + col];
        p.mod[(size_t)(l * 3 + sel) * 6 * D_MODEL + col] = a;
    }
}

HD float resid_in(const Params& p, int layer, int R, int c) {
    if (layer == 0) { const int b = row_b(R), s = row_s(R);
        return s < CTX ? p.ctx[((size_t)b * CTX + s) * D_MODEL + c] : p.x[((size_t)b * SEQ + (s - CTX)) * D_MODEL + c]; }
    float v = p.xres[(size_t)R * D_MODEL + c];
    const float m5 = modv(p, layer - 1, mod_sel(R), 5)[c];
    float acc = 0.f;
    for (int ex = 0; ex < NE; ++ex) { const int j = p.inv[(size_t)R * NE + ex]; if (j >= 0) acc += p.yexp[((size_t)ex * NSLOT + j) * D_MODEL + c]; }
    return v + m5 * acc;
}
template <int G> HD void ph_norm1(const Params& p, int layer, Exec e) {
    for (int R = e.gid; R < MROWS; R += e.ngroups) {
        float ss = 0.f;
        for (int c = e.gl; c < D_MODEL; c += G) { const float v = resid_in(p, layer, R, c); p.xres[(size_t)R * D_MODEL + c] = v; ss += v * v; }
        ss = group_sum<G>(ss);
        const float rstd = 1.f / sqrtf(ss / D_MODEL + NORM_EPS);
        const int sel = mod_sel(R); const float *m0 = modv(p, layer, sel, 0), *m1 = modv(p, layer, sel, 1), *g = p.norm1_g + layer * D_MODEL;
        for (int c = e.gl; c < D_MODEL; c += G) { const float v = p.xres[(size_t)R * D_MODEL + c];
            p.h[(size_t)R * D_MODEL + c] = f2bf(v * rstd * g[c] * (1.f + m1[c]) + m0[c]); }
    }
}
template <int G> HD void ph_final(const Params& p, Exec e) {
    for (int i = e.gid; i < BATCH * SEQ; i += e.ngroups) {
        const int b = i / SEQ, t = i % SEQ, R = b * TOK + CTX + t;
        float ss = 0.f;
        for (int c = e.gl; c < D_MODEL; c += G) { const float v = resid_in(p, DEPTH, R, c); ss += v * v; }
        ss = group_sum<G>(ss);
        const float rstd = 1.f / sqrtf(ss / D_MODEL + NORM_EPS);
        for (int c = e.gl; c < D_MODEL; c += G) p.out[(size_t)i * D_MODEL + c] = resid_in(p, DEPTH, R, c) * rstd * p.final_g[c];
    }
}
template <int G> HD void ph_norm2(const Params& p, int layer, Exec e) {
    const bool last = layer == DEPTH - 1;
    for (int R = e.gid; R < MROWS; R += e.ngroups) {
        if (last && row_ctx(R)) continue;
        float ss = 0.f;
        for (int c = e.gl; c < D_MODEL; c += G) { const float v = p.xres[(size_t)R * D_MODEL + c]; ss += v * v; }
        ss = group_sum<G>(ss);
        const float rstd = 1.f / sqrtf(ss / D_MODEL + NORM_EPS);
        const int sel = mod_sel(R); const float *m3 = modv(p, layer, sel, 3), *m4 = modv(p, layer, sel, 4), *g = p.norm2_g + layer * D_MODEL;
        const float* wr = p.w_router + (size_t)layer * D_MODEL * NE;
        float lg[NE];
#pragma unroll
        for (int ex = 0; ex < NE; ++ex) lg[ex] = 0.f;
        for (int c = e.gl; c < D_MODEL; c += G) { const float v = p.xres[(size_t)R * D_MODEL + c];
            const float hv = v * rstd * g[c] * (1.f + m4[c]) + m3[c];
            p.h[(size_t)R * D_MODEL + c] = f2bf(hv);
#pragma unroll
            for (int ex = 0; ex < NE; ++ex) lg[ex] += hv * wr[c * NE + ex]; }
        float mx = -1e30f;
#pragma unroll
        for (int ex = 0; ex < NE; ++ex) { lg[ex] = group_sum<G>(lg[ex]); mx = fmaxf(mx, lg[ex]); }
        float sum = 0.f;
#pragma unroll
        for (int ex = 0; ex < NE; ++ex) { lg[ex] = expf(lg[ex] - mx); sum += lg[ex]; }
        if (e.gl == 0) {
#pragma unroll
            for (int ex = 0; ex < NE; ++ex) p.aff[(size_t)R * NE + ex] = lg[ex] / sum; }
    }
}
constexpr int TK_PART = 512, TK_PARTS = (SEQ + TK_PART - 1) / TK_PART, TK_SMEM = (SEQ > CTX ? SEQ : CTX) * 4;
HD int topk_units(int layer) { return BATCH * NE * TK_PARTS + (layer == DEPTH - 1 ? 0 : BATCH * NE) + 1; }
HD void ph_topk_unit(const Params& p, int layer, int unit, int tid, int nthr, unsigned char* smem) {
    (void)tid; (void)nthr; OPAQUE_TID();
    const bool last = layer == DEPTH - 1;
    const int nl = BATCH * NE * TK_PARTS, nc = last ? 0 : BATCH * NE;
    float* col = (float*)smem;
    if (unit >= nl + nc) {
        const int per = NSLOT - NSLOT_L - (last ? 0 : NSLOT_C);
        BLOCK_FOR(q, NE * per) { const int ex = q / per, j = NSLOT - per + q % per; p.sel_row[ex * NSLOT + j] = 0; p.sel_gate[ex * NSLOT + j] = 0.f; }
        return; }
    int b, ex, L, base, cap, jbase, t0, t1;
    if (unit < nl) { const int part = unit % TK_PARTS; ex = (unit / TK_PARTS) % NE; b = unit / (TK_PARTS * NE); L = SEQ; base = b * TOK + CTX; cap = CAPL; jbase = b * CAPL;
        t0 = part * TK_PART; t1 = t0 + TK_PART < SEQ ? t0 + TK_PART : SEQ; }
    else { const int q = unit - nl; ex = q % NE; b = q / NE; L = CTX; base = b * TOK; cap = CAPC; jbase = NSLOT_L + b * CAPC; t0 = 0; t1 = CTX; }
    BLOCK_FOR(u, L) col[u] = p.aff[(size_t)(base + u) * NE + ex];
    BLOCK_SYNC();
    BLOCK_FOR(q, t1 - t0) { const int t = t0 + q; const float a = col[t]; int rank = 0;
        for (int u = 0; u < L; ++u) { const float au = col[u]; rank += (au > a || (au == a && u < t)) ? 1 : 0; }
        if (rank < cap) { const int j = jbase + rank; p.sel_row[ex * NSLOT + j] = base + t; p.sel_gate[ex * NSLOT + j] = a; p.inv[(size_t)(base + t) * NE + ex] = j; }
        else p.inv[(size_t)(base + t) * NE + ex] = -1; }
    BLOCK_SYNC();
}
template <int G> HD void ph_gather(const Params& p, int layer, Exec e) {
    const bool last = layer == DEPTH - 1;
    const int nj = last ? NSLOT_L : NSLOT;
    for (int it = e.gid; it < NE * nj; it += e.ngroups) {
        const int ex = it / nj, j = it % nj, R = p.sel_row[ex * NSLOT + j];
        const uint4* s = (const uint4*)(p.h + (size_t)R * D_MODEL); uint4* d = (uint4*)(p.xs + ((size_t)ex * NSLOT + j) * D_MODEL);
        for (int c = e.gl; c < D_MODEL / 8; c += G) d[c] = s[c];
    }
}

template <int G> HD void ph_rw_prep1(const Params& p, int layer, Exec e) {
    const float* mu = p.rw_mu + (size_t)layer * 2 * RW_COLS;
    for (int R = e.gid; R < MROWS; R += e.ngroups) {
        const int s = row_s(R); const bool hp = (s != 0 && s != CTX), hn = (s != CTX - 1 && s != TOK - 1);
        const float* pr = p.P + (size_t)R * LDP + RW_OFF;
        for (int c = e.gl; c < RW_COLS; c += G) {
            const float v = pr[c], pv = hp ? pr[c - LDP] : 0.f, nv = hn ? pr[c + LDP] : 0.f;
            const float pp = v + mu[c] * (pv - v) + mu[RW_COLS + c] * (nv - v);
            if (c < GROUP_W) p.rw_r[(size_t)R * GROUP_W + c] = pp;
            else if (c < 2 * GROUP_W) p.rw_k[(size_t)R * GROUP_W + c - GROUP_W] = pp;
            else if (c < 3 * GROUP_W) p.rw_v[(size_t)R * GROUP_W + c - 2 * GROUP_W] = pp;
            else { const int q = c - 3 * GROUP_W; float o;
                if (q < RW_DR) o = tanhf(pp); else if (q < RW_DR + RW_IR) o = pp; else o = sigmoidf_(pp);
                p.rw_lr[(size_t)R * RW_LR + q] = o; }
        }
    }
}
template <int G> HD void ph_rw_prep2(const Params& p, int layer, Exec e) {
    static_assert(G <= RW_HEAD, "G");
    const float *gup = p.rw_g_up + (size_t)layer * RW_GR * GROUP_W, *kk_w = p.rw_k_k + layer * GROUP_W, *ka_w = p.rw_k_a + layer * GROUP_W;
    for (int R = e.gid; R < MROWS; R += e.ngroups) {
        const float* lr = p.rw_lr + (size_t)R * RW_LR; const float* kr = p.rw_k + (size_t)R * GROUP_W;
        for (int hh = 0; hh < RW_HEADS; ++hh) {
            float ss = 0.f;
            for (int j = hh * RW_HEAD + e.gl; j < (hh + 1) * RW_HEAD; j += G) { const float xk = kr[j] * kk_w[j]; ss += xk * xk; }
            ss = group_sum<G>(ss);
            const float rn = 1.f / sqrtf(ss + 1e-6f);
            for (int j = hh * RW_HEAD + e.gl; j < (hh + 1) * RW_HEAD; j += G) {
                const float kv = kr[j], kkv = kv * kk_w[j] * rn;
                p.rw_kk[(size_t)R * GROUP_W + j] = kkv;
                float g = 0.f;
                for (int i = 0; i < RW_GR; ++i) g += lr[RW_DR + RW_IR + i] * gup[i * GROUP_W + j];
                p.rw_g[(size_t)R * GROUP_W + j] = g;
                for (int d = 0; d < 2; ++d) {
                    const float *wup = p.rw_w_up + ((size_t)(layer * 2 + d) * RW_DR) * GROUP_W, *aup = p.rw_a_up + ((size_t)(layer * 2 + d) * RW_IR) * GROUP_W;
                    float wl = p.rw_w0[(layer * 2 + d) * GROUP_W + j], al = p.rw_a0[(layer * 2 + d) * GROUP_W + j];
                    for (int i = 0; i < RW_DR; ++i) wl += lr[i] * wup[i * GROUP_W + j];
                    for (int i = 0; i < RW_IR; ++i) al += lr[RW_DR + i] * aup[i * GROUP_W + j];
                    const float logw = -RW_DECAY_SCALE * sigmoidf_(wl), a = sigmoidf_(al);
                    const size_t o = ((size_t)d * MROWS + R) * GROUP_W + j;
                    p.rw_ew[o] = logw; p.rw_kka[o] = kkv * a; p.rw_kt[o] = kv * (1.f + (a - 1.f) * ka_w[j]);
                }
            }
        }
    }
}
template <int G> HD void ph_rw_scan(const Params& p, Exec e) {
    constexpr int KPL = RW_HEAD / G;
    for (int it = e.gid; it < RW_CH * RW_HEAD; it += e.ngroups) {
        const int i = it % RW_HEAD, ch = it / RW_HEAD, d = ch % 2, hh = (ch / 2) % RW_HEADS, b = ch / (2 * RW_HEADS);
        float S[KPL];
#pragma unroll
        for (int q = 0; q < KPL; ++q) S[q] = 0.f;
        const int k0 = hh * RW_HEAD + e.gl * KPL;
        for (int pos = 0; pos < TOK; ++pos) {
            const int R = b * TOK + seq_s(d, pos);
            const size_t o1 = (size_t)R * GROUP_W + k0, o2 = ((size_t)d * MROWS + R) * GROUP_W + k0;
            const float vv = p.rw_v[(size_t)R * GROUP_W + hh * RW_HEAD + i];
            float sk = 0.f;
#pragma unroll
            for (int q = 0; q < KPL; ++q) sk += S[q] * p.rw_kk[o1 + q];
            sk = group_sum<G>(sk);
            float y = 0.f;
#pragma unroll
            for (int q = 0; q < KPL; ++q) { S[q] = S[q] * p.rw_ew[o2 + q] - sk * p.rw_kka[o2 + q] + vv * p.rw_kt[o2 + q]; y += S[q] * p.rw_r[o1 + q]; }
            y = group_sum<G>(y);
            if (e.gl == 0) p.rw_y[((size_t)d * MROWS + R) * GROUP_W + hh * RW_HEAD + i] = y;
        }
    }
}

constexpr int RW_N = RW_HEAD, RW_CN = RW_CH * NCHUNK;
static_assert(CHUNK % 32 == 0 && RW_HEAD % 32 == 0, "tile sizes");
HD void rw_chain(int ch, int& b, int& hh, int& d) { d = ch % 2; hh = (ch / 2) % RW_HEADS; b = ch / (2 * RW_HEADS); }
constexpr int RW_C1_SMEM = CHUNK * RW_N * 4 + 2 * CHUNK * RW_N * 2;
HD void ph_rw_c1_unit(const Params& p, int cn, int tid, int nthr, unsigned char* smem) {
    (void)tid; (void)nthr; OPAQUE_TID();
    constexpr int C = CHUNK, N = RW_N;
    const int ch = cn / NCHUNK, n = cn % NCHUNK; int b, hh, d; rw_chain(ch, b, hh, d);
    float* cum = (float*)smem; u16* KKt = (u16*)(cum + C * N); u16* At = KKt + C * N;
    const size_t dofs = (size_t)d * MROWS * GROUP_W;
    BLOCK_FOR(k, N) { float acc = 0.f;
        for (int t = 0; t < C; ++t) { const int R = b * TOK + seq_s(d, n * C + t); acc += p.rw_ew[dofs + (size_t)R * GROUP_W + hh * N + k]; cum[t * N + k] = acc; } }
    BLOCK_SYNC();
    BLOCK_FOR(idx, C * N) { const int t = idx / N, k = idx % N, R = b * TOK + seq_s(d, n * C + t); const size_t o = (size_t)R * GROUP_W + hh * N + k;
        const float cu = cum[idx], cp = cu - p.rw_ew[dofs + o];
        KKt[idx] = f2bf(p.rw_kk[o] * expf(cp)); At[idx] = f2bf(p.rw_kka[dofs + o] * expf(-cu)); }
    BLOCK_SYNC();
    float* Ma = p.rw_Ma + (size_t)cn * C * C;
    WAVE_FOR(w, (C / 32) * (C / 32)) { const int tm = w / (C / 32), tn = w % (C / 32);
        wave_mma32<N>(LANE, [&](int m, int k0, Frag& o) { o.ld_bf(KKt + (tm * 32 + m) * N + k0); },
                            [&](int nn, int k0, Frag& o) { o.ld_bf(At + (tn * 32 + nn) * N + k0); },
                            [&](int m, int nn, float acc, int) { const int t = tm * 32 + m, sx = tn * 32 + nn; Ma[t * C + sx] = sx < t ? acc : 0.f; }); }
    BLOCK_SYNC();
}
constexpr int TS_G = 8, TS_SMEM = TS_G * CHUNK * CHUNK * 4;
HD void ph_tsolve_unit(const float* Mall, float* Tall, int nprob, int unit, int tid, int nthr, unsigned char* smem) {
    (void)tid; (void)nthr; OPAQUE_TID();
    constexpr int C = CHUNK;
    float* Tl = (float*)smem;
    BLOCK_FOR(idx, TS_G * C) { const int w = idx / C, j = idx % C, pr = unit * TS_G + w;
        if (pr < nprob) { const float* M = Mall + (size_t)pr * C * C; float* Tc = Tl + w * C * C; float* To = Tall + (size_t)pr * C * C;
            for (int t = 0; t < C; ++t) { float acc = 0.f;
                if (t == j) acc = 1.f;
                else if (t > j) { for (int sx = j; sx < t; ++sx) acc -= M[t * C + sx] * Tc[sx * C + j]; }
                Tc[t * C + j] = acc; To[t * C + j] = acc; } } }
    BLOCK_SYNC();
}
constexpr int RW_C3_SMEM = CHUNK * RW_N * 4 + 13 * CHUNK * RW_N * 2 + RW_N * 4;
HD void ph_rw_c3_unit(const Params& p, int cn, int tid, int nthr, unsigned char* smem) {
    (void)tid; (void)nthr; OPAQUE_TID();
    constexpr int C = CHUNK, N = RW_N, CN = C * N;
    static_assert(C == N, "c3 buffer aliasing assumes C == N");
    const int ch = cn / NCHUNK, n = cn % NCHUNK; int b, hh, d; rw_chain(ch, b, hh, d);
    float* cum = (float*)smem; u16* mb = (u16*)(cum + CN);
    u16 *KKt = mb, *KKtT = mb + CN, *At = mb + 2 * CN, *KTt = mb + 3 * CN, *Rt = mb + 4 * CN, *ApT = mb + 5 * CN, *KTpT = mb + 6 * CN, *VT = mb + 7 * CN,
        *Tb = mb + 8 * CN, *MkT = mb + 9 * CN, *ZT = mb + 10 * CN, *Na = mb + 11 * CN, *Nk = mb + 12 * CN;
    float* PC = (float*)(mb + 13 * CN);
    u16 *Gm = (u16*)cum, *KKhT = (u16*)cum + CN;
    const size_t dofs = (size_t)d * MROWS * GROUP_W;
    BLOCK_FOR(k, N) { float acc = 0.f;
        for (int t = 0; t < C; ++t) { const int R = b * TOK + seq_s(d, n * C + t); acc += p.rw_ew[dofs + (size_t)R * GROUP_W + hh * N + k]; cum[t * N + k] = acc; }
        PC[k] = expf(acc); }
    BLOCK_SYNC();
    BLOCK_FOR(idx, CN) { const int t = idx / N, k = idx % N, R = b * TOK + seq_s(d, n * C + t); const size_t o = (size_t)R * GROUP_W + hh * N + k;
        const float cu = cum[idx], cp = cu - p.rw_ew[dofs + o], cC = cum[(C - 1) * N + k];
        const float kkv = p.rw_kk[o], kav = p.rw_kka[dofs + o], ktv = p.rw_kt[dofs + o];
        const float e_m = expf(-cu), e_c = expf(cC - cu);
        const u16 kkt = f2bf(kkv * expf(cp));
        KKt[t * N + k] = kkt; KKtT[k * C + t] = kkt; At[t * N + k] = f2bf(kav * e_m); KTt[t * N + k] = f2bf(ktv * e_m); Rt[t * N + k] = f2bf(p.rw_r[o] * expf(cu));
        ApT[k * C + t] = f2bf(kav * e_c); KTpT[k * C + t] = f2bf(ktv * e_c); VT[k * C + t] = f2bf(p.rw_v[o]); }
    BLOCK_FOR(idx, C * C) Tb[idx] = f2bf(p.rw_T[(size_t)cn * C * C + idx]);
    BLOCK_SYNC();
    constexpr int TC = C / 32, TN = N / 32;
    WAVE_FOR(w, 3 * TC * TC) { const int which = w / (TC * TC), tm = (w / TC) % TC, tn = w % TC;
        const u16* Am = which == 0 ? KTt : Rt; const u16* Bm = which == 0 ? KKt : (which == 1 ? At : KTt); u16* Om = which == 0 ? MkT : (which == 1 ? Na : Nk);
        wave_mma32<N>(LANE, [&](int m, int k0, Frag& o) { o.ld_bf(Am + (tm * 32 + m) * N + k0); },
                            [&](int nn, int k0, Frag& o) { o.ld_bf(Bm + (tn * 32 + nn) * N + k0); },
                            [&](int m, int nn, float acc, int) { const int r = tm * 32 + m, cc = tn * 32 + nn; const bool keep = which == 0 ? (cc > r) : (cc <= r);
                                Om[r * C + cc] = f2bf(keep ? acc : 0.f); }); }
    BLOCK_SYNC();
    WAVE_FOR(w, TC * TC + TN * TC) {
        if (w < TC * TC) { const int tm = w / TC, tn = w % TC;
            wave_mma32<C>(LANE, [&](int m, int k0, Frag& o) { o.ld_bf(Tb + (tm * 32 + m) * C + k0); },
                                [&](int nn, int k0, Frag& o) { o.ld_bf(MkT + (tn * 32 + nn) * C + k0); },
                                [&](int m, int nn, float acc, int) { Gm[(tm * 32 + m) * C + tn * 32 + nn] = f2bf(acc); }); }
        else { const int q = w - TC * TC, tm = q / TC, tn = q % TC;
            wave_mma32<C>(LANE, [&](int m, int k0, Frag& o) { o.ld_bf(KKtT + (tm * 32 + m) * C + k0); },
                                [&](int nn, int k0, Frag& o) { o.ld_bf(Tb + (tn * 32 + nn) * C + k0); },
                                [&](int m, int nn, float acc, int) { KKhT[(tm * 32 + m) * C + tn * 32 + nn] = f2bf(acc); }); } }
    BLOCK_SYNC();
    u16* RhG = p.rw_Rh + (size_t)cn * CN; u16* PhiTG = p.rw_PhiT + (size_t)cn * N * N;
    WAVE_FOR(w, TN * TC + TC * TN + TN * TN) {
        if (w < TN * TC) { const int tm = w / TC, tn = w % TC;
            wave_mma32<C>(LANE, [&](int m, int k0, Frag& o) { o.ld_bf(VT + (tm * 32 + m) * C + k0); },
                                [&](int nn, int k0, Frag& o) { o.ld_bf(Gm + (tn * 32 + nn) * C + k0); },
                                [&](int m, int nn, float acc, int) { ZT[(tm * 32 + m) * C + tn * 32 + nn] = f2bf(acc); }); }
        else if (w < TN * TC + TC * TN) { const int q = w - TN * TC, tm = q / TN, tn = q % TN;
            wave_mma32<C>(LANE, [&](int m, int k0, Frag& o) { o.ld_bf(Na + (tm * 32 + m) * C + k0); },
                                [&](int nn, int k0, Frag& o) { o.ld_bf(KKhT + (tn * 32 + nn) * C + k0); },
                                [&](int m, int nn, float acc, int) { const int t = tm * 32 + m, k = tn * 32 + nn; RhG[t * N + k] = f2bf(bf2f(Rt[t * N + k]) - acc); }); }
        else { const int q = w - TN * TC - TC * TN, tm = q / TN, tn = q % TN;
            wave_mma32<C>(LANE, [&](int m, int k0, Frag& o) { o.ld_bf(ApT + (tm * 32 + m) * C + k0); },
                                [&](int nn, int k0, Frag& o) { o.ld_bf(KKhT + (tn * 32 + nn) * C + k0); },
                                [&](int m, int nn, float acc, int) { const int k = tm * 32 + m, k2 = tn * 32 + nn; PhiTG[k * N + k2] = f2bf((k == k2 ? PC[k] : 0.f) - acc); }); } }
    BLOCK_SYNC();
    float* Y0G = p.rw_Y0 + (size_t)cn * CN; float* PsiG = p.rw_Psi + (size_t)cn * N * N;
    WAVE_FOR(w, TC * TN + TN * TN) {
        if (w < TC * TN) { const int tm = w / TN, tn = w % TN;
            wave_mma32<2 * C>(LANE, [&](int m, int k0, Frag& o) { if (k0 < C) o.ld_bf(Nk + (tm * 32 + m) * C + k0); else { o.ld_bf(Na + (tm * 32 + m) * C + k0 - C); o.neg(); } },
                                    [&](int nn, int k0, Frag& o) { if (k0 < C) o.ld_bf(VT + (tn * 32 + nn) * C + k0); else o.ld_bf(ZT + (tn * 32 + nn) * C + k0 - C); },
                                    [&](int m, int nn, float acc, int) { Y0G[(tm * 32 + m) * N + tn * 32 + nn] = acc; }); }
        else { const int q = w - TC * TN, tm = q / TN, tn = q % TN;
            wave_mma32<2 * C>(LANE, [&](int m, int k0, Frag& o) { if (k0 < C) o.ld_bf(VT + (tm * 32 + m) * C + k0); else { o.ld_bf(ZT + (tm * 32 + m) * C + k0 - C); o.neg(); } },
                                    [&](int nn, int k0, Frag& o) { if (k0 < C) o.ld_bf(KTpT + (tn * 32 + nn) * C + k0); else o.ld_bf(ApT + (tn * 32 + nn) * C + k0 - C); },
                                    [&](int m, int nn, float acc, int) { PsiG[(tm * 32 + m) * N + tn * 32 + nn] = acc; }); } }
    BLOCK_SYNC();
}
constexpr int RW_S2_SMEM = 2 * RW_N * RW_N * 2 + RW_N * RW_N * 2 + CHUNK * RW_N * 2 + RW_N * RW_N * 4 + CHUNK * RW_N * 4;
HD void ph_rw_scan2_unit(const Params& p, int ch, int tid, int nthr, unsigned char* smem) {
    (void)tid; (void)nthr; OPAQUE_TID();
    constexpr int C = CHUNK, N = RW_N, TC = C / 32, TN = N / 32;
    int b, hh, d; rw_chain(ch, b, hh, d);
    u16* Sb = (u16*)smem; u16* PhiT = Sb + 2 * N * N; u16* Rh = PhiT + N * N; float* Psi = (float*)(Rh + C * N); float* Y0 = Psi + N * N;
    BLOCK_FOR(i, N * N) Sb[i] = 0;
    for (int n = 0; n < NCHUNK; ++n) {
        const int cn = ch * NCHUNK + n;
        BLOCK_FOR(i, N * N / 8) ((uint4*)PhiT)[i] = ((const uint4*)(p.rw_PhiT + (size_t)cn * N * N))[i];
        BLOCK_FOR(i, C * N / 8) ((uint4*)Rh)[i] = ((const uint4*)(p.rw_Rh + (size_t)cn * C * N))[i];
        BLOCK_FOR(i, N * N / 4) ((uint4*)Psi)[i] = ((const uint4*)(p.rw_Psi + (size_t)cn * N * N))[i];
        BLOCK_FOR(i, C * N / 4) ((uint4*)Y0)[i] = ((const uint4*)(p.rw_Y0 + (size_t)cn * C * N))[i];
        BLOCK_SYNC();
        const u16* Sc = Sb + (n & 1) * N * N; u16* Sn = Sb + ((n + 1) & 1) * N * N;
        WAVE_FOR(w, TN * TN + TC * TN) {
            if (w < TN * TN) { const int tm = w / TN, tn = w % TN;
                wave_mma32<N>(LANE, [&](int m, int k0, Frag& o) { o.ld_bf(Sc + (tm * 32 + m) * N + k0); },
                                    [&](int nn, int k0, Frag& o) { o.ld_bf(PhiT + (tn * 32 + nn) * N + k0); },
                                    [&](int m, int nn, float acc, int) { const int i = tm * 32 + m, k = tn * 32 + nn; Sn[i * N + k] = f2bf(acc + Psi[i * N + k]); }); }
            else { const int q = w - TN * TN, tm = q / TN, tn = q % TN;
                wave_mma32<N>(LANE, [&](int m, int k0, Frag& o) { o.ld_bf(Rh + (tm * 32 + m) * N + k0); },
                                    [&](int nn, int k0, Frag& o) { o.ld_bf(Sc + (tn * 32 + nn) * N + k0); },
                                    [&](int m, int nn, float acc, int) { const int t = tm * 32 + m, i = tn * 32 + nn, R = b * TOK + seq_s(d, n * C + t);
                                        p.rw_y[((size_t)d * MROWS + R) * GROUP_W + hh * N + i] = acc + Y0[t * N + i]; }); } }
        BLOCK_SYNC();
    }
}
template <int G> HD void ph_rw_post(const Params& p, int layer, Exec e) {
    static_assert(G <= RW_HEAD, "G");
    const float *lw = p.rw_ln_w + layer * GROUP_W, *lb = p.rw_ln_b + layer * GROUP_W, *rk = p.rw_r_k + layer * GROUP_W;
    for (int it = e.gid; it < MROWS * RW_HEADS; it += e.ngroups) {
        const int R = it / RW_HEADS, hh = it % RW_HEADS; const size_t o = (size_t)R * GROUP_W + hh * RW_HEAD, o2 = (size_t)MROWS * GROUP_W;
        float s1 = 0.f, bon = 0.f;
        for (int j = e.gl; j < RW_HEAD; j += G) { s1 += p.rw_y[o + j] + p.rw_y[o2 + o + j];
            bon += p.rw_r[o + j] * (p.rw_kt[o + j] + p.rw_kt[o2 + o + j]) * rk[hh * RW_HEAD + j]; }
        s1 = group_sum<G>(s1); bon = group_sum<G>(bon);
        const float mean = s1 / RW_HEAD;
        float s2 = 0.f;
        for (int j = e.gl; j < RW_HEAD; j += G) { const float dlt = p.rw_y[o + j] + p.rw_y[o2 + o + j] - mean; s2 += dlt * dlt; }
        s2 = group_sum<G>(s2);
        const float rstd = 1.f / sqrtf(s2 / RW_HEAD + RW_GN_EPS);
        for (int j = e.gl; j < RW_HEAD; j += G) { const float y = (p.rw_y[o + j] + p.rw_y[o2 + o + j] - mean) * rstd * lw[hh * RW_HEAD + j] + lb[hh * RW_HEAD + j];
            p.mix[(size_t)R * D_MODEL + hh * RW_HEAD + j] = f2bf((y + bon * p.rw_v[o + j]) * p.rw_g[o + j]); }
    }
}

HD void ml_chain(int ch, int& b, int& hh, int& d) { d = ch % 2; hh = (ch / 2) % ML_HEADS; b = ch / (2 * ML_HEADS); }
template <int G> HD void ph_ml_g1(const Params& p, int layer, Exec e) {
    for (int it = e.gid; it < ML_CH * NCHUNK; it += e.ngroups) {
        const int ch = it / NCHUNK, n = it % NCHUNK; int b, hh, d; ml_chain(ch, b, hh, d);
        const float ib = p.ml_ib[(layer * 2 + d) * ML_HEADS + hh], fb = p.ml_fb[(layer * 2 + d) * ML_HEADS + hh];
        float cb = 0.f, cm = -1e30f;
        for (int t0 = 0; t0 < CHUNK; t0 += G) { const int t = t0 + e.gl, pos = n * CHUNK + t, R = b * TOK + seq_s(d, pos);
            const float* g = p.P + (size_t)R * LDP + ML_OFF + 4 * GROUP_W;
            const float li = g[d * ML_HEADS + hh] + ib, lf = logsigmoidf_(g[(2 + d) * ML_HEADS + hh] + fb);
            const float bc = cb + group_scan_sum<G>(lf, e.gl), gv = li - bc, gm = fmaxf(cm, group_scan_max<G>(gv, e.gl));
            p.ml_bcum[(size_t)ch * TOK + pos] = bc; p.ml_g[(size_t)ch * TOK + pos] = gv; p.ml_gmax[(size_t)ch * TOK + pos] = gm;
            cb = group_last<G>(bc); cm = group_last<G>(gm); }
        if (e.gl == 0) { p.ml_bl[ch * NCHUNK + n] = cb; p.ml_gm[ch * NCHUNK + n] = cm; }
    }
}
HD void ph_ml_g2(const Params& p, Exec e) {
    for (int ch = e.gid; ch < ML_CH; ch += e.ngroups) { float m = 0.f;
        for (int n = 0; n < NCHUNK; ++n) { p.ml_min[ch * NCHUNK + n] = m; m = p.ml_bl[ch * NCHUNK + n] + fmaxf(m, p.ml_gm[ch * NCHUNK + n]); } }
}
HD void ph_ml_dC(const Params& p, Exec e) {
    const float ksc = 1.f / sqrtf((float)ML_HEAD);
    const int n1 = ML_CH * NCHUNK * ML_HEAD * ML_HEAD, n2 = ML_CH * NCHUNK * ML_HEAD;
    for (int it = e.gid; it < n1 + n2; it += e.ngroups) {
        const bool isn = it >= n1; const int q = isn ? it - n1 : it;
        const int dd = q % ML_HEAD, ee = isn ? 0 : (q / ML_HEAD) % ML_HEAD, cn = isn ? q / ML_HEAD : q / (ML_HEAD * ML_HEAD), n = cn % NCHUNK, ch = cn / NCHUNK;
        int b, hh, d; ml_chain(ch, b, hh, d);
        const float min_ = p.ml_min[cn], bl = p.ml_bl[cn], mnew = bl + fmaxf(min_, p.ml_gm[cn]);
        float acc = 0.f;
        for (int s = 0; s < CHUNK; ++s) { const int pos = n * CHUNK + s, R = b * TOK + seq_s(d, pos);
            const float wk = expf(bl + p.ml_g[(size_t)ch * TOK + pos] - mnew);
            const float* pr = p.P + (size_t)R * LDP + ML_OFF + hh * ML_HEAD;
            const float kv = pr[GROUP_W + dd] * ksc;
            acc += isn ? wk * kv : wk * kv * pr[2 * GROUP_W + ee]; }
        if (isn) p.ml_dn[(size_t)cn * ML_HEAD + dd] = acc; else p.ml_dC[((size_t)cn * ML_HEAD + ee) * ML_HEAD + dd] = acc;
    }
}
HD void ph_ml_prefix(const Params& p, Exec e) {
    const int n1 = ML_CH * ML_HEAD * ML_HEAD, n2 = ML_CH * ML_HEAD;
    for (int it = e.gid; it < n1 + n2; it += e.ngroups) {
        const bool isn = it >= n1; const int q = isn ? it - n1 : it, per = isn ? ML_HEAD : ML_HEAD * ML_HEAD, ch = q / per, el = q % per;
        float* arr = isn ? p.ml_dn : p.ml_dC; float st = 0.f;
        for (int n = 0; n < NCHUNK; ++n) { const int cn = ch * NCHUNK + n;
            const float min_ = p.ml_min[cn], bl = p.ml_bl[cn], mnew = bl + fmaxf(min_, p.ml_gm[cn]), dc = expf(bl + min_ - mnew);
            const size_t o = (size_t)cn * per + el; const float inc = arr[o]; arr[o] = st; st = dc * st + inc; }
    }
}
HD void ph_ml_S(const Params& p, Exec e) {
    const float ksc = 1.f / sqrtf((float)ML_HEAD);
    for (int it = e.gid; it < ML_CH * NCHUNK * CHUNK * CHUNK; it += e.ngroups) {
        const int s = it % CHUNK, t = (it / CHUNK) % CHUNK, cn = it / (CHUNK * CHUNK), n = cn % NCHUNK, ch = cn / NCHUNK;
        float v = 0.f;
        if (s <= t) { int b, hh, d; ml_chain(ch, b, hh, d);
            const int pt = n * CHUNK + t, ps = n * CHUNK + s, Rt = b * TOK + seq_s(d, pt), Rs = b * TOK + seq_s(d, ps);
            const float* qr = p.P + (size_t)Rt * LDP + ML_OFF + hh * ML_HEAD; const float* kr = p.P + (size_t)Rs * LDP + ML_OFF + GROUP_W + hh * ML_HEAD;
            float dot = 0.f; for (int k = 0; k < ML_HEAD; ++k) dot += qr[k] * kr[k];
            const float bt = p.ml_bcum[(size_t)ch * TOK + pt], mt = bt + fmaxf(p.ml_min[cn], p.ml_gmax[(size_t)ch * TOK + pt]);
            v = dot * ksc * expf(bt + p.ml_g[(size_t)ch * TOK + ps] - mt); }
        p.ml_S[it] = v;
    }
}
HD void ph_ml_out(const Params& p, Exec e) {
    for (int it = e.gid; it < ML_CH * NCHUNK * CHUNK * ML_HEAD; it += e.ngroups) {
        const int ee = it % ML_HEAD, t = (it / ML_HEAD) % CHUNK, cn = it / (ML_HEAD * CHUNK), n = cn % NCHUNK, ch = cn / NCHUNK;
        int b, hh, d; ml_chain(ch, b, hh, d);
        const int pt = n * CHUNK + t, Rt = b * TOK + seq_s(d, pt);
        const float bt = p.ml_bcum[(size_t)ch * TOK + pt], min_ = p.ml_min[cn], mt = bt + fmaxf(min_, p.ml_gmax[(size_t)ch * TOK + pt]), wi = expf(bt + min_ - mt);
        const float* Sr = p.ml_S + ((size_t)cn * CHUNK + t) * CHUNK;
        float num = 0.f, den = 0.f;
        for (int s = 0; s <= t; ++s) { const int Rs = b * TOK + seq_s(d, n * CHUNK + s); const float sv = Sr[s];
            num += sv * p.P[(size_t)Rs * LDP + ML_OFF + 2 * GROUP_W + hh * ML_HEAD + ee]; den += sv; }
        const float* qr = p.P + (size_t)Rt * LDP + ML_OFF + hh * ML_HEAD;
        const float* Cr = p.ml_dC + ((size_t)cn * ML_HEAD + ee) * ML_HEAD; const float* nr = p.ml_dn + (size_t)cn * ML_HEAD;
        float cq = 0.f, nq = 0.f;
        for (int k = 0; k < ML_HEAD; ++k) { cq += Cr[k] * qr[k]; nq += nr[k] * qr[k]; }
        num += wi * cq; den += wi * nq;
        p.ml_hh[((size_t)d * MROWS + Rt) * GROUP_W + hh * ML_HEAD + ee] = num / fmaxf(fabsf(den), expf(-mt));
    }
}

constexpr int ML_N = ML_HEAD, ML_CN = ML_CH * NCHUNK;
static_assert(ML_HEAD % 32 == 0, "tile");
constexpr int ML_C1_SMEM = 2 * ML_N * CHUNK * 2 + 4 * CHUNK * 4;
HD void ph_ml_c1_unit(const Params& p, int cn, int tid, int nthr, unsigned char* smem) {
    (void)tid; (void)nthr; OPAQUE_TID();
    constexpr int C = CHUNK, N = ML_N, TC = C / 32, TN = N / 32;
    const float ksc = 1.f / sqrtf((float)ML_HEAD);
    const int ch = cn / NCHUNK, n = cn % NCHUNK; int b, hh, d; ml_chain(ch, b, hh, d);
    u16* VwT = (u16*)smem; u16* KT = VwT + N * C; float* wk = (float*)(KT + N * C); float* btv = wk + C; float* gv = btv + C; float* mtv = gv + C;
    const float min_ = p.ml_min[cn], bl = p.ml_bl[cn], mnew = bl + fmaxf(min_, p.ml_gm[cn]);
    BLOCK_FOR(sx, C) { const size_t o = (size_t)ch * TOK + n * C + sx; const float g = p.ml_g[o], bt = p.ml_bcum[o];
        wk[sx] = expf(bl + g - mnew); btv[sx] = bt; gv[sx] = g; mtv[sx] = bt + fmaxf(min_, p.ml_gmax[o]); }
    BLOCK_SYNC();
    BLOCK_FOR(idx, C * N) { const int sx = idx / N, dd = idx % N, R = b * TOK + seq_s(d, n * C + sx); const float* pr = p.P + (size_t)R * LDP + ML_OFF + hh * N;
        VwT[dd * C + sx] = f2bf(wk[sx] * pr[2 * GROUP_W + dd]); KT[dd * C + sx] = f2bf(pr[GROUP_W + dd] * ksc); }
    BLOCK_SYNC();
    WAVE_FOR(w, TN * TN + TN + TC * TC) {
        if (w < TN * TN) { const int tm = w / TN, tn = w % TN;
            wave_mma32<C>(LANE, [&](int m, int k0, Frag& o) { o.ld_bf(VwT + (tm * 32 + m) * C + k0); },
                                [&](int nn, int k0, Frag& o) { o.ld_bf(KT + (tn * 32 + nn) * C + k0); },
                                [&](int m, int nn, float acc, int) { p.ml_dC[((size_t)cn * N + tm * 32 + m) * N + tn * 32 + nn] = acc; }); }
        else if (w < TN * TN + TN) { const int tn = w - TN * TN;
            wave_mma32<C>(LANE, [&](int m, int k0, Frag& o) { if (m == 0) o.ld_f(wk + k0); else o.set1(0.f); },
                                [&](int nn, int k0, Frag& o) { o.ld_bf(KT + (tn * 32 + nn) * C + k0); },
                                [&](int m, int nn, float acc, int) { if (m == 0) p.ml_dn[(size_t)cn * N + tn * 32 + nn] = acc; }); }
        else { const int q = w - TN * TN - TN, tm = q / TC, tn = q % TC;
            wave_mma32<N>(LANE, [&](int m, int k0, Frag& o) { const int R = b * TOK + seq_s(d, n * C + tm * 32 + m); o.ld_f(p.P + (size_t)R * LDP + ML_OFF + hh * N + k0); },
                                [&](int nn, int k0, Frag& o) { const int R = b * TOK + seq_s(d, n * C + tn * 32 + nn); o.ld_f(p.P + (size_t)R * LDP + ML_OFF + GROUP_W + hh * N + k0); },
                                [&](int m, int nn, float acc, int) { const int t = tm * 32 + m, sx = tn * 32 + nn;
                                    p.ml_S[((size_t)cn * C + t) * C + sx] = sx <= t ? acc * ksc * expf(btv[t] + gv[sx] - mtv[t]) : 0.f; }); } }
    BLOCK_SYNC();
}
constexpr int ML_C2_SMEM = ML_N * CHUNK * 2 + 3 * CHUNK * 4;
HD void ph_ml_c2_unit(const Params& p, int cn, int tid, int nthr, unsigned char* smem) {
    (void)tid; (void)nthr; OPAQUE_TID();
    constexpr int C = CHUNK, N = ML_N, TC = C / 32, TN = N / 32;
    const int ch = cn / NCHUNK, n = cn % NCHUNK; int b, hh, d; ml_chain(ch, b, hh, d);
    u16* VT = (u16*)smem; float* wi = (float*)(VT + N * C); float* den = wi + C; float* emt = den + C;
    const float min_ = p.ml_min[cn];
    BLOCK_FOR(t, C) { const size_t o = (size_t)ch * TOK + n * C + t; const float bt = p.ml_bcum[o], mt = bt + fmaxf(min_, p.ml_gmax[o]);
        wi[t] = expf(bt + min_ - mt); emt[t] = expf(-mt); }
    BLOCK_FOR(idx, C * N) { const int sx = idx / N, dd = idx % N, R = b * TOK + seq_s(d, n * C + sx);
        VT[dd * C + sx] = f2bf(p.P[(size_t)R * LDP + ML_OFF + 2 * GROUP_W + hh * N + dd]); }
    BLOCK_SYNC();
    WAVE_FOR(w, TC) { const int tm = w;
        wave_mma32<C + N>(LANE, [&](int m, int k0, Frag& o) { const int t = tm * 32 + m;
                                    if (k0 < C) o.ld_f(p.ml_S + ((size_t)cn * C + t) * C + k0);
                                    else { const int R = b * TOK + seq_s(d, n * C + t); o.ld_f_scaled(p.P + (size_t)R * LDP + ML_OFF + hh * N + k0 - C, wi[t]); } },
                                [&](int nn, int k0, Frag& o) { if (nn != 0) o.set1(0.f); else if (k0 < C) o.set1(1.f); else o.ld_f(p.ml_dn + (size_t)cn * N + k0 - C); },
                                [&](int m, int nn, float acc, int) { if (nn == 0) den[tm * 32 + m] = acc; }); }
    BLOCK_SYNC();
    WAVE_FOR(w, TC * TN) { const int tm = w / TN, tn = w % TN;
        wave_mma32<C + N>(LANE, [&](int m, int k0, Frag& o) { const int t = tm * 32 + m;
                                    if (k0 < C) o.ld_f(p.ml_S + ((size_t)cn * C + t) * C + k0);
                                    else { const int R = b * TOK + seq_s(d, n * C + t); o.ld_f_scaled(p.P + (size_t)R * LDP + ML_OFF + hh * N + k0 - C, wi[t]); } },
                                [&](int nn, int k0, Frag& o) { const int ee = tn * 32 + nn;
                                    if (k0 < C) o.ld_bf(VT + ee * C + k0); else o.ld_f(p.ml_dC + ((size_t)cn * N + ee) * N + k0 - C); },
                                [&](int m, int nn, float acc, int) { const int t = tm * 32 + m, ee = tn * 32 + nn, R = b * TOK + seq_s(d, n * C + t);
                                    p.ml_hh[((size_t)d * MROWS + R) * GROUP_W + hh * N + ee] = acc / fmaxf(fabsf(den[t]), emt[t]); }); }
    BLOCK_SYNC();
}
template <int G> HD void ph_ml_post(const Params& p, int layer, Exec e) {
    const float* ng = p.ml_norm_g + layer * GROUP_W;
    for (int it = e.gid; it < MROWS * ML_HEADS; it += e.ngroups) {
        const int R = it / ML_HEADS, hh = it % ML_HEADS; const size_t o = (size_t)R * GROUP_W + hh * ML_HEAD, o2 = (size_t)MROWS * GROUP_W;
        float s1 = 0.f;
        for (int j = e.gl; j < ML_HEAD; j += G) s1 += p.ml_hh[o + j] + p.ml_hh[o2 + o + j];
        s1 = group_sum<G>(s1); const float mean = s1 / ML_HEAD;
        float s2 = 0.f;
        for (int j = e.gl; j < ML_HEAD; j += G) { const float dlt = p.ml_hh[o + j] + p.ml_hh[o2 + o + j] - mean; s2 += dlt * dlt; }
        s2 = group_sum<G>(s2); const float rstd = 1.f / sqrtf(s2 / ML_HEAD + NORM_EPS);
        for (int j = e.gl; j < ML_HEAD; j += G) { const float y = (p.ml_hh[o + j] + p.ml_hh[o2 + o + j] - mean) * rstd * ng[hh * ML_HEAD + j];
            const float og = p.P[(size_t)R * LDP + ML_OFF + 3 * GROUP_W + hh * ML_HEAD + j];
            p.mix[(size_t)R * D_MODEL + GROUP_W + hh * ML_HEAD + j] = f2bf(y * sigmoidf_(og)); }
    }
}

HD float gd_conv_silu(const Params& p, int layer, int R, int c) {
    const int s = row_s(R); const float* pr = p.P + (size_t)R * LDP + GD_OFF + c; const float* cw = p.gd_conv + (size_t)layer * 3 * 3 * GROUP_W + c;
    float v = pr[0] * cw[3 * GROUP_W];
    if (s != 0 && s != CTX) v += pr[-LDP] * cw[0];
    if (s != CTX - 1 && s != TOK - 1) v += pr[LDP] * cw[2 * 3 * GROUP_W];
    return siluf_(v);
}
template <int G> HD void ph_gd_prep(const Params& p, int layer, Exec e) {
    const float qsc = 1.f / sqrtf((float)GD_HEAD);
    for (int it = e.gid; it < MROWS * GD_HEADS; it += e.ngroups) {
        const int R = it / GD_HEADS, hh = it % GD_HEADS;
        float sq = 0.f, sk = 0.f;
        for (int j = e.gl; j < GD_HEAD; j += G) { const float a = gd_conv_silu(p, layer, R, hh * GD_HEAD + j), b2 = gd_conv_silu(p, layer, R, GROUP_W + hh * GD_HEAD + j); sq += a * a; sk += b2 * b2; }
        sq = group_sum<G>(sq); sk = group_sum<G>(sk);
        const float rq = qsc / sqrtf(sq + 1e-6f), rk = 1.f / sqrtf(sk + 1e-6f);
        for (int j = e.gl; j < GD_HEAD; j += G) { const size_t o = (size_t)R * GROUP_W + hh * GD_HEAD + j;
            p.gd_q[o] = gd_conv_silu(p, layer, R, hh * GD_HEAD + j) * rq; p.gd_k[o] = gd_conv_silu(p, layer, R, GROUP_W + hh * GD_HEAD + j) * rk;
            p.gd_v[o] = gd_conv_silu(p, layer, R, 2 * GROUP_W + hh * GD_HEAD + j); }
    }
}
template <int G> HD void ph_gd_gates(const Params& p, int layer, Exec e) {
    for (int it = e.gid; it < GD_CH * NCHUNK; it += e.ngroups) {
        const int ch = it / NCHUNK, n = it % NCHUNK; int b, hh, d; ml_chain(ch, b, hh, d);
        const float al = expf(p.gd_a_log[(layer * 2 + d) * GD_HEADS + hh]), dtb = p.gd_dt_bias[(layer * 2 + d) * GD_HEADS + hh];
        float cg = 0.f;
        for (int t0 = 0; t0 < CHUNK; t0 += G) { const int t = t0 + e.gl, pos = n * CHUNK + t, R = b * TOK + seq_s(d, pos);
            const float* g = p.P + (size_t)R * LDP + GD_OFF + 4 * GROUP_W;
            const float gc = cg + group_scan_sum<G>(-al * softplusf_(g[d * GD_HEADS + hh] + dtb), e.gl);
            p.gd_gc[(size_t)ch * TOK + pos] = gc; p.gd_beta[(size_t)ch * TOK + pos] = sigmoidf_(g[(2 + d) * GD_HEADS + hh]);
            cg = group_last<G>(gc); }
    }
}

constexpr int GD_N = GD_HEAD, GD_CN = GD_CH * NCHUNK;
static_assert(GD_HEAD % 32 == 0, "tile");
HD void ph_gd_c1(const Params& p, Exec e) {
    constexpr int C = CHUNK, N = GD_N, TC = C / 32;
    for (int it = e.gid; it < GD_CN * TC * TC; it += e.ngroups) {
        const int cn = it / (TC * TC), tm = (it / TC) % TC, tn = it % TC, ch = cn / NCHUNK, n = cn % NCHUNK; int b, hh, d; ml_chain(ch, b, hh, d);
        wave_mma32<N>(e.gl, [&](int m, int k0, Frag& o) { const int R = b * TOK + seq_s(d, n * C + tm * 32 + m); o.ld_f(p.gd_k + (size_t)R * GROUP_W + hh * N + k0); },
                            [&](int nn, int k0, Frag& o) { const int R = b * TOK + seq_s(d, n * C + tn * 32 + nn); o.ld_f(p.gd_k + (size_t)R * GROUP_W + hh * N + k0); },
                            [&](int m, int nn, float acc, int) { const int i = tm * 32 + m, j = tn * 32 + nn; const size_t o = (size_t)ch * TOK + n * C;
                                p.gd_A[((size_t)cn * C + i) * C + j] = j < i ? p.gd_beta[o + i] * acc * expf(p.gd_gc[o + i] - p.gd_gc[o + j]) : 0.f; });
    }
}
constexpr int GD_C3_SMEM = (5 * GD_N * CHUNK + 2 * CHUNK * CHUNK) * 2 + 2 * CHUNK * 4;
HD void ph_gd_c3_unit(const Params& p, int cn, int tid, int nthr, unsigned char* smem) {
    (void)tid; (void)nthr; OPAQUE_TID();
    constexpr int C = CHUNK, N = GD_N, TC = C / 32, TN = N / 32;
    const int ch = cn / NCHUNK, n = cn % NCHUNK; int b, hh, d; ml_chain(ch, b, hh, d);
    u16 *KbT = (u16*)smem, *VbT = KbT + N * C, *KdT = VbT + N * C, *uT = KdT + N * C, *wT = uT + N * C, *Tb = wT + N * C, *attn = Tb + C * C;
    float* gcs = (float*)(attn + C * C); float* bet = gcs + C;
    BLOCK_FOR(t, C) { const size_t o = (size_t)ch * TOK + n * C + t; gcs[t] = p.gd_gc[o]; bet[t] = p.gd_beta[o]; }
    BLOCK_SYNC();
    BLOCK_FOR(idx, C * N) { const int t = idx / N, dd = idx % N, R = b * TOK + seq_s(d, n * C + t); const size_t o = (size_t)R * GROUP_W + hh * N + dd;
        const float kv = p.gd_k[o], vv = p.gd_v[o];
        KbT[dd * C + t] = f2bf(kv * bet[t] * expf(gcs[t])); VbT[dd * C + t] = f2bf(vv * bet[t]); KdT[dd * C + t] = f2bf(kv * expf(gcs[C - 1] - gcs[t])); }
    BLOCK_FOR(idx, C * C) Tb[idx] = f2bf(p.gd_T[(size_t)cn * C * C + idx]);
    BLOCK_SYNC();
    WAVE_FOR(w, TC * TC + 2 * TN * TC) {
        if (w < TC * TC) { const int tm = w / TC, tn = w % TC;
            wave_mma32<N>(LANE, [&](int m, int k0, Frag& o) { const int R = b * TOK + seq_s(d, n * C + tm * 32 + m); o.ld_f(p.gd_q + (size_t)R * GROUP_W + hh * N + k0); },
                                [&](int nn, int k0, Frag& o) { const int R = b * TOK + seq_s(d, n * C + tn * 32 + nn); o.ld_f(p.gd_k + (size_t)R * GROUP_W + hh * N + k0); },
                                [&](int m, int nn, float acc, int) { const int i = tm * 32 + m, j = tn * 32 + nn; attn[i * C + j] = f2bf(j <= i ? acc * expf(gcs[i] - gcs[j]) : 0.f); }); }
        else { const int q = w - TC * TC, which = q / (TN * TC), tm = (q / TC) % TN, tn = q % TC;
            const u16* Am = which ? KbT : VbT; u16* Om = which ? wT : uT;
            wave_mma32<C>(LANE, [&](int m, int k0, Frag& o) { o.ld_bf(Am + (tm * 32 + m) * C + k0); },
                                [&](int nn, int k0, Frag& o) { o.ld_bf(Tb + (tn * 32 + nn) * C + k0); },
                                [&](int m, int nn, float acc, int) { Om[(tm * 32 + m) * C + tn * 32 + nn] = f2bf(acc); }); } }
    BLOCK_SYNC();
    WAVE_FOR(w, 2 * TC * TN + 2 * TN * TN) {
        if (w < 2 * TC * TN) { const int which = w / (TC * TN), tm = (w / TN) % TC, tn = w % TN;
            const u16* Bm = which ? uT : wT;
            wave_mma32<C>(LANE, [&](int m, int k0, Frag& o) { o.ld_bf(attn + (tm * 32 + m) * C + k0); },
                                [&](int nn, int k0, Frag& o) { o.ld_bf(Bm + (tn * 32 + nn) * C + k0); },
                                [&](int m, int nn, float acc, int) { const int i = tm * 32 + m, dd = tn * 32 + nn;
                                    if (which) p.gd_O0[((size_t)cn * C + i) * N + dd] = acc;
                                    else { const int R = b * TOK + seq_s(d, n * C + i); p.gd_Qh[((size_t)cn * C + i) * N + dd] = f2bf(p.gd_q[(size_t)R * GROUP_W + hh * N + dd] * expf(gcs[i]) - acc); } }); }
        else { const int q = w - 2 * TC * TN, which = q / (TN * TN), tm = (q / TN) % TN, tn = q % TN;
            const u16* Bm = which ? uT : wT;
            wave_mma32<C>(LANE, [&](int m, int k0, Frag& o) { o.ld_bf(KdT + (tm * 32 + m) * C + k0); },
                                [&](int nn, int k0, Frag& o) { o.ld_bf(Bm + (tn * 32 + nn) * C + k0); },
                                [&](int m, int nn, float acc, int) { const int d1 = tm * 32 + m, d2 = tn * 32 + nn;
                                    if (which) p.gd_Psi[((size_t)cn * N + d1) * N + d2] = acc;
                                    else p.gd_Phi[((size_t)cn * N + d1) * N + d2] = f2bf((d1 == d2 ? expf(gcs[C - 1]) : 0.f) - acc); }); } }
    BLOCK_SYNC();
}
constexpr int GD_EB = 32, GD_S2_UNITS = GD_CH * (GD_N / GD_EB);
constexpr int GD_S2_SMEM = (2 * GD_EB * GD_N + GD_N * GD_N + CHUNK * GD_N) * 2 + (GD_N * GD_EB + CHUNK * GD_EB) * 4;
HD void ph_gd_scan2_unit(const Params& p, int unit, int tid, int nthr, unsigned char* smem) {
    (void)tid; (void)nthr; OPAQUE_TID();
    constexpr int C = CHUNK, N = GD_N, EB = GD_EB;
    const int eb = unit % (N / EB), ch = unit / (N / EB), e0 = eb * EB; int b, hh, d; ml_chain(ch, b, hh, d);
    u16* ST = (u16*)smem; u16* Phi = ST + 2 * EB * N; u16* Qh = Phi + N * N; float* Psi = (float*)(Qh + C * N); float* O0 = Psi + N * EB;
    BLOCK_FOR(i, EB * N) ST[i] = 0;
    for (int n = 0; n < NCHUNK; ++n) {
        const int cn = ch * NCHUNK + n;
        BLOCK_FOR(i, N * N / 8) ((uint4*)Phi)[i] = ((const uint4*)(p.gd_Phi + (size_t)cn * N * N))[i];
        BLOCK_FOR(i, C * N / 8) ((uint4*)Qh)[i] = ((const uint4*)(p.gd_Qh + (size_t)cn * C * N))[i];
        BLOCK_FOR(i, N * EB / 4) ((uint4*)Psi)[i] = *(const uint4*)(p.gd_Psi + ((size_t)cn * N + i / (EB / 4)) * N + e0 + (i % (EB / 4)) * 4);
        BLOCK_FOR(i, C * EB / 4) ((uint4*)O0)[i] = *(const uint4*)(p.gd_O0 + ((size_t)cn * C + i / (EB / 4)) * N + e0 + (i % (EB / 4)) * 4);
        BLOCK_SYNC();
        const u16* Sc = ST + (n & 1) * EB * N; u16* Sn = ST + ((n + 1) & 1) * EB * N;
        WAVE_FOR(w, N / 32 + C / 32) {
            if (w < N / 32) { const int tm = w;
                wave_mma32<N>(LANE, [&](int m, int k0, Frag& o) { o.ld_bf(Phi + (tm * 32 + m) * N + k0); },
                                    [&](int nn, int k0, Frag& o) { o.ld_bf(Sc + nn * N + k0); },
                                    [&](int m, int nn, float acc, int) { const int d1 = tm * 32 + m; Sn[nn * N + d1] = f2bf(acc + Psi[d1 * EB + nn]); }); }
            else { const int tm = w - N / 32;
                wave_mma32<N>(LANE, [&](int m, int k0, Frag& o) { o.ld_bf(Qh + (tm * 32 + m) * N + k0); },
                                    [&](int nn, int k0, Frag& o) { o.ld_bf(Sc + nn * N + k0); },
                                    [&](int m, int nn, float acc, int) { const int t = tm * 32 + m, R = b * TOK + seq_s(d, n * C + t);
                                        p.gd_o[((size_t)d * MROWS + R) * GROUP_W + hh * N + e0 + nn] = acc + O0[t * EB + nn]; }); } }
        BLOCK_SYNC();
    }
}
template <int G> HD void ph_gd_post(const Params& p, int layer, Exec e) {
    const float* ng = p.gd_norm_g + layer * GD_HEAD;
    for (int it = e.gid; it < MROWS * GD_HEADS; it += e.ngroups) {
        const int R = it / GD_HEADS, hh = it % GD_HEADS; const size_t o = (size_t)R * GROUP_W + hh * GD_HEAD, o2 = (size_t)MROWS * GROUP_W;
        float ss = 0.f;
        for (int j = e.gl; j < GD_HEAD; j += G) { const float v = p.gd_o[o + j] + p.gd_o[o2 + o + j]; ss += v * v; }
        ss = group_sum<G>(ss); const float rstd = 1.f / sqrtf(ss / GD_HEAD + NORM_EPS);
        for (int j = e.gl; j < GD_HEAD; j += G) { const float v = (p.gd_o[o + j] + p.gd_o[o2 + o + j]) * rstd * ng[j];
            const float g = p.P[(size_t)R * LDP + GD_OFF + 3 * GROUP_W + hh * GD_HEAD + j];
            p.mix[(size_t)R * D_MODEL + 2 * GROUP_W + hh * GD_HEAD + j] = f2bf(v * siluf_(g)); }
    }
}

template <int G> HD void ph_at_prep(const Params& p, int layer, Exec e) {
    constexpr int NHS = AT_QH + 2 * AT_KVH, HALF = AT_HEAD / 2, QTR = AT_HEAD / 4;
    for (int it = e.gid; it < MROWS * NHS; it += e.ngroups) {
        const int R = it / NHS, hs = it % NHS, b = row_b(R), s = row_s(R);
        const float* pr = p.P + (size_t)R * LDP + AT_OFF + hs * AT_HEAD;
        u16* dst; const float* g = nullptr;
        if (hs < AT_QH) { dst = p.at_q + (((size_t)b * AT_QH + hs) * TOK + s) * AT_HEAD; g = p.at_q_norm + layer * AT_HEAD; }
        else if (hs < AT_QH + AT_KVH) { dst = p.at_k + (((size_t)b * AT_KVH + hs - AT_QH) * TOK + s) * AT_HEAD; g = p.at_k_norm + layer * AT_HEAD; }
        else dst = p.at_v + (((size_t)b * AT_KVH + hs - AT_QH - AT_KVH) * TOK + s) * AT_HEAD;
        if (!g) { for (int j = e.gl; j < AT_HEAD; j += G) dst[j] = f2bf(pr[j]); continue; }
        float ss = 0.f;
        for (int j = e.gl; j < AT_HEAD; j += G) ss += pr[j] * pr[j];
        ss = group_sum<G>(ss); const float rstd = 1.f / sqrtf(ss / AT_HEAD + NORM_EPS);
        if (s < CTX) { for (int j = e.gl; j < AT_HEAD; j += G) dst[j] = f2bf(pr[j] * rstd * g[j]); continue; }
        const int t = s - CTX; const float posr = (float)(t / GRID_W), posc = (float)(t % GRID_W);
        for (int j = e.gl; j < AT_HEAD; j += G) {
            const int half = j / HALF, jj = j % HALF, fi = jj % QTR; const bool second = jj >= QTR;
            const float ang = (half ? posc : posr) * powf(10000.f, -(float)(2 * fi) / (float)HALF);
            const float cs = cosf(ang), sn = sinf(ang);
            const int jp = second ? j - QTR : j + QTR;
            const float own = pr[j] * rstd * g[j], oth = pr[jp] * rstd * g[jp];
            dst[j] = f2bf(second ? own * cs + oth * sn : own * cs - oth * sn);
        }
    }
}

#include <cstdio>
#include <cstddef>
static_assert(D_MODEL == 2048 && CTX == 256 && SEQ % 256 == 0 && AT_HEAD == 128, "GPU part is written for the full configuration");
static_assert(RW_C3_SMEM <= 131072 && TS_SMEM <= 131072 && RW_S2_SMEM <= 131072 && RW_C1_SMEM <= 131072 && GD_C3_SMEM <= 131072 && GD_S2_SMEM <= 131072 && ML_C1_SMEM <= 131072 && ML_C2_SMEM <= 131072, "LDS");
static_assert(CHUNK == RW_N && GD_N * CHUNK * 2 == CHUNK * CHUNK * 4, "buffer aliasing (Y0 on Ma, Qh on A)");

#define XB_TMO      128
#define XB_XCNT(j)  (256  + 64 * (j))
#define XB_XSUB(j)  (1280 + 64 * (j))
#define XB_XGEN(j)  (2304 + 64 * (j))
#define XB_TOP      3328
#define XB_TOPGEN   3392
#define XCD_BAR_WORDS 3456
#define XB_SPIN_CAP (1u << 24)
#define LAS __attribute__((address_space(3)))
__device__ __forceinline__ unsigned xb_ld(unsigned* p)              { return __hip_atomic_load(p, __ATOMIC_RELAXED, __HIP_MEMORY_SCOPE_AGENT); }
__device__ __forceinline__ unsigned xb_add(unsigned* p, unsigned v) { return __hip_atomic_fetch_add(p, v, __ATOMIC_RELAXED, __HIP_MEMORY_SCOPE_AGENT); }
__device__ __forceinline__ unsigned xb_xcc_id() { return (unsigned)__builtin_amdgcn_s_getreg((3 << 11) | 20) & 0xFu; }
#define XB_SPIN(cond, bar) do { unsigned _sp = 0; while (cond) { __builtin_amdgcn_s_sleep(1); \
    if ((++_sp & 255u) == 0u) { if (xb_ld(&(bar)[XB_TMO])) break; if (_sp > XB_SPIN_CAP) { atomicAdd(&(bar)[XB_TMO], 1u); break; } } } } while (0)
struct XcdBarrier { unsigned* bar; unsigned x; volatile LAS unsigned* st; };
__device__ __forceinline__ XcdBarrier xcd_barrier_post(unsigned* bar, volatile LAS unsigned* st) {
    XcdBarrier b; b.bar = bar; b.x = xb_xcc_id(); b.st = st;
    if (threadIdx.x == 0) (void)xb_add(&bar[XB_XCNT(b.x)], 1u);
    return b;
}
__device__ __forceinline__ void xcd_barrier_complete(unsigned* bar, unsigned x, unsigned& nloc, unsigned& nx) {
    const unsigned G = gridDim.x * gridDim.y * gridDim.z;
    unsigned sum, cnt, mine, sp = 0u;
    for (;;) {
        sum = 0u; cnt = 0u; mine = 0u;
#pragma unroll
        for (unsigned j = 0; j < 16; ++j) { const unsigned c = xb_ld(&bar[XB_XCNT(j)]); sum += c; cnt += (c > 0u) ? 1u : 0u; mine = (j == x) ? c : mine; }
        if (sum == G) break;
        __builtin_amdgcn_s_sleep(1);
        if ((++sp & 255u) == 0u) { if (xb_ld(&bar[XB_TMO])) break; if (sp > XB_SPIN_CAP) { atomicAdd(&bar[XB_TMO], 1u); break; } }
    }
    nloc = mine > 0u ? mine : 1u; nx = cnt > 0u ? cnt : 1u;
}
__device__ __forceinline__ void xcd_barrier(const XcdBarrier& b) {
    asm volatile("s_waitcnt vmcnt(0)" ::: "memory");
    __syncthreads();
    if (threadIdx.x == 0) {
        unsigned* bar = b.bar;
        __builtin_amdgcn_s_waitcnt(0);
        unsigned nloc = b.st[0], nx = b.st[1];
        if (nloc == 0u) { xcd_barrier_complete(bar, b.x, nloc, nx); b.st[0] = nloc; b.st[1] = nx; }
        const unsigned old = xb_add(&bar[XB_XSUB(b.x)], 1u);
        const unsigned gen = old / nloc;
        if (old + 1u == (gen + 1u) * nloc) {
            __builtin_amdgcn_fence(__ATOMIC_RELEASE, "agent");
            asm volatile("s_waitcnt vmcnt(0)" ::: "memory");
            const unsigned og = xb_add(&bar[XB_TOP], 1u);
            const unsigned tg = og / nx;
            if (og + 1u == (tg + 1u) * nx) xb_add(&bar[XB_TOPGEN], 1u);
            else XB_SPIN(xb_ld(&bar[XB_TOPGEN]) == tg, bar);
            __builtin_amdgcn_fence(__ATOMIC_ACQUIRE, "agent");
            xb_add(&bar[XB_XGEN(b.x)], 1u);
            asm volatile("s_waitcnt vmcnt(0)" ::: "memory");
        } else {
            XB_SPIN(xb_ld(&bar[XB_XGEN(b.x)]) == gen, bar);
            __builtin_amdgcn_fence(__ATOMIC_ACQUIRE, "agent");
            asm volatile("s_waitcnt vmcnt(0)" ::: "memory");
        }
    }
    __syncthreads();
}

namespace pg8 {
#define PG8_LAS __attribute__((address_space(3)))
typedef unsigned short bf16_t;
typedef short bf16x8 __attribute__((ext_vector_type(8)));
typedef float f32x4 __attribute__((ext_vector_type(4)));
typedef unsigned u32x4 __attribute__((ext_vector_type(4)));
constexpr int BM = 256, BK = 64, HALF = 128, HTB = HALF * BK * 2  , STAGE_BYTES = 8 * HTB, NXCD = 8, WGM = 8;

__host__ __device__ __forceinline__ int lds_byte(int r, int c) { const int st = (r >> 4) * 2 + (c >> 5), rr = r & 15, cc = c & 31, ob = rr * 64 + cc * 2; return st * 1024 + (ob ^ (((ob >> 9) & 1) << 5)); }
__host__ __device__ __forceinline__ void stage_rc(int b, int& R, int& C) { const int st = b / 1024, sb = b % 1024, swz = sb ^ (((sb >> 9) & 1) << 5); R = (st >> 1) * 16 + swz / 64; C = (st & 1) * 32 + (swz % 64) / 2; }
__host__ __device__ __forceinline__ int perm32(int rho) { const int n = rho >> 4, i = rho & 15; return 8 * (i >> 2) + 4 * n + (i & 3); }

struct Unit { int pm, pn; };
struct Gemm { const bf16_t* A; const bf16_t* Bt; int M, N, K; };

struct StaticOrder {
    int nM, nN, nwg, G, c;
    __host__ __device__ void init(int M, int N, int G_, int c_) { nM = M / BM; nN = N / BM; nwg = nM * nN; G = G_; c = c_; }
    __host__ __device__ bool next(int i, Unit& u) const {
        const long L = (long)i * G + c; if (L >= nwg) return false;
        int wgid = (int)L; { const int q = nwg / NXCD, r = nwg % NXCD, xcd = wgid % NXCD, off = wgid / NXCD; wgid = (xcd < r ? xcd * (q + 1) : r * (q + 1) + (xcd - r) * q) + off; }
        const int nig = WGM * nN, gid = wgid / nig, fm = gid * WGM, gsz = (nM - fm) < WGM ? (nM - fm) : WGM;
        u.pm = fm + ((wgid % nig) % gsz); u.pn = (wgid % nig) / gsz; return true;
    }
    __device__ __forceinline__ void a_ready(const Unit&) const {}
    __device__ __forceinline__ void done(const Unit&) const {}
};
__device__ __forceinline__ unsigned cvt_pk_bf16(float lo, float hi) { unsigned r; asm volatile("v_cvt_pk_bf16_f32 %0, %1, %2" : "=v"(r) : "v"(lo), "v"(hi)); return r; }
typedef unsigned u32x2v __attribute__((ext_vector_type(2)));

struct TileOrder {
    int nI, nJ, nwg, G, c, latent_only;
    __device__ void init(int nI_, int nJ_, int G_, int c_, int lat) { nI = nI_; nJ = nJ_; nwg = nI * nJ; G = G_; c = c_; latent_only = lat; }
    __device__ bool next(int i, Unit& u) const { const long L = (long)i * G + c; if (L >= nwg) return false;
        const int ii = (int)(L % nI), j = (int)(L / nI); u.pm = latent_only ? (ii / (SEQ / 256)) * (TOK / 256) + 1 + ii % (SEQ / 256) : ii; u.pn = j; return true; }
    __device__ __forceinline__ void a_ready(const Unit&) const {}
    __device__ __forceinline__ void done(const Unit&) const {}
};
struct GroupedOrder {
    int nI, nJ, tilesA, nwg, G, c;
    __device__ void init(int nI_, int nJ_, int tilesA_, int G_, int c_) { nI = nI_; nJ = nJ_; tilesA = tilesA_; nwg = NE * nI * nJ; G = G_; c = c_; }
    __device__ bool next(int i, Unit& u) const { const long L = (long)i * G + c; if (L >= nwg) return false;
        const int e = (int)(L / (nI * nJ)), r = (int)(L % (nI * nJ)), j = r / nI, ii = r % nI; u.pm = e * tilesA + ii; u.pn = e * nJ + j; return true; }
    __device__ __forceinline__ void a_ready(const Unit&) const {}
    __device__ __forceinline__ void done(const Unit&) const {}
};

struct EpiF32 {
    static constexpr bool PERM = false, AFTER_DRAIN = false;
    float* C; int ldc;
    __device__ __forceinline__ void operator()(const f32x4 (&acc)[2][2][4][2], const Unit& u, int wr, int wc, int fr, int fq) const {
        const int row0 = u.pm * BM + wr * 64 + fr, col0 = u.pn * BM + wc * 32 + 4 * fq;
#pragma unroll
        for (int ai = 0; ai < 2; ++ai)
#pragma unroll
            for (int m = 0; m < 4; ++m) { float* rowp = C + (size_t)(row0 + ai * HALF + m * 16) * ldc + col0;
#pragma unroll
                for (int bj = 0; bj < 2; ++bj)
#pragma unroll
                    for (int n = 0; n < 2; ++n) *(f32x4*)(rowp + bj * HALF + n * 16) = acc[ai][bj][m][n]; }
    }
};
struct EpiResid {
    static constexpr bool PERM = false, AFTER_DRAIN = false;
    float* X; const float* modl;
    __device__ __forceinline__ void operator()(const f32x4 (&acc)[2][2][4][2], const Unit& u, int wr, int wc, int fr, int fq) const {
        const int row0 = u.pm * BM + wr * 64 + fr, col0 = u.pn * BM + wc * 32 + 4 * fq;
        const int tb = TOK / 256, sel = (u.pm % tb == 0) ? 2 : u.pm / tb;
        const float* gate = modl + ((size_t)sel * 6 + 2) * D_MODEL + col0;
        f32x4 gv[2][2];
#pragma unroll
        for (int bj = 0; bj < 2; ++bj)
#pragma unroll
            for (int n = 0; n < 2; ++n) gv[bj][n] = *(const f32x4*)(gate + bj * HALF + n * 16);
#pragma unroll
        for (int ai = 0; ai < 2; ++ai)
#pragma unroll
            for (int m = 0; m < 4; ++m) { float* rowp = X + (size_t)(row0 + ai * HALF + m * 16) * D_MODEL + col0;
#pragma unroll
                for (int bj = 0; bj < 2; ++bj)
#pragma unroll
                    for (int n = 0; n < 2; ++n) { f32x4* q = (f32x4*)(rowp + bj * HALF + n * 16); *q = *q + gv[bj][n] * acc[ai][bj][m][n]; } }
    }
};
struct EpiSwiGLU {
    static constexpr bool PERM = false, AFTER_DRAIN = false;
    bf16_t* H; int nJ;
    __device__ __forceinline__ void operator()(const f32x4 (&acc)[2][2][4][2], const Unit& u, int wr, int wc, int fr, int fq) const {
        const int row0 = u.pm * BM + wr * 64 + fr, col0 = (u.pn % nJ) * HALF + wc * 32 + 4 * fq;
#pragma unroll
        for (int ai = 0; ai < 2; ++ai)
#pragma unroll
            for (int m = 0; m < 4; ++m) { bf16_t* rowp = H + (size_t)(row0 + ai * HALF + m * 16) * D_MODEL + col0;
#pragma unroll
                for (int n = 0; n < 2; ++n) { const f32x4 a = acc[ai][0][m][n], b = acc[ai][1][m][n]; float o[4];
#pragma unroll
                    for (int q = 0; q < 4; ++q) o[q] = a[q] / (1.f + __expf(-a[q])) * b[q];
                    u32x2v w; w.x = cvt_pk_bf16(o[0], o[1]); w.y = cvt_pk_bf16(o[2], o[3]); *(u32x2v*)(rowp + n * 16) = w; } }
    }
};
struct EpiGate {
    static constexpr bool PERM = false, AFTER_DRAIN = false;
    float* Y; const float* gate; int nJ;
    __device__ __forceinline__ void operator()(const f32x4 (&acc)[2][2][4][2], const Unit& u, int wr, int wc, int fr, int fq) const {
        const int row0 = u.pm * BM + wr * 64 + fr, col0 = (u.pn % nJ) * BM + wc * 32 + 4 * fq;
#pragma unroll
        for (int ai = 0; ai < 2; ++ai)
#pragma unroll
            for (int m = 0; m < 4; ++m) { const int r = row0 + ai * HALF + m * 16; const float gt = gate[r]; float* rowp = Y + (size_t)r * D_MODEL + col0;
#pragma unroll
                for (int bj = 0; bj < 2; ++bj)
#pragma unroll
                    for (int n = 0; n < 2; ++n) *(f32x4*)(rowp + bj * HALF + n * 16) = acc[ai][bj][m][n] * gt; }
    }
};
template <class Epi, class Sched>
__device__ __forceinline__ void gemm_phase(PG8_LAS unsigned char* lds, const Gemm g, const Sched& S, const Epi& E) {
    const int tid = threadIdx.x, wid = __builtin_amdgcn_readfirstlane(tid >> 6), lane = tid & 63, wr = wid >> 2, wc = wid & 3, fr = lane & 15, fq = lane >> 4;
    const int K = g.K, nt = K / BK;
    unsigned voffA[2], voffB[2];
#pragma unroll
    for (int i = 0; i < 2; ++i) { int R, C; stage_rc(tid * 16 + i * 8192, R, C); const int Rb = Epi::PERM ? ((R & ~31) + perm32(R & 31)) : R;
        voffA[i] = (unsigned)(R * K + C) * 2u; voffB[i] = (unsigned)(Rb * K + C) * 2u; }
    const size_t kstep = (size_t)(BK * 2);
    const size_t hstep = (size_t)HALF * K * 2;
    const size_t tstep = 2 * hstep;
    const unsigned ldsw = (unsigned)wid * 1024u;
    const int aoff = lds_byte(wr * 64 + fr, fq * 8), boff = lds_byte(wc * 32 + fr, fq * 8);
#define PG8_SA(b, h) (((b) * 2 + (h)) * HTB)
#define PG8_SB(b, h) ((4 + (b) * 2 + (h)) * HTB)
#define PG8_STAGE(bufoff, gbase, voff) do { _Pragma("unroll") for (int _i = 0; _i < 2; ++_i) \
        __builtin_amdgcn_global_load_lds((const unsigned*)((const char*)(gbase) + (voff)[_i]), (PG8_LAS unsigned*)(lds + (bufoff) + ldsw + _i * 8192), 16, 0, 0); } while (0)
#define PG8_LDA(dst, b, h) do { _Pragma("unroll") for (int m = 0; m < 4; ++m) _Pragma("unroll") for (int k = 0; k < 2; ++k) dst[m][k] = *(const PG8_LAS bf16x8*)(lds + PG8_SA(b, h) + aoff + m * 2048 + k * 1024); } while (0)
#define PG8_LDB(dst, b, h) do { _Pragma("unroll") for (int n = 0; n < 2; ++n) _Pragma("unroll") for (int k = 0; k < 2; ++k) dst[n][k] = *(const PG8_LAS bf16x8*)(lds + PG8_SB(b, h) + boff + n * 2048 + k * 1024); } while (0)
#define PG8_MMA(ai, bj, At, Bt) do { __builtin_amdgcn_s_setprio(1); _Pragma("unroll") for (int m = 0; m < 4; ++m) _Pragma("unroll") for (int n = 0; n < 2; ++n) _Pragma("unroll") for (int k = 0; k < 2; ++k) \
        acc[ai][bj][m][n] = __builtin_amdgcn_mfma_f32_16x16x32_bf16(Bt[n][k], At[m][k], acc[ai][bj][m][n], 0, 0, 0); __builtin_amdgcn_s_setprio(0); } while (0)
#define PG8_WAIT_V(n) asm volatile("s_waitcnt vmcnt(" #n ")" ::: "memory")
#define PG8_WAIT_L(n) asm volatile("s_waitcnt lgkmcnt(" #n ")" ::: "memory")
#define PG8_BAR __builtin_amdgcn_s_barrier()
#define PG8_SCHED __builtin_amdgcn_sched_barrier(0)
    Unit cur, nxt; int ui = 0;
    if (!S.next(0, cur)) return;
    f32x4 acc[2][2][4][2];
#pragma unroll
    for (int a = 0; a < 2; ++a)
#pragma unroll
        for (int b = 0; b < 2; ++b)
#pragma unroll
            for (int m = 0; m < 4; ++m)
#pragma unroll
                for (int n = 0; n < 2; ++n) acc[a][b][m][n] = (f32x4){0.f, 0.f, 0.f, 0.f};
    bf16x8 At[4][2], B0[2][2], B1[2][2];
    const char* cA = (const char*)g.A + (size_t)cur.pm * tstep; const char* cB = (const char*)g.Bt + (size_t)cur.pn * tstep;
    S.a_ready(cur);
    PG8_STAGE(PG8_SB(0, 0), cB, voffB); PG8_STAGE(PG8_SA(0, 0), cA, voffA); PG8_STAGE(PG8_SB(0, 1), cB + hstep, voffB); PG8_STAGE(PG8_SA(0, 1), cA + hstep, voffA);
    if (wr == 1) PG8_BAR;
    PG8_WAIT_V(4); PG8_BAR;
    PG8_STAGE(PG8_SB(1, 0), cB + kstep, voffB); PG8_STAGE(PG8_SA(1, 0), cA + kstep, voffA); PG8_STAGE(PG8_SB(1, 1), cB + hstep + kstep, voffB);
    PG8_WAIT_V(6); PG8_BAR;
    for (;;) {
        const bool has_next = S.next(ui + 1, nxt);
        const char* nA = has_next ? (const char*)g.A + (size_t)nxt.pm * tstep : cA; const char* nB = has_next ? (const char*)g.Bt + (size_t)nxt.pn * tstep : cB;
        for (int t = 0; t < nt; t += 2) {
            const bool last = (t == nt - 2);
            const char* a1 = cA + (size_t)(t + 1) * kstep;
            const char* a2 = last ? nA : cA + (size_t)(t + 2) * kstep; const char* b2 = last ? nB : cB + (size_t)(t + 2) * kstep;
            const char* a3 = a2 + kstep; const char* b3 = b2 + kstep;
            if (last && has_next) S.a_ready(nxt);
            PG8_LDB(B0, 0, 0); PG8_SCHED; PG8_LDA(At, 0, 0); PG8_STAGE(PG8_SA(1, 1), a1 + hstep, voffA);
            PG8_WAIT_L(8); PG8_BAR; PG8_WAIT_L(0); PG8_MMA(0, 0, At, B0); PG8_BAR; PG8_SCHED;
            PG8_LDB(B1, 0, 1); PG8_STAGE(PG8_SB(0, 0), b2, voffB);
            PG8_BAR; PG8_WAIT_L(0); PG8_MMA(0, 1, At, B1); PG8_BAR;
            PG8_LDA(At, 0, 1); PG8_STAGE(PG8_SA(0, 0), a2, voffA);
            PG8_BAR; PG8_WAIT_L(0); PG8_MMA(1, 0, At, B0); PG8_BAR; PG8_SCHED;
            PG8_STAGE(PG8_SB(0, 1), b2 + hstep, voffB);
            PG8_WAIT_V(6); PG8_BAR; PG8_MMA(1, 1, At, B1); PG8_BAR;
            PG8_LDB(B0, 1, 0); PG8_SCHED; PG8_LDA(At, 1, 0); PG8_STAGE(PG8_SA(0, 1), a2 + hstep, voffA);
            PG8_WAIT_L(8); PG8_BAR; PG8_WAIT_L(0); PG8_MMA(0, 0, At, B0); PG8_BAR; PG8_SCHED;
            PG8_LDB(B1, 1, 1); PG8_STAGE(PG8_SB(1, 0), b3, voffB);
            PG8_BAR; PG8_WAIT_L(0); PG8_MMA(0, 1, At, B1); PG8_BAR;
            PG8_LDA(At, 1, 1); PG8_STAGE(PG8_SA(1, 0), a3, voffA);
            PG8_BAR; PG8_WAIT_L(0); PG8_MMA(1, 0, At, B0); PG8_BAR; PG8_SCHED;
            PG8_STAGE(PG8_SB(1, 1), b3 + hstep, voffB);
            PG8_WAIT_V(6); PG8_BAR; PG8_MMA(1, 1, At, B1); PG8_BAR;
        }
        if constexpr (!Epi::AFTER_DRAIN) { E(acc, cur, wr, wc, fr, fq); S.done(cur); }
        if (!has_next) break;
#pragma unroll
        for (int a = 0; a < 2; ++a)
#pragma unroll
            for (int b = 0; b < 2; ++b)
#pragma unroll
                for (int m = 0; m < 4; ++m)
#pragma unroll
                    for (int n = 0; n < 2; ++n) acc[a][b][m][n] = (f32x4){0.f, 0.f, 0.f, 0.f};
        cur = nxt; cA = nA; cB = nB; ++ui;
    }
    PG8_WAIT_V(0);
    if (wr == 0) PG8_BAR;
    PG8_BAR;
    if constexpr (Epi::AFTER_DRAIN) { E.fused(acc, cur, wr, wc, fr, fq, lds, wid, lane); S.done(cur); }
#undef PG8_SA
#undef PG8_SB
#undef PG8_STAGE
#undef PG8_LDA
#undef PG8_LDB
#undef PG8_MMA
#undef PG8_WAIT_V
#undef PG8_WAIT_L
#undef PG8_BAR
#undef PG8_SCHED
}
}


namespace att {
using bf16 = unsigned short;
constexpr int   D = 128, NW = 8, QBLK = 32, KVBLK = 64;
constexpr float SCALE = 0.088388347648318440f;
constexpr float THR = 8.f;
constexpr int SDEPTH = 2;
constexpr int LDQ = 128, LDK = 128, LDO = D_MODEL;
constexpr size_t SHM_V = KVBLK * D * 2, SHM_K = KVBLK * D * 2, SHM_ATTN = 2 * SHM_V + 2 * SHM_K + NW * 64 * 4;
using bf16x8 = __attribute__((ext_vector_type(8))) short;
using s16x4  = __attribute__((ext_vector_type(4))) short;
using f32x16 = __attribute__((ext_vector_type(16))) float;
using f32x8  = __attribute__((ext_vector_type(8))) float;
using u32x4  = __attribute__((ext_vector_type(4))) unsigned;
#define KSWZ(row, colB) ((row) * 256 + ((colB) ^ (((row) & 7) << 4)))
#define SBAR() __builtin_amdgcn_sched_barrier(0)
__device__ __forceinline__ int crow(int r, int hi) { return (r & 3) + 8 * (r >> 2) + 4 * hi; }
__device__ __forceinline__ unsigned cvtpk(float lo, float hi) {
  unsigned r; asm volatile("v_cvt_pk_bf16_f32 %0, %1, %2" : "=v"(r) : "v"(lo), "v"(hi)); return r;
}
template <typename TIn> struct Stage;
template <> struct Stage<bf16>  { using T = bf16x8;
  __device__ static __forceinline__ T ld8(const bf16* p) { return *reinterpret_cast<const bf16x8*>(p); }
  __device__ static __forceinline__ bf16x8 tobf(T x) { return x; } };
template <> struct Stage<float> { using T = f32x8;
  __device__ static __forceinline__ T ld8(const float* p) { return *reinterpret_cast<const f32x8*>(p); }
  __device__ static __forceinline__ bf16x8 tobf(T x) {
    u32x4 w = {cvtpk(x[0], x[1]), cvtpk(x[2], x[3]), cvtpk(x[4], x[5]), cvtpk(x[6], x[7])}; return *reinterpret_cast<bf16x8*>(&w); } };

__device__ __forceinline__ void partialSM(f32x16& p0, f32x16& p1, float& m_reg, float& mn, float& alpha) {
  constexpr float C = SCALE * 1.4426950408889634f;
  float pmax = p0[0]; for (int r = 1; r < 16; ++r) pmax = fmaxf(pmax, p0[r]); for (int r = 0; r < 16; ++r) pmax = fmaxf(pmax, p1[r]);
  { auto rr = __builtin_amdgcn_permlane32_swap(__float_as_uint(pmax), __float_as_uint(pmax), false, false);
    pmax = fmaxf(__uint_as_float(rr[0]), __uint_as_float(rr[1])); }
  if (__builtin_expect(__all(pmax - m_reg <= THR / SCALE), 1)) { mn = m_reg; alpha = 1.f; }
  else { mn = fmaxf(m_reg, pmax); alpha = __builtin_amdgcn_exp2f((m_reg - mn) * C); m_reg = mn; }
  float mnC = -mn * C;
  for (int r = 0; r < 16; ++r) p0[r] = fmaf(p0[r], C, mnC); for (int r = 0; r < 16; ++r) p1[r] = fmaf(p1[r], C, mnC);
  for (int r = 0; r < 16; ++r) p0[r] = __builtin_amdgcn_exp2f(p0[r]);
}
__device__ __forceinline__ void finishSM(f32x16& p0, f32x16& p1, float alpha, float& l_reg, bf16x8& pa0, bf16x8& pa1, bf16x8& pa2, bf16x8& pa3) {
  for (int r = 0; r < 16; ++r) p1[r] = __builtin_amdgcn_exp2f(p1[r]);
  float ps = 0; for (int r = 0; r < 16; ++r) ps += p0[r]; for (int r = 0; r < 16; ++r) ps += p1[r];
  { auto rr = __builtin_amdgcn_permlane32_swap(__float_as_uint(ps), __float_as_uint(ps), false, false);
    ps = __uint_as_float(rr[0]) + __uint_as_float(rr[1]); }
  l_reg = l_reg * alpha + ps;
#define PK4(P, BASE, OUT) do { unsigned a0 = cvtpk(P[BASE + 0], P[BASE + 1]), a1 = cvtpk(P[BASE + 2], P[BASE + 3]);   \
    unsigned b0 = cvtpk(P[BASE + 4], P[BASE + 5]), b1 = cvtpk(P[BASE + 6], P[BASE + 7]);                              \
    auto r0 = __builtin_amdgcn_permlane32_swap(a0, b0, false, false); auto r1 = __builtin_amdgcn_permlane32_swap(a1, b1, false, false); \
    u32x4 w = {r0[0], r1[0], r0[1], r1[1]}; OUT = *reinterpret_cast<bf16x8*>(&w); } while (0)
  PK4(p0, 0, pa0); PK4(p0, 8, pa1); PK4(p1, 0, pa2); PK4(p1, 8, pa3);
#undef PK4
}
__device__ __forceinline__ void qkt(f32x16& p0, f32x16& p1, const bf16* Ks, const bf16x8* qr, int r32, int hi) {
  p0 = f32x16{}; p1 = f32x16{};
  for (int d0 = 0; d0 < 8; ++d0) { int cb = (d0 * 16 + hi * 8) * 2;
    bf16x8 b0 = *reinterpret_cast<const bf16x8*>((const char*)Ks + KSWZ(r32, cb));
    bf16x8 b1 = *reinterpret_cast<const bf16x8*>((const char*)Ks + KSWZ(32 + r32, cb));
    p0 = __builtin_amdgcn_mfma_f32_32x32x16_bf16(b0, qr[d0], p0, 0, 0, 0);
    p1 = __builtin_amdgcn_mfma_f32_32x32x16_bf16(b1, qr[d0], p1, 0, 0, 0); }
}
__device__ __forceinline__ int v_st(int k, int c) { const int kk = (k & ~0xC) | ((k & 4) << 1) | ((k & 8) >> 1); return ((kk >> 3) * 4 + (c >> 5)) * 512 + ((kk & 7) * 32 + (c & 31)) * 2; }
__device__ __forceinline__ int v_rd_base(int lane) { return ((lane & 3) << 3) | (((lane >> 2) & 3) << 6) | (((lane >> 4) & 1) << 5) | (((lane >> 5) & 1) << 8); }
constexpr int v_rd_off(int d0, int ks, int half) { return d0 * 512 + ks * 4096 + half * 2048; }
template <int OFF> __device__ __forceinline__ s16x4 tr_read(int vb) {
  s16x4 r; asm volatile("ds_read_b64_tr_b16 %0, %1 offset:%2" : "=&v"(r) : "v"(vb), "i"(OFF) : "memory"); return r;
}
template <int D0> __device__ __forceinline__ void pv_one(f32x16& od, int vb, bf16x8 pa0, bf16x8 pa1, bf16x8 pa2, bf16x8 pa3) {
  const s16x4 l0 = tr_read<v_rd_off(D0, 0, 0)>(vb), h0 = tr_read<v_rd_off(D0, 0, 1)>(vb), l1 = tr_read<v_rd_off(D0, 1, 0)>(vb), h1 = tr_read<v_rd_off(D0, 1, 1)>(vb);
  const s16x4 l2 = tr_read<v_rd_off(D0, 2, 0)>(vb), h2 = tr_read<v_rd_off(D0, 2, 1)>(vb), l3 = tr_read<v_rd_off(D0, 3, 0)>(vb), h3 = tr_read<v_rd_off(D0, 3, 1)>(vb);
  asm volatile("s_waitcnt lgkmcnt(0)" ::: "memory"); SBAR();
#define PK(L, H) (bf16x8){L[0], L[1], L[2], L[3], H[0], H[1], H[2], H[3]}
  od = __builtin_amdgcn_mfma_f32_32x32x16_bf16(pa0, PK(l0, h0), od, 0, 0, 0);
  od = __builtin_amdgcn_mfma_f32_32x32x16_bf16(pa1, PK(l1, h1), od, 0, 0, 0);
  od = __builtin_amdgcn_mfma_f32_32x32x16_bf16(pa2, PK(l2, h2), od, 0, 0, 0);
  od = __builtin_amdgcn_mfma_f32_32x32x16_bf16(pa3, PK(l3, h3), od, 0, 0, 0);
#undef PK
}
__device__ __forceinline__ void pv_d0(f32x16* o, int vb, bf16x8 pa0, bf16x8 pa1, bf16x8 pa2, bf16x8 pa3) {
  pv_one<0>(o[0], vb, pa0, pa1, pa2, pa3); pv_one<1>(o[1], vb, pa0, pa1, pa2, pa3); pv_one<2>(o[2], vb, pa0, pa1, pa2, pa3); pv_one<3>(o[3], vb, pa0, pa1, pa2, pa3);
}

__device__ __forceinline__ void attn_dense_body(const bf16* __restrict__ Qb, const bf16* __restrict__ Kh, const bf16* __restrict__ Vh,
                                                unsigned short* __restrict__ Ob, int seq, char* lds) {
  using St = Stage<bf16>; using SQ = Stage<bf16>; using TQ = bf16;
  const int tid = threadIdx.x, wid = tid >> 6, lane = tid & 63, r32 = lane & 31, hi = lane >> 5;
  bf16* V_lds = (bf16*)lds; bf16* K_lds = (bf16*)(lds + 2 * SHM_V);
  float* ws = (float*)(lds + 2 * SHM_V + 2 * SHM_K) + wid * 64; float* li_l = ws; float* al_l = ws + 32;
  float m_reg = -1e30f, l_reg = 0; f32x16 o[4] = {}; bf16x8 qr[8];
  const TQ* Qw = Qb + (long)(wid * QBLK + r32) * LDQ + hi * 8;
#pragma unroll
  for (int d0 = 0; d0 < 8; ++d0) qr[d0] = SQ::tobf(SQ::ld8(Qw + d0 * 16));
  const int sr = tid >> 4, sc = (tid & 15) * 8, vst0 = v_st(sr, sc), vst1 = v_st(32 + sr, sc);
  const int vb0 = (int)(uintptr_t)V_lds + v_rd_base(lane);
  struct { typename St::T vs0, vs1, ks0, ks1; } sr_[SDEPTH];
#define SLOAD(i, k0) do { sr_[i].vs0 = St::ld8(&Vh[(long)((k0) + sr) * LDK + sc]); sr_[i].vs1 = St::ld8(&Vh[(long)((k0) + 32 + sr) * LDK + sc]); \
    sr_[i].ks0 = St::ld8(&Kh[(long)((k0) + sr) * LDK + sc]); sr_[i].ks1 = St::ld8(&Kh[(long)((k0) + 32 + sr) * LDK + sc]); } while (0)
#define SWRITE(b, i) do { *(bf16x8*)((char*)V_lds + (b) * SHM_V + vst0) = St::tobf(sr_[i].vs0);          \
    *(bf16x8*)((char*)V_lds + (b) * SHM_V + vst1) = St::tobf(sr_[i].vs1); int kc = sc * 2;               \
    *(bf16x8*)((char*)K_lds + (b) * SHM_K + KSWZ(sr, kc)) = St::tobf(sr_[i].ks0);                       \
    *(bf16x8*)((char*)K_lds + (b) * SHM_K + KSWZ(32 + sr, kc)) = St::tobf(sr_[i].ks1); } while (0)
#define SWAIT() do { if constexpr (SDEPTH == 2) asm volatile("s_waitcnt vmcnt(4)" ::: "memory"); else asm volatile("s_waitcnt vmcnt(0)" ::: "memory"); } while (0)
#define RESC(a) do { if (__any((a) < 1.f)) { if (hi == 0) al_l[r32] = (a); asm volatile("s_waitcnt lgkmcnt(0)" ::: "memory"); \
    for (int d = 0; d < 4; ++d) for (int r = 0; r < 16; ++r) o[d][r] *= al_l[crow(r, hi)]; } } while (0)
  f32x16 pA0, pA1, pB0, pB1; float mnA, mnB, alA, alB; bf16x8 pa0, pa1, pa2, pa3; const int NT = seq / KVBLK;
  constexpr int SE = 0, SO = SDEPTH - 1;
  SLOAD(SE, 0); asm volatile("s_waitcnt vmcnt(0)" ::: "memory"); SWRITE(0, SE); __syncthreads();
  qkt(pA0, pA1, K_lds, qr, r32, hi); partialSM(pA0, pA1, m_reg, mnA, alA);
  SLOAD(SO, KVBLK); if constexpr (SDEPTH == 2) { if (2 < NT) SLOAD(SE, 2 * KVBLK); }
  SWAIT(); SWRITE(1, SO); __syncthreads();
  for (int j = 1; j + 1 < NT; j += 2) {
    SBAR(); qkt(pB0, pB1, (bf16*)((char*)K_lds + SHM_K), qr, r32, hi);
    finishSM(pA0, pA1, alA, l_reg, pa0, pa1, pa2, pa3); SBAR();
    SLOAD(SO, (j + SDEPTH) * KVBLK); SBAR();
    pv_d0(o, vb0, pa0, pa1, pa2, pa3); partialSM(pB0, pB1, m_reg, mnB, alB);
    __syncthreads(); SWAIT(); SWRITE(0, SE);
    RESC(alB); __syncthreads();
    SBAR(); qkt(pA0, pA1, K_lds, qr, r32, hi);
    finishSM(pB0, pB1, alB, l_reg, pa0, pa1, pa2, pa3); SBAR();
    if (SDEPTH == 1 || j + 3 < NT) SLOAD(SE, (j + 1 + SDEPTH) * KVBLK); SBAR();
    pv_d0(o, vb0 + (int)SHM_V, pa0, pa1, pa2, pa3); partialSM(pA0, pA1, m_reg, mnA, alA);
    __syncthreads(); SWAIT(); SWRITE(1, SO);
    RESC(alA); __syncthreads();
  }
  SBAR(); qkt(pB0, pB1, (bf16*)((char*)K_lds + SHM_K), qr, r32, hi);
  finishSM(pA0, pA1, alA, l_reg, pa0, pa1, pa2, pa3); SBAR();
  pv_d0(o, vb0, pa0, pa1, pa2, pa3); partialSM(pB0, pB1, m_reg, mnB, alB);
  __syncthreads(); RESC(alB);
  finishSM(pB0, pB1, alB, l_reg, pa0, pa1, pa2, pa3); SBAR();
  pv_d0(o, vb0 + (int)SHM_V, pa0, pa1, pa2, pa3);
  if (hi == 0) li_l[r32] = l_reg; asm volatile("s_waitcnt lgkmcnt(0)" ::: "memory");
  float rli[16];
#pragma unroll
  for (int r = 0; r < 16; ++r) rli[r] = __builtin_amdgcn_rcpf(li_l[crow(r, hi)]);
  unsigned short* Ow = Ob + (long)(wid * QBLK) * LDO;
#pragma unroll
  for (int r = 0; r < 16; ++r) { int orow = crow(r, hi);
    for (int d0 = 0; d0 < 4; ++d0) Ow[(long)orow * LDO + d0 * 32 + r32] = f2bf(o[d0][r] * rli[r]); }
#undef SLOAD
#undef SWRITE
#undef SWAIT
#undef RESC
}
}

__device__ __forceinline__ void cvt_tile(const float* __restrict__ W, int ldw, int nvalid, int k0, int n0, u16* __restrict__ Wt, int rowbase, int rmode, float* lds) {
    const int tid = threadIdx.x;
    for (int idx = tid; idx < 4096; idx += 512) { const int kk = idx >> 6, nn = idx & 63; const int n = n0 + nn;
        lds[kk * 65 + nn] = n < nvalid ? W[(size_t)(k0 + kk) * ldw + n] : 0.f; }
    __syncthreads();
    for (int idx = tid; idx < 1024; idx += 512) { const int nn = idx >> 4, k4 = (idx & 15) * 4; const int n = n0 + nn;
        int row = n;
        if (rmode) row = (n >> 7) * 256 + (n & 127) + (rmode == 2 ? 128 : 0);
        pg8::u32x2v w; w.x = pg8::cvt_pk_bf16(lds[(k4 + 0) * 65 + nn], lds[(k4 + 1) * 65 + nn]); w.y = pg8::cvt_pk_bf16(lds[(k4 + 2) * 65 + nn], lds[(k4 + 3) * 65 + nn]);
        *(pg8::u32x2v*)(Wt + (size_t)(rowbase + row) * D_MODEL + k0 + k4) = w; }
    __syncthreads();
}
__device__ __forceinline__ void ph_convert(const Params& p, float* lds) {
    constexpr int KT = D_MODEL / 64;
    constexpr int T_IN = KT * (LDP / 64), T_OUT = KT * (D_MODEL / 64), T_E = KT * (D_MODEL / 64);
    constexpr int PER_L = T_IN + T_OUT + NE * 3 * T_E, TOTAL = DEPTH * PER_L;
    for (int t = blockIdx.x; t < TOTAL; t += gridDim.x) {
        const int l = t / PER_L; int r = t % PER_L;
        if (r < T_IN) { const int kt = r % KT, nt = r / KT;
            cvt_tile(p.w_in + (size_t)l * D_MODEL * N_IN, N_IN, N_IN, kt * 64, nt * 64, p.wt_in + (size_t)l * LDP * D_MODEL, 0, 0, lds); continue; }
        r -= T_IN;
        if (r < T_OUT) { const int kt = r % KT, nt = r / KT;
            cvt_tile(p.w_out + (size_t)l * D_MODEL * D_MODEL, D_MODEL, D_MODEL, kt * 64, nt * 64, p.wt_out + (size_t)l * D_MODEL * D_MODEL, 0, 0, lds); continue; }
        r -= T_OUT;
        const int e = r / (3 * T_E), which = (r / T_E) % 3, q = r % T_E, kt = q % KT, nt = q / KT;
        const size_t eo = ((size_t)l * NE + e) * D_MODEL * D_MODEL;
        if (which == 0) cvt_tile(p.w_exp1 + eo, D_MODEL, D_MODEL, kt * 64, nt * 64, p.w13t + 2 * eo, 0, 1, lds);
        else if (which == 1) cvt_tile(p.w_exp3 + eo, D_MODEL, D_MODEL, kt * 64, nt * 64, p.w13t + 2 * eo, 0, 2, lds);
        else cvt_tile(p.w_exp2 + eo, D_MODEL, D_MODEL, kt * 64, nt * 64, p.w2t + eo, 0, 0, lds);
    }
}

constexpr int LDS_BYTES = 147456;
constexpr int LDS_MISC = 131072;
constexpr int NPL = 15;
constexpr int NPHASE = 2 + DEPTH * NPL + 1;

struct Args { Params p; int ph_lo, ph_hi; };

template <int G> __device__ __forceinline__ Exec mk_exec() { const int gt = blockIdx.x * 512 + threadIdx.x; return Exec{gt / G, (int)(gridDim.x * 512) / G, gt % G}; }
typedef const __attribute__((address_space(4))) unsigned long long* kq_t;
__device__ __forceinline__ void load_params(Params& p, const __attribute__((address_space(4))) unsigned char* ka) {
    kq_t s = (kq_t)ka; unsigned long long* d = (unsigned long long*)&p;
#pragma unroll
    for (int i = 0; i < (int)(sizeof(Params) / 8); ++i) d[i] = s[i];
}
#define LOADP() Params p; load_params(p, ka)
#define PH(k, ...) do { if (lo <= (k) && (k) < hi) { { LOADP(); __VA_ARGS__; } if ((k) + 1 < hi) xcd_barrier(bar); } } while (0)
#define e1 mk_exec<1>()
#define e16 mk_exec<16>()
#define e64 mk_exec<64>()
#define flds ((float*)lds)
#define glds ((PG8_LAS unsigned char*)lds)
#define G ((int)gridDim.x)
#define c ((int)blockIdx.x)
template <int L> __device__ __forceinline__ void layer_phases(const __attribute__((address_space(4))) unsigned char* ka, int lo, int hi, const XcdBarrier& bar, unsigned char* lds) {
    constexpr int l = L;
        const int b0 = 2 + l * NPL; const bool last = (l == DEPTH - 1);
        PH(b0 + 0, ph_norm1<64>(p, l, e64));
        PH(b0 + 1, { pg8::Gemm g{p.h, p.wt_in + (size_t)l * LDP * D_MODEL, MROWS, LDP, D_MODEL}; pg8::StaticOrder S; S.init(MROWS, LDP, G, c);
                     pg8::EpiF32 E{p.P, LDP}; pg8::gemm_phase<pg8::EpiF32, pg8::StaticOrder>(glds, g, S, E); });
        PH(b0 + 2, ph_rw_prep1<64>(p, l, e64); ph_ml_g1<64>(p, l, e64); ph_gd_prep<64>(p, l, e64); ph_gd_gates<64>(p, l, e64); ph_at_prep<64>(p, l, e64));
        PH(b0 + 3, ph_rw_prep2<64>(p, l, e64); ph_ml_g2(p, e1); ph_gd_c1(p, e64));
        PH(b0 + 4, { for (int u = c; u < RW_CN; u += G) ph_rw_c1_unit(p, u, threadIdx.x, 512, lds); for (int u = G - 1 - c; u < ML_CN; u += G) ph_ml_c1_unit(p, u, threadIdx.x, 512, lds); });
        PH(b0 + 5, { for (int u = c; u < (RW_CN + TS_G - 1) / TS_G; u += G) ph_tsolve_unit(p.rw_Ma, p.rw_T, RW_CN, u, threadIdx.x, 512, lds);
                     for (int u = G - 1 - c; u < (GD_CN + TS_G - 1) / TS_G; u += G) ph_tsolve_unit(p.gd_A, p.gd_T, GD_CN, u, threadIdx.x, 512, lds); });
        PH(b0 + 6, {
            const int nlat = BATCH * AT_QH * (SEQ / 256), nctx = last ? 0 : BATCH * AT_QH;
            if (c < nlat) { const int u = c;
                const int qb = u % (SEQ / 256), hq = (u / (SEQ / 256)) % AT_QH, b = u / ((SEQ / 256) * AT_QH), s0 = CTX + qb * 256, kvh = hq / (AT_QH / AT_KVH);
                att::attn_dense_body((const att::bf16*)p.at_q + (((size_t)b * AT_QH + hq) * TOK + s0) * AT_HEAD,
                                     (const att::bf16*)p.at_k + ((size_t)b * AT_KVH + kvh) * TOK * AT_HEAD, (const att::bf16*)p.at_v + ((size_t)b * AT_KVH + kvh) * TOK * AT_HEAD,
                                     p.mix + ((size_t)b * TOK + s0) * D_MODEL + 3 * GROUP_W + hq * AT_HEAD, TOK, (char*)lds);
                __syncthreads(); }
            if (c >= G - nctx) { const int u = c - (G - nctx);
                const int hq = u % AT_QH, b = u / AT_QH, kvh = hq / (AT_QH / AT_KVH);
                att::attn_dense_body((const att::bf16*)p.at_q + (((size_t)b * AT_QH + hq) * TOK) * AT_HEAD,
                                     (const att::bf16*)p.at_k + ((size_t)b * AT_KVH + kvh) * TOK * AT_HEAD, (const att::bf16*)p.at_v + ((size_t)b * AT_KVH + kvh) * TOK * AT_HEAD,
                                     p.mix + ((size_t)b * TOK) * D_MODEL + 3 * GROUP_W + hq * AT_HEAD, CTX, (char*)lds);
                __syncthreads(); }
            for (int u = c; u < RW_CN; u += G) ph_rw_c3_unit(p, u, threadIdx.x, 512, lds);
            for (int u = G - 1 - c; u < GD_CN; u += G) ph_gd_c3_unit(p, u, threadIdx.x, 512, lds);
            ph_ml_prefix(p, e1); });
        PH(b0 + 7, { for (int u = c; u < GD_S2_UNITS; u += G) ph_gd_scan2_unit(p, u, threadIdx.x, 512, lds); }
                   { for (int u = G - 1 - c; u < RW_CH; u += G) ph_rw_scan2_unit(p, u, threadIdx.x, 512, lds); }
                   { for (int u = c - GD_S2_UNITS; u < ML_CN; u += G - GD_S2_UNITS - RW_CH) if (u >= 0 && c < G - RW_CH) ph_ml_c2_unit(p, u, threadIdx.x, 512, lds); });
        PH(b0 + 8, ph_rw_post<64>(p, l, e64); ph_gd_post<64>(p, l, e64); ph_ml_post<64>(p, l, e64));
        PH(b0 + 9, { pg8::Gemm g{p.mix, p.wt_out + (size_t)l * D_MODEL * D_MODEL, MROWS, D_MODEL, D_MODEL}; pg8::TileOrder S;
                      S.init(last ? BATCH * SEQ / 256 : MROWS / 256, D_MODEL / 256, G, c, last ? 1 : 0);
                      pg8::EpiResid E{p.xres, p.mod + (size_t)l * 3 * 6 * D_MODEL}; pg8::gemm_phase<pg8::EpiResid, pg8::TileOrder>(glds, g, S, E); });
        PH(b0 + 10, ph_norm2<64>(p, l, e64));
        PH(b0 + 11, { for (int u = c; u < topk_units(l); u += G) ph_topk_unit(p, l, u, threadIdx.x, 512, lds); });
        PH(b0 + 12, ph_gather<64>(p, l, e64));
        PH(b0 + 13, { pg8::Gemm g{p.xs, p.w13t + (size_t)l * NE * 2 * D_MODEL * D_MODEL, NE * NSLOT, NE * 2 * D_MODEL, D_MODEL}; pg8::GroupedOrder S;
                      S.init(last ? NSLOT_L / 256 : NSLOT / 256, 2 * D_MODEL / 256, NSLOT / 256, G, c);
                      pg8::EpiSwiGLU E{p.hid, 2 * D_MODEL / 256}; pg8::gemm_phase<pg8::EpiSwiGLU, pg8::GroupedOrder>(glds, g, S, E); });
        PH(b0 + 14, { pg8::Gemm g{p.hid, p.w2t + (size_t)l * NE * D_MODEL * D_MODEL, NE * NSLOT, NE * D_MODEL, D_MODEL}; pg8::GroupedOrder S;
                      S.init(last ? NSLOT_L / 256 : NSLOT / 256, D_MODEL / 256, NSLOT / 256, G, c);
                      pg8::EpiGate E{p.yexp, p.sel_gate, D_MODEL / 256}; pg8::gemm_phase<pg8::EpiGate, pg8::GroupedOrder>(glds, g, S, E); });
    }
__global__ void __launch_bounds__(512, 2) mega(Args args) {
    extern __shared__ __attribute__((aligned(16))) unsigned char lds[];
    typedef const __attribute__((address_space(4))) unsigned char* kptr_t;
    const kptr_t ka = (kptr_t)__builtin_amdgcn_kernarg_segment_ptr();
    (void)args;
    const unsigned long long lohi = ((kq_t)ka)[sizeof(Params) / 8]; const int lo = (int)(unsigned)lohi, hi = (int)(unsigned)(lohi >> 32);
    unsigned* barw = (unsigned*)((kq_t)ka)[offsetof(Params, bar) / 8];
    volatile LAS unsigned* misc = (volatile LAS unsigned*)((LAS unsigned char*)lds + LDS_MISC);
    if (threadIdx.x < 4) misc[threadIdx.x] = 0u;
    __syncthreads();
    const bool use_bar = (hi - lo) > 1;
    XcdBarrier bar; bar.bar = barw; bar.x = 0; bar.st = misc;
    if (use_bar) bar = xcd_barrier_post(barw, misc);
    PH(0, ph_convert(p, flds); ph_mod_partial(p, e1));
    PH(1, ph_mod_final(p, e1));
    layer_phases<0>(ka, lo, hi, bar, lds);
    layer_phases<1>(ka, lo, hi, bar, lds);
    static_assert(DEPTH == 2, "depth");
    PH(2 + DEPTH * NPL, ph_final<64>(p, e64));
}
#undef PH
#undef e1
#undef e16
#undef e64
#undef flds
#undef glds
#undef G
#undef c
#undef LOADP

static size_t ws_carve(Params& p, unsigned char* ws) {
    size_t off = 0;
    auto take = [&](size_t bytes) { size_t o = off; off += (bytes + 255) / 256 * 256; return ws ? ws + o : (unsigned char*)nullptr; };
    p.bar = (unsigned*)take(XCD_BAR_WORDS * 4);
    p.modp = (float*)take((size_t)DEPTH * MOD_KS * 3 * 6 * D_MODEL * 4); p.mod = (float*)take((size_t)DEPTH * 3 * 6 * D_MODEL * 4);
    p.wt_in = (u16*)take((size_t)DEPTH * LDP * D_MODEL * 2); p.wt_out = (u16*)take((size_t)DEPTH * D_MODEL * D_MODEL * 2);
    p.w13t = (u16*)take((size_t)DEPTH * NE * 2 * D_MODEL * D_MODEL * 2); p.w2t = (u16*)take((size_t)DEPTH * NE * D_MODEL * D_MODEL * 2);
    p.xres = (float*)take((size_t)MROWS * D_MODEL * 4); p.h = (u16*)take((size_t)MROWS * D_MODEL * 2); p.mix = (u16*)take((size_t)MROWS * D_MODEL * 2);
    p.aff = (float*)take((size_t)MROWS * NE * 4); p.inv = (int*)take((size_t)MROWS * NE * 4);
    p.sel_row = (int*)take((size_t)NE * NSLOT * 4); p.sel_gate = (float*)take((size_t)NE * NSLOT * 4);
    const size_t region = off;
    p.P = (float*)take((size_t)MROWS * LDP * 4);
    const size_t rg = (size_t)MROWS * GROUP_W * 4;
    p.rw_r = (float*)take(rg); p.rw_k = (float*)take(rg); p.rw_v = (float*)take(rg); p.rw_kk = (float*)take(rg); p.rw_g = (float*)take(rg);
    p.rw_lr = (float*)take((size_t)MROWS * RW_LR * 4);
    p.rw_ew = (float*)take(2 * rg); p.rw_kka = (float*)take(2 * rg); p.rw_kt = (float*)take(2 * rg); p.rw_y = (float*)take(2 * rg);
    p.rw_Ma = (float*)take((size_t)RW_CN * CHUNK * CHUNK * 4); p.rw_T = (float*)take((size_t)RW_CN * CHUNK * CHUNK * 4);
    p.rw_Psi = (float*)take((size_t)RW_CN * RW_N * RW_N * 4); p.rw_Y0 = p.rw_Ma;
    p.rw_PhiT = (u16*)take((size_t)RW_CN * RW_N * RW_N * 2); p.rw_Rh = (u16*)take((size_t)RW_CN * CHUNK * RW_N * 2);
    p.ml_bcum = (float*)take((size_t)ML_CH * TOK * 4); p.ml_g = (float*)take((size_t)ML_CH * TOK * 4); p.ml_gmax = (float*)take((size_t)ML_CH * TOK * 4);
    p.ml_bl = (float*)take((size_t)ML_CH * NCHUNK * 4); p.ml_gm = (float*)take((size_t)ML_CH * NCHUNK * 4); p.ml_min = (float*)take((size_t)ML_CH * NCHUNK * 4);
    p.ml_dC = (float*)take((size_t)ML_CH * NCHUNK * ML_HEAD * ML_HEAD * 4); p.ml_dn = (float*)take((size_t)ML_CH * NCHUNK * ML_HEAD * 4);
    p.ml_S = (float*)take((size_t)ML_CH * NCHUNK * CHUNK * CHUNK * 4); p.ml_hh = (float*)take(2 * rg);
    p.gd_q = (float*)take(rg); p.gd_k = (float*)take(rg); p.gd_v = (float*)take(rg);
    p.gd_gc = (float*)take((size_t)GD_CH * TOK * 4); p.gd_beta = (float*)take((size_t)GD_CH * TOK * 4);
    p.gd_A = (float*)take((size_t)GD_CN * CHUNK * CHUNK * 4); p.gd_T = (float*)take((size_t)GD_CN * CHUNK * CHUNK * 4);
    p.gd_Psi = (float*)take((size_t)GD_CN * GD_N * GD_N * 4); p.gd_O0 = (float*)take((size_t)GD_CN * CHUNK * GD_N * 4);
    p.gd_Phi = (u16*)take((size_t)GD_CN * GD_N * GD_N * 2); p.gd_Qh = (u16*)p.gd_A;
    p.gd_o = (float*)take(2 * rg);
    p.at_q = (u16*)take((size_t)BATCH * AT_QH * TOK * AT_HEAD * 2); p.at_k = (u16*)take((size_t)BATCH * AT_KVH * TOK * AT_HEAD * 2); p.at_v = (u16*)take((size_t)BATCH * AT_KVH * TOK * AT_HEAD * 2);
    const size_t end1 = off;
    off = region;
    p.xs = (u16*)take((size_t)NE * NSLOT * D_MODEL * 2); p.hid = (u16*)take((size_t)NE * NSLOT * D_MODEL * 2); p.yexp = (float*)take((size_t)NE * NSLOT * D_MODEL * 4);
    return end1 > off ? end1 : off;
}

#ifndef MK_PER_PHASE
#define MK_PER_PHASE 0
#endif
extern "C" void kernel_launch(void* const* d_in, const int* in_sizes, int n_in, void* d_out, int out_size, void* d_ws, size_t ws_size, hipStream_t stream) {
    static int grid = 0;
    if (grid == 0) {
        Params q{}; const size_t need = ws_carve(q, nullptr);
        if (n_in != 35 || out_size != BATCH * SEQ * D_MODEL || ws_size < need) {
            fprintf(stderr, "kernel_launch: expected 35 inputs, out %d, ws >= %zu; got n_in %d out %d ws %zu\n", BATCH * SEQ * D_MODEL, need, n_in, out_size, ws_size); grid = -1; return; }
        int dev = 0, cus = 0, per_cu = 0;
        if (hipGetDevice(&dev) != hipSuccess || hipDeviceGetAttribute(&cus, hipDeviceAttributeMultiprocessorCount, dev) != hipSuccess) { grid = -1; return; }
        if (hipFuncSetAttribute((const void*)mega, hipFuncAttributeMaxDynamicSharedMemorySize, LDS_BYTES) != hipSuccess) { fprintf(stderr, "kernel_launch: hipFuncSetAttribute failed\n"); grid = -1; return; }
        if (hipOccupancyMaxActiveBlocksPerMultiprocessor(&per_cu, (const void*)mega, 512, LDS_BYTES) != hipSuccess || per_cu < 1)
            fprintf(stderr, "kernel_launch: occupancy query reports %d workgroups per CU\n", per_cu);
        (void)hipGetLastError();
        if (cus < 160) { fprintf(stderr, "kernel_launch: needs >= 160 CUs\n"); grid = -1; return; }
        grid = cus;
    }
    if (grid < 0) return;
    Args a{};
    Params& p = a.p;
    const float** in = (const float**)&p;
    for (int i = 0; i < 35; ++i) in[i] = (const float*)d_in[i];
    p.out = (float*)d_out;
    (void)ws_carve(p, (unsigned char*)d_ws);
    (void)hipMemsetAsync(p.bar, 0, XCD_BAR_WORDS * 4, stream);
#if MK_PER_PHASE
    for (int k = 0; k < NPHASE; ++k) { a.ph_lo = k; a.ph_hi = k + 1; hipLaunchKernelGGL(mega, dim3(grid), dim3(512), LDS_BYTES, stream, a); }
#else
#ifdef MK_PROBE_K
    a.ph_lo = 0; a.ph_hi = MK_PROBE_K;
    hipLaunchKernelGGL(mega, dim3(grid), dim3(512), LDS_BYTES, stream, a);
    (void)hipMemsetAsync(p.bar, 0, XCD_BAR_WORDS * 4, stream);
#endif
    a.ph_lo = 0; a.ph_hi = NPHASE;
    hipLaunchKernelGGL(mega, dim3(grid), dim3(512), LDS_BYTES, stream, a);
#endif
    const hipError_t le = hipPeekAtLastError();
    if (le != hipSuccess) fprintf(stderr, "kernel_launch: launch failed: %s\n", hipGetErrorName(le));
}
```

```cpp
#include <hip/hip_runtime.h>

#ifndef CFG_D_MODEL
#define CFG_D_MODEL 2048
#define CFG_SEQ 4096
#define CFG_GRID_W 64
#define CFG_CTX 256
#define CFG_RW_HEAD 64
#define CFG_RW_DR 64
#define CFG_RW_IR 64
#define CFG_RW_GR 128
#define CFG_ML_HEAD 128
#define CFG_CHUNK 64
#define CFG_GD_HEAD 128
#define CFG_AT_HEAD 128
#define CFG_AT_KVH 2
#define CFG_NE 16
#endif

constexpr int D_MODEL = CFG_D_MODEL, BATCH = 2, SEQ = CFG_SEQ, DEPTH = 2, GRID_W = CFG_GRID_W, CTX = CFG_CTX;
constexpr int TOK = CTX + SEQ, MROWS = BATCH * TOK, GROUP_W = D_MODEL / 4;
constexpr int RW_HEAD = CFG_RW_HEAD, RW_HEADS = GROUP_W / RW_HEAD, RW_DR = CFG_RW_DR, RW_IR = CFG_RW_IR, RW_GR = CFG_RW_GR;
constexpr int RW_COLS = 3 * GROUP_W + RW_DR + RW_IR + RW_GR, RW_LR = RW_DR + RW_IR + RW_GR;
constexpr int ML_HEAD = CFG_ML_HEAD, ML_HEADS = GROUP_W / ML_HEAD, CHUNK = CFG_CHUNK, ML_COLS = 4 * GROUP_W + 4 * ML_HEADS;
constexpr int GD_HEAD = CFG_GD_HEAD, GD_HEADS = GROUP_W / GD_HEAD, GD_COLS = 4 * GROUP_W + 4 * GD_HEADS;
constexpr int AT_HEAD = CFG_AT_HEAD, AT_QH = GROUP_W / AT_HEAD, AT_KVH = CFG_AT_KVH, AT_COLS = (AT_QH + 2 * AT_KVH) * AT_HEAD;
constexpr int N_IN = RW_COLS + ML_COLS + GD_COLS + AT_COLS;
constexpr int RW_OFF = 0, ML_OFF = RW_COLS, GD_OFF = ML_OFF + ML_COLS, AT_OFF = GD_OFF + GD_COLS;
constexpr int LDP = (N_IN + 255) / 256 * 256;
constexpr int NE = CFG_NE, CAPL = 2 * SEQ / NE, CAPC = 2 * CTX / NE;
constexpr int NSLOT_L = BATCH * CAPL, NSLOT_C = BATCH * CAPC;
constexpr int NSLOT = (NSLOT_L + NSLOT_C + 255) / 256 * 256;
constexpr int NCHUNK = TOK / CHUNK, ML_CH = BATCH * ML_HEADS * 2, GD_CH = BATCH * GD_HEADS * 2, RW_CH = BATCH * RW_HEADS * 2;
constexpr float NORM_EPS = 1e-6f, RW_GN_EPS = 64e-5f, RW_DECAY_SCALE = 0.6065306597126334f;
static_assert(ML_HEADS == GD_HEADS, "heads");

typedef unsigned short u16;

#ifdef CPU_TEST
#include <cmath>
#include <cstdint>
#include <cstring>
#define HD inline
#else
#define HD __device__ __forceinline__
#endif

struct Params {
    const float *x, *c, *ctx, *c_ctx, *ada_w, *ada_b, *norm1_g, *norm2_g, *w_in, *w_out;
    const float *rw_mu, *rw_w0, *rw_w_up, *rw_a0, *rw_a_up, *rw_g_up, *rw_k_k, *rw_k_a, *rw_r_k, *rw_ln_w, *rw_ln_b;
    const float *ml_ib, *ml_fb, *ml_norm_g, *gd_conv, *gd_a_log, *gd_dt_bias, *gd_norm_g, *at_q_norm, *at_k_norm;
    const float *w_router, *w_exp1, *w_exp3, *w_exp2, *final_g;
    float* out;
    unsigned* bar;
    float *modp, *mod;
    u16 *wt_in, *wt_out, *w13t, *w2t;
    float* xres;
    u16* h;
    float* P;
    float *rw_r, *rw_k, *rw_v, *rw_lr, *rw_kk, *rw_g, *rw_ew, *rw_kka, *rw_kt, *rw_y;
    float *rw_Ma, *rw_T, *rw_Psi, *rw_Y0; u16 *rw_PhiT, *rw_Rh;
    float *ml_bcum, *ml_g, *ml_gmax, *ml_bl, *ml_gm, *ml_min, *ml_dC, *ml_dn, *ml_S, *ml_hh;
    float *gd_q, *gd_k, *gd_v, *gd_gc, *gd_beta, *gd_A, *gd_T, *gd_Psi, *gd_O0, *gd_o; u16 *gd_Phi, *gd_Qh;
    u16 *at_q, *at_k, *at_v;
    u16* mix;
    float* aff; int* inv;
    int* sel_row; float* sel_gate;
    u16 *xs, *hid; float* yexp;
};

struct Exec { int gid, ngroups, gl; };

template <int G> HD float group_sum(float v) {
#ifndef CPU_TEST
#pragma unroll
    for (int o = G / 2; o > 0; o >>= 1) v += __shfl_xor(v, o, 64);
#endif
    return v;
}
template <int G> HD float group_max(float v) {
#ifndef CPU_TEST
#pragma unroll
    for (int o = G / 2; o > 0; o >>= 1) v = fmaxf(v, __shfl_xor(v, o, 64));
#endif
    return v;
}

template <int G> HD float group_scan_sum(float v, int gl) {
#ifndef CPU_TEST
#pragma unroll
    for (int o = 1; o < G; o <<= 1) { const float t = __shfl_up(v, o, G); if (gl >= o) v += t; }
#endif
    (void)gl; return v;
}
template <int G> HD float group_scan_max(float v, int gl) {
#ifndef CPU_TEST
#pragma unroll
    for (int o = 1; o < G; o <<= 1) { const float t = __shfl_up(v, o, G); if (gl >= o) v = fmaxf(v, t); }
#endif
    (void)gl; return v;
}
template <int G> HD float group_last(float v) {
#ifndef CPU_TEST
    v = __shfl(v, G - 1, G);
#endif
    return v;
}

HD u16 f2bf(float f) { unsigned u; memcpy(&u, &f, 4); u += 0x7FFFu + ((u >> 16) & 1u); return (u16)(u >> 16); }
HD float bf2f(u16 b) { unsigned u = ((unsigned)b) << 16; float f; memcpy(&f, &u, 4); return f; }
HD float sigmoidf_(float x) { return 1.f / (1.f + expf(-x)); }
HD float siluf_(float x) { return x / (1.f + expf(-x)); }
HD float softplusf_(float x) { return x > 20.f ? x : log1pf(expf(x)); }
HD float logsigmoidf_(float x) { return x < 0.f ? x - log1pf(expf(x)) : -log1pf(expf(-x)); }

HD float bf_round(float f) { return bf2f(f2bf(f)); }
#ifndef CPU_TEST
typedef short mma_bf16x8 __attribute__((ext_vector_type(8)));
typedef float mma_f32x16 __attribute__((ext_vector_type(16)));
__device__ __forceinline__ unsigned mma_cvt_pk(float lo, float hi) { unsigned r; asm volatile("v_cvt_pk_bf16_f32 %0, %1, %2" : "=v"(r) : "v"(lo), "v"(hi)); return r; }
#endif
struct Frag {
#ifdef CPU_TEST
    float v[8];
    HD void ld_bf(const u16* p) { for (int j = 0; j < 8; ++j) v[j] = bf2f(p[j]); }
    HD void ld_f(const float* p) { for (int j = 0; j < 8; ++j) v[j] = bf_round(p[j]); }
    HD void ld_f_scaled(const float* p, float w) { for (int j = 0; j < 8; ++j) v[j] = bf_round(p[j] * w); }
    HD void set1(float x) { for (int j = 0; j < 8; ++j) v[j] = bf_round(x); }
    HD void neg() { for (int j = 0; j < 8; ++j) v[j] = -v[j]; }
#else
    typedef unsigned u4 __attribute__((ext_vector_type(4)));
    typedef float f4 __attribute__((ext_vector_type(4)));
    u4 raw;
    HD void ld_bf(const u16* p) { raw = *(const u4*)p; }
    HD void ld_f(const float* p) { const f4 a = *(const f4*)p, b = *(const f4*)(p + 4);
        raw.x = mma_cvt_pk(a.x, a.y); raw.y = mma_cvt_pk(a.z, a.w); raw.z = mma_cvt_pk(b.x, b.y); raw.w = mma_cvt_pk(b.z, b.w); }
    HD void ld_f_scaled(const float* p, float w) { const f4 a = *(const f4*)p * w, b = *(const f4*)(p + 4) * w;
        raw.x = mma_cvt_pk(a.x, a.y); raw.y = mma_cvt_pk(a.z, a.w); raw.z = mma_cvt_pk(b.x, b.y); raw.w = mma_cvt_pk(b.z, b.w); }
    HD void set1(float x) { const unsigned q = mma_cvt_pk(x, x); raw.x = q; raw.y = q; raw.z = q; raw.w = q; }
    HD void neg() { raw.x ^= 0x80008000u; raw.y ^= 0x80008000u; raw.z ^= 0x80008000u; raw.w ^= 0x80008000u; }
#endif
};
#ifdef CPU_TEST
constexpr int MMA_SLOTS = 1024;
#else
constexpr int MMA_SLOTS = 16;
#endif
template <int K, class FA, class FB, class FE> HD void wave_mma32(int lane, FA fa, FB fb, FE fe) {
    static_assert(K % 16 == 0, "K");
#ifdef CPU_TEST
    (void)lane;
    for (int m = 0; m < 32; ++m) for (int n = 0; n < 32; ++n) { float acc = 0.f;
        for (int k0 = 0; k0 < K; k0 += 8) { Frag a8, b8; fa(m, k0, a8); fb(n, k0, b8);
            for (int j = 0; j < 8; ++j) acc += a8.v[j] * b8.v[j]; }
        fe(m, n, acc, m * 32 + n); }
#else
    const int r = lane & 31, h = lane >> 5;
    mma_f32x16 acc;
#pragma unroll
    for (int q = 0; q < 16; ++q) acc[q] = 0.f;
#pragma unroll
    for (int k0 = 0; k0 < K; k0 += 16) { Frag a8, b8; fa(r, k0 + 8 * h, a8); fb(r, k0 + 8 * h, b8);
        acc = __builtin_amdgcn_mfma_f32_32x32x16_bf16(__builtin_bit_cast(mma_bf16x8, a8.raw), __builtin_bit_cast(mma_bf16x8, b8.raw), acc, 0, 0, 0); }
#pragma unroll
    for (int q = 0; q < 16; ++q) fe((q & 3) + 8 * (q >> 2) + 4 * h, r, acc[q], q);
#endif
}
#ifdef CPU_TEST
#define BLOCK_SYNC()
#define BLOCK_FOR(i, n) for (int i = 0; i < (n); ++i)
#define WAVE_FOR(w, n) for (int w = 0; w < (n); ++w)
#define LANE 0
#define OPAQUE_TID()
#else
#define BLOCK_SYNC() __syncthreads()
#define BLOCK_FOR(i, n) for (int i = tid; i < (n); i += nthr)
#define WAVE_FOR(w, n) _Pragma("unroll 1") for (int w = tid >> 6; w < (n); w += (nthr >> 6))
#define LANE (tid & 63)
#define OPAQUE_TID() asm volatile("" : "+v"(tid))
#endif

HD int row_b(int R) { return R / TOK; }
HD int row_s(int R) { return R % TOK; }
HD bool row_ctx(int R) { return row_s(R) < CTX; }
HD int mod_sel(int R) { return row_ctx(R) ? 2 : row_b(R); }
HD int seq_s(int d, int p) { return d == 0 ? p : (p < CTX ? CTX - 1 - p : TOK - 1 - (p - CTX)); }
HD const float* modv(const Params& p, int layer, int sel, int k) { return p.mod + ((size_t)(layer * 3 + sel) * 6 + k) * D_MODEL; }

constexpr int MOD_KS = 16;
HD void ph_mod_partial(const Params& p, Exec e) {
    const int n = DEPTH * MOD_KS * 6 * D_MODEL;
    for (int it = e.gid; it < n; it += e.ngroups) {
        const int col = it % (6 * D_MODEL), ks = (it / (6 * D_MODEL)) % MOD_KS, l = it / (6 * D_MODEL * MOD_KS);
        const float* w = p.ada_w + (size_t)l * D_MODEL * 6 * D_MODEL + col;
        float a0 = 0.f, a1 = 0.f, a2 = 0.f;
        const int k0 = ks * (D_MODEL / MOD_KS);
        for (int k = k0; k < k0 + D_MODEL / MOD_KS; ++k) {
            const float wv = w[(size_t)k * 6 * D_MODEL];
            a0 += siluf_(p.c[k]) * wv; a1 += siluf_(p.c[D_MODEL + k]) * wv; a2 += siluf_(p.c_ctx[k]) * wv;
        }
        float* o = p.modp + ((size_t)(l * MOD_KS + ks) * 3) * 6 * D_MODEL + col;
        o[0] = a0; o[6 * D_MODEL] = a1; o[2 * 6 * D_MODEL] = a2;
    }
}
HD void ph_mod_final(const Params& p, Exec e) {
    const int n = DEPTH * 3 * 6 * D_MODEL;
    for (int it = e.gid; it < n; it += e.ngroups) {
        const int col = it % (6 * D_MODEL), sel = (it / (6 * D_MODEL)) % 3, l = it / (6 * D_MODEL * 3);
        float a = p.ada_b[l * 6 * D_MODEL + col];
        for (int ks = 0; ks < MOD_KS; ++ks) a += p.modp[((size_t)(l * MOD_KS + ks) * 3 + sel) * 6 * D_MODEL + col];
        p.mod[(size_t)(l * 3 + sel) * 6 * D_MODEL + col] = a;
    }
}

HD float resid_in(const Params& p, int layer, int R, int c) {
    if (layer == 0) { const int b = row_b(R), s = row_s(R);
        return s < CTX ? p.ctx[((size_t)b * CTX + s) * D_MODEL + c] : p.x[((size_t)b * SEQ + (s - CTX)) * D_MODEL + c]; }
    float v = p.xres[(size_t)R * D_MODEL + c];
    const float m5 = modv(p, layer - 1, mod_sel(R), 5)[c];
    float acc = 0.f;
    for (int ex = 0; ex < NE; ++ex) { const int j = p.inv[(size_t)R * NE + ex]; if (j >= 0) acc += p.yexp[((size_t)ex * NSLOT + j) * D_MODEL + c]; }
    return v + m5 * acc;
}
template <int G> HD void ph_norm1(const Params& p, int layer, Exec e) {
    for (int R = e.gid; R < MROWS; R += e.ngroups) {
        float ss = 0.f;
        for (int c = e.gl; c < D_MODEL; c += G) { const float v = resid_in(p, layer, R, c); p.xres[(size_t)R * D_MODEL + c] = v; ss += v * v; }
        ss = group_sum<G>(ss);
        const float rstd = 1.f / sqrtf(ss / D_MODEL + NORM_EPS);
        const int sel = mod_sel(R); const float *m0 = modv(p, layer, sel, 0), *m1 = modv(p, layer, sel, 1), *g = p.norm1_g + layer * D_MODEL;
        for (int c = e.gl; c < D_MODEL; c += G) { const float v = p.xres[(size_t)R * D_MODEL + c];
            p.h[(size_t)R * D_MODEL + c] = f2bf(v * rstd * g[c] * (1.f + m1[c]) + m0[c]); }
    }
}
template <int G> HD void ph_final(const Params& p, Exec e) {
    for (int i = e.gid; i < BATCH * SEQ; i += e.ngroups) {
        const int b = i / SEQ, t = i % SEQ, R = b * TOK + CTX + t;
        float ss = 0.f;
        for (int c = e.gl; c < D_MODEL; c += G) { const float v = resid_in(p, DEPTH, R, c); ss += v * v; }
        ss = group_sum<G>(ss);
        const float rstd = 1.f / sqrtf(ss / D_MODEL + NORM_EPS);
        for (int c = e.gl; c < D_MODEL; c += G) p.out[(size_t)i * D_MODEL + c] = resid_in(p, DEPTH, R, c) * rstd * p.final_g[c];
    }
}
template <int G> HD void ph_norm2(const Params& p, int layer, Exec e) {
    const bool last = layer == DEPTH - 1;
    for (int R = e.gid; R < MROWS; R += e.ngroups) {
        if (last && row_ctx(R)) continue;
        float ss = 0.f;
        for (int c = e.gl; c < D_MODEL; c += G) { const float v = p.xres[(size_t)R * D_MODEL + c]; ss += v * v; }
        ss = group_sum<G>(ss);
        const float rstd = 1.f / sqrtf(ss / D_MODEL + NORM_EPS);
        const int sel = mod_sel(R); const float *m3 = modv(p, layer, sel, 3), *m4 = modv(p, layer, sel, 4), *g = p.norm2_g + layer * D_MODEL;
        const float* wr = p.w_router + (size_t)layer * D_MODEL * NE;
        float lg[NE];
#pragma unroll
        for (int ex = 0; ex < NE; ++ex) lg[ex] = 0.f;
        for (int c = e.gl; c < D_MODEL; c += G) { const float v = p.xres[(size_t)R * D_MODEL + c];
            const float hv = v * rstd * g[c] * (1.f + m4[c]) + m3[c];
            p.h[(size_t)R * D_MODEL + c] = f2bf(hv);
#pragma unroll
            for (int ex = 0; ex < NE; ++ex) lg[ex] += hv * wr[c * NE + ex]; }
        float mx = -1e30f;
#pragma unroll
        for (int ex = 0; ex < NE; ++ex) { lg[ex] = group_sum<G>(lg[ex]); mx = fmaxf(mx, lg[ex]); }
        float sum = 0.f;
#pragma unroll
        for (int ex = 0; ex < NE; ++ex) { lg[ex] = expf(lg[ex] - mx); sum += lg[ex]; }
        if (e.gl == 0) {
#pragma unroll
            for (int ex = 0; ex < NE; ++ex) p.aff[(size_t)R * NE + ex] = lg[ex] / sum; }
    }
}
constexpr int TK_PART = 512, TK_PARTS = (SEQ + TK_PART - 1) / TK_PART, TK_SMEM = (SEQ > CTX ? SEQ : CTX) * 4;
HD int topk_units(int layer) { return BATCH * NE * TK_PARTS + (layer == DEPTH - 1 ? 0 : BATCH * NE) + 1; }
HD void ph_topk_unit(const Params& p, int layer, int unit, int tid, int nthr, unsigned char* smem) {
    (void)tid; (void)nthr; OPAQUE_TID();
    const bool last = layer == DEPTH - 1;
    const int nl = BATCH * NE * TK_PARTS, nc = last ? 0 : BATCH * NE;
    float* col = (float*)smem;
    if (unit >= nl + nc) {
        const int per = NSLOT - NSLOT_L - (last ? 0 : NSLOT_C);
        BLOCK_FOR(q, NE * per) { const int ex = q / per, j = NSLOT - per + q % per; p.sel_row[ex * NSLOT + j] = 0; p.sel_gate[ex * NSLOT + j] = 0.f; }
        return; }
    int b, ex, L, base, cap, jbase, t0, t1;
    if (unit < nl) { const int part = unit % TK_PARTS; ex = (unit / TK_PARTS) % NE; b = unit / (TK_PARTS * NE); L = SEQ; base = b * TOK + CTX; cap = CAPL; jbase = b * CAPL;
        t0 = part * TK_PART; t1 = t0 + TK_PART < SEQ ? t0 + TK_PART : SEQ; }
    else { const int q = unit - nl; ex = q % NE; b = q / NE; L = CTX; base = b * TOK; cap = CAPC; jbase = NSLOT_L + b * CAPC; t0 = 0; t1 = CTX; }
    BLOCK_FOR(u, L) col[u] = p.aff[(size_t)(base + u) * NE + ex];
    BLOCK_SYNC();
    BLOCK_FOR(q, t1 - t0) { const int t = t0 + q; const float a = col[t]; int rank = 0;
        for (int u = 0; u < L; ++u) { const float au = col[u]; rank += (au > a || (au == a && u < t)) ? 1 : 0; }
        if (rank < cap) { const int j = jbase + rank; p.sel_row[ex * NSLOT + j] = base + t; p.sel_gate[ex * NSLOT + j] = a; p.inv[(size_t)(base + t) * NE + ex] = j; }
        else p.inv[(size_t)(base + t) * NE + ex] = -1; }
    BLOCK_SYNC();
}
template <int G> HD void ph_gather(const Params& p, int layer, Exec e) {
    const bool last = layer == DEPTH - 1;
    const int nj = last ? NSLOT_L : NSLOT;
    for (int it = e.gid; it < NE * nj; it += e.ngroups) {
        const int ex = it / nj, j = it % nj, R = p.sel_row[ex * NSLOT + j];
        const uint4* s = (const uint4*)(p.h + (size_t)R * D_MODEL); uint4* d = (uint4*)(p.xs + ((size_t)ex * NSLOT + j) * D_MODEL);
        for (int c = e.gl; c < D_MODEL / 8; c += G) d[c] = s[c];
    }
}

template <int G> HD void ph_rw_prep1(const Params& p, int layer, Exec e) {
    const float* mu = p.rw_mu + (size_t)layer * 2 * RW_COLS;
    for (int R = e.gid; R < MROWS; R += e.ngroups) {
        const int s = row_s(R); const bool hp = (s != 0 && s != CTX), hn = (s != CTX - 1 && s != TOK - 1);
        const float* pr = p.P + (size_t)R * LDP + RW_OFF;
        for (int c = e.gl; c < RW_COLS; c += G) {
            const float v = pr[c], pv = hp ? pr[c - LDP] : 0.f, nv = hn ? pr[c + LDP] : 0.f;
            const float pp = v + mu[c] * (pv - v) + mu[RW_COLS + c] * (nv - v);
            if (c < GROUP_W) p.rw_r[(size_t)R * GROUP_W + c] = pp;
            else if (c < 2 * GROUP_W) p.rw_k[(size_t)R * GROUP_W + c - GROUP_W] = pp;
            else if (c < 3 * GROUP_W) p.rw_v[(size_t)R * GROUP_W + c - 2 * GROUP_W] = pp;
            else { const int q = c - 3 * GROUP_W; float o;
                if (q < RW_DR) o = tanhf(pp); else if (q < RW_DR + RW_IR) o = pp; else o = sigmoidf_(pp);
                p.rw_lr[(size_t)R * RW_LR + q] = o; }
        }
    }
}
template <int G> HD void ph_rw_prep2(const Params& p, int layer, Exec e) {
    static_assert(G <= RW_HEAD, "G");
    const float *gup = p.rw_g_up + (size_t)layer * RW_GR * GROUP_W, *kk_w = p.rw_k_k + layer * GROUP_W, *ka_w = p.rw_k_a + layer * GROUP_W;
    for (int R = e.gid; R < MROWS; R += e.ngroups) {
        const float* lr = p.rw_lr + (size_t)R * RW_LR; const float* kr = p.rw_k + (size_t)R * GROUP_W;
        for (int hh = 0; hh < RW_HEADS; ++hh) {
            float ss = 0.f;
            for (int j = hh * RW_HEAD + e.gl; j < (hh + 1) * RW_HEAD; j += G) { const float xk = kr[j] * kk_w[j]; ss += xk * xk; }
            ss = group_sum<G>(ss);
            const float rn = 1.f / sqrtf(ss + 1e-6f);
            for (int j = hh * RW_HEAD + e.gl; j < (hh + 1) * RW_HEAD; j += G) {
                const float kv = kr[j], kkv = kv * kk_w[j] * rn;
                p.rw_kk[(size_t)R * GROUP_W + j] = kkv;
                float g = 0.f;
                for (int i = 0; i < RW_GR; ++i) g += lr[RW_DR + RW_IR + i] * gup[i * GROUP_W + j];
                p.rw_g[(size_t)R * GROUP_W + j] = g;
                for (int d = 0; d < 2; ++d) {
                    const float *wup = p.rw_w_up + ((size_t)(layer * 2 + d) * RW_DR) * GROUP_W, *aup = p.rw_a_up + ((size_t)(layer * 2 + d) * RW_IR) * GROUP_W;
                    float wl = p.rw_w0[(layer * 2 + d) * GROUP_W + j], al = p.rw_a0[(layer * 2 + d) * GROUP_W + j];
                    for (int i = 0; i < RW_DR; ++i) wl += lr[i] * wup[i * GROUP_W + j];
                    for (int i = 0; i < RW_IR; ++i) al += lr[RW_DR + i] * aup[i * GROUP_W + j];
                    const float logw = -RW_DECAY_SCALE * sigmoidf_(wl), a = sigmoidf_(al);
                    const size_t o = ((size_t)d * MROWS + R) * GROUP_W + j;
                    p.rw_ew[o] = logw; p.rw_kka[o] = kkv * a; p.rw_kt[o] = kv * (1.f + (a - 1.f) * ka_w[j]);
                }
            }
        }
    }
}
template <int G> HD void ph_rw_scan(const Params& p, Exec e) {
    constexpr int KPL = RW_HEAD / G;
    for (int it = e.gid; it < RW_CH * RW_HEAD; it += e.ngroups) {
        const int i = it % RW_HEAD, ch = it / RW_HEAD, d = ch % 2, hh = (ch / 2) % RW_HEADS, b = ch / (2 * RW_HEADS);
        float S[KPL];
#pragma unroll
        for (int q = 0; q < KPL; ++q) S[q] = 0.f;
        const int k0 = hh * RW_HEAD + e.gl * KPL;
        for (int pos = 0; pos < TOK; ++pos) {
            const int R = b * TOK + seq_s(d, pos);
            const size_t o1 = (size_t)R * GROUP_W + k0, o2 = ((size_t)d * MROWS + R) * GROUP_W + k0;
            const float vv = p.rw_v[(size_t)R * GROUP_W + hh * RW_HEAD + i];
            float sk = 0.f;
#pragma unroll
            for (int q = 0; q < KPL; ++q) sk += S[q] * p.rw_kk[o1 + q];
            sk = group_sum<G>(sk);
            float y = 0.f;
#pragma unroll
            for (int q = 0; q < KPL; ++q) { S[q] = S[q] * p.rw_ew[o2 + q] - sk * p.rw_kka[o2 + q] + vv * p.rw_kt[o2 + q]; y += S[q] * p.rw_r[o1 + q]; }
            y = group_sum<G>(y);
            if (e.gl == 0) p.rw_y[((size_t)d * MROWS + R) * GROUP_W + hh * RW_HEAD + i] = y;
        }
    }
}

constexpr int RW_N = RW_HEAD, RW_CN = RW_CH * NCHUNK;
constexpr int LDPAD = 8;
static_assert(CHUNK % 32 == 0 && RW_HEAD % 32 == 0, "tile sizes");
HD void rw_chain(int ch, int& b, int& hh, int& d) { d = ch % 2; hh = (ch / 2) % RW_HEADS; b = ch / (2 * RW_HEADS); }
constexpr int RW_C1_SMEM = CHUNK * RW_N * 4 + 2 * CHUNK * (RW_N + LDPAD) * 2;
HD void ph_rw_c1_unit(const Params& p, int cn, int tid, int nthr, unsigned char* smem) {
    (void)tid; (void)nthr; OPAQUE_TID();
    constexpr int C = CHUNK, N = RW_N, LD = N + LDPAD;
    const int ch = cn / NCHUNK, n = cn % NCHUNK; int b, hh, d; rw_chain(ch, b, hh, d);
    float* cum = (float*)smem; u16* KKt = (u16*)(cum + C * N); u16* At = KKt + C * LD;
    const size_t dofs = (size_t)d * MROWS * GROUP_W;
    BLOCK_FOR(idx, C * N) { const int t = idx / N, k = idx % N, R = b * TOK + seq_s(d, n * C + t); cum[idx] = p.rw_ew[dofs + (size_t)R * GROUP_W + hh * N + k]; }
    BLOCK_SYNC();
    BLOCK_FOR(k, N) { float acc = 0.f; for (int t = 0; t < C; ++t) { acc += cum[t * N + k]; cum[t * N + k] = acc; } }
    BLOCK_SYNC();
    BLOCK_FOR(idx, C * N) { const int t = idx / N, k = idx % N, R = b * TOK + seq_s(d, n * C + t); const size_t o = (size_t)R * GROUP_W + hh * N + k;
        const float cu = cum[idx], cp = cu - p.rw_ew[dofs + o];
        KKt[t * LD + k] = f2bf(p.rw_kk[o] * expf(cp)); At[t * LD + k] = f2bf(p.rw_kka[dofs + o] * expf(-cu)); }
    BLOCK_SYNC();
    float* Ma = p.rw_Ma + (size_t)cn * C * C;
    WAVE_FOR(w, (C / 32) * (C / 32)) { const int tm = w / (C / 32), tn = w % (C / 32);
        wave_mma32<N>(LANE, [&](int m, int k0, Frag& o) { o.ld_bf(KKt + (tm * 32 + m) * LD + k0); },
                            [&](int nn, int k0, Frag& o) { o.ld_bf(At + (tn * 32 + nn) * LD + k0); },
                            [&](int m, int nn, float acc, int) { const int t = tm * 32 + m, sx = tn * 32 + nn; Ma[t * C + sx] = sx < t ? acc : 0.f; }); }
    BLOCK_SYNC();
}
constexpr int TS_G = 8, TS_SMEM = TS_G * CHUNK * CHUNK * 4;
HD void ph_tsolve_unit(const float* Mall, float* Tall, int nprob, int unit, int tid, int nthr, unsigned char* smem) {
    (void)tid; (void)nthr; OPAQUE_TID();
    constexpr int C = CHUNK;
    float* Tl = (float*)smem;
    const int p0 = unit * TS_G, np = (nprob - p0) < TS_G ? (nprob - p0) : TS_G;
    BLOCK_FOR(i, np * C * C / 4) ((uint4*)Tl)[i] = ((const uint4*)(Mall + (size_t)p0 * C * C))[i];
    BLOCK_SYNC();
    BLOCK_FOR(idx, TS_G * C) { const int w = idx / C, j = idx % C;
        if (w < np) { float* Tc = Tl + w * C * C;
            for (int t = 0; t < C; ++t) { float acc = 0.f;
                if (t == j) acc = 1.f;
                else if (t > j) { for (int sx = j; sx < t; ++sx) acc -= Tc[t * C + sx] * Tc[sx * C + j]; }
                Tc[t * C + j] = acc; } } }
    BLOCK_SYNC();
    BLOCK_FOR(i, np * C * C / 4) ((uint4*)(Tall + (size_t)p0 * C * C))[i] = ((const uint4*)Tl)[i];
    BLOCK_SYNC();
}
constexpr int RW_C3_SMEM = 2 * CHUNK * (RW_N + LDPAD) * 2 + 13 * CHUNK * (RW_N + LDPAD) * 2 + RW_N * 4;
HD void ph_rw_c3_unit(const Params& p, int cn, int tid, int nthr, unsigned char* smem) {
    (void)tid; (void)nthr; OPAQUE_TID();
    constexpr int C = CHUNK, N = RW_N, CN = C * N, LD = N + LDPAD, CL = C * LD;
    static_assert(2 * CL * 2 >= CN * 4, "cum region");
    static_assert(C == N, "c3 buffer aliasing assumes C == N");
    const int ch = cn / NCHUNK, n = cn % NCHUNK; int b, hh, d; rw_chain(ch, b, hh, d);
    float* cum = (float*)smem; u16* mb = (u16*)smem + 2 * CL;
    u16 *KKt = mb, *KKtT = mb + CL, *At = mb + 2 * CL, *KTt = mb + 3 * CL, *Rt = mb + 4 * CL, *ApT = mb + 5 * CL, *KTpT = mb + 6 * CL, *VT = mb + 7 * CL,
        *Tb = mb + 8 * CL, *MkT = mb + 9 * CL, *ZT = mb + 10 * CL, *Na = mb + 11 * CL, *Nk = mb + 12 * CL;
    float* PC = (float*)(mb + 13 * CL);
    u16 *Gm = (u16*)cum, *KKhT = (u16*)cum + CL;
    const size_t dofs = (size_t)d * MROWS * GROUP_W;
    BLOCK_FOR(idx, C * N) { const int t = idx / N, k = idx % N, R = b * TOK + seq_s(d, n * C + t); cum[idx] = p.rw_ew[dofs + (size_t)R * GROUP_W + hh * N + k]; }
    BLOCK_SYNC();
    BLOCK_FOR(k, N) { float acc = 0.f; for (int t = 0; t < C; ++t) { acc += cum[t * N + k]; cum[t * N + k] = acc; } PC[k] = expf(acc); }
    BLOCK_SYNC();
    BLOCK_FOR(idx, CN) { const int t = idx / N, k = idx % N, R = b * TOK + seq_s(d, n * C + t); const size_t o = (size_t)R * GROUP_W + hh * N + k;
        const float cu = cum[idx], cp = cu - p.rw_ew[dofs + o], cC = cum[(C - 1) * N + k];
        const float kkv = p.rw_kk[o], kav = p.rw_kka[dofs + o], ktv = p.rw_kt[dofs + o];
        const float e_m = expf(-cu), e_c = expf(cC - cu);
        const u16 kkt = f2bf(kkv * expf(cp));
        KKt[t * LD + k] = kkt; KKtT[k * LD + t] = kkt; At[t * LD + k] = f2bf(kav * e_m); KTt[t * LD + k] = f2bf(ktv * e_m); Rt[t * LD + k] = f2bf(p.rw_r[o] * expf(cu));
        ApT[k * LD + t] = f2bf(kav * e_c); KTpT[k * LD + t] = f2bf(ktv * e_c); VT[k * LD + t] = f2bf(p.rw_v[o]); }
    BLOCK_FOR(idx, C * C) Tb[(idx / C) * LD + idx % C] = f2bf(p.rw_T[(size_t)cn * C * C + idx]);
    BLOCK_SYNC();
    constexpr int TC = C / 32, TN = N / 32;
    WAVE_FOR(w, 3 * TC * TC) { const int which = w / (TC * TC), tm = (w / TC) % TC, tn = w % TC;
        const u16* Am = which == 0 ? KTt : Rt; const u16* Bm = which == 0 ? KKt : (which == 1 ? At : KTt); u16* Om = which == 0 ? MkT : (which == 1 ? Na : Nk);
        wave_mma32<N>(LANE, [&](int m, int k0, Frag& o) { o.ld_bf(Am + (tm * 32 + m) * LD + k0); },
                            [&](int nn, int k0, Frag& o) { o.ld_bf(Bm + (tn * 32 + nn) * LD + k0); },
                            [&](int m, int nn, float acc, int) { const int r = tm * 32 + m, cc = tn * 32 + nn; const bool keep = which == 0 ? (cc > r) : (cc <= r);
                                Om[r * LD + cc] = f2bf(keep ? acc : 0.f); }); }
    BLOCK_SYNC();
    WAVE_FOR(w, TC * TC + TN * TC) {
        if (w < TC * TC) { const int tm = w / TC, tn = w % TC;
            wave_mma32<C>(LANE, [&](int m, int k0, Frag& o) { o.ld_bf(Tb + (tm * 32 + m) * LD + k0); },
                                [&](int nn, int k0, Frag& o) { o.ld_bf(MkT + (tn * 32 + nn) * LD + k0); },
                                [&](int m, int nn, float acc, int) { Gm[(tm * 32 + m) * LD + tn * 32 + nn] = f2bf(acc); }); }
        else { const int q = w - TC * TC, tm = q / TC, tn = q % TC;
            wave_mma32<C>(LANE, [&](int m, int k0, Frag& o) { o.ld_bf(KKtT + (tm * 32 + m) * LD + k0); },
                                [&](int nn, int k0, Frag& o) { o.ld_bf(Tb + (tn * 32 + nn) * LD + k0); },
                                [&](int m, int nn, float acc, int) { KKhT[(tm * 32 + m) * LD + tn * 32 + nn] = f2bf(acc); }); } }
    BLOCK_SYNC();
    u16* RhG = p.rw_Rh + (size_t)cn * CN; u16* PhiTG = p.rw_PhiT + (size_t)cn * N * N;
    WAVE_FOR(w, TN * TC + TC * TN + TN * TN) {
        if (w < TN * TC) { const int tm = w / TC, tn = w % TC;
            wave_mma32<C>(LANE, [&](int m, int k0, Frag& o) { o.ld_bf(VT + (tm * 32 + m) * LD + k0); },
                                [&](int nn, int k0, Frag& o) { o.ld_bf(Gm + (tn * 32 + nn) * LD + k0); },
                                [&](int m, int nn, float acc, int) { ZT[(tm * 32 + m) * LD + tn * 32 + nn] = f2bf(acc); }); }
        else if (w < TN * TC + TC * TN) { const int q = w - TN * TC, tm = q / TN, tn = q % TN;
            wave_mma32<C>(LANE, [&](int m, int k0, Frag& o) { o.ld_bf(Na + (tm * 32 + m) * LD + k0); },
                                [&](int nn, int k0, Frag& o) { o.ld_bf(KKhT + (tn * 32 + nn) * LD + k0); },
                                [&](int m, int nn, float acc, int) { const int t = tm * 32 + m, k = tn * 32 + nn; RhG[t * N + k] = f2bf(bf2f(Rt[t * LD + k]) - acc); }); }
        else { const int q = w - TN * TC - TC * TN, tm = q / TN, tn = q % TN;
            wave_mma32<C>(LANE, [&](int m, int k0, Frag& o) { o.ld_bf(ApT + (tm * 32 + m) * LD + k0); },
                                [&](int nn, int k0, Frag& o) { o.ld_bf(KKhT + (tn * 32 + nn) * LD + k0); },
                                [&](int m, int nn, float acc, int) { const int k = tm * 32 + m, k2 = tn * 32 + nn; PhiTG[k * N + k2] = f2bf((k == k2 ? PC[k] : 0.f) - acc); }); } }
    BLOCK_SYNC();
    float* Y0G = p.rw_Y0 + (size_t)cn * CN; float* PsiG = p.rw_Psi + (size_t)cn * N * N;
    WAVE_FOR(w, TC * TN + TN * TN) {
        if (w < TC * TN) { const int tm = w / TN, tn = w % TN;
            wave_mma32<2 * C>(LANE, [&](int m, int k0, Frag& o) { if (k0 < C) o.ld_bf(Nk + (tm * 32 + m) * LD + k0); else { o.ld_bf(Na + (tm * 32 + m) * LD + k0 - C); o.neg(); } },
                                    [&](int nn, int k0, Frag& o) { if (k0 < C) o.ld_bf(VT + (tn * 32 + nn) * LD + k0); else o.ld_bf(ZT + (tn * 32 + nn) * LD + k0 - C); },
                                    [&](int m, int nn, float acc, int) { Y0G[(tm * 32 + m) * N + tn * 32 + nn] = acc; }); }
        else { const int q = w - TC * TN, tm = q / TN, tn = q % TN;
            wave_mma32<2 * C>(LANE, [&](int m, int k0, Frag& o) { if (k0 < C) o.ld_bf(VT + (tm * 32 + m) * LD + k0); else { o.ld_bf(ZT + (tm * 32 + m) * LD + k0 - C); o.neg(); } },
                                    [&](int nn, int k0, Frag& o) { if (k0 < C) o.ld_bf(KTpT + (tn * 32 + nn) * LD + k0); else o.ld_bf(ApT + (tn * 32 + nn) * LD + k0 - C); },
                                    [&](int m, int nn, float acc, int) { PsiG[(tm * 32 + m) * N + tn * 32 + nn] = acc; }); } }
    BLOCK_SYNC();
}
constexpr int RW_S2_SMEM = (3 * RW_N + CHUNK) * (RW_N + LDPAD) * 2 + RW_N * RW_N * 4 + CHUNK * RW_N * 4;
HD void ph_rw_scan2_unit(const Params& p, int ch, int tid, int nthr, unsigned char* smem) {
    (void)tid; (void)nthr; OPAQUE_TID();
    constexpr int C = CHUNK, N = RW_N, TC = C / 32, TN = N / 32, LD = N + LDPAD;
    int b, hh, d; rw_chain(ch, b, hh, d);
    u16* Sb = (u16*)smem; u16* PhiT = Sb + 2 * N * LD; u16* Rh = PhiT + N * LD; float* Psi = (float*)(Rh + C * LD); float* Y0 = Psi + N * N;
    BLOCK_FOR(i, N * LD) Sb[i] = 0;
    for (int n = 0; n < NCHUNK; ++n) {
        const int cn = ch * NCHUNK + n;
        BLOCK_FOR(i, N * N / 8) *(uint4*)(PhiT + (i / (N / 8)) * LD + (i % (N / 8)) * 8) = ((const uint4*)(p.rw_PhiT + (size_t)cn * N * N))[i];
        BLOCK_FOR(i, C * N / 8) *(uint4*)(Rh + (i / (N / 8)) * LD + (i % (N / 8)) * 8) = ((const uint4*)(p.rw_Rh + (size_t)cn * C * N))[i];
        BLOCK_FOR(i, N * N / 4) ((uint4*)Psi)[i] = ((const uint4*)(p.rw_Psi + (size_t)cn * N * N))[i];
        BLOCK_FOR(i, C * N / 4) ((uint4*)Y0)[i] = ((const uint4*)(p.rw_Y0 + (size_t)cn * C * N))[i];
        BLOCK_SYNC();
        const u16* Sc = Sb + (n & 1) * N * LD; u16* Sn = Sb + ((n + 1) & 1) * N * LD;
        WAVE_FOR(w, TN * TN + TC * TN) {
            if (w < TN * TN) { const int tm = w / TN, tn = w % TN;
                wave_mma32<N>(LANE, [&](int m, int k0, Frag& o) { o.ld_bf(Sc + (tm * 32 + m) * LD + k0); },
                                    [&](int nn, int k0, Frag& o) { o.ld_bf(PhiT + (tn * 32 + nn) * LD + k0); },
                                    [&](int m, int nn, float acc, int) { const int i = tm * 32 + m, k = tn * 32 + nn; Sn[i * LD + k] = f2bf(acc + Psi[i * N + k]); }); }
            else { const int q = w - TN * TN, tm = q / TN, tn = q % TN;
                wave_mma32<N>(LANE, [&](int m, int k0, Frag& o) { o.ld_bf(Rh + (tm * 32 + m) * LD + k0); },
                                    [&](int nn, int k0, Frag& o) { o.ld_bf(Sc + (tn * 32 + nn) * LD + k0); },
                                    [&](int m, int nn, float acc, int) { const int t = tm * 32 + m, i = tn * 32 + nn, R = b * TOK + seq_s(d, n * C + t);
                                        p.rw_y[((size_t)d * MROWS + R) * GROUP_W + hh * N + i] = acc + Y0[t * N + i]; }); } }
        BLOCK_SYNC();
    }
}
template <int G> HD void ph_rw_post(const Params& p, int layer, Exec e) {
    static_assert(G <= RW_HEAD, "G");
    const float *lw = p.rw_ln_w + layer * GROUP_W, *lb = p.rw_ln_b + layer * GROUP_W, *rk = p.rw_r_k + layer * GROUP_W;
    for (int it = e.gid; it < MROWS * RW_HEADS; it += e.ngroups) {
        const int R = it / RW_HEADS, hh = it % RW_HEADS; const size_t o = (size_t)R * GROUP_W + hh * RW_HEAD, o2 = (size_t)MROWS * GROUP_W;
        float s1 = 0.f, bon = 0.f;
        for (int j = e.gl; j < RW_HEAD; j += G) { s1 += p.rw_y[o + j] + p.rw_y[o2 + o + j];
            bon += p.rw_r[o + j] * (p.rw_kt[o + j] + p.rw_kt[o2 + o + j]) * rk[hh * RW_HEAD + j]; }
        s1 = group_sum<G>(s1); bon = group_sum<G>(bon);
        const float mean = s1 / RW_HEAD;
        float s2 = 0.f;
        for (int j = e.gl; j < RW_HEAD; j += G) { const float dlt = p.rw_y[o + j] + p.rw_y[o2 + o + j] - mean; s2 += dlt * dlt; }
        s2 = group_sum<G>(s2);
        const float rstd = 1.f / sqrtf(s2 / RW_HEAD + RW_GN_EPS);
        for (int j = e.gl; j < RW_HEAD; j += G) { const float y = (p.rw_y[o + j] + p.rw_y[o2 + o + j] - mean) * rstd * lw[hh * RW_HEAD + j] + lb[hh * RW_HEAD + j];
            p.mix[(size_t)R * D_MODEL + hh * RW_HEAD + j] = f2bf((y + bon * p.rw_v[o + j]) * p.rw_g[o + j]); }
    }
}

HD void ml_chain(int ch, int& b, int& hh, int& d) { d = ch % 2; hh = (ch / 2) % ML_HEADS; b = ch / (2 * ML_HEADS); }
template <int G> HD void ph_ml_g1(const Params& p, int layer, Exec e) {
    for (int it = e.gid; it < ML_CH * NCHUNK; it += e.ngroups) {
        const int ch = it / NCHUNK, n = it % NCHUNK; int b, hh, d; ml_chain(ch, b, hh, d);
        const float ib = p.ml_ib[(layer * 2 + d) * ML_HEADS + hh], fb = p.ml_fb[(layer * 2 + d) * ML_HEADS + hh];
        float cb = 0.f, cm = -1e30f;
        for (int t0 = 0; t0 < CHUNK; t0 += G) { const int t = t0 + e.gl, pos = n * CHUNK + t, R = b * TOK + seq_s(d, pos);
            const float* g = p.P + (size_t)R * LDP + ML_OFF + 4 * GROUP_W;
            const float li = g[d * ML_HEADS + hh] + ib, lf = logsigmoidf_(g[(2 + d) * ML_HEADS + hh] + fb);
            const float bc = cb + group_scan_sum<G>(lf, e.gl), gv = li - bc, gm = fmaxf(cm, group_scan_max<G>(gv, e.gl));
            p.ml_bcum[(size_t)ch * TOK + pos] = bc; p.ml_g[(size_t)ch * TOK + pos] = gv; p.ml_gmax[(size_t)ch * TOK + pos] = gm;
            cb = group_last<G>(bc); cm = group_last<G>(gm); }
        if (e.gl == 0) { p.ml_bl[ch * NCHUNK + n] = cb; p.ml_gm[ch * NCHUNK + n] = cm; }
    }
}
HD void ph_ml_g2(const Params& p, Exec e) {
    for (int ch = e.gid; ch < ML_CH; ch += e.ngroups) { float m = 0.f;
        for (int n = 0; n < NCHUNK; ++n) { p.ml_min[ch * NCHUNK + n] = m; m = p.ml_bl[ch * NCHUNK + n] + fmaxf(m, p.ml_gm[ch * NCHUNK + n]); } }
}
HD void ph_ml_dC(const Params& p, Exec e) {
    const float ksc = 1.f / sqrtf((float)ML_HEAD);
    const int n1 = ML_CH * NCHUNK * ML_HEAD * ML_HEAD, n2 = ML_CH * NCHUNK * ML_HEAD;
    for (int it = e.gid; it < n1 + n2; it += e.ngroups) {
        const bool isn = it >= n1; const int q = isn ? it - n1 : it;
        const int dd = q % ML_HEAD, ee = isn ? 0 : (q / ML_HEAD) % ML_HEAD, cn = isn ? q / ML_HEAD : q / (ML_HEAD * ML_HEAD), n = cn % NCHUNK, ch = cn / NCHUNK;
        int b, hh, d; ml_chain(ch, b, hh, d);
        const float min_ = p.ml_min[cn], bl = p.ml_bl[cn], mnew = bl + fmaxf(min_, p.ml_gm[cn]);
        float acc = 0.f;
        for (int s = 0; s < CHUNK; ++s) { const int pos = n * CHUNK + s, R = b * TOK + seq_s(d, pos);
            const float wk = expf(bl + p.ml_g[(size_t)ch * TOK + pos] - mnew);
            const float* pr = p.P + (size_t)R * LDP + ML_OFF + hh * ML_HEAD;
            const float kv = pr[GROUP_W + dd] * ksc;
            acc += isn ? wk * kv : wk * kv * pr[2 * GROUP_W + ee]; }
        if (isn) p.ml_dn[(size_t)cn * ML_HEAD + dd] = acc; else p.ml_dC[((size_t)cn * ML_HEAD + ee) * ML_HEAD + dd] = acc;
    }
}
HD void ph_ml_prefix(const Params& p, Exec e) {
    const int n1 = ML_CH * ML_HEAD * ML_HEAD, n2 = ML_CH * ML_HEAD;
    for (int it = e.gid; it < n1 + n2; it += e.ngroups) {
        const bool isn = it >= n1; const int q = isn ? it - n1 : it, per = isn ? ML_HEAD : ML_HEAD * ML_HEAD, ch = q / per, el = q % per;
        float* arr = isn ? p.ml_dn : p.ml_dC; float st = 0.f;
        for (int n = 0; n < NCHUNK; ++n) { const int cn = ch * NCHUNK + n;
            const float min_ = p.ml_min[cn], bl = p.ml_bl[cn], mnew = bl + fmaxf(min_, p.ml_gm[cn]), dc = expf(bl + min_ - mnew);
            const size_t o = (size_t)cn * per + el; const float inc = arr[o]; arr[o] = st; st = dc * st + inc; }
    }
}
HD void ph_ml_S(const Params& p, Exec e) {
    const float ksc = 1.f / sqrtf((float)ML_HEAD);
    for (int it = e.gid; it < ML_CH * NCHUNK * CHUNK * CHUNK; it += e.ngroups) {
        const int s = it % CHUNK, t = (it / CHUNK) % CHUNK, cn = it / (CHUNK * CHUNK), n = cn % NCHUNK, ch = cn / NCHUNK;
        float v = 0.f;
        if (s <= t) { int b, hh, d; ml_chain(ch, b, hh, d);
            const int pt = n * CHUNK + t, ps = n * CHUNK + s, Rt = b * TOK + seq_s(d, pt), Rs = b * TOK + seq_s(d, ps);
            const float* qr = p.P + (size_t)Rt * LDP + ML_OFF + hh * ML_HEAD; const float* kr = p.P + (size_t)Rs * LDP + ML_OFF + GROUP_W + hh * ML_HEAD;
            float dot = 0.f; for (int k = 0; k < ML_HEAD; ++k) dot += qr[k] * kr[k];
            const float bt = p.ml_bcum[(size_t)ch * TOK + pt], mt = bt + fmaxf(p.ml_min[cn], p.ml_gmax[(size_t)ch * TOK + pt]);
            v = dot * ksc * expf(bt + p.ml_g[(size_t)ch * TOK + ps] - mt); }
        p.ml_S[it] = v;
    }
}
HD void ph_ml_out(const Params& p, Exec e) {
    for (int it = e.gid; it < ML_CH * NCHUNK * CHUNK * ML_HEAD; it += e.ngroups) {
        const int ee = it % ML_HEAD, t = (it / ML_HEAD) % CHUNK, cn = it / (ML_HEAD * CHUNK), n = cn % NCHUNK, ch = cn / NCHUNK;
        int b, hh, d; ml_chain(ch, b, hh, d);
        const int pt = n * CHUNK + t, Rt = b * TOK + seq_s(d, pt);
        const float bt = p.ml_bcum[(size_t)ch * TOK + pt], min_ = p.ml_min[cn], mt = bt + fmaxf(min_, p.ml_gmax[(size_t)ch * TOK + pt]), wi = expf(bt + min_ - mt);
        const float* Sr = p.ml_S + ((size_t)cn * CHUNK + t) * CHUNK;
        float num = 0.f, den = 0.f;
        for (int s = 0; s <= t; ++s) { const int Rs = b * TOK + seq_s(d, n * CHUNK + s); const float sv = Sr[s];
            num += sv * p.P[(size_t)Rs * LDP + ML_OFF + 2 * GROUP_W + hh * ML_HEAD + ee]; den += sv; }
        const float* qr = p.P + (size_t)Rt * LDP + ML_OFF + hh * ML_HEAD;
        const float* Cr = p.ml_dC + ((size_t)cn * ML_HEAD + ee) * ML_HEAD; const float* nr = p.ml_dn + (size_t)cn * ML_HEAD;
        float cq = 0.f, nq = 0.f;
        for (int k = 0; k < ML_HEAD; ++k) { cq += Cr[k] * qr[k]; nq += nr[k] * qr[k]; }
        num += wi * cq; den += wi * nq;
        p.ml_hh[((size_t)d * MROWS + Rt) * GROUP_W + hh * ML_HEAD + ee] = num / fmaxf(fabsf(den), expf(-mt));
    }
}

constexpr int ML_N = ML_HEAD, ML_CN = ML_CH * NCHUNK;
static_assert(ML_HEAD % 32 == 0, "tile");
constexpr int ML_C1_SMEM = 2 * ML_N * (CHUNK + LDPAD) * 2 + 4 * CHUNK * 4;
HD void ph_ml_c1_unit(const Params& p, int cn, int tid, int nthr, unsigned char* smem) {
    (void)tid; (void)nthr; OPAQUE_TID();
    constexpr int C = CHUNK, N = ML_N, TC = C / 32, TN = N / 32, LD = C + LDPAD;
    const float ksc = 1.f / sqrtf((float)ML_HEAD);
    const int ch = cn / NCHUNK, n = cn % NCHUNK; int b, hh, d; ml_chain(ch, b, hh, d);
    u16* VwT = (u16*)smem; u16* KT = VwT + N * LD; float* wk = (float*)(KT + N * LD); float* btv = wk + C; float* gv = btv + C; float* mtv = gv + C;
    const float min_ = p.ml_min[cn], bl = p.ml_bl[cn], mnew = bl + fmaxf(min_, p.ml_gm[cn]);
    BLOCK_FOR(sx, C) { const size_t o = (size_t)ch * TOK + n * C + sx; const float g = p.ml_g[o], bt = p.ml_bcum[o];
        wk[sx] = expf(bl + g - mnew); btv[sx] = bt; gv[sx] = g; mtv[sx] = bt + fmaxf(min_, p.ml_gmax[o]); }
    BLOCK_SYNC();
    BLOCK_FOR(idx, C * N) { const int sx = idx / N, dd = idx % N, R = b * TOK + seq_s(d, n * C + sx); const float* pr = p.P + (size_t)R * LDP + ML_OFF + hh * N;
        VwT[dd * LD + sx] = f2bf(wk[sx] * pr[2 * GROUP_W + dd]); KT[dd * LD + sx] = f2bf(pr[GROUP_W + dd] * ksc); }
    BLOCK_SYNC();
    WAVE_FOR(w, TN * TN + TN + TC * TC) {
        if (w < TN * TN) { const int tm = w / TN, tn = w % TN;
            wave_mma32<C>(LANE, [&](int m, int k0, Frag& o) { o.ld_bf(VwT + (tm * 32 + m) * LD + k0); },
                                [&](int nn, int k0, Frag& o) { o.ld_bf(KT + (tn * 32 + nn) * LD + k0); },
                                [&](int m, int nn, float acc, int) { p.ml_dC[((size_t)cn * N + tm * 32 + m) * N + tn * 32 + nn] = acc; }); }
        else if (w < TN * TN + TN) { const int tn = w - TN * TN;
            wave_mma32<C>(LANE, [&](int m, int k0, Frag& o) { if (m == 0) o.ld_f(wk + k0); else o.set1(0.f); },
                                [&](int nn, int k0, Frag& o) { o.ld_bf(KT + (tn * 32 + nn) * LD + k0); },
                                [&](int m, int nn, float acc, int) { if (m == 0) p.ml_dn[(size_t)cn * N + tn * 32 + nn] = acc; }); }
        else { const int q = w - TN * TN - TN, tm = q / TC, tn = q % TC;
            wave_mma32<N>(LANE, [&](int m, int k0, Frag& o) { const int R = b * TOK + seq_s(d, n * C + tm * 32 + m); o.ld_f(p.P + (size_t)R * LDP + ML_OFF + hh * N + k0); },
                                [&](int nn, int k0, Frag& o) { const int R = b * TOK + seq_s(d, n * C + tn * 32 + nn); o.ld_f(p.P + (size_t)R * LDP + ML_OFF + GROUP_W + hh * N + k0); },
                                [&](int m, int nn, float acc, int) { const int t = tm * 32 + m, sx = tn * 32 + nn;
                                    p.ml_S[((size_t)cn * C + t) * C + sx] = sx <= t ? acc * ksc * expf(btv[t] + gv[sx] - mtv[t]) : 0.f; }); } }
    BLOCK_SYNC();
}
constexpr int ML_C2_SMEM = ML_N * (CHUNK + LDPAD) * 2 + 3 * CHUNK * 4;
HD void ph_ml_c2_unit(const Params& p, int cn, int tid, int nthr, unsigned char* smem) {
    (void)tid; (void)nthr; OPAQUE_TID();
    constexpr int C = CHUNK, N = ML_N, TC = C / 32, TN = N / 32, LD = C + LDPAD;
    const int ch = cn / NCHUNK, n = cn % NCHUNK; int b, hh, d; ml_chain(ch, b, hh, d);
    u16* VT = (u16*)smem; float* wi = (float*)(VT + N * LD); float* den = wi + C; float* emt = den + C;
    const float min_ = p.ml_min[cn];
    BLOCK_FOR(t, C) { const size_t o = (size_t)ch * TOK + n * C + t; const float bt = p.ml_bcum[o], mt = bt + fmaxf(min_, p.ml_gmax[o]);
        wi[t] = expf(bt + min_ - mt); emt[t] = expf(-mt); }
    BLOCK_FOR(idx, C * N) { const int sx = idx / N, dd = idx % N, R = b * TOK + seq_s(d, n * C + sx);
        VT[dd * LD + sx] = f2bf(p.P[(size_t)R * LDP + ML_OFF + 2 * GROUP_W + hh * N + dd]); }
    BLOCK_SYNC();
    WAVE_FOR(w, TC) { const int tm = w;
        wave_mma32<C + N>(LANE, [&](int m, int k0, Frag& o) { const int t = tm * 32 + m;
                                    if (k0 < C) o.ld_f(p.ml_S + ((size_t)cn * C + t) * C + k0);
                                    else { const int R = b * TOK + seq_s(d, n * C + t); o.ld_f_scaled(p.P + (size_t)R * LDP + ML_OFF + hh * N + k0 - C, wi[t]); } },
                                [&](int nn, int k0, Frag& o) { if (nn != 0) o.set1(0.f); else if (k0 < C) o.set1(1.f); else o.ld_f(p.ml_dn + (size_t)cn * N + k0 - C); },
                                [&](int m, int nn, float acc, int) { if (nn == 0) den[tm * 32 + m] = acc; }); }
    BLOCK_SYNC();
    WAVE_FOR(w, TC * TN) { const int tm = w / TN, tn = w % TN;
        wave_mma32<C + N>(LANE, [&](int m, int k0, Frag& o) { const int t = tm * 32 + m;
                                    if (k0 < C) o.ld_f(p.ml_S + ((size_t)cn * C + t) * C + k0);
                                    else { const int R = b * TOK + seq_s(d, n * C + t); o.ld_f_scaled(p.P + (size_t)R * LDP + ML_OFF + hh * N + k0 - C, wi[t]); } },
                                [&](int nn, int k0, Frag& o) { const int ee = tn * 32 + nn;
                                    if (k0 < C) o.ld_bf(VT + ee * LD + k0); else o.ld_f(p.ml_dC + ((size_t)cn * N + ee) * N + k0 - C); },
                                [&](int m, int nn, float acc, int) { const int t = tm * 32 + m, ee = tn * 32 + nn, R = b * TOK + seq_s(d, n * C + t);
                                    p.ml_hh[((size_t)d * MROWS + R) * GROUP_W + hh * N + ee] = acc / fmaxf(fabsf(den[t]), emt[t]); }); }
    BLOCK_SYNC();
}
template <int G> HD void ph_ml_post(const Params& p, int layer, Exec e) {
    const float* ng = p.ml_norm_g + layer * GROUP_W;
    for (int it = e.gid; it < MROWS * ML_HEADS; it += e.ngroups) {
        const int R = it / ML_HEADS, hh = it % ML_HEADS; const size_t o = (size_t)R * GROUP_W + hh * ML_HEAD, o2 = (size_t)MROWS * GROUP_W;
        float s1 = 0.f;
        for (int j = e.gl; j < ML_HEAD; j += G) s1 += p.ml_hh[o + j] + p.ml_hh[o2 + o + j];
        s1 = group_sum<G>(s1); const float mean = s1 / ML_HEAD;
        float s2 = 0.f;
        for (int j = e.gl; j < ML_HEAD; j += G) { const float dlt = p.ml_hh[o + j] + p.ml_hh[o2 + o + j] - mean; s2 += dlt * dlt; }
        s2 = group_sum<G>(s2); const float rstd = 1.f / sqrtf(s2 / ML_HEAD + NORM_EPS);
        for (int j = e.gl; j < ML_HEAD; j += G) { const float y = (p.ml_hh[o + j] + p.ml_hh[o2 + o + j] - mean) * rstd * ng[hh * ML_HEAD + j];
            const float og = p.P[(size_t)R * LDP + ML_OFF + 3 * GROUP_W + hh * ML_HEAD + j];
            p.mix[(size_t)R * D_MODEL + GROUP_W + hh * ML_HEAD + j] = f2bf(y * sigmoidf_(og)); }
    }
}

HD float gd_conv_silu(const Params& p, int layer, int R, int c) {
    const int s = row_s(R); const float* pr = p.P + (size_t)R * LDP + GD_OFF + c; const float* cw = p.gd_conv + (size_t)layer * 3 * 3 * GROUP_W + c;
    float v = pr[0] * cw[3 * GROUP_W];
    if (s != 0 && s != CTX) v += pr[-LDP] * cw[0];
    if (s != CTX - 1 && s != TOK - 1) v += pr[LDP] * cw[2 * 3 * GROUP_W];
    return siluf_(v);
}
template <int G> HD void ph_gd_prep(const Params& p, int layer, Exec e) {
    const float qsc = 1.f / sqrtf((float)GD_HEAD);
    for (int it = e.gid; it < MROWS * GD_HEADS; it += e.ngroups) {
        const int R = it / GD_HEADS, hh = it % GD_HEADS;
        float sq = 0.f, sk = 0.f;
        for (int j = e.gl; j < GD_HEAD; j += G) { const float a = gd_conv_silu(p, layer, R, hh * GD_HEAD + j), b2 = gd_conv_silu(p, layer, R, GROUP_W + hh * GD_HEAD + j); sq += a * a; sk += b2 * b2; }
        sq = group_sum<G>(sq); sk = group_sum<G>(sk);
        const float rq = qsc / sqrtf(sq + 1e-6f), rk = 1.f / sqrtf(sk + 1e-6f);
        for (int j = e.gl; j < GD_HEAD; j += G) { const size_t o = (size_t)R * GROUP_W + hh * GD_HEAD + j;
            p.gd_q[o] = gd_conv_silu(p, layer, R, hh * GD_HEAD + j) * rq; p.gd_k[o] = gd_conv_silu(p, layer, R, GROUP_W + hh * GD_HEAD + j) * rk;
            p.gd_v[o] = gd_conv_silu(p, layer, R, 2 * GROUP_W + hh * GD_HEAD + j); }
    }
}
template <int G> HD void ph_gd_gates(const Params& p, int layer, Exec e) {
    for (int it = e.gid; it < GD_CH * NCHUNK; it += e.ngroups) {
        const int ch = it / NCHUNK, n = it % NCHUNK; int b, hh, d; ml_chain(ch, b, hh, d);
        const float al = expf(p.gd_a_log[(layer * 2 + d) * GD_HEADS + hh]), dtb = p.gd_dt_bias[(layer * 2 + d) * GD_HEADS + hh];
        float cg = 0.f;
        for (int t0 = 0; t0 < CHUNK; t0 += G) { const int t = t0 + e.gl, pos = n * CHUNK + t, R = b * TOK + seq_s(d, pos);
            const float* g = p.P + (size_t)R * LDP + GD_OFF + 4 * GROUP_W;
            const float gc = cg + group_scan_sum<G>(-al * softplusf_(g[d * GD_HEADS + hh] + dtb), e.gl);
            p.gd_gc[(size_t)ch * TOK + pos] = gc; p.gd_beta[(size_t)ch * TOK + pos] = sigmoidf_(g[(2 + d) * GD_HEADS + hh]);
            cg = group_last<G>(gc); }
    }
}

constexpr int GD_N = GD_HEAD, GD_CN = GD_CH * NCHUNK;
static_assert(GD_HEAD % 32 == 0, "tile");
HD void ph_gd_c1(const Params& p, Exec e) {
    constexpr int C = CHUNK, N = GD_N, TC = C / 32;
    for (int it = e.gid; it < GD_CN * TC * TC; it += e.ngroups) {
        const int cn = it / (TC * TC), tm = (it / TC) % TC, tn = it % TC, ch = cn / NCHUNK, n = cn % NCHUNK; int b, hh, d; ml_chain(ch, b, hh, d);
        wave_mma32<N>(e.gl, [&](int m, int k0, Frag& o) { const int R = b * TOK + seq_s(d, n * C + tm * 32 + m); o.ld_f(p.gd_k + (size_t)R * GROUP_W + hh * N + k0); },
                            [&](int nn, int k0, Frag& o) { const int R = b * TOK + seq_s(d, n * C + tn * 32 + nn); o.ld_f(p.gd_k + (size_t)R * GROUP_W + hh * N + k0); },
                            [&](int m, int nn, float acc, int) { const int i = tm * 32 + m, j = tn * 32 + nn; const size_t o = (size_t)ch * TOK + n * C;
                                p.gd_A[((size_t)cn * C + i) * C + j] = j < i ? p.gd_beta[o + i] * acc * expf(p.gd_gc[o + i] - p.gd_gc[o + j]) : 0.f; });
    }
}
constexpr int GD_C3_SMEM = (5 * GD_N + 2 * CHUNK) * (CHUNK + LDPAD) * 2 + 2 * CHUNK * 4;
HD void ph_gd_c3_unit(const Params& p, int cn, int tid, int nthr, unsigned char* smem) {
    (void)tid; (void)nthr; OPAQUE_TID();
    constexpr int C = CHUNK, N = GD_N, TC = C / 32, TN = N / 32, LD = C + LDPAD;
    const int ch = cn / NCHUNK, n = cn % NCHUNK; int b, hh, d; ml_chain(ch, b, hh, d);
    u16 *KbT = (u16*)smem, *VbT = KbT + N * LD, *KdT = VbT + N * LD, *uT = KdT + N * LD, *wT = uT + N * LD, *Tb = wT + N * LD, *attn = Tb + C * LD;
    float* gcs = (float*)(attn + C * LD); float* bet = gcs + C;
    BLOCK_FOR(t, C) { const size_t o = (size_t)ch * TOK + n * C + t; gcs[t] = p.gd_gc[o]; bet[t] = p.gd_beta[o]; }
    BLOCK_SYNC();
    BLOCK_FOR(idx, C * N) { const int t = idx / N, dd = idx % N, R = b * TOK + seq_s(d, n * C + t); const size_t o = (size_t)R * GROUP_W + hh * N + dd;
        const float kv = p.gd_k[o], vv = p.gd_v[o];
        KbT[dd * LD + t] = f2bf(kv * bet[t] * expf(gcs[t])); VbT[dd * LD + t] = f2bf(vv * bet[t]); KdT[dd * LD + t] = f2bf(kv * expf(gcs[C - 1] - gcs[t])); }
    BLOCK_FOR(idx, C * C) Tb[(idx / C) * LD + idx % C] = f2bf(p.gd_T[(size_t)cn * C * C + idx]);
    BLOCK_SYNC();
    WAVE_FOR(w, TC * TC + 2 * TN * TC) {
        if (w < TC * TC) { const int tm = w / TC, tn = w % TC;
            wave_mma32<N>(LANE, [&](int m, int k0, Frag& o) { const int R = b * TOK + seq_s(d, n * C + tm * 32 + m); o.ld_f(p.gd_q + (size_t)R * GROUP_W + hh * N + k0); },
                                [&](int nn, int k0, Frag& o) { const int R = b * TOK + seq_s(d, n * C + tn * 32 + nn); o.ld_f(p.gd_k + (size_t)R * GROUP_W + hh * N + k0); },
                                [&](int m, int nn, float acc, int) { const int i = tm * 32 + m, j = tn * 32 + nn; attn[i * LD + j] = f2bf(j <= i ? acc * expf(gcs[i] - gcs[j]) : 0.f); }); }
        else { const int q = w - TC * TC, which = q / (TN * TC), tm = (q / TC) % TN, tn = q % TC;
            const u16* Am = which ? KbT : VbT; u16* Om = which ? wT : uT;
            wave_mma32<C>(LANE, [&](int m, int k0, Frag& o) { o.ld_bf(Am + (tm * 32 + m) * LD + k0); },
                                [&](int nn, int k0, Frag& o) { o.ld_bf(Tb + (tn * 32 + nn) * LD + k0); },
                                [&](int m, int nn, float acc, int) { Om[(tm * 32 + m) * LD + tn * 32 + nn] = f2bf(acc); }); } }
    BLOCK_SYNC();
    WAVE_FOR(w, 2 * TC * TN + 2 * TN * TN) {
        if (w < 2 * TC * TN) { const int which = w / (TC * TN), tm = (w / TN) % TC, tn = w % TN;
            const u16* Bm = which ? uT : wT;
            wave_mma32<C>(LANE, [&](int m, int k0, Frag& o) { o.ld_bf(attn + (tm * 32 + m) * LD + k0); },
                                [&](int nn, int k0, Frag& o) { o.ld_bf(Bm + (tn * 32 + nn) * LD + k0); },
                                [&](int m, int nn, float acc, int) { const int i = tm * 32 + m, dd = tn * 32 + nn;
                                    if (which) p.gd_O0[((size_t)cn * C + i) * N + dd] = acc;
                                    else { const int R = b * TOK + seq_s(d, n * C + i); p.gd_Qh[((size_t)cn * C + i) * N + dd] = f2bf(p.gd_q[(size_t)R * GROUP_W + hh * N + dd] * expf(gcs[i]) - acc); } }); }
        else { const int q = w - 2 * TC * TN, which = q / (TN * TN), tm = (q / TN) % TN, tn = q % TN;
            const u16* Bm = which ? uT : wT;
            wave_mma32<C>(LANE, [&](int m, int k0, Frag& o) { o.ld_bf(KdT + (tm * 32 + m) * LD + k0); },
                                [&](int nn, int k0, Frag& o) { o.ld_bf(Bm + (tn * 32 + nn) * LD + k0); },
                                [&](int m, int nn, float acc, int) { const int d1 = tm * 32 + m, d2 = tn * 32 + nn;
                                    if (which) p.gd_Psi[((size_t)cn * N + d1) * N + d2] = acc;
                                    else p.gd_Phi[((size_t)cn * N + d1) * N + d2] = f2bf((d1 == d2 ? expf(gcs[C - 1]) : 0.f) - acc); }); } }
    BLOCK_SYNC();
}
constexpr int GD_EB = 32, GD_S2_UNITS = GD_CH * (GD_N / GD_EB);
constexpr int GD_S2_SMEM = (2 * GD_EB + GD_N + CHUNK) * (GD_N + LDPAD) * 2 + (GD_N * GD_EB + CHUNK * GD_EB) * 4;
HD void ph_gd_scan2_unit(const Params& p, int unit, int tid, int nthr, unsigned char* smem) {
    (void)tid; (void)nthr; OPAQUE_TID();
    constexpr int C = CHUNK, N = GD_N, EB = GD_EB, LD = N + LDPAD;
    const int eb = unit % (N / EB), ch = unit / (N / EB), e0 = eb * EB; int b, hh, d; ml_chain(ch, b, hh, d);
    u16* ST = (u16*)smem; u16* Phi = ST + 2 * EB * LD; u16* Qh = Phi + N * LD; float* Psi = (float*)(Qh + C * LD); float* O0 = Psi + N * EB;
    BLOCK_FOR(i, EB * LD) ST[i] = 0;
    for (int n = 0; n < NCHUNK; ++n) {
        const int cn = ch * NCHUNK + n;
        BLOCK_FOR(i, N * N / 8) *(uint4*)(Phi + (i / (N / 8)) * LD + (i % (N / 8)) * 8) = ((const uint4*)(p.gd_Phi + (size_t)cn * N * N))[i];
        BLOCK_FOR(i, C * N / 8) *(uint4*)(Qh + (i / (N / 8)) * LD + (i % (N / 8)) * 8) = ((const uint4*)(p.gd_Qh + (size_t)cn * C * N))[i];
        BLOCK_FOR(i, N * EB / 4) ((uint4*)Psi)[i] = *(const uint4*)(p.gd_Psi + ((size_t)cn * N + i / (EB / 4)) * N + e0 + (i % (EB / 4)) * 4);
        BLOCK_FOR(i, C * EB / 4) ((uint4*)O0)[i] = *(const uint4*)(p.gd_O0 + ((size_t)cn * C + i / (EB / 4)) * N + e0 + (i % (EB / 4)) * 4);
        BLOCK_SYNC();
        const u16* Sc = ST + (n & 1) * EB * LD; u16* Sn = ST + ((n + 1) & 1) * EB * LD;
        WAVE_FOR(w, N / 32 + C / 32) {
            if (w < N / 32) { const int tm = w;
                wave_mma32<N>(LANE, [&](int m, int k0, Frag& o) { o.ld_bf(Phi + (tm * 32 + m) * LD + k0); },
                                    [&](int nn, int k0, Frag& o) { o.ld_bf(Sc + nn * LD + k0); },
                                    [&](int m, int nn, float acc, int) { const int d1 = tm * 32 + m; Sn[nn * LD + d1] = f2bf(acc + Psi[d1 * EB + nn]); }); }
            else { const int tm = w - N / 32;
                wave_mma32<N>(LANE, [&](int m, int k0, Frag& o) { o.ld_bf(Qh + (tm * 32 + m) * LD + k0); },
                                    [&](int nn, int k0, Frag& o) { o.ld_bf(Sc + nn * LD + k0); },
                                    [&](int m, int nn, float acc, int) { const int t = tm * 32 + m, R = b * TOK + seq_s(d, n * C + t);
                                        p.gd_o[((size_t)d * MROWS + R) * GROUP_W + hh * N + e0 + nn] = acc + O0[t * EB + nn]; }); } }
        BLOCK_SYNC();
    }
}
template <int G> HD void ph_gd_post(const Params& p, int layer, Exec e) {
    const float* ng = p.gd_norm_g + layer * GD_HEAD;
    for (int it = e.gid; it < MROWS * GD_HEADS; it += e.ngroups) {
        const int R = it / GD_HEADS, hh = it % GD_HEADS; const size_t o = (size_t)R * GROUP_W + hh * GD_HEAD, o2 = (size_t)MROWS * GROUP_W;
        float ss = 0.f;
        for (int j = e.gl; j < GD_HEAD; j += G) { const float v = p.gd_o[o + j] + p.gd_o[o2 + o + j]; ss += v * v; }
        ss = group_sum<G>(ss); const float rstd = 1.f / sqrtf(ss / GD_HEAD + NORM_EPS);
        for (int j = e.gl; j < GD_HEAD; j += G) { const float v = (p.gd_o[o + j] + p.gd_o[o2 + o + j]) * rstd * ng[j];
            const float g = p.P[(size_t)R * LDP + GD_OFF + 3 * GROUP_W + hh * GD_HEAD + j];
            p.mix[(size_t)R * D_MODEL + 2 * GROUP_W + hh * GD_HEAD + j] = f2bf(v * siluf_(g)); }
    }
}

template <int G> HD void ph_at_prep(const Params& p, int layer, Exec e) {
    constexpr int NHS = AT_QH + 2 * AT_KVH, HALF = AT_HEAD / 2, QTR = AT_HEAD / 4;
    for (int it = e.gid; it < MROWS * NHS; it += e.ngroups) {
        const int R = it / NHS, hs = it % NHS, b = row_b(R), s = row_s(R);
        const float* pr = p.P + (size_t)R * LDP + AT_OFF + hs * AT_HEAD;
        u16* dst; const float* g = nullptr;
        if (hs < AT_QH) { dst = p.at_q + (((size_t)b * AT_QH + hs) * TOK + s) * AT_HEAD; g = p.at_q_norm + layer * AT_HEAD; }
        else if (hs < AT_QH + AT_KVH) { dst = p.at_k + (((size_t)b * AT_KVH + hs - AT_QH) * TOK + s) * AT_HEAD; g = p.at_k_norm + layer * AT_HEAD; }
        else dst = p.at_v + (((size_t)b * AT_KVH + hs - AT_QH - AT_KVH) * TOK + s) * AT_HEAD;
        if (!g) { for (int j = e.gl; j < AT_HEAD; j += G) dst[j] = f2bf(pr[j]); continue; }
        float ss = 0.f;
        for (int j = e.gl; j < AT_HEAD; j += G) ss += pr[j] * pr[j];
        ss = group_sum<G>(ss); const float rstd = 1.f / sqrtf(ss / AT_HEAD + NORM_EPS);
        if (s < CTX) { for (int j = e.gl; j < AT_HEAD; j += G) dst[j] = f2bf(pr[j] * rstd * g[j]); continue; }
        const int t = s - CTX; const float posr = (float)(t / GRID_W), posc = (float)(t % GRID_W);
        for (int j = e.gl; j < AT_HEAD; j += G) {
            const int half = j / HALF, jj = j % HALF, fi = jj % QTR; const bool second = jj >= QTR;
            const float ang = (half ? posc : posr) * powf(10000.f, -(float)(2 * fi) / (float)HALF);
            const float cs = cosf(ang), sn = sinf(ang);
            const int jp = second ? j - QTR : j + QTR;
            const float own = pr[j] * rstd * g[j], oth = pr[jp] * rstd * g[jp];
            dst[j] = f2bf(second ? own * cs + oth * sn : own * cs - oth * sn);
        }
    }
}

#include <cstdio>
#include <cstddef>
static_assert(D_MODEL == 2048 && CTX == 256 && SEQ % 256 == 0 && AT_HEAD == 128, "GPU part is written for the full configuration");
static_assert(RW_C3_SMEM <= 147392 && TS_SMEM <= 147392 && RW_S2_SMEM <= 147392 && RW_C1_SMEM <= 147392 && GD_C3_SMEM <= 147392 && GD_S2_SMEM <= 147392 && ML_C1_SMEM <= 147392 && ML_C2_SMEM <= 147392, "LDS");
static_assert(CHUNK == RW_N && GD_N * CHUNK * 2 == CHUNK * CHUNK * 4, "buffer aliasing (Y0 on Ma, Qh on A)");

#define XB_TMO      128
#define XB_XCNT(j)  (256  + 64 * (j))
#define XB_XSUB(j)  (1280 + 64 * (j))
#define XB_XGEN(j)  (2304 + 64 * (j))
#define XB_TOP      3328
#define XB_TOPGEN   3392
#define XCD_BAR_WORDS 3456
#define XB_SPIN_CAP (1u << 24)
#define LAS __attribute__((address_space(3)))
__device__ __forceinline__ unsigned xb_ld(unsigned* p)              { return __hip_atomic_load(p, __ATOMIC_RELAXED, __HIP_MEMORY_SCOPE_AGENT); }
__device__ __forceinline__ unsigned xb_add(unsigned* p, unsigned v) { return __hip_atomic_fetch_add(p, v, __ATOMIC_RELAXED, __HIP_MEMORY_SCOPE_AGENT); }
__device__ __forceinline__ unsigned xb_xcc_id() { return (unsigned)__builtin_amdgcn_s_getreg((3 << 11) | 20) & 0xFu; }
#define XB_SPIN(cond, bar) do { unsigned _sp = 0; while (cond) { __builtin_amdgcn_s_sleep(1); \
    if ((++_sp & 255u) == 0u) { if (xb_ld(&(bar)[XB_TMO])) break; if (_sp > XB_SPIN_CAP) { atomicAdd(&(bar)[XB_TMO], 1u); break; } } } } while (0)
struct XcdBarrier { unsigned* bar; unsigned x; volatile LAS unsigned* st; };
__device__ __forceinline__ XcdBarrier xcd_barrier_post(unsigned* bar, volatile LAS unsigned* st) {
    XcdBarrier b; b.bar = bar; b.x = xb_xcc_id(); b.st = st;
    if (threadIdx.x == 0) (void)xb_add(&bar[XB_XCNT(b.x)], 1u);
    return b;
}
__device__ __forceinline__ void xcd_barrier_complete(unsigned* bar, unsigned x, unsigned& nloc, unsigned& nx) {
    const unsigned G = gridDim.x * gridDim.y * gridDim.z;
    unsigned sum, cnt, mine, sp = 0u;
    for (;;) {
        sum = 0u; cnt = 0u; mine = 0u;
#pragma unroll
        for (unsigned j = 0; j < 16; ++j) { const unsigned c = xb_ld(&bar[XB_XCNT(j)]); sum += c; cnt += (c > 0u) ? 1u : 0u; mine = (j == x) ? c : mine; }
        if (sum == G) break;
        __builtin_amdgcn_s_sleep(1);
        if ((++sp & 255u) == 0u) { if (xb_ld(&bar[XB_TMO])) break; if (sp > XB_SPIN_CAP) { atomicAdd(&bar[XB_TMO], 1u); break; } }
    }
    nloc = mine > 0u ? mine : 1u; nx = cnt > 0u ? cnt : 1u;
}
__device__ __forceinline__ void xcd_barrier(const XcdBarrier& b) {
    asm volatile("s_waitcnt vmcnt(0)" ::: "memory");
    __syncthreads();
    if (threadIdx.x == 0) {
        unsigned* bar = b.bar;
        __builtin_amdgcn_s_waitcnt(0);
        unsigned nloc = b.st[0], nx = b.st[1];
        if (nloc == 0u) { xcd_barrier_complete(bar, b.x, nloc, nx); b.st[0] = nloc; b.st[1] = nx; }
        const unsigned old = xb_add(&bar[XB_XSUB(b.x)], 1u);
        const unsigned gen = old / nloc;
        if (old + 1u == (gen + 1u) * nloc) {
            __builtin_amdgcn_fence(__ATOMIC_RELEASE, "agent");
            asm volatile("s_waitcnt vmcnt(0)" ::: "memory");
            const unsigned og = xb_add(&bar[XB_TOP], 1u);
            const unsigned tg = og / nx;
            if (og + 1u == (tg + 1u) * nx) xb_add(&bar[XB_TOPGEN], 1u);
            else XB_SPIN(xb_ld(&bar[XB_TOPGEN]) == tg, bar);
            __builtin_amdgcn_fence(__ATOMIC_ACQUIRE, "agent");
            xb_add(&bar[XB_XGEN(b.x)], 1u);
            asm volatile("s_waitcnt vmcnt(0)" ::: "memory");
        } else {
            XB_SPIN(xb_ld(&bar[XB_XGEN(b.x)]) == gen, bar);
            __builtin_amdgcn_fence(__ATOMIC_ACQUIRE, "agent");
            asm volatile("s_waitcnt vmcnt(0)" ::: "memory");
        }
    }
    __syncthreads();
}

namespace pg8 {
#define PG8_LAS __attribute__((address_space(3)))
typedef unsigned short bf16_t;
typedef short bf16x8 __attribute__((ext_vector_type(8)));
typedef float f32x4 __attribute__((ext_vector_type(4)));
typedef unsigned u32x4 __attribute__((ext_vector_type(4)));
constexpr int BM = 256, BK = 64, HALF = 128, HTB = HALF * BK * 2  , STAGE_BYTES = 8 * HTB, NXCD = 8, WGM = 8;

__host__ __device__ __forceinline__ int lds_byte(int r, int c) { const int st = (r >> 4) * 2 + (c >> 5), rr = r & 15, cc = c & 31, ob = rr * 64 + cc * 2; return st * 1024 + (ob ^ (((ob >> 9) & 1) << 5)); }
__host__ __device__ __forceinline__ void stage_rc(int b, int& R, int& C) { const int st = b / 1024, sb = b % 1024, swz = sb ^ (((sb >> 9) & 1) << 5); R = (st >> 1) * 16 + swz / 64; C = (st & 1) * 32 + (swz % 64) / 2; }
__host__ __device__ __forceinline__ int perm32(int rho) { const int n = rho >> 4, i = rho & 15; return 8 * (i >> 2) + 4 * n + (i & 3); }

struct Unit { int pm, pn; };
struct Gemm { const bf16_t* A; const bf16_t* Bt; int M, N, K; };

struct StaticOrder {
    int nM, nN, nwg, G, c;
    __host__ __device__ void init(int M, int N, int G_, int c_) { nM = M / BM; nN = N / BM; nwg = nM * nN; G = G_; c = c_; }
    __host__ __device__ bool next(int i, Unit& u) const {
        const long L = (long)i * G + c; if (L >= nwg) return false;
        int wgid = (int)L; { const int q = nwg / NXCD, r = nwg % NXCD, xcd = wgid % NXCD, off = wgid / NXCD; wgid = (xcd < r ? xcd * (q + 1) : r * (q + 1) + (xcd - r) * q) + off; }
        const int nig = WGM * nN, gid = wgid / nig, fm = gid * WGM, gsz = (nM - fm) < WGM ? (nM - fm) : WGM;
        u.pm = fm + ((wgid % nig) % gsz); u.pn = (wgid % nig) / gsz; return true;
    }
    __device__ __forceinline__ void a_ready(const Unit&) const {}
    __device__ __forceinline__ void done(const Unit&) const {}
};
__device__ __forceinline__ unsigned cvt_pk_bf16(float lo, float hi) { unsigned r; asm volatile("v_cvt_pk_bf16_f32 %0, %1, %2" : "=v"(r) : "v"(lo), "v"(hi)); return r; }
typedef unsigned u32x2v __attribute__((ext_vector_type(2)));

struct TileOrder {
    int nI, nJ, nwg, G, c, latent_only;
    __device__ void init(int nI_, int nJ_, int G_, int c_, int lat) { nI = nI_; nJ = nJ_; nwg = nI * nJ; G = G_; c = c_; latent_only = lat; }
    __device__ bool next(int i, Unit& u) const { const long L = (long)i * G + c; if (L >= nwg) return false;
        const int ii = (int)(L % nI), j = (int)(L / nI); u.pm = latent_only ? (ii / (SEQ / 256)) * (TOK / 256) + 1 + ii % (SEQ / 256) : ii; u.pn = j; return true; }
    __device__ __forceinline__ void a_ready(const Unit&) const {}
    __device__ __forceinline__ void done(const Unit&) const {}
};
struct GroupedOrder {
    int nI, nJ, tilesA, nwg, G, c;
    __device__ void init(int nI_, int nJ_, int tilesA_, int G_, int c_) { nI = nI_; nJ = nJ_; tilesA = tilesA_; nwg = NE * nI * nJ; G = G_; c = c_; }
    __device__ bool next(int i, Unit& u) const { const long L = (long)i * G + c; if (L >= nwg) return false;
        const int e = (int)(L / (nI * nJ)), r = (int)(L % (nI * nJ)), j = r / nI, ii = r % nI; u.pm = e * tilesA + ii; u.pn = e * nJ + j; return true; }
    __device__ __forceinline__ void a_ready(const Unit&) const {}
    __device__ __forceinline__ void done(const Unit&) const {}
};

struct EpiF32 {
    static constexpr bool PERM = false, AFTER_DRAIN = false;
    float* C; int ldc;
    __device__ __forceinline__ void operator()(const f32x4 (&acc)[2][2][4][2], const Unit& u, int wr, int wc, int fr, int fq) const {
        const int row0 = u.pm * BM + wr * 64 + fr, col0 = u.pn * BM + wc * 32 + 4 * fq;
#pragma unroll
        for (int ai = 0; ai < 2; ++ai)
#pragma unroll
            for (int m = 0; m < 4; ++m) { float* rowp = C + (size_t)(row0 + ai * HALF + m * 16) * ldc + col0;
#pragma unroll
                for (int bj = 0; bj < 2; ++bj)
#pragma unroll
                    for (int n = 0; n < 2; ++n) *(f32x4*)(rowp + bj * HALF + n * 16) = acc[ai][bj][m][n]; }
    }
};
struct EpiResid {
    static constexpr bool PERM = false, AFTER_DRAIN = false;
    float* X; const float* modl;
    __device__ __forceinline__ void operator()(const f32x4 (&acc)[2][2][4][2], const Unit& u, int wr, int wc, int fr, int fq) const {
        const int row0 = u.pm * BM + wr * 64 + fr, col0 = u.pn * BM + wc * 32 + 4 * fq;
        const int tb = TOK / 256, sel = (u.pm % tb == 0) ? 2 : u.pm / tb;
        const float* gate = modl + ((size_t)sel * 6 + 2) * D_MODEL + col0;
        f32x4 gv[2][2];
#pragma unroll
        for (int bj = 0; bj < 2; ++bj)
#pragma unroll
            for (int n = 0; n < 2; ++n) gv[bj][n] = *(const f32x4*)(gate + bj * HALF + n * 16);
#pragma unroll
        for (int ai = 0; ai < 2; ++ai)
#pragma unroll
            for (int m = 0; m < 4; ++m) { float* rowp = X + (size_t)(row0 + ai * HALF + m * 16) * D_MODEL + col0;
#pragma unroll
                for (int bj = 0; bj < 2; ++bj)
#pragma unroll
                    for (int n = 0; n < 2; ++n) { f32x4* q = (f32x4*)(rowp + bj * HALF + n * 16); *q = *q + gv[bj][n] * acc[ai][bj][m][n]; } }
    }
};
struct EpiSwiGLU {
    static constexpr bool PERM = false, AFTER_DRAIN = false;
    bf16_t* H; int nJ;
    __device__ __forceinline__ void operator()(const f32x4 (&acc)[2][2][4][2], const Unit& u, int wr, int wc, int fr, int fq) const {
        const int row0 = u.pm * BM + wr * 64 + fr, col0 = (u.pn % nJ) * HALF + wc * 32 + 4 * fq;
#pragma unroll
        for (int ai = 0; ai < 2; ++ai)
#pragma unroll
            for (int m = 0; m < 4; ++m) { bf16_t* rowp = H + (size_t)(row0 + ai * HALF + m * 16) * D_MODEL + col0;
#pragma unroll
                for (int n = 0; n < 2; ++n) { const f32x4 a = acc[ai][0][m][n], b = acc[ai][1][m][n]; float o[4];
#pragma unroll
                    for (int q = 0; q < 4; ++q) o[q] = a[q] / (1.f + __expf(-a[q])) * b[q];
                    u32x2v w; w.x = cvt_pk_bf16(o[0], o[1]); w.y = cvt_pk_bf16(o[2], o[3]); *(u32x2v*)(rowp + n * 16) = w; } }
    }
};
struct EpiGate {
    static constexpr bool PERM = false, AFTER_DRAIN = false;
    float* Y; const float* gate; int nJ;
    __device__ __forceinline__ void operator()(const f32x4 (&acc)[2][2][4][2], const Unit& u, int wr, int wc, int fr, int fq) const {
        const int row0 = u.pm * BM + wr * 64 + fr, col0 = (u.pn % nJ) * BM + wc * 32 + 4 * fq;
#pragma unroll
        for (int ai = 0; ai < 2; ++ai)
#pragma unroll
            for (int m = 0; m < 4; ++m) { const int r = row0 + ai * HALF + m * 16; const float gt = gate[r]; float* rowp = Y + (size_t)r * D_MODEL + col0;
#pragma unroll
                for (int bj = 0; bj < 2; ++bj)
#pragma unroll
                    for (int n = 0; n < 2; ++n) *(f32x4*)(rowp + bj * HALF + n * 16) = acc[ai][bj][m][n] * gt; }
    }
};
template <class Epi, class Sched>
__device__ __forceinline__ void gemm_phase(PG8_LAS unsigned char* lds, const Gemm g, const Sched& S, const Epi& E) {
    const int tid = threadIdx.x, wid = __builtin_amdgcn_readfirstlane(tid >> 6), lane = tid & 63, wr = wid >> 2, wc = wid & 3, fr = lane & 15, fq = lane >> 4;
    const int K = g.K, nt = K / BK;
    unsigned voffA[2], voffB[2];
#pragma unroll
    for (int i = 0; i < 2; ++i) { int R, C; stage_rc(tid * 16 + i * 8192, R, C); const int Rb = Epi::PERM ? ((R & ~31) + perm32(R & 31)) : R;
        voffA[i] = (unsigned)(R * K + C) * 2u; voffB[i] = (unsigned)(Rb * K + C) * 2u; }
    const size_t kstep = (size_t)(BK * 2);
    const size_t hstep = (size_t)HALF * K * 2;
    const size_t tstep = 2 * hstep;
    const unsigned ldsw = (unsigned)wid * 1024u;
    const int aoff = lds_byte(wr * 64 + fr, fq * 8), boff = lds_byte(wc * 32 + fr, fq * 8);
#define PG8_SA(b, h) (((b) * 2 + (h)) * HTB)
#define PG8_SB(b, h) ((4 + (b) * 2 + (h)) * HTB)
#define PG8_STAGE(bufoff, gbase, voff) do { _Pragma("unroll") for (int _i = 0; _i < 2; ++_i) \
        __builtin_amdgcn_global_load_lds((const unsigned*)((const char*)(gbase) + (voff)[_i]), (PG8_LAS unsigned*)(lds + (bufoff) + ldsw + _i * 8192), 16, 0, 0); } while (0)
#define PG8_LDA(dst, b, h) do { _Pragma("unroll") for (int m = 0; m < 4; ++m) _Pragma("unroll") for (int k = 0; k < 2; ++k) dst[m][k] = *(const PG8_LAS bf16x8*)(lds + PG8_SA(b, h) + aoff + m * 2048 + k * 1024); } while (0)
#define PG8_LDB(dst, b, h) do { _Pragma("unroll") for (int n = 0; n < 2; ++n) _Pragma("unroll") for (int k = 0; k < 2; ++k) dst[n][k] = *(const PG8_LAS bf16x8*)(lds + PG8_SB(b, h) + boff + n * 2048 + k * 1024); } while (0)
#define PG8_MMA(ai, bj, At, Bt) do { __builtin_amdgcn_s_setprio(1); _Pragma("unroll") for (int m = 0; m < 4; ++m) _Pragma("unroll") for (int n = 0; n < 2; ++n) _Pragma("unroll") for (int k = 0; k < 2; ++k) \
        acc[ai][bj][m][n] = __builtin_amdgcn_mfma_f32_16x16x32_bf16(Bt[n][k], At[m][k], acc[ai][bj][m][n], 0, 0, 0); __builtin_amdgcn_s_setprio(0); } while (0)
#define PG8_WAIT_V(n) asm volatile("s_waitcnt vmcnt(" #n ")" ::: "memory")
#define PG8_WAIT_L(n) asm volatile("s_waitcnt lgkmcnt(" #n ")" ::: "memory")
#define PG8_BAR __builtin_amdgcn_s_barrier()
#define PG8_SCHED __builtin_amdgcn_sched_barrier(0)
    Unit cur, nxt; int ui = 0;
    if (!S.next(0, cur)) return;
    f32x4 acc[2][2][4][2];
#pragma unroll
    for (int a = 0; a < 2; ++a)
#pragma unroll
        for (int b = 0; b < 2; ++b)
#pragma unroll
            for (int m = 0; m < 4; ++m)
#pragma unroll
                for (int n = 0; n < 2; ++n) acc[a][b][m][n] = (f32x4){0.f, 0.f, 0.f, 0.f};
    bf16x8 At[4][2], B0[2][2], B1[2][2];
    const char* cA = (const char*)g.A + (size_t)cur.pm * tstep; const char* cB = (const char*)g.Bt + (size_t)cur.pn * tstep;
    S.a_ready(cur);
    PG8_STAGE(PG8_SB(0, 0), cB, voffB); PG8_STAGE(PG8_SA(0, 0), cA, voffA); PG8_STAGE(PG8_SB(0, 1), cB + hstep, voffB); PG8_STAGE(PG8_SA(0, 1), cA + hstep, voffA);
    if (wr == 1) PG8_BAR;
    PG8_WAIT_V(4); PG8_BAR;
    PG8_STAGE(PG8_SB(1, 0), cB + kstep, voffB); PG8_STAGE(PG8_SA(1, 0), cA + kstep, voffA); PG8_STAGE(PG8_SB(1, 1), cB + hstep + kstep, voffB);
    PG8_WAIT_V(6); PG8_BAR;
    for (;;) {
        const bool has_next = S.next(ui + 1, nxt);
        const char* nA = has_next ? (const char*)g.A + (size_t)nxt.pm * tstep : cA; const char* nB = has_next ? (const char*)g.Bt + (size_t)nxt.pn * tstep : cB;
        for (int t = 0; t < nt; t += 2) {
            const bool last = (t == nt - 2);
            const char* a1 = cA + (size_t)(t + 1) * kstep;
            const char* a2 = last ? nA : cA + (size_t)(t + 2) * kstep; const char* b2 = last ? nB : cB + (size_t)(t + 2) * kstep;
            const char* a3 = a2 + kstep; const char* b3 = b2 + kstep;
            if (last && has_next) S.a_ready(nxt);
            PG8_LDB(B0, 0, 0); PG8_SCHED; PG8_LDA(At, 0, 0); PG8_STAGE(PG8_SA(1, 1), a1 + hstep, voffA);
            PG8_WAIT_L(8); PG8_BAR; PG8_WAIT_L(0); PG8_MMA(0, 0, At, B0); PG8_BAR; PG8_SCHED;
            PG8_LDB(B1, 0, 1); PG8_STAGE(PG8_SB(0, 0), b2, voffB);
            PG8_BAR; PG8_WAIT_L(0); PG8_MMA(0, 1, At, B1); PG8_BAR;
            PG8_LDA(At, 0, 1); PG8_STAGE(PG8_SA(0, 0), a2, voffA);
            PG8_BAR; PG8_WAIT_L(0); PG8_MMA(1, 0, At, B0); PG8_BAR; PG8_SCHED;
            PG8_STAGE(PG8_SB(0, 1), b2 + hstep, voffB);
            PG8_WAIT_V(6); PG8_BAR; PG8_MMA(1, 1, At, B1); PG8_BAR;
            PG8_LDB(B0, 1, 0); PG8_SCHED; PG8_LDA(At, 1, 0); PG8_STAGE(PG8_SA(0, 1), a2 + hstep, voffA);
            PG8_WAIT_L(8); PG8_BAR; PG8_WAIT_L(0); PG8_MMA(0, 0, At, B0); PG8_BAR; PG8_SCHED;
            PG8_LDB(B1, 1, 1); PG8_STAGE(PG8_SB(1, 0), b3, voffB);
            PG8_BAR; PG8_WAIT_L(0); PG8_MMA(0, 1, At, B1); PG8_BAR;
            PG8_LDA(At, 1, 1); PG8_STAGE(PG8_SA(1, 0), a3, voffA);
            PG8_BAR; PG8_WAIT_L(0); PG8_MMA(1, 0, At, B0); PG8_BAR; PG8_SCHED;
            PG8_STAGE(PG8_SB(1, 1), b3 + hstep, voffB);
            PG8_WAIT_V(6); PG8_BAR; PG8_MMA(1, 1, At, B1); PG8_BAR;
        }
        if constexpr (!Epi::AFTER_DRAIN) { E(acc, cur, wr, wc, fr, fq); S.done(cur); }
        if (!has_next) break;
#pragma unroll
        for (int a = 0; a < 2; ++a)
#pragma unroll
            for (int b = 0; b < 2; ++b)
#pragma unroll
                for (int m = 0; m < 4; ++m)
#pragma unroll
                    for (int n = 0; n < 2; ++n) acc[a][b][m][n] = (f32x4){0.f, 0.f, 0.f, 0.f};
        cur = nxt; cA = nA; cB = nB; ++ui;
    }
    PG8_WAIT_V(0);
    if (wr == 0) PG8_BAR;
    PG8_BAR;
    if constexpr (Epi::AFTER_DRAIN) { E.fused(acc, cur, wr, wc, fr, fq, lds, wid, lane); S.done(cur); }
#undef PG8_SA
#undef PG8_SB
#undef PG8_STAGE
#undef PG8_LDA
#undef PG8_LDB
#undef PG8_MMA
#undef PG8_WAIT_V
#undef PG8_WAIT_L
#undef PG8_BAR
#undef PG8_SCHED
}
}


namespace att {
using bf16 = unsigned short;
constexpr int   D = 128, NW = 8, QBLK = 32, KVBLK = 64;
constexpr float SCALE = 0.088388347648318440f;
constexpr float THR = 8.f;
constexpr int SDEPTH = 2;
constexpr int LDQ = 128, LDK = 128, LDO = D_MODEL;
constexpr size_t SHM_V = KVBLK * D * 2, SHM_K = KVBLK * D * 2, SHM_ATTN = 2 * SHM_V + 2 * SHM_K + NW * 64 * 4;
using bf16x8 = __attribute__((ext_vector_type(8))) short;
using s16x4  = __attribute__((ext_vector_type(4))) short;
using f32x16 = __attribute__((ext_vector_type(16))) float;
using f32x8  = __attribute__((ext_vector_type(8))) float;
using u32x4  = __attribute__((ext_vector_type(4))) unsigned;
#define KSWZ(row, colB) ((row) * 256 + ((colB) ^ (((row) & 7) << 4)))
#define SBAR() __builtin_amdgcn_sched_barrier(0)
__device__ __forceinline__ int crow(int r, int hi) { return (r & 3) + 8 * (r >> 2) + 4 * hi; }
__device__ __forceinline__ unsigned cvtpk(float lo, float hi) {
  unsigned r; asm volatile("v_cvt_pk_bf16_f32 %0, %1, %2" : "=v"(r) : "v"(lo), "v"(hi)); return r;
}
template <typename TIn> struct Stage;
template <> struct Stage<bf16>  { using T = bf16x8;
  __device__ static __forceinline__ T ld8(const bf16* p) { return *reinterpret_cast<const bf16x8*>(p); }
  __device__ static __forceinline__ bf16x8 tobf(T x) { return x; } };
template <> struct Stage<float> { using T = f32x8;
  __device__ static __forceinline__ T ld8(const float* p) { return *reinterpret_cast<const f32x8*>(p); }
  __device__ static __forceinline__ bf16x8 tobf(T x) {
    u32x4 w = {cvtpk(x[0], x[1]), cvtpk(x[2], x[3]), cvtpk(x[4], x[5]), cvtpk(x[6], x[7])}; return *reinterpret_cast<bf16x8*>(&w); } };

__device__ __forceinline__ void partialSM(f32x16& p0, f32x16& p1, float& m_reg, float& mn, float& alpha) {
  constexpr float C = SCALE * 1.4426950408889634f;
  float pmax = p0[0]; for (int r = 1; r < 16; ++r) pmax = fmaxf(pmax, p0[r]); for (int r = 0; r < 16; ++r) pmax = fmaxf(pmax, p1[r]);
  { auto rr = __builtin_amdgcn_permlane32_swap(__float_as_uint(pmax), __float_as_uint(pmax), false, false);
    pmax = fmaxf(__uint_as_float(rr[0]), __uint_as_float(rr[1])); }
  if (__builtin_expect(__all(pmax - m_reg <= THR / SCALE), 1)) { mn = m_reg; alpha = 1.f; }
  else { mn = fmaxf(m_reg, pmax); alpha = __builtin_amdgcn_exp2f((m_reg - mn) * C); m_reg = mn; }
  float mnC = -mn * C;
  for (int r = 0; r < 16; ++r) p0[r] = fmaf(p0[r], C, mnC); for (int r = 0; r < 16; ++r) p1[r] = fmaf(p1[r], C, mnC);
  for (int r = 0; r < 16; ++r) p0[r] = __builtin_amdgcn_exp2f(p0[r]);
}
__device__ __forceinline__ void finishSM(f32x16& p0, f32x16& p1, float alpha, float& l_reg, bf16x8& pa0, bf16x8& pa1, bf16x8& pa2, bf16x8& pa3) {
  for (int r = 0; r < 16; ++r) p1[r] = __builtin_amdgcn_exp2f(p1[r]);
  float ps = 0; for (int r = 0; r < 16; ++r) ps += p0[r]; for (int r = 0; r < 16; ++r) ps += p1[r];
  { auto rr = __builtin_amdgcn_permlane32_swap(__float_as_uint(ps), __float_as_uint(ps), false, false);
    ps = __uint_as_float(rr[0]) + __uint_as_float(rr[1]); }
  l_reg = l_reg * alpha + ps;
#define PK4(P, BASE, OUT) do { unsigned a0 = cvtpk(P[BASE + 0], P[BASE + 1]), a1 = cvtpk(P[BASE + 2], P[BASE + 3]);   \
    unsigned b0 = cvtpk(P[BASE + 4], P[BASE + 5]), b1 = cvtpk(P[BASE + 6], P[BASE + 7]);                              \
    auto r0 = __builtin_amdgcn_permlane32_swap(a0, b0, false, false); auto r1 = __builtin_amdgcn_permlane32_swap(a1, b1, false, false); \
    u32x4 w = {r0[0], r1[0], r0[1], r1[1]}; OUT = *reinterpret_cast<bf16x8*>(&w); } while (0)
  PK4(p0, 0, pa0); PK4(p0, 8, pa1); PK4(p1, 0, pa2); PK4(p1, 8, pa3);
#undef PK4
}
__device__ __forceinline__ void qkt(f32x16& p0, f32x16& p1, const bf16* Ks, const bf16x8* qr, int r32, int hi) {
  p0 = f32x16{}; p1 = f32x16{};
  for (int d0 = 0; d0 < 8; ++d0) { int cb = (d0 * 16 + hi * 8) * 2;
    bf16x8 b0 = *reinterpret_cast<const bf16x8*>((const char*)Ks + KSWZ(r32, cb));
    bf16x8 b1 = *reinterpret_cast<const bf16x8*>((const char*)Ks + KSWZ(32 + r32, cb));
    p0 = __builtin_amdgcn_mfma_f32_32x32x16_bf16(b0, qr[d0], p0, 0, 0, 0);
    p1 = __builtin_amdgcn_mfma_f32_32x32x16_bf16(b1, qr[d0], p1, 0, 0, 0); }
}
__device__ __forceinline__ int v_st(int k, int c) { const int kk = (k & ~0xC) | ((k & 4) << 1) | ((k & 8) >> 1); return ((kk >> 3) * 4 + (c >> 5)) * 512 + ((kk & 7) * 32 + (c & 31)) * 2; }
__device__ __forceinline__ int v_rd_base(int lane) { return ((lane & 3) << 3) | (((lane >> 2) & 3) << 6) | (((lane >> 4) & 1) << 5) | (((lane >> 5) & 1) << 8); }
constexpr int v_rd_off(int d0, int ks, int half) { return d0 * 512 + ks * 4096 + half * 2048; }
template <int OFF> __device__ __forceinline__ s16x4 tr_read(int vb) {
  s16x4 r; asm volatile("ds_read_b64_tr_b16 %0, %1 offset:%2" : "=&v"(r) : "v"(vb), "i"(OFF) : "memory"); return r;
}
template <int D0> __device__ __forceinline__ void pv_one(f32x16& od, int vb, bf16x8 pa0, bf16x8 pa1, bf16x8 pa2, bf16x8 pa3) {
  const s16x4 l0 = tr_read<v_rd_off(D0, 0, 0)>(vb), h0 = tr_read<v_rd_off(D0, 0, 1)>(vb), l1 = tr_read<v_rd_off(D0, 1, 0)>(vb), h1 = tr_read<v_rd_off(D0, 1, 1)>(vb);
  const s16x4 l2 = tr_read<v_rd_off(D0, 2, 0)>(vb), h2 = tr_read<v_rd_off(D0, 2, 1)>(vb), l3 = tr_read<v_rd_off(D0, 3, 0)>(vb), h3 = tr_read<v_rd_off(D0, 3, 1)>(vb);
  asm volatile("s_waitcnt lgkmcnt(0)" ::: "memory"); SBAR();
#define PK(L, H) (bf16x8){L[0], L[1], L[2], L[3], H[0], H[1], H[2], H[3]}
  od = __builtin_amdgcn_mfma_f32_32x32x16_bf16(pa0, PK(l0, h0), od, 0, 0, 0);
  od = __builtin_amdgcn_mfma_f32_32x32x16_bf16(pa1, PK(l1, h1), od, 0, 0, 0);
  od = __builtin_amdgcn_mfma_f32_32x32x16_bf16(pa2, PK(l2, h2), od, 0, 0, 0);
  od = __builtin_amdgcn_mfma_f32_32x32x16_bf16(pa3, PK(l3, h3), od, 0, 0, 0);
#undef PK
}
__device__ __forceinline__ void pv_d0(f32x16* o, int vb, bf16x8 pa0, bf16x8 pa1, bf16x8 pa2, bf16x8 pa3) {
  pv_one<0>(o[0], vb, pa0, pa1, pa2, pa3); pv_one<1>(o[1], vb, pa0, pa1, pa2, pa3); pv_one<2>(o[2], vb, pa0, pa1, pa2, pa3); pv_one<3>(o[3], vb, pa0, pa1, pa2, pa3);
}

__device__ __forceinline__ void attn_dense_body(const bf16* __restrict__ Qb, const bf16* __restrict__ Kh, const bf16* __restrict__ Vh,
                                                unsigned short* __restrict__ Ob, int seq, char* lds) {
  using St = Stage<bf16>; using SQ = Stage<bf16>; using TQ = bf16;
  const int tid = threadIdx.x, wid = tid >> 6, lane = tid & 63, r32 = lane & 31, hi = lane >> 5;
  bf16* V_lds = (bf16*)lds; bf16* K_lds = (bf16*)(lds + 2 * SHM_V);
  float* ws = (float*)(lds + 2 * SHM_V + 2 * SHM_K) + wid * 64; float* li_l = ws; float* al_l = ws + 32;
  float m_reg = -1e30f, l_reg = 0; f32x16 o[4] = {}; bf16x8 qr[8];
  const TQ* Qw = Qb + (long)(wid * QBLK + r32) * LDQ + hi * 8;
#pragma unroll
  for (int d0 = 0; d0 < 8; ++d0) qr[d0] = SQ::tobf(SQ::ld8(Qw + d0 * 16));
  const int sr = tid >> 4, sc = (tid & 15) * 8, vst0 = v_st(sr, sc), vst1 = v_st(32 + sr, sc);
  const int vb0 = (int)(uintptr_t)V_lds + v_rd_base(lane);
  struct { typename St::T vs0, vs1, ks0, ks1; } sr_[SDEPTH];
#define SLOAD(i, k0) do { sr_[i].vs0 = St::ld8(&Vh[(long)((k0) + sr) * LDK + sc]); sr_[i].vs1 = St::ld8(&Vh[(long)((k0) + 32 + sr) * LDK + sc]); \
    sr_[i].ks0 = St::ld8(&Kh[(long)((k0) + sr) * LDK + sc]); sr_[i].ks1 = St::ld8(&Kh[(long)((k0) + 32 + sr) * LDK + sc]); } while (0)
#define SWRITE(b, i) do { *(bf16x8*)((char*)V_lds + (b) * SHM_V + vst0) = St::tobf(sr_[i].vs0);          \
    *(bf16x8*)((char*)V_lds + (b) * SHM_V + vst1) = St::tobf(sr_[i].vs1); int kc = sc * 2;               \
    *(bf16x8*)((char*)K_lds + (b) * SHM_K + KSWZ(sr, kc)) = St::tobf(sr_[i].ks0);                       \
    *(bf16x8*)((char*)K_lds + (b) * SHM_K + KSWZ(32 + sr, kc)) = St::tobf(sr_[i].ks1); } while (0)
#define SWAIT() do { if constexpr (SDEPTH == 2) asm volatile("s_waitcnt vmcnt(4)" ::: "memory"); else asm volatile("s_waitcnt vmcnt(0)" ::: "memory"); } while (0)
#define RESC(a) do { if (__any((a) < 1.f)) { if (hi == 0) al_l[r32] = (a); asm volatile("s_waitcnt lgkmcnt(0)" ::: "memory"); \
    for (int d = 0; d < 4; ++d) for (int r = 0; r < 16; ++r) o[d][r] *= al_l[crow(r, hi)]; } } while (0)
  f32x16 pA0, pA1, pB0, pB1; float mnA, mnB, alA, alB; bf16x8 pa0, pa1, pa2, pa3; const int NT = seq / KVBLK;
  constexpr int SE = 0, SO = SDEPTH - 1;
  SLOAD(SE, 0); asm volatile("s_waitcnt vmcnt(0)" ::: "memory"); SWRITE(0, SE); __syncthreads();
  qkt(pA0, pA1, K_lds, qr, r32, hi); partialSM(pA0, pA1, m_reg, mnA, alA);
  SLOAD(SO, KVBLK); if constexpr (SDEPTH == 2) { if (2 < NT) SLOAD(SE, 2 * KVBLK); }
  SWAIT(); SWRITE(1, SO); __syncthreads();
  for (int j = 1; j + 1 < NT; j += 2) {
    SBAR(); qkt(pB0, pB1, (bf16*)((char*)K_lds + SHM_K), qr, r32, hi);
    finishSM(pA0, pA1, alA, l_reg, pa0, pa1, pa2, pa3); SBAR();
    SLOAD(SO, (j + SDEPTH) * KVBLK); SBAR();
    pv_d0(o, vb0, pa0, pa1, pa2, pa3); partialSM(pB0, pB1, m_reg, mnB, alB);
    __syncthreads(); SWAIT(); SWRITE(0, SE);
    RESC(alB); __syncthreads();
    SBAR(); qkt(pA0, pA1, K_lds, qr, r32, hi);
    finishSM(pB0, pB1, alB, l_reg, pa0, pa1, pa2, pa3); SBAR();
    if (SDEPTH == 1 || j + 3 < NT) SLOAD(SE, (j + 1 + SDEPTH) * KVBLK); SBAR();
    pv_d0(o, vb0 + (int)SHM_V, pa0, pa1, pa2, pa3); partialSM(pA0, pA1, m_reg, mnA, alA);
    __syncthreads(); SWAIT(); SWRITE(1, SO);
    RESC(alA); __syncthreads();
  }
  SBAR(); qkt(pB0, pB1, (bf16*)((char*)K_lds + SHM_K), qr, r32, hi);
  finishSM(pA0, pA1, alA, l_reg, pa0, pa1, pa2, pa3); SBAR();
  pv_d0(o, vb0, pa0, pa1, pa2, pa3); partialSM(pB0, pB1, m_reg, mnB, alB);
  __syncthreads(); RESC(alB);
  finishSM(pB0, pB1, alB, l_reg, pa0, pa1, pa2, pa3); SBAR();
  pv_d0(o, vb0 + (int)SHM_V, pa0, pa1, pa2, pa3);
  if (hi == 0) li_l[r32] = l_reg; asm volatile("s_waitcnt lgkmcnt(0)" ::: "memory");
  float rli[16];
#pragma unroll
  for (int r = 0; r < 16; ++r) rli[r] = __builtin_amdgcn_rcpf(li_l[crow(r, hi)]);
  unsigned short* Ow = Ob + (long)(wid * QBLK) * LDO;
#pragma unroll
  for (int r = 0; r < 16; ++r) { int orow = crow(r, hi);
    for (int d0 = 0; d0 < 4; ++d0) Ow[(long)orow * LDO + d0 * 32 + r32] = f2bf(o[d0][r] * rli[r]); }
#undef SLOAD
#undef SWRITE
#undef SWAIT
#undef RESC
}
}

__device__ __forceinline__ void cvt_tile(const float* __restrict__ W, int ldw, int nvalid, int k0, int n0, u16* __restrict__ Wt, int rowbase, int rmode, float* lds) {
    const int tid = threadIdx.x;
    for (int idx = tid; idx < 4096; idx += 512) { const int kk = idx >> 6, nn = idx & 63; const int n = n0 + nn;
        lds[kk * 65 + nn] = n < nvalid ? W[(size_t)(k0 + kk) * ldw + n] : 0.f; }
    __syncthreads();
    for (int idx = tid; idx < 1024; idx += 512) { const int nn = idx >> 4, k4 = (idx & 15) * 4; const int n = n0 + nn;
        int row = n;
        if (rmode) row = (n >> 7) * 256 + (n & 127) + (rmode == 2 ? 128 : 0);
        pg8::u32x2v w; w.x = pg8::cvt_pk_bf16(lds[(k4 + 0) * 65 + nn], lds[(k4 + 1) * 65 + nn]); w.y = pg8::cvt_pk_bf16(lds[(k4 + 2) * 65 + nn], lds[(k4 + 3) * 65 + nn]);
        *(pg8::u32x2v*)(Wt + (size_t)(rowbase + row) * D_MODEL + k0 + k4) = w; }
    __syncthreads();
}
__device__ __forceinline__ void ph_convert(const Params& p, float* lds) {
    constexpr int KT = D_MODEL / 64;
    constexpr int T_IN = KT * (LDP / 64), T_OUT = KT * (D_MODEL / 64), T_E = KT * (D_MODEL / 64);
    constexpr int PER_L = T_IN + T_OUT + NE * 3 * T_E, TOTAL = DEPTH * PER_L;
    for (int t = blockIdx.x; t < TOTAL; t += gridDim.x) {
        const int l = t / PER_L; int r = t % PER_L;
        if (r < T_IN) { const int kt = r % KT, nt = r / KT;
            cvt_tile(p.w_in + (size_t)l * D_MODEL * N_IN, N_IN, N_IN, kt * 64, nt * 64, p.wt_in + (size_t)l * LDP * D_MODEL, 0, 0, lds); continue; }
        r -= T_IN;
        if (r < T_OUT) { const int kt = r % KT, nt = r / KT;
            cvt_tile(p.w_out + (size_t)l * D_MODEL * D_MODEL, D_MODEL, D_MODEL, kt * 64, nt * 64, p.wt_out + (size_t)l * D_MODEL * D_MODEL, 0, 0, lds); continue; }
        r -= T_OUT;
        const int e = r / (3 * T_E), which = (r / T_E) % 3, q = r % T_E, kt = q % KT, nt = q / KT;
        const size_t eo = ((size_t)l * NE + e) * D_MODEL * D_MODEL;
        if (which == 0) cvt_tile(p.w_exp1 + eo, D_MODEL, D_MODEL, kt * 64, nt * 64, p.w13t + 2 * eo, 0, 1, lds);
        else if (which == 1) cvt_tile(p.w_exp3 + eo, D_MODEL, D_MODEL, kt * 64, nt * 64, p.w13t + 2 * eo, 0, 2, lds);
        else cvt_tile(p.w_exp2 + eo, D_MODEL, D_MODEL, kt * 64, nt * 64, p.w2t + eo, 0, 0, lds);
    }
}

constexpr int LDS_BYTES = 147456;
constexpr int LDS_MISC = 147392;
constexpr int NPL = 15;
constexpr int NPHASE = 2 + DEPTH * NPL + 1;

struct Args { Params p; int ph_lo, ph_hi, flags, pad; };

template <int G> __device__ __forceinline__ Exec mk_exec() { const int gt = blockIdx.x * 512 + threadIdx.x; return Exec{gt / G, (int)(gridDim.x * 512) / G, gt % G}; }
typedef const __attribute__((address_space(4))) unsigned long long* kq_t;
__device__ __forceinline__ void load_params(Params& p, const __attribute__((address_space(4))) unsigned char* ka) {
    kq_t s = (kq_t)ka; unsigned long long* d = (unsigned long long*)&p;
#pragma unroll
    for (int i = 0; i < (int)(sizeof(Params) / 8); ++i) d[i] = s[i];
}
#define LOADP() Params p; load_params(p, ka)
#define PH(k, ...) do { if (lo <= (k) && (k) < hi) { { LOADP(); __VA_ARGS__; } if ((k) + 1 < hi) xcd_barrier(bar); } } while (0)
#define e1 mk_exec<1>()
#define e16 mk_exec<16>()
#define e64 mk_exec<64>()
#define flds ((float*)lds)
#define glds ((PG8_LAS unsigned char*)lds)
#define G ((int)gridDim.x)
#define c ((int)blockIdx.x)
template <int L> __device__ __forceinline__ void layer_phases(const __attribute__((address_space(4))) unsigned char* ka, int lo, int hi, int flags, const XcdBarrier& bar, unsigned char* lds) {
    constexpr int l = L;
        const int b0 = 2 + l * NPL; const bool last = (l == DEPTH - 1);
        PH(b0 + 0, ph_norm1<64>(p, l, e64));
        PH(b0 + 1, { pg8::Gemm g{p.h, p.wt_in + (size_t)l * LDP * D_MODEL, MROWS, LDP, D_MODEL}; pg8::StaticOrder S; S.init(MROWS, LDP, G, c);
                     pg8::EpiF32 E{p.P, LDP}; pg8::gemm_phase<pg8::EpiF32, pg8::StaticOrder>(glds, g, S, E); });
        PH(b0 + 2, ph_rw_prep1<64>(p, l, e64); ph_ml_g1<64>(p, l, e64); ph_gd_prep<64>(p, l, e64); ph_gd_gates<64>(p, l, e64); ph_at_prep<64>(p, l, e64));
        PH(b0 + 3, ph_rw_prep2<64>(p, l, e64); ph_ml_g2(p, e1); ph_gd_c1(p, e64));
        PH(b0 + 4, { for (int u = c; u < RW_CN; u += G) ph_rw_c1_unit(p, u, threadIdx.x, 512, lds); for (int u = G - 1 - c; u < ML_CN; u += G) ph_ml_c1_unit(p, u, threadIdx.x, 512, lds); });
        PH(b0 + 5, {
            const int nlat = BATCH * AT_QH * (SEQ / 256), nctx = last ? 0 : BATCH * AT_QH;
            if (flags & 1) {} else if (c < nlat) { const int u = c;
                const int qb = u % (SEQ / 256), hq = (u / (SEQ / 256)) % AT_QH, b = u / ((SEQ / 256) * AT_QH), s0 = CTX + qb * 256, kvh = hq / (AT_QH / AT_KVH);
                att::attn_dense_body((const att::bf16*)p.at_q + (((size_t)b * AT_QH + hq) * TOK + s0) * AT_HEAD,
                                     (const att::bf16*)p.at_k + ((size_t)b * AT_KVH + kvh) * TOK * AT_HEAD, (const att::bf16*)p.at_v + ((size_t)b * AT_KVH + kvh) * TOK * AT_HEAD,
                                     p.mix + ((size_t)b * TOK + s0) * D_MODEL + 3 * GROUP_W + hq * AT_HEAD, TOK, (char*)lds);
                __syncthreads(); }
            else if (c < nlat + nctx) { const int u = c - nlat;
                const int hq = u % AT_QH, b = u / AT_QH, kvh = hq / (AT_QH / AT_KVH);
                att::attn_dense_body((const att::bf16*)p.at_q + (((size_t)b * AT_QH + hq) * TOK) * AT_HEAD,
                                     (const att::bf16*)p.at_k + ((size_t)b * AT_KVH + kvh) * TOK * AT_HEAD, (const att::bf16*)p.at_v + ((size_t)b * AT_KVH + kvh) * TOK * AT_HEAD,
                                     p.mix + ((size_t)b * TOK) * D_MODEL + 3 * GROUP_W + hq * AT_HEAD, CTX, (char*)lds);
                __syncthreads(); }
            else { const int c2 = c - nlat - nctx, G2 = G - nlat - nctx; constexpr int NU1 = (RW_CN + TS_G - 1) / TS_G, NU2 = (GD_CN + TS_G - 1) / TS_G;
                if (!(flags & 2)) for (int u = c2; u < NU1 + NU2; u += G2) { if (u < NU1) ph_tsolve_unit(p.rw_Ma, p.rw_T, RW_CN, u, threadIdx.x, 512, lds); else ph_tsolve_unit(p.gd_A, p.gd_T, GD_CN, u - NU1, threadIdx.x, 512, lds); } } });
        PH(b0 + 6, { if (!(flags & 4)) for (int u = c; u < RW_CN; u += G) ph_rw_c3_unit(p, u, threadIdx.x, 512, lds);
                     if (!(flags & 8)) for (int u = G - 1 - c; u < GD_CN; u += G) ph_gd_c3_unit(p, u, threadIdx.x, 512, lds);
                     ph_ml_prefix(p, e1); });
        PH(b0 + 7, { if (!(flags & 16)) for (int u = c; u < GD_S2_UNITS; u += G) ph_gd_scan2_unit(p, u, threadIdx.x, 512, lds); }
                   { if (!(flags & 32)) for (int u = G - 1 - c; u < RW_CH; u += G) ph_rw_scan2_unit(p, u, threadIdx.x, 512, lds); }
                   { if (!(flags & 64)) for (int u = c - GD_S2_UNITS; u < ML_CN; u += G - GD_S2_UNITS - RW_CH) if (u >= 0 && c < G - RW_CH) ph_ml_c2_unit(p, u, threadIdx.x, 512, lds); });
        PH(b0 + 8, ph_rw_post<64>(p, l, e64); ph_gd_post<64>(p, l, e64); ph_ml_post<64>(p, l, e64));
        PH(b0 + 9, { pg8::Gemm g{p.mix, p.wt_out + (size_t)l * D_MODEL * D_MODEL, MROWS, D_MODEL, D_MODEL}; pg8::TileOrder S;
                      S.init(last ? BATCH * SEQ / 256 : MROWS / 256, D_MODEL / 256, G, c, last ? 1 : 0);
                      pg8::EpiResid E{p.xres, p.mod + (size_t)l * 3 * 6 * D_MODEL}; pg8::gemm_phase<pg8::EpiResid, pg8::TileOrder>(glds, g, S, E); });
        PH(b0 + 10, ph_norm2<64>(p, l, e64));
        PH(b0 + 11, { for (int u = c; u < topk_units(l); u += G) ph_topk_unit(p, l, u, threadIdx.x, 512, lds); });
        PH(b0 + 12, ph_gather<64>(p, l, e64));
        PH(b0 + 13, { pg8::Gemm g{p.xs, p.w13t + (size_t)l * NE * 2 * D_MODEL * D_MODEL, NE * NSLOT, NE * 2 * D_MODEL, D_MODEL}; pg8::GroupedOrder S;
                      S.init(last ? NSLOT_L / 256 : NSLOT / 256, 2 * D_MODEL / 256, NSLOT / 256, G, c);
                      pg8::EpiSwiGLU E{p.hid, 2 * D_MODEL / 256}; pg8::gemm_phase<pg8::EpiSwiGLU, pg8::GroupedOrder>(glds, g, S, E); });
        PH(b0 + 14, { pg8::Gemm g{p.hid, p.w2t + (size_t)l * NE * D_MODEL * D_MODEL, NE * NSLOT, NE * D_MODEL, D_MODEL}; pg8::GroupedOrder S;
                      S.init(last ? NSLOT_L / 256 : NSLOT / 256, D_MODEL / 256, NSLOT / 256, G, c);
                      pg8::EpiGate E{p.yexp, p.sel_gate, D_MODEL / 256}; pg8::gemm_phase<pg8::EpiGate, pg8::GroupedOrder>(glds, g, S, E); });
    }
__global__ void __launch_bounds__(512, 2) mega(Args args) {
    extern __shared__ __attribute__((aligned(16))) unsigned char lds[];
    typedef const __attribute__((address_space(4))) unsigned char* kptr_t;
    const kptr_t ka = (kptr_t)__builtin_amdgcn_kernarg_segment_ptr();
    (void)args;
    const unsigned long long lohi = ((kq_t)ka)[sizeof(Params) / 8]; const int lo = (int)(unsigned)lohi, hi = (int)(unsigned)(lohi >> 32);
    const int flags = (int)(unsigned)((kq_t)ka)[sizeof(Params) / 8 + 1];
    unsigned* barw = (unsigned*)((kq_t)ka)[offsetof(Params, bar) / 8];
    volatile LAS unsigned* misc = (volatile LAS unsigned*)((LAS unsigned char*)lds + LDS_MISC);
    if (threadIdx.x < 4) misc[threadIdx.x] = 0u;
    __syncthreads();
    const bool use_bar = (hi - lo) > 1;
    XcdBarrier bar; bar.bar = barw; bar.x = 0; bar.st = misc;
    if (use_bar) bar = xcd_barrier_post(barw, misc);
    PH(0, ph_convert(p, flds); ph_mod_partial(p, e1));
    PH(1, ph_mod_final(p, e1));
    layer_phases<0>(ka, lo, hi, flags, bar, lds);
    layer_phases<1>(ka, lo, hi, flags, bar, lds);
    static_assert(DEPTH == 2, "depth");
    PH(2 + DEPTH * NPL, ph_final<64>(p, e64));
}
#undef PH
#undef e1
#undef e16
#undef e64
#undef flds
#undef glds
#undef G
#undef c
#undef LOADP

static size_t ws_carve(Params& p, unsigned char* ws) {
    size_t off = 0;
    auto take = [&](size_t bytes) { size_t o = off; off += (bytes + 255) / 256 * 256; return ws ? ws + o : (unsigned char*)nullptr; };
    p.bar = (unsigned*)take(XCD_BAR_WORDS * 4);
    p.modp = (float*)take((size_t)DEPTH * MOD_KS * 3 * 6 * D_MODEL * 4); p.mod = (float*)take((size_t)DEPTH * 3 * 6 * D_MODEL * 4);
    p.wt_in = (u16*)take((size_t)DEPTH * LDP * D_MODEL * 2); p.wt_out = (u16*)take((size_t)DEPTH * D_MODEL * D_MODEL * 2);
    p.w13t = (u16*)take((size_t)DEPTH * NE * 2 * D_MODEL * D_MODEL * 2); p.w2t = (u16*)take((size_t)DEPTH * NE * D_MODEL * D_MODEL * 2);
    p.xres = (float*)take((size_t)MROWS * D_MODEL * 4); p.h = (u16*)take((size_t)MROWS * D_MODEL * 2); p.mix = (u16*)take((size_t)MROWS * D_MODEL * 2);
    p.aff = (float*)take((size_t)MROWS * NE * 4); p.inv = (int*)take((size_t)MROWS * NE * 4);
    p.sel_row = (int*)take((size_t)NE * NSLOT * 4); p.sel_gate = (float*)take((size_t)NE * NSLOT * 4);
    const size_t region = off;
    p.P = (float*)take((size_t)MROWS * LDP * 4);
    const size_t rg = (size_t)MROWS * GROUP_W * 4;
    p.rw_r = (float*)take(rg); p.rw_k = (float*)take(rg); p.rw_v = (float*)take(rg); p.rw_kk = (float*)take(rg); p.rw_g = (float*)take(rg);
    p.rw_lr = (float*)take((size_t)MROWS * RW_LR * 4);
    p.rw_ew = (float*)take(2 * rg); p.rw_kka = (float*)take(2 * rg); p.rw_kt = (float*)take(2 * rg); p.rw_y = (float*)take(2 * rg);
    p.rw_Ma = (float*)take((size_t)RW_CN * CHUNK * CHUNK * 4); p.rw_T = (float*)take((size_t)RW_CN * CHUNK * CHUNK * 4);
    p.rw_Psi = (float*)take((size_t)RW_CN * RW_N * RW_N * 4); p.rw_Y0 = p.rw_Ma;
    p.rw_PhiT = (u16*)take((size_t)RW_CN * RW_N * RW_N * 2); p.rw_Rh = (u16*)take((size_t)RW_CN * CHUNK * RW_N * 2);
    p.ml_bcum = (float*)take((size_t)ML_CH * TOK * 4); p.ml_g = (float*)take((size_t)ML_CH * TOK * 4); p.ml_gmax = (float*)take((size_t)ML_CH * TOK * 4);
    p.ml_bl = (float*)take((size_t)ML_CH * NCHUNK * 4); p.ml_gm = (float*)take((size_t)ML_CH * NCHUNK * 4); p.ml_min = (float*)take((size_t)ML_CH * NCHUNK * 4);
    p.ml_dC = (float*)take((size_t)ML_CH * NCHUNK * ML_HEAD * ML_HEAD * 4); p.ml_dn = (float*)take((size_t)ML_CH * NCHUNK * ML_HEAD * 4);
    p.ml_S = (float*)take((size_t)ML_CH * NCHUNK * CHUNK * CHUNK * 4); p.ml_hh = (float*)take(2 * rg);
    p.gd_q = (float*)take(rg); p.gd_k = (float*)take(rg); p.gd_v = (float*)take(rg);
    p.gd_gc = (float*)take((size_t)GD_CH * TOK * 4); p.gd_beta = (float*)take((size_t)GD_CH * TOK * 4);
    p.gd_A = (float*)take((size_t)GD_CN * CHUNK * CHUNK * 4); p.gd_T = (float*)take((size_t)GD_CN * CHUNK * CHUNK * 4);
    p.gd_Psi = (float*)take((size_t)GD_CN * GD_N * GD_N * 4); p.gd_O0 = (float*)take((size_t)GD_CN * CHUNK * GD_N * 4);
    p.gd_Phi = (u16*)take((size_t)GD_CN * GD_N * GD_N * 2); p.gd_Qh = (u16*)p.gd_A;
    p.gd_o = (float*)take(2 * rg);
    p.at_q = (u16*)take((size_t)BATCH * AT_QH * TOK * AT_HEAD * 2); p.at_k = (u16*)take((size_t)BATCH * AT_KVH * TOK * AT_HEAD * 2); p.at_v = (u16*)take((size_t)BATCH * AT_KVH * TOK * AT_HEAD * 2);
    const size_t end1 = off;
    off = region;
    p.xs = (u16*)take((size_t)NE * NSLOT * D_MODEL * 2); p.hid = (u16*)take((size_t)NE * NSLOT * D_MODEL * 2); p.yexp = (float*)take((size_t)NE * NSLOT * D_MODEL * 4);
    return end1 > off ? end1 : off;
}

#ifndef MK_PER_PHASE
#define MK_PER_PHASE 0
#endif
extern "C" void kernel_launch(void* const* d_in, const int* in_sizes, int n_in, void* d_out, int out_size, void* d_ws, size_t ws_size, hipStream_t stream) {
    static int grid = 0;
    if (grid == 0) {
        Params q{}; const size_t need = ws_carve(q, nullptr);
        if (n_in != 35 || out_size != BATCH * SEQ * D_MODEL || ws_size < need) {
            fprintf(stderr, "kernel_launch: expected 35 inputs, out %d, ws >= %zu; got n_in %d out %d ws %zu\n", BATCH * SEQ * D_MODEL, need, n_in, out_size, ws_size); grid = -1; return; }
        int dev = 0, cus = 0, per_cu = 0;
        if (hipGetDevice(&dev) != hipSuccess || hipDeviceGetAttribute(&cus, hipDeviceAttributeMultiprocessorCount, dev) != hipSuccess) { grid = -1; return; }
        if (hipFuncSetAttribute((const void*)mega, hipFuncAttributeMaxDynamicSharedMemorySize, LDS_BYTES) != hipSuccess) { fprintf(stderr, "kernel_launch: hipFuncSetAttribute failed\n"); grid = -1; return; }
        if (hipOccupancyMaxActiveBlocksPerMultiprocessor(&per_cu, (const void*)mega, 512, LDS_BYTES) != hipSuccess || per_cu < 1)
            fprintf(stderr, "kernel_launch: occupancy query reports %d workgroups per CU\n", per_cu);
        (void)hipGetLastError();
        if (cus < 160) { fprintf(stderr, "kernel_launch: needs >= 160 CUs\n"); grid = -1; return; }
        grid = cus;
    }
    if (grid < 0) return;
    Args a{};
    Params& p = a.p;
    const float** in = (const float**)&p;
    for (int i = 0; i < 35; ++i) in[i] = (const float*)d_in[i];
    p.out = (float*)d_out;
    (void)ws_carve(p, (unsigned char*)d_ws);
    (void)hipMemsetAsync(p.bar, 0, XCD_BAR_WORDS * 4, stream);
#if MK_PER_PHASE
    for (int k = 0; k < NPHASE; ++k) { a.ph_lo = k; a.ph_hi = k + 1; hipLaunchKernelGGL(mega, dim3(grid), dim3(512), LDS_BYTES, stream, a); }
#else
#ifdef MK_PROBE_K
#ifdef MK_PROBE_FLAGS
    a.flags = MK_PROBE_FLAGS;
#endif
    a.ph_lo = 0; a.ph_hi = MK_PROBE_K;
    hipLaunchKernelGGL(mega, dim3(grid), dim3(512), LDS_BYTES, stream, a);
    (void)hipMemsetAsync(p.bar, 0, XCD_BAR_WORDS * 4, stream);
    a.flags = 0;
#endif
    a.ph_lo = 0; a.ph_hi = NPHASE;
    hipLaunchKernelGGL(mega, dim3(grid), dim3(512), LDS_BYTES, stream, a);
#endif
    const hipError_t le = hipPeekAtLastError();
    if (le != hipSuccess) fprintf(stderr, "kernel_launch: launch failed: %s\n", hipGetErrorName(le));
}
```

```cpp
#include <hip/hip_runtime.h>

#ifndef CFG_D_MODEL
#define CFG_D_MODEL 2048
#define CFG_SEQ 4096
#define CFG_GRID_W 64
#define CFG_CTX 256
#define CFG_RW_HEAD 64
#define CFG_RW_DR 64
#define CFG_RW_IR 64
#define CFG_RW_GR 128
#define CFG_ML_HEAD 128
#define CFG_CHUNK 64
#define CFG_GD_HEAD 128
#define CFG_AT_HEAD 128
#define CFG_AT_KVH 2
#define CFG_NE 16
#endif

constexpr int D_MODEL = CFG_D_MODEL, BATCH = 2, SEQ = CFG_SEQ, DEPTH = 2, GRID_W = CFG_GRID_W, CTX = CFG_CTX;
constexpr int TOK = CTX + SEQ, MROWS = BATCH * TOK, GROUP_W = D_MODEL / 4;
constexpr int RW_HEAD = CFG_RW_HEAD, RW_HEADS = GROUP_W / RW_HEAD, RW_DR = CFG_RW_DR, RW_IR = CFG_RW_IR, RW_GR = CFG_RW_GR;
constexpr int RW_COLS = 3 * GROUP_W + RW_DR + RW_IR + RW_GR, RW_LR = RW_DR + RW_IR + RW_GR;
constexpr int ML_HEAD = CFG_ML_HEAD, ML_HEADS = GROUP_W / ML_HEAD, CHUNK = CFG_CHUNK, ML_COLS = 4 * GROUP_W + 4 * ML_HEADS;
constexpr int GD_HEAD = CFG_GD_HEAD, GD_HEADS = GROUP_W / GD_HEAD, GD_COLS = 4 * GROUP_W + 4 * GD_HEADS;
constexpr int AT_HEAD = CFG_AT_HEAD, AT_QH = GROUP_W / AT_HEAD, AT_KVH = CFG_AT_KVH, AT_COLS = (AT_QH + 2 * AT_KVH) * AT_HEAD;
constexpr int N_IN = RW_COLS + ML_COLS + GD_COLS + AT_COLS;
constexpr int RW_OFF = 0, ML_OFF = RW_COLS, GD_OFF = ML_OFF + ML_COLS, AT_OFF = GD_OFF + GD_COLS;
constexpr int LDP = (N_IN + 255) / 256 * 256;
constexpr int NE = CFG_NE, CAPL = 2 * SEQ / NE, CAPC = 2 * CTX / NE;
constexpr int NSLOT_L = BATCH * CAPL, NSLOT_C = BATCH * CAPC;
constexpr int NSLOT = (NSLOT_L + NSLOT_C + 255) / 256 * 256;
constexpr int NCHUNK = TOK / CHUNK, ML_CH = BATCH * ML_HEADS * 2, GD_CH = BATCH * GD_HEADS * 2, RW_CH = BATCH * RW_HEADS * 2;
constexpr float NORM_EPS = 1e-6f, RW_GN_EPS = 64e-5f, RW_DECAY_SCALE = 0.6065306597126334f;
static_assert(ML_HEADS == GD_HEADS, "heads");

typedef unsigned short u16;

#ifdef CPU_TEST
#include <cmath>
#include <cstdint>
#include <cstring>
#define HD inline
#else
#define HD __device__ __forceinline__
#endif

struct Params {
    const float *x, *c, *ctx, *c_ctx, *ada_w, *ada_b, *norm1_g, *norm2_g, *w_in, *w_out;
    const float *rw_mu, *rw_w0, *rw_w_up, *rw_a0, *rw_a_up, *rw_g_up, *rw_k_k, *rw_k_a, *rw_r_k, *rw_ln_w, *rw_ln_b;
    const float *ml_ib, *ml_fb, *ml_norm_g, *gd_conv, *gd_a_log, *gd_dt_bias, *gd_norm_g, *at_q_norm, *at_k_norm;
    const float *w_router, *w_exp1, *w_exp3, *w_exp2, *final_g;
    float* out;
    unsigned* bar;
    float *modp, *mod;
    u16 *wt_in, *wt_out, *w13t, *w2t;
    float* xres;
    u16* h;
    float* P;
    float *rw_r, *rw_k, *rw_v, *rw_lr, *rw_kk, *rw_g, *rw_ew, *rw_kka, *rw_kt, *rw_y;
    float *rw_Ma, *rw_T, *rw_Psi, *rw_Y0; u16 *rw_PhiT, *rw_Rh, *rw_W;
    float *ml_bcum, *ml_g, *ml_gmax, *ml_bl, *ml_gm, *ml_min, *ml_dC, *ml_dn, *ml_S, *ml_hh;
    float *gd_q, *gd_k, *gd_v, *gd_gc, *gd_beta, *gd_A, *gd_T, *gd_Psi, *gd_O0, *gd_o; u16 *gd_Phi, *gd_Qh;
    u16 *at_q, *at_k, *at_v;
    u16* mix;
    float* aff; int* inv;
    int* sel_row; float* sel_gate;
    u16 *xs, *hid; float* yexp;
};

struct Exec { int gid, ngroups, gl; };

template <int G> HD float group_sum(float v) {
#ifndef CPU_TEST
#pragma unroll
    for (int o = G / 2; o > 0; o >>= 1) v += __shfl_xor(v, o, 64);
#endif
    return v;
}
template <int G> HD float group_max(float v) {
#ifndef CPU_TEST
#pragma unroll
    for (int o = G / 2; o > 0; o >>= 1) v = fmaxf(v, __shfl_xor(v, o, 64));
#endif
    return v;
}

template <int G> HD float group_scan_sum(float v, int gl) {
#ifndef CPU_TEST
#pragma unroll
    for (int o = 1; o < G; o <<= 1) { const float t = __shfl_up(v, o, G); if (gl >= o) v += t; }
#endif
    (void)gl; return v;
}
template <int G> HD float group_scan_max(float v, int gl) {
#ifndef CPU_TEST
#pragma unroll
    for (int o = 1; o < G; o <<= 1) { const float t = __shfl_up(v, o, G); if (gl >= o) v = fmaxf(v, t); }
#endif
    (void)gl; return v;
}
template <int G> HD float group_last(float v) {
#ifndef CPU_TEST
    v = __shfl(v, G - 1, G);
#endif
    return v;
}

HD u16 f2bf(float f) { unsigned u; memcpy(&u, &f, 4); u += 0x7FFFu + ((u >> 16) & 1u); return (u16)(u >> 16); }
HD float bf2f(u16 b) { unsigned u = ((unsigned)b) << 16; float f; memcpy(&f, &u, 4); return f; }
HD float sigmoidf_(float x) { return 1.f / (1.f + expf(-x)); }
HD float siluf_(float x) { return x / (1.f + expf(-x)); }
HD float softplusf_(float x) { return x > 20.f ? x : log1pf(expf(x)); }
HD float logsigmoidf_(float x) { return x < 0.f ? x - log1pf(expf(x)) : -log1pf(expf(-x)); }

HD float bf_round(float f) { return bf2f(f2bf(f)); }
#ifndef CPU_TEST
typedef short mma_bf16x8 __attribute__((ext_vector_type(8)));
typedef float mma_f32x16 __attribute__((ext_vector_type(16)));
__device__ __forceinline__ unsigned mma_cvt_pk(float lo, float hi) { unsigned r; asm volatile("v_cvt_pk_bf16_f32 %0, %1, %2" : "=v"(r) : "v"(lo), "v"(hi)); return r; }
#endif
struct Frag {
#ifdef CPU_TEST
    float v[8];
    HD void ld_bf(const u16* p) { for (int j = 0; j < 8; ++j) v[j] = bf2f(p[j]); }
    HD void ld_f(const float* p) { for (int j = 0; j < 8; ++j) v[j] = bf_round(p[j]); }
    HD void ld_f_scaled(const float* p, float w) { for (int j = 0; j < 8; ++j) v[j] = bf_round(p[j] * w); }
    HD void set1(float x) { for (int j = 0; j < 8; ++j) v[j] = bf_round(x); }
    HD void neg() { for (int j = 0; j < 8; ++j) v[j] = -v[j]; }
#else
    typedef unsigned u4 __attribute__((ext_vector_type(4)));
    typedef float f4 __attribute__((ext_vector_type(4)));
    u4 raw;
    HD void ld_bf(const u16* p) { raw = *(const u4*)p; }
    HD void ld_f(const float* p) { const f4 a = *(const f4*)p, b = *(const f4*)(p + 4);
        raw.x = mma_cvt_pk(a.x, a.y); raw.y = mma_cvt_pk(a.z, a.w); raw.z = mma_cvt_pk(b.x, b.y); raw.w = mma_cvt_pk(b.z, b.w); }
    HD void ld_f_scaled(const float* p, float w) { const f4 a = *(const f4*)p * w, b = *(const f4*)(p + 4) * w;
        raw.x = mma_cvt_pk(a.x, a.y); raw.y = mma_cvt_pk(a.z, a.w); raw.z = mma_cvt_pk(b.x, b.y); raw.w = mma_cvt_pk(b.z, b.w); }
    HD void set1(float x) { const unsigned q = mma_cvt_pk(x, x); raw.x = q; raw.y = q; raw.z = q; raw.w = q; }
    HD void neg() { raw.x ^= 0x80008000u; raw.y ^= 0x80008000u; raw.z ^= 0x80008000u; raw.w ^= 0x80008000u; }
#endif
};
#ifdef CPU_TEST
constexpr int MMA_SLOTS = 1024;
#else
constexpr int MMA_SLOTS = 16;
#endif
template <int K, class FA, class FB, class FE> HD void wave_mma32(int lane, FA fa, FB fb, FE fe) {
    static_assert(K % 16 == 0, "K");
#ifdef CPU_TEST
    (void)lane;
    for (int m = 0; m < 32; ++m) for (int n = 0; n < 32; ++n) { float acc = 0.f;
        for (int k0 = 0; k0 < K; k0 += 8) { Frag a8, b8; fa(m, k0, a8); fb(n, k0, b8);
            for (int j = 0; j < 8; ++j) acc += a8.v[j] * b8.v[j]; }
        fe(m, n, acc, m * 32 + n); }
#else
    const int r = lane & 31, h = lane >> 5;
    mma_f32x16 acc;
#pragma unroll
    for (int q = 0; q < 16; ++q) acc[q] = 0.f;
#pragma unroll
    for (int k0 = 0; k0 < K; k0 += 16) { Frag a8, b8; fa(r, k0 + 8 * h, a8); fb(r, k0 + 8 * h, b8);
        acc = __builtin_amdgcn_mfma_f32_32x32x16_bf16(__builtin_bit_cast(mma_bf16x8, a8.raw), __builtin_bit_cast(mma_bf16x8, b8.raw), acc, 0, 0, 0); }
#pragma unroll
    for (int q = 0; q < 16; ++q) fe((q & 3) + 8 * (q >> 2) + 4 * h, r, acc[q], q);
#endif
}

#ifndef CPU_TEST
typedef unsigned pfv4 __attribute__((ext_vector_type(4)));
template <int NQ> HD void pf_ld_lin(pfv4 (&r)[NQ], const void* src, int tid) {
#pragma unroll
    for (int q = 0; q < NQ; ++q) r[q] = ((const pfv4*)src)[tid + q * 512]; }
template <int NQ> HD void pf_ld_rows(pfv4 (&r)[NQ], const float* src, int per_row, int row_stride, int tid) {
#pragma unroll
    for (int q = 0; q < NQ; ++q) { const int i = tid + q * 512; r[q] = *(const pfv4*)(src + (size_t)(i / per_row) * row_stride + (i % per_row) * 4); } }
template <int NQ> HD void pf_st_lin(const pfv4 (&r)[NQ], void* dst, int tid) {
#pragma unroll
    for (int q = 0; q < NQ; ++q) ((pfv4*)dst)[tid + q * 512] = r[q]; }
template <int NQ> HD void pf_st_pad(const pfv4 (&r)[NQ], u16* dst, int per_row, int ld, int tid) {
#pragma unroll
    for (int q = 0; q < NQ; ++q) { const int i = tid + q * 512; *(pfv4*)(dst + (i / per_row) * ld + (i % per_row) * 8) = r[q]; } }
#endif
#ifdef CPU_TEST
#define BLOCK_SYNC()
#define BLOCK_FOR(i, n) for (int i = 0; i < (n); ++i)
#define WAVE_FOR(w, n) for (int w = 0; w < (n); ++w)
#define LANE 0
#define OPAQUE_TID()
#else
#define BLOCK_SYNC() __syncthreads()
#define BLOCK_FOR(i, n) for (int i = tid; i < (n); i += nthr)
#define WAVE_FOR(w, n) _Pragma("unroll 1") for (int w = tid >> 6; w < (n); w += (nthr >> 6))
#define LANE (tid & 63)
#define OPAQUE_TID() asm volatile("" : "+v"(tid))
#endif

HD int row_b(int R) { return R / TOK; }
HD int row_s(int R) { return R % TOK; }
HD bool row_ctx(int R) { return row_s(R) < CTX; }
HD int mod_sel(int R) { return row_ctx(R) ? 2 : row_b(R); }
HD int seq_s(int d, int p) { return d == 0 ? p : (p < CTX ? CTX - 1 - p : TOK - 1 - (p - CTX)); }
HD const float* modv(const Params& p, int layer, int sel, int k) { return p.mod + ((size_t)(layer * 3 + sel) * 6 + k) * D_MODEL; }

constexpr int MOD_KS = 16;
HD void ph_mod_partial(const Params& p, Exec e) {
    const int n = DEPTH * MOD_KS * 6 * D_MODEL;
    for (int it = e.gid; it < n; it += e.ngroups) {
        const int col = it % (6 * D_MODEL), ks = (it / (6 * D_MODEL)) % MOD_KS, l = it / (6 * D_MODEL * MOD_KS);
        const float* w = p.ada_w + (size_t)l * D_MODEL * 6 * D_MODEL + col;
        float a0 = 0.f, a1 = 0.f, a2 = 0.f;
        const int k0 = ks * (D_MODEL / MOD_KS);
        for (int k = k0; k < k0 + D_MODEL / MOD_KS; ++k) {
            const float wv = w[(size_t)k * 6 * D_MODEL];
            a0 += siluf_(p.c[k]) * wv; a1 += siluf_(p.c[D_MODEL + k]) * wv; a2 += siluf_(p.c_ctx[k]) * wv;
        }
        float* o = p.modp + ((size_t)(l * MOD_KS + ks) * 3) * 6 * D_MODEL + col;
        o[0] = a0; o[6 * D_MODEL] = a1; o[2 * 6 * D_MODEL] = a2;
    }
}
HD void ph_mod_final(const Params& p, Exec e) {
    const int n = DEPTH * 3 * 6 * D_MODEL;
    for (int it = e.gid; it < n; it += e.ngroups) {
        const int col = it % (6 * D_MODEL), sel = (it / (6 * D_MODEL)) % 3, l = it / (6 * D_MODEL * 3);
        float a = p.ada_b[l * 6 * D_MODEL + col];
        for (int ks = 0; ks < MOD_KS; ++ks) a += p.modp[((size_t)(l * MOD_KS + ks) * 3 + sel) * 6 * D_MODEL + col];
        p.mod[(size_t)(l * 3 + sel) * 6 * D_MODEL + col] = a;
    }
}

HD float resid_in(const Params& p, int layer, int R, int c) {
    if (layer == 0) { const int b = row_b(R), s = row_s(R);
        return s < CTX ? p.ctx[((size_t)b * CTX + s) * D_MODEL + c] : p.x[((size_t)b * SEQ + (s - CTX)) * D_MODEL + c]; }
    float v = p.xres[(size_t)R * D_MODEL + c];
    const float m5 = modv(p, layer - 1, mod_sel(R), 5)[c];
    float acc = 0.f;
    for (int ex = 0; ex < NE; ++ex) { const int j = p.inv[(size_t)R * NE + ex]; if (j >= 0) acc += p.yexp[((size_t)ex * NSLOT + j) * D_MODEL + c]; }
    return v + m5 * acc;
}
template <int G> HD void ph_norm1(const Params& p, int layer, Exec e) {
    for (int R = e.gid; R < MROWS; R += e.ngroups) {
        float ss = 0.f;
        for (int c = e.gl; c < D_MODEL; c += G) { const float v = resid_in(p, layer, R, c); p.xres[(size_t)R * D_MODEL + c] = v; ss += v * v; }
        ss = group_sum<G>(ss);
        const float rstd = 1.f / sqrtf(ss / D_MODEL + NORM_EPS);
        const int sel = mod_sel(R); const float *m0 = modv(p, layer, sel, 0), *m1 = modv(p, layer, sel, 1), *g = p.norm1_g + layer * D_MODEL;
        for (int c = e.gl; c < D_MODEL; c += G) { const float v = p.xres[(size_t)R * D_MODEL + c];
            p.h[(size_t)R * D_MODEL + c] = f2bf(v * rstd * g[c] * (1.f + m1[c]) + m0[c]); }
    }
}
template <int G> HD void ph_final(const Params& p, Exec e) {
    for (int i = e.gid; i < BATCH * SEQ; i += e.ngroups) {
        const int b = i / SEQ, t = i % SEQ, R = b * TOK + CTX + t;
        float ss = 0.f;
        for (int c = e.gl; c < D_MODEL; c += G) { const float v = resid_in(p, DEPTH, R, c); ss += v * v; }
        ss = group_sum<G>(ss);
        const float rstd = 1.f / sqrtf(ss / D_MODEL + NORM_EPS);
        for (int c = e.gl; c < D_MODEL; c += G) p.out[(size_t)i * D_MODEL + c] = resid_in(p, DEPTH, R, c) * rstd * p.final_g[c];
    }
}
template <int G> HD void ph_norm2(const Params& p, int layer, Exec e) {
    const bool last = layer == DEPTH - 1;
    for (int R = e.gid; R < MROWS; R += e.ngroups) {
        if (last && row_ctx(R)) continue;
        float ss = 0.f;
        for (int c = e.gl; c < D_MODEL; c += G) { const float v = p.xres[(size_t)R * D_MODEL + c]; ss += v * v; }
        ss = group_sum<G>(ss);
        const float rstd = 1.f / sqrtf(ss / D_MODEL + NORM_EPS);
        const int sel = mod_sel(R); const float *m3 = modv(p, layer, sel, 3), *m4 = modv(p, layer, sel, 4), *g = p.norm2_g + layer * D_MODEL;
        const float* wr = p.w_router + (size_t)layer * D_MODEL * NE;
        float lg[NE];
#pragma unroll
        for (int ex = 0; ex < NE; ++ex) lg[ex] = 0.f;
        for (int c = e.gl; c < D_MODEL; c += G) { const float v = p.xres[(size_t)R * D_MODEL + c];
            const float hv = v * rstd * g[c] * (1.f + m4[c]) + m3[c];
            p.h[(size_t)R * D_MODEL + c] = f2bf(hv);
#pragma unroll
            for (int ex = 0; ex < NE; ++ex) lg[ex] += hv * wr[c * NE + ex]; }
        float mx = -1e30f;
#pragma unroll
        for (int ex = 0; ex < NE; ++ex) { lg[ex] = group_sum<G>(lg[ex]); mx = fmaxf(mx, lg[ex]); }
        float sum = 0.f;
#pragma unroll
        for (int ex = 0; ex < NE; ++ex) { lg[ex] = expf(lg[ex] - mx); sum += lg[ex]; }
        if (e.gl == 0) {
#pragma unroll
            for (int ex = 0; ex < NE; ++ex) p.aff[(size_t)R * NE + ex] = lg[ex] / sum; }
    }
}
constexpr int TK_PART = 512, TK_PARTS = (SEQ + TK_PART - 1) / TK_PART, TK_SMEM = (SEQ > CTX ? SEQ : CTX) * 4;
HD int topk_units(int layer) { return BATCH * NE * TK_PARTS + (layer == DEPTH - 1 ? 0 : BATCH * NE) + 1; }
HD void ph_topk_unit(const Params& p, int layer, int unit, int tid, int nthr, unsigned char* smem) {
    (void)tid; (void)nthr; OPAQUE_TID();
    const bool last = layer == DEPTH - 1;
    const int nl = BATCH * NE * TK_PARTS, nc = last ? 0 : BATCH * NE;
    float* col = (float*)smem;
    if (unit >= nl + nc) {
        const int per = NSLOT - NSLOT_L - (last ? 0 : NSLOT_C);
        BLOCK_FOR(q, NE * per) { const int ex = q / per, j = NSLOT - per + q % per; p.sel_row[ex * NSLOT + j] = 0; p.sel_gate[ex * NSLOT + j] = 0.f; }
        return; }
    int b, ex, L, base, cap, jbase, t0, t1;
    if (unit < nl) { const int part = unit % TK_PARTS; ex = (unit / TK_PARTS) % NE; b = unit / (TK_PARTS * NE); L = SEQ; base = b * TOK + CTX; cap = CAPL; jbase = b * CAPL;
        t0 = part * TK_PART; t1 = t0 + TK_PART < SEQ ? t0 + TK_PART : SEQ; }
    else { const int q = unit - nl; ex = q % NE; b = q / NE; L = CTX; base = b * TOK; cap = CAPC; jbase = NSLOT_L + b * CAPC; t0 = 0; t1 = CTX; }
    BLOCK_FOR(u, L) col[u] = p.aff[(size_t)(base + u) * NE + ex];
    BLOCK_SYNC();
    BLOCK_FOR(q, t1 - t0) { const int t = t0 + q; const float a = col[t]; int rank = 0;
        for (int u = 0; u < L; ++u) { const float au = col[u]; rank += (au > a || (au == a && u < t)) ? 1 : 0; }
        if (rank < cap) { const int j = jbase + rank; p.sel_row[ex * NSLOT + j] = base + t; p.sel_gate[ex * NSLOT + j] = a; p.inv[(size_t)(base + t) * NE + ex] = j; }
        else p.inv[(size_t)(base + t) * NE + ex] = -1; }
    BLOCK_SYNC();
}
template <int G> HD void ph_gather(const Params& p, int layer, Exec e) {
    const bool last = layer == DEPTH - 1;
    const int nj = last ? NSLOT_L : NSLOT;
    for (int it = e.gid; it < NE * nj; it += e.ngroups) {
        const int ex = it / nj, j = it % nj, R = p.sel_row[ex * NSLOT + j];
        const uint4* s = (const uint4*)(p.h + (size_t)R * D_MODEL); uint4* d = (uint4*)(p.xs + ((size_t)ex * NSLOT + j) * D_MODEL);
        for (int c = e.gl; c < D_MODEL / 8; c += G) d[c] = s[c];
    }
}

template <int G> HD void ph_rw_prep1(const Params& p, int layer, Exec e) {
    const float* mu = p.rw_mu + (size_t)layer * 2 * RW_COLS;
    for (int R = e.gid; R < MROWS; R += e.ngroups) {
        const int s = row_s(R); const bool hp = (s != 0 && s != CTX), hn = (s != CTX - 1 && s != TOK - 1);
        const float* pr = p.P + (size_t)R * LDP + RW_OFF;
        for (int c = e.gl; c < RW_COLS; c += G) {
            const float v = pr[c], pv = hp ? pr[c - LDP] : 0.f, nv = hn ? pr[c + LDP] : 0.f;
            const float pp = v + mu[c] * (pv - v) + mu[RW_COLS + c] * (nv - v);
            if (c < GROUP_W) p.rw_r[(size_t)R * GROUP_W + c] = pp;
            else if (c < 2 * GROUP_W) p.rw_k[(size_t)R * GROUP_W + c - GROUP_W] = pp;
            else if (c < 3 * GROUP_W) p.rw_v[(size_t)R * GROUP_W + c - 2 * GROUP_W] = pp;
            else { const int q = c - 3 * GROUP_W; float o;
                if (q < RW_DR) o = tanhf(pp); else if (q < RW_DR + RW_IR) o = pp; else o = sigmoidf_(pp);
                p.rw_lr[(size_t)R * RW_LR + q] = o; }
        }
        const float* kk_w = p.rw_k_k + layer * GROUP_W;
        for (int hh = 0; hh < RW_HEADS; ++hh) { float ss = 0.f;
            for (int j = hh * RW_HEAD + e.gl; j < (hh + 1) * RW_HEAD; j += G) { const float xk = p.rw_k[(size_t)R * GROUP_W + j] * kk_w[j]; ss += xk * xk; }
            ss = group_sum<G>(ss); const float rn = 1.f / sqrtf(ss + 1e-6f);
            for (int j = hh * RW_HEAD + e.gl; j < (hh + 1) * RW_HEAD; j += G) p.rw_kk[(size_t)R * GROUP_W + j] = p.rw_k[(size_t)R * GROUP_W + j] * kk_w[j] * rn; }
    }
}
constexpr int RW_WK = 2 * RW_DR + 2 * RW_IR + RW_GR;
static_assert(RW_DR % 16 == 0 && RW_IR % 16 == 0 && RW_GR % 16 == 0, "low-rank K");
HD void ph_rw_wpack(const Params& p, Exec e) {
    for (int it = e.gid; it < DEPTH * GROUP_W * RW_WK; it += e.ngroups) {
        const int kk = it % RW_WK, j = (it / RW_WK) % GROUP_W, l = it / (RW_WK * GROUP_W); float v;
        if (kk < 2 * RW_DR) { const int d = kk / RW_DR, i = kk % RW_DR; v = p.rw_w_up[((size_t)(l * 2 + d) * RW_DR + i) * GROUP_W + j]; }
        else if (kk < 2 * RW_DR + 2 * RW_IR) { const int q = kk - 2 * RW_DR, d = q / RW_IR, i = q % RW_IR; v = p.rw_a_up[((size_t)(l * 2 + d) * RW_IR + i) * GROUP_W + j]; }
        else { const int i = kk - 2 * RW_DR - 2 * RW_IR; v = p.rw_g_up[((size_t)l * RW_GR + i) * GROUP_W + j]; }
        p.rw_W[it] = f2bf(v);
    }
}
HD void ph_rw_prep2(const Params& p, int layer, Exec e) {
    static_assert(MROWS % 32 == 0 && GROUP_W % 32 == 0, "tiles");
    const float* ka_w = p.rw_k_a + layer * GROUP_W;
    for (int it = e.gid; it < (MROWS / 32) * (GROUP_W / 32); it += e.ngroups) {
        const int tm = it / (GROUP_W / 32), tn = it % (GROUP_W / 32);
        const u16* W = p.rw_W + ((size_t)layer * GROUP_W + tn * 32) * RW_WK; const float* A = p.rw_lr + (size_t)tm * 32 * RW_LR;
        float st[4][MMA_SLOTS];
#define RWP2_PROD(K_, AOFF, WOFF, ...) wave_mma32<K_>(e.gl, [&](int m, int k0, Frag& o) { o.ld_f(A + (size_t)m * RW_LR + (AOFF) + k0); }, \
                                                       [&](int nn, int k0, Frag& o) { o.ld_bf(W + (size_t)nn * RW_WK + (WOFF) + k0); }, __VA_ARGS__)
        RWP2_PROD(RW_DR, 0, 0, [&](int, int, float acc, int sl) { st[0][sl] = acc; });
        RWP2_PROD(RW_DR, 0, RW_DR, [&](int, int, float acc, int sl) { st[1][sl] = acc; });
        RWP2_PROD(RW_IR, RW_DR, 2 * RW_DR, [&](int, int, float acc, int sl) { st[2][sl] = acc; });
        RWP2_PROD(RW_IR, RW_DR, 2 * RW_DR + RW_IR, [&](int, int, float acc, int sl) { st[3][sl] = acc; });
        RWP2_PROD(RW_GR, RW_DR + RW_IR, 2 * RW_DR + 2 * RW_IR, [&](int m, int nn, float acc, int sl) {
            const int R = tm * 32 + m, j = tn * 32 + nn; const size_t o = (size_t)R * GROUP_W + j;
            p.rw_g[o] = acc;
            const float kv = p.rw_k[o], kkv = p.rw_kk[o];
            _Pragma("unroll") for (int d = 0; d < 2; ++d) { const float wl = p.rw_w0[(layer * 2 + d) * GROUP_W + j] + st[d][sl], al = p.rw_a0[(layer * 2 + d) * GROUP_W + j] + st[2 + d][sl];
                const float logw = -RW_DECAY_SCALE * sigmoidf_(wl), a = sigmoidf_(al); const size_t o2 = (size_t)d * MROWS * GROUP_W + o;
                p.rw_ew[o2] = logw; p.rw_kka[o2] = kkv * a; p.rw_kt[o2] = kv * (1.f + (a - 1.f) * ka_w[j]); } });
#undef RWP2_PROD
    }
}
template <int G> HD void ph_rw_scan(const Params& p, Exec e) {
    constexpr int KPL = RW_HEAD / G;
    for (int it = e.gid; it < RW_CH * RW_HEAD; it += e.ngroups) {
        const int i = it % RW_HEAD, ch = it / RW_HEAD, d = ch % 2, hh = (ch / 2) % RW_HEADS, b = ch / (2 * RW_HEADS);
        float S[KPL];
#pragma unroll
        for (int q = 0; q < KPL; ++q) S[q] = 0.f;
        const int k0 = hh * RW_HEAD + e.gl * KPL;
        for (int pos = 0; pos < TOK; ++pos) {
            const int R = b * TOK + seq_s(d, pos);
            const size_t o1 = (size_t)R * GROUP_W + k0, o2 = ((size_t)d * MROWS + R) * GROUP_W + k0;
            const float vv = p.rw_v[(size_t)R * GROUP_W + hh * RW_HEAD + i];
            float sk = 0.f;
#pragma unroll
            for (int q = 0; q < KPL; ++q) sk += S[q] * p.rw_kk[o1 + q];
            sk = group_sum<G>(sk);
            float y = 0.f;
#pragma unroll
            for (int q = 0; q < KPL; ++q) { S[q] = S[q] * p.rw_ew[o2 + q] - sk * p.rw_kka[o2 + q] + vv * p.rw_kt[o2 + q]; y += S[q] * p.rw_r[o1 + q]; }
            y = group_sum<G>(y);
            if (e.gl == 0) p.rw_y[((size_t)d * MROWS + R) * GROUP_W + hh * RW_HEAD + i] = y;
        }
    }
}

constexpr int RW_N = RW_HEAD, RW_CN = RW_CH * NCHUNK;
constexpr int LDPAD = 8;
static_assert(CHUNK % 32 == 0 && RW_HEAD % 32 == 0, "tile sizes");
HD void rw_chain(int ch, int& b, int& hh, int& d) { d = ch % 2; hh = (ch / 2) % RW_HEADS; b = ch / (2 * RW_HEADS); }
constexpr int RW_C1_SMEM = CHUNK * RW_N * 4 + 2 * CHUNK * (RW_N + LDPAD) * 2;
HD void ph_rw_c1_unit(const Params& p, int cn, int tid, int nthr, unsigned char* smem) {
    (void)tid; (void)nthr; OPAQUE_TID();
    constexpr int C = CHUNK, N = RW_N, LD = N + LDPAD;
    const int ch = cn / NCHUNK, n = cn % NCHUNK; int b, hh, d; rw_chain(ch, b, hh, d);
    float* cum = (float*)smem; u16* KKt = (u16*)(cum + C * N); u16* At = KKt + C * LD;
    const size_t dofs = (size_t)d * MROWS * GROUP_W;
    BLOCK_FOR(idx, C * N) { const int t = idx / N, k = idx % N, R = b * TOK + seq_s(d, n * C + t); cum[idx] = p.rw_ew[dofs + (size_t)R * GROUP_W + hh * N + k]; }
    BLOCK_SYNC();
    BLOCK_FOR(k, N) { float acc = 0.f; for (int t = 0; t < C; ++t) { acc += cum[t * N + k]; cum[t * N + k] = acc; } }
    BLOCK_SYNC();
    BLOCK_FOR(idx, C * N) { const int t = idx / N, k = idx % N, R = b * TOK + seq_s(d, n * C + t); const size_t o = (size_t)R * GROUP_W + hh * N + k;
        const float cu = cum[idx], cp = cu - p.rw_ew[dofs + o];
        KKt[t * LD + k] = f2bf(p.rw_kk[o] * expf(cp)); At[t * LD + k] = f2bf(p.rw_kka[dofs + o] * expf(-cu)); }
    BLOCK_SYNC();
    float* Ma = p.rw_Ma + (size_t)cn * C * C;
    WAVE_FOR(w, (C / 32) * (C / 32)) { const int tm = w / (C / 32), tn = w % (C / 32);
        wave_mma32<N>(LANE, [&](int m, int k0, Frag& o) { o.ld_bf(KKt + (tm * 32 + m) * LD + k0); },
                            [&](int nn, int k0, Frag& o) { o.ld_bf(At + (tn * 32 + nn) * LD + k0); },
                            [&](int m, int nn, float acc, int) { const int t = tm * 32 + m, sx = tn * 32 + nn; Ma[t * C + sx] = sx < t ? acc : 0.f; }); }
    BLOCK_SYNC();
}
constexpr int TS_G = 8, TS_SMEM = TS_G * CHUNK * CHUNK * 4;
HD void ph_tsolve_unit(const float* Mall, float* Tall, int nprob, int unit, int tid, int nthr, unsigned char* smem) {
    (void)tid; (void)nthr; OPAQUE_TID();
    constexpr int C = CHUNK;
    float* Tl = (float*)smem;
    const int p0 = unit * TS_G, np = (nprob - p0) < TS_G ? (nprob - p0) : TS_G;
    BLOCK_FOR(i, np * C * C / 4) ((uint4*)Tl)[i] = ((const uint4*)(Mall + (size_t)p0 * C * C))[i];
    BLOCK_SYNC();
    BLOCK_FOR(idx, TS_G * C) { const int w = idx / C, j = idx % C;
        if (w < np) { float* Tc = Tl + w * C * C;
            for (int t = 0; t < C; ++t) { float acc = 0.f;
                if (t == j) acc = 1.f;
                else if (t > j) { for (int sx = j; sx < t; ++sx) acc -= Tc[t * C + sx] * Tc[sx * C + j]; }
                Tc[t * C + j] = acc; } } }
    BLOCK_SYNC();
    BLOCK_FOR(i, np * C * C / 4) ((uint4*)(Tall + (size_t)p0 * C * C))[i] = ((const uint4*)Tl)[i];
    BLOCK_SYNC();
}
constexpr int RW_C3_SMEM = 2 * CHUNK * (RW_N + LDPAD) * 2 + 13 * CHUNK * (RW_N + LDPAD) * 2 + RW_N * 4;
HD void ph_rw_c3_unit(const Params& p, int cn, int tid, int nthr, unsigned char* smem) {
    (void)tid; (void)nthr; OPAQUE_TID();
    constexpr int C = CHUNK, N = RW_N, CN = C * N, LD = N + LDPAD, CL = C * LD;
    static_assert(2 * CL * 2 >= CN * 4, "cum region");
    static_assert(C == N, "c3 buffer aliasing assumes C == N");
    const int ch = cn / NCHUNK, n = cn % NCHUNK; int b, hh, d; rw_chain(ch, b, hh, d);
    float* cum = (float*)smem; u16* mb = (u16*)smem + 2 * CL;
    u16 *KKt = mb, *KKtT = mb + CL, *At = mb + 2 * CL, *KTt = mb + 3 * CL, *Rt = mb + 4 * CL, *ApT = mb + 5 * CL, *KTpT = mb + 6 * CL, *VT = mb + 7 * CL,
        *Tb = mb + 8 * CL, *MkT = mb + 9 * CL, *ZT = mb + 10 * CL, *Na = mb + 11 * CL, *Nk = mb + 12 * CL;
    float* PC = (float*)(mb + 13 * CL);
    u16 *Gm = (u16*)cum, *KKhT = (u16*)cum + CL;
    const size_t dofs = (size_t)d * MROWS * GROUP_W;
    BLOCK_FOR(idx, C * N) { const int t = idx / N, k = idx % N, R = b * TOK + seq_s(d, n * C + t); cum[idx] = p.rw_ew[dofs + (size_t)R * GROUP_W + hh * N + k]; }
    BLOCK_SYNC();
    BLOCK_FOR(k, N) { float acc = 0.f; for (int t = 0; t < C; ++t) { acc += cum[t * N + k]; cum[t * N + k] = acc; } PC[k] = expf(acc); }
    BLOCK_SYNC();
    BLOCK_FOR(idx, CN) { const int t = idx / N, k = idx % N, R = b * TOK + seq_s(d, n * C + t); const size_t o = (size_t)R * GROUP_W + hh * N + k;
        const float cu = cum[idx], cp = cu - p.rw_ew[dofs + o], cC = cum[(C - 1) * N + k];
        const float kkv = p.rw_kk[o], kav = p.rw_kka[dofs + o], ktv = p.rw_kt[dofs + o];
        const float e_m = expf(-cu), e_c = expf(cC - cu);
        const u16 kkt = f2bf(kkv * expf(cp));
        KKt[t * LD + k] = kkt; KKtT[k * LD + t] = kkt; At[t * LD + k] = f2bf(kav * e_m); KTt[t * LD + k] = f2bf(ktv * e_m); Rt[t * LD + k] = f2bf(p.rw_r[o] * expf(cu));
        ApT[k * LD + t] = f2bf(kav * e_c); KTpT[k * LD + t] = f2bf(ktv * e_c); VT[k * LD + t] = f2bf(p.rw_v[o]); }
    BLOCK_FOR(idx, C * C) Tb[(idx / C) * LD + idx % C] = f2bf(p.rw_T[(size_t)cn * C * C + idx]);
    BLOCK_SYNC();
    constexpr int TC = C / 32, TN = N / 32;
    WAVE_FOR(w, 3 * TC * TC) { const int which = w / (TC * TC), tm = (w / TC) % TC, tn = w % TC;
        const u16* Am = which == 0 ? KTt : Rt; const u16* Bm = which == 0 ? KKt : (which == 1 ? At : KTt); u16* Om = which == 0 ? MkT : (which == 1 ? Na : Nk);
        wave_mma32<N>(LANE, [&](int m, int k0, Frag& o) { o.ld_bf(Am + (tm * 32 + m) * LD + k0); },
                            [&](int nn, int k0, Frag& o) { o.ld_bf(Bm + (tn * 32 + nn) * LD + k0); },
                            [&](int m, int nn, float acc, int) { const int r = tm * 32 + m, cc = tn * 32 + nn; const bool keep = which == 0 ? (cc > r) : (cc <= r);
                                Om[r * LD + cc] = f2bf(keep ? acc : 0.f); }); }
    BLOCK_SYNC();
    WAVE_FOR(w, TC * TC + TN * TC) {
        if (w < TC * TC) { const int tm = w / TC, tn = w % TC;
            wave_mma32<C>(LANE, [&](int m, int k0, Frag& o) { o.ld_bf(Tb + (tm * 32 + m) * LD + k0); },
                                [&](int nn, int k0, Frag& o) { o.ld_bf(MkT + (tn * 32 + nn) * LD + k0); },
                                [&](int m, int nn, float acc, int) { Gm[(tm * 32 + m) * LD + tn * 32 + nn] = f2bf(acc); }); }
        else { const int q = w - TC * TC, tm = q / TC, tn = q % TC;
            wave_mma32<C>(LANE, [&](int m, int k0, Frag& o) { o.ld_bf(KKtT + (tm * 32 + m) * LD + k0); },
                                [&](int nn, int k0, Frag& o) { o.ld_bf(Tb + (tn * 32 + nn) * LD + k0); },
                                [&](int m, int nn, float acc, int) { KKhT[(tm * 32 + m) * LD + tn * 32 + nn] = f2bf(acc); }); } }
    BLOCK_SYNC();
    u16* RhG = p.rw_Rh + (size_t)cn * CN; u16* PhiTG = p.rw_PhiT + (size_t)cn * N * N;
    WAVE_FOR(w, TN * TC + TC * TN + TN * TN) {
        if (w < TN * TC) { const int tm = w / TC, tn = w % TC;
            wave_mma32<C>(LANE, [&](int m, int k0, Frag& o) { o.ld_bf(VT + (tm * 32 + m) * LD + k0); },
                                [&](int nn, int k0, Frag& o) { o.ld_bf(Gm + (tn * 32 + nn) * LD + k0); },
                                [&](int m, int nn, float acc, int) { ZT[(tm * 32 + m) * LD + tn * 32 + nn] = f2bf(acc); }); }
        else if (w < TN * TC + TC * TN) { const int q = w - TN * TC, tm = q / TN, tn = q % TN;
            wave_mma32<C>(LANE, [&](int m, int k0, Frag& o) { o.ld_bf(Na + (tm * 32 + m) * LD + k0); },
                                [&](int nn, int k0, Frag& o) { o.ld_bf(KKhT + (tn * 32 + nn) * LD + k0); },
                                [&](int m, int nn, float acc, int) { const int t = tm * 32 + m, k = tn * 32 + nn; RhG[t * N + k] = f2bf(bf2f(Rt[t * LD + k]) - acc); }); }
        else { const int q = w - TN * TC - TC * TN, tm = q / TN, tn = q % TN;
            wave_mma32<C>(LANE, [&](int m, int k0, Frag& o) { o.ld_bf(ApT + (tm * 32 + m) * LD + k0); },
                                [&](int nn, int k0, Frag& o) { o.ld_bf(KKhT + (tn * 32 + nn) * LD + k0); },
                                [&](int m, int nn, float acc, int) { const int k = tm * 32 + m, k2 = tn * 32 + nn; PhiTG[k * N + k2] = f2bf((k == k2 ? PC[k] : 0.f) - acc); }); } }
    BLOCK_SYNC();
    float* Y0G = p.rw_Y0 + (size_t)cn * CN; float* PsiG = p.rw_Psi + (size_t)cn * N * N;
    WAVE_FOR(w, TC * TN + TN * TN) {
        if (w < TC * TN) { const int tm = w / TN, tn = w % TN;
            wave_mma32<2 * C>(LANE, [&](int m, int k0, Frag& o) { if (k0 < C) o.ld_bf(Nk + (tm * 32 + m) * LD + k0); else { o.ld_bf(Na + (tm * 32 + m) * LD + k0 - C); o.neg(); } },
                                    [&](int nn, int k0, Frag& o) { if (k0 < C) o.ld_bf(VT + (tn * 32 + nn) * LD + k0); else o.ld_bf(ZT + (tn * 32 + nn) * LD + k0 - C); },
                                    [&](int m, int nn, float acc, int) { Y0G[(tm * 32 + m) * N + tn * 32 + nn] = acc; }); }
        else { const int q = w - TC * TN, tm = q / TN, tn = q % TN;
            wave_mma32<2 * C>(LANE, [&](int m, int k0, Frag& o) { if (k0 < C) o.ld_bf(VT + (tm * 32 + m) * LD + k0); else { o.ld_bf(ZT + (tm * 32 + m) * LD + k0 - C); o.neg(); } },
                                    [&](int nn, int k0, Frag& o) { if (k0 < C) o.ld_bf(KTpT + (tn * 32 + nn) * LD + k0); else o.ld_bf(ApT + (tn * 32 + nn) * LD + k0 - C); },
                                    [&](int m, int nn, float acc, int) { PsiG[(tm * 32 + m) * N + tn * 32 + nn] = acc; }); } }
    BLOCK_SYNC();
}
constexpr int RW_S2_SMEM = (3 * RW_N + CHUNK) * (RW_N + LDPAD) * 2 + RW_N * RW_N * 4 + CHUNK * RW_N * 4;
HD void ph_rw_scan2_unit(const Params& p, int ch, int tid, int nthr, unsigned char* smem) {
    (void)tid; (void)nthr; OPAQUE_TID();
    constexpr int C = CHUNK, N = RW_N, TC = C / 32, TN = N / 32, LD = N + LDPAD;
    int b, hh, d; rw_chain(ch, b, hh, d);
    u16* Sb = (u16*)smem; u16* PhiT = Sb + 2 * N * LD; u16* Rh = PhiT + N * LD; float* Psi = (float*)(Rh + C * LD); float* Y0 = Psi + N * N;
    BLOCK_FOR(i, N * LD) Sb[i] = 0;
#ifndef CPU_TEST
    constexpr int NT = 512, Q_A = N * N / 8 / NT, Q_B = C * N / 8 / NT, Q_C = N * N / 4 / NT, Q_D = C * N / 4 / NT;
    static_assert(Q_A * NT * 8 == N * N && Q_B * NT * 8 == C * N && Q_C * NT * 4 == N * N && Q_D * NT * 4 == C * N, "prefetch split");
    pfv4 rA[Q_A], rB[Q_B], rC[Q_C], rD[Q_D];
#define RW_PF_LOAD(cn_) do { pf_ld_lin(rA, p.rw_PhiT + (size_t)(cn_) * N * N, tid); pf_ld_lin(rB, p.rw_Rh + (size_t)(cn_) * C * N, tid); \
    pf_ld_lin(rC, p.rw_Psi + (size_t)(cn_) * N * N, tid); pf_ld_lin(rD, p.rw_Y0 + (size_t)(cn_) * C * N, tid); } while (0)
#define RW_PF_STORE() do { pf_st_pad(rA, PhiT, N / 8, LD, tid); pf_st_pad(rB, Rh, N / 8, LD, tid); pf_st_lin(rC, Psi, tid); pf_st_lin(rD, Y0, tid); } while (0)
    RW_PF_LOAD(ch * NCHUNK); RW_PF_STORE();
#endif
    for (int n = 0; n < NCHUNK; ++n) {
        const int cn = ch * NCHUNK + n;
#ifdef CPU_TEST
        BLOCK_FOR(i, N * N / 8) *(uint4*)(PhiT + (i / (N / 8)) * LD + (i % (N / 8)) * 8) = ((const uint4*)(p.rw_PhiT + (size_t)cn * N * N))[i];
        BLOCK_FOR(i, C * N / 8) *(uint4*)(Rh + (i / (N / 8)) * LD + (i % (N / 8)) * 8) = ((const uint4*)(p.rw_Rh + (size_t)cn * C * N))[i];
        BLOCK_FOR(i, N * N / 4) ((uint4*)Psi)[i] = ((const uint4*)(p.rw_Psi + (size_t)cn * N * N))[i];
        BLOCK_FOR(i, C * N / 4) ((uint4*)Y0)[i] = ((const uint4*)(p.rw_Y0 + (size_t)cn * C * N))[i];
        BLOCK_SYNC();
#else
        BLOCK_SYNC();
        if (n + 1 < NCHUNK) RW_PF_LOAD(cn + 1);
#endif
        const u16* Sc = Sb + (n & 1) * N * LD; u16* Sn = Sb + ((n + 1) & 1) * N * LD;
        WAVE_FOR(w, TN * TN + TC * TN) {
            if (w < TN * TN) { const int tm = w / TN, tn = w % TN;
                wave_mma32<N>(LANE, [&](int m, int k0, Frag& o) { o.ld_bf(Sc + (tm * 32 + m) * LD + k0); },
                                    [&](int nn, int k0, Frag& o) { o.ld_bf(PhiT + (tn * 32 + nn) * LD + k0); },
                                    [&](int m, int nn, float acc, int) { const int i = tm * 32 + m, k = tn * 32 + nn; Sn[i * LD + k] = f2bf(acc + Psi[i * N + k]); }); }
            else { const int q = w - TN * TN, tm = q / TN, tn = q % TN;
                wave_mma32<N>(LANE, [&](int m, int k0, Frag& o) { o.ld_bf(Rh + (tm * 32 + m) * LD + k0); },
                                    [&](int nn, int k0, Frag& o) { o.ld_bf(Sc + (tn * 32 + nn) * LD + k0); },
                                    [&](int m, int nn, float acc, int) { const int t = tm * 32 + m, i = tn * 32 + nn, R = b * TOK + seq_s(d, n * C + t);
                                        p.rw_y[((size_t)d * MROWS + R) * GROUP_W + hh * N + i] = acc + Y0[t * N + i]; }); } }
        BLOCK_SYNC();
#ifndef CPU_TEST
        if (n + 1 < NCHUNK) RW_PF_STORE();
#endif
    }
#ifndef CPU_TEST
#undef RW_PF_LOAD
#undef RW_PF_STORE
#endif
}
template <int G> HD void ph_rw_post(const Params& p, int layer, Exec e) {
    static_assert(G <= RW_HEAD, "G");
    const float *lw = p.rw_ln_w + layer * GROUP_W, *lb = p.rw_ln_b + layer * GROUP_W, *rk = p.rw_r_k + layer * GROUP_W;
    for (int it = e.gid; it < MROWS * RW_HEADS; it += e.ngroups) {
        const int R = it / RW_HEADS, hh = it % RW_HEADS; const size_t o = (size_t)R * GROUP_W + hh * RW_HEAD, o2 = (size_t)MROWS * GROUP_W;
        float s1 = 0.f, bon = 0.f;
        for (int j = e.gl; j < RW_HEAD; j += G) { s1 += p.rw_y[o + j] + p.rw_y[o2 + o + j];
            bon += p.rw_r[o + j] * (p.rw_kt[o + j] + p.rw_kt[o2 + o + j]) * rk[hh * RW_HEAD + j]; }
        s1 = group_sum<G>(s1); bon = group_sum<G>(bon);
        const float mean = s1 / RW_HEAD;
        float s2 = 0.f;
        for (int j = e.gl; j < RW_HEAD; j += G) { const float dlt = p.rw_y[o + j] + p.rw_y[o2 + o + j] - mean; s2 += dlt * dlt; }
        s2 = group_sum<G>(s2);
        const float rstd = 1.f / sqrtf(s2 / RW_HEAD + RW_GN_EPS);
        for (int j = e.gl; j < RW_HEAD; j += G) { const float y = (p.rw_y[o + j] + p.rw_y[o2 + o + j] - mean) * rstd * lw[hh * RW_HEAD + j] + lb[hh * RW_HEAD + j];
            p.mix[(size_t)R * D_MODEL + hh * RW_HEAD + j] = f2bf((y + bon * p.rw_v[o + j]) * p.rw_g[o + j]); }
    }
}

HD void ml_chain(int ch, int& b, int& hh, int& d) { d = ch % 2; hh = (ch / 2) % ML_HEADS; b = ch / (2 * ML_HEADS); }
template <int G> HD void ph_ml_g1(const Params& p, int layer, Exec e) {
    for (int it = e.gid; it < ML_CH * NCHUNK; it += e.ngroups) {
        const int ch = it / NCHUNK, n = it % NCHUNK; int b, hh, d; ml_chain(ch, b, hh, d);
        const float ib = p.ml_ib[(layer * 2 + d) * ML_HEADS + hh], fb = p.ml_fb[(layer * 2 + d) * ML_HEADS + hh];
        float cb = 0.f, cm = -1e30f;
        for (int t0 = 0; t0 < CHUNK; t0 += G) { const int t = t0 + e.gl, pos = n * CHUNK + t, R = b * TOK + seq_s(d, pos);
            const float* g = p.P + (size_t)R * LDP + ML_OFF + 4 * GROUP_W;
            const float li = g[d * ML_HEADS + hh] + ib, lf = logsigmoidf_(g[(2 + d) * ML_HEADS + hh] + fb);
            const float bc = cb + group_scan_sum<G>(lf, e.gl), gv = li - bc, gm = fmaxf(cm, group_scan_max<G>(gv, e.gl));
            p.ml_bcum[(size_t)ch * TOK + pos] = bc; p.ml_g[(size_t)ch * TOK + pos] = gv; p.ml_gmax[(size_t)ch * TOK + pos] = gm;
            cb = group_last<G>(bc); cm = group_last<G>(gm); }
        if (e.gl == 0) { p.ml_bl[ch * NCHUNK + n] = cb; p.ml_gm[ch * NCHUNK + n] = cm; }
    }
}
HD void ph_ml_g2(const Params& p, Exec e) {
    for (int ch = e.gid; ch < ML_CH; ch += e.ngroups) { float m = 0.f;
        for (int n = 0; n < NCHUNK; ++n) { p.ml_min[ch * NCHUNK + n] = m; m = p.ml_bl[ch * NCHUNK + n] + fmaxf(m, p.ml_gm[ch * NCHUNK + n]); } }
}
HD void ph_ml_dC(const Params& p, Exec e) {
    const float ksc = 1.f / sqrtf((float)ML_HEAD);
    const int n1 = ML_CH * NCHUNK * ML_HEAD * ML_HEAD, n2 = ML_CH * NCHUNK * ML_HEAD;
    for (int it = e.gid; it < n1 + n2; it += e.ngroups) {
        const bool isn = it >= n1; const int q = isn ? it - n1 : it;
        const int dd = q % ML_HEAD, ee = isn ? 0 : (q / ML_HEAD) % ML_HEAD, cn = isn ? q / ML_HEAD : q / (ML_HEAD * ML_HEAD), n = cn % NCHUNK, ch = cn / NCHUNK;
        int b, hh, d; ml_chain(ch, b, hh, d);
        const float min_ = p.ml_min[cn], bl = p.ml_bl[cn], mnew = bl + fmaxf(min_, p.ml_gm[cn]);
        float acc = 0.f;
        for (int s = 0; s < CHUNK; ++s) { const int pos = n * CHUNK + s, R = b * TOK + seq_s(d, pos);
            const float wk = expf(bl + p.ml_g[(size_t)ch * TOK + pos] - mnew);
            const float* pr = p.P + (size_t)R * LDP + ML_OFF + hh * ML_HEAD;
            const float kv = pr[GROUP_W + dd] * ksc;
            acc += isn ? wk * kv : wk * kv * pr[2 * GROUP_W + ee]; }
        if (isn) p.ml_dn[(size_t)cn * ML_HEAD + dd] = acc; else p.ml_dC[((size_t)cn * ML_HEAD + ee) * ML_HEAD + dd] = acc;
    }
}
HD void ph_ml_prefix(const Params& p, Exec e) {
    const int n1 = ML_CH * ML_HEAD * ML_HEAD, n2 = ML_CH * ML_HEAD;
    for (int it = e.gid; it < n1 + n2; it += e.ngroups) {
        const bool isn = it >= n1; const int q = isn ? it - n1 : it, per = isn ? ML_HEAD : ML_HEAD * ML_HEAD, ch = q / per, el = q % per;
        float* arr = isn ? p.ml_dn : p.ml_dC; float st = 0.f;
        for (int n = 0; n < NCHUNK; ++n) { const int cn = ch * NCHUNK + n;
            const float min_ = p.ml_min[cn], bl = p.ml_bl[cn], mnew = bl + fmaxf(min_, p.ml_gm[cn]), dc = expf(bl + min_ - mnew);
            const size_t o = (size_t)cn * per + el; const float inc = arr[o]; arr[o] = st; st = dc * st + inc; }
    }
}
HD void ph_ml_S(const Params& p, Exec e) {
    const float ksc = 1.f / sqrtf((float)ML_HEAD);
    for (int it = e.gid; it < ML_CH * NCHUNK * CHUNK * CHUNK; it += e.ngroups) {
        const int s = it % CHUNK, t = (it / CHUNK) % CHUNK, cn = it / (CHUNK * CHUNK), n = cn % NCHUNK, ch = cn / NCHUNK;
        float v = 0.f;
        if (s <= t) { int b, hh, d; ml_chain(ch, b, hh, d);
            const int pt = n * CHUNK + t, ps = n * CHUNK + s, Rt = b * TOK + seq_s(d, pt), Rs = b * TOK + seq_s(d, ps);
            const float* qr = p.P + (size_t)Rt * LDP + ML_OFF + hh * ML_HEAD; const float* kr = p.P + (size_t)Rs * LDP + ML_OFF + GROUP_W + hh * ML_HEAD;
            float dot = 0.f; for (int k = 0; k < ML_HEAD; ++k) dot += qr[k] * kr[k];
            const float bt = p.ml_bcum[(size_t)ch * TOK + pt], mt = bt + fmaxf(p.ml_min[cn], p.ml_gmax[(size_t)ch * TOK + pt]);
            v = dot * ksc * expf(bt + p.ml_g[(size_t)ch * TOK + ps] - mt); }
        p.ml_S[it] = v;
    }
}
HD void ph_ml_out(const Params& p, Exec e) {
    for (int it = e.gid; it < ML_CH * NCHUNK * CHUNK * ML_HEAD; it += e.ngroups) {
        const int ee = it % ML_HEAD, t = (it / ML_HEAD) % CHUNK, cn = it / (ML_HEAD * CHUNK), n = cn % NCHUNK, ch = cn / NCHUNK;
        int b, hh, d; ml_chain(ch, b, hh, d);
        const int pt = n * CHUNK + t, Rt = b * TOK + seq_s(d, pt);
        const float bt = p.ml_bcum[(size_t)ch * TOK + pt], min_ = p.ml_min[cn], mt = bt + fmaxf(min_, p.ml_gmax[(size_t)ch * TOK + pt]), wi = expf(bt + min_ - mt);
        const float* Sr = p.ml_S + ((size_t)cn * CHUNK + t) * CHUNK;
        float num = 0.f, den = 0.f;
        for (int s = 0; s <= t; ++s) { const int Rs = b * TOK + seq_s(d, n * CHUNK + s); const float sv = Sr[s];
            num += sv * p.P[(size_t)Rs * LDP + ML_OFF + 2 * GROUP_W + hh * ML_HEAD + ee]; den += sv; }
        const float* qr = p.P + (size_t)Rt * LDP + ML_OFF + hh * ML_HEAD;
        const float* Cr = p.ml_dC + ((size_t)cn * ML_HEAD + ee) * ML_HEAD; const float* nr = p.ml_dn + (size_t)cn * ML_HEAD;
        float cq = 0.f, nq = 0.f;
        for (int k = 0; k < ML_HEAD; ++k) { cq += Cr[k] * qr[k]; nq += nr[k] * qr[k]; }
        num += wi * cq; den += wi * nq;
        p.ml_hh[((size_t)d * MROWS + Rt) * GROUP_W + hh * ML_HEAD + ee] = num / fmaxf(fabsf(den), expf(-mt));
    }
}

constexpr int ML_N = ML_HEAD, ML_CN = ML_CH * NCHUNK;
static_assert(ML_HEAD % 32 == 0, "tile");
constexpr int ML_C1_SMEM = 2 * ML_N * (CHUNK + LDPAD) * 2 + 4 * CHUNK * 4;
HD void ph_ml_c1_unit(const Params& p, int cn, int tid, int nthr, unsigned char* smem) {
    (void)tid; (void)nthr; OPAQUE_TID();
    constexpr int C = CHUNK, N = ML_N, TC = C / 32, TN = N / 32, LD = C + LDPAD;
    const float ksc = 1.f / sqrtf((float)ML_HEAD);
    const int ch = cn / NCHUNK, n = cn % NCHUNK; int b, hh, d; ml_chain(ch, b, hh, d);
    u16* VwT = (u16*)smem; u16* KT = VwT + N * LD; float* wk = (float*)(KT + N * LD); float* btv = wk + C; float* gv = btv + C; float* mtv = gv + C;
    const float min_ = p.ml_min[cn], bl = p.ml_bl[cn], mnew = bl + fmaxf(min_, p.ml_gm[cn]);
    BLOCK_FOR(sx, C) { const size_t o = (size_t)ch * TOK + n * C + sx; const float g = p.ml_g[o], bt = p.ml_bcum[o];
        wk[sx] = expf(bl + g - mnew); btv[sx] = bt; gv[sx] = g; mtv[sx] = bt + fmaxf(min_, p.ml_gmax[o]); }
    BLOCK_SYNC();
    BLOCK_FOR(idx, C * N) { const int sx = idx / N, dd = idx % N, R = b * TOK + seq_s(d, n * C + sx); const float* pr = p.P + (size_t)R * LDP + ML_OFF + hh * N;
        VwT[dd * LD + sx] = f2bf(wk[sx] * pr[2 * GROUP_W + dd]); KT[dd * LD + sx] = f2bf(pr[GROUP_W + dd] * ksc); }
    BLOCK_SYNC();
    WAVE_FOR(w, TN * TN + TN + TC * TC) {
        if (w < TN * TN) { const int tm = w / TN, tn = w % TN;
            wave_mma32<C>(LANE, [&](int m, int k0, Frag& o) { o.ld_bf(VwT + (tm * 32 + m) * LD + k0); },
                                [&](int nn, int k0, Frag& o) { o.ld_bf(KT + (tn * 32 + nn) * LD + k0); },
                                [&](int m, int nn, float acc, int) { p.ml_dC[((size_t)cn * N + tm * 32 + m) * N + tn * 32 + nn] = acc; }); }
        else if (w < TN * TN + TN) { const int tn = w - TN * TN;
            wave_mma32<C>(LANE, [&](int m, int k0, Frag& o) { if (m == 0) o.ld_f(wk + k0); else o.set1(0.f); },
                                [&](int nn, int k0, Frag& o) { o.ld_bf(KT + (tn * 32 + nn) * LD + k0); },
                                [&](int m, int nn, float acc, int) { if (m == 0) p.ml_dn[(size_t)cn * N + tn * 32 + nn] = acc; }); }
        else { const int q = w - TN * TN - TN, tm = q / TC, tn = q % TC;
            wave_mma32<N>(LANE, [&](int m, int k0, Frag& o) { const int R = b * TOK + seq_s(d, n * C + tm * 32 + m); o.ld_f(p.P + (size_t)R * LDP + ML_OFF + hh * N + k0); },
                                [&](int nn, int k0, Frag& o) { const int R = b * TOK + seq_s(d, n * C + tn * 32 + nn); o.ld_f(p.P + (size_t)R * LDP + ML_OFF + GROUP_W + hh * N + k0); },
                                [&](int m, int nn, float acc, int) { const int t = tm * 32 + m, sx = tn * 32 + nn;
                                    p.ml_S[((size_t)cn * C + t) * C + sx] = sx <= t ? acc * ksc * expf(btv[t] + gv[sx] - mtv[t]) : 0.f; }); } }
    BLOCK_SYNC();
}
constexpr int ML_C2_SMEM = ML_N * (CHUNK + LDPAD) * 2 + 3 * CHUNK * 4;
HD void ph_ml_c2_unit(const Params& p, int cn, int tid, int nthr, unsigned char* smem) {
    (void)tid; (void)nthr; OPAQUE_TID();
    constexpr int C = CHUNK, N = ML_N, TC = C / 32, TN = N / 32, LD = C + LDPAD;
    const int ch = cn / NCHUNK, n = cn % NCHUNK; int b, hh, d; ml_chain(ch, b, hh, d);
    u16* VT = (u16*)smem; float* wi = (float*)(VT + N * LD); float* den = wi + C; float* emt = den + C;
    const float min_ = p.ml_min[cn];
    BLOCK_FOR(t, C) { const size_t o = (size_t)ch * TOK + n * C + t; const float bt = p.ml_bcum[o], mt = bt + fmaxf(min_, p.ml_gmax[o]);
        wi[t] = expf(bt + min_ - mt); emt[t] = expf(-mt); }
    BLOCK_FOR(idx, C * N) { const int sx = idx / N, dd = idx % N, R = b * TOK + seq_s(d, n * C + sx);
        VT[dd * LD + sx] = f2bf(p.P[(size_t)R * LDP + ML_OFF + 2 * GROUP_W + hh * N + dd]); }
    BLOCK_SYNC();
    WAVE_FOR(w, TC) { const int tm = w;
        wave_mma32<C + N>(LANE, [&](int m, int k0, Frag& o) { const int t = tm * 32 + m;
                                    if (k0 < C) o.ld_f(p.ml_S + ((size_t)cn * C + t) * C + k0);
                                    else { const int R = b * TOK + seq_s(d, n * C + t); o.ld_f_scaled(p.P + (size_t)R * LDP + ML_OFF + hh * N + k0 - C, wi[t]); } },
                                [&](int nn, int k0, Frag& o) { if (nn != 0) o.set1(0.f); else if (k0 < C) o.set1(1.f); else o.ld_f(p.ml_dn + (size_t)cn * N + k0 - C); },
                                [&](int m, int nn, float acc, int) { if (nn == 0) den[tm * 32 + m] = acc; }); }
    BLOCK_SYNC();
    WAVE_FOR(w, TC * TN) { const int tm = w / TN, tn = w % TN;
        wave_mma32<C + N>(LANE, [&](int m, int k0, Frag& o) { const int t = tm * 32 + m;
                                    if (k0 < C) o.ld_f(p.ml_S + ((size_t)cn * C + t) * C + k0);
                                    else { const int R = b * TOK + seq_s(d, n * C + t); o.ld_f_scaled(p.P + (size_t)R * LDP + ML_OFF + hh * N + k0 - C, wi[t]); } },
                                [&](int nn, int k0, Frag& o) { const int ee = tn * 32 + nn;
                                    if (k0 < C) o.ld_bf(VT + ee * LD + k0); else o.ld_f(p.ml_dC + ((size_t)cn * N + ee) * N + k0 - C); },
                                [&](int m, int nn, float acc, int) { const int t = tm * 32 + m, ee = tn * 32 + nn, R = b * TOK + seq_s(d, n * C + t);
                                    p.ml_hh[((size_t)d * MROWS + R) * GROUP_W + hh * N + ee] = acc / fmaxf(fabsf(den[t]), emt[t]); }); }
    BLOCK_SYNC();
}
template <int G> HD void ph_ml_post(const Params& p, int layer, Exec e) {
    const float* ng = p.ml_norm_g + layer * GROUP_W;
    for (int it = e.gid; it < MROWS * ML_HEADS; it += e.ngroups) {
        const int R = it / ML_HEADS, hh = it % ML_HEADS; const size_t o = (size_t)R * GROUP_W + hh * ML_HEAD, o2 = (size_t)MROWS * GROUP_W;
        float s1 = 0.f;
        for (int j = e.gl; j < ML_HEAD; j += G) s1 += p.ml_hh[o + j] + p.ml_hh[o2 + o + j];
        s1 = group_sum<G>(s1); const float mean = s1 / ML_HEAD;
        float s2 = 0.f;
        for (int j = e.gl; j < ML_HEAD; j += G) { const float dlt = p.ml_hh[o + j] + p.ml_hh[o2 + o + j] - mean; s2 += dlt * dlt; }
        s2 = group_sum<G>(s2); const float rstd = 1.f / sqrtf(s2 / ML_HEAD + NORM_EPS);
        for (int j = e.gl; j < ML_HEAD; j += G) { const float y = (p.ml_hh[o + j] + p.ml_hh[o2 + o + j] - mean) * rstd * ng[hh * ML_HEAD + j];
            const float og = p.P[(size_t)R * LDP + ML_OFF + 3 * GROUP_W + hh * ML_HEAD + j];
            p.mix[(size_t)R * D_MODEL + GROUP_W + hh * ML_HEAD + j] = f2bf(y * sigmoidf_(og)); }
    }
}

HD float gd_conv_silu(const Params& p, int layer, int R, int c) {
    const int s = row_s(R); const float* pr = p.P + (size_t)R * LDP + GD_OFF + c; const float* cw = p.gd_conv + (size_t)layer * 3 * 3 * GROUP_W + c;
    float v = pr[0] * cw[3 * GROUP_W];
    if (s != 0 && s != CTX) v += pr[-LDP] * cw[0];
    if (s != CTX - 1 && s != TOK - 1) v += pr[LDP] * cw[2 * 3 * GROUP_W];
    return siluf_(v);
}
template <int G> HD void ph_gd_prep(const Params& p, int layer, Exec e) {
    const float qsc = 1.f / sqrtf((float)GD_HEAD);
    for (int it = e.gid; it < MROWS * GD_HEADS; it += e.ngroups) {
        const int R = it / GD_HEADS, hh = it % GD_HEADS;
        float sq = 0.f, sk = 0.f;
        for (int j = e.gl; j < GD_HEAD; j += G) { const float a = gd_conv_silu(p, layer, R, hh * GD_HEAD + j), b2 = gd_conv_silu(p, layer, R, GROUP_W + hh * GD_HEAD + j); sq += a * a; sk += b2 * b2; }
        sq = group_sum<G>(sq); sk = group_sum<G>(sk);
        const float rq = qsc / sqrtf(sq + 1e-6f), rk = 1.f / sqrtf(sk + 1e-6f);
        for (int j = e.gl; j < GD_HEAD; j += G) { const size_t o = (size_t)R * GROUP_W + hh * GD_HEAD + j;
            p.gd_q[o] = gd_conv_silu(p, layer, R, hh * GD_HEAD + j) * rq; p.gd_k[o] = gd_conv_silu(p, layer, R, GROUP_W + hh * GD_HEAD + j) * rk;
            p.gd_v[o] = gd_conv_silu(p, layer, R, 2 * GROUP_W + hh * GD_HEAD + j); }
    }
}
template <int G> HD void ph_gd_gates(const Params& p, int layer, Exec e) {
    for (int it = e.gid; it < GD_CH * NCHUNK; it += e.ngroups) {
        const int ch = it / NCHUNK, n = it % NCHUNK; int b, hh, d; ml_chain(ch, b, hh, d);
        const float al = expf(p.gd_a_log[(layer * 2 + d) * GD_HEADS + hh]), dtb = p.gd_dt_bias[(layer * 2 + d) * GD_HEADS + hh];
        float cg = 0.f;
        for (int t0 = 0; t0 < CHUNK; t0 += G) { const int t = t0 + e.gl, pos = n * CHUNK + t, R = b * TOK + seq_s(d, pos);
            const float* g = p.P + (size_t)R * LDP + GD_OFF + 4 * GROUP_W;
            const float gc = cg + group_scan_sum<G>(-al * softplusf_(g[d * GD_HEADS + hh] + dtb), e.gl);
            p.gd_gc[(size_t)ch * TOK + pos] = gc; p.gd_beta[(size_t)ch * TOK + pos] = sigmoidf_(g[(2 + d) * GD_HEADS + hh]);
            cg = group_last<G>(gc); }
    }
}

constexpr int GD_N = GD_HEAD, GD_CN = GD_CH * NCHUNK;
static_assert(GD_HEAD % 32 == 0, "tile");
HD void ph_gd_c1(const Params& p, Exec e) {
    constexpr int C = CHUNK, N = GD_N, TC = C / 32;
    for (int it = e.gid; it < GD_CN * TC * TC; it += e.ngroups) {
        const int cn = it / (TC * TC), tm = (it / TC) % TC, tn = it % TC, ch = cn / NCHUNK, n = cn % NCHUNK; int b, hh, d; ml_chain(ch, b, hh, d);
        wave_mma32<N>(e.gl, [&](int m, int k0, Frag& o) { const int R = b * TOK + seq_s(d, n * C + tm * 32 + m); o.ld_f(p.gd_k + (size_t)R * GROUP_W + hh * N + k0); },
                            [&](int nn, int k0, Frag& o) { const int R = b * TOK + seq_s(d, n * C + tn * 32 + nn); o.ld_f(p.gd_k + (size_t)R * GROUP_W + hh * N + k0); },
                            [&](int m, int nn, float acc, int) { const int i = tm * 32 + m, j = tn * 32 + nn; const size_t o = (size_t)ch * TOK + n * C;
                                p.gd_A[((size_t)cn * C + i) * C + j] = j < i ? p.gd_beta[o + i] * acc * expf(p.gd_gc[o + i] - p.gd_gc[o + j]) : 0.f; });
    }
}
constexpr int GD_C3_SMEM = (5 * GD_N + 2 * CHUNK) * (CHUNK + LDPAD) * 2 + 2 * CHUNK * 4;
HD void ph_gd_c3_unit(const Params& p, int cn, int tid, int nthr, unsigned char* smem) {
    (void)tid; (void)nthr; OPAQUE_TID();
    constexpr int C = CHUNK, N = GD_N, TC = C / 32, TN = N / 32, LD = C + LDPAD;
    const int ch = cn / NCHUNK, n = cn % NCHUNK; int b, hh, d; ml_chain(ch, b, hh, d);
    u16 *KbT = (u16*)smem, *VbT = KbT + N * LD, *KdT = VbT + N * LD, *uT = KdT + N * LD, *wT = uT + N * LD, *Tb = wT + N * LD, *attn = Tb + C * LD;
    float* gcs = (float*)(attn + C * LD); float* bet = gcs + C;
    BLOCK_FOR(t, C) { const size_t o = (size_t)ch * TOK + n * C + t; gcs[t] = p.gd_gc[o]; bet[t] = p.gd_beta[o]; }
    BLOCK_SYNC();
    BLOCK_FOR(idx, C * N) { const int t = idx / N, dd = idx % N, R = b * TOK + seq_s(d, n * C + t); const size_t o = (size_t)R * GROUP_W + hh * N + dd;
        const float kv = p.gd_k[o], vv = p.gd_v[o];
        KbT[dd * LD + t] = f2bf(kv * bet[t] * expf(gcs[t])); VbT[dd * LD + t] = f2bf(vv * bet[t]); KdT[dd * LD + t] = f2bf(kv * expf(gcs[C - 1] - gcs[t])); }
    BLOCK_FOR(idx, C * C) Tb[(idx / C) * LD + idx % C] = f2bf(p.gd_T[(size_t)cn * C * C + idx]);
    BLOCK_SYNC();
    WAVE_FOR(w, TC * TC + 2 * TN * TC) {
        if (w < TC * TC) { const int tm = w / TC, tn = w % TC;
            wave_mma32<N>(LANE, [&](int m, int k0, Frag& o) { const int R = b * TOK + seq_s(d, n * C + tm * 32 + m); o.ld_f(p.gd_q + (size_t)R * GROUP_W + hh * N + k0); },
                                [&](int nn, int k0, Frag& o) { const int R = b * TOK + seq_s(d, n * C + tn * 32 + nn); o.ld_f(p.gd_k + (size_t)R * GROUP_W + hh * N + k0); },
                                [&](int m, int nn, float acc, int) { const int i = tm * 32 + m, j = tn * 32 + nn; attn[i * LD + j] = f2bf(j <= i ? acc * expf(gcs[i] - gcs[j]) : 0.f); }); }
        else { const int q = w - TC * TC, which = q / (TN * TC), tm = (q / TC) % TN, tn = q % TC;
            const u16* Am = which ? KbT : VbT; u16* Om = which ? wT : uT;
            wave_mma32<C>(LANE, [&](int m, int k0, Frag& o) { o.ld_bf(Am + (tm * 32 + m) * LD + k0); },
                                [&](int nn, int k0, Frag& o) { o.ld_bf(Tb + (tn * 32 + nn) * LD + k0); },
                                [&](int m, int nn, float acc, int) { Om[(tm * 32 + m) * LD + tn * 32 + nn] = f2bf(acc); }); } }
    BLOCK_SYNC();
    WAVE_FOR(w, 2 * TC * TN + 2 * TN * TN) {
        if (w < 2 * TC * TN) { const int which = w / (TC * TN), tm = (w / TN) % TC, tn = w % TN;
            const u16* Bm = which ? uT : wT;
            wave_mma32<C>(LANE, [&](int m, int k0, Frag& o) { o.ld_bf(attn + (tm * 32 + m) * LD + k0); },
                                [&](int nn, int k0, Frag& o) { o.ld_bf(Bm + (tn * 32 + nn) * LD + k0); },
                                [&](int m, int nn, float acc, int) { const int i = tm * 32 + m, dd = tn * 32 + nn;
                                    if (which) p.gd_O0[((size_t)cn * C + i) * N + dd] = acc;
                                    else { const int R = b * TOK + seq_s(d, n * C + i); p.gd_Qh[((size_t)cn * C + i) * N + dd] = f2bf(p.gd_q[(size_t)R * GROUP_W + hh * N + dd] * expf(gcs[i]) - acc); } }); }
        else { const int q = w - 2 * TC * TN, which = q / (TN * TN), tm = (q / TN) % TN, tn = q % TN;
            const u16* Bm = which ? uT : wT;
            wave_mma32<C>(LANE, [&](int m, int k0, Frag& o) { o.ld_bf(KdT + (tm * 32 + m) * LD + k0); },
                                [&](int nn, int k0, Frag& o) { o.ld_bf(Bm + (tn * 32 + nn) * LD + k0); },
                                [&](int m, int nn, float acc, int) { const int d1 = tm * 32 + m, d2 = tn * 32 + nn;
                                    if (which) p.gd_Psi[((size_t)cn * N + d1) * N + d2] = acc;
                                    else p.gd_Phi[((size_t)cn * N + d1) * N + d2] = f2bf((d1 == d2 ? expf(gcs[C - 1]) : 0.f) - acc); }); } }
    BLOCK_SYNC();
}
constexpr int GD_EB = 32, GD_S2_UNITS = GD_CH * (GD_N / GD_EB);
constexpr int GD_S2_SMEM = (2 * GD_EB + GD_N + CHUNK) * (GD_N + LDPAD) * 2 + (GD_N * GD_EB + CHUNK * GD_EB) * 4;
HD void ph_gd_scan2_unit(const Params& p, int unit, int tid, int nthr, unsigned char* smem) {
    (void)tid; (void)nthr; OPAQUE_TID();
    constexpr int C = CHUNK, N = GD_N, EB = GD_EB, LD = N + LDPAD;
    const int eb = unit % (N / EB), ch = unit / (N / EB), e0 = eb * EB; int b, hh, d; ml_chain(ch, b, hh, d);
    u16* ST = (u16*)smem; u16* Phi = ST + 2 * EB * LD; u16* Qh = Phi + N * LD; float* Psi = (float*)(Qh + C * LD); float* O0 = Psi + N * EB;
    BLOCK_FOR(i, EB * LD) ST[i] = 0;
#ifndef CPU_TEST
    constexpr int NT = 512, Q_PHI = N * N / 8 / NT, Q_QH = C * N / 8 / NT, Q_PSI = N * EB / 4 / NT, Q_O0 = C * EB / 4 / NT;
    static_assert(Q_PHI * NT * 8 == N * N && Q_QH * NT * 8 == C * N && Q_PSI * NT * 4 == N * EB && Q_O0 * NT * 4 == C * EB, "prefetch split");
    pfv4 rA[Q_PHI], rB[Q_QH], rC[Q_PSI], rD[Q_O0];
#define GD_PF_LOAD(cn_) do { pf_ld_lin(rA, p.gd_Phi + (size_t)(cn_) * N * N, tid); pf_ld_lin(rB, p.gd_Qh + (size_t)(cn_) * C * N, tid); \
    pf_ld_rows(rC, p.gd_Psi + (size_t)(cn_) * N * N + e0, EB / 4, N, tid); pf_ld_rows(rD, p.gd_O0 + (size_t)(cn_) * C * N + e0, EB / 4, N, tid); } while (0)
#define GD_PF_STORE() do { pf_st_pad(rA, Phi, N / 8, LD, tid); pf_st_pad(rB, Qh, N / 8, LD, tid); pf_st_lin(rC, Psi, tid); pf_st_lin(rD, O0, tid); } while (0)
    GD_PF_LOAD(ch * NCHUNK); GD_PF_STORE();
#endif
    for (int n = 0; n < NCHUNK; ++n) {
        const int cn = ch * NCHUNK + n;
#ifdef CPU_TEST
        BLOCK_FOR(i, N * N / 8) *(uint4*)(Phi + (i / (N / 8)) * LD + (i % (N / 8)) * 8) = ((const uint4*)(p.gd_Phi + (size_t)cn * N * N))[i];
        BLOCK_FOR(i, C * N / 8) *(uint4*)(Qh + (i / (N / 8)) * LD + (i % (N / 8)) * 8) = ((const uint4*)(p.gd_Qh + (size_t)cn * C * N))[i];
        BLOCK_FOR(i, N * EB / 4) ((uint4*)Psi)[i] = *(const uint4*)(p.gd_Psi + ((size_t)cn * N + i / (EB / 4)) * N + e0 + (i % (EB / 4)) * 4);
        BLOCK_FOR(i, C * EB / 4) ((uint4*)O0)[i] = *(const uint4*)(p.gd_O0 + ((size_t)cn * C + i / (EB / 4)) * N + e0 + (i % (EB / 4)) * 4);
        BLOCK_SYNC();
#else
        BLOCK_SYNC();
        if (n + 1 < NCHUNK) GD_PF_LOAD(cn + 1);
#endif
        const u16* Sc = ST + (n & 1) * EB * LD; u16* Sn = ST + ((n + 1) & 1) * EB * LD;
        WAVE_FOR(w, N / 32 + C / 32) {
            if (w < N / 32) { const int tm = w;
                wave_mma32<N>(LANE, [&](int m, int k0, Frag& o) { o.ld_bf(Phi + (tm * 32 + m) * LD + k0); },
                                    [&](int nn, int k0, Frag& o) { o.ld_bf(Sc + nn * LD + k0); },
                                    [&](int m, int nn, float acc, int) { const int d1 = tm * 32 + m; Sn[nn * LD + d1] = f2bf(acc + Psi[d1 * EB + nn]); }); }
            else { const int tm = w - N / 32;
                wave_mma32<N>(LANE, [&](int m, int k0, Frag& o) { o.ld_bf(Qh + (tm * 32 + m) * LD + k0); },
                                    [&](int nn, int k0, Frag& o) { o.ld_bf(Sc + nn * LD + k0); },
                                    [&](int m, int nn, float acc, int) { const int t = tm * 32 + m, R = b * TOK + seq_s(d, n * C + t);
                                        p.gd_o[((size_t)d * MROWS + R) * GROUP_W + hh * N + e0 + nn] = acc + O0[t * EB + nn]; }); } }
        BLOCK_SYNC();
#ifndef CPU_TEST
        if (n + 1 < NCHUNK) GD_PF_STORE();
#endif
    }
#ifndef CPU_TEST
#undef GD_PF_LOAD
#undef GD_PF_STORE
#endif
}
template <int G> HD void ph_gd_post(const Params& p, int layer, Exec e) {
    const float* ng = p.gd_norm_g + layer * GD_HEAD;
    for (int it = e.gid; it < MROWS * GD_HEADS; it += e.ngroups) {
        const int R = it / GD_HEADS, hh = it % GD_HEADS; const size_t o = (size_t)R * GROUP_W + hh * GD_HEAD, o2 = (size_t)MROWS * GROUP_W;
        float ss = 0.f;
        for (int j = e.gl; j < GD_HEAD; j += G) { const float v = p.gd_o[o + j] + p.gd_o[o2 + o + j]; ss += v * v; }
        ss = group_sum<G>(ss); const float rstd = 1.f / sqrtf(ss / GD_HEAD + NORM_EPS);
        for (int j = e.gl; j < GD_HEAD; j += G) { const float v = (p.gd_o[o + j] + p.gd_o[o2 + o + j]) * rstd * ng[j];
            const float g = p.P[(size_t)R * LDP + GD_OFF + 3 * GROUP_W + hh * GD_HEAD + j];
            p.mix[(size_t)R * D_MODEL + 2 * GROUP_W + hh * GD_HEAD + j] = f2bf(v * siluf_(g)); }
    }
}

template <int G> HD void ph_at_prep(const Params& p, int layer, Exec e) {
    constexpr int NHS = AT_QH + 2 * AT_KVH, HALF = AT_HEAD / 2, QTR = AT_HEAD / 4;
    for (int it = e.gid; it < MROWS * NHS; it += e.ngroups) {
        const int R = it / NHS, hs = it % NHS, b = row_b(R), s = row_s(R);
        const float* pr = p.P + (size_t)R * LDP + AT_OFF + hs * AT_HEAD;
        u16* dst; const float* g = nullptr;
        if (hs < AT_QH) { dst = p.at_q + (((size_t)b * AT_QH + hs) * TOK + s) * AT_HEAD; g = p.at_q_norm + layer * AT_HEAD; }
        else if (hs < AT_QH + AT_KVH) { dst = p.at_k + (((size_t)b * AT_KVH + hs - AT_QH) * TOK + s) * AT_HEAD; g = p.at_k_norm + layer * AT_HEAD; }
        else dst = p.at_v + (((size_t)b * AT_KVH + hs - AT_QH - AT_KVH) * TOK + s) * AT_HEAD;
        if (!g) { for (int j = e.gl; j < AT_HEAD; j += G) dst[j] = f2bf(pr[j]); continue; }
        float ss = 0.f;
        for (int j = e.gl; j < AT_HEAD; j += G) ss += pr[j] * pr[j];
        ss = group_sum<G>(ss); const float rstd = 1.f / sqrtf(ss / AT_HEAD + NORM_EPS);
        if (s < CTX) { for (int j = e.gl; j < AT_HEAD; j += G) dst[j] = f2bf(pr[j] * rstd * g[j]); continue; }
        const int t = s - CTX; const float posr = (float)(t / GRID_W), posc = (float)(t % GRID_W);
        for (int j = e.gl; j < AT_HEAD; j += G) {
            const int half = j / HALF, jj = j % HALF, fi = jj % QTR; const bool second = jj >= QTR;
            const float ang = (half ? posc : posr) * powf(10000.f, -(float)(2 * fi) / (float)HALF);
            const float cs = cosf(ang), sn = sinf(ang);
            const int jp = second ? j - QTR : j + QTR;
            const float own = pr[j] * rstd * g[j], oth = pr[jp] * rstd * g[jp];
            dst[j] = f2bf(second ? own * cs + oth * sn : own * cs - oth * sn);
        }
    }
}

#include <cstdio>
#include <cstddef>
static_assert(D_MODEL == 2048 && CTX == 256 && SEQ % 256 == 0 && AT_HEAD == 128, "GPU part is written for the full configuration");
static_assert(RW_C3_SMEM <= 147392 && TS_SMEM <= 147392 && RW_S2_SMEM <= 147392 && RW_C1_SMEM <= 147392 && GD_C3_SMEM <= 147392 && GD_S2_SMEM <= 147392 && ML_C1_SMEM <= 147392 && ML_C2_SMEM <= 147392, "LDS");
static_assert(CHUNK == RW_N && GD_N * CHUNK * 2 == CHUNK * CHUNK * 4, "buffer aliasing (Y0 on Ma, Qh on A)");

#define XB_TMO      128
#define XB_XCNT(j)  (256  + 64 * (j))
#define XB_XSUB(j)  (1280 + 64 * (j))
#define XB_XGEN(j)  (2304 + 64 * (j))
#define XB_TOP      3328
#define XB_TOPGEN   3392
#define XCD_BAR_WORDS 3456
#define XB_SPIN_CAP (1u << 24)
#define LAS __attribute__((address_space(3)))
__device__ __forceinline__ unsigned xb_ld(unsigned* p)              { return __hip_atomic_load(p, __ATOMIC_RELAXED, __HIP_MEMORY_SCOPE_AGENT); }
__device__ __forceinline__ unsigned xb_add(unsigned* p, unsigned v) { return __hip_atomic_fetch_add(p, v, __ATOMIC_RELAXED, __HIP_MEMORY_SCOPE_AGENT); }
__device__ __forceinline__ unsigned xb_xcc_id() { return (unsigned)__builtin_amdgcn_s_getreg((3 << 11) | 20) & 0xFu; }
#define XB_SPIN(cond, bar) do { unsigned _sp = 0; while (cond) { __builtin_amdgcn_s_sleep(1); \
    if ((++_sp & 255u) == 0u) { if (xb_ld(&(bar)[XB_TMO])) break; if (_sp > XB_SPIN_CAP) { atomicAdd(&(bar)[XB_TMO], 1u); break; } } } } while (0)
struct XcdBarrier { unsigned* bar; unsigned x; volatile LAS unsigned* st; };
__device__ __forceinline__ XcdBarrier xcd_barrier_post(unsigned* bar, volatile LAS unsigned* st) {
    XcdBarrier b; b.bar = bar; b.x = xb_xcc_id(); b.st = st;
    if (threadIdx.x == 0) (void)xb_add(&bar[XB_XCNT(b.x)], 1u);
    return b;
}
__device__ __forceinline__ void xcd_barrier_complete(unsigned* bar, unsigned x, unsigned& nloc, unsigned& nx) {
    const unsigned G = gridDim.x * gridDim.y * gridDim.z;
    unsigned sum, cnt, mine, sp = 0u;
    for (;;) {
        sum = 0u; cnt = 0u; mine = 0u;
#pragma unroll
        for (unsigned j = 0; j < 16; ++j) { const unsigned c = xb_ld(&bar[XB_XCNT(j)]); sum += c; cnt += (c > 0u) ? 1u : 0u; mine = (j == x) ? c : mine; }
        if (sum == G) break;
        __builtin_amdgcn_s_sleep(1);
        if ((++sp & 255u) == 0u) { if (xb_ld(&bar[XB_TMO])) break; if (sp > XB_SPIN_CAP) { atomicAdd(&bar[XB_TMO], 1u); break; } }
    }
    nloc = mine > 0u ? mine : 1u; nx = cnt > 0u ? cnt : 1u;
}
__device__ __forceinline__ void xcd_barrier(const XcdBarrier& b) {
    asm volatile("s_waitcnt vmcnt(0)" ::: "memory");
    __syncthreads();
    if (threadIdx.x == 0) {
        unsigned* bar = b.bar;
        __builtin_amdgcn_s_waitcnt(0);
        unsigned nloc = b.st[0], nx = b.st[1];
        if (nloc == 0u) { xcd_barrier_complete(bar, b.x, nloc, nx); b.st[0] = nloc; b.st[1] = nx; }
        const unsigned old = xb_add(&bar[XB_XSUB(b.x)], 1u);
        const unsigned gen = old / nloc;
        if (old + 1u == (gen + 1u) * nloc) {
            __builtin_amdgcn_fence(__ATOMIC_RELEASE, "agent");
            asm volatile("s_waitcnt vmcnt(0)" ::: "memory");
            const unsigned og = xb_add(&bar[XB_TOP], 1u);
            const unsigned tg = og / nx;
            if (og + 1u == (tg + 1u) * nx) xb_add(&bar[XB_TOPGEN], 1u);
            else XB_SPIN(xb_ld(&bar[XB_TOPGEN]) == tg, bar);
            __builtin_amdgcn_fence(__ATOMIC_ACQUIRE, "agent");
            xb_add(&bar[XB_XGEN(b.x)], 1u);
            asm volatile("s_waitcnt vmcnt(0)" ::: "memory");
        } else {
            XB_SPIN(xb_ld(&bar[XB_XGEN(b.x)]) == gen, bar);
            __builtin_amdgcn_fence(__ATOMIC_ACQUIRE, "agent");
            asm volatile("s_waitcnt vmcnt(0)" ::: "memory");
        }
    }
    __syncthreads();
}

namespace pg8 {
#define PG8_LAS __attribute__((address_space(3)))
typedef unsigned short bf16_t;
typedef short bf16x8 __attribute__((ext_vector_type(8)));
typedef float f32x4 __attribute__((ext_vector_type(4)));
typedef unsigned u32x4 __attribute__((ext_vector_type(4)));
constexpr int BM = 256, BK = 64, HALF = 128, HTB = HALF * BK * 2  , STAGE_BYTES = 8 * HTB, NXCD = 8, WGM = 8;

__host__ __device__ __forceinline__ int lds_byte(int r, int c) { const int st = (r >> 4) * 2 + (c >> 5), rr = r & 15, cc = c & 31, ob = rr * 64 + cc * 2; return st * 1024 + (ob ^ (((ob >> 9) & 1) << 5)); }
__host__ __device__ __forceinline__ void stage_rc(int b, int& R, int& C) { const int st = b / 1024, sb = b % 1024, swz = sb ^ (((sb >> 9) & 1) << 5); R = (st >> 1) * 16 + swz / 64; C = (st & 1) * 32 + (swz % 64) / 2; }
__host__ __device__ __forceinline__ int perm32(int rho) { const int n = rho >> 4, i = rho & 15; return 8 * (i >> 2) + 4 * n + (i & 3); }

struct Unit { int pm, pn; };
struct Gemm { const bf16_t* A; const bf16_t* Bt; int M, N, K; };

struct StaticOrder {
    int nM, nN, nwg, G, c;
    __host__ __device__ void init(int M, int N, int G_, int c_) { nM = M / BM; nN = N / BM; nwg = nM * nN; G = G_; c = c_; }
    __host__ __device__ bool next(int i, Unit& u) const {
        const long L = (long)i * G + c; if (L >= nwg) return false;
        int wgid = (int)L; { const int q = nwg / NXCD, r = nwg % NXCD, xcd = wgid % NXCD, off = wgid / NXCD; wgid = (xcd < r ? xcd * (q + 1) : r * (q + 1) + (xcd - r) * q) + off; }
        const int nig = WGM * nN, gid = wgid / nig, fm = gid * WGM, gsz = (nM - fm) < WGM ? (nM - fm) : WGM;
        u.pm = fm + ((wgid % nig) % gsz); u.pn = (wgid % nig) / gsz; return true;
    }
    __device__ __forceinline__ void a_ready(const Unit&) const {}
    __device__ __forceinline__ void done(const Unit&) const {}
};
__device__ __forceinline__ unsigned cvt_pk_bf16(float lo, float hi) { unsigned r; asm volatile("v_cvt_pk_bf16_f32 %0, %1, %2" : "=v"(r) : "v"(lo), "v"(hi)); return r; }
typedef unsigned u32x2v __attribute__((ext_vector_type(2)));

struct TileOrder {
    int nI, nJ, nwg, G, c, latent_only;
    __device__ void init(int nI_, int nJ_, int G_, int c_, int lat) { nI = nI_; nJ = nJ_; nwg = nI * nJ; G = G_; c = c_; latent_only = lat; }
    __device__ bool next(int i, Unit& u) const { const long L = (long)i * G + c; if (L >= nwg) return false;
        const int ii = (int)(L % nI), j = (int)(L / nI); u.pm = latent_only ? (ii / (SEQ / 256)) * (TOK / 256) + 1 + ii % (SEQ / 256) : ii; u.pn = j; return true; }
    __device__ __forceinline__ void a_ready(const Unit&) const {}
    __device__ __forceinline__ void done(const Unit&) const {}
};
struct GroupedOrder {
    int nI, nJ, tilesA, nwg, G, c;
    __device__ void init(int nI_, int nJ_, int tilesA_, int G_, int c_) { nI = nI_; nJ = nJ_; tilesA = tilesA_; nwg = NE * nI * nJ; G = G_; c = c_; }
    __device__ bool next(int i, Unit& u) const { const long L = (long)i * G + c; if (L >= nwg) return false;
        const int e = (int)(L / (nI * nJ)), r = (int)(L % (nI * nJ)), j = r / nI, ii = r % nI; u.pm = e * tilesA + ii; u.pn = e * nJ + j; return true; }
    __device__ __forceinline__ void a_ready(const Unit&) const {}
    __device__ __forceinline__ void done(const Unit&) const {}
};

struct EpiF32 {
    static constexpr bool PERM = false, AFTER_DRAIN = false;
    float* C; int ldc;
    __device__ __forceinline__ void operator()(const f32x4 (&acc)[2][2][4][2], const Unit& u, int wr, int wc, int fr, int fq) const {
        const int row0 = u.pm * BM + wr * 64 + fr, col0 = u.pn * BM + wc * 32 + 4 * fq;
#pragma unroll
        for (int ai = 0; ai < 2; ++ai)
#pragma unroll
            for (int m = 0; m < 4; ++m) { float* rowp = C + (size_t)(row0 + ai * HALF + m * 16) * ldc + col0;
#pragma unroll
                for (int bj = 0; bj < 2; ++bj)
#pragma unroll
                    for (int n = 0; n < 2; ++n) *(f32x4*)(rowp + bj * HALF + n * 16) = acc[ai][bj][m][n]; }
    }
};
struct EpiResid {
    static constexpr bool PERM = false, AFTER_DRAIN = false;
    float* X; const float* modl;
    __device__ __forceinline__ void operator()(const f32x4 (&acc)[2][2][4][2], const Unit& u, int wr, int wc, int fr, int fq) const {
        const int row0 = u.pm * BM + wr * 64 + fr, col0 = u.pn * BM + wc * 32 + 4 * fq;
        const int tb = TOK / 256, sel = (u.pm % tb == 0) ? 2 : u.pm / tb;
        const float* gate = modl + ((size_t)sel * 6 + 2) * D_MODEL + col0;
        f32x4 gv[2][2];
#pragma unroll
        for (int bj = 0; bj < 2; ++bj)
#pragma unroll
            for (int n = 0; n < 2; ++n) gv[bj][n] = *(const f32x4*)(gate + bj * HALF + n * 16);
#pragma unroll
        for (int ai = 0; ai < 2; ++ai)
#pragma unroll
            for (int m = 0; m < 4; ++m) { float* rowp = X + (size_t)(row0 + ai * HALF + m * 16) * D_MODEL + col0;
#pragma unroll
                for (int bj = 0; bj < 2; ++bj)
#pragma unroll
                    for (int n = 0; n < 2; ++n) { f32x4* q = (f32x4*)(rowp + bj * HALF + n * 16); *q = *q + gv[bj][n] * acc[ai][bj][m][n]; } }
    }
};
struct EpiSwiGLU {
    static constexpr bool PERM = false, AFTER_DRAIN = false;
    bf16_t* H; int nJ;
    __device__ __forceinline__ void operator()(const f32x4 (&acc)[2][2][4][2], const Unit& u, int wr, int wc, int fr, int fq) const {
        const int row0 = u.pm * BM + wr * 64 + fr, col0 = (u.pn % nJ) * HALF + wc * 32 + 4 * fq;
#pragma unroll
        for (int ai = 0; ai < 2; ++ai)
#pragma unroll
            for (int m = 0; m < 4; ++m) { bf16_t* rowp = H + (size_t)(row0 + ai * HALF + m * 16) * D_MODEL + col0;
#pragma unroll
                for (int n = 0; n < 2; ++n) { const f32x4 a = acc[ai][0][m][n], b = acc[ai][1][m][n]; float o[4];
#pragma unroll
                    for (int q = 0; q < 4; ++q) o[q] = a[q] / (1.f + __expf(-a[q])) * b[q];
                    u32x2v w; w.x = cvt_pk_bf16(o[0], o[1]); w.y = cvt_pk_bf16(o[2], o[3]); *(u32x2v*)(rowp + n * 16) = w; } }
    }
};
struct EpiGate {
    static constexpr bool PERM = false, AFTER_DRAIN = false;
    float* Y; const float* gate; int nJ;
    __device__ __forceinline__ void operator()(const f32x4 (&acc)[2][2][4][2], const Unit& u, int wr, int wc, int fr, int fq) const {
        const int row0 = u.pm * BM + wr * 64 + fr, col0 = (u.pn % nJ) * BM + wc * 32 + 4 * fq;
#pragma unroll
        for (int ai = 0; ai < 2; ++ai)
#pragma unroll
            for (int m = 0; m < 4; ++m) { const int r = row0 + ai * HALF + m * 16; const float gt = gate[r]; float* rowp = Y + (size_t)r * D_MODEL + col0;
#pragma unroll
                for (int bj = 0; bj < 2; ++bj)
#pragma unroll
                    for (int n = 0; n < 2; ++n) *(f32x4*)(rowp + bj * HALF + n * 16) = acc[ai][bj][m][n] * gt; }
    }
};
template <class Epi, class Sched>
__device__ __forceinline__ void gemm_phase(PG8_LAS unsigned char* lds, const Gemm g, const Sched& S, const Epi& E) {
    const int tid = threadIdx.x, wid = __builtin_amdgcn_readfirstlane(tid >> 6), lane = tid & 63, wr = wid >> 2, wc = wid & 3, fr = lane & 15, fq = lane >> 4;
    const int K = g.K, nt = K / BK;
    unsigned voffA[2], voffB[2];
#pragma unroll
    for (int i = 0; i < 2; ++i) { int R, C; stage_rc(tid * 16 + i * 8192, R, C); const int Rb = Epi::PERM ? ((R & ~31) + perm32(R & 31)) : R;
        voffA[i] = (unsigned)(R * K + C) * 2u; voffB[i] = (unsigned)(Rb * K + C) * 2u; }
    const size_t kstep = (size_t)(BK * 2);
    const size_t hstep = (size_t)HALF * K * 2;
    const size_t tstep = 2 * hstep;
    const unsigned ldsw = (unsigned)wid * 1024u;
    const int aoff = lds_byte(wr * 64 + fr, fq * 8), boff = lds_byte(wc * 32 + fr, fq * 8);
#define PG8_SA(b, h) (((b) * 2 + (h)) * HTB)
#define PG8_SB(b, h) ((4 + (b) * 2 + (h)) * HTB)
#define PG8_STAGE(bufoff, gbase, voff) do { _Pragma("unroll") for (int _i = 0; _i < 2; ++_i) \
        __builtin_amdgcn_global_load_lds((const unsigned*)((const char*)(gbase) + (voff)[_i]), (PG8_LAS unsigned*)(lds + (bufoff) + ldsw + _i * 8192), 16, 0, 0); } while (0)
#define PG8_LDA(dst, b, h) do { _Pragma("unroll") for (int m = 0; m < 4; ++m) _Pragma("unroll") for (int k = 0; k < 2; ++k) dst[m][k] = *(const PG8_LAS bf16x8*)(lds + PG8_SA(b, h) + aoff + m * 2048 + k * 1024); } while (0)
#define PG8_LDB(dst, b, h) do { _Pragma("unroll") for (int n = 0; n < 2; ++n) _Pragma("unroll") for (int k = 0; k < 2; ++k) dst[n][k] = *(const PG8_LAS bf16x8*)(lds + PG8_SB(b, h) + boff + n * 2048 + k * 1024); } while (0)
#define PG8_MMA(ai, bj, At, Bt) do { __builtin_amdgcn_s_setprio(1); _Pragma("unroll") for (int m = 0; m < 4; ++m) _Pragma("unroll") for (int n = 0; n < 2; ++n) _Pragma("unroll") for (int k = 0; k < 2; ++k) \
        acc[ai][bj][m][n] = __builtin_amdgcn_mfma_f32_16x16x32_bf16(Bt[n][k], At[m][k], acc[ai][bj][m][n], 0, 0, 0); __builtin_amdgcn_s_setprio(0); } while (0)
#define PG8_WAIT_V(n) asm volatile("s_waitcnt vmcnt(" #n ")" ::: "memory")
#define PG8_WAIT_L(n) asm volatile("s_waitcnt lgkmcnt(" #n ")" ::: "memory")
#define PG8_BAR __builtin_amdgcn_s_barrier()
#define PG8_SCHED __builtin_amdgcn_sched_barrier(0)
    Unit cur, nxt; int ui = 0;
    if (!S.next(0, cur)) return;
    f32x4 acc[2][2][4][2];
#pragma unroll
    for (int a = 0; a < 2; ++a)
#pragma unroll
        for (int b = 0; b < 2; ++b)
#pragma unroll
            for (int m = 0; m < 4; ++m)
#pragma unroll
                for (int n = 0; n < 2; ++n) acc[a][b][m][n] = (f32x4){0.f, 0.f, 0.f, 0.f};
    bf16x8 At[4][2], B0[2][2], B1[2][2];
    const char* cA = (const char*)g.A + (size_t)cur.pm * tstep; const char* cB = (const char*)g.Bt + (size_t)cur.pn * tstep;
    S.a_ready(cur);
    PG8_STAGE(PG8_SB(0, 0), cB, voffB); PG8_STAGE(PG8_SA(0, 0), cA, voffA); PG8_STAGE(PG8_SB(0, 1), cB + hstep, voffB); PG8_STAGE(PG8_SA(0, 1), cA + hstep, voffA);
    if (wr == 1) PG8_BAR;
    PG8_WAIT_V(4); PG8_BAR;
    PG8_STAGE(PG8_SB(1, 0), cB + kstep, voffB); PG8_STAGE(PG8_SA(1, 0), cA + kstep, voffA); PG8_STAGE(PG8_SB(1, 1), cB + hstep + kstep, voffB);
    PG8_WAIT_V(6); PG8_BAR;
    for (;;) {
        const bool has_next = S.next(ui + 1, nxt);
        const char* nA = has_next ? (const char*)g.A + (size_t)nxt.pm * tstep : cA; const char* nB = has_next ? (const char*)g.Bt + (size_t)nxt.pn * tstep : cB;
        for (int t = 0; t < nt; t += 2) {
            const bool last = (t == nt - 2);
            const char* a1 = cA + (size_t)(t + 1) * kstep;
            const char* a2 = last ? nA : cA + (size_t)(t + 2) * kstep; const char* b2 = last ? nB : cB + (size_t)(t + 2) * kstep;
            const char* a3 = a2 + kstep; const char* b3 = b2 + kstep;
            if (last && has_next) S.a_ready(nxt);
            PG8_LDB(B0, 0, 0); PG8_SCHED; PG8_LDA(At, 0, 0); PG8_STAGE(PG8_SA(1, 1), a1 + hstep, voffA);
            PG8_WAIT_L(8); PG8_BAR; PG8_WAIT_L(0); PG8_MMA(0, 0, At, B0); PG8_BAR; PG8_SCHED;
            PG8_LDB(B1, 0, 1); PG8_STAGE(PG8_SB(0, 0), b2, voffB);
            PG8_BAR; PG8_WAIT_L(0); PG8_MMA(0, 1, At, B1); PG8_BAR;
            PG8_LDA(At, 0, 1); PG8_STAGE(PG8_SA(0, 0), a2, voffA);
            PG8_BAR; PG8_WAIT_L(0); PG8_MMA(1, 0, At, B0); PG8_BAR; PG8_SCHED;
            PG8_STAGE(PG8_SB(0, 1), b2 + hstep, voffB);
            PG8_WAIT_V(6); PG8_BAR; PG8_MMA(1, 1, At, B1); PG8_BAR;
            PG8_LDB(B0, 1, 0); PG8_SCHED; PG8_LDA(At, 1, 0); PG8_STAGE(PG8_SA(0, 1), a2 + hstep, voffA);
            PG8_WAIT_L(8); PG8_BAR; PG8_WAIT_L(0); PG8_MMA(0, 0, At, B0); PG8_BAR; PG8_SCHED;
            PG8_LDB(B1, 1, 1); PG8_STAGE(PG8_SB(1, 0), b3, voffB);
            PG8_BAR; PG8_WAIT_L(0); PG8_MMA(0, 1, At, B1); PG8_BAR;
            PG8_LDA(At, 1, 1); PG8_STAGE(PG8_SA(1, 0), a3, voffA);
            PG8_BAR; PG8_WAIT_L(0); PG8_MMA(1, 0, At, B0); PG8_BAR; PG8_SCHED;
            PG8_STAGE(PG8_SB(1, 1), b3 + hstep, voffB);
            PG8_WAIT_V(6); PG8_BAR; PG8_MMA(1, 1, At, B1); PG8_BAR;
        }
        if constexpr (!Epi::AFTER_DRAIN) { E(acc, cur, wr, wc, fr, fq); S.done(cur); }
        if (!has_next) break;
#pragma unroll
        for (int a = 0; a < 2; ++a)
#pragma unroll
            for (int b = 0; b < 2; ++b)
#pragma unroll
                for (int m = 0; m < 4; ++m)
#pragma unroll
                    for (int n = 0; n < 2; ++n) acc[a][b][m][n] = (f32x4){0.f, 0.f, 0.f, 0.f};
        cur = nxt; cA = nA; cB = nB; ++ui;
    }
    PG8_WAIT_V(0);
    if (wr == 0) PG8_BAR;
    PG8_BAR;
    if constexpr (Epi::AFTER_DRAIN) { E.fused(acc, cur, wr, wc, fr, fq, lds, wid, lane); S.done(cur); }
#undef PG8_SA
#undef PG8_SB
#undef PG8_STAGE
#undef PG8_LDA
#undef PG8_LDB
#undef PG8_MMA
#undef PG8_WAIT_V
#undef PG8_WAIT_L
#undef PG8_BAR
#undef PG8_SCHED
}
}


namespace att {
using bf16 = unsigned short;
constexpr int   D = 128, NW = 8, QBLK = 32, KVBLK = 64;
constexpr float SCALE = 0.088388347648318440f;
constexpr float THR = 8.f;
constexpr int SDEPTH = 2;
constexpr int LDQ = 128, LDK = 128, LDO = D_MODEL;
constexpr size_t SHM_V = KVBLK * D * 2, SHM_K = KVBLK * D * 2, SHM_ATTN = 2 * SHM_V + 2 * SHM_K + NW * 64 * 4;
using bf16x8 = __attribute__((ext_vector_type(8))) short;
using s16x4  = __attribute__((ext_vector_type(4))) short;
using f32x16 = __attribute__((ext_vector_type(16))) float;
using f32x8  = __attribute__((ext_vector_type(8))) float;
using u32x4  = __attribute__((ext_vector_type(4))) unsigned;
#define KSWZ(row, colB) ((row) * 256 + ((colB) ^ (((row) & 7) << 4)))
#define SBAR() __builtin_amdgcn_sched_barrier(0)
__device__ __forceinline__ int crow(int r, int hi) { return (r & 3) + 8 * (r >> 2) + 4 * hi; }
__device__ __forceinline__ unsigned cvtpk(float lo, float hi) {
  unsigned r; asm volatile("v_cvt_pk_bf16_f32 %0, %1, %2" : "=v"(r) : "v"(lo), "v"(hi)); return r;
}
template <typename TIn> struct Stage;
template <> struct Stage<bf16>  { using T = bf16x8;
  __device__ static __forceinline__ T ld8(const bf16* p) { return *reinterpret_cast<const bf16x8*>(p); }
  __device__ static __forceinline__ bf16x8 tobf(T x) { return x; } };
template <> struct Stage<float> { using T = f32x8;
  __device__ static __forceinline__ T ld8(const float* p) { return *reinterpret_cast<const f32x8*>(p); }
  __device__ static __forceinline__ bf16x8 tobf(T x) {
    u32x4 w = {cvtpk(x[0], x[1]), cvtpk(x[2], x[3]), cvtpk(x[4], x[5]), cvtpk(x[6], x[7])}; return *reinterpret_cast<bf16x8*>(&w); } };

__device__ __forceinline__ void partialSM(f32x16& p0, f32x16& p1, float& m_reg, float& mn, float& alpha) {
  constexpr float C = SCALE * 1.4426950408889634f;
  float pmax = p0[0]; for (int r = 1; r < 16; ++r) pmax = fmaxf(pmax, p0[r]); for (int r = 0; r < 16; ++r) pmax = fmaxf(pmax, p1[r]);
  { auto rr = __builtin_amdgcn_permlane32_swap(__float_as_uint(pmax), __float_as_uint(pmax), false, false);
    pmax = fmaxf(__uint_as_float(rr[0]), __uint_as_float(rr[1])); }
  if (__builtin_expect(__all(pmax - m_reg <= THR / SCALE), 1)) { mn = m_reg; alpha = 1.f; }
  else { mn = fmaxf(m_reg, pmax); alpha = __builtin_amdgcn_exp2f((m_reg - mn) * C); m_reg = mn; }
  float mnC = -mn * C;
  for (int r = 0; r < 16; ++r) p0[r] = fmaf(p0[r], C, mnC); for (int r = 0; r < 16; ++r) p1[r] = fmaf(p1[r], C, mnC);
  for (int r = 0; r < 16; ++r) p0[r] = __builtin_amdgcn_exp2f(p0[r]);
}
__device__ __forceinline__ void finishSM(f32x16& p0, f32x16& p1, float alpha, float& l_reg, bf16x8& pa0, bf16x8& pa1, bf16x8& pa2, bf16x8& pa3) {
  for (int r = 0; r < 16; ++r) p1[r] = __builtin_amdgcn_exp2f(p1[r]);
  float ps = 0; for (int r = 0; r < 16; ++r) ps += p0[r]; for (int r = 0; r < 16; ++r) ps += p1[r];
  { auto rr = __builtin_amdgcn_permlane32_swap(__float_as_uint(ps), __float_as_uint(ps), false, false);
    ps = __uint_as_float(rr[0]) + __uint_as_float(rr[1]); }
  l_reg = l_reg * alpha + ps;
#define PK4(P, BASE, OUT) do { unsigned a0 = cvtpk(P[BASE + 0], P[BASE + 1]), a1 = cvtpk(P[BASE + 2], P[BASE + 3]);   \
    unsigned b0 = cvtpk(P[BASE + 4], P[BASE + 5]), b1 = cvtpk(P[BASE + 6], P[BASE + 7]);                              \
    auto r0 = __builtin_amdgcn_permlane32_swap(a0, b0, false, false); auto r1 = __builtin_amdgcn_permlane32_swap(a1, b1, false, false); \
    u32x4 w = {r0[0], r1[0], r0[1], r1[1]}; OUT = *reinterpret_cast<bf16x8*>(&w); } while (0)
  PK4(p0, 0, pa0); PK4(p0, 8, pa1); PK4(p1, 0, pa2); PK4(p1, 8, pa3);
#undef PK4
}
__device__ __forceinline__ void qkt(f32x16& p0, f32x16& p1, const bf16* Ks, const bf16x8* qr, int r32, int hi) {
  p0 = f32x16{}; p1 = f32x16{};
  for (int d0 = 0; d0 < 8; ++d0) { int cb = (d0 * 16 + hi * 8) * 2;
    bf16x8 b0 = *reinterpret_cast<const bf16x8*>((const char*)Ks + KSWZ(r32, cb));
    bf16x8 b1 = *reinterpret_cast<const bf16x8*>((const char*)Ks + KSWZ(32 + r32, cb));
    p0 = __builtin_amdgcn_mfma_f32_32x32x16_bf16(b0, qr[d0], p0, 0, 0, 0);
    p1 = __builtin_amdgcn_mfma_f32_32x32x16_bf16(b1, qr[d0], p1, 0, 0, 0); }
}
__device__ __forceinline__ int v_st(int k, int c) { const int kk = (k & ~0xC) | ((k & 4) << 1) | ((k & 8) >> 1); return ((kk >> 3) * 4 + (c >> 5)) * 512 + ((kk & 7) * 32 + (c & 31)) * 2; }
__device__ __forceinline__ int v_rd_base(int lane) { return ((lane & 3) << 3) | (((lane >> 2) & 3) << 6) | (((lane >> 4) & 1) << 5) | (((lane >> 5) & 1) << 8); }
constexpr int v_rd_off(int d0, int ks, int half) { return d0 * 512 + ks * 4096 + half * 2048; }
template <int OFF> __device__ __forceinline__ s16x4 tr_read(int vb) {
  s16x4 r; asm volatile("ds_read_b64_tr_b16 %0, %1 offset:%2" : "=&v"(r) : "v"(vb), "i"(OFF) : "memory"); return r;
}
template <int D0> __device__ __forceinline__ void pv_one(f32x16& od, int vb, bf16x8 pa0, bf16x8 pa1, bf16x8 pa2, bf16x8 pa3) {
  const s16x4 l0 = tr_read<v_rd_off(D0, 0, 0)>(vb), h0 = tr_read<v_rd_off(D0, 0, 1)>(vb), l1 = tr_read<v_rd_off(D0, 1, 0)>(vb), h1 = tr_read<v_rd_off(D0, 1, 1)>(vb);
  const s16x4 l2 = tr_read<v_rd_off(D0, 2, 0)>(vb), h2 = tr_read<v_rd_off(D0, 2, 1)>(vb), l3 = tr_read<v_rd_off(D0, 3, 0)>(vb), h3 = tr_read<v_rd_off(D0, 3, 1)>(vb);
  asm volatile("s_waitcnt lgkmcnt(0)" ::: "memory"); SBAR();
#define PK(L, H) (bf16x8){L[0], L[1], L[2], L[3], H[0], H[1], H[2], H[3]}
  od = __builtin_amdgcn_mfma_f32_32x32x16_bf16(pa0, PK(l0, h0), od, 0, 0, 0);
  od = __builtin_amdgcn_mfma_f32_32x32x16_bf16(pa1, PK(l1, h1), od, 0, 0, 0);
  od = __builtin_amdgcn_mfma_f32_32x32x16_bf16(pa2, PK(l2, h2), od, 0, 0, 0);
  od = __builtin_amdgcn_mfma_f32_32x32x16_bf16(pa3, PK(l3, h3), od, 0, 0, 0);
#undef PK
}
__device__ __forceinline__ void pv_d0(f32x16* o, int vb, bf16x8 pa0, bf16x8 pa1, bf16x8 pa2, bf16x8 pa3) {
  pv_one<0>(o[0], vb, pa0, pa1, pa2, pa3); pv_one<1>(o[1], vb, pa0, pa1, pa2, pa3); pv_one<2>(o[2], vb, pa0, pa1, pa2, pa3); pv_one<3>(o[3], vb, pa0, pa1, pa2, pa3);
}

__device__ __forceinline__ void attn_dense_body(const bf16* __restrict__ Qb, const bf16* __restrict__ Kh, const bf16* __restrict__ Vh,
                                                unsigned short* __restrict__ Ob, int seq, char* lds) {
  using St = Stage<bf16>; using SQ = Stage<bf16>; using TQ = bf16;
  const int tid = threadIdx.x, wid = tid >> 6, lane = tid & 63, r32 = lane & 31, hi = lane >> 5;
  bf16* V_lds = (bf16*)lds; bf16* K_lds = (bf16*)(lds + 2 * SHM_V);
  float* ws = (float*)(lds + 2 * SHM_V + 2 * SHM_K) + wid * 64; float* li_l = ws; float* al_l = ws + 32;
  float m_reg = -1e30f, l_reg = 0; f32x16 o[4] = {}; bf16x8 qr[8];
  const TQ* Qw = Qb + (long)(wid * QBLK + r32) * LDQ + hi * 8;
#pragma unroll
  for (int d0 = 0; d0 < 8; ++d0) qr[d0] = SQ::tobf(SQ::ld8(Qw + d0 * 16));
  const int sr = tid >> 4, sc = (tid & 15) * 8, vst0 = v_st(sr, sc), vst1 = v_st(32 + sr, sc);
  const int vb0 = (int)(uintptr_t)V_lds + v_rd_base(lane);
  struct { typename St::T vs0, vs1, ks0, ks1; } sr_[SDEPTH];
#define SLOAD(i, k0) do { sr_[i].vs0 = St::ld8(&Vh[(long)((k0) + sr) * LDK + sc]); sr_[i].vs1 = St::ld8(&Vh[(long)((k0) + 32 + sr) * LDK + sc]); \
    sr_[i].ks0 = St::ld8(&Kh[(long)((k0) + sr) * LDK + sc]); sr_[i].ks1 = St::ld8(&Kh[(long)((k0) + 32 + sr) * LDK + sc]); } while (0)
#define SWRITE(b, i) do { *(bf16x8*)((char*)V_lds + (b) * SHM_V + vst0) = St::tobf(sr_[i].vs0);          \
    *(bf16x8*)((char*)V_lds + (b) * SHM_V + vst1) = St::tobf(sr_[i].vs1); int kc = sc * 2;               \
    *(bf16x8*)((char*)K_lds + (b) * SHM_K + KSWZ(sr, kc)) = St::tobf(sr_[i].ks0);                       \
    *(bf16x8*)((char*)K_lds + (b) * SHM_K + KSWZ(32 + sr, kc)) = St::tobf(sr_[i].ks1); } while (0)
#define SWAIT() do { if constexpr (SDEPTH == 2) asm volatile("s_waitcnt vmcnt(4)" ::: "memory"); else asm volatile("s_waitcnt vmcnt(0)" ::: "memory"); } while (0)
#define RESC(a) do { if (__any((a) < 1.f)) { if (hi == 0) al_l[r32] = (a); asm volatile("s_waitcnt lgkmcnt(0)" ::: "memory"); \
    for (int d = 0; d < 4; ++d) for (int r = 0; r < 16; ++r) o[d][r] *= al_l[crow(r, hi)]; } } while (0)
  f32x16 pA0, pA1, pB0, pB1; float mnA, mnB, alA, alB; bf16x8 pa0, pa1, pa2, pa3; const int NT = seq / KVBLK;
  constexpr int SE = 0, SO = SDEPTH - 1;
  SLOAD(SE, 0); asm volatile("s_waitcnt vmcnt(0)" ::: "memory"); SWRITE(0, SE); __syncthreads();
  qkt(pA0, pA1, K_lds, qr, r32, hi); partialSM(pA0, pA1, m_reg, mnA, alA);
  SLOAD(SO, KVBLK); if constexpr (SDEPTH == 2) { if (2 < NT) SLOAD(SE, 2 * KVBLK); }
  SWAIT(); SWRITE(1, SO); __syncthreads();
  for (int j = 1; j + 1 < NT; j += 2) {
    SBAR(); qkt(pB0, pB1, (bf16*)((char*)K_lds + SHM_K), qr, r32, hi);
    finishSM(pA0, pA1, alA, l_reg, pa0, pa1, pa2, pa3); SBAR();
    SLOAD(SO, (j + SDEPTH) * KVBLK); SBAR();
    pv_d0(o, vb0, pa0, pa1, pa2, pa3); partialSM(pB0, pB1, m_reg, mnB, alB);
    __syncthreads(); SWAIT(); SWRITE(0, SE);
    RESC(alB); __syncthreads();
    SBAR(); qkt(pA0, pA1, K_lds, qr, r32, hi);
    finishSM(pB0, pB1, alB, l_reg, pa0, pa1, pa2, pa3); SBAR();
    if (SDEPTH == 1 || j + 3 < NT) SLOAD(SE, (j + 1 + SDEPTH) * KVBLK); SBAR();
    pv_d0(o, vb0 + (int)SHM_V, pa0, pa1, pa2, pa3); partialSM(pA0, pA1, m_reg, mnA, alA);
    __syncthreads(); SWAIT(); SWRITE(1, SO);
    RESC(alA); __syncthreads();
  }
  SBAR(); qkt(pB0, pB1, (bf16*)((char*)K_lds + SHM_K), qr, r32, hi);
  finishSM(pA0, pA1, alA, l_reg, pa0, pa1, pa2, pa3); SBAR();
  pv_d0(o, vb0, pa0, pa1, pa2, pa3); partialSM(pB0, pB1, m_reg, mnB, alB);
  __syncthreads(); RESC(alB);
  finishSM(pB0, pB1, alB, l_reg, pa0, pa1, pa2, pa3); SBAR();
  pv_d0(o, vb0 + (int)SHM_V, pa0, pa1, pa2, pa3);
  if (hi == 0) li_l[r32] = l_reg; asm volatile("s_waitcnt lgkmcnt(0)" ::: "memory");
  float rli[16];
#pragma unroll
  for (int r = 0; r < 16; ++r) rli[r] = __builtin_amdgcn_rcpf(li_l[crow(r, hi)]);
  unsigned short* Ow = Ob + (long)(wid * QBLK) * LDO;
#pragma unroll
  for (int r = 0; r < 16; ++r) { int orow = crow(r, hi);
    for (int d0 = 0; d0 < 4; ++d0) Ow[(long)orow * LDO + d0 * 32 + r32] = f2bf(o[d0][r] * rli[r]); }
#undef SLOAD
#undef SWRITE
#undef SWAIT
#undef RESC
}
}

__device__ __forceinline__ void cvt_tile(const float* __restrict__ W, int ldw, int nvalid, int k0, int n0, u16* __restrict__ Wt, int rowbase, int rmode, float* lds) {
    const int tid = threadIdx.x;
    for (int idx = tid; idx < 4096; idx += 512) { const int kk = idx >> 6, nn = idx & 63; const int n = n0 + nn;
        lds[kk * 65 + nn] = n < nvalid ? W[(size_t)(k0 + kk) * ldw + n] : 0.f; }
    __syncthreads();
    for (int idx = tid; idx < 1024; idx += 512) { const int nn = idx >> 4, k4 = (idx & 15) * 4; const int n = n0 + nn;
        int row = n;
        if (rmode) row = (n >> 7) * 256 + (n & 127) + (rmode == 2 ? 128 : 0);
        pg8::u32x2v w; w.x = pg8::cvt_pk_bf16(lds[(k4 + 0) * 65 + nn], lds[(k4 + 1) * 65 + nn]); w.y = pg8::cvt_pk_bf16(lds[(k4 + 2) * 65 + nn], lds[(k4 + 3) * 65 + nn]);
        *(pg8::u32x2v*)(Wt + (size_t)(rowbase + row) * D_MODEL + k0 + k4) = w; }
    __syncthreads();
}
__device__ __forceinline__ void ph_convert(const Params& p, float* lds) {
    constexpr int KT = D_MODEL / 64;
    constexpr int T_IN = KT * (LDP / 64), T_OUT = KT * (D_MODEL / 64), T_E = KT * (D_MODEL / 64);
    constexpr int PER_L = T_IN + T_OUT + NE * 3 * T_E, TOTAL = DEPTH * PER_L;
    for (int t = blockIdx.x; t < TOTAL; t += gridDim.x) {
        const int l = t / PER_L; int r = t % PER_L;
        if (r < T_IN) { const int kt = r % KT, nt = r / KT;
            cvt_tile(p.w_in + (size_t)l * D_MODEL * N_IN, N_IN, N_IN, kt * 64, nt * 64, p.wt_in + (size_t)l * LDP * D_MODEL, 0, 0, lds); continue; }
        r -= T_IN;
        if (r < T_OUT) { const int kt = r % KT, nt = r / KT;
            cvt_tile(p.w_out + (size_t)l * D_MODEL * D_MODEL, D_MODEL, D_MODEL, kt * 64, nt * 64, p.wt_out + (size_t)l * D_MODEL * D_MODEL, 0, 0, lds); continue; }
        r -= T_OUT;
        const int e = r / (3 * T_E), which = (r / T_E) % 3, q = r % T_E, kt = q % KT, nt = q / KT;
        const size_t eo = ((size_t)l * NE + e) * D_MODEL * D_MODEL;
        if (which == 0) cvt_tile(p.w_exp1 + eo, D_MODEL, D_MODEL, kt * 64, nt * 64, p.w13t + 2 * eo, 0, 1, lds);
        else if (which == 1) cvt_tile(p.w_exp3 + eo, D_MODEL, D_MODEL, kt * 64, nt * 64, p.w13t + 2 * eo, 0, 2, lds);
        else cvt_tile(p.w_exp2 + eo, D_MODEL, D_MODEL, kt * 64, nt * 64, p.w2t + eo, 0, 0, lds);
    }
}

constexpr int LDS_BYTES = 147456;
constexpr int LDS_MISC = 147392;
constexpr int NPL = 15;
constexpr int NPHASE = 2 + DEPTH * NPL + 1;

struct Args { Params p; int ph_lo, ph_hi, flags, pad; };

template <int G> __device__ __forceinline__ Exec mk_exec() { const int gt = blockIdx.x * 512 + threadIdx.x; return Exec{gt / G, (int)(gridDim.x * 512) / G, gt % G}; }
typedef const __attribute__((address_space(4))) unsigned long long* kq_t;
__device__ __forceinline__ void load_params(Params& p, const __attribute__((address_space(4))) unsigned char* ka) {
    kq_t s = (kq_t)ka; unsigned long long* d = (unsigned long long*)&p;
#pragma unroll
    for (int i = 0; i < (int)(sizeof(Params) / 8); ++i) d[i] = s[i];
}
#define LOADP() Params p; load_params(p, ka)
#define PH(k, ...) do { if (lo <= (k) && (k) < hi) { { LOADP(); __VA_ARGS__; } if ((k) + 1 < hi) xcd_barrier(bar); } } while (0)
#define e1 mk_exec<1>()
#define e16 mk_exec<16>()
#define e64 mk_exec<64>()
#define flds ((float*)lds)
#define glds ((PG8_LAS unsigned char*)lds)
#define G ((int)gridDim.x)
#define c ((int)blockIdx.x)
template <int L> __device__ __forceinline__ void layer_phases(const __attribute__((address_space(4))) unsigned char* ka, int lo, int hi, int flags, const XcdBarrier& bar, unsigned char* lds) {
    constexpr int l = L;
        const int b0 = 2 + l * NPL; const bool last = (l == DEPTH - 1);
        PH(b0 + 0, ph_norm1<64>(p, l, e64));
        PH(b0 + 1, { pg8::Gemm g{p.h, p.wt_in + (size_t)l * LDP * D_MODEL, MROWS, LDP, D_MODEL}; pg8::StaticOrder S; S.init(MROWS, LDP, G, c);
                     pg8::EpiF32 E{p.P, LDP}; pg8::gemm_phase<pg8::EpiF32, pg8::StaticOrder>(glds, g, S, E); });
        PH(b0 + 2, ph_rw_prep1<64>(p, l, e64); ph_ml_g1<64>(p, l, e64); ph_gd_prep<64>(p, l, e64); ph_gd_gates<64>(p, l, e64); ph_at_prep<64>(p, l, e64));
        PH(b0 + 3, ph_rw_prep2(p, l, e64); ph_ml_g2(p, e1); ph_gd_c1(p, e64));
        PH(b0 + 4, { for (int u = c; u < RW_CN; u += G) ph_rw_c1_unit(p, u, threadIdx.x, 512, lds); for (int u = G - 1 - c; u < ML_CN; u += G) ph_ml_c1_unit(p, u, threadIdx.x, 512, lds); });
        PH(b0 + 5, {
            const int nlat = BATCH * AT_QH * (SEQ / 256), nctx = last ? 0 : BATCH * AT_QH;
            if (flags & 1) {} else if (c < nlat) { const int u = c;
                const int qb = u % (SEQ / 256), hq = (u / (SEQ / 256)) % AT_QH, b = u / ((SEQ / 256) * AT_QH), s0 = CTX + qb * 256, kvh = hq / (AT_QH / AT_KVH);
                att::attn_dense_body((const att::bf16*)p.at_q + (((size_t)b * AT_QH + hq) * TOK + s0) * AT_HEAD,
                                     (const att::bf16*)p.at_k + ((size_t)b * AT_KVH + kvh) * TOK * AT_HEAD, (const att::bf16*)p.at_v + ((size_t)b * AT_KVH + kvh) * TOK * AT_HEAD,
                                     p.mix + ((size_t)b * TOK + s0) * D_MODEL + 3 * GROUP_W + hq * AT_HEAD, TOK, (char*)lds);
                __syncthreads(); }
            else if (c < nlat + nctx) { const int u = c - nlat;
                const int hq = u % AT_QH, b = u / AT_QH, kvh = hq / (AT_QH / AT_KVH);
                att::attn_dense_body((const att::bf16*)p.at_q + (((size_t)b * AT_QH + hq) * TOK) * AT_HEAD,
                                     (const att::bf16*)p.at_k + ((size_t)b * AT_KVH + kvh) * TOK * AT_HEAD, (const att::bf16*)p.at_v + ((size_t)b * AT_KVH + kvh) * TOK * AT_HEAD,
                                     p.mix + ((size_t)b * TOK) * D_MODEL + 3 * GROUP_W + hq * AT_HEAD, CTX, (char*)lds);
                __syncthreads(); }
            else { const int c2 = c - nlat - nctx, G2 = G - nlat - nctx; constexpr int NU1 = (RW_CN + TS_G - 1) / TS_G, NU2 = (GD_CN + TS_G - 1) / TS_G;
                if (!(flags & 2)) for (int u = c2; u < NU1 + NU2; u += G2) { if (u < NU1) ph_tsolve_unit(p.rw_Ma, p.rw_T, RW_CN, u, threadIdx.x, 512, lds); else ph_tsolve_unit(p.gd_A, p.gd_T, GD_CN, u - NU1, threadIdx.x, 512, lds); } } });
        PH(b0 + 6, { if (!(flags & 4)) for (int u = c; u < RW_CN; u += G) ph_rw_c3_unit(p, u, threadIdx.x, 512, lds);
                     if (!(flags & 8)) for (int u = G - 1 - c; u < GD_CN; u += G) ph_gd_c3_unit(p, u, threadIdx.x, 512, lds);
                     ph_ml_prefix(p, e1); });
        PH(b0 + 7, { if (!(flags & 16)) for (int u = c; u < GD_S2_UNITS; u += G) ph_gd_scan2_unit(p, u, threadIdx.x, 512, lds); }
                   { if (!(flags & 32)) for (int u = G - 1 - c; u < RW_CH; u += G) ph_rw_scan2_unit(p, u, threadIdx.x, 512, lds); }
                   { if (!(flags & 64)) for (int u = c - GD_S2_UNITS; u < ML_CN; u += G - GD_S2_UNITS - RW_CH) if (u >= 0 && c < G - RW_CH) ph_ml_c2_unit(p, u, threadIdx.x, 512, lds); });
        PH(b0 + 8, ph_rw_post<64>(p, l, e64); ph_gd_post<64>(p, l, e64); ph_ml_post<64>(p, l, e64));
        PH(b0 + 9, { pg8::Gemm g{p.mix, p.wt_out + (size_t)l * D_MODEL * D_MODEL, MROWS, D_MODEL, D_MODEL}; pg8::TileOrder S;
                      S.init(last ? BATCH * SEQ / 256 : MROWS / 256, D_MODEL / 256, G, c, last ? 1 : 0);
                      pg8::EpiResid E{p.xres, p.mod + (size_t)l * 3 * 6 * D_MODEL}; pg8::gemm_phase<pg8::EpiResid, pg8::TileOrder>(glds, g, S, E); });
        PH(b0 + 10, ph_norm2<64>(p, l, e64));
        PH(b0 + 11, { for (int u = c; u < topk_units(l); u += G) ph_topk_unit(p, l, u, threadIdx.x, 512, lds); });
        PH(b0 + 12, ph_gather<64>(p, l, e64));
        PH(b0 + 13, { pg8::Gemm g{p.xs, p.w13t + (size_t)l * NE * 2 * D_MODEL * D_MODEL, NE * NSLOT, NE * 2 * D_MODEL, D_MODEL}; pg8::GroupedOrder S;
                      S.init(last ? NSLOT_L / 256 : NSLOT / 256, 2 * D_MODEL / 256, NSLOT / 256, G, c);
                      pg8::EpiSwiGLU E{p.hid, 2 * D_MODEL / 256}; pg8::gemm_phase<pg8::EpiSwiGLU, pg8::GroupedOrder>(glds, g, S, E); });
        PH(b0 + 14, { pg8::Gemm g{p.hid, p.w2t + (size_t)l * NE * D_MODEL * D_MODEL, NE * NSLOT, NE * D_MODEL, D_MODEL}; pg8::GroupedOrder S;
                      S.init(last ? NSLOT_L / 256 : NSLOT / 256, D_MODEL / 256, NSLOT / 256, G, c);
                      pg8::EpiGate E{p.yexp, p.sel_gate, D_MODEL / 256}; pg8::gemm_phase<pg8::EpiGate, pg8::GroupedOrder>(glds, g, S, E); });
    }
__global__ void __launch_bounds__(512, 2) mega(Args args) {
    extern __shared__ __attribute__((aligned(16))) unsigned char lds[];
    typedef const __attribute__((address_space(4))) unsigned char* kptr_t;
    const kptr_t ka = (kptr_t)__builtin_amdgcn_kernarg_segment_ptr();
    (void)args;
    const unsigned long long lohi = ((kq_t)ka)[sizeof(Params) / 8]; const int lo = (int)(unsigned)lohi, hi = (int)(unsigned)(lohi >> 32);
    const int flags = (int)(unsigned)((kq_t)ka)[sizeof(Params) / 8 + 1];
    unsigned* barw = (unsigned*)((kq_t)ka)[offsetof(Params, bar) / 8];
    volatile LAS unsigned* misc = (volatile LAS unsigned*)((LAS unsigned char*)lds + LDS_MISC);
    if (threadIdx.x < 4) misc[threadIdx.x] = 0u;
    __syncthreads();
    const bool use_bar = (hi - lo) > 1;
    XcdBarrier bar; bar.bar = barw; bar.x = 0; bar.st = misc;
    if (use_bar) bar = xcd_barrier_post(barw, misc);
    PH(0, ph_convert(p, flds); ph_mod_partial(p, e1); ph_rw_wpack(p, e1));
    PH(1, ph_mod_final(p, e1));
    layer_phases<0>(ka, lo, hi, flags, bar, lds);
    layer_phases<1>(ka, lo, hi, flags, bar, lds);
    static_assert(DEPTH == 2, "depth");
    PH(2 + DEPTH * NPL, ph_final<64>(p, e64));
}
#undef PH
#undef e1
#undef e16
#undef e64
#undef flds
#undef glds
#undef G
#undef c
#undef LOADP

static size_t ws_carve(Params& p, unsigned char* ws) {
    size_t off = 0;
    auto take = [&](size_t bytes) { size_t o = off; off += (bytes + 255) / 256 * 256; return ws ? ws + o : (unsigned char*)nullptr; };
    p.bar = (unsigned*)take(XCD_BAR_WORDS * 4);
    p.modp = (float*)take((size_t)DEPTH * MOD_KS * 3 * 6 * D_MODEL * 4); p.mod = (float*)take((size_t)DEPTH * 3 * 6 * D_MODEL * 4);
    p.wt_in = (u16*)take((size_t)DEPTH * LDP * D_MODEL * 2); p.wt_out = (u16*)take((size_t)DEPTH * D_MODEL * D_MODEL * 2);
    p.w13t = (u16*)take((size_t)DEPTH * NE * 2 * D_MODEL * D_MODEL * 2); p.w2t = (u16*)take((size_t)DEPTH * NE * D_MODEL * D_MODEL * 2);
    p.xres = (float*)take((size_t)MROWS * D_MODEL * 4); p.h = (u16*)take((size_t)MROWS * D_MODEL * 2); p.mix = (u16*)take((size_t)MROWS * D_MODEL * 2);
    p.aff = (float*)take((size_t)MROWS * NE * 4); p.inv = (int*)take((size_t)MROWS * NE * 4);
    p.sel_row = (int*)take((size_t)NE * NSLOT * 4); p.sel_gate = (float*)take((size_t)NE * NSLOT * 4);
    const size_t region = off;
    p.P = (float*)take((size_t)MROWS * LDP * 4);
    const size_t rg = (size_t)MROWS * GROUP_W * 4;
    p.rw_r = (float*)take(rg); p.rw_k = (float*)take(rg); p.rw_v = (float*)take(rg); p.rw_kk = (float*)take(rg); p.rw_g = (float*)take(rg);
    p.rw_lr = (float*)take((size_t)MROWS * RW_LR * 4);
    p.rw_ew = (float*)take(2 * rg); p.rw_kka = (float*)take(2 * rg); p.rw_kt = (float*)take(2 * rg); p.rw_y = (float*)take(2 * rg);
    p.rw_Ma = (float*)take((size_t)RW_CN * CHUNK * CHUNK * 4); p.rw_T = (float*)take((size_t)RW_CN * CHUNK * CHUNK * 4);
    p.rw_Psi = (float*)take((size_t)RW_CN * RW_N * RW_N * 4); p.rw_Y0 = p.rw_Ma;
    p.rw_PhiT = (u16*)take((size_t)RW_CN * RW_N * RW_N * 2); p.rw_Rh = (u16*)take((size_t)RW_CN * CHUNK * RW_N * 2);
    p.rw_W = (u16*)take((size_t)DEPTH * GROUP_W * RW_WK * 2);
    p.ml_bcum = (float*)take((size_t)ML_CH * TOK * 4); p.ml_g = (float*)take((size_t)ML_CH * TOK * 4); p.ml_gmax = (float*)take((size_t)ML_CH * TOK * 4);
    p.ml_bl = (float*)take((size_t)ML_CH * NCHUNK * 4); p.ml_gm = (float*)take((size_t)ML_CH * NCHUNK * 4); p.ml_min = (float*)take((size_t)ML_CH * NCHUNK * 4);
    p.ml_dC = (float*)take((size_t)ML_CH * NCHUNK * ML_HEAD * ML_HEAD * 4); p.ml_dn = (float*)take((size_t)ML_CH * NCHUNK * ML_HEAD * 4);
    p.ml_S = (float*)take((size_t)ML_CH * NCHUNK * CHUNK * CHUNK * 4); p.ml_hh = (float*)take(2 * rg);
    p.gd_q = (float*)take(rg); p.gd_k = (float*)take(rg); p.gd_v = (float*)take(rg);
    p.gd_gc = (float*)take((size_t)GD_CH * TOK * 4); p.gd_beta = (float*)take((size_t)GD_CH * TOK * 4);
    p.gd_A = (float*)take((size_t)GD_CN * CHUNK * CHUNK * 4); p.gd_T = (float*)take((size_t)GD_CN * CHUNK * CHUNK * 4);
    p.gd_Psi = (float*)take((size_t)GD_CN * GD_N * GD_N * 4); p.gd_O0 = (float*)take((size_t)GD_CN * CHUNK * GD_N * 4);
    p.gd_Phi = (u16*)take((size_t)GD_CN * GD_N * GD_N * 2); p.gd_Qh = (u16*)p.gd_A;
    p.gd_o = (float*)take(2 * rg);
    p.at_q = (u16*)take((size_t)BATCH * AT_QH * TOK * AT_HEAD * 2); p.at_k = (u16*)take((size_t)BATCH * AT_KVH * TOK * AT_HEAD * 2); p.at_v = (u16*)take((size_t)BATCH * AT_KVH * TOK * AT_HEAD * 2);
    const size_t end1 = off;
    off = region;
    p.xs = (u16*)take((size_t)NE * NSLOT * D_MODEL * 2); p.hid = (u16*)take((size_t)NE * NSLOT * D_MODEL * 2); p.yexp = (float*)take((size_t)NE * NSLOT * D_MODEL * 4);
    return end1 > off ? end1 : off;
}

#ifndef MK_PER_PHASE
#define MK_PER_PHASE 0
#endif
extern "C" void kernel_launch(void* const* d_in, const int* in_sizes, int n_in, void* d_out, int out_size, void* d_ws, size_t ws_size, hipStream_t stream) {
    static int grid = 0;
    if (grid == 0) {
        Params q{}; const size_t need = ws_carve(q, nullptr);
        if (n_in != 35 || out_size != BATCH * SEQ * D_MODEL || ws_size < need) {
            fprintf(stderr, "kernel_launch: expected 35 inputs, out %d, ws >= %zu; got n_in %d out %d ws %zu\n", BATCH * SEQ * D_MODEL, need, n_in, out_size, ws_size); grid = -1; return; }
        int dev = 0, cus = 0, per_cu = 0;
        if (hipGetDevice(&dev) != hipSuccess || hipDeviceGetAttribute(&cus, hipDeviceAttributeMultiprocessorCount, dev) != hipSuccess) { grid = -1; return; }
        if (hipFuncSetAttribute((const void*)mega, hipFuncAttributeMaxDynamicSharedMemorySize, LDS_BYTES) != hipSuccess) { fprintf(stderr, "kernel_launch: hipFuncSetAttribute failed\n"); grid = -1; return; }
        if (hipOccupancyMaxActiveBlocksPerMultiprocessor(&per_cu, (const void*)mega, 512, LDS_BYTES) != hipSuccess || per_cu < 1)
            fprintf(stderr, "kernel_launch: occupancy query reports %d workgroups per CU\n", per_cu);
        (void)hipGetLastError();
        if (cus < 160) { fprintf(stderr, "kernel_launch: needs >= 160 CUs\n"); grid = -1; return; }
        grid = cus;
    }
    if (grid < 0) return;
    Args a{};
    Params& p = a.p;
    const float** in = (const float**)&p;
    for (int i = 0; i < 35; ++i) in[i] = (const float*)d_in[i];
    p.out = (float*)d_out;
    (void)ws_carve(p, (unsigned char*)d_ws);
    (void)hipMemsetAsync(p.bar, 0, XCD_BAR_WORDS * 4, stream);
#if MK_PER_PHASE
    for (int k = 0; k < NPHASE; ++k) { a.ph_lo = k; a.ph_hi = k + 1; hipLaunchKernelGGL(mega, dim3(grid), dim3(512), LDS_BYTES, stream, a); }
#else
#ifdef MK_PROBE_K
#ifdef MK_PROBE_FLAGS
    a.flags = MK_PROBE_FLAGS;
#endif
    a.ph_lo = 0; a.ph_hi = MK_PROBE_K;
    hipLaunchKernelGGL(mega, dim3(grid), dim3(512), LDS_BYTES, stream, a);
    (void)hipMemsetAsync(p.bar, 0, XCD_BAR_WORDS * 4, stream);
    a.flags = 0;
#endif
    a.ph_lo = 0; a.ph_hi = NPHASE;
    hipLaunchKernelGGL(mega, dim3(grid), dim3(512), LDS_BYTES, stream, a);
#endif
    const hipError_t le = hipPeekAtLastError();
    if (le != hipSuccess) fprintf(stderr, "kernel_launch: launch failed: %s\n", hipGetErrorName(le));
}
```

```cpp
#include <hip/hip_runtime.h>

#ifndef CFG_D_MODEL
#define CFG_D_MODEL 2048
#define CFG_SEQ 4096
#define CFG_GRID_W 64
#define CFG_CTX 256
#define CFG_RW_HEAD 64
#define CFG_RW_DR 64
#define CFG_RW_IR 64
#define CFG_RW_GR 128
#define CFG_ML_HEAD 128
#define CFG_CHUNK 64
#define CFG_GD_HEAD 128
#define CFG_AT_HEAD 128
#define CFG_AT_KVH 2
#define CFG_NE 16
#endif

constexpr int D_MODEL = CFG_D_MODEL, BATCH = 2, SEQ = CFG_SEQ, DEPTH = 2, GRID_W = CFG_GRID_W, CTX = CFG_CTX;
constexpr int TOK = CTX + SEQ, MROWS = BATCH * TOK, GROUP_W = D_MODEL / 4;
constexpr int RW_HEAD = CFG_RW_HEAD, RW_HEADS = GROUP_W / RW_HEAD, RW_DR = CFG_RW_DR, RW_IR = CFG_RW_IR, RW_GR = CFG_RW_GR;
constexpr int RW_COLS = 3 * GROUP_W + RW_DR + RW_IR + RW_GR, RW_LR = RW_DR + RW_IR + RW_GR;
constexpr int ML_HEAD = CFG_ML_HEAD, ML_HEADS = GROUP_W / ML_HEAD, CHUNK = CFG_CHUNK, ML_COLS = 4 * GROUP_W + 4 * ML_HEADS;
constexpr int GD_HEAD = CFG_GD_HEAD, GD_HEADS = GROUP_W / GD_HEAD, GD_COLS = 4 * GROUP_W + 4 * GD_HEADS;
constexpr int AT_HEAD = CFG_AT_HEAD, AT_QH = GROUP_W / AT_HEAD, AT_KVH = CFG_AT_KVH, AT_COLS = (AT_QH + 2 * AT_KVH) * AT_HEAD;
constexpr int N_IN = RW_COLS + ML_COLS + GD_COLS + AT_COLS;
constexpr int RW_OFF = 0, ML_OFF = RW_COLS, GD_OFF = ML_OFF + ML_COLS, AT_OFF = GD_OFF + GD_COLS;
constexpr int LDP = (N_IN + 255) / 256 * 256;
constexpr int NE = CFG_NE, CAPL = 2 * SEQ / NE, CAPC = 2 * CTX / NE;
constexpr int NSLOT_L = BATCH * CAPL, NSLOT_C = BATCH * CAPC;
constexpr int NSLOT = (NSLOT_L + NSLOT_C + 255) / 256 * 256;
constexpr int NCHUNK = TOK / CHUNK, ML_CH = BATCH * ML_HEADS * 2, GD_CH = BATCH * GD_HEADS * 2, RW_CH = BATCH * RW_HEADS * 2;
constexpr float NORM_EPS = 1e-6f, RW_GN_EPS = 64e-5f, RW_DECAY_SCALE = 0.6065306597126334f;
static_assert(ML_HEADS == GD_HEADS, "heads");

typedef unsigned short u16;

#ifdef CPU_TEST
#include <cmath>
#include <cstdint>
#include <cstring>
#define HD inline
#else
#define HD __device__ __forceinline__
#endif

struct Params {
    const float *x, *c, *ctx, *c_ctx, *ada_w, *ada_b, *norm1_g, *norm2_g, *w_in, *w_out;
    const float *rw_mu, *rw_w0, *rw_w_up, *rw_a0, *rw_a_up, *rw_g_up, *rw_k_k, *rw_k_a, *rw_r_k, *rw_ln_w, *rw_ln_b;
    const float *ml_ib, *ml_fb, *ml_norm_g, *gd_conv, *gd_a_log, *gd_dt_bias, *gd_norm_g, *at_q_norm, *at_k_norm;
    const float *w_router, *w_exp1, *w_exp3, *w_exp2, *final_g;
    float* out;
    unsigned* bar;
    float *modp, *mod;
    u16 *wt_in, *wt_out, *w13t, *w2t;
    float* xres;
    u16* h;
    float* P;
    float *rw_r, *rw_k, *rw_v, *rw_lr, *rw_kk, *rw_g, *rw_ew, *rw_kka, *rw_kt, *rw_y;
    float *rw_Ma, *rw_T, *rw_Psi, *rw_Y0; u16 *rw_PhiT, *rw_Rh, *rw_W;
    float *ml_bcum, *ml_g, *ml_gmax, *ml_bl, *ml_gm, *ml_min, *ml_dcv, *ml_dC, *ml_dn, *ml_S, *ml_hh;
    float *gd_q, *gd_k, *gd_v, *gd_gc, *gd_beta, *gd_A, *gd_T, *gd_Psi, *gd_O0, *gd_o; u16 *gd_Phi, *gd_Qh;
    u16 *at_q, *at_k, *at_v;
    u16* mix;
    float* aff; int* inv;
    int* sel_row; float* sel_gate;
    u16 *xs, *hid; float* yexp;
};

struct Exec { int gid, ngroups, gl; };

template <int G> HD float group_sum(float v) {
#ifndef CPU_TEST
#pragma unroll
    for (int o = G / 2; o > 0; o >>= 1) v += __shfl_xor(v, o, 64);
#endif
    return v;
}
template <int G> HD float group_max(float v) {
#ifndef CPU_TEST
#pragma unroll
    for (int o = G / 2; o > 0; o >>= 1) v = fmaxf(v, __shfl_xor(v, o, 64));
#endif
    return v;
}

template <int G> HD float group_scan_sum(float v, int gl) {
#ifndef CPU_TEST
#pragma unroll
    for (int o = 1; o < G; o <<= 1) { const float t = __shfl_up(v, o, G); if (gl >= o) v += t; }
#endif
    (void)gl; return v;
}
template <int G> HD float group_scan_max(float v, int gl) {
#ifndef CPU_TEST
#pragma unroll
    for (int o = 1; o < G; o <<= 1) { const float t = __shfl_up(v, o, G); if (gl >= o) v = fmaxf(v, t); }
#endif
    (void)gl; return v;
}
template <int G> HD float group_last(float v) {
#ifndef CPU_TEST
    v = __shfl(v, G - 1, G);
#endif
    return v;
}

HD u16 f2bf(float f) { unsigned u; memcpy(&u, &f, 4); u += 0x7FFFu + ((u >> 16) & 1u); return (u16)(u >> 16); }
HD float bf2f(u16 b) { unsigned u = ((unsigned)b) << 16; float f; memcpy(&f, &u, 4); return f; }
HD float sigmoidf_(float x) { return 1.f / (1.f + expf(-x)); }
HD float siluf_(float x) { return x / (1.f + expf(-x)); }
HD float softplusf_(float x) { return x > 20.f ? x : log1pf(expf(x)); }
HD float logsigmoidf_(float x) { return x < 0.f ? x - log1pf(expf(x)) : -log1pf(expf(-x)); }

HD float bf_round(float f) { return bf2f(f2bf(f)); }
#ifndef CPU_TEST
typedef short mma_bf16x8 __attribute__((ext_vector_type(8)));
typedef float mma_f32x16 __attribute__((ext_vector_type(16)));
__device__ __forceinline__ unsigned mma_cvt_pk(float lo, float hi) { unsigned r; asm volatile("v_cvt_pk_bf16_f32 %0, %1, %2" : "=v"(r) : "v"(lo), "v"(hi)); return r; }
#endif
struct Frag {
#ifdef CPU_TEST
    float v[8];
    HD void ld_bf(const u16* p) { for (int j = 0; j < 8; ++j) v[j] = bf2f(p[j]); }
    HD void ld_f(const float* p) { for (int j = 0; j < 8; ++j) v[j] = bf_round(p[j]); }
    HD void ld_f_scaled(const float* p, float w) { for (int j = 0; j < 8; ++j) v[j] = bf_round(p[j] * w); }
    HD void set1(float x) { for (int j = 0; j < 8; ++j) v[j] = bf_round(x); }
    HD void neg() { for (int j = 0; j < 8; ++j) v[j] = -v[j]; }
#else
    typedef unsigned u4 __attribute__((ext_vector_type(4)));
    typedef float f4 __attribute__((ext_vector_type(4)));
    u4 raw;
    HD void ld_bf(const u16* p) { raw = *(const u4*)p; }
    HD void ld_f(const float* p) { const f4 a = *(const f4*)p, b = *(const f4*)(p + 4);
        raw.x = mma_cvt_pk(a.x, a.y); raw.y = mma_cvt_pk(a.z, a.w); raw.z = mma_cvt_pk(b.x, b.y); raw.w = mma_cvt_pk(b.z, b.w); }
    HD void ld_f_scaled(const float* p, float w) { const f4 a = *(const f4*)p * w, b = *(const f4*)(p + 4) * w;
        raw.x = mma_cvt_pk(a.x, a.y); raw.y = mma_cvt_pk(a.z, a.w); raw.z = mma_cvt_pk(b.x, b.y); raw.w = mma_cvt_pk(b.z, b.w); }
    HD void set1(float x) { const unsigned q = mma_cvt_pk(x, x); raw.x = q; raw.y = q; raw.z = q; raw.w = q; }
    HD void neg() { raw.x ^= 0x80008000u; raw.y ^= 0x80008000u; raw.z ^= 0x80008000u; raw.w ^= 0x80008000u; }
#endif
};
#ifdef CPU_TEST
constexpr int MMA_SLOTS = 1024;
#else
constexpr int MMA_SLOTS = 16;
#endif
template <int K, class FA, class FB, class FE> HD void wave_mma32(int lane, FA fa, FB fb, FE fe) {
    static_assert(K % 16 == 0, "K");
#ifdef CPU_TEST
    (void)lane;
    for (int m = 0; m < 32; ++m) for (int n = 0; n < 32; ++n) { float acc = 0.f;
        for (int k0 = 0; k0 < K; k0 += 8) { Frag a8, b8; fa(m, k0, a8); fb(n, k0, b8);
            for (int j = 0; j < 8; ++j) acc += a8.v[j] * b8.v[j]; }
        fe(m, n, acc, m * 32 + n); }
#else
    const int r = lane & 31, h = lane >> 5;
    mma_f32x16 acc;
#pragma unroll
    for (int q = 0; q < 16; ++q) acc[q] = 0.f;
#pragma unroll
    for (int k0 = 0; k0 < K; k0 += 16) { Frag a8, b8; fa(r, k0 + 8 * h, a8); fb(r, k0 + 8 * h, b8);
        acc = __builtin_amdgcn_mfma_f32_32x32x16_bf16(__builtin_bit_cast(mma_bf16x8, a8.raw), __builtin_bit_cast(mma_bf16x8, b8.raw), acc, 0, 0, 0); }
#pragma unroll
    for (int q = 0; q < 16; ++q) fe((q & 3) + 8 * (q >> 2) + 4 * h, r, acc[q], q);
#endif
}

#ifndef CPU_TEST
typedef unsigned pfv4 __attribute__((ext_vector_type(4)));
template <int NQ> HD void pf_ld_lin(pfv4 (&r)[NQ], const void* src, int tid) {
#pragma unroll
    for (int q = 0; q < NQ; ++q) r[q] = ((const pfv4*)src)[tid + q * 512]; }
template <int NQ> HD void pf_ld_rows(pfv4 (&r)[NQ], const float* src, int per_row, int row_stride, int tid) {
#pragma unroll
    for (int q = 0; q < NQ; ++q) { const int i = tid + q * 512; r[q] = *(const pfv4*)(src + (size_t)(i / per_row) * row_stride + (i % per_row) * 4); } }
template <int NQ> HD void pf_st_lin(const pfv4 (&r)[NQ], void* dst, int tid) {
#pragma unroll
    for (int q = 0; q < NQ; ++q) ((pfv4*)dst)[tid + q * 512] = r[q]; }
template <int NQ> HD void pf_st_pad(const pfv4 (&r)[NQ], u16* dst, int per_row, int ld, int tid) {
#pragma unroll
    for (int q = 0; q < NQ; ++q) { const int i = tid + q * 512; *(pfv4*)(dst + (i / per_row) * ld + (i % per_row) * 8) = r[q]; } }
#endif
#ifdef CPU_TEST
#define BLOCK_SYNC()
#define BLOCK_FOR(i, n) for (int i = 0; i < (n); ++i)
#define WAVE_FOR(w, n) for (int w = 0; w < (n); ++w)
#define LANE 0
#define OPAQUE_TID()
#else
#define BLOCK_SYNC() __syncthreads()
#define BLOCK_FOR(i, n) for (int i = tid; i < (n); i += nthr)
#define WAVE_FOR(w, n) _Pragma("unroll 1") for (int w = tid >> 6; w < (n); w += (nthr >> 6))
#define LANE (tid & 63)
#define OPAQUE_TID() asm volatile("" : "+v"(tid))
#endif

HD int row_b(int R) { return R / TOK; }
HD int row_s(int R) { return R % TOK; }
HD bool row_ctx(int R) { return row_s(R) < CTX; }
HD int mod_sel(int R) { return row_ctx(R) ? 2 : row_b(R); }
HD int seq_s(int d, int p) { return d == 0 ? p : (p < CTX ? CTX - 1 - p : TOK - 1 - (p - CTX)); }
HD const float* modv(const Params& p, int layer, int sel, int k) { return p.mod + ((size_t)(layer * 3 + sel) * 6 + k) * D_MODEL; }

constexpr int MOD_KS = 16;
HD void ph_mod_partial(const Params& p, Exec e) {
    const int n = DEPTH * MOD_KS * 6 * D_MODEL;
    for (int it = e.gid; it < n; it += e.ngroups) {
        const int col = it % (6 * D_MODEL), ks = (it / (6 * D_MODEL)) % MOD_KS, l = it / (6 * D_MODEL * MOD_KS);
        const float* w = p.ada_w + (size_t)l * D_MODEL * 6 * D_MODEL + col;
        float a0 = 0.f, a1 = 0.f, a2 = 0.f;
        const int k0 = ks * (D_MODEL / MOD_KS);
        for (int k = k0; k < k0 + D_MODEL / MOD_KS; ++k) {
            const float wv = w[(size_t)k * 6 * D_MODEL];
            a0 += siluf_(p.c[k]) * wv; a1 += siluf_(p.c[D_MODEL + k]) * wv; a2 += siluf_(p.c_ctx[k]) * wv;
        }
        float* o = p.modp + ((size_t)(l * MOD_KS + ks) * 3) * 6 * D_MODEL + col;
        o[0] = a0; o[6 * D_MODEL] = a1; o[2 * 6 * D_MODEL] = a2;
    }
}
HD void ph_mod_final(const Params& p, Exec e) {
    const int n = DEPTH * 3 * 6 * D_MODEL;
    for (int it = e.gid; it < n; it += e.ngroups) {
        const int col = it % (6 * D_MODEL), sel = (it / (6 * D_MODEL)) % 3, l = it / (6 * D_MODEL * 3);
        float a = p.ada_b[l * 6 * D_MODEL + col];
        for (int ks = 0; ks < MOD_KS; ++ks) a += p.modp[((size_t)(l * MOD_KS + ks) * 3 + sel) * 6 * D_MODEL + col];
        p.mod[(size_t)(l * 3 + sel) * 6 * D_MODEL + col] = a;
    }
}

HD float resid_in(const Params& p, int layer, int R, int c) {
    if (layer == 0) { const int b = row_b(R), s = row_s(R);
        return s < CTX ? p.ctx[((size_t)b * CTX + s) * D_MODEL + c] : p.x[((size_t)b * SEQ + (s - CTX)) * D_MODEL + c]; }
    float v = p.xres[(size_t)R * D_MODEL + c];
    const float m5 = modv(p, layer - 1, mod_sel(R), 5)[c];
    float acc = 0.f;
    for (int ex = 0; ex < NE; ++ex) { const int j = p.inv[(size_t)R * NE + ex]; if (j >= 0) acc += p.yexp[((size_t)ex * NSLOT + j) * D_MODEL + c]; }
    return v + m5 * acc;
}
template <int G> HD void ph_norm1(const Params& p, int layer, Exec e) {
    for (int R = e.gid; R < MROWS; R += e.ngroups) {
        float ss = 0.f;
        for (int c = e.gl; c < D_MODEL; c += G) { const float v = resid_in(p, layer, R, c); p.xres[(size_t)R * D_MODEL + c] = v; ss += v * v; }
        ss = group_sum<G>(ss);
        const float rstd = 1.f / sqrtf(ss / D_MODEL + NORM_EPS);
        const int sel = mod_sel(R); const float *m0 = modv(p, layer, sel, 0), *m1 = modv(p, layer, sel, 1), *g = p.norm1_g + layer * D_MODEL;
        for (int c = e.gl; c < D_MODEL; c += G) { const float v = p.xres[(size_t)R * D_MODEL + c];
            p.h[(size_t)R * D_MODEL + c] = f2bf(v * rstd * g[c] * (1.f + m1[c]) + m0[c]); }
    }
}
template <int G> HD void ph_final(const Params& p, Exec e) {
    for (int i = e.gid; i < BATCH * SEQ; i += e.ngroups) {
        const int b = i / SEQ, t = i % SEQ, R = b * TOK + CTX + t;
        float ss = 0.f;
        for (int c = e.gl; c < D_MODEL; c += G) { const float v = resid_in(p, DEPTH, R, c); ss += v * v; }
        ss = group_sum<G>(ss);
        const float rstd = 1.f / sqrtf(ss / D_MODEL + NORM_EPS);
        for (int c = e.gl; c < D_MODEL; c += G) p.out[(size_t)i * D_MODEL + c] = resid_in(p, DEPTH, R, c) * rstd * p.final_g[c];
    }
}
template <int G> HD void ph_norm2(const Params& p, int layer, Exec e) {
    const bool last = layer == DEPTH - 1;
    for (int R = e.gid; R < MROWS; R += e.ngroups) {
        if (last && row_ctx(R)) continue;
        float ss = 0.f;
        for (int c = e.gl; c < D_MODEL; c += G) { const float v = p.xres[(size_t)R * D_MODEL + c]; ss += v * v; }
        ss = group_sum<G>(ss);
        const float rstd = 1.f / sqrtf(ss / D_MODEL + NORM_EPS);
        const int sel = mod_sel(R); const float *m3 = modv(p, layer, sel, 3), *m4 = modv(p, layer, sel, 4), *g = p.norm2_g + layer * D_MODEL;
        const float* wr = p.w_router + (size_t)layer * D_MODEL * NE;
        float lg[NE];
#pragma unroll
        for (int ex = 0; ex < NE; ++ex) lg[ex] = 0.f;
        for (int c = e.gl; c < D_MODEL; c += G) { const float v = p.xres[(size_t)R * D_MODEL + c];
            const float hv = v * rstd * g[c] * (1.f + m4[c]) + m3[c];
            p.h[(size_t)R * D_MODEL + c] = f2bf(hv);
#pragma unroll
            for (int ex = 0; ex < NE; ++ex) lg[ex] += hv * wr[c * NE + ex]; }
        float mx = -1e30f;
#pragma unroll
        for (int ex = 0; ex < NE; ++ex) { lg[ex] = group_sum<G>(lg[ex]); mx = fmaxf(mx, lg[ex]); }
        float sum = 0.f;
#pragma unroll
        for (int ex = 0; ex < NE; ++ex) { lg[ex] = expf(lg[ex] - mx); sum += lg[ex]; }
        if (e.gl == 0) {
#pragma unroll
            for (int ex = 0; ex < NE; ++ex) p.aff[(size_t)R * NE + ex] = lg[ex] / sum; }
    }
}
constexpr int TK_PART = 512, TK_PARTS = (SEQ + TK_PART - 1) / TK_PART, TK_SMEM = (SEQ > CTX ? SEQ : CTX) * 4;
HD int topk_units(int layer) { return BATCH * NE * TK_PARTS + (layer == DEPTH - 1 ? 0 : BATCH * NE) + 1; }
HD void ph_topk_unit(const Params& p, int layer, int unit, int tid, int nthr, unsigned char* smem) {
    (void)tid; (void)nthr; OPAQUE_TID();
    const bool last = layer == DEPTH - 1;
    const int nl = BATCH * NE * TK_PARTS, nc = last ? 0 : BATCH * NE;
    float* col = (float*)smem;
    if (unit >= nl + nc) {
        const int per = NSLOT - NSLOT_L - (last ? 0 : NSLOT_C);
        BLOCK_FOR(q, NE * per) { const int ex = q / per, j = NSLOT - per + q % per; p.sel_row[ex * NSLOT + j] = 0; p.sel_gate[ex * NSLOT + j] = 0.f; }
        return; }
    int b, ex, L, base, cap, jbase, t0, t1;
    if (unit < nl) { const int part = unit % TK_PARTS; ex = (unit / TK_PARTS) % NE; b = unit / (TK_PARTS * NE); L = SEQ; base = b * TOK + CTX; cap = CAPL; jbase = b * CAPL;
        t0 = part * TK_PART; t1 = t0 + TK_PART < SEQ ? t0 + TK_PART : SEQ; }
    else { const int q = unit - nl; ex = q % NE; b = q / NE; L = CTX; base = b * TOK; cap = CAPC; jbase = NSLOT_L + b * CAPC; t0 = 0; t1 = CTX; }
    BLOCK_FOR(u, L) col[u] = p.aff[(size_t)(base + u) * NE + ex];
    BLOCK_SYNC();
    BLOCK_FOR(q, t1 - t0) { const int t = t0 + q; const float a = col[t]; int rank = 0;
        for (int u = 0; u < L; ++u) { const float au = col[u]; rank += (au > a || (au == a && u < t)) ? 1 : 0; }
        if (rank < cap) { const int j = jbase + rank; p.sel_row[ex * NSLOT + j] = base + t; p.sel_gate[ex * NSLOT + j] = a; p.inv[(size_t)(base + t) * NE + ex] = j; }
        else p.inv[(size_t)(base + t) * NE + ex] = -1; }
    BLOCK_SYNC();
}
template <int G> HD void ph_gather(const Params& p, int layer, Exec e) {
    const bool last = layer == DEPTH - 1;
    const int nj = last ? NSLOT_L : NSLOT;
    for (int it = e.gid; it < NE * nj; it += e.ngroups) {
        const int ex = it / nj, j = it % nj, R = p.sel_row[ex * NSLOT + j];
        const uint4* s = (const uint4*)(p.h + (size_t)R * D_MODEL); uint4* d = (uint4*)(p.xs + ((size_t)ex * NSLOT + j) * D_MODEL);
        for (int c = e.gl; c < D_MODEL / 8; c += G) d[c] = s[c];
    }
}

template <int G> HD void ph_rw_prep1(const Params& p, int layer, Exec e) {
    const float* mu = p.rw_mu + (size_t)layer * 2 * RW_COLS;
    for (int R = e.gid; R < MROWS; R += e.ngroups) {
        const int s = row_s(R); const bool hp = (s != 0 && s != CTX), hn = (s != CTX - 1 && s != TOK - 1);
        const float* pr = p.P + (size_t)R * LDP + RW_OFF;
        for (int c = e.gl; c < RW_COLS; c += G) {
            const float v = pr[c], pv = hp ? pr[c - LDP] : 0.f, nv = hn ? pr[c + LDP] : 0.f;
            const float pp = v + mu[c] * (pv - v) + mu[RW_COLS + c] * (nv - v);
            if (c < GROUP_W) p.rw_r[(size_t)R * GROUP_W + c] = pp;
            else if (c < 2 * GROUP_W) p.rw_k[(size_t)R * GROUP_W + c - GROUP_W] = pp;
            else if (c < 3 * GROUP_W) p.rw_v[(size_t)R * GROUP_W + c - 2 * GROUP_W] = pp;
            else { const int q = c - 3 * GROUP_W; float o;
                if (q < RW_DR) o = tanhf(pp); else if (q < RW_DR + RW_IR) o = pp; else o = sigmoidf_(pp);
                p.rw_lr[(size_t)R * RW_LR + q] = o; }
        }
        const float* kk_w = p.rw_k_k + layer * GROUP_W;
        for (int hh = 0; hh < RW_HEADS; ++hh) { float ss = 0.f;
            for (int j = hh * RW_HEAD + e.gl; j < (hh + 1) * RW_HEAD; j += G) { const float xk = p.rw_k[(size_t)R * GROUP_W + j] * kk_w[j]; ss += xk * xk; }
            ss = group_sum<G>(ss); const float rn = 1.f / sqrtf(ss + 1e-6f);
            for (int j = hh * RW_HEAD + e.gl; j < (hh + 1) * RW_HEAD; j += G) p.rw_kk[(size_t)R * GROUP_W + j] = p.rw_k[(size_t)R * GROUP_W + j] * kk_w[j] * rn; }
    }
}
constexpr int RW_WK = 2 * RW_DR + 2 * RW_IR + RW_GR;
static_assert(RW_DR % 16 == 0 && RW_IR % 16 == 0 && RW_GR % 16 == 0, "low-rank K");
HD void ph_rw_wpack(const Params& p, Exec e) {
    for (int it = e.gid; it < DEPTH * GROUP_W * RW_WK; it += e.ngroups) {
        const int kk = it % RW_WK, j = (it / RW_WK) % GROUP_W, l = it / (RW_WK * GROUP_W); float v;
        if (kk < 2 * RW_DR) { const int d = kk / RW_DR, i = kk % RW_DR; v = p.rw_w_up[((size_t)(l * 2 + d) * RW_DR + i) * GROUP_W + j]; }
        else if (kk < 2 * RW_DR + 2 * RW_IR) { const int q = kk - 2 * RW_DR, d = q / RW_IR, i = q % RW_IR; v = p.rw_a_up[((size_t)(l * 2 + d) * RW_IR + i) * GROUP_W + j]; }
        else { const int i = kk - 2 * RW_DR - 2 * RW_IR; v = p.rw_g_up[((size_t)l * RW_GR + i) * GROUP_W + j]; }
        p.rw_W[it] = f2bf(v);
    }
}
HD void ph_rw_prep2(const Params& p, int layer, Exec e) {
    static_assert(MROWS % 32 == 0 && GROUP_W % 32 == 0, "tiles");
    const float* ka_w = p.rw_k_a + layer * GROUP_W;
    for (int it = e.gid; it < (MROWS / 32) * (GROUP_W / 32); it += e.ngroups) {
        const int tm = it / (GROUP_W / 32), tn = it % (GROUP_W / 32);
        const u16* W = p.rw_W + ((size_t)layer * GROUP_W + tn * 32) * RW_WK; const float* A = p.rw_lr + (size_t)tm * 32 * RW_LR;
        float st[4][MMA_SLOTS];
#define RWP2_PROD(K_, AOFF, WOFF, ...) wave_mma32<K_>(e.gl, [&](int m, int k0, Frag& o) { o.ld_f(A + (size_t)m * RW_LR + (AOFF) + k0); }, \
                                                       [&](int nn, int k0, Frag& o) { o.ld_bf(W + (size_t)nn * RW_WK + (WOFF) + k0); }, __VA_ARGS__)
        RWP2_PROD(RW_DR, 0, 0, [&](int, int, float acc, int sl) { st[0][sl] = acc; });
        RWP2_PROD(RW_DR, 0, RW_DR, [&](int, int, float acc, int sl) { st[1][sl] = acc; });
        RWP2_PROD(RW_IR, RW_DR, 2 * RW_DR, [&](int, int, float acc, int sl) { st[2][sl] = acc; });
        RWP2_PROD(RW_IR, RW_DR, 2 * RW_DR + RW_IR, [&](int, int, float acc, int sl) { st[3][sl] = acc; });
        RWP2_PROD(RW_GR, RW_DR + RW_IR, 2 * RW_DR + 2 * RW_IR, [&](int m, int nn, float acc, int sl) {
            const int R = tm * 32 + m, j = tn * 32 + nn; const size_t o = (size_t)R * GROUP_W + j;
            p.rw_g[o] = acc;
            const float kv = p.rw_k[o], kkv = p.rw_kk[o];
            _Pragma("unroll") for (int d = 0; d < 2; ++d) { const float wl = p.rw_w0[(layer * 2 + d) * GROUP_W + j] + st[d][sl], al = p.rw_a0[(layer * 2 + d) * GROUP_W + j] + st[2 + d][sl];
                const float logw = -RW_DECAY_SCALE * sigmoidf_(wl), a = sigmoidf_(al); const size_t o2 = (size_t)d * MROWS * GROUP_W + o;
                p.rw_ew[o2] = logw; p.rw_kka[o2] = kkv * a; p.rw_kt[o2] = kv * (1.f + (a - 1.f) * ka_w[j]); } });
#undef RWP2_PROD
    }
}
template <int G> HD void ph_rw_scan(const Params& p, Exec e) {
    constexpr int KPL = RW_HEAD / G;
    for (int it = e.gid; it < RW_CH * RW_HEAD; it += e.ngroups) {
        const int i = it % RW_HEAD, ch = it / RW_HEAD, d = ch % 2, hh = (ch / 2) % RW_HEADS, b = ch / (2 * RW_HEADS);
        float S[KPL];
#pragma unroll
        for (int q = 0; q < KPL; ++q) S[q] = 0.f;
        const int k0 = hh * RW_HEAD + e.gl * KPL;
        for (int pos = 0; pos < TOK; ++pos) {
            const int R = b * TOK + seq_s(d, pos);
            const size_t o1 = (size_t)R * GROUP_W + k0, o2 = ((size_t)d * MROWS + R) * GROUP_W + k0;
            const float vv = p.rw_v[(size_t)R * GROUP_W + hh * RW_HEAD + i];
            float sk = 0.f;
#pragma unroll
            for (int q = 0; q < KPL; ++q) sk += S[q] * p.rw_kk[o1 + q];
            sk = group_sum<G>(sk);
            float y = 0.f;
#pragma unroll
            for (int q = 0; q < KPL; ++q) { S[q] = S[q] * p.rw_ew[o2 + q] - sk * p.rw_kka[o2 + q] + vv * p.rw_kt[o2 + q]; y += S[q] * p.rw_r[o1 + q]; }
            y = group_sum<G>(y);
            if (e.gl == 0) p.rw_y[((size_t)d * MROWS + R) * GROUP_W + hh * RW_HEAD + i] = y;
        }
    }
}

constexpr int RW_N = RW_HEAD, RW_CN = RW_CH * NCHUNK;
constexpr int LDPAD = 8;
static_assert(CHUNK % 32 == 0 && RW_HEAD % 32 == 0, "tile sizes");
HD void rw_chain(int ch, int& b, int& hh, int& d) { d = ch % 2; hh = (ch / 2) % RW_HEADS; b = ch / (2 * RW_HEADS); }
constexpr int RW_C1_SMEM = CHUNK * RW_N * 4 + 2 * CHUNK * (RW_N + LDPAD) * 2;
HD void ph_rw_c1_unit(const Params& p, int cn, int tid, int nthr, unsigned char* smem) {
    (void)tid; (void)nthr; OPAQUE_TID();
    constexpr int C = CHUNK, N = RW_N, LD = N + LDPAD;
    const int ch = cn / NCHUNK, n = cn % NCHUNK; int b, hh, d; rw_chain(ch, b, hh, d);
    float* cum = (float*)smem; u16* KKt = (u16*)(cum + C * N); u16* At = KKt + C * LD;
    const size_t dofs = (size_t)d * MROWS * GROUP_W;
    BLOCK_FOR(idx, C * N) { const int t = idx / N, k = idx % N, R = b * TOK + seq_s(d, n * C + t); cum[idx] = p.rw_ew[dofs + (size_t)R * GROUP_W + hh * N + k]; }
    BLOCK_SYNC();
    BLOCK_FOR(k, N) { float acc = 0.f; for (int t = 0; t < C; ++t) { acc += cum[t * N + k]; cum[t * N + k] = acc; } }
    BLOCK_SYNC();
    BLOCK_FOR(idx, C * N) { const int t = idx / N, k = idx % N, R = b * TOK + seq_s(d, n * C + t); const size_t o = (size_t)R * GROUP_W + hh * N + k;
        const float cu = cum[idx], cp = cu - p.rw_ew[dofs + o];
        KKt[t * LD + k] = f2bf(p.rw_kk[o] * expf(cp)); At[t * LD + k] = f2bf(p.rw_kka[dofs + o] * expf(-cu)); }
    BLOCK_SYNC();
    float* Ma = p.rw_Ma + (size_t)cn * C * C;
    WAVE_FOR(w, (C / 32) * (C / 32)) { const int tm = w / (C / 32), tn = w % (C / 32);
        wave_mma32<N>(LANE, [&](int m, int k0, Frag& o) { o.ld_bf(KKt + (tm * 32 + m) * LD + k0); },
                            [&](int nn, int k0, Frag& o) { o.ld_bf(At + (tn * 32 + nn) * LD + k0); },
                            [&](int m, int nn, float acc, int) { const int t = tm * 32 + m, sx = tn * 32 + nn; Ma[t * C + sx] = sx < t ? acc : 0.f; }); }
    BLOCK_SYNC();
}
constexpr int TS_G = 8, TS_SMEM = TS_G * CHUNK * CHUNK * 4;
HD void ph_tsolve_unit(const float* Mall, float* Tall, int nprob, int unit, int tid, int nthr, unsigned char* smem) {
    (void)tid; (void)nthr; OPAQUE_TID();
    constexpr int C = CHUNK;
    float* Tl = (float*)smem;
    const int p0 = unit * TS_G, np = (nprob - p0) < TS_G ? (nprob - p0) : TS_G;
    BLOCK_FOR(i, np * C * C / 4) ((uint4*)Tl)[i] = ((const uint4*)(Mall + (size_t)p0 * C * C))[i];
    BLOCK_SYNC();
    BLOCK_FOR(idx, TS_G * C) { const int w = idx / C, j = idx % C;
        if (w < np) { float* Tc = Tl + w * C * C;
            for (int t = 0; t < C; ++t) { float acc = 0.f;
                if (t == j) acc = 1.f;
                else if (t > j) { for (int sx = j; sx < t; ++sx) acc -= Tc[t * C + sx] * Tc[sx * C + j]; }
                Tc[t * C + j] = acc; } } }
    BLOCK_SYNC();
    BLOCK_FOR(i, np * C * C / 4) ((uint4*)(Tall + (size_t)p0 * C * C))[i] = ((const uint4*)Tl)[i];
    BLOCK_SYNC();
}
constexpr int RW_C3_SMEM = 2 * CHUNK * (RW_N + LDPAD) * 2 + 13 * CHUNK * (RW_N + LDPAD) * 2 + RW_N * 4;
HD void ph_rw_c3_unit(const Params& p, int cn, int tid, int nthr, unsigned char* smem) {
    (void)tid; (void)nthr; OPAQUE_TID();
    constexpr int C = CHUNK, N = RW_N, CN = C * N, LD = N + LDPAD, CL = C * LD;
    static_assert(2 * CL * 2 >= CN * 4, "cum region");
    static_assert(C == N, "c3 buffer aliasing assumes C == N");
    const int ch = cn / NCHUNK, n = cn % NCHUNK; int b, hh, d; rw_chain(ch, b, hh, d);
    float* cum = (float*)smem; u16* mb = (u16*)smem + 2 * CL;
    u16 *KKt = mb, *KKtT = mb + CL, *At = mb + 2 * CL, *KTt = mb + 3 * CL, *Rt = mb + 4 * CL, *ApT = mb + 5 * CL, *KTpT = mb + 6 * CL, *VT = mb + 7 * CL,
        *Tb = mb + 8 * CL, *MkT = mb + 9 * CL, *ZT = mb + 10 * CL, *Na = mb + 11 * CL, *Nk = mb + 12 * CL;
    float* PC = (float*)(mb + 13 * CL);
    u16 *Gm = (u16*)cum, *KKhT = (u16*)cum + CL;
    const size_t dofs = (size_t)d * MROWS * GROUP_W;
    BLOCK_FOR(idx, C * N) { const int t = idx / N, k = idx % N, R = b * TOK + seq_s(d, n * C + t); cum[idx] = p.rw_ew[dofs + (size_t)R * GROUP_W + hh * N + k]; }
    BLOCK_SYNC();
    BLOCK_FOR(k, N) { float acc = 0.f; for (int t = 0; t < C; ++t) { acc += cum[t * N + k]; cum[t * N + k] = acc; } PC[k] = expf(acc); }
    BLOCK_SYNC();
    BLOCK_FOR(idx, CN) { const int t = idx / N, k = idx % N, R = b * TOK + seq_s(d, n * C + t); const size_t o = (size_t)R * GROUP_W + hh * N + k;
        const float cu = cum[idx], cp = cu - p.rw_ew[dofs + o], cC = cum[(C - 1) * N + k];
        const float kkv = p.rw_kk[o], kav = p.rw_kka[dofs + o], ktv = p.rw_kt[dofs + o];
        const float e_m = expf(-cu), e_c = expf(cC - cu);
        const u16 kkt = f2bf(kkv * expf(cp));
        KKt[t * LD + k] = kkt; KKtT[k * LD + t] = kkt; At[t * LD + k] = f2bf(kav * e_m); KTt[t * LD + k] = f2bf(ktv * e_m); Rt[t * LD + k] = f2bf(p.rw_r[o] * expf(cu));
        ApT[k * LD + t] = f2bf(kav * e_c); KTpT[k * LD + t] = f2bf(ktv * e_c); VT[k * LD + t] = f2bf(p.rw_v[o]); }
    BLOCK_FOR(idx, C * C) Tb[(idx / C) * LD + idx % C] = f2bf(p.rw_T[(size_t)cn * C * C + idx]);
    BLOCK_SYNC();
    constexpr int TC = C / 32, TN = N / 32;
    WAVE_FOR(w, 3 * TC * TC) { const int which = w / (TC * TC), tm = (w / TC) % TC, tn = w % TC;
        const u16* Am = which == 0 ? KTt : Rt; const u16* Bm = which == 0 ? KKt : (which == 1 ? At : KTt); u16* Om = which == 0 ? MkT : (which == 1 ? Na : Nk);
        wave_mma32<N>(LANE, [&](int m, int k0, Frag& o) { o.ld_bf(Am + (tm * 32 + m) * LD + k0); },
                            [&](int nn, int k0, Frag& o) { o.ld_bf(Bm + (tn * 32 + nn) * LD + k0); },
                            [&](int m, int nn, float acc, int) { const int r = tm * 32 + m, cc = tn * 32 + nn; const bool keep = which == 0 ? (cc > r) : (cc <= r);
                                Om[r * LD + cc] = f2bf(keep ? acc : 0.f); }); }
    BLOCK_SYNC();
    WAVE_FOR(w, TC * TC + TN * TC) {
        if (w < TC * TC) { const int tm = w / TC, tn = w % TC;
            wave_mma32<C>(LANE, [&](int m, int k0, Frag& o) { o.ld_bf(Tb + (tm * 32 + m) * LD + k0); },
                                [&](int nn, int k0, Frag& o) { o.ld_bf(MkT + (tn * 32 + nn) * LD + k0); },
                                [&](int m, int nn, float acc, int) { Gm[(tm * 32 + m) * LD + tn * 32 + nn] = f2bf(acc); }); }
        else { const int q = w - TC * TC, tm = q / TC, tn = q % TC;
            wave_mma32<C>(LANE, [&](int m, int k0, Frag& o) { o.ld_bf(KKtT + (tm * 32 + m) * LD + k0); },
                                [&](int nn, int k0, Frag& o) { o.ld_bf(Tb + (tn * 32 + nn) * LD + k0); },
                                [&](int m, int nn, float acc, int) { KKhT[(tm * 32 + m) * LD + tn * 32 + nn] = f2bf(acc); }); } }
    BLOCK_SYNC();
    u16* RhG = p.rw_Rh + (size_t)cn * CN; u16* PhiTG = p.rw_PhiT + (size_t)cn * N * N;
    WAVE_FOR(w, TN * TC + TC * TN + TN * TN) {
        if (w < TN * TC) { const int tm = w / TC, tn = w % TC;
            wave_mma32<C>(LANE, [&](int m, int k0, Frag& o) { o.ld_bf(VT + (tm * 32 + m) * LD + k0); },
                                [&](int nn, int k0, Frag& o) { o.ld_bf(Gm + (tn * 32 + nn) * LD + k0); },
                                [&](int m, int nn, float acc, int) { ZT[(tm * 32 + m) * LD + tn * 32 + nn] = f2bf(acc); }); }
        else if (w < TN * TC + TC * TN) { const int q = w - TN * TC, tm = q / TN, tn = q % TN;
            wave_mma32<C>(LANE, [&](int m, int k0, Frag& o) { o.ld_bf(Na + (tm * 32 + m) * LD + k0); },
                                [&](int nn, int k0, Frag& o) { o.ld_bf(KKhT + (tn * 32 + nn) * LD + k0); },
                                [&](int m, int nn, float acc, int) { const int t = tm * 32 + m, k = tn * 32 + nn; RhG[t * N + k] = f2bf(bf2f(Rt[t * LD + k]) - acc); }); }
        else { const int q = w - TN * TC - TC * TN, tm = q / TN, tn = q % TN;
            wave_mma32<C>(LANE, [&](int m, int k0, Frag& o) { o.ld_bf(ApT + (tm * 32 + m) * LD + k0); },
                                [&](int nn, int k0, Frag& o) { o.ld_bf(KKhT + (tn * 32 + nn) * LD + k0); },
                                [&](int m, int nn, float acc, int) { const int k = tm * 32 + m, k2 = tn * 32 + nn; PhiTG[k * N + k2] = f2bf((k == k2 ? PC[k] : 0.f) - acc); }); } }
    BLOCK_SYNC();
    float* Y0G = p.rw_Y0 + (size_t)cn * CN; float* PsiG = p.rw_Psi + (size_t)cn * N * N;
    WAVE_FOR(w, TC * TN + TN * TN) {
        if (w < TC * TN) { const int tm = w / TN, tn = w % TN;
            wave_mma32<2 * C>(LANE, [&](int m, int k0, Frag& o) { if (k0 < C) o.ld_bf(Nk + (tm * 32 + m) * LD + k0); else { o.ld_bf(Na + (tm * 32 + m) * LD + k0 - C); o.neg(); } },
                                    [&](int nn, int k0, Frag& o) { if (k0 < C) o.ld_bf(VT + (tn * 32 + nn) * LD + k0); else o.ld_bf(ZT + (tn * 32 + nn) * LD + k0 - C); },
                                    [&](int m, int nn, float acc, int) { Y0G[(tm * 32 + m) * N + tn * 32 + nn] = acc; }); }
        else { const int q = w - TC * TN, tm = q / TN, tn = q % TN;
            wave_mma32<2 * C>(LANE, [&](int m, int k0, Frag& o) { if (k0 < C) o.ld_bf(VT + (tm * 32 + m) * LD + k0); else { o.ld_bf(ZT + (tm * 32 + m) * LD + k0 - C); o.neg(); } },
                                    [&](int nn, int k0, Frag& o) { if (k0 < C) o.ld_bf(KTpT + (tn * 32 + nn) * LD + k0); else o.ld_bf(ApT + (tn * 32 + nn) * LD + k0 - C); },
                                    [&](int m, int nn, float acc, int) { PsiG[(tm * 32 + m) * N + tn * 32 + nn] = acc; }); } }
    BLOCK_SYNC();
}
constexpr int RW_S2_SMEM = (3 * RW_N + CHUNK) * (RW_N + LDPAD) * 2 + RW_N * RW_N * 4 + CHUNK * RW_N * 4;
HD void ph_rw_scan2_unit(const Params& p, int ch, int tid, int nthr, unsigned char* smem) {
    (void)tid; (void)nthr; OPAQUE_TID();
    constexpr int C = CHUNK, N = RW_N, TC = C / 32, TN = N / 32, LD = N + LDPAD;
    int b, hh, d; rw_chain(ch, b, hh, d);
    u16* Sb = (u16*)smem; u16* PhiT = Sb + 2 * N * LD; u16* Rh = PhiT + N * LD; float* Psi = (float*)(Rh + C * LD); float* Y0 = Psi + N * N;
    BLOCK_FOR(i, N * LD) Sb[i] = 0;
    auto tiles = [&](int n) {
        const u16* Sc = Sb + (n & 1) * N * LD; u16* Sn = Sb + ((n + 1) & 1) * N * LD;
        WAVE_FOR(w, TN * TN + TC * TN) {
            if (w < TN * TN) { const int tm = w / TN, tn = w % TN;
                wave_mma32<N>(LANE, [&](int m, int k0, Frag& o) { o.ld_bf(Sc + (tm * 32 + m) * LD + k0); },
                                    [&](int nn, int k0, Frag& o) { o.ld_bf(PhiT + (tn * 32 + nn) * LD + k0); },
                                    [&](int m, int nn, float acc, int) { const int i = tm * 32 + m, k = tn * 32 + nn; Sn[i * LD + k] = f2bf(acc + Psi[i * N + k]); }); }
            else { const int q = w - TN * TN, tm = q / TN, tn = q % TN;
                wave_mma32<N>(LANE, [&](int m, int k0, Frag& o) { o.ld_bf(Rh + (tm * 32 + m) * LD + k0); },
                                    [&](int nn, int k0, Frag& o) { o.ld_bf(Sc + (tn * 32 + nn) * LD + k0); },
                                    [&](int m, int nn, float acc, int) { const int t = tm * 32 + m, i = tn * 32 + nn, R = b * TOK + seq_s(d, n * C + t);
                                        p.rw_y[((size_t)d * MROWS + R) * GROUP_W + hh * N + i] = acc + Y0[t * N + i]; }); } } };
#ifdef CPU_TEST
    for (int n = 0; n < NCHUNK; ++n) { const int cn = ch * NCHUNK + n;
        BLOCK_FOR(i, N * N / 8) *(uint4*)(PhiT + (i / (N / 8)) * LD + (i % (N / 8)) * 8) = ((const uint4*)(p.rw_PhiT + (size_t)cn * N * N))[i];
        BLOCK_FOR(i, C * N / 8) *(uint4*)(Rh + (i / (N / 8)) * LD + (i % (N / 8)) * 8) = ((const uint4*)(p.rw_Rh + (size_t)cn * C * N))[i];
        BLOCK_FOR(i, N * N / 4) ((uint4*)Psi)[i] = ((const uint4*)(p.rw_Psi + (size_t)cn * N * N))[i];
        BLOCK_FOR(i, C * N / 4) ((uint4*)Y0)[i] = ((const uint4*)(p.rw_Y0 + (size_t)cn * C * N))[i];
        BLOCK_SYNC(); tiles(n); BLOCK_SYNC(); }
#else
    constexpr int NT = 512, Q_A = N * N / 8 / NT, Q_B = C * N / 8 / NT, Q_C = N * N / 4 / NT, Q_D = C * N / 4 / NT;
    static_assert(Q_A * NT * 8 == N * N && Q_B * NT * 8 == C * N && Q_C * NT * 4 == N * N && Q_D * NT * 4 == C * N && NCHUNK % 4 == 0, "prefetch split");
    pfv4 rA[4][Q_A], rB[4][Q_B], rC[4][Q_C], rD[4][Q_D];
#define RW_PF_LOAD(st, cn_) do { pf_ld_lin(rA[st], p.rw_PhiT + (size_t)(cn_) * N * N, tid); pf_ld_lin(rB[st], p.rw_Rh + (size_t)(cn_) * C * N, tid); \
    pf_ld_lin(rC[st], p.rw_Psi + (size_t)(cn_) * N * N, tid); pf_ld_lin(rD[st], p.rw_Y0 + (size_t)(cn_) * C * N, tid); } while (0)
#define RW_PF_STORE(st) do { pf_st_pad(rA[st], PhiT, N / 8, LD, tid); pf_st_pad(rB[st], Rh, N / 8, LD, tid); pf_st_lin(rC[st], Psi, tid); pf_st_lin(rD[st], Y0, tid); } while (0)
    const int cn0 = ch * NCHUNK;
    RW_PF_LOAD(0, cn0); RW_PF_LOAD(1, cn0 + 1); RW_PF_LOAD(2, cn0 + 2); RW_PF_LOAD(3, cn0 + 3); RW_PF_STORE(0);
    for (int n0 = 0; n0 < NCHUNK; n0 += 4) {
#pragma unroll
        for (int j = 0; j < 4; ++j) { const int n = n0 + j;
            BLOCK_SYNC();
            if (n + 4 < NCHUNK) RW_PF_LOAD(j, cn0 + n + 4);
            tiles(n);
            BLOCK_SYNC();
            if (n + 1 < NCHUNK) RW_PF_STORE((j + 1) & 3); } }
#undef RW_PF_LOAD
#undef RW_PF_STORE
#endif
}
template <int G> HD void ph_rw_post(const Params& p, int layer, Exec e) {
    static_assert(G <= RW_HEAD, "G");
    const float *lw = p.rw_ln_w + layer * GROUP_W, *lb = p.rw_ln_b + layer * GROUP_W, *rk = p.rw_r_k + layer * GROUP_W;
    for (int it = e.gid; it < MROWS * RW_HEADS; it += e.ngroups) {
        const int R = it / RW_HEADS, hh = it % RW_HEADS; const size_t o = (size_t)R * GROUP_W + hh * RW_HEAD, o2 = (size_t)MROWS * GROUP_W;
        float s1 = 0.f, bon = 0.f;
        for (int j = e.gl; j < RW_HEAD; j += G) { s1 += p.rw_y[o + j] + p.rw_y[o2 + o + j];
            bon += p.rw_r[o + j] * (p.rw_kt[o + j] + p.rw_kt[o2 + o + j]) * rk[hh * RW_HEAD + j]; }
        s1 = group_sum<G>(s1); bon = group_sum<G>(bon);
        const float mean = s1 / RW_HEAD;
        float s2 = 0.f;
        for (int j = e.gl; j < RW_HEAD; j += G) { const float dlt = p.rw_y[o + j] + p.rw_y[o2 + o + j] - mean; s2 += dlt * dlt; }
        s2 = group_sum<G>(s2);
        const float rstd = 1.f / sqrtf(s2 / RW_HEAD + RW_GN_EPS);
        for (int j = e.gl; j < RW_HEAD; j += G) { const float y = (p.rw_y[o + j] + p.rw_y[o2 + o + j] - mean) * rstd * lw[hh * RW_HEAD + j] + lb[hh * RW_HEAD + j];
            p.mix[(size_t)R * D_MODEL + hh * RW_HEAD + j] = f2bf((y + bon * p.rw_v[o + j]) * p.rw_g[o + j]); }
    }
}

HD void ml_chain(int ch, int& b, int& hh, int& d) { d = ch % 2; hh = (ch / 2) % ML_HEADS; b = ch / (2 * ML_HEADS); }
template <int G> HD void ph_ml_g1(const Params& p, int layer, Exec e) {
    for (int it = e.gid; it < ML_CH * NCHUNK; it += e.ngroups) {
        const int ch = it / NCHUNK, n = it % NCHUNK; int b, hh, d; ml_chain(ch, b, hh, d);
        const float ib = p.ml_ib[(layer * 2 + d) * ML_HEADS + hh], fb = p.ml_fb[(layer * 2 + d) * ML_HEADS + hh];
        float cb = 0.f, cm = -1e30f;
        for (int t0 = 0; t0 < CHUNK; t0 += G) { const int t = t0 + e.gl, pos = n * CHUNK + t, R = b * TOK + seq_s(d, pos);
            const float* g = p.P + (size_t)R * LDP + ML_OFF + 4 * GROUP_W;
            const float li = g[d * ML_HEADS + hh] + ib, lf = logsigmoidf_(g[(2 + d) * ML_HEADS + hh] + fb);
            const float bc = cb + group_scan_sum<G>(lf, e.gl), gv = li - bc, gm = fmaxf(cm, group_scan_max<G>(gv, e.gl));
            p.ml_bcum[(size_t)ch * TOK + pos] = bc; p.ml_g[(size_t)ch * TOK + pos] = gv; p.ml_gmax[(size_t)ch * TOK + pos] = gm;
            cb = group_last<G>(bc); cm = group_last<G>(gm); }
        if (e.gl == 0) { p.ml_bl[ch * NCHUNK + n] = cb; p.ml_gm[ch * NCHUNK + n] = cm; }
    }
}
HD void ph_ml_g2(const Params& p, Exec e) {
    for (int ch = e.gid; ch < ML_CH; ch += e.ngroups) { float m = 0.f;
        for (int n = 0; n < NCHUNK; ++n) { const float bl = p.ml_bl[ch * NCHUNK + n], mnew = bl + fmaxf(m, p.ml_gm[ch * NCHUNK + n]);
            p.ml_min[ch * NCHUNK + n] = m; p.ml_dcv[ch * NCHUNK + n] = expf(bl + m - mnew); m = mnew; } }
}
HD void ph_ml_prefix(const Params& p, Exec e) {
    const int n1 = ML_CH * ML_HEAD * ML_HEAD, n2 = ML_CH * ML_HEAD;
    for (int it = e.gid; it < n1 + n2; it += e.ngroups) {
        const bool isn = it >= n1; const int q = isn ? it - n1 : it, per = isn ? ML_HEAD : ML_HEAD * ML_HEAD, ch = q / per, el = q % per;
        float* arr = (isn ? p.ml_dn : p.ml_dC) + (size_t)ch * NCHUNK * per + el; const float* dcv = p.ml_dcv + ch * NCHUNK; float st = 0.f;
        for (int n = 0; n < NCHUNK; n += 4) { float inc[4], dc[4];
#pragma unroll
            for (int j = 0; j < 4; ++j) if (n + j < NCHUNK) { inc[j] = arr[(size_t)(n + j) * per]; dc[j] = dcv[n + j]; }
#pragma unroll
            for (int j = 0; j < 4; ++j) if (n + j < NCHUNK) { arr[(size_t)(n + j) * per] = st; st = dc[j] * st + inc[j]; } }
    }
}

constexpr int ML_N = ML_HEAD, ML_CN = ML_CH * NCHUNK;
static_assert(ML_HEAD % 32 == 0, "tile");
constexpr int ML_C1_SMEM = 2 * ML_N * (CHUNK + LDPAD) * 2 + 4 * CHUNK * 4;
HD void ph_ml_c1_unit(const Params& p, int cn, int tid, int nthr, unsigned char* smem) {
    (void)tid; (void)nthr; OPAQUE_TID();
    constexpr int C = CHUNK, N = ML_N, TC = C / 32, TN = N / 32, LD = C + LDPAD;
    const float ksc = 1.f / sqrtf((float)ML_HEAD);
    const int ch = cn / NCHUNK, n = cn % NCHUNK; int b, hh, d; ml_chain(ch, b, hh, d);
    u16* VwT = (u16*)smem; u16* KT = VwT + N * LD; float* wk = (float*)(KT + N * LD); float* btv = wk + C; float* gv = btv + C; float* mtv = gv + C;
    const float min_ = p.ml_min[cn], bl = p.ml_bl[cn], mnew = bl + fmaxf(min_, p.ml_gm[cn]);
    BLOCK_FOR(sx, C) { const size_t o = (size_t)ch * TOK + n * C + sx; const float g = p.ml_g[o], bt = p.ml_bcum[o];
        wk[sx] = expf(bl + g - mnew); btv[sx] = bt; gv[sx] = g; mtv[sx] = bt + fmaxf(min_, p.ml_gmax[o]); }
    BLOCK_SYNC();
    BLOCK_FOR(idx, C * N) { const int sx = idx / N, dd = idx % N, R = b * TOK + seq_s(d, n * C + sx); const float* pr = p.P + (size_t)R * LDP + ML_OFF + hh * N;
        VwT[dd * LD + sx] = f2bf(wk[sx] * pr[2 * GROUP_W + dd]); KT[dd * LD + sx] = f2bf(pr[GROUP_W + dd] * ksc); }
    BLOCK_SYNC();
    WAVE_FOR(w, TN * TN + TN + TC * TC) {
        if (w < TN * TN) { const int tm = w / TN, tn = w % TN;
            wave_mma32<C>(LANE, [&](int m, int k0, Frag& o) { o.ld_bf(VwT + (tm * 32 + m) * LD + k0); },
                                [&](int nn, int k0, Frag& o) { o.ld_bf(KT + (tn * 32 + nn) * LD + k0); },
                                [&](int m, int nn, float acc, int) { p.ml_dC[((size_t)cn * N + tm * 32 + m) * N + tn * 32 + nn] = acc; }); }
        else if (w < TN * TN + TN) { const int tn = w - TN * TN;
            wave_mma32<C>(LANE, [&](int m, int k0, Frag& o) { if (m == 0) o.ld_f(wk + k0); else o.set1(0.f); },
                                [&](int nn, int k0, Frag& o) { o.ld_bf(KT + (tn * 32 + nn) * LD + k0); },
                                [&](int m, int nn, float acc, int) { if (m == 0) p.ml_dn[(size_t)cn * N + tn * 32 + nn] = acc; }); }
        else { const int q = w - TN * TN - TN, tm = q / TC, tn = q % TC;
            wave_mma32<N>(LANE, [&](int m, int k0, Frag& o) { const int R = b * TOK + seq_s(d, n * C + tm * 32 + m); o.ld_f(p.P + (size_t)R * LDP + ML_OFF + hh * N + k0); },
                                [&](int nn, int k0, Frag& o) { const int R = b * TOK + seq_s(d, n * C + tn * 32 + nn); o.ld_f(p.P + (size_t)R * LDP + ML_OFF + GROUP_W + hh * N + k0); },
                                [&](int m, int nn, float acc, int) { const int t = tm * 32 + m, sx = tn * 32 + nn;
                                    p.ml_S[((size_t)cn * C + t) * C + sx] = sx <= t ? acc * ksc * expf(btv[t] + gv[sx] - mtv[t]) : 0.f; }); } }
    BLOCK_SYNC();
}
constexpr int ML_C2_SMEM = ML_N * (CHUNK + LDPAD) * 2 + 3 * CHUNK * 4;
HD void ph_ml_c2_unit(const Params& p, int cn, int tid, int nthr, unsigned char* smem) {
    (void)tid; (void)nthr; OPAQUE_TID();
    constexpr int C = CHUNK, N = ML_N, TC = C / 32, TN = N / 32, LD = C + LDPAD;
    const int ch = cn / NCHUNK, n = cn % NCHUNK; int b, hh, d; ml_chain(ch, b, hh, d);
    u16* VT = (u16*)smem; float* wi = (float*)(VT + N * LD); float* den = wi + C; float* emt = den + C;
    const float min_ = p.ml_min[cn];
    BLOCK_FOR(t, C) { const size_t o = (size_t)ch * TOK + n * C + t; const float bt = p.ml_bcum[o], mt = bt + fmaxf(min_, p.ml_gmax[o]);
        wi[t] = expf(bt + min_ - mt); emt[t] = expf(-mt); }
    BLOCK_FOR(idx, C * N) { const int sx = idx / N, dd = idx % N, R = b * TOK + seq_s(d, n * C + sx);
        VT[dd * LD + sx] = f2bf(p.P[(size_t)R * LDP + ML_OFF + 2 * GROUP_W + hh * N + dd]); }
    BLOCK_SYNC();
    WAVE_FOR(w, TC) { const int tm = w;
        wave_mma32<C + N>(LANE, [&](int m, int k0, Frag& o) { const int t = tm * 32 + m;
                                    if (k0 < C) o.ld_f(p.ml_S + ((size_t)cn * C + t) * C + k0);
                                    else { const int R = b * TOK + seq_s(d, n * C + t); o.ld_f_scaled(p.P + (size_t)R * LDP + ML_OFF + hh * N + k0 - C, wi[t]); } },
                                [&](int nn, int k0, Frag& o) { if (nn != 0) o.set1(0.f); else if (k0 < C) o.set1(1.f); else o.ld_f(p.ml_dn + (size_t)cn * N + k0 - C); },
                                [&](int m, int nn, float acc, int) { if (nn == 0) den[tm * 32 + m] = acc; }); }
    BLOCK_SYNC();
    WAVE_FOR(w, TC * TN) { const int tm = w / TN, tn = w % TN;
        wave_mma32<C + N>(LANE, [&](int m, int k0, Frag& o) { const int t = tm * 32 + m;
                                    if (k0 < C) o.ld_f(p.ml_S + ((size_t)cn * C + t) * C + k0);
                                    else { const int R = b * TOK + seq_s(d, n * C + t); o.ld_f_scaled(p.P + (size_t)R * LDP + ML_OFF + hh * N + k0 - C, wi[t]); } },
                                [&](int nn, int k0, Frag& o) { const int ee = tn * 32 + nn;
                                    if (k0 < C) o.ld_bf(VT + ee * LD + k0); else o.ld_f(p.ml_dC + ((size_t)cn * N + ee) * N + k0 - C); },
                                [&](int m, int nn, float acc, int) { const int t = tm * 32 + m, ee = tn * 32 + nn, R = b * TOK + seq_s(d, n * C + t);
                                    p.ml_hh[((size_t)d * MROWS + R) * GROUP_W + hh * N + ee] = acc / fmaxf(fabsf(den[t]), emt[t]); }); }
    BLOCK_SYNC();
}
template <int G> HD void ph_ml_post(const Params& p, int layer, Exec e) {
    const float* ng = p.ml_norm_g + layer * GROUP_W;
    for (int it = e.gid; it < MROWS * ML_HEADS; it += e.ngroups) {
        const int R = it / ML_HEADS, hh = it % ML_HEADS; const size_t o = (size_t)R * GROUP_W + hh * ML_HEAD, o2 = (size_t)MROWS * GROUP_W;
        float s1 = 0.f;
        for (int j = e.gl; j < ML_HEAD; j += G) s1 += p.ml_hh[o + j] + p.ml_hh[o2 + o + j];
        s1 = group_sum<G>(s1); const float mean = s1 / ML_HEAD;
        float s2 = 0.f;
        for (int j = e.gl; j < ML_HEAD; j += G) { const float dlt = p.ml_hh[o + j] + p.ml_hh[o2 + o + j] - mean; s2 += dlt * dlt; }
        s2 = group_sum<G>(s2); const float rstd = 1.f / sqrtf(s2 / ML_HEAD + NORM_EPS);
        for (int j = e.gl; j < ML_HEAD; j += G) { const float y = (p.ml_hh[o + j] + p.ml_hh[o2 + o + j] - mean) * rstd * ng[hh * ML_HEAD + j];
            const float og = p.P[(size_t)R * LDP + ML_OFF + 3 * GROUP_W + hh * ML_HEAD + j];
            p.mix[(size_t)R * D_MODEL + GROUP_W + hh * ML_HEAD + j] = f2bf(y * sigmoidf_(og)); }
    }
}

HD float gd_conv_silu(const Params& p, int layer, int R, int c) {
    const int s = row_s(R); const float* pr = p.P + (size_t)R * LDP + GD_OFF + c; const float* cw = p.gd_conv + (size_t)layer * 3 * 3 * GROUP_W + c;
    float v = pr[0] * cw[3 * GROUP_W];
    if (s != 0 && s != CTX) v += pr[-LDP] * cw[0];
    if (s != CTX - 1 && s != TOK - 1) v += pr[LDP] * cw[2 * 3 * GROUP_W];
    return siluf_(v);
}
template <int G> HD void ph_gd_prep(const Params& p, int layer, Exec e) {
    const float qsc = 1.f / sqrtf((float)GD_HEAD);
    constexpr int NI = GD_HEAD / G;
    for (int it = e.gid; it < MROWS * GD_HEADS; it += e.ngroups) {
        const int R = it / GD_HEADS, hh = it % GD_HEADS;
        float xq[NI], xk[NI], xv[NI]; float sq = 0.f, sk = 0.f;
#pragma unroll
        for (int i = 0; i < NI; ++i) { const int j = hh * GD_HEAD + e.gl + G * i;
            xq[i] = gd_conv_silu(p, layer, R, j); xk[i] = gd_conv_silu(p, layer, R, GROUP_W + j); xv[i] = gd_conv_silu(p, layer, R, 2 * GROUP_W + j);
            sq += xq[i] * xq[i]; sk += xk[i] * xk[i]; }
        sq = group_sum<G>(sq); sk = group_sum<G>(sk);
        const float rq = qsc / sqrtf(sq + 1e-6f), rk = 1.f / sqrtf(sk + 1e-6f);
#pragma unroll
        for (int i = 0; i < NI; ++i) { const size_t o = (size_t)R * GROUP_W + hh * GD_HEAD + e.gl + G * i;
            p.gd_q[o] = xq[i] * rq; p.gd_k[o] = xk[i] * rk; p.gd_v[o] = xv[i]; }
    }
}
template <int G> HD void ph_gd_gates(const Params& p, int layer, Exec e) {
    for (int it = e.gid; it < GD_CH * NCHUNK; it += e.ngroups) {
        const int ch = it / NCHUNK, n = it % NCHUNK; int b, hh, d; ml_chain(ch, b, hh, d);
        const float al = expf(p.gd_a_log[(layer * 2 + d) * GD_HEADS + hh]), dtb = p.gd_dt_bias[(layer * 2 + d) * GD_HEADS + hh];
        float cg = 0.f;
        for (int t0 = 0; t0 < CHUNK; t0 += G) { const int t = t0 + e.gl, pos = n * CHUNK + t, R = b * TOK + seq_s(d, pos);
            const float* g = p.P + (size_t)R * LDP + GD_OFF + 4 * GROUP_W;
            const float gc = cg + group_scan_sum<G>(-al * softplusf_(g[d * GD_HEADS + hh] + dtb), e.gl);
            p.gd_gc[(size_t)ch * TOK + pos] = gc; p.gd_beta[(size_t)ch * TOK + pos] = sigmoidf_(g[(2 + d) * GD_HEADS + hh]);
            cg = group_last<G>(gc); }
    }
}

constexpr int GD_N = GD_HEAD, GD_CN = GD_CH * NCHUNK;
static_assert(GD_HEAD % 32 == 0, "tile");
HD void ph_gd_c1(const Params& p, Exec e) {
    constexpr int C = CHUNK, N = GD_N, TC = C / 32;
    for (int it = e.gid; it < GD_CN * TC * TC; it += e.ngroups) {
        const int cn = it / (TC * TC), tm = (it / TC) % TC, tn = it % TC, ch = cn / NCHUNK, n = cn % NCHUNK; int b, hh, d; ml_chain(ch, b, hh, d);
        wave_mma32<N>(e.gl, [&](int m, int k0, Frag& o) { const int R = b * TOK + seq_s(d, n * C + tm * 32 + m); o.ld_f(p.gd_k + (size_t)R * GROUP_W + hh * N + k0); },
                            [&](int nn, int k0, Frag& o) { const int R = b * TOK + seq_s(d, n * C + tn * 32 + nn); o.ld_f(p.gd_k + (size_t)R * GROUP_W + hh * N + k0); },
                            [&](int m, int nn, float acc, int) { const int i = tm * 32 + m, j = tn * 32 + nn; const size_t o = (size_t)ch * TOK + n * C;
                                p.gd_A[((size_t)cn * C + i) * C + j] = j < i ? p.gd_beta[o + i] * acc * expf(p.gd_gc[o + i] - p.gd_gc[o + j]) : 0.f; });
    }
}
constexpr int GD_C3_SMEM = (5 * GD_N + 2 * CHUNK) * (CHUNK + LDPAD) * 2 + 2 * CHUNK * 4;
HD void ph_gd_c3_unit(const Params& p, int cn, int tid, int nthr, unsigned char* smem) {
    (void)tid; (void)nthr; OPAQUE_TID();
    constexpr int C = CHUNK, N = GD_N, TC = C / 32, TN = N / 32, LD = C + LDPAD;
    const int ch = cn / NCHUNK, n = cn % NCHUNK; int b, hh, d; ml_chain(ch, b, hh, d);
    u16 *KbT = (u16*)smem, *VbT = KbT + N * LD, *KdT = VbT + N * LD, *uT = KdT + N * LD, *wT = uT + N * LD, *Tb = wT + N * LD, *attn = Tb + C * LD;
    float* gcs = (float*)(attn + C * LD); float* bet = gcs + C;
    BLOCK_FOR(t, C) { const size_t o = (size_t)ch * TOK + n * C + t; gcs[t] = p.gd_gc[o]; bet[t] = p.gd_beta[o]; }
    BLOCK_SYNC();
    BLOCK_FOR(idx, C * N) { const int t = idx / N, dd = idx % N, R = b * TOK + seq_s(d, n * C + t); const size_t o = (size_t)R * GROUP_W + hh * N + dd;
        const float kv = p.gd_k[o], vv = p.gd_v[o];
        KbT[dd * LD + t] = f2bf(kv * bet[t] * expf(gcs[t])); VbT[dd * LD + t] = f2bf(vv * bet[t]); KdT[dd * LD + t] = f2bf(kv * expf(gcs[C - 1] - gcs[t])); }
    BLOCK_FOR(idx, C * C) Tb[(idx / C) * LD + idx % C] = f2bf(p.gd_T[(size_t)cn * C * C + idx]);
    BLOCK_SYNC();
    WAVE_FOR(w, TC * TC + 2 * TN * TC) {
        if (w < TC * TC) { const int tm = w / TC, tn = w % TC;
            wave_mma32<N>(LANE, [&](int m, int k0, Frag& o) { const int R = b * TOK + seq_s(d, n * C + tm * 32 + m); o.ld_f(p.gd_q + (size_t)R * GROUP_W + hh * N + k0); },
                                [&](int nn, int k0, Frag& o) { const int R = b * TOK + seq_s(d, n * C + tn * 32 + nn); o.ld_f(p.gd_k + (size_t)R * GROUP_W + hh * N + k0); },
                                [&](int m, int nn, float acc, int) { const int i = tm * 32 + m, j = tn * 32 + nn; attn[i * LD + j] = f2bf(j <= i ? acc * expf(gcs[i] - gcs[j]) : 0.f); }); }
        else { const int q = w - TC * TC, which = q / (TN * TC), tm = (q / TC) % TN, tn = q % TC;
            const u16* Am = which ? KbT : VbT; u16* Om = which ? wT : uT;
            wave_mma32<C>(LANE, [&](int m, int k0, Frag& o) { o.ld_bf(Am + (tm * 32 + m) * LD + k0); },
                                [&](int nn, int k0, Frag& o) { o.ld_bf(Tb + (tn * 32 + nn) * LD + k0); },
                                [&](int m, int nn, float acc, int) { Om[(tm * 32 + m) * LD + tn * 32 + nn] = f2bf(acc); }); } }
    BLOCK_SYNC();
    WAVE_FOR(w, 2 * TC * TN + 2 * TN * TN) {
        if (w < 2 * TC * TN) { const int which = w / (TC * TN), tm = (w / TN) % TC, tn = w % TN;
            const u16* Bm = which ? uT : wT;
            wave_mma32<C>(LANE, [&](int m, int k0, Frag& o) { o.ld_bf(attn + (tm * 32 + m) * LD + k0); },
                                [&](int nn, int k0, Frag& o) { o.ld_bf(Bm + (tn * 32 + nn) * LD + k0); },
                                [&](int m, int nn, float acc, int) { const int i = tm * 32 + m, dd = tn * 32 + nn;
                                    if (which) p.gd_O0[((size_t)cn * C + i) * N + dd] = acc;
                                    else { const int R = b * TOK + seq_s(d, n * C + i); p.gd_Qh[((size_t)cn * C + i) * N + dd] = f2bf(p.gd_q[(size_t)R * GROUP_W + hh * N + dd] * expf(gcs[i]) - acc); } }); }
        else { const int q = w - 2 * TC * TN, which = q / (TN * TN), tm = (q / TN) % TN, tn = q % TN;
            const u16* Bm = which ? uT : wT;
            wave_mma32<C>(LANE, [&](int m, int k0, Frag& o) { o.ld_bf(KdT + (tm * 32 + m) * LD + k0); },
                                [&](int nn, int k0, Frag& o) { o.ld_bf(Bm + (tn * 32 + nn) * LD + k0); },
                                [&](int m, int nn, float acc, int) { const int d1 = tm * 32 + m, d2 = tn * 32 + nn;
                                    if (which) p.gd_Psi[((size_t)cn * N + d1) * N + d2] = acc;
                                    else p.gd_Phi[((size_t)cn * N + d1) * N + d2] = f2bf((d1 == d2 ? expf(gcs[C - 1]) : 0.f) - acc); }); } }
    BLOCK_SYNC();
}
constexpr int GD_EB = 32, GD_S2_UNITS = GD_CH * (GD_N / GD_EB);
constexpr int GD_S2_SMEM = (2 * GD_EB + GD_N + CHUNK) * (GD_N + LDPAD) * 2 + (GD_N * GD_EB + CHUNK * GD_EB) * 4;
HD void ph_gd_scan2_unit(const Params& p, int unit, int tid, int nthr, unsigned char* smem) {
    (void)tid; (void)nthr; OPAQUE_TID();
    constexpr int C = CHUNK, N = GD_N, EB = GD_EB, LD = N + LDPAD;
    const int eb = unit % (N / EB), ch = unit / (N / EB), e0 = eb * EB; int b, hh, d; ml_chain(ch, b, hh, d);
    u16* ST = (u16*)smem; u16* Phi = ST + 2 * EB * LD; u16* Qh = Phi + N * LD; float* Psi = (float*)(Qh + C * LD); float* O0 = Psi + N * EB;
    BLOCK_FOR(i, EB * LD) ST[i] = 0;
    auto tiles = [&](int n) {
        const u16* Sc = ST + (n & 1) * EB * LD; u16* Sn = ST + ((n + 1) & 1) * EB * LD;
        WAVE_FOR(w, N / 32 + C / 32) {
            if (w < N / 32) { const int tm = w;
                wave_mma32<N>(LANE, [&](int m, int k0, Frag& o) { o.ld_bf(Phi + (tm * 32 + m) * LD + k0); },
                                    [&](int nn, int k0, Frag& o) { o.ld_bf(Sc + nn * LD + k0); },
                                    [&](int m, int nn, float acc, int) { const int d1 = tm * 32 + m; Sn[nn * LD + d1] = f2bf(acc + Psi[d1 * EB + nn]); }); }
            else { const int tm = w - N / 32;
                wave_mma32<N>(LANE, [&](int m, int k0, Frag& o) { o.ld_bf(Qh + (tm * 32 + m) * LD + k0); },
                                    [&](int nn, int k0, Frag& o) { o.ld_bf(Sc + nn * LD + k0); },
                                    [&](int m, int nn, float acc, int) { const int t = tm * 32 + m, R = b * TOK + seq_s(d, n * C + t);
                                        p.gd_o[((size_t)d * MROWS + R) * GROUP_W + hh * N + e0 + nn] = acc + O0[t * EB + nn]; }); } } };
#ifdef CPU_TEST
    for (int n = 0; n < NCHUNK; ++n) { const int cn = ch * NCHUNK + n;
        BLOCK_FOR(i, N * N / 8) *(uint4*)(Phi + (i / (N / 8)) * LD + (i % (N / 8)) * 8) = ((const uint4*)(p.gd_Phi + (size_t)cn * N * N))[i];
        BLOCK_FOR(i, C * N / 8) *(uint4*)(Qh + (i / (N / 8)) * LD + (i % (N / 8)) * 8) = ((const uint4*)(p.gd_Qh + (size_t)cn * C * N))[i];
        BLOCK_FOR(i, N * EB / 4) ((uint4*)Psi)[i] = *(const uint4*)(p.gd_Psi + ((size_t)cn * N + i / (EB / 4)) * N + e0 + (i % (EB / 4)) * 4);
        BLOCK_FOR(i, C * EB / 4) ((uint4*)O0)[i] = *(const uint4*)(p.gd_O0 + ((size_t)cn * C + i / (EB / 4)) * N + e0 + (i % (EB / 4)) * 4);
        BLOCK_SYNC(); tiles(n); BLOCK_SYNC(); }
#else
    constexpr int NT = 512, Q_PHI = N * N / 8 / NT, Q_QH = C * N / 8 / NT, Q_PSI = N * EB / 4 / NT, Q_O0 = C * EB / 4 / NT;
    static_assert(Q_PHI * NT * 8 == N * N && Q_QH * NT * 8 == C * N && Q_PSI * NT * 4 == N * EB && Q_O0 * NT * 4 == C * EB && NCHUNK % 4 == 0, "prefetch split");
    pfv4 rA[4][Q_PHI], rB[4][Q_QH], rC[4][Q_PSI], rD[4][Q_O0];
#define GD_PF_LOAD(st, cn_) do { pf_ld_lin(rA[st], p.gd_Phi + (size_t)(cn_) * N * N, tid); pf_ld_lin(rB[st], p.gd_Qh + (size_t)(cn_) * C * N, tid); \
    pf_ld_rows(rC[st], p.gd_Psi + (size_t)(cn_) * N * N + e0, EB / 4, N, tid); pf_ld_rows(rD[st], p.gd_O0 + (size_t)(cn_) * C * N + e0, EB / 4, N, tid); } while (0)
#define GD_PF_STORE(st) do { pf_st_pad(rA[st], Phi, N / 8, LD, tid); pf_st_pad(rB[st], Qh, N / 8, LD, tid); pf_st_lin(rC[st], Psi, tid); pf_st_lin(rD[st], O0, tid); } while (0)
    const int cn0 = ch * NCHUNK;
    GD_PF_LOAD(0, cn0); GD_PF_LOAD(1, cn0 + 1); GD_PF_LOAD(2, cn0 + 2); GD_PF_LOAD(3, cn0 + 3); GD_PF_STORE(0);
    for (int n0 = 0; n0 < NCHUNK; n0 += 4) {
#pragma unroll
        for (int j = 0; j < 4; ++j) { const int n = n0 + j;
            BLOCK_SYNC();
            if (n + 4 < NCHUNK) GD_PF_LOAD(j, cn0 + n + 4);
            tiles(n);
            BLOCK_SYNC();
            if (n + 1 < NCHUNK) GD_PF_STORE((j + 1) & 3); } }
#undef GD_PF_LOAD
#undef GD_PF_STORE
#endif
}
template <int G> HD void ph_gd_post(const Params& p, int layer, Exec e) {
    const float* ng = p.gd_norm_g + layer * GD_HEAD;
    for (int it = e.gid; it < MROWS * GD_HEADS; it += e.ngroups) {
        const int R = it / GD_HEADS, hh = it % GD_HEADS; const size_t o = (size_t)R * GROUP_W + hh * GD_HEAD, o2 = (size_t)MROWS * GROUP_W;
        float ss = 0.f;
        for (int j = e.gl; j < GD_HEAD; j += G) { const float v = p.gd_o[o + j] + p.gd_o[o2 + o + j]; ss += v * v; }
        ss = group_sum<G>(ss); const float rstd = 1.f / sqrtf(ss / GD_HEAD + NORM_EPS);
        for (int j = e.gl; j < GD_HEAD; j += G) { const float v = (p.gd_o[o + j] + p.gd_o[o2 + o + j]) * rstd * ng[j];
            const float g = p.P[(size_t)R * LDP + GD_OFF + 3 * GROUP_W + hh * GD_HEAD + j];
            p.mix[(size_t)R * D_MODEL + 2 * GROUP_W + hh * GD_HEAD + j] = f2bf(v * siluf_(g)); }
    }
}

template <int G> HD void ph_at_prep(const Params& p, int layer, Exec e) {
    constexpr int NHS = AT_QH + 2 * AT_KVH, HALF = AT_HEAD / 2, QTR = AT_HEAD / 4;
    for (int it = e.gid; it < MROWS * NHS; it += e.ngroups) {
        const int R = it / NHS, hs = it % NHS, b = row_b(R), s = row_s(R);
        const float* pr = p.P + (size_t)R * LDP + AT_OFF + hs * AT_HEAD;
        u16* dst; const float* g = nullptr;
        if (hs < AT_QH) { dst = p.at_q + (((size_t)b * AT_QH + hs) * TOK + s) * AT_HEAD; g = p.at_q_norm + layer * AT_HEAD; }
        else if (hs < AT_QH + AT_KVH) { dst = p.at_k + (((size_t)b * AT_KVH + hs - AT_QH) * TOK + s) * AT_HEAD; g = p.at_k_norm + layer * AT_HEAD; }
        else dst = p.at_v + (((size_t)b * AT_KVH + hs - AT_QH - AT_KVH) * TOK + s) * AT_HEAD;
        if (!g) { for (int j = e.gl; j < AT_HEAD; j += G) dst[j] = f2bf(pr[j]); continue; }
        float ss = 0.f;
        for (int j = e.gl; j < AT_HEAD; j += G) ss += pr[j] * pr[j];
        ss = group_sum<G>(ss); const float rstd = 1.f / sqrtf(ss / AT_HEAD + NORM_EPS);
        if (s < CTX) { for (int j = e.gl; j < AT_HEAD; j += G) dst[j] = f2bf(pr[j] * rstd * g[j]); continue; }
        const int t = s - CTX; const float posr = (float)(t / GRID_W), posc = (float)(t % GRID_W);
        for (int j = e.gl; j < AT_HEAD; j += G) {
            const int half = j / HALF, jj = j % HALF, fi = jj % QTR; const bool second = jj >= QTR;
            const float ang = (half ? posc : posr) * exp2f(-(float)(2 * fi) * (13.287712379549449f / (float)HALF));
            float cs, sn; sincosf(ang, &sn, &cs);
            const int jp = second ? j - QTR : j + QTR;
            const float own = pr[j] * rstd * g[j], oth = pr[jp] * rstd * g[jp];
            dst[j] = f2bf(second ? own * cs + oth * sn : own * cs - oth * sn);
        }
    }
}

#include <cstdio>
#include <cstddef>
static_assert(D_MODEL == 2048 && CTX == 256 && SEQ % 256 == 0 && AT_HEAD == 128, "GPU part is written for the full configuration");
static_assert(RW_C3_SMEM <= 147392 && TS_SMEM <= 147392 && RW_S2_SMEM <= 147392 && RW_C1_SMEM <= 147392 && GD_C3_SMEM <= 147392 && GD_S2_SMEM <= 147392 && ML_C1_SMEM <= 147392 && ML_C2_SMEM <= 147392, "LDS");
static_assert(CHUNK == RW_N && GD_N * CHUNK * 2 == CHUNK * CHUNK * 4, "buffer aliasing (Y0 on Ma, Qh on A)");

#define XB_TMO      128
#define XB_XCNT(j)  (256  + 64 * (j))
#define XB_XSUB(j)  (1280 + 64 * (j))
#define XB_XGEN(j)  (2304 + 64 * (j))
#define XB_TOP      3328
#define XB_TOPGEN   3392
#define XCD_BAR_WORDS 3456
#define XB_SPIN_CAP (1u << 24)
#define LAS __attribute__((address_space(3)))
__device__ __forceinline__ unsigned xb_ld(unsigned* p)              { return __hip_atomic_load(p, __ATOMIC_RELAXED, __HIP_MEMORY_SCOPE_AGENT); }
__device__ __forceinline__ unsigned xb_add(unsigned* p, unsigned v) { return __hip_atomic_fetch_add(p, v, __ATOMIC_RELAXED, __HIP_MEMORY_SCOPE_AGENT); }
__device__ __forceinline__ unsigned xb_xcc_id() { return (unsigned)__builtin_amdgcn_s_getreg((3 << 11) | 20) & 0xFu; }
#define XB_SPIN(cond, bar) do { unsigned _sp = 0; while (cond) { __builtin_amdgcn_s_sleep(1); \
    if ((++_sp & 255u) == 0u) { if (xb_ld(&(bar)[XB_TMO])) break; if (_sp > XB_SPIN_CAP) { atomicAdd(&(bar)[XB_TMO], 1u); break; } } } } while (0)
struct XcdBarrier { unsigned* bar; unsigned x; volatile LAS unsigned* st; };
__device__ __forceinline__ XcdBarrier xcd_barrier_post(unsigned* bar, volatile LAS unsigned* st) {
    XcdBarrier b; b.bar = bar; b.x = xb_xcc_id(); b.st = st;
    if (threadIdx.x == 0) (void)xb_add(&bar[XB_XCNT(b.x)], 1u);
    return b;
}
__device__ __forceinline__ void xcd_barrier_complete(unsigned* bar, unsigned x, unsigned& nloc, unsigned& nx) {
    const unsigned G = gridDim.x * gridDim.y * gridDim.z;
    unsigned sum, cnt, mine, sp = 0u;
    for (;;) {
        sum = 0u; cnt = 0u; mine = 0u;
#pragma unroll
        for (unsigned j = 0; j < 16; ++j) { const unsigned c = xb_ld(&bar[XB_XCNT(j)]); sum += c; cnt += (c > 0u) ? 1u : 0u; mine = (j == x) ? c : mine; }
        if (sum == G) break;
        __builtin_amdgcn_s_sleep(1);
        if ((++sp & 255u) == 0u) { if (xb_ld(&bar[XB_TMO])) break; if (sp > XB_SPIN_CAP) { atomicAdd(&bar[XB_TMO], 1u); break; } }
    }
    nloc = mine > 0u ? mine : 1u; nx = cnt > 0u ? cnt : 1u;
}
__device__ __forceinline__ void xcd_barrier(const XcdBarrier& b) {
    asm volatile("s_waitcnt vmcnt(0)" ::: "memory");
    __syncthreads();
    if (threadIdx.x == 0) {
        unsigned* bar = b.bar;
        __builtin_amdgcn_s_waitcnt(0);
        unsigned nloc = b.st[0], nx = b.st[1];
        if (nloc == 0u) { xcd_barrier_complete(bar, b.x, nloc, nx); b.st[0] = nloc; b.st[1] = nx; }
        const unsigned old = xb_add(&bar[XB_XSUB(b.x)], 1u);
        const unsigned gen = old / nloc;
        if (old + 1u == (gen + 1u) * nloc) {
            __builtin_amdgcn_fence(__ATOMIC_RELEASE, "agent");
            asm volatile("s_waitcnt vmcnt(0)" ::: "memory");
            const unsigned og = xb_add(&bar[XB_TOP], 1u);
            const unsigned tg = og / nx;
            if (og + 1u == (tg + 1u) * nx) xb_add(&bar[XB_TOPGEN], 1u);
            else XB_SPIN(xb_ld(&bar[XB_TOPGEN]) == tg, bar);
            __builtin_amdgcn_fence(__ATOMIC_ACQUIRE, "agent");
            xb_add(&bar[XB_XGEN(b.x)], 1u);
            asm volatile("s_waitcnt vmcnt(0)" ::: "memory");
        } else {
            XB_SPIN(xb_ld(&bar[XB_XGEN(b.x)]) == gen, bar);
            __builtin_amdgcn_fence(__ATOMIC_ACQUIRE, "agent");
            asm volatile("s_waitcnt vmcnt(0)" ::: "memory");
        }
    }
    __syncthreads();
}

namespace pg8 {
#define PG8_LAS __attribute__((address_space(3)))
typedef unsigned short bf16_t;
typedef short bf16x8 __attribute__((ext_vector_type(8)));
typedef float f32x4 __attribute__((ext_vector_type(4)));
typedef unsigned u32x4 __attribute__((ext_vector_type(4)));
constexpr int BM = 256, BK = 64, HALF = 128, HTB = HALF * BK * 2  , STAGE_BYTES = 8 * HTB, NXCD = 8, WGM = 8;

__host__ __device__ __forceinline__ int lds_byte(int r, int c) { const int st = (r >> 4) * 2 + (c >> 5), rr = r & 15, cc = c & 31, ob = rr * 64 + cc * 2; return st * 1024 + (ob ^ (((ob >> 9) & 1) << 5)); }
__host__ __device__ __forceinline__ void stage_rc(int b, int& R, int& C) { const int st = b / 1024, sb = b % 1024, swz = sb ^ (((sb >> 9) & 1) << 5); R = (st >> 1) * 16 + swz / 64; C = (st & 1) * 32 + (swz % 64) / 2; }
__host__ __device__ __forceinline__ int perm32(int rho) { const int n = rho >> 4, i = rho & 15; return 8 * (i >> 2) + 4 * n + (i & 3); }

struct Unit { int pm, pn; };
struct Gemm { const bf16_t* A; const bf16_t* Bt; int M, N, K; };

struct StaticOrder {
    int nM, nN, nwg, G, c;
    __host__ __device__ void init(int M, int N, int G_, int c_) { nM = M / BM; nN = N / BM; nwg = nM * nN; G = G_; c = c_; }
    __host__ __device__ bool next(int i, Unit& u) const {
        const long L = (long)i * G + c; if (L >= nwg) return false;
        int wgid = (int)L; { const int q = nwg / NXCD, r = nwg % NXCD, xcd = wgid % NXCD, off = wgid / NXCD; wgid = (xcd < r ? xcd * (q + 1) : r * (q + 1) + (xcd - r) * q) + off; }
        const int nig = WGM * nN, gid = wgid / nig, fm = gid * WGM, gsz = (nM - fm) < WGM ? (nM - fm) : WGM;
        u.pm = fm + ((wgid % nig) % gsz); u.pn = (wgid % nig) / gsz; return true;
    }
    __device__ __forceinline__ void a_ready(const Unit&) const {}
    __device__ __forceinline__ void done(const Unit&) const {}
};
__device__ __forceinline__ unsigned cvt_pk_bf16(float lo, float hi) { unsigned r; asm volatile("v_cvt_pk_bf16_f32 %0, %1, %2" : "=v"(r) : "v"(lo), "v"(hi)); return r; }
typedef unsigned u32x2v __attribute__((ext_vector_type(2)));

struct TileOrder {
    int nI, nJ, nwg, G, c, latent_only;
    __device__ void init(int nI_, int nJ_, int G_, int c_, int lat) { nI = nI_; nJ = nJ_; nwg = nI * nJ; G = G_; c = c_; latent_only = lat; }
    __device__ bool next(int i, Unit& u) const { const long L = (long)i * G + c; if (L >= nwg) return false;
        const int ii = (int)(L % nI), j = (int)(L / nI); u.pm = latent_only ? (ii / (SEQ / 256)) * (TOK / 256) + 1 + ii % (SEQ / 256) : ii; u.pn = j; return true; }
    __device__ __forceinline__ void a_ready(const Unit&) const {}
    __device__ __forceinline__ void done(const Unit&) const {}
};
struct GroupedOrder {
    int nI, nJ, tilesA, nwg, G, c;
    __device__ void init(int nI_, int nJ_, int tilesA_, int G_, int c_) { nI = nI_; nJ = nJ_; tilesA = tilesA_; nwg = NE * nI * nJ; G = G_; c = c_; }
    __device__ bool next(int i, Unit& u) const { const long L = (long)i * G + c; if (L >= nwg) return false;
        const int e = (int)(L / (nI * nJ)), r = (int)(L % (nI * nJ)), j = r / nI, ii = r % nI; u.pm = e * tilesA + ii; u.pn = e * nJ + j; return true; }
    __device__ __forceinline__ void a_ready(const Unit&) const {}
    __device__ __forceinline__ void done(const Unit&) const {}
};

struct EpiF32 {
    static constexpr bool PERM = false, AFTER_DRAIN = false;
    float* C; int ldc;
    __device__ __forceinline__ void operator()(const f32x4 (&acc)[2][2][4][2], const Unit& u, int wr, int wc, int fr, int fq) const {
        const int row0 = u.pm * BM + wr * 64 + fr, col0 = u.pn * BM + wc * 32 + 4 * fq;
#pragma unroll
        for (int ai = 0; ai < 2; ++ai)
#pragma unroll
            for (int m = 0; m < 4; ++m) { float* rowp = C + (size_t)(row0 + ai * HALF + m * 16) * ldc + col0;
#pragma unroll
                for (int bj = 0; bj < 2; ++bj)
#pragma unroll
                    for (int n = 0; n < 2; ++n) *(f32x4*)(rowp + bj * HALF + n * 16) = acc[ai][bj][m][n]; }
    }
};
struct EpiResid {
    static constexpr bool PERM = false, AFTER_DRAIN = false;
    float* X; const float* modl;
    __device__ __forceinline__ void operator()(const f32x4 (&acc)[2][2][4][2], const Unit& u, int wr, int wc, int fr, int fq) const {
        const int row0 = u.pm * BM + wr * 64 + fr, col0 = u.pn * BM + wc * 32 + 4 * fq;
        const int tb = TOK / 256, sel = (u.pm % tb == 0) ? 2 : u.pm / tb;
        const float* gate = modl + ((size_t)sel * 6 + 2) * D_MODEL + col0;
        f32x4 gv[2][2];
#pragma unroll
        for (int bj = 0; bj < 2; ++bj)
#pragma unroll
            for (int n = 0; n < 2; ++n) gv[bj][n] = *(const f32x4*)(gate + bj * HALF + n * 16);
#pragma unroll
        for (int ai = 0; ai < 2; ++ai)
#pragma unroll
            for (int m = 0; m < 4; ++m) { float* rowp = X + (size_t)(row0 + ai * HALF + m * 16) * D_MODEL + col0;
#pragma unroll
                for (int bj = 0; bj < 2; ++bj)
#pragma unroll
                    for (int n = 0; n < 2; ++n) { f32x4* q = (f32x4*)(rowp + bj * HALF + n * 16); *q = *q + gv[bj][n] * acc[ai][bj][m][n]; } }
    }
};
struct EpiSwiGLU {
    static constexpr bool PERM = false, AFTER_DRAIN = false;
    bf16_t* H; int nJ;
    __device__ __forceinline__ void operator()(const f32x4 (&acc)[2][2][4][2], const Unit& u, int wr, int wc, int fr, int fq) const {
        const int row0 = u.pm * BM + wr * 64 + fr, col0 = (u.pn % nJ) * HALF + wc * 32 + 4 * fq;
#pragma unroll
        for (int ai = 0; ai < 2; ++ai)
#pragma unroll
            for (int m = 0; m < 4; ++m) { bf16_t* rowp = H + (size_t)(row0 + ai * HALF + m * 16) * D_MODEL + col0;
#pragma unroll
                for (int n = 0; n < 2; ++n) { const f32x4 a = acc[ai][0][m][n], b = acc[ai][1][m][n]; float o[4];
#pragma unroll
                    for (int q = 0; q < 4; ++q) o[q] = a[q] / (1.f + __expf(-a[q])) * b[q];
                    u32x2v w; w.x = cvt_pk_bf16(o[0], o[1]); w.y = cvt_pk_bf16(o[2], o[3]); *(u32x2v*)(rowp + n * 16) = w; } }
    }
};
struct EpiGate {
    static constexpr bool PERM = false, AFTER_DRAIN = false;
    float* Y; const float* gate; int nJ;
    __device__ __forceinline__ void operator()(const f32x4 (&acc)[2][2][4][2], const Unit& u, int wr, int wc, int fr, int fq) const {
        const int row0 = u.pm * BM + wr * 64 + fr, col0 = (u.pn % nJ) * BM + wc * 32 + 4 * fq;
#pragma unroll
        for (int ai = 0; ai < 2; ++ai)
#pragma unroll
            for (int m = 0; m < 4; ++m) { const int r = row0 + ai * HALF + m * 16; const float gt = gate[r]; float* rowp = Y + (size_t)r * D_MODEL + col0;
#pragma unroll
                for (int bj = 0; bj < 2; ++bj)
#pragma unroll
                    for (int n = 0; n < 2; ++n) *(f32x4*)(rowp + bj * HALF + n * 16) = acc[ai][bj][m][n] * gt; }
    }
};
template <class Epi, class Sched>
__device__ __forceinline__ void gemm_phase(PG8_LAS unsigned char* lds, const Gemm g, const Sched& S, const Epi& E) {
    const int tid = threadIdx.x, wid = __builtin_amdgcn_readfirstlane(tid >> 6), lane = tid & 63, wr = wid >> 2, wc = wid & 3, fr = lane & 15, fq = lane >> 4;
    const int K = g.K, nt = K / BK;
    unsigned voffA[2], voffB[2];
#pragma unroll
    for (int i = 0; i < 2; ++i) { int R, C; stage_rc(tid * 16 + i * 8192, R, C); const int Rb = Epi::PERM ? ((R & ~31) + perm32(R & 31)) : R;
        voffA[i] = (unsigned)(R * K + C) * 2u; voffB[i] = (unsigned)(Rb * K + C) * 2u; }
    const size_t kstep = (size_t)(BK * 2);
    const size_t hstep = (size_t)HALF * K * 2;
    const size_t tstep = 2 * hstep;
    const unsigned ldsw = (unsigned)wid * 1024u;
    const int aoff = lds_byte(wr * 64 + fr, fq * 8), boff = lds_byte(wc * 32 + fr, fq * 8);
#define PG8_SA(b, h) (((b) * 2 + (h)) * HTB)
#define PG8_SB(b, h) ((4 + (b) * 2 + (h)) * HTB)
#define PG8_STAGE(bufoff, gbase, voff) do { _Pragma("unroll") for (int _i = 0; _i < 2; ++_i) \
        __builtin_amdgcn_global_load_lds((const unsigned*)((const char*)(gbase) + (voff)[_i]), (PG8_LAS unsigned*)(lds + (bufoff) + ldsw + _i * 8192), 16, 0, 0); } while (0)
#define PG8_LDA(dst, b, h) do { _Pragma("unroll") for (int m = 0; m < 4; ++m) _Pragma("unroll") for (int k = 0; k < 2; ++k) dst[m][k] = *(const PG8_LAS bf16x8*)(lds + PG8_SA(b, h) + aoff + m * 2048 + k * 1024); } while (0)
#define PG8_LDB(dst, b, h) do { _Pragma("unroll") for (int n = 0; n < 2; ++n) _Pragma("unroll") for (int k = 0; k < 2; ++k) dst[n][k] = *(const PG8_LAS bf16x8*)(lds + PG8_SB(b, h) + boff + n * 2048 + k * 1024); } while (0)
#define PG8_MMA(ai, bj, At, Bt) do { __builtin_amdgcn_s_setprio(1); _Pragma("unroll") for (int m = 0; m < 4; ++m) _Pragma("unroll") for (int n = 0; n < 2; ++n) _Pragma("unroll") for (int k = 0; k < 2; ++k) \
        acc[ai][bj][m][n] = __builtin_amdgcn_mfma_f32_16x16x32_bf16(Bt[n][k], At[m][k], acc[ai][bj][m][n], 0, 0, 0); __builtin_amdgcn_s_setprio(0); } while (0)
#define PG8_WAIT_V(n) asm volatile("s_waitcnt vmcnt(" #n ")" ::: "memory")
#define PG8_WAIT_L(n) asm volatile("s_waitcnt lgkmcnt(" #n ")" ::: "memory")
#define PG8_BAR __builtin_amdgcn_s_barrier()
#define PG8_SCHED __builtin_amdgcn_sched_barrier(0)
    Unit cur, nxt; int ui = 0;
    if (!S.next(0, cur)) return;
    f32x4 acc[2][2][4][2];
#pragma unroll
    for (int a = 0; a < 2; ++a)
#pragma unroll
        for (int b = 0; b < 2; ++b)
#pragma unroll
            for (int m = 0; m < 4; ++m)
#pragma unroll
                for (int n = 0; n < 2; ++n) acc[a][b][m][n] = (f32x4){0.f, 0.f, 0.f, 0.f};
    bf16x8 At[4][2], B0[2][2], B1[2][2];
    const char* cA = (const char*)g.A + (size_t)cur.pm * tstep; const char* cB = (const char*)g.Bt + (size_t)cur.pn * tstep;
    S.a_ready(cur);
    PG8_STAGE(PG8_SB(0, 0), cB, voffB); PG8_STAGE(PG8_SA(0, 0), cA, voffA); PG8_STAGE(PG8_SB(0, 1), cB + hstep, voffB); PG8_STAGE(PG8_SA(0, 1), cA + hstep, voffA);
    if (wr == 1) PG8_BAR;
    PG8_WAIT_V(4); PG8_BAR;
    PG8_STAGE(PG8_SB(1, 0), cB + kstep, voffB); PG8_STAGE(PG8_SA(1, 0), cA + kstep, voffA); PG8_STAGE(PG8_SB(1, 1), cB + hstep + kstep, voffB);
    PG8_WAIT_V(6); PG8_BAR;
    for (;;) {
        const bool has_next = S.next(ui + 1, nxt);
        const char* nA = has_next ? (const char*)g.A + (size_t)nxt.pm * tstep : cA; const char* nB = has_next ? (const char*)g.Bt + (size_t)nxt.pn * tstep : cB;
        for (int t = 0; t < nt; t += 2) {
            const bool last = (t == nt - 2);
            const char* a1 = cA + (size_t)(t + 1) * kstep;
            const char* a2 = last ? nA : cA + (size_t)(t + 2) * kstep; const char* b2 = last ? nB : cB + (size_t)(t + 2) * kstep;
            const char* a3 = a2 + kstep; const char* b3 = b2 + kstep;
            if (last && has_next) S.a_ready(nxt);
            PG8_LDB(B0, 0, 0); PG8_SCHED; PG8_LDA(At, 0, 0); PG8_STAGE(PG8_SA(1, 1), a1 + hstep, voffA);
            PG8_WAIT_L(8); PG8_BAR; PG8_WAIT_L(0); PG8_MMA(0, 0, At, B0); PG8_BAR; PG8_SCHED;
            PG8_LDB(B1, 0, 1); PG8_STAGE(PG8_SB(0, 0), b2, voffB);
            PG8_BAR; PG8_WAIT_L(0); PG8_MMA(0, 1, At, B1); PG8_BAR;
            PG8_LDA(At, 0, 1); PG8_STAGE(PG8_SA(0, 0), a2, voffA);
            PG8_BAR; PG8_WAIT_L(0); PG8_MMA(1, 0, At, B0); PG8_BAR; PG8_SCHED;
            PG8_STAGE(PG8_SB(0, 1), b2 + hstep, voffB);
            PG8_WAIT_V(6); PG8_BAR; PG8_MMA(1, 1, At, B1); PG8_BAR;
            PG8_LDB(B0, 1, 0); PG8_SCHED; PG8_LDA(At, 1, 0); PG8_STAGE(PG8_SA(0, 1), a2 + hstep, voffA);
            PG8_WAIT_L(8); PG8_BAR; PG8_WAIT_L(0); PG8_MMA(0, 0, At, B0); PG8_BAR; PG8_SCHED;
            PG8_LDB(B1, 1, 1); PG8_STAGE(PG8_SB(1, 0), b3, voffB);
            PG8_BAR; PG8_WAIT_L(0); PG8_MMA(0, 1, At, B1); PG8_BAR;
            PG8_LDA(At, 1, 1); PG8_STAGE(PG8_SA(1, 0), a3, voffA);
            PG8_BAR; PG8_WAIT_L(0); PG8_MMA(1, 0, At, B0); PG8_BAR; PG8_SCHED;
            PG8_STAGE(PG8_SB(1, 1), b3 + hstep, voffB);
            PG8_WAIT_V(6); PG8_BAR; PG8_MMA(1, 1, At, B1); PG8_BAR;
        }
        if constexpr (!Epi::AFTER_DRAIN) { E(acc, cur, wr, wc, fr, fq); S.done(cur); }
        if (!has_next) break;
#pragma unroll
        for (int a = 0; a < 2; ++a)
#pragma unroll
            for (int b = 0; b < 2; ++b)
#pragma unroll
                for (int m = 0; m < 4; ++m)
#pragma unroll
                    for (int n = 0; n < 2; ++n) acc[a][b][m][n] = (f32x4){0.f, 0.f, 0.f, 0.f};
        cur = nxt; cA = nA; cB = nB; ++ui;
    }
    PG8_WAIT_V(0);
    if (wr == 0) PG8_BAR;
    PG8_BAR;
    if constexpr (Epi::AFTER_DRAIN) { E.fused(acc, cur, wr, wc, fr, fq, lds, wid, lane); S.done(cur); }
#undef PG8_SA
#undef PG8_SB
#undef PG8_STAGE
#undef PG8_LDA
#undef PG8_LDB
#undef PG8_MMA
#undef PG8_WAIT_V
#undef PG8_WAIT_L
#undef PG8_BAR
#undef PG8_SCHED
}
}


namespace att {
using bf16 = unsigned short;
constexpr int   D = 128, NW = 8, QBLK = 32, KVBLK = 64;
constexpr float SCALE = 0.088388347648318440f;
constexpr float THR = 8.f;
constexpr int SDEPTH = 2;
constexpr int LDQ = 128, LDK = 128, LDO = D_MODEL;
constexpr size_t SHM_V = KVBLK * D * 2, SHM_K = KVBLK * D * 2, SHM_ATTN = 2 * SHM_V + 2 * SHM_K + NW * 64 * 4;
using bf16x8 = __attribute__((ext_vector_type(8))) short;
using s16x4  = __attribute__((ext_vector_type(4))) short;
using f32x16 = __attribute__((ext_vector_type(16))) float;
using f32x8  = __attribute__((ext_vector_type(8))) float;
using u32x4  = __attribute__((ext_vector_type(4))) unsigned;
#define KSWZ(row, colB) ((row) * 256 + ((colB) ^ (((row) & 7) << 4)))
#define SBAR() __builtin_amdgcn_sched_barrier(0)
__device__ __forceinline__ int crow(int r, int hi) { return (r & 3) + 8 * (r >> 2) + 4 * hi; }
__device__ __forceinline__ unsigned cvtpk(float lo, float hi) {
  unsigned r; asm volatile("v_cvt_pk_bf16_f32 %0, %1, %2" : "=v"(r) : "v"(lo), "v"(hi)); return r;
}
template <typename TIn> struct Stage;
template <> struct Stage<bf16>  { using T = bf16x8;
  __device__ static __forceinline__ T ld8(const bf16* p) { return *reinterpret_cast<const bf16x8*>(p); }
  __device__ static __forceinline__ bf16x8 tobf(T x) { return x; } };
template <> struct Stage<float> { using T = f32x8;
  __device__ static __forceinline__ T ld8(const float* p) { return *reinterpret_cast<const f32x8*>(p); }
  __device__ static __forceinline__ bf16x8 tobf(T x) {
    u32x4 w = {cvtpk(x[0], x[1]), cvtpk(x[2], x[3]), cvtpk(x[4], x[5]), cvtpk(x[6], x[7])}; return *reinterpret_cast<bf16x8*>(&w); } };

__device__ __forceinline__ void partialSM(f32x16& p0, f32x16& p1, float& m_reg, float& mn, float& alpha) {
  constexpr float C = SCALE * 1.4426950408889634f;
  float pmax = p0[0]; for (int r = 1; r < 16; ++r) pmax = fmaxf(pmax, p0[r]); for (int r = 0; r < 16; ++r) pmax = fmaxf(pmax, p1[r]);
  { auto rr = __builtin_amdgcn_permlane32_swap(__float_as_uint(pmax), __float_as_uint(pmax), false, false);
    pmax = fmaxf(__uint_as_float(rr[0]), __uint_as_float(rr[1])); }
  if (__builtin_expect(__all(pmax - m_reg <= THR / SCALE), 1)) { mn = m_reg; alpha = 1.f; }
  else { mn = fmaxf(m_reg, pmax); alpha = __builtin_amdgcn_exp2f((m_reg - mn) * C); m_reg = mn; }
  float mnC = -mn * C;
  for (int r = 0; r < 16; ++r) p0[r] = fmaf(p0[r], C, mnC); for (int r = 0; r < 16; ++r) p1[r] = fmaf(p1[r], C, mnC);
  for (int r = 0; r < 16; ++r) p0[r] = __builtin_amdgcn_exp2f(p0[r]);
}
__device__ __forceinline__ void finishSM(f32x16& p0, f32x16& p1, float alpha, float& l_reg, bf16x8& pa0, bf16x8& pa1, bf16x8& pa2, bf16x8& pa3) {
  for (int r = 0; r < 16; ++r) p1[r] = __builtin_amdgcn_exp2f(p1[r]);
  float ps = 0; for (int r = 0; r < 16; ++r) ps += p0[r]; for (int r = 0; r < 16; ++r) ps += p1[r];
  { auto rr = __builtin_amdgcn_permlane32_swap(__float_as_uint(ps), __float_as_uint(ps), false, false);
    ps = __uint_as_float(rr[0]) + __uint_as_float(rr[1]); }
  l_reg = l_reg * alpha + ps;
#define PK4(P, BASE, OUT) do { unsigned a0 = cvtpk(P[BASE + 0], P[BASE + 1]), a1 = cvtpk(P[BASE + 2], P[BASE + 3]);   \
    unsigned b0 = cvtpk(P[BASE + 4], P[BASE + 5]), b1 = cvtpk(P[BASE + 6], P[BASE + 7]);                              \
    auto r0 = __builtin_amdgcn_permlane32_swap(a0, b0, false, false); auto r1 = __builtin_amdgcn_permlane32_swap(a1, b1, false, false); \
    u32x4 w = {r0[0], r1[0], r0[1], r1[1]}; OUT = *reinterpret_cast<bf16x8*>(&w); } while (0)
  PK4(p0, 0, pa0); PK4(p0, 8, pa1); PK4(p1, 0, pa2); PK4(p1, 8, pa3);
#undef PK4
}
__device__ __forceinline__ void qkt(f32x16& p0, f32x16& p1, const bf16* Ks, const bf16x8* qr, int r32, int hi) {
  p0 = f32x16{}; p1 = f32x16{};
  for (int d0 = 0; d0 < 8; ++d0) { int cb = (d0 * 16 + hi * 8) * 2;
    bf16x8 b0 = *reinterpret_cast<const bf16x8*>((const char*)Ks + KSWZ(r32, cb));
    bf16x8 b1 = *reinterpret_cast<const bf16x8*>((const char*)Ks + KSWZ(32 + r32, cb));
    p0 = __builtin_amdgcn_mfma_f32_32x32x16_bf16(b0, qr[d0], p0, 0, 0, 0);
    p1 = __builtin_amdgcn_mfma_f32_32x32x16_bf16(b1, qr[d0], p1, 0, 0, 0); }
}
__device__ __forceinline__ int v_st(int k, int c) { const int kk = (k & ~0xC) | ((k & 4) << 1) | ((k & 8) >> 1); return ((kk >> 3) * 4 + (c >> 5)) * 512 + ((kk & 7) * 32 + (c & 31)) * 2; }
__device__ __forceinline__ int v_rd_base(int lane) { return ((lane & 3) << 3) | (((lane >> 2) & 3) << 6) | (((lane >> 4) & 1) << 5) | (((lane >> 5) & 1) << 8); }
constexpr int v_rd_off(int d0, int ks, int half) { return d0 * 512 + ks * 4096 + half * 2048; }
template <int OFF> __device__ __forceinline__ s16x4 tr_read(int vb) {
  s16x4 r; asm volatile("ds_read_b64_tr_b16 %0, %1 offset:%2" : "=&v"(r) : "v"(vb), "i"(OFF) : "memory"); return r;
}
template <int D0> __device__ __forceinline__ void pv_one(f32x16& od, int vb, bf16x8 pa0, bf16x8 pa1, bf16x8 pa2, bf16x8 pa3) {
  const s16x4 l0 = tr_read<v_rd_off(D0, 0, 0)>(vb), h0 = tr_read<v_rd_off(D0, 0, 1)>(vb), l1 = tr_read<v_rd_off(D0, 1, 0)>(vb), h1 = tr_read<v_rd_off(D0, 1, 1)>(vb);
  const s16x4 l2 = tr_read<v_rd_off(D0, 2, 0)>(vb), h2 = tr_read<v_rd_off(D0, 2, 1)>(vb), l3 = tr_read<v_rd_off(D0, 3, 0)>(vb), h3 = tr_read<v_rd_off(D0, 3, 1)>(vb);
  asm volatile("s_waitcnt lgkmcnt(0)" ::: "memory"); SBAR();
#define PK(L, H) (bf16x8){L[0], L[1], L[2], L[3], H[0], H[1], H[2], H[3]}
  od = __builtin_amdgcn_mfma_f32_32x32x16_bf16(pa0, PK(l0, h0), od, 0, 0, 0);
  od = __builtin_amdgcn_mfma_f32_32x32x16_bf16(pa1, PK(l1, h1), od, 0, 0, 0);
  od = __builtin_amdgcn_mfma_f32_32x32x16_bf16(pa2, PK(l2, h2), od, 0, 0, 0);
  od = __builtin_amdgcn_mfma_f32_32x32x16_bf16(pa3, PK(l3, h3), od, 0, 0, 0);
#undef PK
}
__device__ __forceinline__ void pv_d0(f32x16* o, int vb, bf16x8 pa0, bf16x8 pa1, bf16x8 pa2, bf16x8 pa3) {
  pv_one<0>(o[0], vb, pa0, pa1, pa2, pa3); pv_one<1>(o[1], vb, pa0, pa1, pa2, pa3); pv_one<2>(o[2], vb, pa0, pa1, pa2, pa3); pv_one<3>(o[3], vb, pa0, pa1, pa2, pa3);
}

__device__ __forceinline__ void attn_dense_body(const bf16* __restrict__ Qb, const bf16* __restrict__ Kh, const bf16* __restrict__ Vh,
                                                unsigned short* __restrict__ Ob, int seq, char* lds) {
  using St = Stage<bf16>; using SQ = Stage<bf16>; using TQ = bf16;
  const int tid = threadIdx.x, wid = tid >> 6, lane = tid & 63, r32 = lane & 31, hi = lane >> 5;
  bf16* V_lds = (bf16*)lds; bf16* K_lds = (bf16*)(lds + 2 * SHM_V);
  float* ws = (float*)(lds + 2 * SHM_V + 2 * SHM_K) + wid * 64; float* li_l = ws; float* al_l = ws + 32;
  float m_reg = -1e30f, l_reg = 0; f32x16 o[4] = {}; bf16x8 qr[8];
  const TQ* Qw = Qb + (long)(wid * QBLK + r32) * LDQ + hi * 8;
#pragma unroll
  for (int d0 = 0; d0 < 8; ++d0) qr[d0] = SQ::tobf(SQ::ld8(Qw + d0 * 16));
  const int sr = tid >> 4, sc = (tid & 15) * 8, vst0 = v_st(sr, sc), vst1 = v_st(32 + sr, sc);
  const int vb0 = (int)(uintptr_t)V_lds + v_rd_base(lane);
  struct { typename St::T vs0, vs1, ks0, ks1; } sr_[SDEPTH];
#define SLOAD(i, k0) do { sr_[i].vs0 = St::ld8(&Vh[(long)((k0) + sr) * LDK + sc]); sr_[i].vs1 = St::ld8(&Vh[(long)((k0) + 32 + sr) * LDK + sc]); \
    sr_[i].ks0 = St::ld8(&Kh[(long)((k0) + sr) * LDK + sc]); sr_[i].ks1 = St::ld8(&Kh[(long)((k0) + 32 + sr) * LDK + sc]); } while (0)
#define SWRITE(b, i) do { *(bf16x8*)((char*)V_lds + (b) * SHM_V + vst0) = St::tobf(sr_[i].vs0);          \
    *(bf16x8*)((char*)V_lds + (b) * SHM_V + vst1) = St::tobf(sr_[i].vs1); int kc = sc * 2;               \
    *(bf16x8*)((char*)K_lds + (b) * SHM_K + KSWZ(sr, kc)) = St::tobf(sr_[i].ks0);                       \
    *(bf16x8*)((char*)K_lds + (b) * SHM_K + KSWZ(32 + sr, kc)) = St::tobf(sr_[i].ks1); } while (0)
#define SWAIT() do { if constexpr (SDEPTH == 2) asm volatile("s_waitcnt vmcnt(4)" ::: "memory"); else asm volatile("s_waitcnt vmcnt(0)" ::: "memory"); } while (0)
#define RESC(a) do { if (__any((a) < 1.f)) { if (hi == 0) al_l[r32] = (a); asm volatile("s_waitcnt lgkmcnt(0)" ::: "memory"); \
    for (int d = 0; d < 4; ++d) for (int r = 0; r < 16; ++r) o[d][r] *= al_l[crow(r, hi)]; } } while (0)
  f32x16 pA0, pA1, pB0, pB1; float mnA, mnB, alA, alB; bf16x8 pa0, pa1, pa2, pa3; const int NT = seq / KVBLK;
  constexpr int SE = 0, SO = SDEPTH - 1;
  SLOAD(SE, 0); asm volatile("s_waitcnt vmcnt(0)" ::: "memory"); SWRITE(0, SE); __syncthreads();
  qkt(pA0, pA1, K_lds, qr, r32, hi); partialSM(pA0, pA1, m_reg, mnA, alA);
  SLOAD(SO, KVBLK); if constexpr (SDEPTH == 2) { if (2 < NT) SLOAD(SE, 2 * KVBLK); }
  SWAIT(); SWRITE(1, SO); __syncthreads();
  for (int j = 1; j + 1 < NT; j += 2) {
    SBAR(); qkt(pB0, pB1, (bf16*)((char*)K_lds + SHM_K), qr, r32, hi);
    finishSM(pA0, pA1, alA, l_reg, pa0, pa1, pa2, pa3); SBAR();
    SLOAD(SO, (j + SDEPTH) * KVBLK); SBAR();
    pv_d0(o, vb0, pa0, pa1, pa2, pa3); partialSM(pB0, pB1, m_reg, mnB, alB);
    __syncthreads(); SWAIT(); SWRITE(0, SE);
    RESC(alB); __syncthreads();
    SBAR(); qkt(pA0, pA1, K_lds, qr, r32, hi);
    finishSM(pB0, pB1, alB, l_reg, pa0, pa1, pa2, pa3); SBAR();
    if (SDEPTH == 1 || j + 3 < NT) SLOAD(SE, (j + 1 + SDEPTH) * KVBLK); SBAR();
    pv_d0(o, vb0 + (int)SHM_V, pa0, pa1, pa2, pa3); partialSM(pA0, pA1, m_reg, mnA, alA);
    __syncthreads(); SWAIT(); SWRITE(1, SO);
    RESC(alA); __syncthreads();
  }
  SBAR(); qkt(pB0, pB1, (bf16*)((char*)K_lds + SHM_K), qr, r32, hi);
  finishSM(pA0, pA1, alA, l_reg, pa0, pa1, pa2, pa3); SBAR();
  pv_d0(o, vb0, pa0, pa1, pa2, pa3); partialSM(pB0, pB1, m_reg, mnB, alB);
  __syncthreads(); RESC(alB);
  finishSM(pB0, pB1, alB, l_reg, pa0, pa1, pa2, pa3); SBAR();
  pv_d0(o, vb0 + (int)SHM_V, pa0, pa1, pa2, pa3);
  if (hi == 0) li_l[r32] = l_reg; asm volatile("s_waitcnt lgkmcnt(0)" ::: "memory");
  float rli[16];
#pragma unroll
  for (int r = 0; r < 16; ++r) rli[r] = __builtin_amdgcn_rcpf(li_l[crow(r, hi)]);
  unsigned short* Ow = Ob + (long)(wid * QBLK) * LDO;
#pragma unroll
  for (int r = 0; r < 16; ++r) { int orow = crow(r, hi);
    for (int d0 = 0; d0 < 4; ++d0) Ow[(long)orow * LDO + d0 * 32 + r32] = f2bf(o[d0][r] * rli[r]); }
#undef SLOAD
#undef SWRITE
#undef SWAIT
#undef RESC
}
}

__device__ __forceinline__ void cvt_tile(const float* __restrict__ W, int ldw, int nvalid, int k0, int n0, u16* __restrict__ Wt, int rowbase, int rmode, float* lds) {
    const int tid = threadIdx.x;
    for (int idx = tid; idx < 4096; idx += 512) { const int kk = idx >> 6, nn = idx & 63; const int n = n0 + nn;
        lds[kk * 65 + nn] = n < nvalid ? W[(size_t)(k0 + kk) * ldw + n] : 0.f; }
    __syncthreads();
    for (int idx = tid; idx < 1024; idx += 512) { const int nn = idx >> 4, k4 = (idx & 15) * 4; const int n = n0 + nn;
        int row = n;
        if (rmode) row = (n >> 7) * 256 + (n & 127) + (rmode == 2 ? 128 : 0);
        pg8::u32x2v w; w.x = pg8::cvt_pk_bf16(lds[(k4 + 0) * 65 + nn], lds[(k4 + 1) * 65 + nn]); w.y = pg8::cvt_pk_bf16(lds[(k4 + 2) * 65 + nn], lds[(k4 + 3) * 65 + nn]);
        *(pg8::u32x2v*)(Wt + (size_t)(rowbase + row) * D_MODEL + k0 + k4) = w; }
    __syncthreads();
}
__device__ __forceinline__ void ph_convert(const Params& p, float* lds) {
    constexpr int KT = D_MODEL / 64;
    constexpr int T_IN = KT * (LDP / 64), T_OUT = KT * (D_MODEL / 64), T_E = KT * (D_MODEL / 64);
    constexpr int PER_L = T_IN + T_OUT + NE * 3 * T_E, TOTAL = DEPTH * PER_L;
    for (int t = blockIdx.x; t < TOTAL; t += gridDim.x) {
        const int l = t / PER_L; int r = t % PER_L;
        if (r < T_IN) { const int kt = r % KT, nt = r / KT;
            cvt_tile(p.w_in + (size_t)l * D_MODEL * N_IN, N_IN, N_IN, kt * 64, nt * 64, p.wt_in + (size_t)l * LDP * D_MODEL, 0, 0, lds); continue; }
        r -= T_IN;
        if (r < T_OUT) { const int kt = r % KT, nt = r / KT;
            cvt_tile(p.w_out + (size_t)l * D_MODEL * D_MODEL, D_MODEL, D_MODEL, kt * 64, nt * 64, p.wt_out + (size_t)l * D_MODEL * D_MODEL, 0, 0, lds); continue; }
        r -= T_OUT;
        const int e = r / (3 * T_E), which = (r / T_E) % 3, q = r % T_E, kt = q % KT, nt = q / KT;
        const size_t eo = ((size_t)l * NE + e) * D_MODEL * D_MODEL;
        if (which == 0) cvt_tile(p.w_exp1 + eo, D_MODEL, D_MODEL, kt * 64, nt * 64, p.w13t + 2 * eo, 0, 1, lds);
        else if (which == 1) cvt_tile(p.w_exp3 + eo, D_MODEL, D_MODEL, kt * 64, nt * 64, p.w13t + 2 * eo, 0, 2, lds);
        else cvt_tile(p.w_exp2 + eo, D_MODEL, D_MODEL, kt * 64, nt * 64, p.w2t + eo, 0, 0, lds);
    }
}

constexpr int LDS_BYTES = 147456;
constexpr int LDS_MISC = 147392;
constexpr int NPL = 15;
constexpr int NPHASE = 2 + DEPTH * NPL + 1;

struct Args { Params p; int ph_lo, ph_hi, flags, pad; };

template <int G> __device__ __forceinline__ Exec mk_exec() { const int gt = blockIdx.x * 512 + threadIdx.x; return Exec{gt / G, (int)(gridDim.x * 512) / G, gt % G}; }
typedef const __attribute__((address_space(4))) unsigned long long* kq_t;
__device__ __forceinline__ void load_params(Params& p, const __attribute__((address_space(4))) unsigned char* ka) {
    kq_t s = (kq_t)ka; unsigned long long* d = (unsigned long long*)&p;
#pragma unroll
    for (int i = 0; i < (int)(sizeof(Params) / 8); ++i) d[i] = s[i];
}
#define LOADP() Params p; load_params(p, ka)
#define PH(k, ...) do { if (lo <= (k) && (k) < hi) { { LOADP(); __VA_ARGS__; } if ((k) + 1 < hi) xcd_barrier(bar); } } while (0)
#define e1 mk_exec<1>()
#define e16 mk_exec<16>()
#define e64 mk_exec<64>()
#define flds ((float*)lds)
#define glds ((PG8_LAS unsigned char*)lds)
#define G ((int)gridDim.x)
#define c ((int)blockIdx.x)
template <int L> __device__ __forceinline__ void layer_phases(const __attribute__((address_space(4))) unsigned char* ka, int lo, int hi, int flags, const XcdBarrier& bar, unsigned char* lds) {
    constexpr int l = L;
        const int b0 = 2 + l * NPL; const bool last = (l == DEPTH - 1);
        PH(b0 + 0, ph_norm1<64>(p, l, e64));
        PH(b0 + 1, { pg8::Gemm g{p.h, p.wt_in + (size_t)l * LDP * D_MODEL, MROWS, LDP, D_MODEL}; pg8::StaticOrder S; S.init(MROWS, LDP, G, c);
                     pg8::EpiF32 E{p.P, LDP}; pg8::gemm_phase<pg8::EpiF32, pg8::StaticOrder>(glds, g, S, E); });
        PH(b0 + 2, ph_rw_prep1<64>(p, l, e64); ph_ml_g1<64>(p, l, e64); ph_gd_prep<64>(p, l, e64); ph_gd_gates<64>(p, l, e64); ph_at_prep<64>(p, l, e64));
        PH(b0 + 3, ph_rw_prep2(p, l, e64); ph_ml_g2(p, e1); ph_gd_c1(p, e64));
        PH(b0 + 4, { for (int u = c; u < RW_CN; u += G) ph_rw_c1_unit(p, u, threadIdx.x, 512, lds); for (int u = G - 1 - c; u < ML_CN; u += G) ph_ml_c1_unit(p, u, threadIdx.x, 512, lds); });
        PH(b0 + 5, {
            const int nlat = BATCH * AT_QH * (SEQ / 256), nctx = last ? 0 : BATCH * AT_QH;
            if (flags & 1) {} else if (c < nlat) { const int u = c;
                const int qb = u % (SEQ / 256), hq = (u / (SEQ / 256)) % AT_QH, b = u / ((SEQ / 256) * AT_QH), s0 = CTX + qb * 256, kvh = hq / (AT_QH / AT_KVH);
                att::attn_dense_body((const att::bf16*)p.at_q + (((size_t)b * AT_QH + hq) * TOK + s0) * AT_HEAD,
                                     (const att::bf16*)p.at_k + ((size_t)b * AT_KVH + kvh) * TOK * AT_HEAD, (const att::bf16*)p.at_v + ((size_t)b * AT_KVH + kvh) * TOK * AT_HEAD,
                                     p.mix + ((size_t)b * TOK + s0) * D_MODEL + 3 * GROUP_W + hq * AT_HEAD, TOK, (char*)lds);
                __syncthreads(); }
            else if (c < nlat + nctx) { const int u = c - nlat;
                const int hq = u % AT_QH, b = u / AT_QH, kvh = hq / (AT_QH / AT_KVH);
                att::attn_dense_body((const att::bf16*)p.at_q + (((size_t)b * AT_QH + hq) * TOK) * AT_HEAD,
                                     (const att::bf16*)p.at_k + ((size_t)b * AT_KVH + kvh) * TOK * AT_HEAD, (const att::bf16*)p.at_v + ((size_t)b * AT_KVH + kvh) * TOK * AT_HEAD,
                                     p.mix + ((size_t)b * TOK) * D_MODEL + 3 * GROUP_W + hq * AT_HEAD, CTX, (char*)lds);
                __syncthreads(); }
            else { const int c2 = c - nlat - nctx, G2 = G - nlat - nctx; constexpr int NU1 = (RW_CN + TS_G - 1) / TS_G, NU2 = (GD_CN + TS_G - 1) / TS_G;
                if (!(flags & 2)) for (int u = c2; u < NU1 + NU2; u += G2) { if (u < NU1) ph_tsolve_unit(p.rw_Ma, p.rw_T, RW_CN, u, threadIdx.x, 512, lds); else ph_tsolve_unit(p.gd_A, p.gd_T, GD_CN, u - NU1, threadIdx.x, 512, lds); } } });
        PH(b0 + 6, { if (!(flags & 4)) for (int u = c; u < RW_CN; u += G) ph_rw_c3_unit(p, u, threadIdx.x, 512, lds);
                     if (!(flags & 8)) for (int u = G - 1 - c; u < GD_CN; u += G) ph_gd_c3_unit(p, u, threadIdx.x, 512, lds);
                     ph_ml_prefix(p, e1); });
        PH(b0 + 7, { if (!(flags & 16)) for (int u = c; u < GD_S2_UNITS; u += G) ph_gd_scan2_unit(p, u, threadIdx.x, 512, lds); }
                   { if (!(flags & 32)) for (int u = G - 1 - c; u < RW_CH; u += G) ph_rw_scan2_unit(p, u, threadIdx.x, 512, lds); }
                   { if (!(flags & 64)) for (int u = c - GD_S2_UNITS; u < ML_CN; u += G - GD_S2_UNITS - RW_CH) if (u >= 0 && c < G - RW_CH) ph_ml_c2_unit(p, u, threadIdx.x, 512, lds); });
        PH(b0 + 8, ph_rw_post<64>(p, l, e64); ph_gd_post<64>(p, l, e64); ph_ml_post<64>(p, l, e64));
        PH(b0 + 9, { pg8::Gemm g{p.mix, p.wt_out + (size_t)l * D_MODEL * D_MODEL, MROWS, D_MODEL, D_MODEL}; pg8::TileOrder S;
                      S.init(last ? BATCH * SEQ / 256 : MROWS / 256, D_MODEL / 256, G, c, last ? 1 : 0);
                      pg8::EpiResid E{p.xres, p.mod + (size_t)l * 3 * 6 * D_MODEL}; pg8::gemm_phase<pg8::EpiResid, pg8::TileOrder>(glds, g, S, E); });
        PH(b0 + 10, ph_norm2<64>(p, l, e64));
        PH(b0 + 11, { for (int u = c; u < topk_units(l); u += G) ph_topk_unit(p, l, u, threadIdx.x, 512, lds); });
        PH(b0 + 12, ph_gather<64>(p, l, e64));
        PH(b0 + 13, { pg8::Gemm g{p.xs, p.w13t + (size_t)l * NE * 2 * D_MODEL * D_MODEL, NE * NSLOT, NE * 2 * D_MODEL, D_MODEL}; pg8::GroupedOrder S;
                      S.init(last ? NSLOT_L / 256 : NSLOT / 256, 2 * D_MODEL / 256, NSLOT / 256, G, c);
                      pg8::EpiSwiGLU E{p.hid, 2 * D_MODEL / 256}; pg8::gemm_phase<pg8::EpiSwiGLU, pg8::GroupedOrder>(glds, g, S, E); });
        PH(b0 + 14, { pg8::Gemm g{p.hid, p.w2t + (size_t)l * NE * D_MODEL * D_MODEL, NE * NSLOT, NE * D_MODEL, D_MODEL}; pg8::GroupedOrder S;
                      S.init(last ? NSLOT_L / 256 : NSLOT / 256, D_MODEL / 256, NSLOT / 256, G, c);
                      pg8::EpiGate E{p.yexp, p.sel_gate, D_MODEL / 256}; pg8::gemm_phase<pg8::EpiGate, pg8::GroupedOrder>(glds, g, S, E); });
    }
__global__ void __launch_bounds__(512, 2) mega(Args args) {
    extern __shared__ __attribute__((aligned(16))) unsigned char lds[];
    typedef const __attribute__((address_space(4))) unsigned char* kptr_t;
    const kptr_t ka = (kptr_t)__builtin_amdgcn_kernarg_segment_ptr();
    (void)args;
    const unsigned long long lohi = ((kq_t)ka)[sizeof(Params) / 8]; const int lo = (int)(unsigned)lohi, hi = (int)(unsigned)(lohi >> 32);
    const int flags = (int)(unsigned)((kq_t)ka)[sizeof(Params) / 8 + 1];
    unsigned* barw = (unsigned*)((kq_t)ka)[offsetof(Params, bar) / 8];
    volatile LAS unsigned* misc = (volatile LAS unsigned*)((LAS unsigned char*)lds + LDS_MISC);
    if (threadIdx.x < 4) misc[threadIdx.x] = 0u;
    __syncthreads();
    const bool use_bar = (hi - lo) > 1;
    XcdBarrier bar; bar.bar = barw; bar.x = 0; bar.st = misc;
    if (use_bar) bar = xcd_barrier_post(barw, misc);
    PH(0, ph_convert(p, flds); ph_mod_partial(p, e1); ph_rw_wpack(p, e1));
    PH(1, ph_mod_final(p, e1));
    layer_phases<0>(ka, lo, hi, flags, bar, lds);
    layer_phases<1>(ka, lo, hi, flags, bar, lds);
    static_assert(DEPTH == 2, "depth");
    PH(2 + DEPTH * NPL, ph_final<64>(p, e64));
}
#undef PH
#undef e1
#undef e16
#undef e64
#undef flds
#undef glds
#undef G
#undef c
#undef LOADP

static size_t ws_carve(Params& p, unsigned char* ws) {
    size_t off = 0;
    auto take = [&](size_t bytes) { size_t o = off; off += (bytes + 255) / 256 * 256; return ws ? ws + o : (unsigned char*)nullptr; };
    p.bar = (unsigned*)take(XCD_BAR_WORDS * 4);
    p.modp = (float*)take((size_t)DEPTH * MOD_KS * 3 * 6 * D_MODEL * 4); p.mod = (float*)take((size_t)DEPTH * 3 * 6 * D_MODEL * 4);
    p.wt_in = (u16*)take((size_t)DEPTH * LDP * D_MODEL * 2); p.wt_out = (u16*)take((size_t)DEPTH * D_MODEL * D_MODEL * 2);
    p.w13t = (u16*)take((size_t)DEPTH * NE * 2 * D_MODEL * D_MODEL * 2); p.w2t = (u16*)take((size_t)DEPTH * NE * D_MODEL * D_MODEL * 2);
    p.xres = (float*)take((size_t)MROWS * D_MODEL * 4); p.h = (u16*)take((size_t)MROWS * D_MODEL * 2); p.mix = (u16*)take((size_t)MROWS * D_MODEL * 2);
    p.aff = (float*)take((size_t)MROWS * NE * 4); p.inv = (int*)take((size_t)MROWS * NE * 4);
    p.sel_row = (int*)take((size_t)NE * NSLOT * 4); p.sel_gate = (float*)take((size_t)NE * NSLOT * 4);
    const size_t region = off;
    p.P = (float*)take((size_t)MROWS * LDP * 4);
    const size_t rg = (size_t)MROWS * GROUP_W * 4;
    p.rw_r = (float*)take(rg); p.rw_k = (float*)take(rg); p.rw_v = (float*)take(rg); p.rw_kk = (float*)take(rg); p.rw_g = (float*)take(rg);
    p.rw_lr = (float*)take((size_t)MROWS * RW_LR * 4);
    p.rw_ew = (float*)take(2 * rg); p.rw_kka = (float*)take(2 * rg); p.rw_kt = (float*)take(2 * rg); p.rw_y = (float*)take(2 * rg);
    p.rw_Ma = (float*)take((size_t)RW_CN * CHUNK * CHUNK * 4); p.rw_T = (float*)take((size_t)RW_CN * CHUNK * CHUNK * 4);
    p.rw_Psi = (float*)take((size_t)RW_CN * RW_N * RW_N * 4); p.rw_Y0 = p.rw_Ma;
    p.rw_PhiT = (u16*)take((size_t)RW_CN * RW_N * RW_N * 2); p.rw_Rh = (u16*)take((size_t)RW_CN * CHUNK * RW_N * 2);
    p.rw_W = (u16*)take((size_t)DEPTH * GROUP_W * RW_WK * 2);
    p.ml_bcum = (float*)take((size_t)ML_CH * TOK * 4); p.ml_g = (float*)take((size_t)ML_CH * TOK * 4); p.ml_gmax = (float*)take((size_t)ML_CH * TOK * 4);
    p.ml_bl = (float*)take((size_t)ML_CH * NCHUNK * 4); p.ml_gm = (float*)take((size_t)ML_CH * NCHUNK * 4); p.ml_min = (float*)take((size_t)ML_CH * NCHUNK * 4); p.ml_dcv = (float*)take((size_t)ML_CH * NCHUNK * 4);
    p.ml_dC = (float*)take((size_t)ML_CH * NCHUNK * ML_HEAD * ML_HEAD * 4); p.ml_dn = (float*)take((size_t)ML_CH * NCHUNK * ML_HEAD * 4);
    p.ml_S = (float*)take((size_t)ML_CH * NCHUNK * CHUNK * CHUNK * 4); p.ml_hh = (float*)take(2 * rg);
    p.gd_q = (float*)take(rg); p.gd_k = (float*)take(rg); p.gd_v = (float*)take(rg);
    p.gd_gc = (float*)take((size_t)GD_CH * TOK * 4); p.gd_beta = (float*)take((size_t)GD_CH * TOK * 4);
    p.gd_A = (float*)take((size_t)GD_CN * CHUNK * CHUNK * 4); p.gd_T = (float*)take((size_t)GD_CN * CHUNK * CHUNK * 4);
    p.gd_Psi = (float*)take((size_t)GD_CN * GD_N * GD_N * 4); p.gd_O0 = (float*)take((size_t)GD_CN * CHUNK * GD_N * 4);
    p.gd_Phi = (u16*)take((size_t)GD_CN * GD_N * GD_N * 2); p.gd_Qh = (u16*)p.gd_A;
    p.gd_o = (float*)take(2 * rg);
    p.at_q = (u16*)take((size_t)BATCH * AT_QH * TOK * AT_HEAD * 2); p.at_k = (u16*)take((size_t)BATCH * AT_KVH * TOK * AT_HEAD * 2); p.at_v = (u16*)take((size_t)BATCH * AT_KVH * TOK * AT_HEAD * 2);
    const size_t end1 = off;
    off = region;
    p.xs = (u16*)take((size_t)NE * NSLOT * D_MODEL * 2); p.hid = (u16*)take((size_t)NE * NSLOT * D_MODEL * 2); p.yexp = (float*)take((size_t)NE * NSLOT * D_MODEL * 4);
    return end1 > off ? end1 : off;
}

#ifndef MK_PER_PHASE
#define MK_PER_PHASE 0
#endif
extern "C" void kernel_launch(void* const* d_in, const int* in_sizes, int n_in, void* d_out, int out_size, void* d_ws, size_t ws_size, hipStream_t stream) {
    static int grid = 0;
    if (grid == 0) {
        Params q{}; const size_t need = ws_carve(q, nullptr);
        if (n_in != 35 || out_size != BATCH * SEQ * D_MODEL || ws_size < need) {
            fprintf(stderr, "kernel_launch: expected 35 inputs, out %d, ws >= %zu; got n_in %d out %d ws %zu\n", BATCH * SEQ * D_MODEL, need, n_in, out_size, ws_size); grid = -1; return; }
        int dev = 0, cus = 0, per_cu = 0;
        if (hipGetDevice(&dev) != hipSuccess || hipDeviceGetAttribute(&cus, hipDeviceAttributeMultiprocessorCount, dev) != hipSuccess) { grid = -1; return; }
        if (hipFuncSetAttribute((const void*)mega, hipFuncAttributeMaxDynamicSharedMemorySize, LDS_BYTES) != hipSuccess) { fprintf(stderr, "kernel_launch: hipFuncSetAttribute failed\n"); grid = -1; return; }
        if (hipOccupancyMaxActiveBlocksPerMultiprocessor(&per_cu, (const void*)mega, 512, LDS_BYTES) != hipSuccess || per_cu < 1)
            fprintf(stderr, "kernel_launch: occupancy query reports %d workgroups per CU\n", per_cu);
        (void)hipGetLastError();
        if (cus < 160) { fprintf(stderr, "kernel_launch: needs >= 160 CUs\n"); grid = -1; return; }
        grid = cus;
    }
    if (grid < 0) return;
    Args a{};
    Params& p = a.p;
    const float** in = (const float**)&p;
    for (int i = 0; i < 35; ++i) in[i] = (const float*)d_in[i];
    p.out = (float*)d_out;
    (void)ws_carve(p, (unsigned char*)d_ws);
    (void)hipMemsetAsync(p.bar, 0, XCD_BAR_WORDS * 4, stream);
#if MK_PER_PHASE
    for (int k = 0; k < NPHASE; ++k) { a.ph_lo = k; a.ph_hi = k + 1; hipLaunchKernelGGL(mega, dim3(grid), dim3(512), LDS_BYTES, stream, a); }
#else
#ifdef MK_PROBE_K
#ifdef MK_PROBE_FLAGS
    a.flags = MK_PROBE_FLAGS;
#endif
    a.ph_lo = 0; a.ph_hi = MK_PROBE_K;
    hipLaunchKernelGGL(mega, dim3(grid), dim3(512), LDS_BYTES, stream, a);
    (void)hipMemsetAsync(p.bar, 0, XCD_BAR_WORDS * 4, stream);
    a.flags = 0;
#endif
    a.ph_lo = 0; a.ph_hi = NPHASE;
    hipLaunchKernelGGL(mega, dim3(grid), dim3(512), LDS_BYTES, stream, a);
#endif
    const hipError_t le = hipPeekAtLastError();
    if (le != hipSuccess) fprintf(stderr, "kernel_launch: launch failed: %s\n", hipGetErrorName(le));
}
```

```cpp
#include <hip/hip_runtime.h>

#ifndef CFG_D_MODEL
#define CFG_D_MODEL 2048
#define CFG_SEQ 4096
#define CFG_GRID_W 64
#define CFG_CTX 256
#define CFG_RW_HEAD 64
#define CFG_RW_DR 64
#define CFG_RW_IR 64
#define CFG_RW_GR 128
#define CFG_ML_HEAD 128
#define CFG_CHUNK 64
#define CFG_GD_HEAD 128
#define CFG_AT_HEAD 128
#define CFG_AT_KVH 2
#define CFG_NE 16
#endif

constexpr int D_MODEL = CFG_D_MODEL, BATCH = 2, SEQ = CFG_SEQ, DEPTH = 2, GRID_W = CFG_GRID_W, CTX = CFG_CTX;
constexpr int TOK = CTX + SEQ, MROWS = BATCH * TOK, GROUP_W = D_MODEL / 4;
constexpr int RW_HEAD = CFG_RW_HEAD, RW_HEADS = GROUP_W / RW_HEAD, RW_DR = CFG_RW_DR, RW_IR = CFG_RW_IR, RW_GR = CFG_RW_GR;
constexpr int RW_COLS = 3 * GROUP_W + RW_DR + RW_IR + RW_GR, RW_LR = RW_DR + RW_IR + RW_GR;
constexpr int ML_HEAD = CFG_ML_HEAD, ML_HEADS = GROUP_W / ML_HEAD, CHUNK = CFG_CHUNK, ML_COLS = 4 * GROUP_W + 4 * ML_HEADS;
constexpr int GD_HEAD = CFG_GD_HEAD, GD_HEADS = GROUP_W / GD_HEAD, GD_COLS = 4 * GROUP_W + 4 * GD_HEADS;
constexpr int AT_HEAD = CFG_AT_HEAD, AT_QH = GROUP_W / AT_HEAD, AT_KVH = CFG_AT_KVH, AT_COLS = (AT_QH + 2 * AT_KVH) * AT_HEAD;
constexpr int N_IN = RW_COLS + ML_COLS + GD_COLS + AT_COLS;
constexpr int RW_OFF = 0, ML_OFF = RW_COLS, GD_OFF = ML_OFF + ML_COLS, AT_OFF = GD_OFF + GD_COLS;
constexpr int LDP = (N_IN + 255) / 256 * 256;
constexpr int NE = CFG_NE, CAPL = 2 * SEQ / NE, CAPC = 2 * CTX / NE;
constexpr int NSLOT_L = BATCH * CAPL, NSLOT_C = BATCH * CAPC;
constexpr int NSLOT = (NSLOT_L + NSLOT_C + 255) / 256 * 256;
constexpr int NCHUNK = TOK / CHUNK, ML_CH = BATCH * ML_HEADS * 2, GD_CH = BATCH * GD_HEADS * 2, RW_CH = BATCH * RW_HEADS * 2;
constexpr float NORM_EPS = 1e-6f, RW_GN_EPS = 64e-5f, RW_DECAY_SCALE = 0.6065306597126334f;
static_assert(ML_HEADS == GD_HEADS, "heads");

typedef unsigned short u16;

#ifdef CPU_TEST
#include <cmath>
#include <cstdint>
#include <cstring>
#define HD inline
#else
#define HD __device__ __forceinline__
#endif

struct Params {
    const float *x, *c, *ctx, *c_ctx, *ada_w, *ada_b, *norm1_g, *norm2_g, *w_in, *w_out;
    const float *rw_mu, *rw_w0, *rw_w_up, *rw_a0, *rw_a_up, *rw_g_up, *rw_k_k, *rw_k_a, *rw_r_k, *rw_ln_w, *rw_ln_b;
    const float *ml_ib, *ml_fb, *ml_norm_g, *gd_conv, *gd_a_log, *gd_dt_bias, *gd_norm_g, *at_q_norm, *at_k_norm;
    const float *w_router, *w_exp1, *w_exp3, *w_exp2, *final_g;
    float* out;
    unsigned* bar;
    float *modp, *mod;
    u16 *wt_in, *wt_out, *w13t, *w2t;
    float* xres;
    u16* h;
    float* P;
    float *rw_r, *rw_k, *rw_v, *rw_lr, *rw_kk, *rw_g, *rw_ew, *rw_kka, *rw_kt, *rw_y;
    float *rw_Ma, *rw_T, *rw_Psi, *rw_Y0; u16 *rw_PhiT, *rw_Rh, *rw_W;
    float *ml_bcum, *ml_g, *ml_gmax, *ml_bl, *ml_gm, *ml_min, *ml_dcv, *ml_dC, *ml_dn, *ml_S, *ml_hh;
    float *gd_q, *gd_k, *gd_v, *gd_gc, *gd_beta, *gd_A, *gd_T, *gd_Psi, *gd_O0, *gd_o; u16 *gd_Phi, *gd_Qh;
    u16 *at_q, *at_k, *at_v;
    u16* mix;
    float* aff; int* inv;
    int* sel_row; float* sel_gate;
    u16 *xs, *hid; float* yexp;
};

struct Exec { int gid, ngroups, gl; };

template <int G> HD float group_sum(float v) {
#ifndef CPU_TEST
#pragma unroll
    for (int o = G / 2; o > 0; o >>= 1) v += __shfl_xor(v, o, 64);
#endif
    return v;
}
template <int G> HD float group_max(float v) {
#ifndef CPU_TEST
#pragma unroll
    for (int o = G / 2; o > 0; o >>= 1) v = fmaxf(v, __shfl_xor(v, o, 64));
#endif
    return v;
}

template <int G> HD float group_scan_sum(float v, int gl) {
#ifndef CPU_TEST
#pragma unroll
    for (int o = 1; o < G; o <<= 1) { const float t = __shfl_up(v, o, G); if (gl >= o) v += t; }
#endif
    (void)gl; return v;
}
template <int G> HD float group_scan_max(float v, int gl) {
#ifndef CPU_TEST
#pragma unroll
    for (int o = 1; o < G; o <<= 1) { const float t = __shfl_up(v, o, G); if (gl >= o) v = fmaxf(v, t); }
#endif
    (void)gl; return v;
}
template <int G> HD float group_last(float v) {
#ifndef CPU_TEST
    v = __shfl(v, G - 1, G);
#endif
    return v;
}

HD u16 f2bf(float f) { unsigned u; memcpy(&u, &f, 4); u += 0x7FFFu + ((u >> 16) & 1u); return (u16)(u >> 16); }
HD float bf2f(u16 b) { unsigned u = ((unsigned)b) << 16; float f; memcpy(&f, &u, 4); return f; }
HD float sigmoidf_(float x) { return 1.f / (1.f + expf(-x)); }
HD float siluf_(float x) { return x / (1.f + expf(-x)); }
HD float softplusf_(float x) { return x > 20.f ? x : log1pf(expf(x)); }
HD float logsigmoidf_(float x) { return x < 0.f ? x - log1pf(expf(x)) : -log1pf(expf(-x)); }

HD float bf_round(float f) { return bf2f(f2bf(f)); }
#ifndef CPU_TEST
typedef short mma_bf16x8 __attribute__((ext_vector_type(8)));
typedef float mma_f32x16 __attribute__((ext_vector_type(16)));
__device__ __forceinline__ unsigned mma_cvt_pk(float lo, float hi) { unsigned r; asm volatile("v_cvt_pk_bf16_f32 %0, %1, %2" : "=v"(r) : "v"(lo), "v"(hi)); return r; }
#endif
struct Frag {
#ifdef CPU_TEST
    float v[8];
    HD void ld_bf(const u16* p) { for (int j = 0; j < 8; ++j) v[j] = bf2f(p[j]); }
    HD void ld_f(const float* p) { for (int j = 0; j < 8; ++j) v[j] = bf_round(p[j]); }
    HD void ld_f_scaled(const float* p, float w) { for (int j = 0; j < 8; ++j) v[j] = bf_round(p[j] * w); }
    HD void set1(float x) { for (int j = 0; j < 8; ++j) v[j] = bf_round(x); }
    HD void neg() { for (int j = 0; j < 8; ++j) v[j] = -v[j]; }
#else
    typedef unsigned u4 __attribute__((ext_vector_type(4)));
    typedef float f4 __attribute__((ext_vector_type(4)));
    u4 raw;
    HD void ld_bf(const u16* p) { raw = *(const u4*)p; }
    HD void ld_f(const float* p) { const f4 a = *(const f4*)p, b = *(const f4*)(p + 4);
        raw.x = mma_cvt_pk(a.x, a.y); raw.y = mma_cvt_pk(a.z, a.w); raw.z = mma_cvt_pk(b.x, b.y); raw.w = mma_cvt_pk(b.z, b.w); }
    HD void ld_f_scaled(const float* p, float w) { const f4 a = *(const f4*)p * w, b = *(const f4*)(p + 4) * w;
        raw.x = mma_cvt_pk(a.x, a.y); raw.y = mma_cvt_pk(a.z, a.w); raw.z = mma_cvt_pk(b.x, b.y); raw.w = mma_cvt_pk(b.z, b.w); }
    HD void set1(float x) { const unsigned q = mma_cvt_pk(x, x); raw.x = q; raw.y = q; raw.z = q; raw.w = q; }
    HD void neg() { raw.x ^= 0x80008000u; raw.y ^= 0x80008000u; raw.z ^= 0x80008000u; raw.w ^= 0x80008000u; }
#endif
};
#ifdef CPU_TEST
constexpr int MMA_SLOTS = 1024;
#else
constexpr int MMA_SLOTS = 16;
#endif
template <int K, class FA, class FB, class FE> HD void wave_mma32(int lane, FA fa, FB fb, FE fe) {
    static_assert(K % 16 == 0, "K");
#ifdef CPU_TEST
    (void)lane;
    for (int m = 0; m < 32; ++m) for (int n = 0; n < 32; ++n) { float acc = 0.f;
        for (int k0 = 0; k0 < K; k0 += 8) { Frag a8, b8; fa(m, k0, a8); fb(n, k0, b8);
            for (int j = 0; j < 8; ++j) acc += a8.v[j] * b8.v[j]; }
        fe(m, n, acc, m * 32 + n); }
#else
    const int r = lane & 31, h = lane >> 5;
    mma_f32x16 acc;
#pragma unroll
    for (int q = 0; q < 16; ++q) acc[q] = 0.f;
#pragma unroll
    for (int k0 = 0; k0 < K; k0 += 16) { Frag a8, b8; fa(r, k0 + 8 * h, a8); fb(r, k0 + 8 * h, b8);
        acc = __builtin_amdgcn_mfma_f32_32x32x16_bf16(__builtin_bit_cast(mma_bf16x8, a8.raw), __builtin_bit_cast(mma_bf16x8, b8.raw), acc, 0, 0, 0); }
#pragma unroll
    for (int q = 0; q < 16; ++q) fe((q & 3) + 8 * (q >> 2) + 4 * h, r, acc[q], q);
#endif
}

#ifndef CPU_TEST
typedef unsigned pfv4 __attribute__((ext_vector_type(4)));
template <int NQ> HD void pf_ld_lin(pfv4 (&r)[NQ], const void* src, int tid) {
#pragma unroll
    for (int q = 0; q < NQ; ++q) r[q] = ((const pfv4*)src)[tid + q * 512]; }
template <int NQ> HD void pf_ld_rows(pfv4 (&r)[NQ], const float* src, int per_row, int row_stride, int tid) {
#pragma unroll
    for (int q = 0; q < NQ; ++q) { const int i = tid + q * 512; r[q] = *(const pfv4*)(src + (size_t)(i / per_row) * row_stride + (i % per_row) * 4); } }
template <int NQ> HD void pf_st_lin(const pfv4 (&r)[NQ], void* dst, int tid) {
#pragma unroll
    for (int q = 0; q < NQ; ++q) ((pfv4*)dst)[tid + q * 512] = r[q]; }
template <int NQ> HD void pf_st_pad(const pfv4 (&r)[NQ], u16* dst, int per_row, int ld, int tid) {
#pragma unroll
    for (int q = 0; q < NQ; ++q) { const int i = tid + q * 512; *(pfv4*)(dst + (i / per_row) * ld + (i % per_row) * 8) = r[q]; } }
#endif
#ifdef CPU_TEST
#define BLOCK_SYNC()
#define BLOCK_FOR(i, n) for (int i = 0; i < (n); ++i)
#define WAVE_FOR(w, n) for (int w = 0; w < (n); ++w)
#define LANE 0
#define OPAQUE_TID()
#else
#define BLOCK_SYNC() __syncthreads()
#define BLOCK_FOR(i, n) for (int i = tid; i < (n); i += nthr)
#define WAVE_FOR(w, n) _Pragma("unroll 1") for (int w = tid >> 6; w < (n); w += (nthr >> 6))
#define LANE (tid & 63)
#define OPAQUE_TID() asm volatile("" : "+v"(tid))
#endif

HD int row_b(int R) { return R / TOK; }
HD int row_s(int R) { return R % TOK; }
HD bool row_ctx(int R) { return row_s(R) < CTX; }
HD int mod_sel(int R) { return row_ctx(R) ? 2 : row_b(R); }
HD int seq_s(int d, int p) { return d == 0 ? p : (p < CTX ? CTX - 1 - p : TOK - 1 - (p - CTX)); }
HD const float* modv(const Params& p, int layer, int sel, int k) { return p.mod + ((size_t)(layer * 3 + sel) * 6 + k) * D_MODEL; }

constexpr int MOD_KS = 16;
HD void ph_mod_partial(const Params& p, Exec e) {
    const int n = DEPTH * MOD_KS * 6 * D_MODEL;
    for (int it = e.gid; it < n; it += e.ngroups) {
        const int col = it % (6 * D_MODEL), ks = (it / (6 * D_MODEL)) % MOD_KS, l = it / (6 * D_MODEL * MOD_KS);
        const float* w = p.ada_w + (size_t)l * D_MODEL * 6 * D_MODEL + col;
        float a0 = 0.f, a1 = 0.f, a2 = 0.f;
        const int k0 = ks * (D_MODEL / MOD_KS);
        for (int k = k0; k < k0 + D_MODEL / MOD_KS; ++k) {
            const float wv = w[(size_t)k * 6 * D_MODEL];
            a0 += siluf_(p.c[k]) * wv; a1 += siluf_(p.c[D_MODEL + k]) * wv; a2 += siluf_(p.c_ctx[k]) * wv;
        }
        float* o = p.modp + ((size_t)(l * MOD_KS + ks) * 3) * 6 * D_MODEL + col;
        o[0] = a0; o[6 * D_MODEL] = a1; o[2 * 6 * D_MODEL] = a2;
    }
}
HD void ph_mod_final(const Params& p, Exec e) {
    const int n = DEPTH * 3 * 6 * D_MODEL;
    for (int it = e.gid; it < n; it += e.ngroups) {
        const int col = it % (6 * D_MODEL), sel = (it / (6 * D_MODEL)) % 3, l = it / (6 * D_MODEL * 3);
        float a = p.ada_b[l * 6 * D_MODEL + col];
        for (int ks = 0; ks < MOD_KS; ++ks) a += p.modp[((size_t)(l * MOD_KS + ks) * 3 + sel) * 6 * D_MODEL + col];
        p.mod[(size_t)(l * 3 + sel) * 6 * D_MODEL + col] = a;
    }
}

HD float resid_in(const Params& p, int layer, int R, int c) {
    if (layer == 0) { const int b = row_b(R), s = row_s(R);
        return s < CTX ? p.ctx[((size_t)b * CTX + s) * D_MODEL + c] : p.x[((size_t)b * SEQ + (s - CTX)) * D_MODEL + c]; }
    float v = p.xres[(size_t)R * D_MODEL + c];
    const float m5 = modv(p, layer - 1, mod_sel(R), 5)[c];
    float acc = 0.f;
    for (int ex = 0; ex < NE; ++ex) { const int j = p.inv[(size_t)R * NE + ex]; if (j >= 0) acc += p.yexp[((size_t)ex * NSLOT + j) * D_MODEL + c]; }
    return v + m5 * acc;
}
template <int G> HD void ph_norm1(const Params& p, int layer, Exec e) {
    for (int R = e.gid; R < MROWS; R += e.ngroups) {
        float ss = 0.f;
        for (int c = e.gl; c < D_MODEL; c += G) { const float v = resid_in(p, layer, R, c); p.xres[(size_t)R * D_MODEL + c] = v; ss += v * v; }
        ss = group_sum<G>(ss);
        const float rstd = 1.f / sqrtf(ss / D_MODEL + NORM_EPS);
        const int sel = mod_sel(R); const float *m0 = modv(p, layer, sel, 0), *m1 = modv(p, layer, sel, 1), *g = p.norm1_g + layer * D_MODEL;
        for (int c = e.gl; c < D_MODEL; c += G) { const float v = p.xres[(size_t)R * D_MODEL + c];
            p.h[(size_t)R * D_MODEL + c] = f2bf(v * rstd * g[c] * (1.f + m1[c]) + m0[c]); }
    }
}
template <int G> HD void ph_final(const Params& p, Exec e) {
    for (int i = e.gid; i < BATCH * SEQ; i += e.ngroups) {
        const int b = i / SEQ, t = i % SEQ, R = b * TOK + CTX + t;
        float ss = 0.f;
        for (int c = e.gl; c < D_MODEL; c += G) { const float v = resid_in(p, DEPTH, R, c); ss += v * v; }
        ss = group_sum<G>(ss);
        const float rstd = 1.f / sqrtf(ss / D_MODEL + NORM_EPS);
        for (int c = e.gl; c < D_MODEL; c += G) p.out[(size_t)i * D_MODEL + c] = resid_in(p, DEPTH, R, c) * rstd * p.final_g[c];
    }
}
template <int G> HD void ph_norm2(const Params& p, int layer, Exec e) {
    const bool last = layer == DEPTH - 1;
    for (int R = e.gid; R < MROWS; R += e.ngroups) {
        if (last && row_ctx(R)) continue;
        float ss = 0.f;
        for (int c = e.gl; c < D_MODEL; c += G) { const float v = p.xres[(size_t)R * D_MODEL + c]; ss += v * v; }
        ss = group_sum<G>(ss);
        const float rstd = 1.f / sqrtf(ss / D_MODEL + NORM_EPS);
        const int sel = mod_sel(R); const float *m3 = modv(p, layer, sel, 3), *m4 = modv(p, layer, sel, 4), *g = p.norm2_g + layer * D_MODEL;
        const float* wr = p.w_router + (size_t)layer * D_MODEL * NE;
        float lg[NE];
#pragma unroll
        for (int ex = 0; ex < NE; ++ex) lg[ex] = 0.f;
        for (int c = e.gl; c < D_MODEL; c += G) { const float v = p.xres[(size_t)R * D_MODEL + c];
            const float hv = v * rstd * g[c] * (1.f + m4[c]) + m3[c];
            p.h[(size_t)R * D_MODEL + c] = f2bf(hv);
#pragma unroll
            for (int ex = 0; ex < NE; ++ex) lg[ex] += hv * wr[c * NE + ex]; }
        float mx = -1e30f;
#pragma unroll
        for (int ex = 0; ex < NE; ++ex) { lg[ex] = group_sum<G>(lg[ex]); mx = fmaxf(mx, lg[ex]); }
        float sum = 0.f;
#pragma unroll
        for (int ex = 0; ex < NE; ++ex) { lg[ex] = expf(lg[ex] - mx); sum += lg[ex]; }
        if (e.gl == 0) {
#pragma unroll
            for (int ex = 0; ex < NE; ++ex) p.aff[(size_t)R * NE + ex] = lg[ex] / sum; }
    }
}
constexpr int TK_PART = 512, TK_PARTS = (SEQ + TK_PART - 1) / TK_PART, TK_SMEM = (SEQ > CTX ? SEQ : CTX) * 4;
HD int topk_units(int layer) { return BATCH * NE * TK_PARTS + (layer == DEPTH - 1 ? 0 : BATCH * NE) + 1; }
HD void ph_topk_unit(const Params& p, int layer, int unit, int tid, int nthr, unsigned char* smem) {
    (void)tid; (void)nthr; OPAQUE_TID();
    const bool last = layer == DEPTH - 1;
    const int nl = BATCH * NE * TK_PARTS, nc = last ? 0 : BATCH * NE;
    float* col = (float*)smem;
    if (unit >= nl + nc) {
        const int per = NSLOT - NSLOT_L - (last ? 0 : NSLOT_C);
        BLOCK_FOR(q, NE * per) { const int ex = q / per, j = NSLOT - per + q % per; p.sel_row[ex * NSLOT + j] = 0; p.sel_gate[ex * NSLOT + j] = 0.f; }
        return; }
    int b, ex, L, base, cap, jbase, t0, t1;
    if (unit < nl) { const int part = unit % TK_PARTS; ex = (unit / TK_PARTS) % NE; b = unit / (TK_PARTS * NE); L = SEQ; base = b * TOK + CTX; cap = CAPL; jbase = b * CAPL;
        t0 = part * TK_PART; t1 = t0 + TK_PART < SEQ ? t0 + TK_PART : SEQ; }
    else { const int q = unit - nl; ex = q % NE; b = q / NE; L = CTX; base = b * TOK; cap = CAPC; jbase = NSLOT_L + b * CAPC; t0 = 0; t1 = CTX; }
    BLOCK_FOR(u, L) col[u] = p.aff[(size_t)(base + u) * NE + ex];
    BLOCK_SYNC();
    BLOCK_FOR(q, t1 - t0) { const int t = t0 + q; const float a = col[t]; int rank = 0;
        for (int u = 0; u < L; ++u) { const float au = col[u]; rank += (au > a || (au == a && u < t)) ? 1 : 0; }
        if (rank < cap) { const int j = jbase + rank; p.sel_row[ex * NSLOT + j] = base + t; p.sel_gate[ex * NSLOT + j] = a; p.inv[(size_t)(base + t) * NE + ex] = j; }
        else p.inv[(size_t)(base + t) * NE + ex] = -1; }
    BLOCK_SYNC();
}
template <int G> HD void ph_gather(const Params& p, int layer, Exec e) {
    const bool last = layer == DEPTH - 1;
    const int nj = last ? NSLOT_L : NSLOT;
    for (int it = e.gid; it < NE * nj; it += e.ngroups) {
        const int ex = it / nj, j = it % nj, R = p.sel_row[ex * NSLOT + j];
        const uint4* s = (const uint4*)(p.h + (size_t)R * D_MODEL); uint4* d = (uint4*)(p.xs + ((size_t)ex * NSLOT + j) * D_MODEL);
        for (int c = e.gl; c < D_MODEL / 8; c += G) d[c] = s[c];
    }
}

template <int G> HD void ph_rw_prep1(const Params& p, int layer, Exec e) {
    const float* mu = p.rw_mu + (size_t)layer * 2 * RW_COLS;
    for (int R = e.gid; R < MROWS; R += e.ngroups) {
        const int s = row_s(R); const bool hp = (s != 0 && s != CTX), hn = (s != CTX - 1 && s != TOK - 1);
        const float* pr = p.P + (size_t)R * LDP + RW_OFF;
        for (int c = e.gl; c < RW_COLS; c += G) {
            const float v = pr[c], pv = hp ? pr[c - LDP] : 0.f, nv = hn ? pr[c + LDP] : 0.f;
            const float pp = v + mu[c] * (pv - v) + mu[RW_COLS + c] * (nv - v);
            if (c < GROUP_W) p.rw_r[(size_t)R * GROUP_W + c] = pp;
            else if (c < 2 * GROUP_W) p.rw_k[(size_t)R * GROUP_W + c - GROUP_W] = pp;
            else if (c < 3 * GROUP_W) p.rw_v[(size_t)R * GROUP_W + c - 2 * GROUP_W] = pp;
            else { const int q = c - 3 * GROUP_W; float o;
                if (q < RW_DR) o = tanhf(pp); else if (q < RW_DR + RW_IR) o = pp; else o = sigmoidf_(pp);
                p.rw_lr[(size_t)R * RW_LR + q] = o; }
        }
        const float* kk_w = p.rw_k_k + layer * GROUP_W;
        for (int hh = 0; hh < RW_HEADS; ++hh) { float ss = 0.f;
            for (int j = hh * RW_HEAD + e.gl; j < (hh + 1) * RW_HEAD; j += G) { const float xk = p.rw_k[(size_t)R * GROUP_W + j] * kk_w[j]; ss += xk * xk; }
            ss = group_sum<G>(ss); const float rn = 1.f / sqrtf(ss + 1e-6f);
            for (int j = hh * RW_HEAD + e.gl; j < (hh + 1) * RW_HEAD; j += G) p.rw_kk[(size_t)R * GROUP_W + j] = p.rw_k[(size_t)R * GROUP_W + j] * kk_w[j] * rn; }
    }
}
constexpr int RW_WK = 2 * RW_DR + 2 * RW_IR + RW_GR;
static_assert(RW_DR % 16 == 0 && RW_IR % 16 == 0 && RW_GR % 16 == 0, "low-rank K");
HD void ph_rw_wpack(const Params& p, Exec e) {
    for (int it = e.gid; it < DEPTH * GROUP_W * RW_WK; it += e.ngroups) {
        const int kk = it % RW_WK, j = (it / RW_WK) % GROUP_W, l = it / (RW_WK * GROUP_W); float v;
        if (kk < 2 * RW_DR) { const int d = kk / RW_DR, i = kk % RW_DR; v = p.rw_w_up[((size_t)(l * 2 + d) * RW_DR + i) * GROUP_W + j]; }
        else if (kk < 2 * RW_DR + 2 * RW_IR) { const int q = kk - 2 * RW_DR, d = q / RW_IR, i = q % RW_IR; v = p.rw_a_up[((size_t)(l * 2 + d) * RW_IR + i) * GROUP_W + j]; }
        else { const int i = kk - 2 * RW_DR - 2 * RW_IR; v = p.rw_g_up[((size_t)l * RW_GR + i) * GROUP_W + j]; }
        p.rw_W[it] = f2bf(v);
    }
}
HD void ph_rw_prep2(const Params& p, int layer, Exec e) {
    static_assert(MROWS % 32 == 0 && GROUP_W % 32 == 0, "tiles");
    const float* ka_w = p.rw_k_a + layer * GROUP_W;
    for (int it = e.gid; it < (MROWS / 32) * (GROUP_W / 32); it += e.ngroups) {
        const int tm = it / (GROUP_W / 32), tn = it % (GROUP_W / 32);
        const u16* W = p.rw_W + ((size_t)layer * GROUP_W + tn * 32) * RW_WK; const float* A = p.rw_lr + (size_t)tm * 32 * RW_LR;
        float st[4][MMA_SLOTS];
#define RWP2_PROD(K_, AOFF, WOFF, ...) wave_mma32<K_>(e.gl, [&](int m, int k0, Frag& o) { o.ld_f(A + (size_t)m * RW_LR + (AOFF) + k0); }, \
                                                       [&](int nn, int k0, Frag& o) { o.ld_bf(W + (size_t)nn * RW_WK + (WOFF) + k0); }, __VA_ARGS__)
        RWP2_PROD(RW_DR, 0, 0, [&](int, int, float acc, int sl) { st[0][sl] = acc; });
        RWP2_PROD(RW_DR, 0, RW_DR, [&](int, int, float acc, int sl) { st[1][sl] = acc; });
        RWP2_PROD(RW_IR, RW_DR, 2 * RW_DR, [&](int, int, float acc, int sl) { st[2][sl] = acc; });
        RWP2_PROD(RW_IR, RW_DR, 2 * RW_DR + RW_IR, [&](int, int, float acc, int sl) { st[3][sl] = acc; });
        RWP2_PROD(RW_GR, RW_DR + RW_IR, 2 * RW_DR + 2 * RW_IR, [&](int m, int nn, float acc, int sl) {
            const int R = tm * 32 + m, j = tn * 32 + nn; const size_t o = (size_t)R * GROUP_W + j;
            p.rw_g[o] = acc;
            const float kv = p.rw_k[o], kkv = p.rw_kk[o];
            _Pragma("unroll") for (int d = 0; d < 2; ++d) { const float wl = p.rw_w0[(layer * 2 + d) * GROUP_W + j] + st[d][sl], al = p.rw_a0[(layer * 2 + d) * GROUP_W + j] + st[2 + d][sl];
                const float logw = -RW_DECAY_SCALE * sigmoidf_(wl), a = sigmoidf_(al); const size_t o2 = (size_t)d * MROWS * GROUP_W + o;
                p.rw_ew[o2] = logw; p.rw_kka[o2] = kkv * a; p.rw_kt[o2] = kv * (1.f + (a - 1.f) * ka_w[j]); } });
#undef RWP2_PROD
    }
}
template <int G> HD void ph_rw_scan(const Params& p, Exec e) {
    constexpr int KPL = RW_HEAD / G;
    for (int it = e.gid; it < RW_CH * RW_HEAD; it += e.ngroups) {
        const int i = it % RW_HEAD, ch = it / RW_HEAD, d = ch % 2, hh = (ch / 2) % RW_HEADS, b = ch / (2 * RW_HEADS);
        float S[KPL];
#pragma unroll
        for (int q = 0; q < KPL; ++q) S[q] = 0.f;
        const int k0 = hh * RW_HEAD + e.gl * KPL;
        for (int pos = 0; pos < TOK; ++pos) {
            const int R = b * TOK + seq_s(d, pos);
            const size_t o1 = (size_t)R * GROUP_W + k0, o2 = ((size_t)d * MROWS + R) * GROUP_W + k0;
            const float vv = p.rw_v[(size_t)R * GROUP_W + hh * RW_HEAD + i];
            float sk = 0.f;
#pragma unroll
            for (int q = 0; q < KPL; ++q) sk += S[q] * p.rw_kk[o1 + q];
            sk = group_sum<G>(sk);
            float y = 0.f;
#pragma unroll
            for (int q = 0; q < KPL; ++q) { S[q] = S[q] * p.rw_ew[o2 + q] - sk * p.rw_kka[o2 + q] + vv * p.rw_kt[o2 + q]; y += S[q] * p.rw_r[o1 + q]; }
            y = group_sum<G>(y);
            if (e.gl == 0) p.rw_y[((size_t)d * MROWS + R) * GROUP_W + hh * RW_HEAD + i] = y;
        }
    }
}

constexpr int RW_N = RW_HEAD, RW_CN = RW_CH * NCHUNK;
constexpr int LDPAD = 8;
static_assert(CHUNK % 32 == 0 && RW_HEAD % 32 == 0, "tile sizes");
HD void rw_chain(int ch, int& b, int& hh, int& d) { d = ch % 2; hh = (ch / 2) % RW_HEADS; b = ch / (2 * RW_HEADS); }
constexpr int RW_C1_SMEM = CHUNK * RW_N * 4 + 2 * CHUNK * (RW_N + LDPAD) * 2;
HD void ph_rw_c1_unit(const Params& p, int cn, int tid, int nthr, unsigned char* smem) {
    (void)tid; (void)nthr; OPAQUE_TID();
    constexpr int C = CHUNK, N = RW_N, LD = N + LDPAD;
    const int ch = cn / NCHUNK, n = cn % NCHUNK; int b, hh, d; rw_chain(ch, b, hh, d);
    float* cum = (float*)smem; u16* KKt = (u16*)(cum + C * N); u16* At = KKt + C * LD;
    const size_t dofs = (size_t)d * MROWS * GROUP_W;
    BLOCK_FOR(idx, C * N) { const int t = idx / N, k = idx % N, R = b * TOK + seq_s(d, n * C + t); cum[idx] = p.rw_ew[dofs + (size_t)R * GROUP_W + hh * N + k]; }
    BLOCK_SYNC();
    BLOCK_FOR(k, N) { float acc = 0.f; for (int t = 0; t < C; ++t) { acc += cum[t * N + k]; cum[t * N + k] = acc; } }
    BLOCK_SYNC();
    BLOCK_FOR(idx, C * N) { const int t = idx / N, k = idx % N, R = b * TOK + seq_s(d, n * C + t); const size_t o = (size_t)R * GROUP_W + hh * N + k;
        const float cu = cum[idx], cp = cu - p.rw_ew[dofs + o];
        KKt[t * LD + k] = f2bf(p.rw_kk[o] * expf(cp)); At[t * LD + k] = f2bf(p.rw_kka[dofs + o] * expf(-cu)); }
    BLOCK_SYNC();
    float* Ma = p.rw_Ma + (size_t)cn * C * C;
    WAVE_FOR(w, (C / 32) * (C / 32)) { const int tm = w / (C / 32), tn = w % (C / 32);
        wave_mma32<N>(LANE, [&](int m, int k0, Frag& o) { o.ld_bf(KKt + (tm * 32 + m) * LD + k0); },
                            [&](int nn, int k0, Frag& o) { o.ld_bf(At + (tn * 32 + nn) * LD + k0); },
                            [&](int m, int nn, float acc, int) { const int t = tm * 32 + m, sx = tn * 32 + nn; Ma[t * C + sx] = sx < t ? acc : 0.f; }); }
    BLOCK_SYNC();
}
constexpr int TS_G = 8, TS_SMEM = TS_G * CHUNK * CHUNK * 4;
HD void ph_tsolve_unit(const float* Mall, float* Tall, int nprob, int unit, int tid, int nthr, unsigned char* smem) {
    (void)tid; (void)nthr; OPAQUE_TID();
    constexpr int C = CHUNK;
    float* Tl = (float*)smem;
    const int p0 = unit * TS_G, np = (nprob - p0) < TS_G ? (nprob - p0) : TS_G;
    BLOCK_FOR(i, np * C * C / 4) ((uint4*)Tl)[i] = ((const uint4*)(Mall + (size_t)p0 * C * C))[i];
    BLOCK_SYNC();
    BLOCK_FOR(idx, TS_G * C) { const int w = idx / C, j = idx % C;
        if (w < np) { float* Tc = Tl + w * C * C;
            for (int t = 0; t < C; ++t) { float acc = 0.f;
                if (t == j) acc = 1.f;
                else if (t > j) { for (int sx = j; sx < t; ++sx) acc -= Tc[t * C + sx] * Tc[sx * C + j]; }
                Tc[t * C + j] = acc; } } }
    BLOCK_SYNC();
    BLOCK_FOR(i, np * C * C / 4) ((uint4*)(Tall + (size_t)p0 * C * C))[i] = ((const uint4*)Tl)[i];
    BLOCK_SYNC();
}
constexpr int RW_C3_SMEM = 2 * CHUNK * (RW_N + LDPAD) * 2 + 13 * CHUNK * (RW_N + LDPAD) * 2 + RW_N * 4;
HD void ph_rw_c3_unit(const Params& p, int cn, int tid, int nthr, unsigned char* smem) {
    (void)tid; (void)nthr; OPAQUE_TID();
    constexpr int C = CHUNK, N = RW_N, CN = C * N, LD = N + LDPAD, CL = C * LD;
    static_assert(2 * CL * 2 >= CN * 4, "cum region");
    static_assert(C == N, "c3 buffer aliasing assumes C == N");
    const int ch = cn / NCHUNK, n = cn % NCHUNK; int b, hh, d; rw_chain(ch, b, hh, d);
    float* cum = (float*)smem; u16* mb = (u16*)smem + 2 * CL;
    u16 *KKt = mb, *KKtT = mb + CL, *At = mb + 2 * CL, *KTt = mb + 3 * CL, *Rt = mb + 4 * CL, *ApT = mb + 5 * CL, *KTpT = mb + 6 * CL, *VT = mb + 7 * CL,
        *Tb = mb + 8 * CL, *MkT = mb + 9 * CL, *ZT = mb + 10 * CL, *Na = mb + 11 * CL, *Nk = mb + 12 * CL;
    float* PC = (float*)(mb + 13 * CL);
    u16 *Gm = (u16*)cum, *KKhT = (u16*)cum + CL;
    const size_t dofs = (size_t)d * MROWS * GROUP_W;
    BLOCK_FOR(idx, C * N) { const int t = idx / N, k = idx % N, R = b * TOK + seq_s(d, n * C + t); cum[idx] = p.rw_ew[dofs + (size_t)R * GROUP_W + hh * N + k]; }
    BLOCK_SYNC();
    BLOCK_FOR(k, N) { float acc = 0.f; for (int t = 0; t < C; ++t) { acc += cum[t * N + k]; cum[t * N + k] = acc; } PC[k] = expf(acc); }
    BLOCK_SYNC();
    BLOCK_FOR(idx, CN) { const int t = idx / N, k = idx % N, R = b * TOK + seq_s(d, n * C + t); const size_t o = (size_t)R * GROUP_W + hh * N + k;
        const float cu = cum[idx], cp = cu - p.rw_ew[dofs + o], cC = cum[(C - 1) * N + k];
        const float kkv = p.rw_kk[o], kav = p.rw_kka[dofs + o], ktv = p.rw_kt[dofs + o];
        const float e_m = expf(-cu), e_c = expf(cC - cu);
        const u16 kkt = f2bf(kkv * expf(cp));
        KKt[t * LD + k] = kkt; KKtT[k * LD + t] = kkt; At[t * LD + k] = f2bf(kav * e_m); KTt[t * LD + k] = f2bf(ktv * e_m); Rt[t * LD + k] = f2bf(p.rw_r[o] * expf(cu));
        ApT[k * LD + t] = f2bf(kav * e_c); KTpT[k * LD + t] = f2bf(ktv * e_c); VT[k * LD + t] = f2bf(p.rw_v[o]); }
    BLOCK_FOR(idx, C * C) Tb[(idx / C) * LD + idx % C] = f2bf(p.rw_T[(size_t)cn * C * C + idx]);
    BLOCK_SYNC();
    constexpr int TC = C / 32, TN = N / 32;
    WAVE_FOR(w, 3 * TC * TC) { const int which = w / (TC * TC), tm = (w / TC) % TC, tn = w % TC;
        const u16* Am = which == 0 ? KTt : Rt; const u16* Bm = which == 0 ? KKt : (which == 1 ? At : KTt); u16* Om = which == 0 ? MkT : (which == 1 ? Na : Nk);
        wave_mma32<N>(LANE, [&](int m, int k0, Frag& o) { o.ld_bf(Am + (tm * 32 + m) * LD + k0); },
                            [&](int nn, int k0, Frag& o) { o.ld_bf(Bm + (tn * 32 + nn) * LD + k0); },
                            [&](int m, int nn, float acc, int) { const int r = tm * 32 + m, cc = tn * 32 + nn; const bool keep = which == 0 ? (cc > r) : (cc <= r);
                                Om[r * LD + cc] = f2bf(keep ? acc : 0.f); }); }
    BLOCK_SYNC();
    WAVE_FOR(w, TC * TC + TN * TC) {
        if (w < TC * TC) { const int tm = w / TC, tn = w % TC;
            wave_mma32<C>(LANE, [&](int m, int k0, Frag& o) { o.ld_bf(Tb + (tm * 32 + m) * LD + k0); },
                                [&](int nn, int k0, Frag& o) { o.ld_bf(MkT + (tn * 32 + nn) * LD + k0); },
                                [&](int m, int nn, float acc, int) { Gm[(tm * 32 + m) * LD + tn * 32 + nn] = f2bf(acc); }); }
        else { const int q = w - TC * TC, tm = q / TC, tn = q % TC;
            wave_mma32<C>(LANE, [&](int m, int k0, Frag& o) { o.ld_bf(KKtT + (tm * 32 + m) * LD + k0); },
                                [&](int nn, int k0, Frag& o) { o.ld_bf(Tb + (tn * 32 + nn) * LD + k0); },
                                [&](int m, int nn, float acc, int) { KKhT[(tm * 32 + m) * LD + tn * 32 + nn] = f2bf(acc); }); } }
    BLOCK_SYNC();
    u16* RhG = p.rw_Rh + (size_t)cn * CN; u16* PhiTG = p.rw_PhiT + (size_t)cn * N * N;
    WAVE_FOR(w, TN * TC + TC * TN + TN * TN) {
        if (w < TN * TC) { const int tm = w / TC, tn = w % TC;
            wave_mma32<C>(LANE, [&](int m, int k0, Frag& o) { o.ld_bf(VT + (tm * 32 + m) * LD + k0); },
                                [&](int nn, int k0, Frag& o) { o.ld_bf(Gm + (tn * 32 + nn) * LD + k0); },
                                [&](int m, int nn, float acc, int) { ZT[(tm * 32 + m) * LD + tn * 32 + nn] = f2bf(acc); }); }
        else if (w < TN * TC + TC * TN) { const int q = w - TN * TC, tm = q / TN, tn = q % TN;
            wave_mma32<C>(LANE, [&](int m, int k0, Frag& o) { o.ld_bf(Na + (tm * 32 + m) * LD + k0); },
                                [&](int nn, int k0, Frag& o) { o.ld_bf(KKhT + (tn * 32 + nn) * LD + k0); },
                                [&](int m, int nn, float acc, int) { const int t = tm * 32 + m, k = tn * 32 + nn; RhG[t * N + k] = f2bf(bf2f(Rt[t * LD + k]) - acc); }); }
        else { const int q = w - TN * TC - TC * TN, tm = q / TN, tn = q % TN;
            wave_mma32<C>(LANE, [&](int m, int k0, Frag& o) { o.ld_bf(ApT + (tm * 32 + m) * LD + k0); },
                                [&](int nn, int k0, Frag& o) { o.ld_bf(KKhT + (tn * 32 + nn) * LD + k0); },
                                [&](int m, int nn, float acc, int) { const int k = tm * 32 + m, k2 = tn * 32 + nn; PhiTG[k * N + k2] = f2bf((k == k2 ? PC[k] : 0.f) - acc); }); } }
    BLOCK_SYNC();
    float* Y0G = p.rw_Y0 + (size_t)cn * CN; float* PsiG = p.rw_Psi + (size_t)cn * N * N;
    WAVE_FOR(w, TC * TN + TN * TN) {
        if (w < TC * TN) { const int tm = w / TN, tn = w % TN;
            wave_mma32<2 * C>(LANE, [&](int m, int k0, Frag& o) { if (k0 < C) o.ld_bf(Nk + (tm * 32 + m) * LD + k0); else { o.ld_bf(Na + (tm * 32 + m) * LD + k0 - C); o.neg(); } },
                                    [&](int nn, int k0, Frag& o) { if (k0 < C) o.ld_bf(VT + (tn * 32 + nn) * LD + k0); else o.ld_bf(ZT + (tn * 32 + nn) * LD + k0 - C); },
                                    [&](int m, int nn, float acc, int) { Y0G[(tm * 32 + m) * N + tn * 32 + nn] = acc; }); }
        else { const int q = w - TC * TN, tm = q / TN, tn = q % TN;
            wave_mma32<2 * C>(LANE, [&](int m, int k0, Frag& o) { if (k0 < C) o.ld_bf(VT + (tm * 32 + m) * LD + k0); else { o.ld_bf(ZT + (tm * 32 + m) * LD + k0 - C); o.neg(); } },
                                    [&](int nn, int k0, Frag& o) { if (k0 < C) o.ld_bf(KTpT + (tn * 32 + nn) * LD + k0); else o.ld_bf(ApT + (tn * 32 + nn) * LD + k0 - C); },
                                    [&](int m, int nn, float acc, int) { PsiG[(tm * 32 + m) * N + tn * 32 + nn] = acc; }); } }
    BLOCK_SYNC();
}
constexpr int RW_S2_SMEM = (3 * RW_N + CHUNK) * (RW_N + LDPAD) * 2 + RW_N * RW_N * 4 + CHUNK * RW_N * 4;
HD void ph_rw_scan2_unit(const Params& p, int ch, int tid, int nthr, unsigned char* smem) {
    (void)tid; (void)nthr; OPAQUE_TID();
    constexpr int C = CHUNK, N = RW_N, TC = C / 32, TN = N / 32, LD = N + LDPAD;
    int b, hh, d; rw_chain(ch, b, hh, d);
    u16* Sb = (u16*)smem; u16* PhiT = Sb + 2 * N * LD; u16* Rh = PhiT + N * LD; float* Psi = (float*)(Rh + C * LD); float* Y0 = Psi + N * N;
    BLOCK_FOR(i, N * LD) Sb[i] = 0;
    auto tiles = [&](int n) {
        const u16* Sc = Sb + (n & 1) * N * LD; u16* Sn = Sb + ((n + 1) & 1) * N * LD;
        WAVE_FOR(w, TN * TN + TC * TN) {
            if (w < TN * TN) { const int tm = w / TN, tn = w % TN;
                wave_mma32<N>(LANE, [&](int m, int k0, Frag& o) { o.ld_bf(Sc + (tm * 32 + m) * LD + k0); },
                                    [&](int nn, int k0, Frag& o) { o.ld_bf(PhiT + (tn * 32 + nn) * LD + k0); },
                                    [&](int m, int nn, float acc, int) { const int i = tm * 32 + m, k = tn * 32 + nn; Sn[i * LD + k] = f2bf(acc + Psi[i * N + k]); }); }
            else { const int q = w - TN * TN, tm = q / TN, tn = q % TN;
                wave_mma32<N>(LANE, [&](int m, int k0, Frag& o) { o.ld_bf(Rh + (tm * 32 + m) * LD + k0); },
                                    [&](int nn, int k0, Frag& o) { o.ld_bf(Sc + (tn * 32 + nn) * LD + k0); },
                                    [&](int m, int nn, float acc, int) { const int t = tm * 32 + m, i = tn * 32 + nn, R = b * TOK + seq_s(d, n * C + t);
                                        p.rw_y[((size_t)d * MROWS + R) * GROUP_W + hh * N + i] = acc + Y0[t * N + i]; }); } } };
#ifdef CPU_TEST
    for (int n = 0; n < NCHUNK; ++n) { const int cn = ch * NCHUNK + n;
        BLOCK_FOR(i, N * N / 8) *(uint4*)(PhiT + (i / (N / 8)) * LD + (i % (N / 8)) * 8) = ((const uint4*)(p.rw_PhiT + (size_t)cn * N * N))[i];
        BLOCK_FOR(i, C * N / 8) *(uint4*)(Rh + (i / (N / 8)) * LD + (i % (N / 8)) * 8) = ((const uint4*)(p.rw_Rh + (size_t)cn * C * N))[i];
        BLOCK_FOR(i, N * N / 4) ((uint4*)Psi)[i] = ((const uint4*)(p.rw_Psi + (size_t)cn * N * N))[i];
        BLOCK_FOR(i, C * N / 4) ((uint4*)Y0)[i] = ((const uint4*)(p.rw_Y0 + (size_t)cn * C * N))[i];
        BLOCK_SYNC(); tiles(n); BLOCK_SYNC(); }
#else
    constexpr int NT = 512, Q_A = N * N / 8 / NT, Q_B = C * N / 8 / NT, Q_C = N * N / 4 / NT, Q_D = C * N / 4 / NT;
    static_assert(Q_A * NT * 8 == N * N && Q_B * NT * 8 == C * N && Q_C * NT * 4 == N * N && Q_D * NT * 4 == C * N && NCHUNK % 4 == 0, "prefetch split");
    pfv4 rA[4][Q_A], rB[4][Q_B], rC[4][Q_C], rD[4][Q_D];
#define RW_PF_LOAD(st, cn_) do { pf_ld_lin(rA[st], p.rw_PhiT + (size_t)(cn_) * N * N, tid); pf_ld_lin(rB[st], p.rw_Rh + (size_t)(cn_) * C * N, tid); \
    pf_ld_lin(rC[st], p.rw_Psi + (size_t)(cn_) * N * N, tid); pf_ld_lin(rD[st], p.rw_Y0 + (size_t)(cn_) * C * N, tid); } while (0)
#define RW_PF_STORE(st) do { pf_st_pad(rA[st], PhiT, N / 8, LD, tid); pf_st_pad(rB[st], Rh, N / 8, LD, tid); pf_st_lin(rC[st], Psi, tid); pf_st_lin(rD[st], Y0, tid); } while (0)
    const int cn0 = ch * NCHUNK;
    RW_PF_LOAD(0, cn0); RW_PF_LOAD(1, cn0 + 1); RW_PF_LOAD(2, cn0 + 2); RW_PF_LOAD(3, cn0 + 3); RW_PF_STORE(0);
    for (int n0 = 0; n0 < NCHUNK; n0 += 4) {
#pragma unroll
        for (int j = 0; j < 4; ++j) { const int n = n0 + j;
            BLOCK_SYNC();
            if (n + 4 < NCHUNK) RW_PF_LOAD(j, cn0 + n + 4);
            tiles(n);
            BLOCK_SYNC();
            if (n + 1 < NCHUNK) RW_PF_STORE((j + 1) & 3); } }
#undef RW_PF_LOAD
#undef RW_PF_STORE
#endif
}
template <int G> HD void ph_rw_post(const Params& p, int layer, Exec e) {
    static_assert(G <= RW_HEAD, "G");
    const float *lw = p.rw_ln_w + layer * GROUP_W, *lb = p.rw_ln_b + layer * GROUP_W, *rk = p.rw_r_k + layer * GROUP_W;
    for (int it = e.gid; it < MROWS * RW_HEADS; it += e.ngroups) {
        const int R = it / RW_HEADS, hh = it % RW_HEADS; const size_t o = (size_t)R * GROUP_W + hh * RW_HEAD, o2 = (size_t)MROWS * GROUP_W;
        float s1 = 0.f, bon = 0.f;
        for (int j = e.gl; j < RW_HEAD; j += G) { s1 += p.rw_y[o + j] + p.rw_y[o2 + o + j];
            bon += p.rw_r[o + j] * (p.rw_kt[o + j] + p.rw_kt[o2 + o + j]) * rk[hh * RW_HEAD + j]; }
        s1 = group_sum<G>(s1); bon = group_sum<G>(bon);
        const float mean = s1 / RW_HEAD;
        float s2 = 0.f;
        for (int j = e.gl; j < RW_HEAD; j += G) { const float dlt = p.rw_y[o + j] + p.rw_y[o2 + o + j] - mean; s2 += dlt * dlt; }
        s2 = group_sum<G>(s2);
        const float rstd = 1.f / sqrtf(s2 / RW_HEAD + RW_GN_EPS);
        for (int j = e.gl; j < RW_HEAD; j += G) { const float y = (p.rw_y[o + j] + p.rw_y[o2 + o + j] - mean) * rstd * lw[hh * RW_HEAD + j] + lb[hh * RW_HEAD + j];
            p.mix[(size_t)R * D_MODEL + hh * RW_HEAD + j] = f2bf((y + bon * p.rw_v[o + j]) * p.rw_g[o + j]); }
    }
}

HD void ml_chain(int ch, int& b, int& hh, int& d) { d = ch % 2; hh = (ch / 2) % ML_HEADS; b = ch / (2 * ML_HEADS); }
template <int G> HD void ph_ml_g1(const Params& p, int layer, Exec e) {
    for (int it = e.gid; it < ML_CH * NCHUNK; it += e.ngroups) {
        const int ch = it / NCHUNK, n = it % NCHUNK; int b, hh, d; ml_chain(ch, b, hh, d);
        const float ib = p.ml_ib[(layer * 2 + d) * ML_HEADS + hh], fb = p.ml_fb[(layer * 2 + d) * ML_HEADS + hh];
        float cb = 0.f, cm = -1e30f;
        for (int t0 = 0; t0 < CHUNK; t0 += G) { const int t = t0 + e.gl, pos = n * CHUNK + t, R = b * TOK + seq_s(d, pos);
            const float* g = p.P + (size_t)R * LDP + ML_OFF + 4 * GROUP_W;
            const float li = g[d * ML_HEADS + hh] + ib, lf = logsigmoidf_(g[(2 + d) * ML_HEADS + hh] + fb);
            const float bc = cb + group_scan_sum<G>(lf, e.gl), gv = li - bc, gm = fmaxf(cm, group_scan_max<G>(gv, e.gl));
            p.ml_bcum[(size_t)ch * TOK + pos] = bc; p.ml_g[(size_t)ch * TOK + pos] = gv; p.ml_gmax[(size_t)ch * TOK + pos] = gm;
            cb = group_last<G>(bc); cm = group_last<G>(gm); }
        if (e.gl == 0) { p.ml_bl[ch * NCHUNK + n] = cb; p.ml_gm[ch * NCHUNK + n] = cm; }
    }
}
HD void ph_ml_g2(const Params& p, Exec e) {
    for (int ch = e.gid; ch < ML_CH; ch += e.ngroups) { float m = 0.f;
        for (int n = 0; n < NCHUNK; ++n) { const float bl = p.ml_bl[ch * NCHUNK + n], mnew = bl + fmaxf(m, p.ml_gm[ch * NCHUNK + n]);
            p.ml_min[ch * NCHUNK + n] = m; p.ml_dcv[ch * NCHUNK + n] = expf(bl + m - mnew); m = mnew; } }
}
HD void ph_ml_prefix(const Params& p, Exec e) {
    const int n1 = ML_CH * ML_HEAD * ML_HEAD, n2 = ML_CH * ML_HEAD;
    for (int it = e.gid; it < n1 + n2; it += e.ngroups) {
        const bool isn = it >= n1; const int q = isn ? it - n1 : it, per = isn ? ML_HEAD : ML_HEAD * ML_HEAD, ch = q / per, el = q % per;
        float* arr = (isn ? p.ml_dn : p.ml_dC) + (size_t)ch * NCHUNK * per + el; const float* dcv = p.ml_dcv + ch * NCHUNK; float st = 0.f;
        for (int n = 0; n < NCHUNK; n += 4) { float inc[4], dc[4];
#pragma unroll
            for (int j = 0; j < 4; ++j) if (n + j < NCHUNK) { inc[j] = arr[(size_t)(n + j) * per]; dc[j] = dcv[n + j]; }
#pragma unroll
            for (int j = 0; j < 4; ++j) if (n + j < NCHUNK) { arr[(size_t)(n + j) * per] = st; st = dc[j] * st + inc[j]; } }
    }
}

constexpr int ML_N = ML_HEAD, ML_CN = ML_CH * NCHUNK;
static_assert(ML_HEAD % 32 == 0, "tile");
constexpr int ML_C1_SMEM = 2 * ML_N * (CHUNK + LDPAD) * 2 + 4 * CHUNK * 4;
HD void ph_ml_c1_unit(const Params& p, int cn, int tid, int nthr, unsigned char* smem) {
    (void)tid; (void)nthr; OPAQUE_TID();
    constexpr int C = CHUNK, N = ML_N, TC = C / 32, TN = N / 32, LD = C + LDPAD;
    const float ksc = 1.f / sqrtf((float)ML_HEAD);
    const int ch = cn / NCHUNK, n = cn % NCHUNK; int b, hh, d; ml_chain(ch, b, hh, d);
    u16* VwT = (u16*)smem; u16* KT = VwT + N * LD; float* wk = (float*)(KT + N * LD); float* btv = wk + C; float* gv = btv + C; float* mtv = gv + C;
    const float min_ = p.ml_min[cn], bl = p.ml_bl[cn], mnew = bl + fmaxf(min_, p.ml_gm[cn]);
    BLOCK_FOR(sx, C) { const size_t o = (size_t)ch * TOK + n * C + sx; const float g = p.ml_g[o], bt = p.ml_bcum[o];
        wk[sx] = expf(bl + g - mnew); btv[sx] = bt; gv[sx] = g; mtv[sx] = bt + fmaxf(min_, p.ml_gmax[o]); }
    BLOCK_SYNC();
    BLOCK_FOR(idx, C * N) { const int sx = idx / N, dd = idx % N, R = b * TOK + seq_s(d, n * C + sx); const float* pr = p.P + (size_t)R * LDP + ML_OFF + hh * N;
        VwT[dd * LD + sx] = f2bf(wk[sx] * pr[2 * GROUP_W + dd]); KT[dd * LD + sx] = f2bf(pr[GROUP_W + dd] * ksc); }
    BLOCK_SYNC();
    WAVE_FOR(w, TN * TN + TN + TC * TC) {
        if (w < TN * TN) { const int tm = w / TN, tn = w % TN;
            wave_mma32<C>(LANE, [&](int m, int k0, Frag& o) { o.ld_bf(VwT + (tm * 32 + m) * LD + k0); },
                                [&](int nn, int k0, Frag& o) { o.ld_bf(KT + (tn * 32 + nn) * LD + k0); },
                                [&](int m, int nn, float acc, int) { p.ml_dC[((size_t)cn * N + tm * 32 + m) * N + tn * 32 + nn] = acc; }); }
        else if (w < TN * TN + TN) { const int tn = w - TN * TN;
            wave_mma32<C>(LANE, [&](int m, int k0, Frag& o) { if (m == 0) o.ld_f(wk + k0); else o.set1(0.f); },
                                [&](int nn, int k0, Frag& o) { o.ld_bf(KT + (tn * 32 + nn) * LD + k0); },
                                [&](int m, int nn, float acc, int) { if (m == 0) p.ml_dn[(size_t)cn * N + tn * 32 + nn] = acc; }); }
        else { const int q = w - TN * TN - TN, tm = q / TC, tn = q % TC;
            wave_mma32<N>(LANE, [&](int m, int k0, Frag& o) { const int R = b * TOK + seq_s(d, n * C + tm * 32 + m); o.ld_f(p.P + (size_t)R * LDP + ML_OFF + hh * N + k0); },
                                [&](int nn, int k0, Frag& o) { const int R = b * TOK + seq_s(d, n * C + tn * 32 + nn); o.ld_f(p.P + (size_t)R * LDP + ML_OFF + GROUP_W + hh * N + k0); },
                                [&](int m, int nn, float acc, int) { const int t = tm * 32 + m, sx = tn * 32 + nn;
                                    p.ml_S[((size_t)cn * C + t) * C + sx] = sx <= t ? acc * ksc * expf(btv[t] + gv[sx] - mtv[t]) : 0.f; }); } }
    BLOCK_SYNC();
}
constexpr int ML_C2_SMEM = ML_N * (CHUNK + LDPAD) * 2 + 3 * CHUNK * 4;
HD void ph_ml_c2_unit(const Params& p, int cn, int tid, int nthr, unsigned char* smem) {
    (void)tid; (void)nthr; OPAQUE_TID();
    constexpr int C = CHUNK, N = ML_N, TC = C / 32, TN = N / 32, LD = C + LDPAD;
    const int ch = cn / NCHUNK, n = cn % NCHUNK; int b, hh, d; ml_chain(ch, b, hh, d);
    u16* VT = (u16*)smem; float* wi = (float*)(VT + N * LD); float* den = wi + C; float* emt = den + C;
    const float min_ = p.ml_min[cn];
    BLOCK_FOR(t, C) { const size_t o = (size_t)ch * TOK + n * C + t; const float bt = p.ml_bcum[o], mt = bt + fmaxf(min_, p.ml_gmax[o]);
        wi[t] = expf(bt + min_ - mt); emt[t] = expf(-mt); }
    BLOCK_FOR(idx, C * N) { const int sx = idx / N, dd = idx % N, R = b * TOK + seq_s(d, n * C + sx);
        VT[dd * LD + sx] = f2bf(p.P[(size_t)R * LDP + ML_OFF + 2 * GROUP_W + hh * N + dd]); }
    BLOCK_SYNC();
    WAVE_FOR(w, TC) { const int tm = w;
        wave_mma32<C + N>(LANE, [&](int m, int k0, Frag& o) { const int t = tm * 32 + m;
                                    if (k0 < C) o.ld_f(p.ml_S + ((size_t)cn * C + t) * C + k0);
                                    else { const int R = b * TOK + seq_s(d, n * C + t); o.ld_f_scaled(p.P + (size_t)R * LDP + ML_OFF + hh * N + k0 - C, wi[t]); } },
                                [&](int nn, int k0, Frag& o) { if (nn != 0) o.set1(0.f); else if (k0 < C) o.set1(1.f); else o.ld_f(p.ml_dn + (size_t)cn * N + k0 - C); },
                                [&](int m, int nn, float acc, int) { if (nn == 0) den[tm * 32 + m] = acc; }); }
    BLOCK_SYNC();
    WAVE_FOR(w, TC * TN) { const int tm = w / TN, tn = w % TN;
        wave_mma32<C + N>(LANE, [&](int m, int k0, Frag& o) { const int t = tm * 32 + m;
                                    if (k0 < C) o.ld_f(p.ml_S + ((size_t)cn * C + t) * C + k0);
                                    else { const int R = b * TOK + seq_s(d, n * C + t); o.ld_f_scaled(p.P + (size_t)R * LDP + ML_OFF + hh * N + k0 - C, wi[t]); } },
                                [&](int nn, int k0, Frag& o) { const int ee = tn * 32 + nn;
                                    if (k0 < C) o.ld_bf(VT + ee * LD + k0); else o.ld_f(p.ml_dC + ((size_t)cn * N + ee) * N + k0 - C); },
                                [&](int m, int nn, float acc, int) { const int t = tm * 32 + m, ee = tn * 32 + nn, R = b * TOK + seq_s(d, n * C + t);
                                    p.ml_hh[((size_t)d * MROWS + R) * GROUP_W + hh * N + ee] = acc / fmaxf(fabsf(den[t]), emt[t]); }); }
    BLOCK_SYNC();
}
template <int G> HD void ph_ml_post(const Params& p, int layer, Exec e) {
    const float* ng = p.ml_norm_g + layer * GROUP_W;
    for (int it = e.gid; it < MROWS * ML_HEADS; it += e.ngroups) {
        const int R = it / ML_HEADS, hh = it % ML_HEADS; const size_t o = (size_t)R * GROUP_W + hh * ML_HEAD, o2 = (size_t)MROWS * GROUP_W;
        float s1 = 0.f;
        for (int j = e.gl; j < ML_HEAD; j += G) s1 += p.ml_hh[o + j] + p.ml_hh[o2 + o + j];
        s1 = group_sum<G>(s1); const float mean = s1 / ML_HEAD;
        float s2 = 0.f;
        for (int j = e.gl; j < ML_HEAD; j += G) { const float dlt = p.ml_hh[o + j] + p.ml_hh[o2 + o + j] - mean; s2 += dlt * dlt; }
        s2 = group_sum<G>(s2); const float rstd = 1.f / sqrtf(s2 / ML_HEAD + NORM_EPS);
        for (int j = e.gl; j < ML_HEAD; j += G) { const float y = (p.ml_hh[o + j] + p.ml_hh[o2 + o + j] - mean) * rstd * ng[hh * ML_HEAD + j];
            const float og = p.P[(size_t)R * LDP + ML_OFF + 3 * GROUP_W + hh * ML_HEAD + j];
            p.mix[(size_t)R * D_MODEL + GROUP_W + hh * ML_HEAD + j] = f2bf(y * sigmoidf_(og)); }
    }
}

HD float gd_conv_silu(const Params& p, int layer, int R, int c) {
    const int s = row_s(R); const float* pr = p.P + (size_t)R * LDP + GD_OFF + c; const float* cw = p.gd_conv + (size_t)layer * 3 * 3 * GROUP_W + c;
    float v = pr[0] * cw[3 * GROUP_W];
    if (s != 0 && s != CTX) v += pr[-LDP] * cw[0];
    if (s != CTX - 1 && s != TOK - 1) v += pr[LDP] * cw[2 * 3 * GROUP_W];
    return siluf_(v);
}
template <int G> HD void ph_gd_prep(const Params& p, int layer, Exec e) {
    const float qsc = 1.f / sqrtf((float)GD_HEAD);
    constexpr int NI = GD_HEAD / G;
    for (int it = e.gid; it < MROWS * GD_HEADS; it += e.ngroups) {
        const int R = it / GD_HEADS, hh = it % GD_HEADS;
        float xq[NI], xk[NI], xv[NI]; float sq = 0.f, sk = 0.f;
#pragma unroll
        for (int i = 0; i < NI; ++i) { const int j = hh * GD_HEAD + e.gl + G * i;
            xq[i] = gd_conv_silu(p, layer, R, j); xk[i] = gd_conv_silu(p, layer, R, GROUP_W + j); xv[i] = gd_conv_silu(p, layer, R, 2 * GROUP_W + j);
            sq += xq[i] * xq[i]; sk += xk[i] * xk[i]; }
        sq = group_sum<G>(sq); sk = group_sum<G>(sk);
        const float rq = qsc / sqrtf(sq + 1e-6f), rk = 1.f / sqrtf(sk + 1e-6f);
#pragma unroll
        for (int i = 0; i < NI; ++i) { const size_t o = (size_t)R * GROUP_W + hh * GD_HEAD + e.gl + G * i;
            p.gd_q[o] = xq[i] * rq; p.gd_k[o] = xk[i] * rk; p.gd_v[o] = xv[i]; }
    }
}
template <int G> HD void ph_gd_gates(const Params& p, int layer, Exec e) {
    for (int it = e.gid; it < GD_CH * NCHUNK; it += e.ngroups) {
        const int ch = it / NCHUNK, n = it % NCHUNK; int b, hh, d; ml_chain(ch, b, hh, d);
        const float al = expf(p.gd_a_log[(layer * 2 + d) * GD_HEADS + hh]), dtb = p.gd_dt_bias[(layer * 2 + d) * GD_HEADS + hh];
        float cg = 0.f;
        for (int t0 = 0; t0 < CHUNK; t0 += G) { const int t = t0 + e.gl, pos = n * CHUNK + t, R = b * TOK + seq_s(d, pos);
            const float* g = p.P + (size_t)R * LDP + GD_OFF + 4 * GROUP_W;
            const float gc = cg + group_scan_sum<G>(-al * softplusf_(g[d * GD_HEADS + hh] + dtb), e.gl);
            p.gd_gc[(size_t)ch * TOK + pos] = gc; p.gd_beta[(size_t)ch * TOK + pos] = sigmoidf_(g[(2 + d) * GD_HEADS + hh]);
            cg = group_last<G>(gc); }
    }
}

constexpr int GD_N = GD_HEAD, GD_CN = GD_CH * NCHUNK;
static_assert(GD_HEAD % 32 == 0, "tile");
HD void ph_gd_c1(const Params& p, Exec e) {
    constexpr int C = CHUNK, N = GD_N, TC = C / 32;
    for (int it = e.gid; it < GD_CN * TC * TC; it += e.ngroups) {
        const int cn = it / (TC * TC), tm = (it / TC) % TC, tn = it % TC, ch = cn / NCHUNK, n = cn % NCHUNK; int b, hh, d; ml_chain(ch, b, hh, d);
        wave_mma32<N>(e.gl, [&](int m, int k0, Frag& o) { const int R = b * TOK + seq_s(d, n * C + tm * 32 + m); o.ld_f(p.gd_k + (size_t)R * GROUP_W + hh * N + k0); },
                            [&](int nn, int k0, Frag& o) { const int R = b * TOK + seq_s(d, n * C + tn * 32 + nn); o.ld_f(p.gd_k + (size_t)R * GROUP_W + hh * N + k0); },
                            [&](int m, int nn, float acc, int) { const int i = tm * 32 + m, j = tn * 32 + nn; const size_t o = (size_t)ch * TOK + n * C;
                                p.gd_A[((size_t)cn * C + i) * C + j] = j < i ? p.gd_beta[o + i] * acc * expf(p.gd_gc[o + i] - p.gd_gc[o + j]) : 0.f; });
    }
}
constexpr int GD_C3_SMEM = (5 * GD_N + 2 * CHUNK) * (CHUNK + LDPAD) * 2 + 2 * CHUNK * 4;
HD void ph_gd_c3_unit(const Params& p, int cn, int tid, int nthr, unsigned char* smem) {
    (void)tid; (void)nthr; OPAQUE_TID();
    constexpr int C = CHUNK, N = GD_N, TC = C / 32, TN = N / 32, LD = C + LDPAD;
    const int ch = cn / NCHUNK, n = cn % NCHUNK; int b, hh, d; ml_chain(ch, b, hh, d);
    u16 *KbT = (u16*)smem, *VbT = KbT + N * LD, *KdT = VbT + N * LD, *uT = KdT + N * LD, *wT = uT + N * LD, *Tb = wT + N * LD, *attn = Tb + C * LD;
    float* gcs = (float*)(attn + C * LD); float* bet = gcs + C;
    BLOCK_FOR(t, C) { const size_t o = (size_t)ch * TOK + n * C + t; gcs[t] = p.gd_gc[o]; bet[t] = p.gd_beta[o]; }
    BLOCK_SYNC();
    BLOCK_FOR(idx, C * N) { const int t = idx / N, dd = idx % N, R = b * TOK + seq_s(d, n * C + t); const size_t o = (size_t)R * GROUP_W + hh * N + dd;
        const float kv = p.gd_k[o], vv = p.gd_v[o];
        KbT[dd * LD + t] = f2bf(kv * bet[t] * expf(gcs[t])); VbT[dd * LD + t] = f2bf(vv * bet[t]); KdT[dd * LD + t] = f2bf(kv * expf(gcs[C - 1] - gcs[t])); }
    BLOCK_FOR(idx, C * C) Tb[(idx / C) * LD + idx % C] = f2bf(p.gd_T[(size_t)cn * C * C + idx]);
    BLOCK_SYNC();
    WAVE_FOR(w, TC * TC + 2 * TN * TC) {
        if (w < TC * TC) { const int tm = w / TC, tn = w % TC;
            wave_mma32<N>(LANE, [&](int m, int k0, Frag& o) { const int R = b * TOK + seq_s(d, n * C + tm * 32 + m); o.ld_f(p.gd_q + (size_t)R * GROUP_W + hh * N + k0); },
                                [&](int nn, int k0, Frag& o) { const int R = b * TOK + seq_s(d, n * C + tn * 32 + nn); o.ld_f(p.gd_k + (size_t)R * GROUP_W + hh * N + k0); },
                                [&](int m, int nn, float acc, int) { const int i = tm * 32 + m, j = tn * 32 + nn; attn[i * LD + j] = f2bf(j <= i ? acc * expf(gcs[i] - gcs[j]) : 0.f); }); }
        else { const int q = w - TC * TC, which = q / (TN * TC), tm = (q / TC) % TN, tn = q % TC;
            const u16* Am = which ? KbT : VbT; u16* Om = which ? wT : uT;
            wave_mma32<C>(LANE, [&](int m, int k0, Frag& o) { o.ld_bf(Am + (tm * 32 + m) * LD + k0); },
                                [&](int nn, int k0, Frag& o) { o.ld_bf(Tb + (tn * 32 + nn) * LD + k0); },
                                [&](int m, int nn, float acc, int) { Om[(tm * 32 + m) * LD + tn * 32 + nn] = f2bf(acc); }); } }
    BLOCK_SYNC();
    WAVE_FOR(w, 2 * TC * TN + 2 * TN * TN) {
        if (w < 2 * TC * TN) { const int which = w / (TC * TN), tm = (w / TN) % TC, tn = w % TN;
            const u16* Bm = which ? uT : wT;
            wave_mma32<C>(LANE, [&](int m, int k0, Frag& o) { o.ld_bf(attn + (tm * 32 + m) * LD + k0); },
                                [&](int nn, int k0, Frag& o) { o.ld_bf(Bm + (tn * 32 + nn) * LD + k0); },
                                [&](int m, int nn, float acc, int) { const int i = tm * 32 + m, dd = tn * 32 + nn;
                                    if (which) p.gd_O0[((size_t)cn * C + i) * N + dd] = acc;
                                    else { const int R = b * TOK + seq_s(d, n * C + i); p.gd_Qh[((size_t)cn * C + i) * N + dd] = f2bf(p.gd_q[(size_t)R * GROUP_W + hh * N + dd] * expf(gcs[i]) - acc); } }); }
        else { const int q = w - 2 * TC * TN, which = q / (TN * TN), tm = (q / TN) % TN, tn = q % TN;
            const u16* Bm = which ? uT : wT;
            wave_mma32<C>(LANE, [&](int m, int k0, Frag& o) { o.ld_bf(KdT + (tm * 32 + m) * LD + k0); },
                                [&](int nn, int k0, Frag& o) { o.ld_bf(Bm + (tn * 32 + nn) * LD + k0); },
                                [&](int m, int nn, float acc, int) { const int d1 = tm * 32 + m, d2 = tn * 32 + nn;
                                    if (which) p.gd_Psi[((size_t)cn * N + d1) * N + d2] = acc;
                                    else p.gd_Phi[((size_t)cn * N + d1) * N + d2] = f2bf((d1 == d2 ? expf(gcs[C - 1]) : 0.f) - acc); }); } }
    BLOCK_SYNC();
}
constexpr int GD_EB = 32, GD_S2_UNITS = GD_CH * (GD_N / GD_EB);
constexpr int GD_S2_SMEM = (2 * GD_EB + GD_N + CHUNK) * (GD_N + LDPAD) * 2 + (GD_N * GD_EB + CHUNK * GD_EB) * 4;
HD void ph_gd_scan2_unit(const Params& p, int unit, int tid, int nthr, unsigned char* smem) {
    (void)tid; (void)nthr; OPAQUE_TID();
    constexpr int C = CHUNK, N = GD_N, EB = GD_EB, LD = N + LDPAD;
    const int eb = unit % (N / EB), ch = unit / (N / EB), e0 = eb * EB; int b, hh, d; ml_chain(ch, b, hh, d);
    u16* ST = (u16*)smem; u16* Phi = ST + 2 * EB * LD; u16* Qh = Phi + N * LD; float* Psi = (float*)(Qh + C * LD); float* O0 = Psi + N * EB;
    BLOCK_FOR(i, EB * LD) ST[i] = 0;
    auto tiles = [&](int n) {
        const u16* Sc = ST + (n & 1) * EB * LD; u16* Sn = ST + ((n + 1) & 1) * EB * LD;
        WAVE_FOR(w, N / 32 + C / 32) {
            if (w < N / 32) { const int tm = w;
                wave_mma32<N>(LANE, [&](int m, int k0, Frag& o) { o.ld_bf(Phi + (tm * 32 + m) * LD + k0); },
                                    [&](int nn, int k0, Frag& o) { o.ld_bf(Sc + nn * LD + k0); },
                                    [&](int m, int nn, float acc, int) { const int d1 = tm * 32 + m; Sn[nn * LD + d1] = f2bf(acc + Psi[d1 * EB + nn]); }); }
            else { const int tm = w - N / 32;
                wave_mma32<N>(LANE, [&](int m, int k0, Frag& o) { o.ld_bf(Qh + (tm * 32 + m) * LD + k0); },
                                    [&](int nn, int k0, Frag& o) { o.ld_bf(Sc + nn * LD + k0); },
                                    [&](int m, int nn, float acc, int) { const int t = tm * 32 + m, R = b * TOK + seq_s(d, n * C + t);
                                        p.gd_o[((size_t)d * MROWS + R) * GROUP_W + hh * N + e0 + nn] = acc + O0[t * EB + nn]; }); } } };
#ifdef CPU_TEST
    for (int n = 0; n < NCHUNK; ++n) { const int cn = ch * NCHUNK + n;
        BLOCK_FOR(i, N * N / 8) *(uint4*)(Phi + (i / (N / 8)) * LD + (i % (N / 8)) * 8) = ((const uint4*)(p.gd_Phi + (size_t)cn * N * N))[i];
        BLOCK_FOR(i, C * N / 8) *(uint4*)(Qh + (i / (N / 8)) * LD + (i % (N / 8)) * 8) = ((const uint4*)(p.gd_Qh + (size_t)cn * C * N))[i];
        BLOCK_FOR(i, N * EB / 4) ((uint4*)Psi)[i] = *(const uint4*)(p.gd_Psi + ((size_t)cn * N + i / (EB / 4)) * N + e0 + (i % (EB / 4)) * 4);
        BLOCK_FOR(i, C * EB / 4) ((uint4*)O0)[i] = *(const uint4*)(p.gd_O0 + ((size_t)cn * C + i / (EB / 4)) * N + e0 + (i % (EB / 4)) * 4);
        BLOCK_SYNC(); tiles(n); BLOCK_SYNC(); }
#else
    constexpr int NT = 512, Q_PHI = N * N / 8 / NT, Q_QH = C * N / 8 / NT, Q_PSI = N * EB / 4 / NT, Q_O0 = C * EB / 4 / NT;
    static_assert(Q_PHI * NT * 8 == N * N && Q_QH * NT * 8 == C * N && Q_PSI * NT * 4 == N * EB && Q_O0 * NT * 4 == C * EB && NCHUNK % 4 == 0, "prefetch split");
    pfv4 rA[4][Q_PHI], rB[4][Q_QH], rC[4][Q_PSI], rD[4][Q_O0];
#define GD_PF_LOAD(st, cn_) do { pf_ld_lin(rA[st], p.gd_Phi + (size_t)(cn_) * N * N, tid); pf_ld_lin(rB[st], p.gd_Qh + (size_t)(cn_) * C * N, tid); \
    pf_ld_rows(rC[st], p.gd_Psi + (size_t)(cn_) * N * N + e0, EB / 4, N, tid); pf_ld_rows(rD[st], p.gd_O0 + (size_t)(cn_) * C * N + e0, EB / 4, N, tid); } while (0)
#define GD_PF_STORE(st) do { pf_st_pad(rA[st], Phi, N / 8, LD, tid); pf_st_pad(rB[st], Qh, N / 8, LD, tid); pf_st_lin(rC[st], Psi, tid); pf_st_lin(rD[st], O0, tid); } while (0)
    const int cn0 = ch * NCHUNK;
    GD_PF_LOAD(0, cn0); GD_PF_LOAD(1, cn0 + 1); GD_PF_LOAD(2, cn0 + 2); GD_PF_LOAD(3, cn0 + 3); GD_PF_STORE(0);
    for (int n0 = 0; n0 < NCHUNK; n0 += 4) {
#pragma unroll
        for (int j = 0; j < 4; ++j) { const int n = n0 + j;
            BLOCK_SYNC();
            if (n + 4 < NCHUNK) GD_PF_LOAD(j, cn0 + n + 4);
            tiles(n);
            BLOCK_SYNC();
            if (n + 1 < NCHUNK) GD_PF_STORE((j + 1) & 3); } }
#undef GD_PF_LOAD
#undef GD_PF_STORE
#endif
}
template <int G> HD void ph_gd_post(const Params& p, int layer, Exec e) {
    const float* ng = p.gd_norm_g + layer * GD_HEAD;
    for (int it = e.gid; it < MROWS * GD_HEADS; it += e.ngroups) {
        const int R = it / GD_HEADS, hh = it % GD_HEADS; const size_t o = (size_t)R * GROUP_W + hh * GD_HEAD, o2 = (size_t)MROWS * GROUP_W;
        float ss = 0.f;
        for (int j = e.gl; j < GD_HEAD; j += G) { const float v = p.gd_o[o + j] + p.gd_o[o2 + o + j]; ss += v * v; }
        ss = group_sum<G>(ss); const float rstd = 1.f / sqrtf(ss / GD_HEAD + NORM_EPS);
        for (int j = e.gl; j < GD_HEAD; j += G) { const float v = (p.gd_o[o + j] + p.gd_o[o2 + o + j]) * rstd * ng[j];
            const float g = p.P[(size_t)R * LDP + GD_OFF + 3 * GROUP_W + hh * GD_HEAD + j];
            p.mix[(size_t)R * D_MODEL + 2 * GROUP_W + hh * GD_HEAD + j] = f2bf(v * siluf_(g)); }
    }
}

template <int G> HD void ph_at_prep(const Params& p, int layer, Exec e) {
    constexpr int NHS = AT_QH + 2 * AT_KVH, HALF = AT_HEAD / 2, QTR = AT_HEAD / 4;
    for (int it = e.gid; it < MROWS * NHS; it += e.ngroups) {
        const int R = it / NHS, hs = it % NHS, b = row_b(R), s = row_s(R);
        const float* pr = p.P + (size_t)R * LDP + AT_OFF + hs * AT_HEAD;
        u16* dst; const float* g = nullptr;
        if (hs < AT_QH) { dst = p.at_q + (((size_t)b * AT_QH + hs) * TOK + s) * AT_HEAD; g = p.at_q_norm + layer * AT_HEAD; }
        else if (hs < AT_QH + AT_KVH) { dst = p.at_k + (((size_t)b * AT_KVH + hs - AT_QH) * TOK + s) * AT_HEAD; g = p.at_k_norm + layer * AT_HEAD; }
        else dst = p.at_v + (((size_t)b * AT_KVH + hs - AT_QH - AT_KVH) * TOK + s) * AT_HEAD;
        if (!g) { for (int j = e.gl; j < AT_HEAD; j += G) dst[j] = f2bf(pr[j]); continue; }
        float ss = 0.f;
        for (int j = e.gl; j < AT_HEAD; j += G) ss += pr[j] * pr[j];
        ss = group_sum<G>(ss); const float rstd = 1.f / sqrtf(ss / AT_HEAD + NORM_EPS);
        if (s < CTX) { for (int j = e.gl; j < AT_HEAD; j += G) dst[j] = f2bf(pr[j] * rstd * g[j]); continue; }
        const int t = s - CTX; const float posr = (float)(t / GRID_W), posc = (float)(t % GRID_W);
        for (int j = e.gl; j < AT_HEAD; j += G) {
            const int half = j / HALF, jj = j % HALF, fi = jj % QTR; const bool second = jj >= QTR;
            const float ang = (half ? posc : posr) * exp2f(-(float)(2 * fi) * (13.287712379549449f / (float)HALF));
            float cs, sn; sincosf(ang, &sn, &cs);
            const int jp = second ? j - QTR : j + QTR;
            const float own = pr[j] * rstd * g[j], oth = pr[jp] * rstd * g[jp];
            dst[j] = f2bf(second ? own * cs + oth * sn : own * cs - oth * sn);
        }
    }
}

#include <cstdio>
#include <cstddef>
static_assert(D_MODEL == 2048 && CTX == 256 && SEQ % 256 == 0 && AT_HEAD == 128, "GPU part is written for the full configuration");
static_assert(RW_C3_SMEM <= 147392 && TS_SMEM <= 147392 && RW_S2_SMEM <= 147392 && RW_C1_SMEM <= 147392 && GD_C3_SMEM <= 147392 && GD_S2_SMEM <= 147392 && ML_C1_SMEM <= 147392 && ML_C2_SMEM <= 147392, "LDS");
static_assert(CHUNK == RW_N && GD_N * CHUNK * 2 == CHUNK * CHUNK * 4, "buffer aliasing (Y0 on Ma, Qh on A)");

#define XB_TMO      128
#define XB_XCNT(j)  (256  + 64 * (j))
#define XB_XSUB(j)  (1280 + 64 * (j))
#define XB_XGEN(j)  (2304 + 64 * (j))
#define XB_TOP      3328
#define XB_TOPGEN   3392
#define XCD_BAR_WORDS 3456
#define XB_SPIN_CAP (1u << 24)
#define LAS __attribute__((address_space(3)))
__device__ __forceinline__ unsigned xb_ld(unsigned* p)              { return __hip_atomic_load(p, __ATOMIC_RELAXED, __HIP_MEMORY_SCOPE_AGENT); }
__device__ __forceinline__ unsigned xb_add(unsigned* p, unsigned v) { return __hip_atomic_fetch_add(p, v, __ATOMIC_RELAXED, __HIP_MEMORY_SCOPE_AGENT); }
__device__ __forceinline__ unsigned xb_xcc_id() { return (unsigned)__builtin_amdgcn_s_getreg((3 << 11) | 20) & 0xFu; }
#define XB_SPIN(cond, bar) do { unsigned _sp = 0; while (cond) { __builtin_amdgcn_s_sleep(1); \
    if ((++_sp & 255u) == 0u) { if (xb_ld(&(bar)[XB_TMO])) break; if (_sp > XB_SPIN_CAP) { atomicAdd(&(bar)[XB_TMO], 1u); break; } } } } while (0)
struct XcdBarrier { unsigned* bar; unsigned x; volatile LAS unsigned* st; };
__device__ __forceinline__ XcdBarrier xcd_barrier_post(unsigned* bar, volatile LAS unsigned* st) {
    XcdBarrier b; b.bar = bar; b.x = xb_xcc_id(); b.st = st;
    if (threadIdx.x == 0) (void)xb_add(&bar[XB_XCNT(b.x)], 1u);
    return b;
}
__device__ __forceinline__ void xcd_barrier_complete(unsigned* bar, unsigned x, unsigned& nloc, unsigned& nx) {
    const unsigned G = gridDim.x * gridDim.y * gridDim.z;
    unsigned sum, cnt, mine, sp = 0u;
    for (;;) {
        sum = 0u; cnt = 0u; mine = 0u;
#pragma unroll
        for (unsigned j = 0; j < 16; ++j) { const unsigned c = xb_ld(&bar[XB_XCNT(j)]); sum += c; cnt += (c > 0u) ? 1u : 0u; mine = (j == x) ? c : mine; }
        if (sum == G) break;
        __builtin_amdgcn_s_sleep(1);
        if ((++sp & 255u) == 0u) { if (xb_ld(&bar[XB_TMO])) break; if (sp > XB_SPIN_CAP) { atomicAdd(&bar[XB_TMO], 1u); break; } }
    }
    nloc = mine > 0u ? mine : 1u; nx = cnt > 0u ? cnt : 1u;
}
__device__ __forceinline__ void xcd_barrier(const XcdBarrier& b) {
    asm volatile("s_waitcnt vmcnt(0)" ::: "memory");
    __syncthreads();
    if (threadIdx.x == 0) {
        unsigned* bar = b.bar;
        __builtin_amdgcn_s_waitcnt(0);
        unsigned nloc = b.st[0], nx = b.st[1];
        if (nloc == 0u) { xcd_barrier_complete(bar, b.x, nloc, nx); b.st[0] = nloc; b.st[1] = nx; }
        const unsigned old = xb_add(&bar[XB_XSUB(b.x)], 1u);
        const unsigned gen = old / nloc;
        if (old + 1u == (gen + 1u) * nloc) {
            __builtin_amdgcn_fence(__ATOMIC_RELEASE, "agent");
            asm volatile("s_waitcnt vmcnt(0)" ::: "memory");
            const unsigned og = xb_add(&bar[XB_TOP], 1u);
            const unsigned tg = og / nx;
            if (og + 1u == (tg + 1u) * nx) xb_add(&bar[XB_TOPGEN], 1u);
            else XB_SPIN(xb_ld(&bar[XB_TOPGEN]) == tg, bar);
            __builtin_amdgcn_fence(__ATOMIC_ACQUIRE, "agent");
            xb_add(&bar[XB_XGEN(b.x)], 1u);
            asm volatile("s_waitcnt vmcnt(0)" ::: "memory");
        } else {
            XB_SPIN(xb_ld(&bar[XB_XGEN(b.x)]) == gen, bar);
            __builtin_amdgcn_fence(__ATOMIC_ACQUIRE, "agent");
            asm volatile("s_waitcnt vmcnt(0)" ::: "memory");
        }
    }
    __syncthreads();
}

namespace pg8 {
#define PG8_LAS __attribute__((address_space(3)))
typedef unsigned short bf16_t;
typedef short bf16x8 __attribute__((ext_vector_type(8)));
typedef float f32x4 __attribute__((ext_vector_type(4)));
typedef unsigned u32x4 __attribute__((ext_vector_type(4)));
constexpr int BM = 256, BK = 64, HALF = 128, HTB = HALF * BK * 2  , STAGE_BYTES = 8 * HTB, NXCD = 8, WGM = 8;

__host__ __device__ __forceinline__ int lds_byte(int r, int c) { const int st = (r >> 4) * 2 + (c >> 5), rr = r & 15, cc = c & 31, ob = rr * 64 + cc * 2; return st * 1024 + (ob ^ (((ob >> 9) & 1) << 5)); }
__host__ __device__ __forceinline__ void stage_rc(int b, int& R, int& C) { const int st = b / 1024, sb = b % 1024, swz = sb ^ (((sb >> 9) & 1) << 5); R = (st >> 1) * 16 + swz / 64; C = (st & 1) * 32 + (swz % 64) / 2; }
__host__ __device__ __forceinline__ int perm32(int rho) { const int n = rho >> 4, i = rho & 15; return 8 * (i >> 2) + 4 * n + (i & 3); }

struct Unit { int pm, pn; };
struct Gemm { const bf16_t* A; const bf16_t* Bt; int M, N, K; };

struct StaticOrder {
    int nM, nN, nwg, G, c;
    __host__ __device__ void init(int M, int N, int G_, int c_) { nM = M / BM; nN = N / BM; nwg = nM * nN; G = G_; c = c_; }
    __host__ __device__ bool next(int i, Unit& u) const {
        const long L = (long)i * G + c; if (L >= nwg) return false;
        int wgid = (int)L; { const int q = nwg / NXCD, r = nwg % NXCD, xcd = wgid % NXCD, off = wgid / NXCD; wgid = (xcd < r ? xcd * (q + 1) : r * (q + 1) + (xcd - r) * q) + off; }
        const int nig = WGM * nN, gid = wgid / nig, fm = gid * WGM, gsz = (nM - fm) < WGM ? (nM - fm) : WGM;
        u.pm = fm + ((wgid % nig) % gsz); u.pn = (wgid % nig) / gsz; return true;
    }
    __device__ __forceinline__ void a_ready(const Unit&) const {}
    __device__ __forceinline__ void done(const Unit&) const {}
};
__device__ __forceinline__ unsigned cvt_pk_bf16(float lo, float hi) { unsigned r; asm volatile("v_cvt_pk_bf16_f32 %0, %1, %2" : "=v"(r) : "v"(lo), "v"(hi)); return r; }
typedef unsigned u32x2v __attribute__((ext_vector_type(2)));

struct TileOrder {
    int nI, nJ, nwg, G, c, latent_only;
    __device__ void init(int nI_, int nJ_, int G_, int c_, int lat) { nI = nI_; nJ = nJ_; nwg = nI * nJ; G = G_; c = c_; latent_only = lat; }
    __device__ bool next(int i, Unit& u) const { const long L = (long)i * G + c; if (L >= nwg) return false;
        const int ii = (int)(L % nI), j = (int)(L / nI); u.pm = latent_only ? (ii / (SEQ / 256)) * (TOK / 256) + 1 + ii % (SEQ / 256) : ii; u.pn = j; return true; }
    __device__ __forceinline__ void a_ready(const Unit&) const {}
    __device__ __forceinline__ void done(const Unit&) const {}
};
struct GroupedOrder {
    int nI, nJ, tilesA, nwg, G, c;
    __device__ void init(int nI_, int nJ_, int tilesA_, int G_, int c_) { nI = nI_; nJ = nJ_; tilesA = tilesA_; nwg = NE * nI * nJ; G = G_; c = c_; }
    __device__ bool next(int i, Unit& u) const { const long L = (long)i * G + c; if (L >= nwg) return false;
        const int e = (int)(L / (nI * nJ)), r = (int)(L % (nI * nJ)), j = r / nI, ii = r % nI; u.pm = e * tilesA + ii; u.pn = e * nJ + j; return true; }
    __device__ __forceinline__ void a_ready(const Unit&) const {}
    __device__ __forceinline__ void done(const Unit&) const {}
};

struct EpiF32 {
    static constexpr bool PERM = false, AFTER_DRAIN = false;
    float* C; int ldc;
    __device__ __forceinline__ void operator()(const f32x4 (&acc)[2][2][4][2], const Unit& u, int wr, int wc, int fr, int fq) const {
        const int row0 = u.pm * BM + wr * 64 + fr, col0 = u.pn * BM + wc * 32 + 4 * fq;
#pragma unroll
        for (int ai = 0; ai < 2; ++ai)
#pragma unroll
            for (int m = 0; m < 4; ++m) { float* rowp = C + (size_t)(row0 + ai * HALF + m * 16) * ldc + col0;
#pragma unroll
                for (int bj = 0; bj < 2; ++bj)
#pragma unroll
                    for (int n = 0; n < 2; ++n) *(f32x4*)(rowp + bj * HALF + n * 16) = acc[ai][bj][m][n]; }
    }
};
struct EpiResid {
    static constexpr bool PERM = false, AFTER_DRAIN = false;
    float* X; const float* modl;
    __device__ __forceinline__ void operator()(const f32x4 (&acc)[2][2][4][2], const Unit& u, int wr, int wc, int fr, int fq) const {
        const int row0 = u.pm * BM + wr * 64 + fr, col0 = u.pn * BM + wc * 32 + 4 * fq;
        const int tb = TOK / 256, sel = (u.pm % tb == 0) ? 2 : u.pm / tb;
        const float* gate = modl + ((size_t)sel * 6 + 2) * D_MODEL + col0;
        f32x4 gv[2][2];
#pragma unroll
        for (int bj = 0; bj < 2; ++bj)
#pragma unroll
            for (int n = 0; n < 2; ++n) gv[bj][n] = *(const f32x4*)(gate + bj * HALF + n * 16);
#pragma unroll
        for (int ai = 0; ai < 2; ++ai)
#pragma unroll
            for (int m = 0; m < 4; ++m) { float* rowp = X + (size_t)(row0 + ai * HALF + m * 16) * D_MODEL + col0;
#pragma unroll
                for (int bj = 0; bj < 2; ++bj)
#pragma unroll
                    for (int n = 0; n < 2; ++n) { f32x4* q = (f32x4*)(rowp + bj * HALF + n * 16); *q = *q + gv[bj][n] * acc[ai][bj][m][n]; } }
    }
};
struct EpiSwiGLU {
    static constexpr bool PERM = false, AFTER_DRAIN = false;
    bf16_t* H; int nJ;
    __device__ __forceinline__ void operator()(const f32x4 (&acc)[2][2][4][2], const Unit& u, int wr, int wc, int fr, int fq) const {
        const int row0 = u.pm * BM + wr * 64 + fr, col0 = (u.pn % nJ) * HALF + wc * 32 + 4 * fq;
#pragma unroll
        for (int ai = 0; ai < 2; ++ai)
#pragma unroll
            for (int m = 0; m < 4; ++m) { bf16_t* rowp = H + (size_t)(row0 + ai * HALF + m * 16) * D_MODEL + col0;
#pragma unroll
                for (int n = 0; n < 2; ++n) { const f32x4 a = acc[ai][0][m][n], b = acc[ai][1][m][n]; float o[4];
#pragma unroll
                    for (int q = 0; q < 4; ++q) o[q] = a[q] / (1.f + __expf(-a[q])) * b[q];
                    u32x2v w; w.x = cvt_pk_bf16(o[0], o[1]); w.y = cvt_pk_bf16(o[2], o[3]); *(u32x2v*)(rowp + n * 16) = w; } }
    }
};
struct EpiGate {
    static constexpr bool PERM = false, AFTER_DRAIN = false;
    float* Y; const float* gate; int nJ;
    __device__ __forceinline__ void operator()(const f32x4 (&acc)[2][2][4][2], const Unit& u, int wr, int wc, int fr, int fq) const {
        const int row0 = u.pm * BM + wr * 64 + fr, col0 = (u.pn % nJ) * BM + wc * 32 + 4 * fq;
#pragma unroll
        for (int ai = 0; ai < 2; ++ai)
#pragma unroll
            for (int m = 0; m < 4; ++m) { const int r = row0 + ai * HALF + m * 16; const float gt = gate[r]; float* rowp = Y + (size_t)r * D_MODEL + col0;
#pragma unroll
                for (int bj = 0; bj < 2; ++bj)
#pragma unroll
                    for (int n = 0; n < 2; ++n) *(f32x4*)(rowp + bj * HALF + n * 16) = acc[ai][bj][m][n] * gt; }
    }
};
template <class Epi, class Sched>
__device__ __forceinline__ void gemm_phase(PG8_LAS unsigned char* lds, const Gemm g, const Sched& S, const Epi& E) {
    const int tid = threadIdx.x, wid = __builtin_amdgcn_readfirstlane(tid >> 6), lane = tid & 63, wr = wid >> 2, wc = wid & 3, fr = lane & 15, fq = lane >> 4;
    const int K = g.K, nt = K / BK;
    unsigned voffA[2], voffB[2];
#pragma unroll
    for (int i = 0; i < 2; ++i) { int R, C; stage_rc(tid * 16 + i * 8192, R, C); const int Rb = Epi::PERM ? ((R & ~31) + perm32(R & 31)) : R;
        voffA[i] = (unsigned)(R * K + C) * 2u; voffB[i] = (unsigned)(Rb * K + C) * 2u; }
    const size_t kstep = (size_t)(BK * 2);
    const size_t hstep = (size_t)HALF * K * 2;
    const size_t tstep = 2 * hstep;
    const unsigned ldsw = (unsigned)wid * 1024u;
    const int aoff = lds_byte(wr * 64 + fr, fq * 8), boff = lds_byte(wc * 32 + fr, fq * 8);
#define PG8_SA(b, h) (((b) * 2 + (h)) * HTB)
#define PG8_SB(b, h) ((4 + (b) * 2 + (h)) * HTB)
#define PG8_STAGE(bufoff, gbase, voff) do { _Pragma("unroll") for (int _i = 0; _i < 2; ++_i) \
        __builtin_amdgcn_global_load_lds((const unsigned*)((const char*)(gbase) + (voff)[_i]), (PG8_LAS unsigned*)(lds + (bufoff) + ldsw + _i * 8192), 16, 0, 0); } while (0)
#define PG8_LDA(dst, b, h) do { _Pragma("unroll") for (int m = 0; m < 4; ++m) _Pragma("unroll") for (int k = 0; k < 2; ++k) dst[m][k] = *(const PG8_LAS bf16x8*)(lds + PG8_SA(b, h) + aoff + m * 2048 + k * 1024); } while (0)
#define PG8_LDB(dst, b, h) do { _Pragma("unroll") for (int n = 0; n < 2; ++n) _Pragma("unroll") for (int k = 0; k < 2; ++k) dst[n][k] = *(const PG8_LAS bf16x8*)(lds + PG8_SB(b, h) + boff + n * 2048 + k * 1024); } while (0)
#define PG8_MMA(ai, bj, At, Bt) do { __builtin_amdgcn_s_setprio(1); _Pragma("unroll") for (int m = 0; m < 4; ++m) _Pragma("unroll") for (int n = 0; n < 2; ++n) _Pragma("unroll") for (int k = 0; k < 2; ++k) \
        acc[ai][bj][m][n] = __builtin_amdgcn_mfma_f32_16x16x32_bf16(Bt[n][k], At[m][k], acc[ai][bj][m][n], 0, 0, 0); __builtin_amdgcn_s_setprio(0); } while (0)
#define PG8_WAIT_V(n) asm volatile("s_waitcnt vmcnt(" #n ")" ::: "memory")
#define PG8_WAIT_L(n) asm volatile("s_waitcnt lgkmcnt(" #n ")" ::: "memory")
#define PG8_BAR __builtin_amdgcn_s_barrier()
#define PG8_SCHED __builtin_amdgcn_sched_barrier(0)
    Unit cur, nxt; int ui = 0;
    if (!S.next(0, cur)) return;
    f32x4 acc[2][2][4][2];
#pragma unroll
    for (int a = 0; a < 2; ++a)
#pragma unroll
        for (int b = 0; b < 2; ++b)
#pragma unroll
            for (int m = 0; m < 4; ++m)
#pragma unroll
                for (int n = 0; n < 2; ++n) acc[a][b][m][n] = (f32x4){0.f, 0.f, 0.f, 0.f};
    bf16x8 At[4][2], B0[2][2], B1[2][2];
    const char* cA = (const char*)g.A + (size_t)cur.pm * tstep; const char* cB = (const char*)g.Bt + (size_t)cur.pn * tstep;
    S.a_ready(cur);
    PG8_STAGE(PG8_SB(0, 0), cB, voffB); PG8_STAGE(PG8_SA(0, 0), cA, voffA); PG8_STAGE(PG8_SB(0, 1), cB + hstep, voffB); PG8_STAGE(PG8_SA(0, 1), cA + hstep, voffA);
    if (wr == 1) PG8_BAR;
    PG8_WAIT_V(4); PG8_BAR;
    PG8_STAGE(PG8_SB(1, 0), cB + kstep, voffB); PG8_STAGE(PG8_SA(1, 0), cA + kstep, voffA); PG8_STAGE(PG8_SB(1, 1), cB + hstep + kstep, voffB);
    PG8_WAIT_V(6); PG8_BAR;
    for (;;) {
        const bool has_next = S.next(ui + 1, nxt);
        const char* nA = has_next ? (const char*)g.A + (size_t)nxt.pm * tstep : cA; const char* nB = has_next ? (const char*)g.Bt + (size_t)nxt.pn * tstep : cB;
        for (int t = 0; t < nt; t += 2) {
            const bool last = (t == nt - 2);
            const char* a1 = cA + (size_t)(t + 1) * kstep;
            const char* a2 = last ? nA : cA + (size_t)(t + 2) * kstep; const char* b2 = last ? nB : cB + (size_t)(t + 2) * kstep;
            const char* a3 = a2 + kstep; const char* b3 = b2 + kstep;
            if (last && has_next) S.a_ready(nxt);
            PG8_LDB(B0, 0, 0); PG8_SCHED; PG8_LDA(At, 0, 0); PG8_STAGE(PG8_SA(1, 1), a1 + hstep, voffA);
            PG8_WAIT_L(8); PG8_BAR; PG8_WAIT_L(0); PG8_MMA(0, 0, At, B0); PG8_BAR; PG8_SCHED;
            PG8_LDB(B1, 0, 1); PG8_STAGE(PG8_SB(0, 0), b2, voffB);
            PG8_BAR; PG8_WAIT_L(0); PG8_MMA(0, 1, At, B1); PG8_BAR;
            PG8_LDA(At, 0, 1); PG8_STAGE(PG8_SA(0, 0), a2, voffA);
            PG8_BAR; PG8_WAIT_L(0); PG8_MMA(1, 0, At, B0); PG8_BAR; PG8_SCHED;
            PG8_STAGE(PG8_SB(0, 1), b2 + hstep, voffB);
            PG8_WAIT_V(6); PG8_BAR; PG8_MMA(1, 1, At, B1); PG8_BAR;
            PG8_LDB(B0, 1, 0); PG8_SCHED; PG8_LDA(At, 1, 0); PG8_STAGE(PG8_SA(0, 1), a2 + hstep, voffA);
            PG8_WAIT_L(8); PG8_BAR; PG8_WAIT_L(0); PG8_MMA(0, 0, At, B0); PG8_BAR; PG8_SCHED;
            PG8_LDB(B1, 1, 1); PG8_STAGE(PG8_SB(1, 0), b3, voffB);
            PG8_BAR; PG8_WAIT_L(0); PG8_MMA(0, 1, At, B1); PG8_BAR;
            PG8_LDA(At, 1, 1); PG8_STAGE(PG8_SA(1, 0), a3, voffA);
            PG8_BAR; PG8_WAIT_L(0); PG8_MMA(1, 0, At, B0); PG8_BAR; PG8_SCHED;
            PG8_STAGE(PG8_SB(1, 1), b3 + hstep, voffB);
            PG8_WAIT_V(6); PG8_BAR; PG8_MMA(1, 1, At, B1); PG8_BAR;
        }
        if constexpr (!Epi::AFTER_DRAIN) { E(acc, cur, wr, wc, fr, fq); S.done(cur); }
        if (!has_next) break;
#pragma unroll
        for (int a = 0; a < 2; ++a)
#pragma unroll
            for (int b = 0; b < 2; ++b)
#pragma unroll
                for (int m = 0; m < 4; ++m)
#pragma unroll
                    for (int n = 0; n < 2; ++n) acc[a][b][m][n] = (f32x4){0.f, 0.f, 0.f, 0.f};
        cur = nxt; cA = nA; cB = nB; ++ui;
    }
    PG8_WAIT_V(0);
    if (wr == 0) PG8_BAR;
    PG8_BAR;
    if constexpr (Epi::AFTER_DRAIN) { E.fused(acc, cur, wr, wc, fr, fq, lds, wid, lane); S.done(cur); }
#undef PG8_SA
#undef PG8_SB
#undef PG8_STAGE
#undef PG8_LDA
#undef PG8_LDB
#undef PG8_MMA
#undef PG8_WAIT_V
#undef PG8_WAIT_L
#undef PG8_BAR
#undef PG8_SCHED
}
}


namespace att {
using bf16 = unsigned short;
constexpr int   D = 128, NW = 8, QBLK = 32, KVBLK = 64;
constexpr float SCALE = 0.088388347648318440f;
constexpr float THR = 8.f;
constexpr int SDEPTH = 2;
constexpr int LDQ = 128, LDK = 128, LDO = D_MODEL;
constexpr size_t SHM_V = KVBLK * D * 2, SHM_K = KVBLK * D * 2, SHM_ATTN = 2 * SHM_V + 2 * SHM_K + NW * 64 * 4;
using bf16x8 = __attribute__((ext_vector_type(8))) short;
using s16x4  = __attribute__((ext_vector_type(4))) short;
using f32x16 = __attribute__((ext_vector_type(16))) float;
using f32x8  = __attribute__((ext_vector_type(8))) float;
using u32x4  = __attribute__((ext_vector_type(4))) unsigned;
#define KSWZ(row, colB) ((row) * 256 + ((colB) ^ (((row) & 7) << 4)))
#define SBAR() __builtin_amdgcn_sched_barrier(0)
__device__ __forceinline__ int crow(int r, int hi) { return (r & 3) + 8 * (r >> 2) + 4 * hi; }
__device__ __forceinline__ unsigned cvtpk(float lo, float hi) {
  unsigned r; asm volatile("v_cvt_pk_bf16_f32 %0, %1, %2" : "=v"(r) : "v"(lo), "v"(hi)); return r;
}
template <typename TIn> struct Stage;
template <> struct Stage<bf16>  { using T = bf16x8;
  __device__ static __forceinline__ T ld8(const bf16* p) { return *reinterpret_cast<const bf16x8*>(p); }
  __device__ static __forceinline__ bf16x8 tobf(T x) { return x; } };
template <> struct Stage<float> { using T = f32x8;
  __device__ static __forceinline__ T ld8(const float* p) { return *reinterpret_cast<const f32x8*>(p); }
  __device__ static __forceinline__ bf16x8 tobf(T x) {
    u32x4 w = {cvtpk(x[0], x[1]), cvtpk(x[2], x[3]), cvtpk(x[4], x[5]), cvtpk(x[6], x[7])}; return *reinterpret_cast<bf16x8*>(&w); } };

__device__ __forceinline__ void partialSM(f32x16& p0, f32x16& p1, float& m_reg, float& mn, float& alpha) {
  constexpr float C = SCALE * 1.4426950408889634f;
  float pmax = p0[0]; for (int r = 1; r < 16; ++r) pmax = fmaxf(pmax, p0[r]); for (int r = 0; r < 16; ++r) pmax = fmaxf(pmax, p1[r]);
  { auto rr = __builtin_amdgcn_permlane32_swap(__float_as_uint(pmax), __float_as_uint(pmax), false, false);
    pmax = fmaxf(__uint_as_float(rr[0]), __uint_as_float(rr[1])); }
  if (__builtin_expect(__all(pmax - m_reg <= THR / SCALE), 1)) { mn = m_reg; alpha = 1.f; }
  else { mn = fmaxf(m_reg, pmax); alpha = __builtin_amdgcn_exp2f((m_reg - mn) * C); m_reg = mn; }
  float mnC = -mn * C;
  for (int r = 0; r < 16; ++r) p0[r] = fmaf(p0[r], C, mnC); for (int r = 0; r < 16; ++r) p1[r] = fmaf(p1[r], C, mnC);
  for (int r = 0; r < 16; ++r) p0[r] = __builtin_amdgcn_exp2f(p0[r]);
}
__device__ __forceinline__ void finishSM(f32x16& p0, f32x16& p1, float alpha, float& l_reg, bf16x8& pa0, bf16x8& pa1, bf16x8& pa2, bf16x8& pa3) {
  for (int r = 0; r < 16; ++r) p1[r] = __builtin_amdgcn_exp2f(p1[r]);
  float ps = 0; for (int r = 0; r < 16; ++r) ps += p0[r]; for (int r = 0; r < 16; ++r) ps += p1[r];
  { auto rr = __builtin_amdgcn_permlane32_swap(__float_as_uint(ps), __float_as_uint(ps), false, false);
    ps = __uint_as_float(rr[0]) + __uint_as_float(rr[1]); }
  l_reg = l_reg * alpha + ps;
#define PK4(P, BASE, OUT) do { unsigned a0 = cvtpk(P[BASE + 0], P[BASE + 1]), a1 = cvtpk(P[BASE + 2], P[BASE + 3]);   \
    unsigned b0 = cvtpk(P[BASE + 4], P[BASE + 5]), b1 = cvtpk(P[BASE + 6], P[BASE + 7]);                              \
    auto r0 = __builtin_amdgcn_permlane32_swap(a0, b0, false, false); auto r1 = __builtin_amdgcn_permlane32_swap(a1, b1, false, false); \
    u32x4 w = {r0[0], r1[0], r0[1], r1[1]}; OUT = *reinterpret_cast<bf16x8*>(&w); } while (0)
  PK4(p0, 0, pa0); PK4(p0, 8, pa1); PK4(p1, 0, pa2); PK4(p1, 8, pa3);
#undef PK4
}
__device__ __forceinline__ void qkt(f32x16& p0, f32x16& p1, const bf16* Ks, const bf16x8* qr, int r32, int hi) {
  p0 = f32x16{}; p1 = f32x16{};
  for (int d0 = 0; d0 < 8; ++d0) { int cb = (d0 * 16 + hi * 8) * 2;
    bf16x8 b0 = *reinterpret_cast<const bf16x8*>((const char*)Ks + KSWZ(r32, cb));
    bf16x8 b1 = *reinterpret_cast<const bf16x8*>((const char*)Ks + KSWZ(32 + r32, cb));
    p0 = __builtin_amdgcn_mfma_f32_32x32x16_bf16(b0, qr[d0], p0, 0, 0, 0);
    p1 = __builtin_amdgcn_mfma_f32_32x32x16_bf16(b1, qr[d0], p1, 0, 0, 0); }
}
__device__ __forceinline__ int v_st(int k, int c) { const int kk = (k & ~0xC) | ((k & 4) << 1) | ((k & 8) >> 1); return ((kk >> 3) * 4 + (c >> 5)) * 512 + ((kk & 7) * 32 + (c & 31)) * 2; }
__device__ __forceinline__ int v_rd_base(int lane) { return ((lane & 3) << 3) | (((lane >> 2) & 3) << 6) | (((lane >> 4) & 1) << 5) | (((lane >> 5) & 1) << 8); }
constexpr int v_rd_off(int d0, int ks, int half) { return d0 * 512 + ks * 4096 + half * 2048; }
template <int OFF> __device__ __forceinline__ s16x4 tr_read(int vb) {
  s16x4 r; asm volatile("ds_read_b64_tr_b16 %0, %1 offset:%2" : "=&v"(r) : "v"(vb), "i"(OFF) : "memory"); return r;
}
template <int D0> __device__ __forceinline__ void pv_one(f32x16& od, int vb, bf16x8 pa0, bf16x8 pa1, bf16x8 pa2, bf16x8 pa3) {
  const s16x4 l0 = tr_read<v_rd_off(D0, 0, 0)>(vb), h0 = tr_read<v_rd_off(D0, 0, 1)>(vb), l1 = tr_read<v_rd_off(D0, 1, 0)>(vb), h1 = tr_read<v_rd_off(D0, 1, 1)>(vb);
  const s16x4 l2 = tr_read<v_rd_off(D0, 2, 0)>(vb), h2 = tr_read<v_rd_off(D0, 2, 1)>(vb), l3 = tr_read<v_rd_off(D0, 3, 0)>(vb), h3 = tr_read<v_rd_off(D0, 3, 1)>(vb);
  asm volatile("s_waitcnt lgkmcnt(0)" ::: "memory"); SBAR();
#define PK(L, H) (bf16x8){L[0], L[1], L[2], L[3], H[0], H[1], H[2], H[3]}
  od = __builtin_amdgcn_mfma_f32_32x32x16_bf16(pa0, PK(l0, h0), od, 0, 0, 0);
  od = __builtin_amdgcn_mfma_f32_32x32x16_bf16(pa1, PK(l1, h1), od, 0, 0, 0);
  od = __builtin_amdgcn_mfma_f32_32x32x16_bf16(pa2, PK(l2, h2), od, 0, 0, 0);
  od = __builtin_amdgcn_mfma_f32_32x32x16_bf16(pa3, PK(l3, h3), od, 0, 0, 0);
#undef PK
}
__device__ __forceinline__ void pv_d0(f32x16* o, int vb, bf16x8 pa0, bf16x8 pa1, bf16x8 pa2, bf16x8 pa3) {
  pv_one<0>(o[0], vb, pa0, pa1, pa2, pa3); pv_one<1>(o[1], vb, pa0, pa1, pa2, pa3); pv_one<2>(o[2], vb, pa0, pa1, pa2, pa3); pv_one<3>(o[3], vb, pa0, pa1, pa2, pa3);
}

__device__ __forceinline__ void attn_dense_body(const bf16* __restrict__ Qb, const bf16* __restrict__ Kh, const bf16* __restrict__ Vh,
                                                unsigned short* __restrict__ Ob, int seq, char* lds) {
  using St = Stage<bf16>; using SQ = Stage<bf16>; using TQ = bf16;
  const int tid = threadIdx.x, wid = tid >> 6, lane = tid & 63, r32 = lane & 31, hi = lane >> 5;
  bf16* V_lds = (bf16*)lds; bf16* K_lds = (bf16*)(lds + 2 * SHM_V);
  float* ws = (float*)(lds + 2 * SHM_V + 2 * SHM_K) + wid * 64; float* li_l = ws; float* al_l = ws + 32;
  float m_reg = -1e30f, l_reg = 0; f32x16 o[4] = {}; bf16x8 qr[8];
  const TQ* Qw = Qb + (long)(wid * QBLK + r32) * LDQ + hi * 8;
#pragma unroll
  for (int d0 = 0; d0 < 8; ++d0) qr[d0] = SQ::tobf(SQ::ld8(Qw + d0 * 16));
  const int sr = tid >> 4, sc = (tid & 15) * 8, vst0 = v_st(sr, sc), vst1 = v_st(32 + sr, sc);
  const int vb0 = (int)(uintptr_t)V_lds + v_rd_base(lane);
  struct { typename St::T vs0, vs1, ks0, ks1; } sr_[SDEPTH];
#define SLOAD(i, k0) do { sr_[i].vs0 = St::ld8(&Vh[(long)((k0) + sr) * LDK + sc]); sr_[i].vs1 = St::ld8(&Vh[(long)((k0) + 32 + sr) * LDK + sc]); \
    sr_[i].ks0 = St::ld8(&Kh[(long)((k0) + sr) * LDK + sc]); sr_[i].ks1 = St::ld8(&Kh[(long)((k0) + 32 + sr) * LDK + sc]); } while (0)
#define SWRITE(b, i) do { *(bf16x8*)((char*)V_lds + (b) * SHM_V + vst0) = St::tobf(sr_[i].vs0);          \
    *(bf16x8*)((char*)V_lds + (b) * SHM_V + vst1) = St::tobf(sr_[i].vs1); int kc = sc * 2;               \
    *(bf16x8*)((char*)K_lds + (b) * SHM_K + KSWZ(sr, kc)) = St::tobf(sr_[i].ks0);                       \
    *(bf16x8*)((char*)K_lds + (b) * SHM_K + KSWZ(32 + sr, kc)) = St::tobf(sr_[i].ks1); } while (0)
#define SWAIT() do { if constexpr (SDEPTH == 2) asm volatile("s_waitcnt vmcnt(4)" ::: "memory"); else asm volatile("s_waitcnt vmcnt(0)" ::: "memory"); } while (0)
#define RESC(a) do { if (__any((a) < 1.f)) { if (hi == 0) al_l[r32] = (a); asm volatile("s_waitcnt lgkmcnt(0)" ::: "memory"); \
    for (int d = 0; d < 4; ++d) for (int r = 0; r < 16; ++r) o[d][r] *= al_l[crow(r, hi)]; } } while (0)
  f32x16 pA0, pA1, pB0, pB1; float mnA, mnB, alA, alB; bf16x8 pa0, pa1, pa2, pa3; const int NT = seq / KVBLK;
  constexpr int SE = 0, SO = SDEPTH - 1;
  SLOAD(SE, 0); asm volatile("s_waitcnt vmcnt(0)" ::: "memory"); SWRITE(0, SE); __syncthreads();
  qkt(pA0, pA1, K_lds, qr, r32, hi); partialSM(pA0, pA1, m_reg, mnA, alA);
  SLOAD(SO, KVBLK); if constexpr (SDEPTH == 2) { if (2 < NT) SLOAD(SE, 2 * KVBLK); }
  SWAIT(); SWRITE(1, SO); __syncthreads();
  for (int j = 1; j + 1 < NT; j += 2) {
    SBAR(); qkt(pB0, pB1, (bf16*)((char*)K_lds + SHM_K), qr, r32, hi);
    finishSM(pA0, pA1, alA, l_reg, pa0, pa1, pa2, pa3); SBAR();
    SLOAD(SO, (j + SDEPTH) * KVBLK); SBAR();
    pv_d0(o, vb0, pa0, pa1, pa2, pa3); partialSM(pB0, pB1, m_reg, mnB, alB);
    __syncthreads(); SWAIT(); SWRITE(0, SE);
    RESC(alB); __syncthreads();
    SBAR(); qkt(pA0, pA1, K_lds, qr, r32, hi);
    finishSM(pB0, pB1, alB, l_reg, pa0, pa1, pa2, pa3); SBAR();
    if (SDEPTH == 1 || j + 3 < NT) SLOAD(SE, (j + 1 + SDEPTH) * KVBLK); SBAR();
    pv_d0(o, vb0 + (int)SHM_V, pa0, pa1, pa2, pa3); partialSM(pA0, pA1, m_reg, mnA, alA);
    __syncthreads(); SWAIT(); SWRITE(1, SO);
    RESC(alA); __syncthreads();
  }
  SBAR(); qkt(pB0, pB1, (bf16*)((char*)K_lds + SHM_K), qr, r32, hi);
  finishSM(pA0, pA1, alA, l_reg, pa0, pa1, pa2, pa3); SBAR();
  pv_d0(o, vb0, pa0, pa1, pa2, pa3); partialSM(pB0, pB1, m_reg, mnB, alB);
  __syncthreads(); RESC(alB);
  finishSM(pB0, pB1, alB, l_reg, pa0, pa1, pa2, pa3); SBAR();
  pv_d0(o, vb0 + (int)SHM_V, pa0, pa1, pa2, pa3);
  if (hi == 0) li_l[r32] = l_reg; asm volatile("s_waitcnt lgkmcnt(0)" ::: "memory");
  float rli[16];
#pragma unroll
  for (int r = 0; r < 16; ++r) rli[r] = __builtin_amdgcn_rcpf(li_l[crow(r, hi)]);
  unsigned short* Ow = Ob + (long)(wid * QBLK) * LDO;
#pragma unroll
  for (int r = 0; r < 16; ++r) { int orow = crow(r, hi);
    for (int d0 = 0; d0 < 4; ++d0) Ow[(long)orow * LDO + d0 * 32 + r32] = f2bf(o[d0][r] * rli[r]); }
#undef SLOAD
#undef SWRITE
#undef SWAIT
#undef RESC
}
}

__device__ __forceinline__ void cvt_tile(const float* __restrict__ W, int ldw, int nvalid, int k0, int n0, u16* __restrict__ Wt, int rmode, float* lds) {
    typedef float f4 __attribute__((ext_vector_type(4)));
    typedef unsigned u4 __attribute__((ext_vector_type(4)));
    const int tid = threadIdx.x, c4 = (tid & 31) * 4, r0 = tid >> 5;
    f4 v[8];
    const bool ok = (n0 + c4) < nvalid;
#pragma unroll
    for (int i = 0; i < 8; ++i) v[i] = ok ? *(const f4*)(W + (size_t)(k0 + r0 + 16 * i) * ldw + n0 + c4) : (f4){0.f, 0.f, 0.f, 0.f};
#pragma unroll
    for (int i = 0; i < 8; ++i) *(f4*)(lds + (r0 + 16 * i) * 132 + c4) = v[i];
    __syncthreads();
    const int nn = tid & 127, kq = tid >> 7, n = n0 + nn;
    int row = n;
    if (rmode) row = (n >> 7) * 256 + (n & 127) + (rmode == 2 ? 128 : 0);
    u16* dst = Wt + (size_t)row * D_MODEL + k0 + kq * 32;
#pragma unroll
    for (int j = 0; j < 4; ++j) { const float* s = lds + (kq * 32 + j * 8) * 132 + nn; u4 w;
        w.x = pg8::cvt_pk_bf16(s[0], s[132]); w.y = pg8::cvt_pk_bf16(s[2 * 132], s[3 * 132]); w.z = pg8::cvt_pk_bf16(s[4 * 132], s[5 * 132]); w.w = pg8::cvt_pk_bf16(s[6 * 132], s[7 * 132]);
        *(u4*)(dst + j * 8) = w; }
    __syncthreads();
}
__device__ __forceinline__ void ph_convert(const Params& p, float* lds) {
    constexpr int KT = D_MODEL / 128;
    constexpr int T_IN = KT * (LDP / 128), T_OUT = KT * (D_MODEL / 128), T_E = KT * (D_MODEL / 128);
    constexpr int PER_L = T_IN + T_OUT + NE * 3 * T_E, TOTAL = DEPTH * PER_L;
    static_assert(N_IN % 4 == 0 && LDP % 128 == 0, "conversion tiles");
    for (int t = blockIdx.x; t < TOTAL; t += gridDim.x) {
        const int l = t / PER_L; int r = t % PER_L;
        if (r < T_IN) { const int kt = r % KT, nt = r / KT;
            cvt_tile(p.w_in + (size_t)l * D_MODEL * N_IN, N_IN, N_IN, kt * 128, nt * 128, p.wt_in + (size_t)l * LDP * D_MODEL, 0, lds); continue; }
        r -= T_IN;
        if (r < T_OUT) { const int kt = r % KT, nt = r / KT;
            cvt_tile(p.w_out + (size_t)l * D_MODEL * D_MODEL, D_MODEL, D_MODEL, kt * 128, nt * 128, p.wt_out + (size_t)l * D_MODEL * D_MODEL, 0, lds); continue; }
        r -= T_OUT;
        const int e = r / (3 * T_E), which = (r / T_E) % 3, q = r % T_E, kt = q % KT, nt = q / KT;
        const size_t eo = ((size_t)l * NE + e) * D_MODEL * D_MODEL;
        if (which == 0) cvt_tile(p.w_exp1 + eo, D_MODEL, D_MODEL, kt * 128, nt * 128, p.w13t + 2 * eo, 1, lds);
        else if (which == 1) cvt_tile(p.w_exp3 + eo, D_MODEL, D_MODEL, kt * 128, nt * 128, p.w13t + 2 * eo, 2, lds);
        else cvt_tile(p.w_exp2 + eo, D_MODEL, D_MODEL, kt * 128, nt * 128, p.w2t + eo, 0, lds);
    }
}

constexpr int LDS_BYTES = 147456;
constexpr int LDS_MISC = 147392;
constexpr int NPL = 16;
constexpr int NPHASE = 2 + DEPTH * NPL + 1;

struct Args { Params p; int ph_lo, ph_hi, flags, pad; };

template <int G> __device__ __forceinline__ Exec mk_exec() { const int gt = blockIdx.x * 512 + threadIdx.x; return Exec{gt / G, (int)(gridDim.x * 512) / G, gt % G}; }
typedef const __attribute__((address_space(4))) unsigned long long* kq_t;
__device__ __forceinline__ void load_params(Params& p, const __attribute__((address_space(4))) unsigned char* ka) {
    kq_t s = (kq_t)ka; unsigned long long* d = (unsigned long long*)&p;
#pragma unroll
    for (int i = 0; i < (int)(sizeof(Params) / 8); ++i) d[i] = s[i];
}
#define LOADP() Params p; load_params(p, ka)
#define PH(k, ...) do { if (lo <= (k) && (k) < hi) { { LOADP(); __VA_ARGS__; } if ((k) + 1 < hi) xcd_barrier(bar); } } while (0)
#define e1 mk_exec<1>()
#define e16 mk_exec<16>()
#define e64 mk_exec<64>()
#define flds ((float*)lds)
#define glds ((PG8_LAS unsigned char*)lds)
#define G ((int)gridDim.x)
#define c ((int)blockIdx.x)
template <int L> __device__ __forceinline__ void layer_phases(const __attribute__((address_space(4))) unsigned char* ka, int lo, int hi, int flags, const XcdBarrier& bar, unsigned char* lds) {
    constexpr int l = L;
        const int b0 = 2 + l * NPL; const bool last = (l == DEPTH - 1);
        PH(b0 + 0, ph_norm1<64>(p, l, e64));
        PH(b0 + 1, { pg8::Gemm g{p.h, p.wt_in + (size_t)l * LDP * D_MODEL, MROWS, LDP, D_MODEL}; pg8::StaticOrder S; S.init(MROWS, LDP, G, c);
                     pg8::EpiF32 E{p.P, LDP}; pg8::gemm_phase<pg8::EpiF32, pg8::StaticOrder>(glds, g, S, E); });
        PH(b0 + 2, ph_rw_prep1<64>(p, l, e64); ph_ml_g1<64>(p, l, e64); ph_gd_prep<64>(p, l, e64); ph_gd_gates<64>(p, l, e64); ph_at_prep<64>(p, l, e64));
        PH(b0 + 3, ph_rw_prep2(p, l, e64); ph_ml_g2(p, e1); ph_gd_c1(p, e64));
        PH(b0 + 4, { for (int u = c; u < RW_CN; u += G) ph_rw_c1_unit(p, u, threadIdx.x, 512, lds); for (int u = G - 1 - c; u < ML_CN; u += G) ph_ml_c1_unit(p, u, threadIdx.x, 512, lds); });
        PH(b0 + 5, { constexpr int NU1 = (RW_CN + TS_G - 1) / TS_G, NU2 = (GD_CN + TS_G - 1) / TS_G;
            if (!(flags & 2)) for (int u = c; u < NU1 + NU2; u += G) { if (u < NU1) ph_tsolve_unit(p.rw_Ma, p.rw_T, RW_CN, u, threadIdx.x, 512, lds); else ph_tsolve_unit(p.gd_A, p.gd_T, GD_CN, u - NU1, threadIdx.x, 512, lds); } });
        PH(b0 + 6, {
            const int nlat = BATCH * AT_QH * (SEQ / 256), nctx = last ? 0 : BATCH * AT_QH;
            if (flags & 1) {} else if (c < nlat) { const int u = c;
                const int qb = u % (SEQ / 256), hq = (u / (SEQ / 256)) % AT_QH, b = u / ((SEQ / 256) * AT_QH), s0 = CTX + qb * 256, kvh = hq / (AT_QH / AT_KVH);
                att::attn_dense_body((const att::bf16*)p.at_q + (((size_t)b * AT_QH + hq) * TOK + s0) * AT_HEAD,
                                     (const att::bf16*)p.at_k + ((size_t)b * AT_KVH + kvh) * TOK * AT_HEAD, (const att::bf16*)p.at_v + ((size_t)b * AT_KVH + kvh) * TOK * AT_HEAD,
                                     p.mix + ((size_t)b * TOK + s0) * D_MODEL + 3 * GROUP_W + hq * AT_HEAD, TOK, (char*)lds);
                __syncthreads(); }
            else if (c < nlat + nctx) { const int u = c - nlat;
                const int hq = u % AT_QH, b = u / AT_QH, kvh = hq / (AT_QH / AT_KVH);
                att::attn_dense_body((const att::bf16*)p.at_q + (((size_t)b * AT_QH + hq) * TOK) * AT_HEAD,
                                     (const att::bf16*)p.at_k + ((size_t)b * AT_KVH + kvh) * TOK * AT_HEAD, (const att::bf16*)p.at_v + ((size_t)b * AT_KVH + kvh) * TOK * AT_HEAD,
                                     p.mix + ((size_t)b * TOK) * D_MODEL + 3 * GROUP_W + hq * AT_HEAD, CTX, (char*)lds);
                __syncthreads(); } });
        PH(b0 + 7, { if (!(flags & 4)) for (int u = c; u < RW_CN; u += G) ph_rw_c3_unit(p, u, threadIdx.x, 512, lds);
                     if (!(flags & 8)) for (int u = G - 1 - c; u < GD_CN; u += G) ph_gd_c3_unit(p, u, threadIdx.x, 512, lds);
                     ph_ml_prefix(p, e1); });
        PH(b0 + 8, { if (!(flags & 16)) for (int u = c; u < GD_S2_UNITS; u += G) ph_gd_scan2_unit(p, u, threadIdx.x, 512, lds); }
                   { if (!(flags & 32)) for (int u = G - 1 - c; u < RW_CH; u += G) ph_rw_scan2_unit(p, u, threadIdx.x, 512, lds); }
                   { if (!(flags & 64)) for (int u = c - GD_S2_UNITS; u < ML_CN; u += G - GD_S2_UNITS - RW_CH) if (u >= 0 && c < G - RW_CH) ph_ml_c2_unit(p, u, threadIdx.x, 512, lds); });
        PH(b0 + 9, ph_rw_post<64>(p, l, e64); ph_gd_post<64>(p, l, e64); ph_ml_post<64>(p, l, e64));
        PH(b0 + 10, { pg8::Gemm g{p.mix, p.wt_out + (size_t)l * D_MODEL * D_MODEL, MROWS, D_MODEL, D_MODEL}; pg8::TileOrder S;
                      S.init(last ? BATCH * SEQ / 256 : MROWS / 256, D_MODEL / 256, G, c, last ? 1 : 0);
                      pg8::EpiResid E{p.xres, p.mod + (size_t)l * 3 * 6 * D_MODEL}; pg8::gemm_phase<pg8::EpiResid, pg8::TileOrder>(glds, g, S, E); });
        PH(b0 + 11, ph_norm2<64>(p, l, e64));
        PH(b0 + 12, { for (int u = c; u < topk_units(l); u += G) ph_topk_unit(p, l, u, threadIdx.x, 512, lds); });
        PH(b0 + 13, ph_gather<64>(p, l, e64));
        PH(b0 + 14, { pg8::Gemm g{p.xs, p.w13t + (size_t)l * NE * 2 * D_MODEL * D_MODEL, NE * NSLOT, NE * 2 * D_MODEL, D_MODEL}; pg8::GroupedOrder S;
                      S.init(last ? NSLOT_L / 256 : NSLOT / 256, 2 * D_MODEL / 256, NSLOT / 256, G, c);
                      pg8::EpiSwiGLU E{p.hid, 2 * D_MODEL / 256}; pg8::gemm_phase<pg8::EpiSwiGLU, pg8::GroupedOrder>(glds, g, S, E); });
        PH(b0 + 15, { pg8::Gemm g{p.hid, p.w2t + (size_t)l * NE * D_MODEL * D_MODEL, NE * NSLOT, NE * D_MODEL, D_MODEL}; pg8::GroupedOrder S;
                      S.init(last ? NSLOT_L / 256 : NSLOT / 256, D_MODEL / 256, NSLOT / 256, G, c);
                      pg8::EpiGate E{p.yexp, p.sel_gate, D_MODEL / 256}; pg8::gemm_phase<pg8::EpiGate, pg8::GroupedOrder>(glds, g, S, E); });
    }
__global__ void __launch_bounds__(512, 2) mega(Args args) {
    extern __shared__ __attribute__((aligned(16))) unsigned char lds[];
    typedef const __attribute__((address_space(4))) unsigned char* kptr_t;
    const kptr_t ka = (kptr_t)__builtin_amdgcn_kernarg_segment_ptr();
    (void)args;
    const unsigned long long lohi = ((kq_t)ka)[sizeof(Params) / 8]; const int lo = (int)(unsigned)lohi, hi = (int)(unsigned)(lohi >> 32);
    const int flags = (int)(unsigned)((kq_t)ka)[sizeof(Params) / 8 + 1];
    unsigned* barw = (unsigned*)((kq_t)ka)[offsetof(Params, bar) / 8];
    volatile LAS unsigned* misc = (volatile LAS unsigned*)((LAS unsigned char*)lds + LDS_MISC);
    if (threadIdx.x < 4) misc[threadIdx.x] = 0u;
    __syncthreads();
    const bool use_bar = (hi - lo) > 1;
    XcdBarrier bar; bar.bar = barw; bar.x = 0; bar.st = misc;
    if (use_bar) bar = xcd_barrier_post(barw, misc);
    PH(0, ph_convert(p, flds); ph_mod_partial(p, e1); ph_rw_wpack(p, e1));
    PH(1, ph_mod_final(p, e1));
    layer_phases<0>(ka, lo, hi, flags, bar, lds);
    layer_phases<1>(ka, lo, hi, flags, bar, lds);
    static_assert(DEPTH == 2, "depth");
    PH(2 + DEPTH * NPL, ph_final<64>(p, e64));
}
#undef PH
#undef e1
#undef e16
#undef e64
#undef flds
#undef glds
#undef G
#undef c
#undef LOADP

static size_t ws_carve(Params& p, unsigned char* ws) {
    size_t off = 0;
    auto take = [&](size_t bytes) { size_t o = off; off += (bytes + 255) / 256 * 256; return ws ? ws + o : (unsigned char*)nullptr; };
    p.bar = (unsigned*)take(XCD_BAR_WORDS * 4);
    p.modp = (float*)take((size_t)DEPTH * MOD_KS * 3 * 6 * D_MODEL * 4); p.mod = (float*)take((size_t)DEPTH * 3 * 6 * D_MODEL * 4);
    p.wt_in = (u16*)take((size_t)DEPTH * LDP * D_MODEL * 2); p.wt_out = (u16*)take((size_t)DEPTH * D_MODEL * D_MODEL * 2);
    p.w13t = (u16*)take((size_t)DEPTH * NE * 2 * D_MODEL * D_MODEL * 2); p.w2t = (u16*)take((size_t)DEPTH * NE * D_MODEL * D_MODEL * 2);
    p.xres = (float*)take((size_t)MROWS * D_MODEL * 4); p.h = (u16*)take((size_t)MROWS * D_MODEL * 2); p.mix = (u16*)take((size_t)MROWS * D_MODEL * 2);
    p.aff = (float*)take((size_t)MROWS * NE * 4); p.inv = (int*)take((size_t)MROWS * NE * 4);
    p.sel_row = (int*)take((size_t)NE * NSLOT * 4); p.sel_gate = (float*)take((size_t)NE * NSLOT * 4);
    const size_t region = off;
    p.P = (float*)take((size_t)MROWS * LDP * 4);
    const size_t rg = (size_t)MROWS * GROUP_W * 4;
    p.rw_r = (float*)take(rg); p.rw_k = (float*)take(rg); p.rw_v = (float*)take(rg); p.rw_kk = (float*)take(rg); p.rw_g = (float*)take(rg);
    p.rw_lr = (float*)take((size_t)MROWS * RW_LR * 4);
    p.rw_ew = (float*)take(2 * rg); p.rw_kka = (float*)take(2 * rg); p.rw_kt = (float*)take(2 * rg); p.rw_y = (float*)take(2 * rg);
    p.rw_Ma = (float*)take((size_t)RW_CN * CHUNK * CHUNK * 4); p.rw_T = (float*)take((size_t)RW_CN * CHUNK * CHUNK * 4);
    p.rw_Psi = (float*)take((size_t)RW_CN * RW_N * RW_N * 4); p.rw_Y0 = p.rw_Ma;
    p.rw_PhiT = (u16*)take((size_t)RW_CN * RW_N * RW_N * 2); p.rw_Rh = (u16*)take((size_t)RW_CN * CHUNK * RW_N * 2);
    p.rw_W = (u16*)take((size_t)DEPTH * GROUP_W * RW_WK * 2);
    p.ml_bcum = (float*)take((size_t)ML_CH * TOK * 4); p.ml_g = (float*)take((size_t)ML_CH * TOK * 4); p.ml_gmax = (float*)take((size_t)ML_CH * TOK * 4);
    p.ml_bl = (float*)take((size_t)ML_CH * NCHUNK * 4); p.ml_gm = (float*)take((size_t)ML_CH * NCHUNK * 4); p.ml_min = (float*)take((size_t)ML_CH * NCHUNK * 4); p.ml_dcv = (float*)take((size_t)ML_CH * NCHUNK * 4);
    p.ml_dC = (float*)take((size_t)ML_CH * NCHUNK * ML_HEAD * ML_HEAD * 4); p.ml_dn = (float*)take((size_t)ML_CH * NCHUNK * ML_HEAD * 4);
    p.ml_S = (float*)take((size_t)ML_CH * NCHUNK * CHUNK * CHUNK * 4); p.ml_hh = (float*)take(2 * rg);
    p.gd_q = (float*)take(rg); p.gd_k = (float*)take(rg); p.gd_v = (float*)take(rg);
    p.gd_gc = (float*)take((size_t)GD_CH * TOK * 4); p.gd_beta = (float*)take((size_t)GD_CH * TOK * 4);
    p.gd_A = (float*)take((size_t)GD_CN * CHUNK * CHUNK * 4); p.gd_T = (float*)take((size_t)GD_CN * CHUNK * CHUNK * 4);
    p.gd_Psi = (float*)take((size_t)GD_CN * GD_N * GD_N * 4); p.gd_O0 = (float*)take((size_t)GD_CN * CHUNK * GD_N * 4);
    p.gd_Phi = (u16*)take((size_t)GD_CN * GD_N * GD_N * 2); p.gd_Qh = (u16*)p.gd_A;
    p.gd_o = (float*)take(2 * rg);
    p.at_q = (u16*)take((size_t)BATCH * AT_QH * TOK * AT_HEAD * 2); p.at_k = (u16*)take((size_t)BATCH * AT_KVH * TOK * AT_HEAD * 2); p.at_v = (u16*)take((size_t)BATCH * AT_KVH * TOK * AT_HEAD * 2);
    const size_t end1 = off;
    off = region;
    p.xs = (u16*)take((size_t)NE * NSLOT * D_MODEL * 2); p.hid = (u16*)take((size_t)NE * NSLOT * D_MODEL * 2); p.yexp = (float*)take((size_t)NE * NSLOT * D_MODEL * 4);
    return end1 > off ? end1 : off;
}

#ifndef MK_PER_PHASE
#define MK_PER_PHASE 0
#endif
extern "C" void kernel_launch(void* const* d_in, const int* in_sizes, int n_in, void* d_out, int out_size, void* d_ws, size_t ws_size, hipStream_t stream) {
    static int grid = 0;
    if (grid == 0) {
        Params q{}; const size_t need = ws_carve(q, nullptr);
        if (n_in != 35 || out_size != BATCH * SEQ * D_MODEL || ws_size < need) {
            fprintf(stderr, "kernel_launch: expected 35 inputs, out %d, ws >= %zu; got n_in %d out %d ws %zu\n", BATCH * SEQ * D_MODEL, need, n_in, out_size, ws_size); grid = -1; return; }
        int dev = 0, cus = 0, per_cu = 0;
        if (hipGetDevice(&dev) != hipSuccess || hipDeviceGetAttribute(&cus, hipDeviceAttributeMultiprocessorCount, dev) != hipSuccess) { grid = -1; return; }
        if (hipFuncSetAttribute((const void*)mega, hipFuncAttributeMaxDynamicSharedMemorySize, LDS_BYTES) != hipSuccess) { fprintf(stderr, "kernel_launch: hipFuncSetAttribute failed\n"); grid = -1; return; }
        if (hipOccupancyMaxActiveBlocksPerMultiprocessor(&per_cu, (const void*)mega, 512, LDS_BYTES) != hipSuccess || per_cu < 1)
            fprintf(stderr, "kernel_launch: occupancy query reports %d workgroups per CU\n", per_cu);
        (void)hipGetLastError();
        if (cus < 160) { fprintf(stderr, "kernel_launch: needs >= 160 CUs\n"); grid = -1; return; }
        grid = cus;
    }
    if (grid < 0) return;
    Args a{};
    Params& p = a.p;
    const float** in = (const float**)&p;
    for (int i = 0; i < 35; ++i) in[i] = (const float*)d_in[i];
    p.out = (float*)d_out;
    (void)ws_carve(p, (unsigned char*)d_ws);
    (void)hipMemsetAsync(p.bar, 0, XCD_BAR_WORDS * 4, stream);
#if MK_PER_PHASE
    for (int k = 0; k < NPHASE; ++k) { a.ph_lo = k; a.ph_hi = k + 1; hipLaunchKernelGGL(mega, dim3(grid), dim3(512), LDS_BYTES, stream, a); }
#else
#ifdef MK_PROBE_K
#ifdef MK_PROBE_FLAGS
    a.flags = MK_PROBE_FLAGS;
#endif
    a.ph_lo = 0; a.ph_hi = MK_PROBE_K;
    hipLaunchKernelGGL(mega, dim3(grid), dim3(512), LDS_BYTES, stream, a);
    (void)hipMemsetAsync(p.bar, 0, XCD_BAR_WORDS * 4, stream);
    a.flags = 0;
#endif
    a.ph_lo = 0; a.ph_hi = NPHASE;
    hipLaunchKernelGGL(mega, dim3(grid), dim3(512), LDS_BYTES, stream, a);
#endif
    const hipError_t le = hipPeekAtLastError();
    if (le != hipSuccess) fprintf(stderr, "kernel_launch: launch failed: %s\n", hipGetErrorName(le));
}
```

```cpp
#include <hip/hip_runtime.h>

#ifndef CFG_D_MODEL
#define CFG_D_MODEL 2048
#define CFG_SEQ 4096
#define CFG_GRID_W 64
#define CFG_CTX 256
#define CFG_RW_HEAD 64
#define CFG_RW_DR 64
#define CFG_RW_IR 64
#define CFG_RW_GR 128
#define CFG_ML_HEAD 128
#define CFG_CHUNK 64
#define CFG_GD_HEAD 128
#define CFG_AT_HEAD 128
#define CFG_AT_KVH 2
#define CFG_NE 16
#endif

constexpr int D_MODEL = CFG_D_MODEL, BATCH = 2, SEQ = CFG_SEQ, DEPTH = 2, GRID_W = CFG_GRID_W, CTX = CFG_CTX;
constexpr int TOK = CTX + SEQ, MROWS = BATCH * TOK, GROUP_W = D_MODEL / 4;
constexpr int RW_HEAD = CFG_RW_HEAD, RW_HEADS = GROUP_W / RW_HEAD, RW_DR = CFG_RW_DR, RW_IR = CFG_RW_IR, RW_GR = CFG_RW_GR;
constexpr int RW_COLS = 3 * GROUP_W + RW_DR + RW_IR + RW_GR, RW_LR = RW_DR + RW_IR + RW_GR;
constexpr int ML_HEAD = CFG_ML_HEAD, ML_HEADS = GROUP_W / ML_HEAD, CHUNK = CFG_CHUNK, ML_COLS = 4 * GROUP_W + 4 * ML_HEADS;
constexpr int GD_HEAD = CFG_GD_HEAD, GD_HEADS = GROUP_W / GD_HEAD, GD_COLS = 4 * GROUP_W + 4 * GD_HEADS;
constexpr int AT_HEAD = CFG_AT_HEAD, AT_QH = GROUP_W / AT_HEAD, AT_KVH = CFG_AT_KVH, AT_COLS = (AT_QH + 2 * AT_KVH) * AT_HEAD;
constexpr int N_IN = RW_COLS + ML_COLS + GD_COLS + AT_COLS;
constexpr int RW_OFF = 0, ML_OFF = RW_COLS, GD_OFF = ML_OFF + ML_COLS, AT_OFF = GD_OFF + GD_COLS;
constexpr int LDP = (N_IN + 255) / 256 * 256;
constexpr int NE = CFG_NE, CAPL = 2 * SEQ / NE, CAPC = 2 * CTX / NE;
constexpr int NSLOT_L = BATCH * CAPL, NSLOT_C = BATCH * CAPC;
constexpr int NSLOT = (NSLOT_L + NSLOT_C + 255) / 256 * 256;
constexpr int NCHUNK = TOK / CHUNK, ML_CH = BATCH * ML_HEADS * 2, GD_CH = BATCH * GD_HEADS * 2, RW_CH = BATCH * RW_HEADS * 2;
constexpr float NORM_EPS = 1e-6f, RW_GN_EPS = 64e-5f, RW_DECAY_SCALE = 0.6065306597126334f;
static_assert(ML_HEADS == GD_HEADS, "heads");

typedef unsigned short u16;

#ifdef CPU_TEST
#include <cmath>
#include <cstdint>
#include <cstring>
#define HD inline
#else
#define HD __device__ __forceinline__
#endif

struct Params {
    const float *x, *c, *ctx, *c_ctx, *ada_w, *ada_b, *norm1_g, *norm2_g, *w_in, *w_out;
    const float *rw_mu, *rw_w0, *rw_w_up, *rw_a0, *rw_a_up, *rw_g_up, *rw_k_k, *rw_k_a, *rw_r_k, *rw_ln_w, *rw_ln_b;
    const float *ml_ib, *ml_fb, *ml_norm_g, *gd_conv, *gd_a_log, *gd_dt_bias, *gd_norm_g, *at_q_norm, *at_k_norm;
    const float *w_router, *w_exp1, *w_exp3, *w_exp2, *final_g;
    float* out;
    unsigned* bar;
    float *modp, *mod;
    u16 *wt_in, *wt_out, *w13t, *w2t;
    float* xres;
    u16* h;
    float* P;
    float *rw_r, *rw_k, *rw_v, *rw_lr, *rw_kk, *rw_g, *rw_ew, *rw_kka, *rw_kt, *rw_y;
    float *rw_Ma, *rw_T, *rw_Psi, *rw_Y0; u16 *rw_PhiT, *rw_Rh, *rw_W;
    float *ml_bcum, *ml_g, *ml_gmax, *ml_bl, *ml_gm, *ml_min, *ml_dcv, *ml_dC, *ml_dn, *ml_S, *ml_hh;
    float *gd_q, *gd_k, *gd_v, *gd_gc, *gd_beta, *gd_A, *gd_T, *gd_Psi, *gd_O0, *gd_o; u16 *gd_Phi, *gd_Qh;
    u16 *at_q, *at_k, *at_v;
    u16* mix;
    float* aff; int* inv;
    int* sel_row; float* sel_gate;
    u16 *xs, *hid; float* yexp;
};

struct Exec { int gid, ngroups, gl; };

template <int G> HD float group_sum(float v) {
#ifndef CPU_TEST
#pragma unroll
    for (int o = G / 2; o > 0; o >>= 1) v += __shfl_xor(v, o, 64);
#endif
    return v;
}
template <int G> HD float group_max(float v) {
#ifndef CPU_TEST
#pragma unroll
    for (int o = G / 2; o > 0; o >>= 1) v = fmaxf(v, __shfl_xor(v, o, 64));
#endif
    return v;
}

template <int G> HD float group_scan_sum(float v, int gl) {
#ifndef CPU_TEST
#pragma unroll
    for (int o = 1; o < G; o <<= 1) { const float t = __shfl_up(v, o, G); if (gl >= o) v += t; }
#endif
    (void)gl; return v;
}
template <int G> HD float group_scan_max(float v, int gl) {
#ifndef CPU_TEST
#pragma unroll
    for (int o = 1; o < G; o <<= 1) { const float t = __shfl_up(v, o, G); if (gl >= o) v = fmaxf(v, t); }
#endif
    (void)gl; return v;
}
template <int G> HD float group_last(float v) {
#ifndef CPU_TEST
    v = __shfl(v, G - 1, G);
#endif
    return v;
}

HD u16 f2bf(float f) { unsigned u; memcpy(&u, &f, 4); u += 0x7FFFu + ((u >> 16) & 1u); return (u16)(u >> 16); }
HD float bf2f(u16 b) { unsigned u = ((unsigned)b) << 16; float f; memcpy(&f, &u, 4); return f; }
HD float sigmoidf_(float x) { return 1.f / (1.f + expf(-x)); }
HD float siluf_(float x) { return x / (1.f + expf(-x)); }
HD float softplusf_(float x) { return x > 20.f ? x : log1pf(expf(x)); }
HD float logsigmoidf_(float x) { return x < 0.f ? x - log1pf(expf(x)) : -log1pf(expf(-x)); }

HD float bf_round(float f) { return bf2f(f2bf(f)); }
#ifndef CPU_TEST
typedef short mma_bf16x8 __attribute__((ext_vector_type(8)));
typedef float mma_f32x16 __attribute__((ext_vector_type(16)));
__device__ __forceinline__ unsigned mma_cvt_pk(float lo, float hi) { unsigned r; asm volatile("v_cvt_pk_bf16_f32 %0, %1, %2" : "=v"(r) : "v"(lo), "v"(hi)); return r; }
#endif
struct Frag {
#ifdef CPU_TEST
    float v[8];
    HD void ld_bf(const u16* p) { for (int j = 0; j < 8; ++j) v[j] = bf2f(p[j]); }
    HD void ld_f(const float* p) { for (int j = 0; j < 8; ++j) v[j] = bf_round(p[j]); }
    HD void ld_f_scaled(const float* p, float w) { for (int j = 0; j < 8; ++j) v[j] = bf_round(p[j] * w); }
    HD void set1(float x) { for (int j = 0; j < 8; ++j) v[j] = bf_round(x); }
    HD void neg() { for (int j = 0; j < 8; ++j) v[j] = -v[j]; }
#else
    typedef unsigned u4 __attribute__((ext_vector_type(4)));
    typedef float f4 __attribute__((ext_vector_type(4)));
    u4 raw;
    HD void ld_bf(const u16* p) { raw = *(const u4*)p; }
    HD void ld_f(const float* p) { const f4 a = *(const f4*)p, b = *(const f4*)(p + 4);
        raw.x = mma_cvt_pk(a.x, a.y); raw.y = mma_cvt_pk(a.z, a.w); raw.z = mma_cvt_pk(b.x, b.y); raw.w = mma_cvt_pk(b.z, b.w); }
    HD void ld_f_scaled(const float* p, float w) { const f4 a = *(const f4*)p * w, b = *(const f4*)(p + 4) * w;
        raw.x = mma_cvt_pk(a.x, a.y); raw.y = mma_cvt_pk(a.z, a.w); raw.z = mma_cvt_pk(b.x, b.y); raw.w = mma_cvt_pk(b.z, b.w); }
    HD void set1(float x) { const unsigned q = mma_cvt_pk(x, x); raw.x = q; raw.y = q; raw.z = q; raw.w = q; }
    HD void neg() { raw.x ^= 0x80008000u; raw.y ^= 0x80008000u; raw.z ^= 0x80008000u; raw.w ^= 0x80008000u; }
#endif
};
#ifdef CPU_TEST
constexpr int MMA_SLOTS = 1024;
#else
constexpr int MMA_SLOTS = 16;
#endif
template <int K, class FA, class FB, class FE> HD void wave_mma32(int lane, FA fa, FB fb, FE fe) {
    static_assert(K % 16 == 0, "K");
#ifdef CPU_TEST
    (void)lane;
    for (int m = 0; m < 32; ++m) for (int n = 0; n < 32; ++n) { float acc = 0.f;
        for (int k0 = 0; k0 < K; k0 += 8) { Frag a8, b8; fa(m, k0, a8); fb(n, k0, b8);
            for (int j = 0; j < 8; ++j) acc += a8.v[j] * b8.v[j]; }
        fe(m, n, acc, m * 32 + n); }
#else
    const int r = lane & 31, h = lane >> 5;
    mma_f32x16 acc;
#pragma unroll
    for (int q = 0; q < 16; ++q) acc[q] = 0.f;
#pragma unroll
    for (int k0 = 0; k0 < K; k0 += 16) { Frag a8, b8; fa(r, k0 + 8 * h, a8); fb(r, k0 + 8 * h, b8);
        acc = __builtin_amdgcn_mfma_f32_32x32x16_bf16(__builtin_bit_cast(mma_bf16x8, a8.raw), __builtin_bit_cast(mma_bf16x8, b8.raw), acc, 0, 0, 0); }
#pragma unroll
    for (int q = 0; q < 16; ++q) fe((q & 3) + 8 * (q >> 2) + 4 * h, r, acc[q], q);
#endif
}

#ifndef CPU_TEST
typedef unsigned pfv4 __attribute__((ext_vector_type(4)));
template <int NQ> HD void pf_ld_lin(pfv4 (&r)[NQ], const void* src, int tid) {
#pragma unroll
    for (int q = 0; q < NQ; ++q) r[q] = ((const pfv4*)src)[tid + q * 512]; }
template <int NQ> HD void pf_ld_rows(pfv4 (&r)[NQ], const float* src, int per_row, int row_stride, int tid) {
#pragma unroll
    for (int q = 0; q < NQ; ++q) { const int i = tid + q * 512; r[q] = *(const pfv4*)(src + (size_t)(i / per_row) * row_stride + (i % per_row) * 4); } }
template <int NQ> HD void pf_st_lin(const pfv4 (&r)[NQ], void* dst, int tid) {
#pragma unroll
    for (int q = 0; q < NQ; ++q) ((pfv4*)dst)[tid + q * 512] = r[q]; }
template <int NQ> HD void pf_st_pad(const pfv4 (&r)[NQ], u16* dst, int per_row, int ld, int tid) {
#pragma unroll
    for (int q = 0; q < NQ; ++q) { const int i = tid + q * 512; *(pfv4*)(dst + (i / per_row) * ld + (i % per_row) * 8) = r[q]; } }
#endif
#ifdef CPU_TEST
#define BLOCK_SYNC()
#define BLOCK_FOR(i, n) for (int i = 0; i < (n); ++i)
#define WAVE_FOR(w, n) for (int w = 0; w < (n); ++w)
#define LANE 0
#define OPAQUE_TID()
#define OPAQUE_I(x)
#else
#define BLOCK_SYNC() __syncthreads()
#define BLOCK_FOR(i, n) for (int i = tid; i < (n); i += nthr)
#define WAVE_FOR(w, n) _Pragma("unroll 1") for (int w = tid >> 6; w < (n); w += (nthr >> 6))
#define LANE (tid & 63)
#define OPAQUE_I(x) asm volatile("" : "+v"(x))
#define OPAQUE_TID() asm volatile("" : "+v"(tid))
#endif

HD int row_b(int R) { return R / TOK; }
HD int row_s(int R) { return R % TOK; }
HD bool row_ctx(int R) { return row_s(R) < CTX; }
HD int mod_sel(int R) { return row_ctx(R) ? 2 : row_b(R); }
HD int seq_s(int d, int p) { return d == 0 ? p : (p < CTX ? CTX - 1 - p : TOK - 1 - (p - CTX)); }
HD const float* modv(const Params& p, int layer, int sel, int k) { return p.mod + ((size_t)(layer * 3 + sel) * 6 + k) * D_MODEL; }

#ifdef CPU_TEST
struct alignas(16) F4 { float x, y, z, w; };
HD F4 operator+(F4 a, F4 b) { return F4{a.x + b.x, a.y + b.y, a.z + b.z, a.w + b.w}; }
HD F4 operator-(F4 a, F4 b) { return F4{a.x - b.x, a.y - b.y, a.z - b.z, a.w - b.w}; }
HD F4 operator*(F4 a, F4 b) { return F4{a.x * b.x, a.y * b.y, a.z * b.z, a.w * b.w}; }
HD F4 operator*(F4 a, float s) { return F4{a.x * s, a.y * s, a.z * s, a.w * s}; }
HD F4 operator+(F4 a, float s) { return F4{a.x + s, a.y + s, a.z + s, a.w + s}; }
#else
typedef float F4 __attribute__((ext_vector_type(4)));
#endif
struct alignas(8) H4 { u16 x, y, z, w; };
HD F4 ld4(const float* p) { return *(const F4*)p; }
HD void st4(float* p, F4 v) { *(F4*)p = v; }
HD float hsum(F4 a) { return (a.x + a.y) + (a.z + a.w); }
HD void st4bf(u16* p, F4 v) { *(H4*)p = H4{f2bf(v.x), f2bf(v.y), f2bf(v.z), f2bf(v.w)}; }

constexpr int MOD_KS = 16;
HD void ph_mod_partial(const Params& p, Exec e) {
    const int n = DEPTH * MOD_KS * 6 * D_MODEL;
    for (int it = e.gid; it < n; it += e.ngroups) {
        const int col = it % (6 * D_MODEL), ks = (it / (6 * D_MODEL)) % MOD_KS, l = it / (6 * D_MODEL * MOD_KS);
        const float* w = p.ada_w + (size_t)l * D_MODEL * 6 * D_MODEL + col;
        float a0 = 0.f, a1 = 0.f, a2 = 0.f;
        const int k0 = ks * (D_MODEL / MOD_KS);
        for (int k = k0; k < k0 + D_MODEL / MOD_KS; ++k) {
            const float wv = w[(size_t)k * 6 * D_MODEL];
            a0 += siluf_(p.c[k]) * wv; a1 += siluf_(p.c[D_MODEL + k]) * wv; a2 += siluf_(p.c_ctx[k]) * wv;
        }
        float* o = p.modp + ((size_t)(l * MOD_KS + ks) * 3) * 6 * D_MODEL + col;
        o[0] = a0; o[6 * D_MODEL] = a1; o[2 * 6 * D_MODEL] = a2;
    }
}
HD void ph_mod_final(const Params& p, Exec e) {
    const int n = DEPTH * 3 * 6 * D_MODEL;
    for (int it = e.gid; it < n; it += e.ngroups) {
        const int col = it % (6 * D_MODEL), sel = (it / (6 * D_MODEL)) % 3, l = it / (6 * D_MODEL * 3);
        float a = p.ada_b[l * 6 * D_MODEL + col];
        for (int ks = 0; ks < MOD_KS; ++ks) a += p.modp[((size_t)(l * MOD_KS + ks) * 3 + sel) * 6 * D_MODEL + col];
        p.mod[(size_t)(l * 3 + sel) * 6 * D_MODEL + col] = a;
    }
}

template <int G, int NI> HD void resid_row(const Params& p, int layer, int R, int gl, F4 (&v)[NI]) {
    if (layer == 0) { const int b = row_b(R), sx = row_s(R);
        const float* src = sx < CTX ? p.ctx + ((size_t)b * CTX + sx) * D_MODEL : p.x + ((size_t)b * SEQ + (sx - CTX)) * D_MODEL;
#pragma unroll
        for (int i = 0; i < NI; ++i) v[i] = ld4(src + (gl + G * i) * 4);
        return; }
    F4 acc[NI];
#pragma unroll
    for (int i = 0; i < NI; ++i) acc[i] = F4{0.f, 0.f, 0.f, 0.f};
    for (int ex = 0; ex < NE; ++ex) { const int j = p.inv[(size_t)R * NE + ex];
        if (j >= 0) { const float* y = p.yexp + ((size_t)ex * NSLOT + j) * D_MODEL;
#pragma unroll
            for (int i = 0; i < NI; ++i) acc[i] = acc[i] + ld4(y + (gl + G * i) * 4); } }
    const float* m5 = modv(p, layer - 1, mod_sel(R), 5);
#pragma unroll
    for (int i = 0; i < NI; ++i) { const int c4 = (gl + G * i) * 4; v[i] = ld4(p.xres + (size_t)R * D_MODEL + c4) + ld4(m5 + c4) * acc[i]; }
}
template <int G> HD void ph_norm1(const Params& p, int layer, Exec e) {
    constexpr int NI = D_MODEL / 4 / G;
    for (int R = e.gid; R < MROWS; R += e.ngroups) {
        int gl = e.gl; OPAQUE_I(gl);
        F4 v[NI]; resid_row<G, NI>(p, layer, R, gl, v);
        float ss = 0.f;
#pragma unroll
        for (int i = 0; i < NI; ++i) ss += hsum(v[i] * v[i]);
        ss = group_sum<G>(ss);
        const float rstd = 1.f / sqrtf(ss / D_MODEL + NORM_EPS);
        const int sel = mod_sel(R); const float *m0 = modv(p, layer, sel, 0), *m1 = modv(p, layer, sel, 1), *g = p.norm1_g + layer * D_MODEL;
#pragma unroll
        for (int i = 0; i < NI; ++i) { const int c4 = (gl + G * i) * 4; st4(p.xres + (size_t)R * D_MODEL + c4, v[i]);
            st4bf(p.h + (size_t)R * D_MODEL + c4, v[i] * rstd * ld4(g + c4) * (ld4(m1 + c4) + 1.f) + ld4(m0 + c4)); }
    }
}
template <int G> HD void ph_final(const Params& p, Exec e) {
    constexpr int NI = D_MODEL / 4 / G;
    for (int it = e.gid; it < BATCH * SEQ; it += e.ngroups) {
        const int b = it / SEQ, t = it % SEQ, R = b * TOK + CTX + t;
        int gl = e.gl; OPAQUE_I(gl);
        F4 v[NI]; resid_row<G, NI>(p, DEPTH, R, gl, v);
        float ss = 0.f;
#pragma unroll
        for (int i = 0; i < NI; ++i) ss += hsum(v[i] * v[i]);
        ss = group_sum<G>(ss);
        const float rstd = 1.f / sqrtf(ss / D_MODEL + NORM_EPS);
#pragma unroll
        for (int i = 0; i < NI; ++i) { const int c4 = (gl + G * i) * 4; st4(p.out + (size_t)it * D_MODEL + c4, v[i] * rstd * ld4(p.final_g + c4)); }
    }
}
template <int G> HD void ph_norm2(const Params& p, int layer, Exec e) {
    constexpr int NI = D_MODEL / 4 / G;
    static_assert(NE % 4 == 0, "router");
    const bool last = layer == DEPTH - 1;
    for (int R = e.gid; R < MROWS; R += e.ngroups) {
        if (last && row_ctx(R)) continue;
        int gl = e.gl; OPAQUE_I(gl);
        F4 v[NI]; float ss = 0.f;
#pragma unroll
        for (int i = 0; i < NI; ++i) { v[i] = ld4(p.xres + (size_t)R * D_MODEL + (gl + G * i) * 4); ss += hsum(v[i] * v[i]); }
        ss = group_sum<G>(ss);
        const float rstd = 1.f / sqrtf(ss / D_MODEL + NORM_EPS);
        const int sel = mod_sel(R); const float *m3 = modv(p, layer, sel, 3), *m4 = modv(p, layer, sel, 4), *g = p.norm2_g + layer * D_MODEL;
        const float* wr = p.w_router + (size_t)layer * D_MODEL * NE;
        F4 lg[NE / 4];
#pragma unroll
        for (int q = 0; q < NE / 4; ++q) lg[q] = F4{0.f, 0.f, 0.f, 0.f};
#pragma unroll
        for (int i = 0; i < NI; ++i) { const int c4 = (gl + G * i) * 4;
            const F4 hv = v[i] * rstd * ld4(g + c4) * (ld4(m4 + c4) + 1.f) + ld4(m3 + c4);
            st4bf(p.h + (size_t)R * D_MODEL + c4, hv);
#pragma unroll
            for (int q = 0; q < NE / 4; ++q) lg[q] = lg[q] + ld4(wr + (size_t)(c4 + 0) * NE + 4 * q) * hv.x + ld4(wr + (size_t)(c4 + 1) * NE + 4 * q) * hv.y
                                                            + ld4(wr + (size_t)(c4 + 2) * NE + 4 * q) * hv.z + ld4(wr + (size_t)(c4 + 3) * NE + 4 * q) * hv.w; }
        float l1[NE]; float mx = -1e30f;
#pragma unroll
        for (int q = 0; q < NE / 4; ++q) { l1[4 * q] = group_sum<G>(lg[q].x); l1[4 * q + 1] = group_sum<G>(lg[q].y); l1[4 * q + 2] = group_sum<G>(lg[q].z); l1[4 * q + 3] = group_sum<G>(lg[q].w); }
#pragma unroll
        for (int ex = 0; ex < NE; ++ex) mx = fmaxf(mx, l1[ex]);
        float sum = 0.f;
#pragma unroll
        for (int ex = 0; ex < NE; ++ex) { l1[ex] = expf(l1[ex] - mx); sum += l1[ex]; }
        if (gl == 0) {
#pragma unroll
            for (int ex = 0; ex < NE; ++ex) p.aff[(size_t)R * NE + ex] = l1[ex] / sum; }
    }
}
constexpr int TK_PART = 512, TK_PARTS = (SEQ + TK_PART - 1) / TK_PART, TK_SMEM = (SEQ > CTX ? SEQ : CTX) * 4;
HD int topk_units(int layer) { return BATCH * NE * TK_PARTS + (layer == DEPTH - 1 ? 0 : BATCH * NE) + 1; }
HD void ph_topk_unit(const Params& p, int layer, int unit, int tid, int nthr, unsigned char* smem) {
    (void)tid; (void)nthr; OPAQUE_TID();
    const bool last = layer == DEPTH - 1;
    const int nl = BATCH * NE * TK_PARTS, nc = last ? 0 : BATCH * NE;
    float* col = (float*)smem;
    if (unit >= nl + nc) {
        const int per = NSLOT - NSLOT_L - (last ? 0 : NSLOT_C);
        BLOCK_FOR(q, NE * per) { const int ex = q / per, j = NSLOT - per + q % per; p.sel_row[ex * NSLOT + j] = 0; p.sel_gate[ex * NSLOT + j] = 0.f; }
        return; }
    int b, ex, L, base, cap, jbase, t0, t1;
    if (unit < nl) { const int part = unit % TK_PARTS; ex = (unit / TK_PARTS) % NE; b = unit / (TK_PARTS * NE); L = SEQ; base = b * TOK + CTX; cap = CAPL; jbase = b * CAPL;
        t0 = part * TK_PART; t1 = t0 + TK_PART < SEQ ? t0 + TK_PART : SEQ; }
    else { const int q = unit - nl; ex = q % NE; b = q / NE; L = CTX; base = b * TOK; cap = CAPC; jbase = NSLOT_L + b * CAPC; t0 = 0; t1 = CTX; }
    BLOCK_FOR(u, L) col[u] = p.aff[(size_t)(base + u) * NE + ex];
    BLOCK_SYNC();
    BLOCK_FOR(q, t1 - t0) { const int t = t0 + q; const float a = col[t]; int rank = 0;
        for (int u = 0; u < L; ++u) { const float au = col[u]; rank += (au > a || (au == a && u < t)) ? 1 : 0; }
        if (rank < cap) { const int j = jbase + rank; p.sel_row[ex * NSLOT + j] = base + t; p.sel_gate[ex * NSLOT + j] = a; p.inv[(size_t)(base + t) * NE + ex] = j; }
        else p.inv[(size_t)(base + t) * NE + ex] = -1; }
    BLOCK_SYNC();
}
template <int G> HD void ph_gather(const Params& p, int layer, Exec e) {
    const bool last = layer == DEPTH - 1;
    const int nj = last ? NSLOT_L : NSLOT;
    for (int it = e.gid; it < NE * nj; it += e.ngroups) {
        const int ex = it / nj, j = it % nj, R = p.sel_row[ex * NSLOT + j];
        const uint4* s = (const uint4*)(p.h + (size_t)R * D_MODEL); uint4* d = (uint4*)(p.xs + ((size_t)ex * NSLOT + j) * D_MODEL);
        for (int c = e.gl; c < D_MODEL / 8; c += G) d[c] = s[c];
    }
}

template <int G> HD void ph_rw_prep1(const Params& p, int layer, Exec e) {
    const float* mu = p.rw_mu + (size_t)layer * 2 * RW_COLS;
    for (int R = e.gid; R < MROWS; R += e.ngroups) {
        const int s = row_s(R); const bool hp = (s != 0 && s != CTX), hn = (s != CTX - 1 && s != TOK - 1);
        const float* pr = p.P + (size_t)R * LDP + RW_OFF;
        for (int c = e.gl; c < RW_COLS; c += G) {
            const float v = pr[c], pv = hp ? pr[c - LDP] : 0.f, nv = hn ? pr[c + LDP] : 0.f;
            const float pp = v + mu[c] * (pv - v) + mu[RW_COLS + c] * (nv - v);
            if (c < GROUP_W) p.rw_r[(size_t)R * GROUP_W + c] = pp;
            else if (c < 2 * GROUP_W) p.rw_k[(size_t)R * GROUP_W + c - GROUP_W] = pp;
            else if (c < 3 * GROUP_W) p.rw_v[(size_t)R * GROUP_W + c - 2 * GROUP_W] = pp;
            else { const int q = c - 3 * GROUP_W; float o;
                if (q < RW_DR) o = tanhf(pp); else if (q < RW_DR + RW_IR) o = pp; else o = sigmoidf_(pp);
                p.rw_lr[(size_t)R * RW_LR + q] = o; }
        }
        const float* kk_w = p.rw_k_k + layer * GROUP_W;
        for (int hh = 0; hh < RW_HEADS; ++hh) { float ss = 0.f;
            for (int j = hh * RW_HEAD + e.gl; j < (hh + 1) * RW_HEAD; j += G) { const float xk = p.rw_k[(size_t)R * GROUP_W + j] * kk_w[j]; ss += xk * xk; }
            ss = group_sum<G>(ss); const float rn = 1.f / sqrtf(ss + 1e-6f);
            for (int j = hh * RW_HEAD + e.gl; j < (hh + 1) * RW_HEAD; j += G) p.rw_kk[(size_t)R * GROUP_W + j] = p.rw_k[(size_t)R * GROUP_W + j] * kk_w[j] * rn; }
    }
}
constexpr int RW_WK = 2 * RW_DR + 2 * RW_IR + RW_GR;
static_assert(RW_DR % 16 == 0 && RW_IR % 16 == 0 && RW_GR % 16 == 0, "low-rank K");
HD void ph_rw_wpack(const Params& p, Exec e) {
    for (int it = e.gid; it < DEPTH * GROUP_W * RW_WK; it += e.ngroups) {
        const int kk = it % RW_WK, j = (it / RW_WK) % GROUP_W, l = it / (RW_WK * GROUP_W); float v;
        if (kk < 2 * RW_DR) { const int d = kk / RW_DR, i = kk % RW_DR; v = p.rw_w_up[((size_t)(l * 2 + d) * RW_DR + i) * GROUP_W + j]; }
        else if (kk < 2 * RW_DR + 2 * RW_IR) { const int q = kk - 2 * RW_DR, d = q / RW_IR, i = q % RW_IR; v = p.rw_a_up[((size_t)(l * 2 + d) * RW_IR + i) * GROUP_W + j]; }
        else { const int i = kk - 2 * RW_DR - 2 * RW_IR; v = p.rw_g_up[((size_t)l * RW_GR + i) * GROUP_W + j]; }
        p.rw_W[it] = f2bf(v);
    }
}
HD void ph_rw_prep2(const Params& p, int layer, Exec e) {
    static_assert(MROWS % 32 == 0 && GROUP_W % 32 == 0, "tiles");
    const float* ka_w = p.rw_k_a + layer * GROUP_W;
    for (int it = e.gid; it < (MROWS / 32) * (GROUP_W / 32); it += e.ngroups) {
        const int tm = it / (GROUP_W / 32), tn = it % (GROUP_W / 32);
        const u16* W = p.rw_W + ((size_t)layer * GROUP_W + tn * 32) * RW_WK; const float* A = p.rw_lr + (size_t)tm * 32 * RW_LR;
        float st[4][MMA_SLOTS];
#define RWP2_PROD(K_, AOFF, WOFF, ...) wave_mma32<K_>(e.gl, [&](int m, int k0, Frag& o) { o.ld_f(A + (size_t)m * RW_LR + (AOFF) + k0); }, \
                                                       [&](int nn, int k0, Frag& o) { o.ld_bf(W + (size_t)nn * RW_WK + (WOFF) + k0); }, __VA_ARGS__)
        RWP2_PROD(RW_DR, 0, 0, [&](int, int, float acc, int sl) { st[0][sl] = acc; });
        RWP2_PROD(RW_DR, 0, RW_DR, [&](int, int, float acc, int sl) { st[1][sl] = acc; });
        RWP2_PROD(RW_IR, RW_DR, 2 * RW_DR, [&](int, int, float acc, int sl) { st[2][sl] = acc; });
        RWP2_PROD(RW_IR, RW_DR, 2 * RW_DR + RW_IR, [&](int, int, float acc, int sl) { st[3][sl] = acc; });
        RWP2_PROD(RW_GR, RW_DR + RW_IR, 2 * RW_DR + 2 * RW_IR, [&](int m, int nn, float acc, int sl) {
            const int R = tm * 32 + m, j = tn * 32 + nn; const size_t o = (size_t)R * GROUP_W + j;
            p.rw_g[o] = acc;
            const float kv = p.rw_k[o], kkv = p.rw_kk[o];
            _Pragma("unroll") for (int d = 0; d < 2; ++d) { const float wl = p.rw_w0[(layer * 2 + d) * GROUP_W + j] + st[d][sl], al = p.rw_a0[(layer * 2 + d) * GROUP_W + j] + st[2 + d][sl];
                const float logw = -RW_DECAY_SCALE * sigmoidf_(wl), a = sigmoidf_(al); const size_t o2 = (size_t)d * MROWS * GROUP_W + o;
                p.rw_ew[o2] = logw; p.rw_kka[o2] = kkv * a; p.rw_kt[o2] = kv * (1.f + (a - 1.f) * ka_w[j]); } });
#undef RWP2_PROD
    }
}
template <int G> HD void ph_rw_scan(const Params& p, Exec e) {
    constexpr int KPL = RW_HEAD / G;
    for (int it = e.gid; it < RW_CH * RW_HEAD; it += e.ngroups) {
        const int i = it % RW_HEAD, ch = it / RW_HEAD, d = ch % 2, hh = (ch / 2) % RW_HEADS, b = ch / (2 * RW_HEADS);
        float S[KPL];
#pragma unroll
        for (int q = 0; q < KPL; ++q) S[q] = 0.f;
        const int k0 = hh * RW_HEAD + e.gl * KPL;
        for (int pos = 0; pos < TOK; ++pos) {
            const int R = b * TOK + seq_s(d, pos);
            const size_t o1 = (size_t)R * GROUP_W + k0, o2 = ((size_t)d * MROWS + R) * GROUP_W + k0;
            const float vv = p.rw_v[(size_t)R * GROUP_W + hh * RW_HEAD + i];
            float sk = 0.f;
#pragma unroll
            for (int q = 0; q < KPL; ++q) sk += S[q] * p.rw_kk[o1 + q];
            sk = group_sum<G>(sk);
            float y = 0.f;
#pragma unroll
            for (int q = 0; q < KPL; ++q) { S[q] = S[q] * p.rw_ew[o2 + q] - sk * p.rw_kka[o2 + q] + vv * p.rw_kt[o2 + q]; y += S[q] * p.rw_r[o1 + q]; }
            y = group_sum<G>(y);
            if (e.gl == 0) p.rw_y[((size_t)d * MROWS + R) * GROUP_W + hh * RW_HEAD + i] = y;
        }
    }
}

constexpr int RW_N = RW_HEAD, RW_CN = RW_CH * NCHUNK;
constexpr int LDPAD = 8;
static_assert(CHUNK % 32 == 0 && RW_HEAD % 32 == 0, "tile sizes");
HD void rw_chain(int ch, int& b, int& hh, int& d) { d = ch % 2; hh = (ch / 2) % RW_HEADS; b = ch / (2 * RW_HEADS); }
constexpr int RW_C1_SMEM = CHUNK * RW_N * 4 + 2 * CHUNK * (RW_N + LDPAD) * 2;
HD void ph_rw_c1_unit(const Params& p, int cn, int tid, int nthr, unsigned char* smem) {
    (void)tid; (void)nthr; OPAQUE_TID();
    constexpr int C = CHUNK, N = RW_N, LD = N + LDPAD;
    const int ch = cn / NCHUNK, n = cn % NCHUNK; int b, hh, d; rw_chain(ch, b, hh, d);
    float* cum = (float*)smem; u16* KKt = (u16*)(cum + C * N); u16* At = KKt + C * LD;
    const size_t dofs = (size_t)d * MROWS * GROUP_W;
    BLOCK_FOR(idx, C * N) { const int t = idx / N, k = idx % N, R = b * TOK + seq_s(d, n * C + t); cum[idx] = p.rw_ew[dofs + (size_t)R * GROUP_W + hh * N + k]; }
    BLOCK_SYNC();
    BLOCK_FOR(k, N) { float acc = 0.f; for (int t = 0; t < C; ++t) { acc += cum[t * N + k]; cum[t * N + k] = acc; } }
    BLOCK_SYNC();
    BLOCK_FOR(idx, C * N) { const int t = idx / N, k = idx % N, R = b * TOK + seq_s(d, n * C + t); const size_t o = (size_t)R * GROUP_W + hh * N + k;
        const float cu = cum[idx], cp = cu - p.rw_ew[dofs + o];
        KKt[t * LD + k] = f2bf(p.rw_kk[o] * expf(cp)); At[t * LD + k] = f2bf(p.rw_kka[dofs + o] * expf(-cu)); }
    BLOCK_SYNC();
    float* Ma = p.rw_Ma + (size_t)cn * C * C;
    WAVE_FOR(w, (C / 32) * (C / 32)) { const int tm = w / (C / 32), tn = w % (C / 32);
        wave_mma32<N>(LANE, [&](int m, int k0, Frag& o) { o.ld_bf(KKt + (tm * 32 + m) * LD + k0); },
                            [&](int nn, int k0, Frag& o) { o.ld_bf(At + (tn * 32 + nn) * LD + k0); },
                            [&](int m, int nn, float acc, int) { const int t = tm * 32 + m, sx = tn * 32 + nn; Ma[t * C + sx] = sx < t ? acc : 0.f; }); }
    BLOCK_SYNC();
}
constexpr int TS_G = 8, TS_SMEM = TS_G * CHUNK * CHUNK * 4;
HD void ph_tsolve_unit(const float* Mall, float* Tall, int nprob, int unit, int tid, int nthr, unsigned char* smem) {
    (void)tid; (void)nthr; OPAQUE_TID();
    constexpr int C = CHUNK;
    float* Tl = (float*)smem;
    const int p0 = unit * TS_G, np = (nprob - p0) < TS_G ? (nprob - p0) : TS_G;
    BLOCK_FOR(i, np * C * C / 4) ((uint4*)Tl)[i] = ((const uint4*)(Mall + (size_t)p0 * C * C))[i];
    BLOCK_SYNC();
    BLOCK_FOR(idx, TS_G * C) { const int w = idx / C, j = idx % C;
        if (w < np) { float* Tc = Tl + w * C * C;
            for (int t = 0; t < C; ++t) { float acc = 0.f;
                if (t == j) acc = 1.f;
                else if (t > j) { for (int sx = j; sx < t; ++sx) acc -= Tc[t * C + sx] * Tc[sx * C + j]; }
                Tc[t * C + j] = acc; } } }
    BLOCK_SYNC();
    BLOCK_FOR(i, np * C * C / 4) ((uint4*)(Tall + (size_t)p0 * C * C))[i] = ((const uint4*)Tl)[i];
    BLOCK_SYNC();
}
constexpr int RW_C3_SMEM = 2 * CHUNK * (RW_N + LDPAD) * 2 + 13 * CHUNK * (RW_N + LDPAD) * 2 + RW_N * 4;
HD void ph_rw_c3_unit(const Params& p, int cn, int tid, int nthr, unsigned char* smem) {
    (void)tid; (void)nthr; OPAQUE_TID();
    constexpr int C = CHUNK, N = RW_N, CN = C * N, LD = N + LDPAD, CL = C * LD;
    static_assert(2 * CL * 2 >= CN * 4, "cum region");
    static_assert(C == N, "c3 buffer aliasing assumes C == N");
    const int ch = cn / NCHUNK, n = cn % NCHUNK; int b, hh, d; rw_chain(ch, b, hh, d);
    float* cum = (float*)smem; u16* mb = (u16*)smem + 2 * CL;
    u16 *KKt = mb, *KKtT = mb + CL, *At = mb + 2 * CL, *KTt = mb + 3 * CL, *Rt = mb + 4 * CL, *ApT = mb + 5 * CL, *KTpT = mb + 6 * CL, *VT = mb + 7 * CL,
        *Tb = mb + 8 * CL, *MkT = mb + 9 * CL, *ZT = mb + 10 * CL, *Na = mb + 11 * CL, *Nk = mb + 12 * CL;
    float* PC = (float*)(mb + 13 * CL);
    u16 *Gm = (u16*)cum, *KKhT = (u16*)cum + CL;
    const size_t dofs = (size_t)d * MROWS * GROUP_W;
    BLOCK_FOR(idx, C * N) { const int t = idx / N, k = idx % N, R = b * TOK + seq_s(d, n * C + t); cum[idx] = p.rw_ew[dofs + (size_t)R * GROUP_W + hh * N + k]; }
    BLOCK_SYNC();
    BLOCK_FOR(k, N) { float acc = 0.f; for (int t = 0; t < C; ++t) { acc += cum[t * N + k]; cum[t * N + k] = acc; } PC[k] = expf(acc); }
    BLOCK_SYNC();
    BLOCK_FOR(idx, CN) { const int t = idx / N, k = idx % N, R = b * TOK + seq_s(d, n * C + t); const size_t o = (size_t)R * GROUP_W + hh * N + k;
        const float cu = cum[idx], cp = cu - p.rw_ew[dofs + o], cC = cum[(C - 1) * N + k];
        const float kkv = p.rw_kk[o], kav = p.rw_kka[dofs + o], ktv = p.rw_kt[dofs + o];
        const float e_m = expf(-cu), e_c = expf(cC - cu);
        const u16 kkt = f2bf(kkv * expf(cp));
        KKt[t * LD + k] = kkt; KKtT[k * LD + t] = kkt; At[t * LD + k] = f2bf(kav * e_m); KTt[t * LD + k] = f2bf(ktv * e_m); Rt[t * LD + k] = f2bf(p.rw_r[o] * expf(cu));
        ApT[k * LD + t] = f2bf(kav * e_c); KTpT[k * LD + t] = f2bf(ktv * e_c); VT[k * LD + t] = f2bf(p.rw_v[o]); }
    BLOCK_FOR(idx, C * C) Tb[(idx / C) * LD + idx % C] = f2bf(p.rw_T[(size_t)cn * C * C + idx]);
    BLOCK_SYNC();
    constexpr int TC = C / 32, TN = N / 32;
    WAVE_FOR(w, 3 * TC * TC) { const int which = w / (TC * TC), tm = (w / TC) % TC, tn = w % TC;
        const u16* Am = which == 0 ? KTt : Rt; const u16* Bm = which == 0 ? KKt : (which == 1 ? At : KTt); u16* Om = which == 0 ? MkT : (which == 1 ? Na : Nk);
        wave_mma32<N>(LANE, [&](int m, int k0, Frag& o) { o.ld_bf(Am + (tm * 32 + m) * LD + k0); },
                            [&](int nn, int k0, Frag& o) { o.ld_bf(Bm + (tn * 32 + nn) * LD + k0); },
                            [&](int m, int nn, float acc, int) { const int r = tm * 32 + m, cc = tn * 32 + nn; const bool keep = which == 0 ? (cc > r) : (cc <= r);
                                Om[r * LD + cc] = f2bf(keep ? acc : 0.f); }); }
    BLOCK_SYNC();
    WAVE_FOR(w, TC * TC + TN * TC) {
        if (w < TC * TC) { const int tm = w / TC, tn = w % TC;
            wave_mma32<C>(LANE, [&](int m, int k0, Frag& o) { o.ld_bf(Tb + (tm * 32 + m) * LD + k0); },
                                [&](int nn, int k0, Frag& o) { o.ld_bf(MkT + (tn * 32 + nn) * LD + k0); },
                                [&](int m, int nn, float acc, int) { Gm[(tm * 32 + m) * LD + tn * 32 + nn] = f2bf(acc); }); }
        else { const int q = w - TC * TC, tm = q / TC, tn = q % TC;
            wave_mma32<C>(LANE, [&](int m, int k0, Frag& o) { o.ld_bf(KKtT + (tm * 32 + m) * LD + k0); },
                                [&](int nn, int k0, Frag& o) { o.ld_bf(Tb + (tn * 32 + nn) * LD + k0); },
                                [&](int m, int nn, float acc, int) { KKhT[(tm * 32 + m) * LD + tn * 32 + nn] = f2bf(acc); }); } }
    BLOCK_SYNC();
    u16* RhG = p.rw_Rh + (size_t)cn * CN; u16* PhiTG = p.rw_PhiT + (size_t)cn * N * N;
    WAVE_FOR(w, TN * TC + TC * TN + TN * TN) {
        if (w < TN * TC) { const int tm = w / TC, tn = w % TC;
            wave_mma32<C>(LANE, [&](int m, int k0, Frag& o) { o.ld_bf(VT + (tm * 32 + m) * LD + k0); },
                                [&](int nn, int k0, Frag& o) { o.ld_bf(Gm + (tn * 32 + nn) * LD + k0); },
                                [&](int m, int nn, float acc, int) { ZT[(tm * 32 + m) * LD + tn * 32 + nn] = f2bf(acc); }); }
        else if (w < TN * TC + TC * TN) { const int q = w - TN * TC, tm = q / TN, tn = q % TN;
            wave_mma32<C>(LANE, [&](int m, int k0, Frag& o) { o.ld_bf(Na + (tm * 32 + m) * LD + k0); },
                                [&](int nn, int k0, Frag& o) { o.ld_bf(KKhT + (tn * 32 + nn) * LD + k0); },
                                [&](int m, int nn, float acc, int) { const int t = tm * 32 + m, k = tn * 32 + nn; RhG[t * N + k] = f2bf(bf2f(Rt[t * LD + k]) - acc); }); }
        else { const int q = w - TN * TC - TC * TN, tm = q / TN, tn = q % TN;
            wave_mma32<C>(LANE, [&](int m, int k0, Frag& o) { o.ld_bf(ApT + (tm * 32 + m) * LD + k0); },
                                [&](int nn, int k0, Frag& o) { o.ld_bf(KKhT + (tn * 32 + nn) * LD + k0); },
                                [&](int m, int nn, float acc, int) { const int k = tm * 32 + m, k2 = tn * 32 + nn; PhiTG[k * N + k2] = f2bf((k == k2 ? PC[k] : 0.f) - acc); }); } }
    BLOCK_SYNC();
    float* Y0G = p.rw_Y0 + (size_t)cn * CN; float* PsiG = p.rw_Psi + (size_t)cn * N * N;
    WAVE_FOR(w, TC * TN + TN * TN) {
        if (w < TC * TN) { const int tm = w / TN, tn = w % TN;
            wave_mma32<2 * C>(LANE, [&](int m, int k0, Frag& o) { if (k0 < C) o.ld_bf(Nk + (tm * 32 + m) * LD + k0); else { o.ld_bf(Na + (tm * 32 + m) * LD + k0 - C); o.neg(); } },
                                    [&](int nn, int k0, Frag& o) { if (k0 < C) o.ld_bf(VT + (tn * 32 + nn) * LD + k0); else o.ld_bf(ZT + (tn * 32 + nn) * LD + k0 - C); },
                                    [&](int m, int nn, float acc, int) { Y0G[(tm * 32 + m) * N + tn * 32 + nn] = acc; }); }
        else { const int q = w - TC * TN, tm = q / TN, tn = q % TN;
            wave_mma32<2 * C>(LANE, [&](int m, int k0, Frag& o) { if (k0 < C) o.ld_bf(VT + (tm * 32 + m) * LD + k0); else { o.ld_bf(ZT + (tm * 32 + m) * LD + k0 - C); o.neg(); } },
                                    [&](int nn, int k0, Frag& o) { if (k0 < C) o.ld_bf(KTpT + (tn * 32 + nn) * LD + k0); else o.ld_bf(ApT + (tn * 32 + nn) * LD + k0 - C); },
                                    [&](int m, int nn, float acc, int) { PsiG[(tm * 32 + m) * N + tn * 32 + nn] = acc; }); } }
    BLOCK_SYNC();
}
constexpr int RW_S2_SMEM = (3 * RW_N + CHUNK) * (RW_N + LDPAD) * 2 + RW_N * RW_N * 4 + CHUNK * RW_N * 4;
HD void ph_rw_scan2_unit(const Params& p, int ch, int tid, int nthr, unsigned char* smem) {
    (void)tid; (void)nthr; OPAQUE_TID();
    constexpr int C = CHUNK, N = RW_N, TC = C / 32, TN = N / 32, LD = N + LDPAD;
    int b, hh, d; rw_chain(ch, b, hh, d);
    u16* Sb = (u16*)smem; u16* PhiT = Sb + 2 * N * LD; u16* Rh = PhiT + N * LD; float* Psi = (float*)(Rh + C * LD); float* Y0 = Psi + N * N;
    BLOCK_FOR(i, N * LD) Sb[i] = 0;
    auto tiles = [&](int n) {
        const u16* Sc = Sb + (n & 1) * N * LD; u16* Sn = Sb + ((n + 1) & 1) * N * LD;
        WAVE_FOR(w, TN * TN + TC * TN) {
            if (w < TN * TN) { const int tm = w / TN, tn = w % TN;
                wave_mma32<N>(LANE, [&](int m, int k0, Frag& o) { o.ld_bf(Sc + (tm * 32 + m) * LD + k0); },
                                    [&](int nn, int k0, Frag& o) { o.ld_bf(PhiT + (tn * 32 + nn) * LD + k0); },
                                    [&](int m, int nn, float acc, int) { const int i = tm * 32 + m, k = tn * 32 + nn; Sn[i * LD + k] = f2bf(acc + Psi[i * N + k]); }); }
            else { const int q = w - TN * TN, tm = q / TN, tn = q % TN;
                wave_mma32<N>(LANE, [&](int m, int k0, Frag& o) { o.ld_bf(Rh + (tm * 32 + m) * LD + k0); },
                                    [&](int nn, int k0, Frag& o) { o.ld_bf(Sc + (tn * 32 + nn) * LD + k0); },
                                    [&](int m, int nn, float acc, int) { const int t = tm * 32 + m, i = tn * 32 + nn, R = b * TOK + seq_s(d, n * C + t);
                                        p.rw_y[((size_t)d * MROWS + R) * GROUP_W + hh * N + i] = acc + Y0[t * N + i]; }); } } };
#ifdef CPU_TEST
    for (int n = 0; n < NCHUNK; ++n) { const int cn = ch * NCHUNK + n;
        BLOCK_FOR(i, N * N / 8) *(uint4*)(PhiT + (i / (N / 8)) * LD + (i % (N / 8)) * 8) = ((const uint4*)(p.rw_PhiT + (size_t)cn * N * N))[i];
        BLOCK_FOR(i, C * N / 8) *(uint4*)(Rh + (i / (N / 8)) * LD + (i % (N / 8)) * 8) = ((const uint4*)(p.rw_Rh + (size_t)cn * C * N))[i];
        BLOCK_FOR(i, N * N / 4) ((uint4*)Psi)[i] = ((const uint4*)(p.rw_Psi + (size_t)cn * N * N))[i];
        BLOCK_FOR(i, C * N / 4) ((uint4*)Y0)[i] = ((const uint4*)(p.rw_Y0 + (size_t)cn * C * N))[i];
        BLOCK_SYNC(); tiles(n); BLOCK_SYNC(); }
#else
    constexpr int NT = 512, Q_A = N * N / 8 / NT, Q_B = C * N / 8 / NT, Q_C = N * N / 4 / NT, Q_D = C * N / 4 / NT;
    static_assert(Q_A * NT * 8 == N * N && Q_B * NT * 8 == C * N && Q_C * NT * 4 == N * N && Q_D * NT * 4 == C * N && NCHUNK % 4 == 0, "prefetch split");
    pfv4 rA[4][Q_A], rB[4][Q_B], rC[4][Q_C], rD[4][Q_D];
#define RW_PF_LOAD(st, cn_) do { pf_ld_lin(rA[st], p.rw_PhiT + (size_t)(cn_) * N * N, tid); pf_ld_lin(rB[st], p.rw_Rh + (size_t)(cn_) * C * N, tid); \
    pf_ld_lin(rC[st], p.rw_Psi + (size_t)(cn_) * N * N, tid); pf_ld_lin(rD[st], p.rw_Y0 + (size_t)(cn_) * C * N, tid); } while (0)
#define RW_PF_STORE(st) do { pf_st_pad(rA[st], PhiT, N / 8, LD, tid); pf_st_pad(rB[st], Rh, N / 8, LD, tid); pf_st_lin(rC[st], Psi, tid); pf_st_lin(rD[st], Y0, tid); } while (0)
    const int cn0 = ch * NCHUNK;
    RW_PF_LOAD(0, cn0); RW_PF_LOAD(1, cn0 + 1); RW_PF_LOAD(2, cn0 + 2); RW_PF_LOAD(3, cn0 + 3); RW_PF_STORE(0);
    for (int n0 = 0; n0 < NCHUNK; n0 += 4) {
#pragma unroll
        for (int j = 0; j < 4; ++j) { const int n = n0 + j;
            BLOCK_SYNC();
            if (n + 4 < NCHUNK) RW_PF_LOAD(j, cn0 + n + 4);
            tiles(n);
            BLOCK_SYNC();
            if (n + 1 < NCHUNK) RW_PF_STORE((j + 1) & 3); } }
#undef RW_PF_LOAD
#undef RW_PF_STORE
#endif
}
template <int G> HD void ph_rw_post(const Params& p, int layer, Exec e) {
    constexpr int NI = RW_HEAD / 4 / G;
    static_assert(NI * 4 * G == RW_HEAD, "G");
    const float *lw = p.rw_ln_w + layer * GROUP_W, *lb = p.rw_ln_b + layer * GROUP_W, *rk = p.rw_r_k + layer * GROUP_W;
    for (int it = e.gid; it < MROWS * RW_HEADS; it += e.ngroups) {
        const int R = it / RW_HEADS, hh = it % RW_HEADS; const size_t o = (size_t)R * GROUP_W + hh * RW_HEAD, o2 = (size_t)MROWS * GROUP_W;
        F4 y[NI]; float s1 = 0.f, bon = 0.f;
#pragma unroll
        for (int i = 0; i < NI; ++i) { const int c4 = (e.gl + G * i) * 4; y[i] = ld4(p.rw_y + o + c4) + ld4(p.rw_y + o2 + o + c4); s1 += hsum(y[i]);
            bon += hsum(ld4(p.rw_r + o + c4) * (ld4(p.rw_kt + o + c4) + ld4(p.rw_kt + o2 + o + c4)) * ld4(rk + hh * RW_HEAD + c4)); }
        s1 = group_sum<G>(s1); bon = group_sum<G>(bon);
        const float mean = s1 / RW_HEAD;
        float s2 = 0.f;
#pragma unroll
        for (int i = 0; i < NI; ++i) { y[i] = y[i] + (-mean); s2 += hsum(y[i] * y[i]); }
        s2 = group_sum<G>(s2);
        const float rstd = 1.f / sqrtf(s2 / RW_HEAD + RW_GN_EPS);
#pragma unroll
        for (int i = 0; i < NI; ++i) { const int c4 = (e.gl + G * i) * 4;
            const F4 yn = y[i] * rstd * ld4(lw + hh * RW_HEAD + c4) + ld4(lb + hh * RW_HEAD + c4);
            st4bf(p.mix + (size_t)R * D_MODEL + hh * RW_HEAD + c4, (yn + ld4(p.rw_v + o + c4) * bon) * ld4(p.rw_g + o + c4)); }
    }
}

HD void ml_chain(int ch, int& b, int& hh, int& d) { d = ch % 2; hh = (ch / 2) % ML_HEADS; b = ch / (2 * ML_HEADS); }
template <int G> HD void ph_ml_g1(const Params& p, int layer, Exec e) {
    for (int it = e.gid; it < ML_CH * NCHUNK; it += e.ngroups) {
        const int ch = it / NCHUNK, n = it % NCHUNK; int b, hh, d; ml_chain(ch, b, hh, d);
        const float ib = p.ml_ib[(layer * 2 + d) * ML_HEADS + hh], fb = p.ml_fb[(layer * 2 + d) * ML_HEADS + hh];
        float cb = 0.f, cm = -1e30f;
        for (int t0 = 0; t0 < CHUNK; t0 += G) { const int t = t0 + e.gl, pos = n * CHUNK + t, R = b * TOK + seq_s(d, pos);
            const float* g = p.P + (size_t)R * LDP + ML_OFF + 4 * GROUP_W;
            const float li = g[d * ML_HEADS + hh] + ib, lf = logsigmoidf_(g[(2 + d) * ML_HEADS + hh] + fb);
            const float bc = cb + group_scan_sum<G>(lf, e.gl), gv = li - bc, gm = fmaxf(cm, group_scan_max<G>(gv, e.gl));
            p.ml_bcum[(size_t)ch * TOK + pos] = bc; p.ml_g[(size_t)ch * TOK + pos] = gv; p.ml_gmax[(size_t)ch * TOK + pos] = gm;
            cb = group_last<G>(bc); cm = group_last<G>(gm); }
        if (e.gl == 0) { p.ml_bl[ch * NCHUNK + n] = cb; p.ml_gm[ch * NCHUNK + n] = cm; }
    }
}
HD void ph_ml_g2(const Params& p, Exec e) {
    for (int ch = e.gid; ch < ML_CH; ch += e.ngroups) { float m = 0.f;
        for (int n = 0; n < NCHUNK; ++n) { const float bl = p.ml_bl[ch * NCHUNK + n], mnew = bl + fmaxf(m, p.ml_gm[ch * NCHUNK + n]);
            p.ml_min[ch * NCHUNK + n] = m; p.ml_dcv[ch * NCHUNK + n] = expf(bl + m - mnew); m = mnew; } }
}
HD void ph_ml_prefix(const Params& p, Exec e) {
    const int n1 = ML_CH * ML_HEAD * ML_HEAD, n2 = ML_CH * ML_HEAD;
    for (int it = e.gid; it < n1 + n2; it += e.ngroups) {
        const bool isn = it >= n1; const int q = isn ? it - n1 : it, per = isn ? ML_HEAD : ML_HEAD * ML_HEAD, ch = q / per, el = q % per;
        float* arr = (isn ? p.ml_dn : p.ml_dC) + (size_t)ch * NCHUNK * per + el; const float* dcv = p.ml_dcv + ch * NCHUNK; float st = 0.f;
        for (int n = 0; n < NCHUNK; n += 4) { float inc[4], dc[4];
#pragma unroll
            for (int j = 0; j < 4; ++j) if (n + j < NCHUNK) { inc[j] = arr[(size_t)(n + j) * per]; dc[j] = dcv[n + j]; }
#pragma unroll
            for (int j = 0; j < 4; ++j) if (n + j < NCHUNK) { arr[(size_t)(n + j) * per] = st; st = dc[j] * st + inc[j]; } }
    }
}

constexpr int ML_N = ML_HEAD, ML_CN = ML_CH * NCHUNK;
static_assert(ML_HEAD % 32 == 0, "tile");
constexpr int ML_C1_SMEM = 2 * ML_N * (CHUNK + LDPAD) * 2 + 4 * CHUNK * 4;
HD void ph_ml_c1_unit(const Params& p, int cn, int tid, int nthr, unsigned char* smem) {
    (void)tid; (void)nthr; OPAQUE_TID();
    constexpr int C = CHUNK, N = ML_N, TC = C / 32, TN = N / 32, LD = C + LDPAD;
    const float ksc = 1.f / sqrtf((float)ML_HEAD);
    const int ch = cn / NCHUNK, n = cn % NCHUNK; int b, hh, d; ml_chain(ch, b, hh, d);
    u16* VwT = (u16*)smem; u16* KT = VwT + N * LD; float* wk = (float*)(KT + N * LD); float* btv = wk + C; float* gv = btv + C; float* mtv = gv + C;
    const float min_ = p.ml_min[cn], bl = p.ml_bl[cn], mnew = bl + fmaxf(min_, p.ml_gm[cn]);
    BLOCK_FOR(sx, C) { const size_t o = (size_t)ch * TOK + n * C + sx; const float g = p.ml_g[o], bt = p.ml_bcum[o];
        wk[sx] = expf(bl + g - mnew); btv[sx] = bt; gv[sx] = g; mtv[sx] = bt + fmaxf(min_, p.ml_gmax[o]); }
    BLOCK_SYNC();
    BLOCK_FOR(idx, C * N) { const int sx = idx / N, dd = idx % N, R = b * TOK + seq_s(d, n * C + sx); const float* pr = p.P + (size_t)R * LDP + ML_OFF + hh * N;
        VwT[dd * LD + sx] = f2bf(wk[sx] * pr[2 * GROUP_W + dd]); KT[dd * LD + sx] = f2bf(pr[GROUP_W + dd] * ksc); }
    BLOCK_SYNC();
    WAVE_FOR(w, TN * TN + TN + TC * TC) {
        if (w < TN * TN) { const int tm = w / TN, tn = w % TN;
            wave_mma32<C>(LANE, [&](int m, int k0, Frag& o) { o.ld_bf(VwT + (tm * 32 + m) * LD + k0); },
                                [&](int nn, int k0, Frag& o) { o.ld_bf(KT + (tn * 32 + nn) * LD + k0); },
                                [&](int m, int nn, float acc, int) { p.ml_dC[((size_t)cn * N + tm * 32 + m) * N + tn * 32 + nn] = acc; }); }
        else if (w < TN * TN + TN) { const int tn = w - TN * TN;
            wave_mma32<C>(LANE, [&](int m, int k0, Frag& o) { if (m == 0) o.ld_f(wk + k0); else o.set1(0.f); },
                                [&](int nn, int k0, Frag& o) { o.ld_bf(KT + (tn * 32 + nn) * LD + k0); },
                                [&](int m, int nn, float acc, int) { if (m == 0) p.ml_dn[(size_t)cn * N + tn * 32 + nn] = acc; }); }
        else { const int q = w - TN * TN - TN, tm = q / TC, tn = q % TC;
            wave_mma32<N>(LANE, [&](int m, int k0, Frag& o) { const int R = b * TOK + seq_s(d, n * C + tm * 32 + m); o.ld_f(p.P + (size_t)R * LDP + ML_OFF + hh * N + k0); },
                                [&](int nn, int k0, Frag& o) { const int R = b * TOK + seq_s(d, n * C + tn * 32 + nn); o.ld_f(p.P + (size_t)R * LDP + ML_OFF + GROUP_W + hh * N + k0); },
                                [&](int m, int nn, float acc, int) { const int t = tm * 32 + m, sx = tn * 32 + nn;
                                    p.ml_S[((size_t)cn * C + t) * C + sx] = sx <= t ? acc * ksc * expf(btv[t] + gv[sx] - mtv[t]) : 0.f; }); } }
    BLOCK_SYNC();
}
constexpr int ML_C2_SMEM = ML_N * (CHUNK + LDPAD) * 2 + 3 * CHUNK * 4;
HD void ph_ml_c2_unit(const Params& p, int cn, int tid, int nthr, unsigned char* smem) {
    (void)tid; (void)nthr; OPAQUE_TID();
    constexpr int C = CHUNK, N = ML_N, TC = C / 32, TN = N / 32, LD = C + LDPAD;
    const int ch = cn / NCHUNK, n = cn % NCHUNK; int b, hh, d; ml_chain(ch, b, hh, d);
    u16* VT = (u16*)smem; float* wi = (float*)(VT + N * LD); float* den = wi + C; float* emt = den + C;
    const float min_ = p.ml_min[cn];
    BLOCK_FOR(t, C) { const size_t o = (size_t)ch * TOK + n * C + t; const float bt = p.ml_bcum[o], mt = bt + fmaxf(min_, p.ml_gmax[o]);
        wi[t] = expf(bt + min_ - mt); emt[t] = expf(-mt); }
    BLOCK_FOR(idx, C * N) { const int sx = idx / N, dd = idx % N, R = b * TOK + seq_s(d, n * C + sx);
        VT[dd * LD + sx] = f2bf(p.P[(size_t)R * LDP + ML_OFF + 2 * GROUP_W + hh * N + dd]); }
    BLOCK_SYNC();
    WAVE_FOR(w, TC) { const int tm = w;
        wave_mma32<C + N>(LANE, [&](int m, int k0, Frag& o) { const int t = tm * 32 + m;
                                    if (k0 < C) o.ld_f(p.ml_S + ((size_t)cn * C + t) * C + k0);
                                    else { const int R = b * TOK + seq_s(d, n * C + t); o.ld_f_scaled(p.P + (size_t)R * LDP + ML_OFF + hh * N + k0 - C, wi[t]); } },
                                [&](int nn, int k0, Frag& o) { if (nn != 0) o.set1(0.f); else if (k0 < C) o.set1(1.f); else o.ld_f(p.ml_dn + (size_t)cn * N + k0 - C); },
                                [&](int m, int nn, float acc, int) { if (nn == 0) den[tm * 32 + m] = acc; }); }
    BLOCK_SYNC();
    WAVE_FOR(w, TC * TN) { const int tm = w / TN, tn = w % TN;
        wave_mma32<C + N>(LANE, [&](int m, int k0, Frag& o) { const int t = tm * 32 + m;
                                    if (k0 < C) o.ld_f(p.ml_S + ((size_t)cn * C + t) * C + k0);
                                    else { const int R = b * TOK + seq_s(d, n * C + t); o.ld_f_scaled(p.P + (size_t)R * LDP + ML_OFF + hh * N + k0 - C, wi[t]); } },
                                [&](int nn, int k0, Frag& o) { const int ee = tn * 32 + nn;
                                    if (k0 < C) o.ld_bf(VT + ee * LD + k0); else o.ld_f(p.ml_dC + ((size_t)cn * N + ee) * N + k0 - C); },
                                [&](int m, int nn, float acc, int) { const int t = tm * 32 + m, ee = tn * 32 + nn, R = b * TOK + seq_s(d, n * C + t);
                                    p.ml_hh[((size_t)d * MROWS + R) * GROUP_W + hh * N + ee] = acc / fmaxf(fabsf(den[t]), emt[t]); }); }
    BLOCK_SYNC();
}
template <int G> HD void ph_ml_post(const Params& p, int layer, Exec e) {
    constexpr int NI = ML_HEAD / 4 / G;
    static_assert(NI * 4 * G == ML_HEAD, "G");
    const float* ng = p.ml_norm_g + layer * GROUP_W;
    for (int it = e.gid; it < MROWS * ML_HEADS; it += e.ngroups) {
        const int R = it / ML_HEADS, hh = it % ML_HEADS; const size_t o = (size_t)R * GROUP_W + hh * ML_HEAD, o2 = (size_t)MROWS * GROUP_W;
        F4 y[NI]; float s1 = 0.f;
#pragma unroll
        for (int i = 0; i < NI; ++i) { const int c4 = (e.gl + G * i) * 4; y[i] = ld4(p.ml_hh + o + c4) + ld4(p.ml_hh + o2 + o + c4); s1 += hsum(y[i]); }
        s1 = group_sum<G>(s1); const float mean = s1 / ML_HEAD;
        float s2 = 0.f;
#pragma unroll
        for (int i = 0; i < NI; ++i) { y[i] = y[i] + (-mean); s2 += hsum(y[i] * y[i]); }
        s2 = group_sum<G>(s2); const float rstd = 1.f / sqrtf(s2 / ML_HEAD + NORM_EPS);
#pragma unroll
        for (int i = 0; i < NI; ++i) { const int c4 = (e.gl + G * i) * 4; const F4 og = ld4(p.P + (size_t)R * LDP + ML_OFF + 3 * GROUP_W + hh * ML_HEAD + c4);
            const F4 sg = F4{sigmoidf_(og.x), sigmoidf_(og.y), sigmoidf_(og.z), sigmoidf_(og.w)};
            st4bf(p.mix + (size_t)R * D_MODEL + GROUP_W + hh * ML_HEAD + c4, y[i] * rstd * ld4(ng + hh * ML_HEAD + c4) * sg); }
    }
}

HD float gd_conv_silu(const Params& p, int layer, int R, int c) {
    const int s = row_s(R); const float* pr = p.P + (size_t)R * LDP + GD_OFF + c; const float* cw = p.gd_conv + (size_t)layer * 3 * 3 * GROUP_W + c;
    float v = pr[0] * cw[3 * GROUP_W];
    if (s != 0 && s != CTX) v += pr[-LDP] * cw[0];
    if (s != CTX - 1 && s != TOK - 1) v += pr[LDP] * cw[2 * 3 * GROUP_W];
    return siluf_(v);
}
template <int G> HD void ph_gd_prep(const Params& p, int layer, Exec e) {
    const float qsc = 1.f / sqrtf((float)GD_HEAD);
    constexpr int NI = GD_HEAD / G;
    for (int it = e.gid; it < MROWS * GD_HEADS; it += e.ngroups) {
        const int R = it / GD_HEADS, hh = it % GD_HEADS;
        float xq[NI], xk[NI], xv[NI]; float sq = 0.f, sk = 0.f;
#pragma unroll
        for (int i = 0; i < NI; ++i) { const int j = hh * GD_HEAD + e.gl + G * i;
            xq[i] = gd_conv_silu(p, layer, R, j); xk[i] = gd_conv_silu(p, layer, R, GROUP_W + j); xv[i] = gd_conv_silu(p, layer, R, 2 * GROUP_W + j);
            sq += xq[i] * xq[i]; sk += xk[i] * xk[i]; }
        sq = group_sum<G>(sq); sk = group_sum<G>(sk);
        const float rq = qsc / sqrtf(sq + 1e-6f), rk = 1.f / sqrtf(sk + 1e-6f);
#pragma unroll
        for (int i = 0; i < NI; ++i) { const size_t o = (size_t)R * GROUP_W + hh * GD_HEAD + e.gl + G * i;
            p.gd_q[o] = xq[i] * rq; p.gd_k[o] = xk[i] * rk; p.gd_v[o] = xv[i]; }
    }
}
template <int G> HD void ph_gd_gates(const Params& p, int layer, Exec e) {
    for (int it = e.gid; it < GD_CH * NCHUNK; it += e.ngroups) {
        const int ch = it / NCHUNK, n = it % NCHUNK; int b, hh, d; ml_chain(ch, b, hh, d);
        const float al = expf(p.gd_a_log[(layer * 2 + d) * GD_HEADS + hh]), dtb = p.gd_dt_bias[(layer * 2 + d) * GD_HEADS + hh];
        float cg = 0.f;
        for (int t0 = 0; t0 < CHUNK; t0 += G) { const int t = t0 + e.gl, pos = n * CHUNK + t, R = b * TOK + seq_s(d, pos);
            const float* g = p.P + (size_t)R * LDP + GD_OFF + 4 * GROUP_W;
            const float gc = cg + group_scan_sum<G>(-al * softplusf_(g[d * GD_HEADS + hh] + dtb), e.gl);
            p.gd_gc[(size_t)ch * TOK + pos] = gc; p.gd_beta[(size_t)ch * TOK + pos] = sigmoidf_(g[(2 + d) * GD_HEADS + hh]);
            cg = group_last<G>(gc); }
    }
}

constexpr int GD_N = GD_HEAD, GD_CN = GD_CH * NCHUNK;
static_assert(GD_HEAD % 32 == 0, "tile");
HD void ph_gd_c1(const Params& p, Exec e) {
    constexpr int C = CHUNK, N = GD_N, TC = C / 32;
    for (int it = e.gid; it < GD_CN * TC * TC; it += e.ngroups) {
        const int cn = it / (TC * TC), tm = (it / TC) % TC, tn = it % TC, ch = cn / NCHUNK, n = cn % NCHUNK; int b, hh, d; ml_chain(ch, b, hh, d);
        wave_mma32<N>(e.gl, [&](int m, int k0, Frag& o) { const int R = b * TOK + seq_s(d, n * C + tm * 32 + m); o.ld_f(p.gd_k + (size_t)R * GROUP_W + hh * N + k0); },
                            [&](int nn, int k0, Frag& o) { const int R = b * TOK + seq_s(d, n * C + tn * 32 + nn); o.ld_f(p.gd_k + (size_t)R * GROUP_W + hh * N + k0); },
                            [&](int m, int nn, float acc, int) { const int i = tm * 32 + m, j = tn * 32 + nn; const size_t o = (size_t)ch * TOK + n * C;
                                p.gd_A[((size_t)cn * C + i) * C + j] = j < i ? p.gd_beta[o + i] * acc * expf(p.gd_gc[o + i] - p.gd_gc[o + j]) : 0.f; });
    }
}
constexpr int GD_C3_SMEM = (5 * GD_N + 2 * CHUNK) * (CHUNK + LDPAD) * 2 + 2 * CHUNK * 4;
HD void ph_gd_c3_unit(const Params& p, int cn, int tid, int nthr, unsigned char* smem) {
    (void)tid; (void)nthr; OPAQUE_TID();
    constexpr int C = CHUNK, N = GD_N, TC = C / 32, TN = N / 32, LD = C + LDPAD;
    const int ch = cn / NCHUNK, n = cn % NCHUNK; int b, hh, d; ml_chain(ch, b, hh, d);
    u16 *KbT = (u16*)smem, *VbT = KbT + N * LD, *KdT = VbT + N * LD, *uT = KdT + N * LD, *wT = uT + N * LD, *Tb = wT + N * LD, *attn = Tb + C * LD;
    float* gcs = (float*)(attn + C * LD); float* bet = gcs + C;
    BLOCK_FOR(t, C) { const size_t o = (size_t)ch * TOK + n * C + t; gcs[t] = p.gd_gc[o]; bet[t] = p.gd_beta[o]; }
    BLOCK_SYNC();
    BLOCK_FOR(idx, C * N) { const int t = idx / N, dd = idx % N, R = b * TOK + seq_s(d, n * C + t); const size_t o = (size_t)R * GROUP_W + hh * N + dd;
        const float kv = p.gd_k[o], vv = p.gd_v[o];
        KbT[dd * LD + t] = f2bf(kv * bet[t] * expf(gcs[t])); VbT[dd * LD + t] = f2bf(vv * bet[t]); KdT[dd * LD + t] = f2bf(kv * expf(gcs[C - 1] - gcs[t])); }
    BLOCK_FOR(idx, C * C) Tb[(idx / C) * LD + idx % C] = f2bf(p.gd_T[(size_t)cn * C * C + idx]);
    BLOCK_SYNC();
    WAVE_FOR(w, TC * TC + 2 * TN * TC) {
        if (w < TC * TC) { const int tm = w / TC, tn = w % TC;
            wave_mma32<N>(LANE, [&](int m, int k0, Frag& o) { const int R = b * TOK + seq_s(d, n * C + tm * 32 + m); o.ld_f(p.gd_q + (size_t)R * GROUP_W + hh * N + k0); },
                                [&](int nn, int k0, Frag& o) { const int R = b * TOK + seq_s(d, n * C + tn * 32 + nn); o.ld_f(p.gd_k + (size_t)R * GROUP_W + hh * N + k0); },
                                [&](int m, int nn, float acc, int) { const int i = tm * 32 + m, j = tn * 32 + nn; attn[i * LD + j] = f2bf(j <= i ? acc * expf(gcs[i] - gcs[j]) : 0.f); }); }
        else { const int q = w - TC * TC, which = q / (TN * TC), tm = (q / TC) % TN, tn = q % TC;
            const u16* Am = which ? KbT : VbT; u16* Om = which ? wT : uT;
            wave_mma32<C>(LANE, [&](int m, int k0, Frag& o) { o.ld_bf(Am + (tm * 32 + m) * LD + k0); },
                                [&](int nn, int k0, Frag& o) { o.ld_bf(Tb + (tn * 32 + nn) * LD + k0); },
                                [&](int m, int nn, float acc, int) { Om[(tm * 32 + m) * LD + tn * 32 + nn] = f2bf(acc); }); } }
    BLOCK_SYNC();
    WAVE_FOR(w, 2 * TC * TN + 2 * TN * TN) {
        if (w < 2 * TC * TN) { const int which = w / (TC * TN), tm = (w / TN) % TC, tn = w % TN;
            const u16* Bm = which ? uT : wT;
            wave_mma32<C>(LANE, [&](int m, int k0, Frag& o) { o.ld_bf(attn + (tm * 32 + m) * LD + k0); },
                                [&](int nn, int k0, Frag& o) { o.ld_bf(Bm + (tn * 32 + nn) * LD + k0); },
                                [&](int m, int nn, float acc, int) { const int i = tm * 32 + m, dd = tn * 32 + nn;
                                    if (which) p.gd_O0[((size_t)cn * C + i) * N + dd] = acc;
                                    else { const int R = b * TOK + seq_s(d, n * C + i); p.gd_Qh[((size_t)cn * C + i) * N + dd] = f2bf(p.gd_q[(size_t)R * GROUP_W + hh * N + dd] * expf(gcs[i]) - acc); } }); }
        else { const int q = w - 2 * TC * TN, which = q / (TN * TN), tm = (q / TN) % TN, tn = q % TN;
            const u16* Bm = which ? uT : wT;
            wave_mma32<C>(LANE, [&](int m, int k0, Frag& o) { o.ld_bf(KdT + (tm * 32 + m) * LD + k0); },
                                [&](int nn, int k0, Frag& o) { o.ld_bf(Bm + (tn * 32 + nn) * LD + k0); },
                                [&](int m, int nn, float acc, int) { const int d1 = tm * 32 + m, d2 = tn * 32 + nn;
                                    if (which) p.gd_Psi[((size_t)cn * N + d1) * N + d2] = acc;
                                    else p.gd_Phi[((size_t)cn * N + d1) * N + d2] = f2bf((d1 == d2 ? expf(gcs[C - 1]) : 0.f) - acc); }); } }
    BLOCK_SYNC();
}
constexpr int GD_EB = 32, GD_S2_UNITS = GD_CH * (GD_N / GD_EB);
constexpr int GD_S2_SMEM = (2 * GD_EB + GD_N + CHUNK) * (GD_N + LDPAD) * 2 + (GD_N * GD_EB + CHUNK * GD_EB) * 4;
HD void ph_gd_scan2_unit(const Params& p, int unit, int tid, int nthr, unsigned char* smem) {
    (void)tid; (void)nthr; OPAQUE_TID();
    constexpr int C = CHUNK, N = GD_N, EB = GD_EB, LD = N + LDPAD;
    const int eb = unit % (N / EB), ch = unit / (N / EB), e0 = eb * EB; int b, hh, d; ml_chain(ch, b, hh, d);
    u16* ST = (u16*)smem; u16* Phi = ST + 2 * EB * LD; u16* Qh = Phi + N * LD; float* Psi = (float*)(Qh + C * LD); float* O0 = Psi + N * EB;
    BLOCK_FOR(i, EB * LD) ST[i] = 0;
    auto tiles = [&](int n) {
        const u16* Sc = ST + (n & 1) * EB * LD; u16* Sn = ST + ((n + 1) & 1) * EB * LD;
        WAVE_FOR(w, N / 32 + C / 32) {
            if (w < N / 32) { const int tm = w;
                wave_mma32<N>(LANE, [&](int m, int k0, Frag& o) { o.ld_bf(Phi + (tm * 32 + m) * LD + k0); },
                                    [&](int nn, int k0, Frag& o) { o.ld_bf(Sc + nn * LD + k0); },
                                    [&](int m, int nn, float acc, int) { const int d1 = tm * 32 + m; Sn[nn * LD + d1] = f2bf(acc + Psi[d1 * EB + nn]); }); }
            else { const int tm = w - N / 32;
                wave_mma32<N>(LANE, [&](int m, int k0, Frag& o) { o.ld_bf(Qh + (tm * 32 + m) * LD + k0); },
                                    [&](int nn, int k0, Frag& o) { o.ld_bf(Sc + nn * LD + k0); },
                                    [&](int m, int nn, float acc, int) { const int t = tm * 32 + m, R = b * TOK + seq_s(d, n * C + t);
                                        p.gd_o[((size_t)d * MROWS + R) * GROUP_W + hh * N + e0 + nn] = acc + O0[t * EB + nn]; }); } } };
#ifdef CPU_TEST
    for (int n = 0; n < NCHUNK; ++n) { const int cn = ch * NCHUNK + n;
        BLOCK_FOR(i, N * N / 8) *(uint4*)(Phi + (i / (N / 8)) * LD + (i % (N / 8)) * 8) = ((const uint4*)(p.gd_Phi + (size_t)cn * N * N))[i];
        BLOCK_FOR(i, C * N / 8) *(uint4*)(Qh + (i / (N / 8)) * LD + (i % (N / 8)) * 8) = ((const uint4*)(p.gd_Qh + (size_t)cn * C * N))[i];
        BLOCK_FOR(i, N * EB / 4) ((uint4*)Psi)[i] = *(const uint4*)(p.gd_Psi + ((size_t)cn * N + i / (EB / 4)) * N + e0 + (i % (EB / 4)) * 4);
        BLOCK_FOR(i, C * EB / 4) ((uint4*)O0)[i] = *(const uint4*)(p.gd_O0 + ((size_t)cn * C + i / (EB / 4)) * N + e0 + (i % (EB / 4)) * 4);
        BLOCK_SYNC(); tiles(n); BLOCK_SYNC(); }
#else
    constexpr int NT = 512, Q_PHI = N * N / 8 / NT, Q_QH = C * N / 8 / NT, Q_PSI = N * EB / 4 / NT, Q_O0 = C * EB / 4 / NT;
    static_assert(Q_PHI * NT * 8 == N * N && Q_QH * NT * 8 == C * N && Q_PSI * NT * 4 == N * EB && Q_O0 * NT * 4 == C * EB && NCHUNK % 4 == 0, "prefetch split");
    pfv4 rA[4][Q_PHI], rB[4][Q_QH], rC[4][Q_PSI], rD[4][Q_O0];
#define GD_PF_LOAD(st, cn_) do { pf_ld_lin(rA[st], p.gd_Phi + (size_t)(cn_) * N * N, tid); pf_ld_lin(rB[st], p.gd_Qh + (size_t)(cn_) * C * N, tid); \
    pf_ld_rows(rC[st], p.gd_Psi + (size_t)(cn_) * N * N + e0, EB / 4, N, tid); pf_ld_rows(rD[st], p.gd_O0 + (size_t)(cn_) * C * N + e0, EB / 4, N, tid); } while (0)
#define GD_PF_STORE(st) do { pf_st_pad(rA[st], Phi, N / 8, LD, tid); pf_st_pad(rB[st], Qh, N / 8, LD, tid); pf_st_lin(rC[st], Psi, tid); pf_st_lin(rD[st], O0, tid); } while (0)
    const int cn0 = ch * NCHUNK;
    GD_PF_LOAD(0, cn0); GD_PF_LOAD(1, cn0 + 1); GD_PF_LOAD(2, cn0 + 2); GD_PF_LOAD(3, cn0 + 3); GD_PF_STORE(0);
    for (int n0 = 0; n0 < NCHUNK; n0 += 4) {
#pragma unroll
        for (int j = 0; j < 4; ++j) { const int n = n0 + j;
            BLOCK_SYNC();
            if (n + 4 < NCHUNK) GD_PF_LOAD(j, cn0 + n + 4);
            tiles(n);
            BLOCK_SYNC();
            if (n + 1 < NCHUNK) GD_PF_STORE((j + 1) & 3); } }
#undef GD_PF_LOAD
#undef GD_PF_STORE
#endif
}
template <int G> HD void ph_gd_post(const Params& p, int layer, Exec e) {
    constexpr int NI = GD_HEAD / 4 / G;
    static_assert(NI * 4 * G == GD_HEAD, "G");
    const float* ng = p.gd_norm_g + layer * GD_HEAD;
    for (int it = e.gid; it < MROWS * GD_HEADS; it += e.ngroups) {
        const int R = it / GD_HEADS, hh = it % GD_HEADS; const size_t o = (size_t)R * GROUP_W + hh * GD_HEAD, o2 = (size_t)MROWS * GROUP_W;
        F4 y[NI]; float ss = 0.f;
#pragma unroll
        for (int i = 0; i < NI; ++i) { const int c4 = (e.gl + G * i) * 4; y[i] = ld4(p.gd_o + o + c4) + ld4(p.gd_o + o2 + o + c4); ss += hsum(y[i] * y[i]); }
        ss = group_sum<G>(ss); const float rstd = 1.f / sqrtf(ss / GD_HEAD + NORM_EPS);
#pragma unroll
        for (int i = 0; i < NI; ++i) { const int c4 = (e.gl + G * i) * 4; const F4 gg = ld4(p.P + (size_t)R * LDP + GD_OFF + 3 * GROUP_W + hh * GD_HEAD + c4);
            const F4 sg = F4{siluf_(gg.x), siluf_(gg.y), siluf_(gg.z), siluf_(gg.w)};
            st4bf(p.mix + (size_t)R * D_MODEL + 2 * GROUP_W + hh * GD_HEAD + c4, y[i] * rstd * ld4(ng + c4) * sg); }
    }
}

template <int G> HD void ph_at_prep(const Params& p, int layer, Exec e) {
    constexpr int NHS = AT_QH + 2 * AT_KVH, HALF = AT_HEAD / 2, QTR = AT_HEAD / 4;
    for (int it = e.gid; it < MROWS * NHS; it += e.ngroups) {
        const int R = it / NHS, hs = it % NHS, b = row_b(R), s = row_s(R);
        const float* pr = p.P + (size_t)R * LDP + AT_OFF + hs * AT_HEAD;
        u16* dst; const float* g = nullptr;
        if (hs < AT_QH) { dst = p.at_q + (((size_t)b * AT_QH + hs) * TOK + s) * AT_HEAD; g = p.at_q_norm + layer * AT_HEAD; }
        else if (hs < AT_QH + AT_KVH) { dst = p.at_k + (((size_t)b * AT_KVH + hs - AT_QH) * TOK + s) * AT_HEAD; g = p.at_k_norm + layer * AT_HEAD; }
        else dst = p.at_v + (((size_t)b * AT_KVH + hs - AT_QH - AT_KVH) * TOK + s) * AT_HEAD;
        if (!g) { for (int j = e.gl; j < AT_HEAD; j += G) dst[j] = f2bf(pr[j]); continue; }
        float ss = 0.f;
        for (int j = e.gl; j < AT_HEAD; j += G) ss += pr[j] * pr[j];
        ss = group_sum<G>(ss); const float rstd = 1.f / sqrtf(ss / AT_HEAD + NORM_EPS);
        if (s < CTX) { for (int j = e.gl; j < AT_HEAD; j += G) dst[j] = f2bf(pr[j] * rstd * g[j]); continue; }
        const int t = s - CTX; const float posr = (float)(t / GRID_W), posc = (float)(t % GRID_W);
        for (int j = e.gl; j < AT_HEAD; j += G) {
            const int half = j / HALF, jj = j % HALF, fi = jj % QTR; const bool second = jj >= QTR;
            const float ang = (half ? posc : posr) * exp2f(-(float)(2 * fi) * (13.287712379549449f / (float)HALF));
            float cs, sn; sincosf(ang, &sn, &cs);
            const int jp = second ? j - QTR : j + QTR;
            const float own = pr[j] * rstd * g[j], oth = pr[jp] * rstd * g[jp];
            dst[j] = f2bf(second ? own * cs + oth * sn : own * cs - oth * sn);
        }
    }
}

#include <cstdio>
#include <cstddef>
static_assert(D_MODEL == 2048 && CTX == 256 && SEQ % 256 == 0 && AT_HEAD == 128, "GPU part is written for the full configuration");
static_assert(RW_C3_SMEM <= 147392 && TS_SMEM <= 147392 && RW_S2_SMEM <= 147392 && RW_C1_SMEM <= 147392 && GD_C3_SMEM <= 147392 && GD_S2_SMEM <= 147392 && ML_C1_SMEM <= 147392 && ML_C2_SMEM <= 147392, "LDS");
static_assert(CHUNK == RW_N && GD_N * CHUNK * 2 == CHUNK * CHUNK * 4, "buffer aliasing (Y0 on Ma, Qh on A)");

#define XB_TMO      128
#define XB_XCNT(j)  (256  + 64 * (j))
#define XB_XSUB(j)  (1280 + 64 * (j))
#define XB_XGEN(j)  (2304 + 64 * (j))
#define XB_TOP      3328
#define XB_TOPGEN   3392
#define XCD_BAR_WORDS 3456
#define XB_SPIN_CAP (1u << 24)
#define LAS __attribute__((address_space(3)))
__device__ __forceinline__ unsigned xb_ld(unsigned* p)              { return __hip_atomic_load(p, __ATOMIC_RELAXED, __HIP_MEMORY_SCOPE_AGENT); }
__device__ __forceinline__ unsigned xb_add(unsigned* p, unsigned v) { return __hip_atomic_fetch_add(p, v, __ATOMIC_RELAXED, __HIP_MEMORY_SCOPE_AGENT); }
__device__ __forceinline__ unsigned xb_xcc_id() { return (unsigned)__builtin_amdgcn_s_getreg((3 << 11) | 20) & 0xFu; }
#define XB_SPIN(cond, bar) do { unsigned _sp = 0; while (cond) { __builtin_amdgcn_s_sleep(1); \
    if ((++_sp & 255u) == 0u) { if (xb_ld(&(bar)[XB_TMO])) break; if (_sp > XB_SPIN_CAP) { atomicAdd(&(bar)[XB_TMO], 1u); break; } } } } while (0)
struct XcdBarrier { unsigned* bar; unsigned x; volatile LAS unsigned* st; };
__device__ __forceinline__ XcdBarrier xcd_barrier_post(unsigned* bar, volatile LAS unsigned* st) {
    XcdBarrier b; b.bar = bar; b.x = xb_xcc_id(); b.st = st;
    if (threadIdx.x == 0) (void)xb_add(&bar[XB_XCNT(b.x)], 1u);
    return b;
}
__device__ __forceinline__ void xcd_barrier_complete(unsigned* bar, unsigned x, unsigned& nloc, unsigned& nx) {
    const unsigned G = gridDim.x * gridDim.y * gridDim.z;
    unsigned sum, cnt, mine, sp = 0u;
    for (;;) {
        sum = 0u; cnt = 0u; mine = 0u;
#pragma unroll
        for (unsigned j = 0; j < 16; ++j) { const unsigned c = xb_ld(&bar[XB_XCNT(j)]); sum += c; cnt += (c > 0u) ? 1u : 0u; mine = (j == x) ? c : mine; }
        if (sum == G) break;
        __builtin_amdgcn_s_sleep(1);
        if ((++sp & 255u) == 0u) { if (xb_ld(&bar[XB_TMO])) break; if (sp > XB_SPIN_CAP) { atomicAdd(&bar[XB_TMO], 1u); break; } }
    }
    nloc = mine > 0u ? mine : 1u; nx = cnt > 0u ? cnt : 1u;
}
__device__ __forceinline__ void xcd_barrier(const XcdBarrier& b) {
    asm volatile("s_waitcnt vmcnt(0)" ::: "memory");
    __syncthreads();
    if (threadIdx.x == 0) {
        unsigned* bar = b.bar;
        __builtin_amdgcn_s_waitcnt(0);
        unsigned nloc = b.st[0], nx = b.st[1];
        if (nloc == 0u) { xcd_barrier_complete(bar, b.x, nloc, nx); b.st[0] = nloc; b.st[1] = nx; }
        const unsigned old = xb_add(&bar[XB_XSUB(b.x)], 1u);
        const unsigned gen = old / nloc;
        if (old + 1u == (gen + 1u) * nloc) {
            __builtin_amdgcn_fence(__ATOMIC_RELEASE, "agent");
            asm volatile("s_waitcnt vmcnt(0)" ::: "memory");
            const unsigned og = xb_add(&bar[XB_TOP], 1u);
            const unsigned tg = og / nx;
            if (og + 1u == (tg + 1u) * nx) xb_add(&bar[XB_TOPGEN], 1u);
            else XB_SPIN(xb_ld(&bar[XB_TOPGEN]) == tg, bar);
            __builtin_amdgcn_fence(__ATOMIC_ACQUIRE, "agent");
            xb_add(&bar[XB_XGEN(b.x)], 1u);
            asm volatile("s_waitcnt vmcnt(0)" ::: "memory");
        } else {
            XB_SPIN(xb_ld(&bar[XB_XGEN(b.x)]) == gen, bar);
            __builtin_amdgcn_fence(__ATOMIC_ACQUIRE, "agent");
            asm volatile("s_waitcnt vmcnt(0)" ::: "memory");
        }
    }
    __syncthreads();
}

namespace pg8 {
#define PG8_LAS __attribute__((address_space(3)))
typedef unsigned short bf16_t;
typedef short bf16x8 __attribute__((ext_vector_type(8)));
typedef float f32x4 __attribute__((ext_vector_type(4)));
typedef unsigned u32x4 __attribute__((ext_vector_type(4)));
constexpr int BM = 256, BK = 64, HALF = 128, HTB = HALF * BK * 2  , STAGE_BYTES = 8 * HTB, NXCD = 8, WGM = 8;

__host__ __device__ __forceinline__ int lds_byte(int r, int c) { const int st = (r >> 4) * 2 + (c >> 5), rr = r & 15, cc = c & 31, ob = rr * 64 + cc * 2; return st * 1024 + (ob ^ (((ob >> 9) & 1) << 5)); }
__host__ __device__ __forceinline__ void stage_rc(int b, int& R, int& C) { const int st = b / 1024, sb = b % 1024, swz = sb ^ (((sb >> 9) & 1) << 5); R = (st >> 1) * 16 + swz / 64; C = (st & 1) * 32 + (swz % 64) / 2; }
__host__ __device__ __forceinline__ int perm32(int rho) { const int n = rho >> 4, i = rho & 15; return 8 * (i >> 2) + 4 * n + (i & 3); }

struct Unit { int pm, pn; };
struct Gemm { const bf16_t* A; const bf16_t* Bt; int M, N, K; };

struct StaticOrder {
    int nM, nN, nwg, G, c;
    __host__ __device__ void init(int M, int N, int G_, int c_) { nM = M / BM; nN = N / BM; nwg = nM * nN; G = G_; c = c_; }
    __host__ __device__ bool next(int i, Unit& u) const {
        const long L = (long)i * G + c; if (L >= nwg) return false;
        int wgid = (int)L; { const int q = nwg / NXCD, r = nwg % NXCD, xcd = wgid % NXCD, off = wgid / NXCD; wgid = (xcd < r ? xcd * (q + 1) : r * (q + 1) + (xcd - r) * q) + off; }
        const int nig = WGM * nN, gid = wgid / nig, fm = gid * WGM, gsz = (nM - fm) < WGM ? (nM - fm) : WGM;
        u.pm = fm + ((wgid % nig) % gsz); u.pn = (wgid % nig) / gsz; return true;
    }
    __device__ __forceinline__ void a_ready(const Unit&) const {}
    __device__ __forceinline__ void done(const Unit&) const {}
};
__device__ __forceinline__ unsigned cvt_pk_bf16(float lo, float hi) { unsigned r; asm volatile("v_cvt_pk_bf16_f32 %0, %1, %2" : "=v"(r) : "v"(lo), "v"(hi)); return r; }
typedef unsigned u32x2v __attribute__((ext_vector_type(2)));

struct TileOrder {
    int nI, nJ, nwg, G, c, latent_only;
    __device__ void init(int nI_, int nJ_, int G_, int c_, int lat) { nI = nI_; nJ = nJ_; nwg = nI * nJ; G = G_; c = c_; latent_only = lat; }
    __device__ bool next(int i, Unit& u) const { const long L = (long)i * G + c; if (L >= nwg) return false;
        const int ii = (int)(L % nI), j = (int)(L / nI); u.pm = latent_only ? (ii / (SEQ / 256)) * (TOK / 256) + 1 + ii % (SEQ / 256) : ii; u.pn = j; return true; }
    __device__ __forceinline__ void a_ready(const Unit&) const {}
    __device__ __forceinline__ void done(const Unit&) const {}
};
struct GroupedOrder {
    int nI, nJ, tilesA, nwg, G, c;
    __device__ void init(int nI_, int nJ_, int tilesA_, int G_, int c_) { nI = nI_; nJ = nJ_; tilesA = tilesA_; nwg = NE * nI * nJ; G = G_; c = c_; }
    __device__ bool next(int i, Unit& u) const { const long L = (long)i * G + c; if (L >= nwg) return false;
        const int e = (int)(L / (nI * nJ)), r = (int)(L % (nI * nJ)), j = r / nI, ii = r % nI; u.pm = e * tilesA + ii; u.pn = e * nJ + j; return true; }
    __device__ __forceinline__ void a_ready(const Unit&) const {}
    __device__ __forceinline__ void done(const Unit&) const {}
};

struct EpiF32 {
    static constexpr bool PERM = false, AFTER_DRAIN = false;
    float* C; int ldc;
    __device__ __forceinline__ void operator()(const f32x4 (&acc)[2][2][4][2], const Unit& u, int wr, int wc, int fr, int fq) const {
        const int row0 = u.pm * BM + wr * 64 + fr, col0 = u.pn * BM + wc * 32 + 4 * fq;
#pragma unroll
        for (int ai = 0; ai < 2; ++ai)
#pragma unroll
            for (int m = 0; m < 4; ++m) { float* rowp = C + (size_t)(row0 + ai * HALF + m * 16) * ldc + col0;
#pragma unroll
                for (int bj = 0; bj < 2; ++bj)
#pragma unroll
                    for (int n = 0; n < 2; ++n) *(f32x4*)(rowp + bj * HALF + n * 16) = acc[ai][bj][m][n]; }
    }
};
struct EpiResid {
    static constexpr bool PERM = false, AFTER_DRAIN = false;
    float* X; const float* modl;
    __device__ __forceinline__ void operator()(const f32x4 (&acc)[2][2][4][2], const Unit& u, int wr, int wc, int fr, int fq) const {
        const int row0 = u.pm * BM + wr * 64 + fr, col0 = u.pn * BM + wc * 32 + 4 * fq;
        const int tb = TOK / 256, sel = (u.pm % tb == 0) ? 2 : u.pm / tb;
        const float* gate = modl + ((size_t)sel * 6 + 2) * D_MODEL + col0;
        f32x4 gv[2][2];
#pragma unroll
        for (int bj = 0; bj < 2; ++bj)
#pragma unroll
            for (int n = 0; n < 2; ++n) gv[bj][n] = *(const f32x4*)(gate + bj * HALF + n * 16);
#pragma unroll
        for (int ai = 0; ai < 2; ++ai)
#pragma unroll
            for (int m = 0; m < 4; ++m) { float* rowp = X + (size_t)(row0 + ai * HALF + m * 16) * D_MODEL + col0;
#pragma unroll
                for (int bj = 0; bj < 2; ++bj)
#pragma unroll
                    for (int n = 0; n < 2; ++n) { f32x4* q = (f32x4*)(rowp + bj * HALF + n * 16); *q = *q + gv[bj][n] * acc[ai][bj][m][n]; } }
    }
};
struct EpiSwiGLU {
    static constexpr bool PERM = false, AFTER_DRAIN = false;
    bf16_t* H; int nJ;
    __device__ __forceinline__ void operator()(const f32x4 (&acc)[2][2][4][2], const Unit& u, int wr, int wc, int fr, int fq) const {
        const int row0 = u.pm * BM + wr * 64 + fr, col0 = (u.pn % nJ) * HALF + wc * 32 + 4 * fq;
#pragma unroll
        for (int ai = 0; ai < 2; ++ai)
#pragma unroll
            for (int m = 0; m < 4; ++m) { bf16_t* rowp = H + (size_t)(row0 + ai * HALF + m * 16) * D_MODEL + col0;
#pragma unroll
                for (int n = 0; n < 2; ++n) { const f32x4 a = acc[ai][0][m][n], b = acc[ai][1][m][n]; float o[4];
#pragma unroll
                    for (int q = 0; q < 4; ++q) o[q] = a[q] / (1.f + __expf(-a[q])) * b[q];
                    u32x2v w; w.x = cvt_pk_bf16(o[0], o[1]); w.y = cvt_pk_bf16(o[2], o[3]); *(u32x2v*)(rowp + n * 16) = w; } }
    }
};
struct EpiGate {
    static constexpr bool PERM = false, AFTER_DRAIN = false;
    float* Y; const float* gate; int nJ;
    __device__ __forceinline__ void operator()(const f32x4 (&acc)[2][2][4][2], const Unit& u, int wr, int wc, int fr, int fq) const {
        const int row0 = u.pm * BM + wr * 64 + fr, col0 = (u.pn % nJ) * BM + wc * 32 + 4 * fq;
#pragma unroll
        for (int ai = 0; ai < 2; ++ai)
#pragma unroll
            for (int m = 0; m < 4; ++m) { const int r = row0 + ai * HALF + m * 16; const float gt = gate[r]; float* rowp = Y + (size_t)r * D_MODEL + col0;
#pragma unroll
                for (int bj = 0; bj < 2; ++bj)
#pragma unroll
                    for (int n = 0; n < 2; ++n) *(f32x4*)(rowp + bj * HALF + n * 16) = acc[ai][bj][m][n] * gt; }
    }
};
template <class Epi, class Sched>
__device__ __forceinline__ void gemm_phase(PG8_LAS unsigned char* lds, const Gemm g, const Sched& S, const Epi& E) {
    const int tid = threadIdx.x, wid = __builtin_amdgcn_readfirstlane(tid >> 6), lane = tid & 63, wr = wid >> 2, wc = wid & 3, fr = lane & 15, fq = lane >> 4;
    const int K = g.K, nt = K / BK;
    unsigned voffA[2], voffB[2];
#pragma unroll
    for (int i = 0; i < 2; ++i) { int R, C; stage_rc(tid * 16 + i * 8192, R, C); const int Rb = Epi::PERM ? ((R & ~31) + perm32(R & 31)) : R;
        voffA[i] = (unsigned)(R * K + C) * 2u; voffB[i] = (unsigned)(Rb * K + C) * 2u; }
    const size_t kstep = (size_t)(BK * 2);
    const size_t hstep = (size_t)HALF * K * 2;
    const size_t tstep = 2 * hstep;
    const unsigned ldsw = (unsigned)wid * 1024u;
    const int aoff = lds_byte(wr * 64 + fr, fq * 8), boff = lds_byte(wc * 32 + fr, fq * 8);
#define PG8_SA(b, h) (((b) * 2 + (h)) * HTB)
#define PG8_SB(b, h) ((4 + (b) * 2 + (h)) * HTB)
#define PG8_STAGE(bufoff, gbase, voff) do { _Pragma("unroll") for (int _i = 0; _i < 2; ++_i) \
        __builtin_amdgcn_global_load_lds((const unsigned*)((const char*)(gbase) + (voff)[_i]), (PG8_LAS unsigned*)(lds + (bufoff) + ldsw + _i * 8192), 16, 0, 0); } while (0)
#define PG8_LDA(dst, b, h) do { _Pragma("unroll") for (int m = 0; m < 4; ++m) _Pragma("unroll") for (int k = 0; k < 2; ++k) dst[m][k] = *(const PG8_LAS bf16x8*)(lds + PG8_SA(b, h) + aoff + m * 2048 + k * 1024); } while (0)
#define PG8_LDB(dst, b, h) do { _Pragma("unroll") for (int n = 0; n < 2; ++n) _Pragma("unroll") for (int k = 0; k < 2; ++k) dst[n][k] = *(const PG8_LAS bf16x8*)(lds + PG8_SB(b, h) + boff + n * 2048 + k * 1024); } while (0)
#define PG8_MMA(ai, bj, At, Bt) do { __builtin_amdgcn_s_setprio(1); _Pragma("unroll") for (int m = 0; m < 4; ++m) _Pragma("unroll") for (int n = 0; n < 2; ++n) _Pragma("unroll") for (int k = 0; k < 2; ++k) \
        acc[ai][bj][m][n] = __builtin_amdgcn_mfma_f32_16x16x32_bf16(Bt[n][k], At[m][k], acc[ai][bj][m][n], 0, 0, 0); __builtin_amdgcn_s_setprio(0); } while (0)
#define PG8_WAIT_V(n) asm volatile("s_waitcnt vmcnt(" #n ")" ::: "memory")
#define PG8_WAIT_L(n) asm volatile("s_waitcnt lgkmcnt(" #n ")" ::: "memory")
#define PG8_BAR __builtin_amdgcn_s_barrier()
#define PG8_SCHED __builtin_amdgcn_sched_barrier(0)
    Unit cur, nxt; int ui = 0;
    if (!S.next(0, cur)) return;
    f32x4 acc[2][2][4][2];
#pragma unroll
    for (int a = 0; a < 2; ++a)
#pragma unroll
        for (int b = 0; b < 2; ++b)
#pragma unroll
            for (int m = 0; m < 4; ++m)
#pragma unroll
                for (int n = 0; n < 2; ++n) acc[a][b][m][n] = (f32x4){0.f, 0.f, 0.f, 0.f};
    bf16x8 At[4][2], B0[2][2], B1[2][2];
    const char* cA = (const char*)g.A + (size_t)cur.pm * tstep; const char* cB = (const char*)g.Bt + (size_t)cur.pn * tstep;
    S.a_ready(cur);
    PG8_STAGE(PG8_SB(0, 0), cB, voffB); PG8_STAGE(PG8_SA(0, 0), cA, voffA); PG8_STAGE(PG8_SB(0, 1), cB + hstep, voffB); PG8_STAGE(PG8_SA(0, 1), cA + hstep, voffA);
    if (wr == 1) PG8_BAR;
    PG8_WAIT_V(4); PG8_BAR;
    PG8_STAGE(PG8_SB(1, 0), cB + kstep, voffB); PG8_STAGE(PG8_SA(1, 0), cA + kstep, voffA); PG8_STAGE(PG8_SB(1, 1), cB + hstep + kstep, voffB);
    PG8_WAIT_V(6); PG8_BAR;
    for (;;) {
        const bool has_next = S.next(ui + 1, nxt);
        const char* nA = has_next ? (const char*)g.A + (size_t)nxt.pm * tstep : cA; const char* nB = has_next ? (const char*)g.Bt + (size_t)nxt.pn * tstep : cB;
        for (int t = 0; t < nt; t += 2) {
            const bool last = (t == nt - 2);
            const char* a1 = cA + (size_t)(t + 1) * kstep;
            const char* a2 = last ? nA : cA + (size_t)(t + 2) * kstep; const char* b2 = last ? nB : cB + (size_t)(t + 2) * kstep;
            const char* a3 = a2 + kstep; const char* b3 = b2 + kstep;
            if (last && has_next) S.a_ready(nxt);
            PG8_LDB(B0, 0, 0); PG8_SCHED; PG8_LDA(At, 0, 0); PG8_STAGE(PG8_SA(1, 1), a1 + hstep, voffA);
            PG8_WAIT_L(8); PG8_BAR; PG8_WAIT_L(0); PG8_MMA(0, 0, At, B0); PG8_BAR; PG8_SCHED;
            PG8_LDB(B1, 0, 1); PG8_STAGE(PG8_SB(0, 0), b2, voffB);
            PG8_BAR; PG8_WAIT_L(0); PG8_MMA(0, 1, At, B1); PG8_BAR;
            PG8_LDA(At, 0, 1); PG8_STAGE(PG8_SA(0, 0), a2, voffA);
            PG8_BAR; PG8_WAIT_L(0); PG8_MMA(1, 0, At, B0); PG8_BAR; PG8_SCHED;
            PG8_STAGE(PG8_SB(0, 1), b2 + hstep, voffB);
            PG8_WAIT_V(6); PG8_BAR; PG8_MMA(1, 1, At, B1); PG8_BAR;
            PG8_LDB(B0, 1, 0); PG8_SCHED; PG8_LDA(At, 1, 0); PG8_STAGE(PG8_SA(0, 1), a2 + hstep, voffA);
            PG8_WAIT_L(8); PG8_BAR; PG8_WAIT_L(0); PG8_MMA(0, 0, At, B0); PG8_BAR; PG8_SCHED;
            PG8_LDB(B1, 1, 1); PG8_STAGE(PG8_SB(1, 0), b3, voffB);
            PG8_BAR; PG8_WAIT_L(0); PG8_MMA(0, 1, At, B1); PG8_BAR;
            PG8_LDA(At, 1, 1); PG8_STAGE(PG8_SA(1, 0), a3, voffA);
            PG8_BAR; PG8_WAIT_L(0); PG8_MMA(1, 0, At, B0); PG8_BAR; PG8_SCHED;
            PG8_STAGE(PG8_SB(1, 1), b3 + hstep, voffB);
            PG8_WAIT_V(6); PG8_BAR; PG8_MMA(1, 1, At, B1); PG8_BAR;
        }
        if constexpr (!Epi::AFTER_DRAIN) { E(acc, cur, wr, wc, fr, fq); S.done(cur); }
        if (!has_next) break;
#pragma unroll
        for (int a = 0; a < 2; ++a)
#pragma unroll
            for (int b = 0; b < 2; ++b)
#pragma unroll
                for (int m = 0; m < 4; ++m)
#pragma unroll
                    for (int n = 0; n < 2; ++n) acc[a][b][m][n] = (f32x4){0.f, 0.f, 0.f, 0.f};
        cur = nxt; cA = nA; cB = nB; ++ui;
    }
    PG8_WAIT_V(0);
    if (wr == 0) PG8_BAR;
    PG8_BAR;
    if constexpr (Epi::AFTER_DRAIN) { E.fused(acc, cur, wr, wc, fr, fq, lds, wid, lane); S.done(cur); }
#undef PG8_SA
#undef PG8_SB
#undef PG8_STAGE
#undef PG8_LDA
#undef PG8_LDB
#undef PG8_MMA
#undef PG8_WAIT_V
#undef PG8_WAIT_L
#undef PG8_BAR
#undef PG8_SCHED
}
}


namespace att {
using bf16 = unsigned short;
constexpr int   D = 128, NW = 8, QBLK = 32, KVBLK = 64;
constexpr float SCALE = 0.088388347648318440f;
constexpr float THR = 8.f;
constexpr int SDEPTH = 2;
constexpr int LDQ = 128, LDK = 128, LDO = D_MODEL;
constexpr size_t SHM_V = KVBLK * D * 2, SHM_K = KVBLK * D * 2, SHM_ATTN = 2 * SHM_V + 2 * SHM_K + NW * 64 * 4;
using bf16x8 = __attribute__((ext_vector_type(8))) short;
using s16x4  = __attribute__((ext_vector_type(4))) short;
using f32x16 = __attribute__((ext_vector_type(16))) float;
using f32x8  = __attribute__((ext_vector_type(8))) float;
using u32x4  = __attribute__((ext_vector_type(4))) unsigned;
#define KSWZ(row, colB) ((row) * 256 + ((colB) ^ (((row) & 7) << 4)))
#define SBAR() __builtin_amdgcn_sched_barrier(0)
__device__ __forceinline__ int crow(int r, int hi) { return (r & 3) + 8 * (r >> 2) + 4 * hi; }
__device__ __forceinline__ unsigned cvtpk(float lo, float hi) {
  unsigned r; asm volatile("v_cvt_pk_bf16_f32 %0, %1, %2" : "=v"(r) : "v"(lo), "v"(hi)); return r;
}
template <typename TIn> struct Stage;
template <> struct Stage<bf16>  { using T = bf16x8;
  __device__ static __forceinline__ T ld8(const bf16* p) { return *reinterpret_cast<const bf16x8*>(p); }
  __device__ static __forceinline__ bf16x8 tobf(T x) { return x; } };
template <> struct Stage<float> { using T = f32x8;
  __device__ static __forceinline__ T ld8(const float* p) { return *reinterpret_cast<const f32x8*>(p); }
  __device__ static __forceinline__ bf16x8 tobf(T x) {
    u32x4 w = {cvtpk(x[0], x[1]), cvtpk(x[2], x[3]), cvtpk(x[4], x[5]), cvtpk(x[6], x[7])}; return *reinterpret_cast<bf16x8*>(&w); } };

__device__ __forceinline__ void partialSM(f32x16& p0, f32x16& p1, float& m_reg, float& mn, float& alpha) {
  constexpr float C = SCALE * 1.4426950408889634f;
  float pmax = p0[0]; for (int r = 1; r < 16; ++r) pmax = fmaxf(pmax, p0[r]); for (int r = 0; r < 16; ++r) pmax = fmaxf(pmax, p1[r]);
  { auto rr = __builtin_amdgcn_permlane32_swap(__float_as_uint(pmax), __float_as_uint(pmax), false, false);
    pmax = fmaxf(__uint_as_float(rr[0]), __uint_as_float(rr[1])); }
  if (__builtin_expect(__all(pmax - m_reg <= THR / SCALE), 1)) { mn = m_reg; alpha = 1.f; }
  else { mn = fmaxf(m_reg, pmax); alpha = __builtin_amdgcn_exp2f((m_reg - mn) * C); m_reg = mn; }
  float mnC = -mn * C;
  for (int r = 0; r < 16; ++r) p0[r] = fmaf(p0[r], C, mnC); for (int r = 0; r < 16; ++r) p1[r] = fmaf(p1[r], C, mnC);
  for (int r = 0; r < 16; ++r) p0[r] = __builtin_amdgcn_exp2f(p0[r]);
}
__device__ __forceinline__ void finishSM(f32x16& p0, f32x16& p1, float alpha, float& l_reg, bf16x8& pa0, bf16x8& pa1, bf16x8& pa2, bf16x8& pa3) {
  for (int r = 0; r < 16; ++r) p1[r] = __builtin_amdgcn_exp2f(p1[r]);
  float ps = 0; for (int r = 0; r < 16; ++r) ps += p0[r]; for (int r = 0; r < 16; ++r) ps += p1[r];
  { auto rr = __builtin_amdgcn_permlane32_swap(__float_as_uint(ps), __float_as_uint(ps), false, false);
    ps = __uint_as_float(rr[0]) + __uint_as_float(rr[1]); }
  l_reg = l_reg * alpha + ps;
#define PK4(P, BASE, OUT) do { unsigned a0 = cvtpk(P[BASE + 0], P[BASE + 1]), a1 = cvtpk(P[BASE + 2], P[BASE + 3]);   \
    unsigned b0 = cvtpk(P[BASE + 4], P[BASE + 5]), b1 = cvtpk(P[BASE + 6], P[BASE + 7]);                              \
    auto r0 = __builtin_amdgcn_permlane32_swap(a0, b0, false, false); auto r1 = __builtin_amdgcn_permlane32_swap(a1, b1, false, false); \
    u32x4 w = {r0[0], r1[0], r0[1], r1[1]}; OUT = *reinterpret_cast<bf16x8*>(&w); } while (0)
  PK4(p0, 0, pa0); PK4(p0, 8, pa1); PK4(p1, 0, pa2); PK4(p1, 8, pa3);
#undef PK4
}
__device__ __forceinline__ void qkt(f32x16& p0, f32x16& p1, const bf16* Ks, const bf16x8* qr, int r32, int hi) {
  p0 = f32x16{}; p1 = f32x16{};
  for (int d0 = 0; d0 < 8; ++d0) { int cb = (d0 * 16 + hi * 8) * 2;
    bf16x8 b0 = *reinterpret_cast<const bf16x8*>((const char*)Ks + KSWZ(r32, cb));
    bf16x8 b1 = *reinterpret_cast<const bf16x8*>((const char*)Ks + KSWZ(32 + r32, cb));
    p0 = __builtin_amdgcn_mfma_f32_32x32x16_bf16(b0, qr[d0], p0, 0, 0, 0);
    p1 = __builtin_amdgcn_mfma_f32_32x32x16_bf16(b1, qr[d0], p1, 0, 0, 0); }
}
__device__ __forceinline__ int v_st(int k, int c) { const int kk = (k & ~0xC) | ((k & 4) << 1) | ((k & 8) >> 1); return ((kk >> 3) * 4 + (c >> 5)) * 512 + ((kk & 7) * 32 + (c & 31)) * 2; }
__device__ __forceinline__ int v_rd_base(int lane) { return ((lane & 3) << 3) | (((lane >> 2) & 3) << 6) | (((lane >> 4) & 1) << 5) | (((lane >> 5) & 1) << 8); }
constexpr int v_rd_off(int d0, int ks, int half) { return d0 * 512 + ks * 4096 + half * 2048; }
template <int OFF> __device__ __forceinline__ s16x4 tr_read(int vb) {
  s16x4 r; asm volatile("ds_read_b64_tr_b16 %0, %1 offset:%2" : "=&v"(r) : "v"(vb), "i"(OFF) : "memory"); return r;
}
template <int D0> __device__ __forceinline__ void pv_one(f32x16& od, int vb, bf16x8 pa0, bf16x8 pa1, bf16x8 pa2, bf16x8 pa3) {
  const s16x4 l0 = tr_read<v_rd_off(D0, 0, 0)>(vb), h0 = tr_read<v_rd_off(D0, 0, 1)>(vb), l1 = tr_read<v_rd_off(D0, 1, 0)>(vb), h1 = tr_read<v_rd_off(D0, 1, 1)>(vb);
  const s16x4 l2 = tr_read<v_rd_off(D0, 2, 0)>(vb), h2 = tr_read<v_rd_off(D0, 2, 1)>(vb), l3 = tr_read<v_rd_off(D0, 3, 0)>(vb), h3 = tr_read<v_rd_off(D0, 3, 1)>(vb);
  asm volatile("s_waitcnt lgkmcnt(0)" ::: "memory"); SBAR();
#define PK(L, H) (bf16x8){L[0], L[1], L[2], L[3], H[0], H[1], H[2], H[3]}
  od = __builtin_amdgcn_mfma_f32_32x32x16_bf16(pa0, PK(l0, h0), od, 0, 0, 0);
  od = __builtin_amdgcn_mfma_f32_32x32x16_bf16(pa1, PK(l1, h1), od, 0, 0, 0);
  od = __builtin_amdgcn_mfma_f32_32x32x16_bf16(pa2, PK(l2, h2), od, 0, 0, 0);
  od = __builtin_amdgcn_mfma_f32_32x32x16_bf16(pa3, PK(l3, h3), od, 0, 0, 0);
#undef PK
}
__device__ __forceinline__ void pv_d0(f32x16* o, int vb, bf16x8 pa0, bf16x8 pa1, bf16x8 pa2, bf16x8 pa3) {
  pv_one<0>(o[0], vb, pa0, pa1, pa2, pa3); pv_one<1>(o[1], vb, pa0, pa1, pa2, pa3); pv_one<2>(o[2], vb, pa0, pa1, pa2, pa3); pv_one<3>(o[3], vb, pa0, pa1, pa2, pa3);
}

__device__ __forceinline__ void attn_dense_body(const bf16* __restrict__ Qb, const bf16* __restrict__ Kh, const bf16* __restrict__ Vh,
                                                unsigned short* __restrict__ Ob, int seq, char* lds) {
  using St = Stage<bf16>; using SQ = Stage<bf16>; using TQ = bf16;
  const int tid = threadIdx.x, wid = tid >> 6, lane = tid & 63, r32 = lane & 31, hi = lane >> 5;
  bf16* V_lds = (bf16*)lds; bf16* K_lds = (bf16*)(lds + 2 * SHM_V);
  float* ws = (float*)(lds + 2 * SHM_V + 2 * SHM_K) + wid * 64; float* li_l = ws; float* al_l = ws + 32;
  float m_reg = -1e30f, l_reg = 0; f32x16 o[4] = {}; bf16x8 qr[8];
  const TQ* Qw = Qb + (long)(wid * QBLK + r32) * LDQ + hi * 8;
#pragma unroll
  for (int d0 = 0; d0 < 8; ++d0) qr[d0] = SQ::tobf(SQ::ld8(Qw + d0 * 16));
  const int sr = tid >> 4, sc = (tid & 15) * 8, vst0 = v_st(sr, sc), vst1 = v_st(32 + sr, sc);
  const int vb0 = (int)(uintptr_t)V_lds + v_rd_base(lane);
  struct { typename St::T vs0, vs1, ks0, ks1; } sr_[SDEPTH];
#define SLOAD(i, k0) do { sr_[i].vs0 = St::ld8(&Vh[(long)((k0) + sr) * LDK + sc]); sr_[i].vs1 = St::ld8(&Vh[(long)((k0) + 32 + sr) * LDK + sc]); \
    sr_[i].ks0 = St::ld8(&Kh[(long)((k0) + sr) * LDK + sc]); sr_[i].ks1 = St::ld8(&Kh[(long)((k0) + 32 + sr) * LDK + sc]); } while (0)
#define SWRITE(b, i) do { *(bf16x8*)((char*)V_lds + (b) * SHM_V + vst0) = St::tobf(sr_[i].vs0);          \
    *(bf16x8*)((char*)V_lds + (b) * SHM_V + vst1) = St::tobf(sr_[i].vs1); int kc = sc * 2;               \
    *(bf16x8*)((char*)K_lds + (b) * SHM_K + KSWZ(sr, kc)) = St::tobf(sr_[i].ks0);                       \
    *(bf16x8*)((char*)K_lds + (b) * SHM_K + KSWZ(32 + sr, kc)) = St::tobf(sr_[i].ks1); } while (0)
#define SWAIT() do { if constexpr (SDEPTH == 2) asm volatile("s_waitcnt vmcnt(4)" ::: "memory"); else asm volatile("s_waitcnt vmcnt(0)" ::: "memory"); } while (0)
#define RESC(a) do { if (__any((a) < 1.f)) { if (hi == 0) al_l[r32] = (a); asm volatile("s_waitcnt lgkmcnt(0)" ::: "memory"); \
    for (int d = 0; d < 4; ++d) for (int r = 0; r < 16; ++r) o[d][r] *= al_l[crow(r, hi)]; } } while (0)
  f32x16 pA0, pA1, pB0, pB1; float mnA, mnB, alA, alB; bf16x8 pa0, pa1, pa2, pa3; const int NT = seq / KVBLK;
  constexpr int SE = 0, SO = SDEPTH - 1;
  SLOAD(SE, 0); asm volatile("s_waitcnt vmcnt(0)" ::: "memory"); SWRITE(0, SE); __syncthreads();
  qkt(pA0, pA1, K_lds, qr, r32, hi); partialSM(pA0, pA1, m_reg, mnA, alA);
  SLOAD(SO, KVBLK); if constexpr (SDEPTH == 2) { if (2 < NT) SLOAD(SE, 2 * KVBLK); }
  SWAIT(); SWRITE(1, SO); __syncthreads();
  for (int j = 1; j + 1 < NT; j += 2) {
    SBAR(); qkt(pB0, pB1, (bf16*)((char*)K_lds + SHM_K), qr, r32, hi);
    finishSM(pA0, pA1, alA, l_reg, pa0, pa1, pa2, pa3); SBAR();
    SLOAD(SO, (j + SDEPTH) * KVBLK); SBAR();
    pv_d0(o, vb0, pa0, pa1, pa2, pa3); partialSM(pB0, pB1, m_reg, mnB, alB);
    __syncthreads(); SWAIT(); SWRITE(0, SE);
    RESC(alB); __syncthreads();
    SBAR(); qkt(pA0, pA1, K_lds, qr, r32, hi);
    finishSM(pB0, pB1, alB, l_reg, pa0, pa1, pa2, pa3); SBAR();
    if (SDEPTH == 1 || j + 3 < NT) SLOAD(SE, (j + 1 + SDEPTH) * KVBLK); SBAR();
    pv_d0(o, vb0 + (int)SHM_V, pa0, pa1, pa2, pa3); partialSM(pA0, pA1, m_reg, mnA, alA);
    __syncthreads(); SWAIT(); SWRITE(1, SO);
    RESC(alA); __syncthreads();
  }
  SBAR(); qkt(pB0, pB1, (bf16*)((char*)K_lds + SHM_K), qr, r32, hi);
  finishSM(pA0, pA1, alA, l_reg, pa0, pa1, pa2, pa3); SBAR();
  pv_d0(o, vb0, pa0, pa1, pa2, pa3); partialSM(pB0, pB1, m_reg, mnB, alB);
  __syncthreads(); RESC(alB);
  finishSM(pB0, pB1, alB, l_reg, pa0, pa1, pa2, pa3); SBAR();
  pv_d0(o, vb0 + (int)SHM_V, pa0, pa1, pa2, pa3);
  if (hi == 0) li_l[r32] = l_reg; asm volatile("s_waitcnt lgkmcnt(0)" ::: "memory");
  float rli[16];
#pragma unroll
  for (int r = 0; r < 16; ++r) rli[r] = __builtin_amdgcn_rcpf(li_l[crow(r, hi)]);
  unsigned short* Ow = Ob + (long)(wid * QBLK) * LDO;
#pragma unroll
  for (int r = 0; r < 16; ++r) { int orow = crow(r, hi);
    for (int d0 = 0; d0 < 4; ++d0) Ow[(long)orow * LDO + d0 * 32 + r32] = f2bf(o[d0][r] * rli[r]); }
#undef SLOAD
#undef SWRITE
#undef SWAIT
#undef RESC
}
}

__device__ __forceinline__ void cvt_tile(const float* __restrict__ W, int ldw, int nvalid, int k0, int n0, u16* __restrict__ Wt, int rmode, float* lds) {
    typedef float f4 __attribute__((ext_vector_type(4)));
    typedef unsigned u4 __attribute__((ext_vector_type(4)));
    const int tid = threadIdx.x, c4 = (tid & 31) * 4, r0 = tid >> 5;
    f4 v[8];
    const bool ok = (n0 + c4) < nvalid;
#pragma unroll
    for (int i = 0; i < 8; ++i) v[i] = ok ? *(const f4*)(W + (size_t)(k0 + r0 + 16 * i) * ldw + n0 + c4) : (f4){0.f, 0.f, 0.f, 0.f};
#pragma unroll
    for (int i = 0; i < 8; ++i) *(f4*)(lds + (r0 + 16 * i) * 132 + c4) = v[i];
    __syncthreads();
    const int nn = tid & 127, kq = tid >> 7, n = n0 + nn;
    int row = n;
    if (rmode) row = (n >> 7) * 256 + (n & 127) + (rmode == 2 ? 128 : 0);
    u16* dst = Wt + (size_t)row * D_MODEL + k0 + kq * 32;
#pragma unroll
    for (int j = 0; j < 4; ++j) { const float* s = lds + (kq * 32 + j * 8) * 132 + nn; u4 w;
        w.x = pg8::cvt_pk_bf16(s[0], s[132]); w.y = pg8::cvt_pk_bf16(s[2 * 132], s[3 * 132]); w.z = pg8::cvt_pk_bf16(s[4 * 132], s[5 * 132]); w.w = pg8::cvt_pk_bf16(s[6 * 132], s[7 * 132]);
        *(u4*)(dst + j * 8) = w; }
    __syncthreads();
}
__device__ __forceinline__ void ph_convert(const Params& p, float* lds) {
    constexpr int KT = D_MODEL / 128;
    constexpr int T_IN = KT * (LDP / 128), T_OUT = KT * (D_MODEL / 128), T_E = KT * (D_MODEL / 128);
    constexpr int PER_L = T_IN + T_OUT + NE * 3 * T_E, TOTAL = DEPTH * PER_L;
    static_assert(N_IN % 4 == 0 && LDP % 128 == 0, "conversion tiles");
    for (int t = blockIdx.x; t < TOTAL; t += gridDim.x) {
        const int l = t / PER_L; int r = t % PER_L;
        if (r < T_IN) { const int kt = r % KT, nt = r / KT;
            cvt_tile(p.w_in + (size_t)l * D_MODEL * N_IN, N_IN, N_IN, kt * 128, nt * 128, p.wt_in + (size_t)l * LDP * D_MODEL, 0, lds); continue; }
        r -= T_IN;
        if (r < T_OUT) { const int kt = r % KT, nt = r / KT;
            cvt_tile(p.w_out + (size_t)l * D_MODEL * D_MODEL, D_MODEL, D_MODEL, kt * 128, nt * 128, p.wt_out + (size_t)l * D_MODEL * D_MODEL, 0, lds); continue; }
        r -= T_OUT;
        const int e = r / (3 * T_E), which = (r / T_E) % 3, q = r % T_E, kt = q % KT, nt = q / KT;
        const size_t eo = ((size_t)l * NE + e) * D_MODEL * D_MODEL;
        if (which == 0) cvt_tile(p.w_exp1 + eo, D_MODEL, D_MODEL, kt * 128, nt * 128, p.w13t + 2 * eo, 1, lds);
        else if (which == 1) cvt_tile(p.w_exp3 + eo, D_MODEL, D_MODEL, kt * 128, nt * 128, p.w13t + 2 * eo, 2, lds);
        else cvt_tile(p.w_exp2 + eo, D_MODEL, D_MODEL, kt * 128, nt * 128, p.w2t + eo, 0, lds);
    }
}

constexpr int LDS_BYTES = 147456;
constexpr int LDS_MISC = 147392;
constexpr int NPL = 16;
constexpr int NPHASE = 2 + DEPTH * NPL + 1;

struct Args { Params p; int ph_lo, ph_hi, flags, pad; };

template <int G> __device__ __forceinline__ Exec mk_exec() { const int gt = blockIdx.x * 512 + threadIdx.x; return Exec{gt / G, (int)(gridDim.x * 512) / G, gt % G}; }
typedef const __attribute__((address_space(4))) unsigned long long* kq_t;
__device__ __forceinline__ void load_params(Params& p, const __attribute__((address_space(4))) unsigned char* ka) {
    kq_t s = (kq_t)ka; unsigned long long* d = (unsigned long long*)&p;
#pragma unroll
    for (int i = 0; i < (int)(sizeof(Params) / 8); ++i) d[i] = s[i];
}
#define LOADP() Params p; load_params(p, ka)
#define PH(k, ...) do { if (lo <= (k) && (k) < hi) { { LOADP(); __VA_ARGS__; } if ((k) + 1 < hi) xcd_barrier(bar); } } while (0)
#define e1 mk_exec<1>()
#define e16 mk_exec<16>()
#define e64 mk_exec<64>()
#define flds ((float*)lds)
#define glds ((PG8_LAS unsigned char*)lds)
#define G ((int)gridDim.x)
#define c ((int)blockIdx.x)
template <int L> __device__ __forceinline__ void layer_phases(const __attribute__((address_space(4))) unsigned char* ka, int lo, int hi, int flags, const XcdBarrier& bar, unsigned char* lds) {
    constexpr int l = L;
        const int b0 = 2 + l * NPL; const bool last = (l == DEPTH - 1);
        PH(b0 + 0, ph_norm1<64>(p, l, e64));
        PH(b0 + 1, { pg8::Gemm g{p.h, p.wt_in + (size_t)l * LDP * D_MODEL, MROWS, LDP, D_MODEL}; pg8::StaticOrder S; S.init(MROWS, LDP, G, c);
                     pg8::EpiF32 E{p.P, LDP}; pg8::gemm_phase<pg8::EpiF32, pg8::StaticOrder>(glds, g, S, E); });
        PH(b0 + 2, ph_rw_prep1<64>(p, l, e64); ph_ml_g1<64>(p, l, e64); ph_gd_prep<64>(p, l, e64); ph_gd_gates<64>(p, l, e64); ph_at_prep<64>(p, l, e64));
        PH(b0 + 3, ph_rw_prep2(p, l, e64); ph_ml_g2(p, e1); ph_gd_c1(p, e64));
        PH(b0 + 4, { for (int u = c; u < RW_CN; u += G) ph_rw_c1_unit(p, u, threadIdx.x, 512, lds); for (int u = G - 1 - c; u < ML_CN; u += G) ph_ml_c1_unit(p, u, threadIdx.x, 512, lds); });
        PH(b0 + 5, { constexpr int NU1 = (RW_CN + TS_G - 1) / TS_G, NU2 = (GD_CN + TS_G - 1) / TS_G;
            if (!(flags & 2)) for (int u = c; u < NU1 + NU2; u += G) { if (u < NU1) ph_tsolve_unit(p.rw_Ma, p.rw_T, RW_CN, u, threadIdx.x, 512, lds); else ph_tsolve_unit(p.gd_A, p.gd_T, GD_CN, u - NU1, threadIdx.x, 512, lds); }
            ph_ml_prefix(p, e1); });
        PH(b0 + 6, {
            const int nlat = BATCH * AT_QH * (SEQ / 256), nctx = last ? 0 : BATCH * AT_QH;
            if (flags & 1) {} else if (c < nlat) { const int u = c;
                const int qb = u % (SEQ / 256), hq = (u / (SEQ / 256)) % AT_QH, b = u / ((SEQ / 256) * AT_QH), s0 = CTX + qb * 256, kvh = hq / (AT_QH / AT_KVH);
                att::attn_dense_body((const att::bf16*)p.at_q + (((size_t)b * AT_QH + hq) * TOK + s0) * AT_HEAD,
                                     (const att::bf16*)p.at_k + ((size_t)b * AT_KVH + kvh) * TOK * AT_HEAD, (const att::bf16*)p.at_v + ((size_t)b * AT_KVH + kvh) * TOK * AT_HEAD,
                                     p.mix + ((size_t)b * TOK + s0) * D_MODEL + 3 * GROUP_W + hq * AT_HEAD, TOK, (char*)lds);
                __syncthreads(); }
            else if (c < nlat + nctx) { const int u = c - nlat;
                const int hq = u % AT_QH, b = u / AT_QH, kvh = hq / (AT_QH / AT_KVH);
                att::attn_dense_body((const att::bf16*)p.at_q + (((size_t)b * AT_QH + hq) * TOK) * AT_HEAD,
                                     (const att::bf16*)p.at_k + ((size_t)b * AT_KVH + kvh) * TOK * AT_HEAD, (const att::bf16*)p.at_v + ((size_t)b * AT_KVH + kvh) * TOK * AT_HEAD,
                                     p.mix + ((size_t)b * TOK) * D_MODEL + 3 * GROUP_W + hq * AT_HEAD, CTX, (char*)lds);
                __syncthreads(); } });
        PH(b0 + 7, { if (!(flags & 4)) for (int u = c; u < RW_CN; u += G) ph_rw_c3_unit(p, u, threadIdx.x, 512, lds);
                     if (!(flags & 8)) for (int u = G - 1 - c; u < GD_CN; u += G) ph_gd_c3_unit(p, u, threadIdx.x, 512, lds);
                     if (!(flags & 64)) for (int u = c; u < ML_CN; u += G) ph_ml_c2_unit(p, u, threadIdx.x, 512, lds); });
        PH(b0 + 8, { if (!(flags & 16)) for (int u = c; u < GD_S2_UNITS; u += G) ph_gd_scan2_unit(p, u, threadIdx.x, 512, lds); }
                   { if (!(flags & 32)) for (int u = G - 1 - c; u < RW_CH; u += G) ph_rw_scan2_unit(p, u, threadIdx.x, 512, lds); });
        PH(b0 + 9, ph_rw_post<16>(p, l, e16); ph_gd_post<16>(p, l, e16); ph_ml_post<16>(p, l, e16));
        PH(b0 + 10, { pg8::Gemm g{p.mix, p.wt_out + (size_t)l * D_MODEL * D_MODEL, MROWS, D_MODEL, D_MODEL}; pg8::TileOrder S;
                      S.init(last ? BATCH * SEQ / 256 : MROWS / 256, D_MODEL / 256, G, c, last ? 1 : 0);
                      pg8::EpiResid E{p.xres, p.mod + (size_t)l * 3 * 6 * D_MODEL}; pg8::gemm_phase<pg8::EpiResid, pg8::TileOrder>(glds, g, S, E); });
        PH(b0 + 11, ph_norm2<64>(p, l, e64));
        PH(b0 + 12, { for (int u = c; u < topk_units(l); u += G) ph_topk_unit(p, l, u, threadIdx.x, 512, lds); });
        PH(b0 + 13, ph_gather<64>(p, l, e64));
        PH(b0 + 14, { pg8::Gemm g{p.xs, p.w13t + (size_t)l * NE * 2 * D_MODEL * D_MODEL, NE * NSLOT, NE * 2 * D_MODEL, D_MODEL}; pg8::GroupedOrder S;
                      S.init(last ? NSLOT_L / 256 : NSLOT / 256, 2 * D_MODEL / 256, NSLOT / 256, G, c);
                      pg8::EpiSwiGLU E{p.hid, 2 * D_MODEL / 256}; pg8::gemm_phase<pg8::EpiSwiGLU, pg8::GroupedOrder>(glds, g, S, E); });
        PH(b0 + 15, { pg8::Gemm g{p.hid, p.w2t + (size_t)l * NE * D_MODEL * D_MODEL, NE * NSLOT, NE * D_MODEL, D_MODEL}; pg8::GroupedOrder S;
                      S.init(last ? NSLOT_L / 256 : NSLOT / 256, D_MODEL / 256, NSLOT / 256, G, c);
                      pg8::EpiGate E{p.yexp, p.sel_gate, D_MODEL / 256}; pg8::gemm_phase<pg8::EpiGate, pg8::GroupedOrder>(glds, g, S, E); });
    }
__global__ void __launch_bounds__(512, 2) mega(Args args) {
    extern __shared__ __attribute__((aligned(16))) unsigned char lds[];
    typedef const __attribute__((address_space(4))) unsigned char* kptr_t;
    const kptr_t ka = (kptr_t)__builtin_amdgcn_kernarg_segment_ptr();
    (void)args;
    const unsigned long long lohi = ((kq_t)ka)[sizeof(Params) / 8]; const int lo = (int)(unsigned)lohi, hi = (int)(unsigned)(lohi >> 32);
    const int flags = (int)(unsigned)((kq_t)ka)[sizeof(Params) / 8 + 1];
    unsigned* barw = (unsigned*)((kq_t)ka)[offsetof(Params, bar) / 8];
    volatile LAS unsigned* misc = (volatile LAS unsigned*)((LAS unsigned char*)lds + LDS_MISC);
    if (threadIdx.x < 4) misc[threadIdx.x] = 0u;
    __syncthreads();
    const bool use_bar = (hi - lo) > 1;
    XcdBarrier bar; bar.bar = barw; bar.x = 0; bar.st = misc;
    if (use_bar) bar = xcd_barrier_post(barw, misc);
    PH(0, ph_convert(p, flds); ph_mod_partial(p, e1); ph_rw_wpack(p, e1));
    PH(1, ph_mod_final(p, e1));
    layer_phases<0>(ka, lo, hi, flags, bar, lds);
    layer_phases<1>(ka, lo, hi, flags, bar, lds);
    static_assert(DEPTH == 2, "depth");
    PH(2 + DEPTH * NPL, ph_final<64>(p, e64));
}
#undef PH
#undef e1
#undef e16
#undef e64
#undef flds
#undef glds
#undef G
#undef c
#undef LOADP

static size_t ws_carve(Params& p, unsigned char* ws) {
    size_t off = 0;
    auto take = [&](size_t bytes) { size_t o = off; off += (bytes + 255) / 256 * 256; return ws ? ws + o : (unsigned char*)nullptr; };
    p.bar = (unsigned*)take(XCD_BAR_WORDS * 4);
    p.modp = (float*)take((size_t)DEPTH * MOD_KS * 3 * 6 * D_MODEL * 4); p.mod = (float*)take((size_t)DEPTH * 3 * 6 * D_MODEL * 4);
    p.wt_in = (u16*)take((size_t)DEPTH * LDP * D_MODEL * 2); p.wt_out = (u16*)take((size_t)DEPTH * D_MODEL * D_MODEL * 2);
    p.w13t = (u16*)take((size_t)DEPTH * NE * 2 * D_MODEL * D_MODEL * 2); p.w2t = (u16*)take((size_t)DEPTH * NE * D_MODEL * D_MODEL * 2);
    p.xres = (float*)take((size_t)MROWS * D_MODEL * 4); p.h = (u16*)take((size_t)MROWS * D_MODEL * 2); p.mix = (u16*)take((size_t)MROWS * D_MODEL * 2);
    p.aff = (float*)take((size_t)MROWS * NE * 4); p.inv = (int*)take((size_t)MROWS * NE * 4);
    p.sel_row = (int*)take((size_t)NE * NSLOT * 4); p.sel_gate = (float*)take((size_t)NE * NSLOT * 4);
    const size_t region = off;
    p.P = (float*)take((size_t)MROWS * LDP * 4);
    const size_t rg = (size_t)MROWS * GROUP_W * 4;
    p.rw_r = (float*)take(rg); p.rw_k = (float*)take(rg); p.rw_v = (float*)take(rg); p.rw_kk = (float*)take(rg); p.rw_g = (float*)take(rg);
    p.rw_lr = (float*)take((size_t)MROWS * RW_LR * 4);
    p.rw_ew = (float*)take(2 * rg); p.rw_kka = (float*)take(2 * rg); p.rw_kt = (float*)take(2 * rg); p.rw_y = (float*)take(2 * rg);
    p.rw_Ma = (float*)take((size_t)RW_CN * CHUNK * CHUNK * 4); p.rw_T = (float*)take((size_t)RW_CN * CHUNK * CHUNK * 4);
    p.rw_Psi = (float*)take((size_t)RW_CN * RW_N * RW_N * 4); p.rw_Y0 = p.rw_Ma;
    p.rw_PhiT = (u16*)take((size_t)RW_CN * RW_N * RW_N * 2); p.rw_Rh = (u16*)take((size_t)RW_CN * CHUNK * RW_N * 2);
    p.rw_W = (u16*)take((size_t)DEPTH * GROUP_W * RW_WK * 2);
    p.ml_bcum = (float*)take((size_t)ML_CH * TOK * 4); p.ml_g = (float*)take((size_t)ML_CH * TOK * 4); p.ml_gmax = (float*)take((size_t)ML_CH * TOK * 4);
    p.ml_bl = (float*)take((size_t)ML_CH * NCHUNK * 4); p.ml_gm = (float*)take((size_t)ML_CH * NCHUNK * 4); p.ml_min = (float*)take((size_t)ML_CH * NCHUNK * 4); p.ml_dcv = (float*)take((size_t)ML_CH * NCHUNK * 4);
    p.ml_dC = (float*)take((size_t)ML_CH * NCHUNK * ML_HEAD * ML_HEAD * 4); p.ml_dn = (float*)take((size_t)ML_CH * NCHUNK * ML_HEAD * 4);
    p.ml_S = (float*)take((size_t)ML_CH * NCHUNK * CHUNK * CHUNK * 4); p.ml_hh = (float*)take(2 * rg);
    p.gd_q = (float*)take(rg); p.gd_k = (float*)take(rg); p.gd_v = (float*)take(rg);
    p.gd_gc = (float*)take((size_t)GD_CH * TOK * 4); p.gd_beta = (float*)take((size_t)GD_CH * TOK * 4);
    p.gd_A = (float*)take((size_t)GD_CN * CHUNK * CHUNK * 4); p.gd_T = (float*)take((size_t)GD_CN * CHUNK * CHUNK * 4);
    p.gd_Psi = (float*)take((size_t)GD_CN * GD_N * GD_N * 4); p.gd_O0 = (float*)take((size_t)GD_CN * CHUNK * GD_N * 4);
    p.gd_Phi = (u16*)take((size_t)GD_CN * GD_N * GD_N * 2); p.gd_Qh = (u16*)p.gd_A;
    p.gd_o = (float*)take(2 * rg);
    p.at_q = (u16*)take((size_t)BATCH * AT_QH * TOK * AT_HEAD * 2); p.at_k = (u16*)take((size_t)BATCH * AT_KVH * TOK * AT_HEAD * 2); p.at_v = (u16*)take((size_t)BATCH * AT_KVH * TOK * AT_HEAD * 2);
    const size_t end1 = off;
    off = region;
    p.xs = (u16*)take((size_t)NE * NSLOT * D_MODEL * 2); p.hid = (u16*)take((size_t)NE * NSLOT * D_MODEL * 2); p.yexp = (float*)take((size_t)NE * NSLOT * D_MODEL * 4);
    return end1 > off ? end1 : off;
}

#ifndef MK_PER_PHASE
#define MK_PER_PHASE 0
#endif
extern "C" void kernel_launch(void* const* d_in, const int* in_sizes, int n_in, void* d_out, int out_size, void* d_ws, size_t ws_size, hipStream_t stream) {
    static int grid = 0;
    if (grid == 0) {
        Params q{}; const size_t need = ws_carve(q, nullptr);
        if (n_in != 35 || out_size != BATCH * SEQ * D_MODEL || ws_size < need) {
            fprintf(stderr, "kernel_launch: expected 35 inputs, out %d, ws >= %zu; got n_in %d out %d ws %zu\n", BATCH * SEQ * D_MODEL, need, n_in, out_size, ws_size); grid = -1; return; }
        int dev = 0, cus = 0, per_cu = 0;
        if (hipGetDevice(&dev) != hipSuccess || hipDeviceGetAttribute(&cus, hipDeviceAttributeMultiprocessorCount, dev) != hipSuccess) { grid = -1; return; }
        if (hipFuncSetAttribute((const void*)mega, hipFuncAttributeMaxDynamicSharedMemorySize, LDS_BYTES) != hipSuccess) { fprintf(stderr, "kernel_launch: hipFuncSetAttribute failed\n"); grid = -1; return; }
        if (hipOccupancyMaxActiveBlocksPerMultiprocessor(&per_cu, (const void*)mega, 512, LDS_BYTES) != hipSuccess || per_cu < 1)
            fprintf(stderr, "kernel_launch: occupancy query reports %d workgroups per CU\n", per_cu);
        (void)hipGetLastError();
        if (cus < 160) { fprintf(stderr, "kernel_launch: needs >= 160 CUs\n"); grid = -1; return; }
        grid = cus;
    }
    if (grid < 0) return;
    Args a{};
    Params& p = a.p;
    const float** in = (const float**)&p;
    for (int i = 0; i < 35; ++i) in[i] = (const float*)d_in[i];
    p.out = (float*)d_out;
    (void)ws_carve(p, (unsigned char*)d_ws);
    (void)hipMemsetAsync(p.bar, 0, XCD_BAR_WORDS * 4, stream);
#if MK_PER_PHASE
    for (int k = 0; k < NPHASE; ++k) { a.ph_lo = k; a.ph_hi = k + 1; hipLaunchKernelGGL(mega, dim3(grid), dim3(512), LDS_BYTES, stream, a); }
#else
#ifdef MK_PROBE_K
#ifdef MK_PROBE_FLAGS
    a.flags = MK_PROBE_FLAGS;
#endif
    a.ph_lo = 0; a.ph_hi = MK_PROBE_K;
    hipLaunchKernelGGL(mega, dim3(grid), dim3(512), LDS_BYTES, stream, a);
    (void)hipMemsetAsync(p.bar, 0, XCD_BAR_WORDS * 4, stream);
    a.flags = 0;
#endif
    a.ph_lo = 0; a.ph_hi = NPHASE;
    hipLaunchKernelGGL(mega, dim3(grid), dim3(512), LDS_BYTES, stream, a);
#endif
    const hipError_t le = hipPeekAtLastError();
    if (le != hipSuccess) fprintf(stderr, "kernel_launch: launch failed: %s\n", hipGetErrorName(le));
}
```

```cpp
#include <hip/hip_runtime.h>

#ifndef CFG_D_MODEL
#define CFG_D_MODEL 2048
#define CFG_SEQ 4096
#define CFG_GRID_W 64
#define CFG_CTX 256
#define CFG_RW_HEAD 64
#define CFG_RW_DR 64
#define CFG_RW_IR 64
#define CFG_RW_GR 128
#define CFG_ML_HEAD 128
#define CFG_CHUNK 64
#define CFG_GD_HEAD 128
#define CFG_AT_HEAD 128
#define CFG_AT_KVH 2
#define CFG_NE 16
#endif

constexpr int D_MODEL = CFG_D_MODEL, BATCH = 2, SEQ = CFG_SEQ, DEPTH = 2, GRID_W = CFG_GRID_W, CTX = CFG_CTX;
constexpr int TOK = CTX + SEQ, MROWS = BATCH * TOK, GROUP_W = D_MODEL / 4;
constexpr int RW_HEAD = CFG_RW_HEAD, RW_HEADS = GROUP_W / RW_HEAD, RW_DR = CFG_RW_DR, RW_IR = CFG_RW_IR, RW_GR = CFG_RW_GR;
constexpr int RW_COLS = 3 * GROUP_W + RW_DR + RW_IR + RW_GR, RW_LR = RW_DR + RW_IR + RW_GR;
constexpr int ML_HEAD = CFG_ML_HEAD, ML_HEADS = GROUP_W / ML_HEAD, CHUNK = CFG_CHUNK, ML_COLS = 4 * GROUP_W + 4 * ML_HEADS;
constexpr int GD_HEAD = CFG_GD_HEAD, GD_HEADS = GROUP_W / GD_HEAD, GD_COLS = 4 * GROUP_W + 4 * GD_HEADS;
constexpr int AT_HEAD = CFG_AT_HEAD, AT_QH = GROUP_W / AT_HEAD, AT_KVH = CFG_AT_KVH, AT_COLS = (AT_QH + 2 * AT_KVH) * AT_HEAD;
constexpr int N_IN = RW_COLS + ML_COLS + GD_COLS + AT_COLS;
constexpr int RW_OFF = 0, ML_OFF = RW_COLS, GD_OFF = ML_OFF + ML_COLS, AT_OFF = GD_OFF + GD_COLS;
constexpr int LDP = (N_IN + 255) / 256 * 256;
constexpr int NE = CFG_NE, CAPL = 2 * SEQ / NE, CAPC = 2 * CTX / NE;
constexpr int NSLOT_L = BATCH * CAPL, NSLOT_C = BATCH * CAPC;
constexpr int NSLOT = (NSLOT_L + NSLOT_C + 255) / 256 * 256;
constexpr int NCHUNK = TOK / CHUNK, ML_CH = BATCH * ML_HEADS * 2, GD_CH = BATCH * GD_HEADS * 2, RW_CH = BATCH * RW_HEADS * 2;
constexpr float NORM_EPS = 1e-6f, RW_GN_EPS = 64e-5f, RW_DECAY_SCALE = 0.6065306597126334f;
static_assert(ML_HEADS == GD_HEADS, "heads");

typedef unsigned short u16;

#ifdef CPU_TEST
#include <cmath>
#include <cstdint>
#include <cstring>
#define HD inline
#else
#define HD __device__ __forceinline__
#endif

struct Params {
    const float *x, *c, *ctx, *c_ctx, *ada_w, *ada_b, *norm1_g, *norm2_g, *w_in, *w_out;
    const float *rw_mu, *rw_w0, *rw_w_up, *rw_a0, *rw_a_up, *rw_g_up, *rw_k_k, *rw_k_a, *rw_r_k, *rw_ln_w, *rw_ln_b;
    const float *ml_ib, *ml_fb, *ml_norm_g, *gd_conv, *gd_a_log, *gd_dt_bias, *gd_norm_g, *at_q_norm, *at_k_norm;
    const float *w_router, *w_exp1, *w_exp3, *w_exp2, *final_g;
    float* out;
    unsigned* bar;
    float *modp, *mod;
    u16 *wt_in, *wt_out, *w13t, *w2t;
    float* xres;
    u16* h;
    float* P;
    float *rw_r, *rw_k, *rw_v, *rw_lr, *rw_kk, *rw_g, *rw_ew, *rw_kka, *rw_kt, *rw_y;
    float *rw_Ma, *rw_T, *rw_Psi, *rw_Y0; u16 *rw_PhiT, *rw_Rh, *rw_W;
    float *ml_bcum, *ml_g, *ml_gmax, *ml_bl, *ml_gm, *ml_min, *ml_dcv, *ml_dC, *ml_dn, *ml_S, *ml_hh;
    float *gd_q, *gd_k, *gd_v, *gd_gc, *gd_beta, *gd_A, *gd_T, *gd_Psi, *gd_O0, *gd_o; u16 *gd_Phi, *gd_Qh;
    u16 *at_q, *at_k, *at_v;
    u16* mix;
    float* aff; int* inv;
    int* sel_row; float* sel_gate;
    u16 *xs, *hid; float* yexp;
};

struct Exec { int gid, ngroups, gl; };

template <int G> HD float group_sum(float v) {
#ifndef CPU_TEST
#pragma unroll
    for (int o = G / 2; o > 0; o >>= 1) v += __shfl_xor(v, o, 64);
#endif
    return v;
}
template <int G> HD float group_max(float v) {
#ifndef CPU_TEST
#pragma unroll
    for (int o = G / 2; o > 0; o >>= 1) v = fmaxf(v, __shfl_xor(v, o, 64));
#endif
    return v;
}

template <int G> HD float group_scan_sum(float v, int gl) {
#ifndef CPU_TEST
#pragma unroll
    for (int o = 1; o < G; o <<= 1) { const float t = __shfl_up(v, o, G); if (gl >= o) v += t; }
#endif
    (void)gl; return v;
}
template <int G> HD float group_scan_max(float v, int gl) {
#ifndef CPU_TEST
#pragma unroll
    for (int o = 1; o < G; o <<= 1) { const float t = __shfl_up(v, o, G); if (gl >= o) v = fmaxf(v, t); }
#endif
    (void)gl; return v;
}
template <int G> HD float group_last(float v) {
#ifndef CPU_TEST
    v = __shfl(v, G - 1, G);
#endif
    return v;
}

HD u16 f2bf(float f) { unsigned u; memcpy(&u, &f, 4); u += 0x7FFFu + ((u >> 16) & 1u); return (u16)(u >> 16); }
HD float bf2f(u16 b) { unsigned u = ((unsigned)b) << 16; float f; memcpy(&f, &u, 4); return f; }
HD float sigmoidf_(float x) { return 1.f / (1.f + expf(-x)); }
HD float siluf_(float x) { return x / (1.f + expf(-x)); }
HD float softplusf_(float x) { return x > 20.f ? x : log1pf(expf(x)); }
HD float logsigmoidf_(float x) { return x < 0.f ? x - log1pf(expf(x)) : -log1pf(expf(-x)); }

HD float bf_round(float f) { return bf2f(f2bf(f)); }
#ifndef CPU_TEST
typedef short mma_bf16x8 __attribute__((ext_vector_type(8)));
typedef float mma_f32x16 __attribute__((ext_vector_type(16)));
__device__ __forceinline__ unsigned mma_cvt_pk(float lo, float hi) { unsigned r; asm volatile("v_cvt_pk_bf16_f32 %0, %1, %2" : "=v"(r) : "v"(lo), "v"(hi)); return r; }
#endif
struct Frag {
#ifdef CPU_TEST
    float v[8];
    HD void ld_bf(const u16* p) { for (int j = 0; j < 8; ++j) v[j] = bf2f(p[j]); }
    HD void ld_f(const float* p) { for (int j = 0; j < 8; ++j) v[j] = bf_round(p[j]); }
    HD void ld_f_scaled(const float* p, float w) { for (int j = 0; j < 8; ++j) v[j] = bf_round(p[j] * w); }
    HD void set1(float x) { for (int j = 0; j < 8; ++j) v[j] = bf_round(x); }
    HD void neg() { for (int j = 0; j < 8; ++j) v[j] = -v[j]; }
#else
    typedef unsigned u4 __attribute__((ext_vector_type(4)));
    typedef float f4 __attribute__((ext_vector_type(4)));
    u4 raw;
    HD void ld_bf(const u16* p) { raw = *(const u4*)p; }
    HD void ld_f(const float* p) { const f4 a = *(const f4*)p, b = *(const f4*)(p + 4);
        raw.x = mma_cvt_pk(a.x, a.y); raw.y = mma_cvt_pk(a.z, a.w); raw.z = mma_cvt_pk(b.x, b.y); raw.w = mma_cvt_pk(b.z, b.w); }
    HD void ld_f_scaled(const float* p, float w) { const f4 a = *(const f4*)p * w, b = *(const f4*)(p + 4) * w;
        raw.x = mma_cvt_pk(a.x, a.y); raw.y = mma_cvt_pk(a.z, a.w); raw.z = mma_cvt_pk(b.x, b.y); raw.w = mma_cvt_pk(b.z, b.w); }
    HD void set1(float x) { const unsigned q = mma_cvt_pk(x, x); raw.x = q; raw.y = q; raw.z = q; raw.w = q; }
    HD void neg() { raw.x ^= 0x80008000u; raw.y ^= 0x80008000u; raw.z ^= 0x80008000u; raw.w ^= 0x80008000u; }
#endif
};
#ifdef CPU_TEST
constexpr int MMA_SLOTS = 1024;
#else
constexpr int MMA_SLOTS = 16;
#endif
template <int K, class FA, class FB, class FE> HD void wave_mma32(int lane, FA fa, FB fb, FE fe) {
    static_assert(K % 16 == 0, "K");
#ifdef CPU_TEST
    (void)lane;
    for (int m = 0; m < 32; ++m) for (int n = 0; n < 32; ++n) { float acc = 0.f;
        for (int k0 = 0; k0 < K; k0 += 8) { Frag a8, b8; fa(m, k0, a8); fb(n, k0, b8);
            for (int j = 0; j < 8; ++j) acc += a8.v[j] * b8.v[j]; }
        fe(m, n, acc, m * 32 + n); }
#else
    const int r = lane & 31, h = lane >> 5;
    mma_f32x16 acc;
#pragma unroll
    for (int q = 0; q < 16; ++q) acc[q] = 0.f;
#pragma unroll
    for (int k0 = 0; k0 < K; k0 += 16) { Frag a8, b8; fa(r, k0 + 8 * h, a8); fb(r, k0 + 8 * h, b8);
        acc = __builtin_amdgcn_mfma_f32_32x32x16_bf16(__builtin_bit_cast(mma_bf16x8, a8.raw), __builtin_bit_cast(mma_bf16x8, b8.raw), acc, 0, 0, 0); }
#pragma unroll
    for (int q = 0; q < 16; ++q) fe((q & 3) + 8 * (q >> 2) + 4 * h, r, acc[q], q);
#endif
}

#ifndef CPU_TEST
typedef unsigned pfv4 __attribute__((ext_vector_type(4)));
template <int NQ> HD void pf_ld_lin(pfv4 (&r)[NQ], const void* src, int tid) {
#pragma unroll
    for (int q = 0; q < NQ; ++q) r[q] = ((const pfv4*)src)[tid + q * 512]; }
template <int NQ> HD void pf_ld_rows(pfv4 (&r)[NQ], const float* src, int per_row, int row_stride, int tid) {
#pragma unroll
    for (int q = 0; q < NQ; ++q) { const int i = tid + q * 512; r[q] = *(const pfv4*)(src + (size_t)(i / per_row) * row_stride + (i % per_row) * 4); } }
template <int NQ> HD void pf_st_lin(const pfv4 (&r)[NQ], void* dst, int tid) {
#pragma unroll
    for (int q = 0; q < NQ; ++q) ((pfv4*)dst)[tid + q * 512] = r[q]; }
template <int NQ> HD void pf_st_pad(const pfv4 (&r)[NQ], u16* dst, int per_row, int ld, int tid) {
#pragma unroll
    for (int q = 0; q < NQ; ++q) { const int i = tid + q * 512; *(pfv4*)(dst + (i / per_row) * ld + (i % per_row) * 8) = r[q]; } }
#endif
#ifdef CPU_TEST
#define BLOCK_SYNC()
#define BLOCK_FOR(i, n) for (int i = 0; i < (n); ++i)
#define WAVE_FOR(w, n) for (int w = 0; w < (n); ++w)
#define LANE 0
#define OPAQUE_TID()
#define OPAQUE_I(x)
#else
#define BLOCK_SYNC() __syncthreads()
#define BLOCK_FOR(i, n) for (int i = tid; i < (n); i += nthr)
#define WAVE_FOR(w, n) _Pragma("unroll 1") for (int w = tid >> 6; w < (n); w += (nthr >> 6))
#define LANE (tid & 63)
#define OPAQUE_I(x) asm volatile("" : "+v"(x))
#define OPAQUE_TID() asm volatile("" : "+v"(tid))
#endif

HD int row_b(int R) { return R / TOK; }
HD int row_s(int R) { return R % TOK; }
HD bool row_ctx(int R) { return row_s(R) < CTX; }
HD int mod_sel(int R) { return row_ctx(R) ? 2 : row_b(R); }
HD int seq_s(int d, int p) { return d == 0 ? p : (p < CTX ? CTX - 1 - p : TOK - 1 - (p - CTX)); }
HD const float* modv(const Params& p, int layer, int sel, int k) { return p.mod + ((size_t)(layer * 3 + sel) * 6 + k) * D_MODEL; }

#ifdef CPU_TEST
struct alignas(16) F4 { float x, y, z, w; };
HD F4 operator+(F4 a, F4 b) { return F4{a.x + b.x, a.y + b.y, a.z + b.z, a.w + b.w}; }
HD F4 operator-(F4 a, F4 b) { return F4{a.x - b.x, a.y - b.y, a.z - b.z, a.w - b.w}; }
HD F4 operator*(F4 a, F4 b) { return F4{a.x * b.x, a.y * b.y, a.z * b.z, a.w * b.w}; }
HD F4 operator*(F4 a, float s) { return F4{a.x * s, a.y * s, a.z * s, a.w * s}; }
HD F4 operator+(F4 a, float s) { return F4{a.x + s, a.y + s, a.z + s, a.w + s}; }
#else
typedef float F4 __attribute__((ext_vector_type(4)));
#endif
struct alignas(8) H4 { u16 x, y, z, w; };
HD F4 ld4(const float* p) { return *(const F4*)p; }
HD void st4(float* p, F4 v) { *(F4*)p = v; }
HD float hsum(F4 a) { return (a.x + a.y) + (a.z + a.w); }
HD void st4bf(u16* p, F4 v) { *(H4*)p = H4{f2bf(v.x), f2bf(v.y), f2bf(v.z), f2bf(v.w)}; }

constexpr int MOD_KS = 16;
HD void ph_mod_partial(const Params& p, Exec e) {
    const int n = DEPTH * MOD_KS * 6 * D_MODEL;
    for (int it = e.gid; it < n; it += e.ngroups) {
        const int col = it % (6 * D_MODEL), ks = (it / (6 * D_MODEL)) % MOD_KS, l = it / (6 * D_MODEL * MOD_KS);
        const float* w = p.ada_w + (size_t)l * D_MODEL * 6 * D_MODEL + col;
        float a0 = 0.f, a1 = 0.f, a2 = 0.f;
        const int k0 = ks * (D_MODEL / MOD_KS);
        for (int k = k0; k < k0 + D_MODEL / MOD_KS; ++k) {
            const float wv = w[(size_t)k * 6 * D_MODEL];
            a0 += siluf_(p.c[k]) * wv; a1 += siluf_(p.c[D_MODEL + k]) * wv; a2 += siluf_(p.c_ctx[k]) * wv;
        }
        float* o = p.modp + ((size_t)(l * MOD_KS + ks) * 3) * 6 * D_MODEL + col;
        o[0] = a0; o[6 * D_MODEL] = a1; o[2 * 6 * D_MODEL] = a2;
    }
}
HD void ph_mod_final(const Params& p, Exec e) {
    const int n = DEPTH * 3 * 6 * D_MODEL;
    for (int it = e.gid; it < n; it += e.ngroups) {
        const int col = it % (6 * D_MODEL), sel = (it / (6 * D_MODEL)) % 3, l = it / (6 * D_MODEL * 3);
        float a = p.ada_b[l * 6 * D_MODEL + col];
        for (int ks = 0; ks < MOD_KS; ++ks) a += p.modp[((size_t)(l * MOD_KS + ks) * 3 + sel) * 6 * D_MODEL + col];
        p.mod[(size_t)(l * 3 + sel) * 6 * D_MODEL + col] = a;
    }
}

template <int G, int NI> HD void resid_row(const Params& p, int layer, int R, int gl, F4 (&v)[NI]) {
    if (layer == 0) { const int b = row_b(R), sx = row_s(R);
        const float* src = sx < CTX ? p.ctx + ((size_t)b * CTX + sx) * D_MODEL : p.x + ((size_t)b * SEQ + (sx - CTX)) * D_MODEL;
#pragma unroll
        for (int i = 0; i < NI; ++i) v[i] = ld4(src + (gl + G * i) * 4);
        return; }
    F4 acc[NI];
#pragma unroll
    for (int i = 0; i < NI; ++i) acc[i] = F4{0.f, 0.f, 0.f, 0.f};
    for (int ex = 0; ex < NE; ++ex) { const int j = p.inv[(size_t)R * NE + ex];
        if (j >= 0) { const float* y = p.yexp + ((size_t)ex * NSLOT + j) * D_MODEL;
#pragma unroll
            for (int i = 0; i < NI; ++i) acc[i] = acc[i] + ld4(y + (gl + G * i) * 4); } }
    const float* m5 = modv(p, layer - 1, mod_sel(R), 5);
#pragma unroll
    for (int i = 0; i < NI; ++i) { const int c4 = (gl + G * i) * 4; v[i] = ld4(p.xres + (size_t)R * D_MODEL + c4) + ld4(m5 + c4) * acc[i]; }
}
template <int G> HD void ph_norm1(const Params& p, int layer, Exec e) {
    constexpr int NI = D_MODEL / 4 / G;
    for (int R = e.gid; R < MROWS; R += e.ngroups) {
        int gl = e.gl; OPAQUE_I(gl);
        F4 v[NI]; resid_row<G, NI>(p, layer, R, gl, v);
        float ss = 0.f;
#pragma unroll
        for (int i = 0; i < NI; ++i) ss += hsum(v[i] * v[i]);
        ss = group_sum<G>(ss);
        const float rstd = 1.f / sqrtf(ss / D_MODEL + NORM_EPS);
        const int sel = mod_sel(R); const float *m0 = modv(p, layer, sel, 0), *m1 = modv(p, layer, sel, 1), *g = p.norm1_g + layer * D_MODEL;
#pragma unroll
        for (int i = 0; i < NI; ++i) { const int c4 = (gl + G * i) * 4; st4(p.xres + (size_t)R * D_MODEL + c4, v[i]);
            st4bf(p.h + (size_t)R * D_MODEL + c4, v[i] * rstd * ld4(g + c4) * (ld4(m1 + c4) + 1.f) + ld4(m0 + c4)); }
    }
}
template <int G> HD void ph_final(const Params& p, Exec e) {
    constexpr int NI = D_MODEL / 4 / G;
    for (int it = e.gid; it < BATCH * SEQ; it += e.ngroups) {
        const int b = it / SEQ, t = it % SEQ, R = b * TOK + CTX + t;
        int gl = e.gl; OPAQUE_I(gl);
        F4 v[NI]; resid_row<G, NI>(p, DEPTH, R, gl, v);
        float ss = 0.f;
#pragma unroll
        for (int i = 0; i < NI; ++i) ss += hsum(v[i] * v[i]);
        ss = group_sum<G>(ss);
        const float rstd = 1.f / sqrtf(ss / D_MODEL + NORM_EPS);
#pragma unroll
        for (int i = 0; i < NI; ++i) { const int c4 = (gl + G * i) * 4; st4(p.out + (size_t)it * D_MODEL + c4, v[i] * rstd * ld4(p.final_g + c4)); }
    }
}
template <int G> HD void ph_norm2(const Params& p, int layer, Exec e) {
    constexpr int NI = D_MODEL / 4 / G;
    static_assert(NE % 4 == 0, "router");
    const bool last = layer == DEPTH - 1;
    for (int R = e.gid; R < MROWS; R += e.ngroups) {
        if (last && row_ctx(R)) continue;
        int gl = e.gl; OPAQUE_I(gl);
        F4 v[NI]; float ss = 0.f;
#pragma unroll
        for (int i = 0; i < NI; ++i) { v[i] = ld4(p.xres + (size_t)R * D_MODEL + (gl + G * i) * 4); ss += hsum(v[i] * v[i]); }
        ss = group_sum<G>(ss);
        const float rstd = 1.f / sqrtf(ss / D_MODEL + NORM_EPS);
        const int sel = mod_sel(R); const float *m3 = modv(p, layer, sel, 3), *m4 = modv(p, layer, sel, 4), *g = p.norm2_g + layer * D_MODEL;
        const float* wr = p.w_router + (size_t)layer * D_MODEL * NE;
        F4 lg[NE / 4];
#pragma unroll
        for (int q = 0; q < NE / 4; ++q) lg[q] = F4{0.f, 0.f, 0.f, 0.f};
#pragma unroll
        for (int i = 0; i < NI; ++i) { const int c4 = (gl + G * i) * 4;
            const F4 hv = v[i] * rstd * ld4(g + c4) * (ld4(m4 + c4) + 1.f) + ld4(m3 + c4);
            st4bf(p.h + (size_t)R * D_MODEL + c4, hv);
#pragma unroll
            for (int q = 0; q < NE / 4; ++q) lg[q] = lg[q] + ld4(wr + (size_t)(c4 + 0) * NE + 4 * q) * hv.x + ld4(wr + (size_t)(c4 + 1) * NE + 4 * q) * hv.y
                                                            + ld4(wr + (size_t)(c4 + 2) * NE + 4 * q) * hv.z + ld4(wr + (size_t)(c4 + 3) * NE + 4 * q) * hv.w; }
        float l1[NE]; float mx = -1e30f;
#pragma unroll
        for (int q = 0; q < NE / 4; ++q) { l1[4 * q] = group_sum<G>(lg[q].x); l1[4 * q + 1] = group_sum<G>(lg[q].y); l1[4 * q + 2] = group_sum<G>(lg[q].z); l1[4 * q + 3] = group_sum<G>(lg[q].w); }
#pragma unroll
        for (int ex = 0; ex < NE; ++ex) mx = fmaxf(mx, l1[ex]);
        float sum = 0.f;
#pragma unroll
        for (int ex = 0; ex < NE; ++ex) { l1[ex] = expf(l1[ex] - mx); sum += l1[ex]; }
        if (gl == 0) {
#pragma unroll
            for (int ex = 0; ex < NE; ++ex) p.aff[(size_t)R * NE + ex] = l1[ex] / sum; }
    }
}
constexpr int TK_PART = 512, TK_PARTS = (SEQ + TK_PART - 1) / TK_PART, TK_SMEM = (SEQ > CTX ? SEQ : CTX) * 4;
HD int topk_units(int layer) { return BATCH * NE * TK_PARTS + (layer == DEPTH - 1 ? 0 : BATCH * NE) + 1; }
HD void ph_topk_unit(const Params& p, int layer, int unit, int tid, int nthr, unsigned char* smem) {
    (void)tid; (void)nthr; OPAQUE_TID();
    const bool last = layer == DEPTH - 1;
    const int nl = BATCH * NE * TK_PARTS, nc = last ? 0 : BATCH * NE;
    float* col = (float*)smem;
    if (unit >= nl + nc) {
        const int per = NSLOT - NSLOT_L - (last ? 0 : NSLOT_C);
        BLOCK_FOR(q, NE * per) { const int ex = q / per, j = NSLOT - per + q % per; p.sel_row[ex * NSLOT + j] = 0; p.sel_gate[ex * NSLOT + j] = 0.f; }
        return; }
    int b, ex, L, base, cap, jbase, t0, t1;
    if (unit < nl) { const int part = unit % TK_PARTS; ex = (unit / TK_PARTS) % NE; b = unit / (TK_PARTS * NE); L = SEQ; base = b * TOK + CTX; cap = CAPL; jbase = b * CAPL;
        t0 = part * TK_PART; t1 = t0 + TK_PART < SEQ ? t0 + TK_PART : SEQ; }
    else { const int q = unit - nl; ex = q % NE; b = q / NE; L = CTX; base = b * TOK; cap = CAPC; jbase = NSLOT_L + b * CAPC; t0 = 0; t1 = CTX; }
    BLOCK_FOR(u, L) col[u] = p.aff[(size_t)(base + u) * NE + ex];
    BLOCK_SYNC();
    BLOCK_FOR(q, t1 - t0) { const int t = t0 + q; const float a = col[t]; int rank = 0;
        for (int u = 0; u < L; ++u) { const float au = col[u]; rank += (au > a || (au == a && u < t)) ? 1 : 0; }
        if (rank < cap) { const int j = jbase + rank; p.sel_row[ex * NSLOT + j] = base + t; p.sel_gate[ex * NSLOT + j] = a; p.inv[(size_t)(base + t) * NE + ex] = j; }
        else p.inv[(size_t)(base + t) * NE + ex] = -1; }
    BLOCK_SYNC();
}
template <int G> HD void ph_gather(const Params& p, int layer, Exec e) {
    const bool last = layer == DEPTH - 1;
    const int nj = last ? NSLOT_L : NSLOT;
    for (int it = e.gid; it < NE * nj; it += e.ngroups) {
        const int ex = it / nj, j = it % nj, R = p.sel_row[ex * NSLOT + j];
        const uint4* s = (const uint4*)(p.h + (size_t)R * D_MODEL); uint4* d = (uint4*)(p.xs + ((size_t)ex * NSLOT + j) * D_MODEL);
        for (int c = e.gl; c < D_MODEL / 8; c += G) d[c] = s[c];
    }
}

template <int G> HD void ph_rw_prep1(const Params& p, int layer, Exec e) {
    constexpr int NI = RW_COLS / 4 / G;
    static_assert(NI * 4 * G == RW_COLS && GROUP_W % 4 == 0 && RW_DR % 4 == 0 && RW_IR % 4 == 0, "layout");
    const float* mu = p.rw_mu + (size_t)layer * 2 * RW_COLS; const float* kk_w = p.rw_k_k + layer * GROUP_W;
    for (int R = e.gid; R < MROWS; R += e.ngroups) {
        int gl = e.gl; OPAQUE_I(gl);
        const int sx = row_s(R); const bool hp = (sx != 0 && sx != CTX), hn = (sx != CTX - 1 && sx != TOK - 1);
        const float* pr = p.P + (size_t)R * LDP + RW_OFF;
#pragma unroll
        for (int i = 0; i < NI; ++i) { const int c = (gl + G * i) * 4;
            const F4 v = ld4(pr + c), pv = hp ? ld4(pr + c - LDP) : F4{0.f, 0.f, 0.f, 0.f}, nv = hn ? ld4(pr + c + LDP) : F4{0.f, 0.f, 0.f, 0.f};
            const F4 pp = v + ld4(mu + c) * (pv - v) + ld4(mu + RW_COLS + c) * (nv - v);
            if (c < GROUP_W) st4(p.rw_r + (size_t)R * GROUP_W + c, pp);
            else if (c < 2 * GROUP_W) { const int ck = c - GROUP_W; st4(p.rw_k + (size_t)R * GROUP_W + ck, pp);
                if (G != 1) {
                    const F4 xk = pp * ld4(kk_w + ck); const float ss = group_sum<(G == 1 ? 1 : RW_HEAD / 4)>(hsum(xk * xk));
                    st4(p.rw_kk + (size_t)R * GROUP_W + ck, xk * (1.f / sqrtf(ss + 1e-6f))); } }
            else if (c < 3 * GROUP_W) st4(p.rw_v + (size_t)R * GROUP_W + c - 2 * GROUP_W, pp);
            else { const int q = c - 3 * GROUP_W; F4 o;
                if (q < RW_DR) o = F4{tanhf(pp.x), tanhf(pp.y), tanhf(pp.z), tanhf(pp.w)}; else if (q < RW_DR + RW_IR) o = pp;
                else o = F4{sigmoidf_(pp.x), sigmoidf_(pp.y), sigmoidf_(pp.z), sigmoidf_(pp.w)};
                st4(p.rw_lr + (size_t)R * RW_LR + q, o); }
        }
        if (G == 1) {
            for (int hh = 0; hh < RW_HEADS; ++hh) { float ss = 0.f;
                for (int j = hh * RW_HEAD; j < (hh + 1) * RW_HEAD; ++j) { const float xk = p.rw_k[(size_t)R * GROUP_W + j] * kk_w[j]; ss += xk * xk; }
                const float rn = 1.f / sqrtf(ss + 1e-6f);
                for (int j = hh * RW_HEAD; j < (hh + 1) * RW_HEAD; ++j) p.rw_kk[(size_t)R * GROUP_W + j] = p.rw_k[(size_t)R * GROUP_W + j] * kk_w[j] * rn; } }
    }
}
constexpr int RW_WK = 2 * RW_DR + 2 * RW_IR + RW_GR;
static_assert(RW_DR % 16 == 0 && RW_IR % 16 == 0 && RW_GR % 16 == 0, "low-rank K");
HD void ph_rw_wpack(const Params& p, Exec e) {
    for (int it = e.gid; it < DEPTH * GROUP_W * RW_WK; it += e.ngroups) {
        const int kk = it % RW_WK, j = (it / RW_WK) % GROUP_W, l = it / (RW_WK * GROUP_W); float v;
        if (kk < 2 * RW_DR) { const int d = kk / RW_DR, i = kk % RW_DR; v = p.rw_w_up[((size_t)(l * 2 + d) * RW_DR + i) * GROUP_W + j]; }
        else if (kk < 2 * RW_DR + 2 * RW_IR) { const int q = kk - 2 * RW_DR, d = q / RW_IR, i = q % RW_IR; v = p.rw_a_up[((size_t)(l * 2 + d) * RW_IR + i) * GROUP_W + j]; }
        else { const int i = kk - 2 * RW_DR - 2 * RW_IR; v = p.rw_g_up[((size_t)l * RW_GR + i) * GROUP_W + j]; }
        p.rw_W[it] = f2bf(v);
    }
}
HD void ph_rw_prep2(const Params& p, int layer, Exec e) {
    static_assert(MROWS % 32 == 0 && GROUP_W % 32 == 0, "tiles");
    const float* ka_w = p.rw_k_a + layer * GROUP_W;
    for (int it = e.gid; it < (MROWS / 32) * (GROUP_W / 32); it += e.ngroups) {
        const int tm = it / (GROUP_W / 32), tn = it % (GROUP_W / 32);
        const u16* W = p.rw_W + ((size_t)layer * GROUP_W + tn * 32) * RW_WK; const float* A = p.rw_lr + (size_t)tm * 32 * RW_LR;
        float st[4][MMA_SLOTS];
#define RWP2_PROD(K_, AOFF, WOFF, ...) wave_mma32<K_>(e.gl, [&](int m, int k0, Frag& o) { o.ld_f(A + (size_t)m * RW_LR + (AOFF) + k0); }, \
                                                       [&](int nn, int k0, Frag& o) { o.ld_bf(W + (size_t)nn * RW_WK + (WOFF) + k0); }, __VA_ARGS__)
        RWP2_PROD(RW_DR, 0, 0, [&](int, int, float acc, int sl) { st[0][sl] = acc; });
        RWP2_PROD(RW_DR, 0, RW_DR, [&](int, int, float acc, int sl) { st[1][sl] = acc; });
        RWP2_PROD(RW_IR, RW_DR, 2 * RW_DR, [&](int, int, float acc, int sl) { st[2][sl] = acc; });
        RWP2_PROD(RW_IR, RW_DR, 2 * RW_DR + RW_IR, [&](int, int, float acc, int sl) { st[3][sl] = acc; });
        RWP2_PROD(RW_GR, RW_DR + RW_IR, 2 * RW_DR + 2 * RW_IR, [&](int m, int nn, float acc, int sl) {
            const int R = tm * 32 + m, j = tn * 32 + nn; const size_t o = (size_t)R * GROUP_W + j;
            p.rw_g[o] = acc;
            const float kv = p.rw_k[o], kkv = p.rw_kk[o];
            _Pragma("unroll") for (int d = 0; d < 2; ++d) { const float wl = p.rw_w0[(layer * 2 + d) * GROUP_W + j] + st[d][sl], al = p.rw_a0[(layer * 2 + d) * GROUP_W + j] + st[2 + d][sl];
                const float logw = -RW_DECAY_SCALE * sigmoidf_(wl), a = sigmoidf_(al); const size_t o2 = (size_t)d * MROWS * GROUP_W + o;
                p.rw_ew[o2] = logw; p.rw_kka[o2] = kkv * a; p.rw_kt[o2] = kv * (1.f + (a - 1.f) * ka_w[j]); } });
#undef RWP2_PROD
    }
}
template <int G> HD void ph_rw_scan(const Params& p, Exec e) {
    constexpr int KPL = RW_HEAD / G;
    for (int it = e.gid; it < RW_CH * RW_HEAD; it += e.ngroups) {
        const int i = it % RW_HEAD, ch = it / RW_HEAD, d = ch % 2, hh = (ch / 2) % RW_HEADS, b = ch / (2 * RW_HEADS);
        float S[KPL];
#pragma unroll
        for (int q = 0; q < KPL; ++q) S[q] = 0.f;
        const int k0 = hh * RW_HEAD + e.gl * KPL;
        for (int pos = 0; pos < TOK; ++pos) {
            const int R = b * TOK + seq_s(d, pos);
            const size_t o1 = (size_t)R * GROUP_W + k0, o2 = ((size_t)d * MROWS + R) * GROUP_W + k0;
            const float vv = p.rw_v[(size_t)R * GROUP_W + hh * RW_HEAD + i];
            float sk = 0.f;
#pragma unroll
            for (int q = 0; q < KPL; ++q) sk += S[q] * p.rw_kk[o1 + q];
            sk = group_sum<G>(sk);
            float y = 0.f;
#pragma unroll
            for (int q = 0; q < KPL; ++q) { S[q] = S[q] * p.rw_ew[o2 + q] - sk * p.rw_kka[o2 + q] + vv * p.rw_kt[o2 + q]; y += S[q] * p.rw_r[o1 + q]; }
            y = group_sum<G>(y);
            if (e.gl == 0) p.rw_y[((size_t)d * MROWS + R) * GROUP_W + hh * RW_HEAD + i] = y;
        }
    }
}

constexpr int RW_N = RW_HEAD, RW_CN = RW_CH * NCHUNK;
constexpr int LDPAD = 8;
static_assert(CHUNK % 32 == 0 && RW_HEAD % 32 == 0, "tile sizes");
HD void rw_chain(int ch, int& b, int& hh, int& d) { d = ch % 2; hh = (ch / 2) % RW_HEADS; b = ch / (2 * RW_HEADS); }
constexpr int RW_C1_SMEM = CHUNK * RW_N * 4 + 2 * CHUNK * (RW_N + LDPAD) * 2;
HD void ph_rw_c1_unit(const Params& p, int cn, int tid, int nthr, unsigned char* smem) {
    (void)tid; (void)nthr; OPAQUE_TID();
    constexpr int C = CHUNK, N = RW_N, LD = N + LDPAD;
    const int ch = cn / NCHUNK, n = cn % NCHUNK; int b, hh, d; rw_chain(ch, b, hh, d);
    float* cum = (float*)smem; u16* KKt = (u16*)(cum + C * N); u16* At = KKt + C * LD;
    const size_t dofs = (size_t)d * MROWS * GROUP_W;
    BLOCK_FOR(idx, C * N) { const int t = idx / N, k = idx % N, R = b * TOK + seq_s(d, n * C + t); cum[idx] = p.rw_ew[dofs + (size_t)R * GROUP_W + hh * N + k]; }
    BLOCK_SYNC();
    BLOCK_FOR(k, N) { float acc = 0.f; for (int t = 0; t < C; ++t) { acc += cum[t * N + k]; cum[t * N + k] = acc; } }
    BLOCK_SYNC();
    BLOCK_FOR(idx, C * N) { const int t = idx / N, k = idx % N, R = b * TOK + seq_s(d, n * C + t); const size_t o = (size_t)R * GROUP_W + hh * N + k;
        const float cu = cum[idx], cp = cu - p.rw_ew[dofs + o];
        KKt[t * LD + k] = f2bf(p.rw_kk[o] * expf(cp)); At[t * LD + k] = f2bf(p.rw_kka[dofs + o] * expf(-cu)); }
    BLOCK_SYNC();
    float* Ma = p.rw_Ma + (size_t)cn * C * C;
    WAVE_FOR(w, (C / 32) * (C / 32)) { const int tm = w / (C / 32), tn = w % (C / 32);
        wave_mma32<N>(LANE, [&](int m, int k0, Frag& o) { o.ld_bf(KKt + (tm * 32 + m) * LD + k0); },
                            [&](int nn, int k0, Frag& o) { o.ld_bf(At + (tn * 32 + nn) * LD + k0); },
                            [&](int m, int nn, float acc, int) { const int t = tm * 32 + m, sx = tn * 32 + nn; Ma[t * C + sx] = sx < t ? acc : 0.f; }); }
    BLOCK_SYNC();
}
constexpr int TS_G = 8, TS_SMEM = TS_G * CHUNK * CHUNK * 4;
HD void ph_tsolve_unit(const float* Mall, float* Tall, int nprob, int unit, int tid, int nthr, unsigned char* smem) {
    (void)tid; (void)nthr; OPAQUE_TID();
    constexpr int C = CHUNK;
    float* Tl = (float*)smem;
    const int p0 = unit * TS_G, np = (nprob - p0) < TS_G ? (nprob - p0) : TS_G;
    BLOCK_FOR(i, np * C * C / 4) ((uint4*)Tl)[i] = ((const uint4*)(Mall + (size_t)p0 * C * C))[i];
    BLOCK_SYNC();
    BLOCK_FOR(idx, TS_G * C) { const int w = idx / C, j = idx % C;
        if (w < np) { float* Tc = Tl + w * C * C;
            for (int t = 0; t < C; ++t) { float acc = 0.f;
                if (t == j) acc = 1.f;
                else if (t > j) { for (int sx = j; sx < t; ++sx) acc -= Tc[t * C + sx] * Tc[sx * C + j]; }
                Tc[t * C + j] = acc; } } }
    BLOCK_SYNC();
    BLOCK_FOR(i, np * C * C / 4) ((uint4*)(Tall + (size_t)p0 * C * C))[i] = ((const uint4*)Tl)[i];
    BLOCK_SYNC();
}
constexpr int RW_C3_SMEM = 2 * CHUNK * (RW_N + LDPAD) * 2 + 13 * CHUNK * (RW_N + LDPAD) * 2 + RW_N * 4;
HD void ph_rw_c3_unit(const Params& p, int cn, int tid, int nthr, unsigned char* smem) {
    (void)tid; (void)nthr; OPAQUE_TID();
    constexpr int C = CHUNK, N = RW_N, CN = C * N, LD = N + LDPAD, CL = C * LD;
    static_assert(2 * CL * 2 >= CN * 4, "cum region");
    static_assert(C == N, "c3 buffer aliasing assumes C == N");
    const int ch = cn / NCHUNK, n = cn % NCHUNK; int b, hh, d; rw_chain(ch, b, hh, d);
    float* cum = (float*)smem; u16* mb = (u16*)smem + 2 * CL;
    u16 *KKt = mb, *KKtT = mb + CL, *At = mb + 2 * CL, *KTt = mb + 3 * CL, *Rt = mb + 4 * CL, *ApT = mb + 5 * CL, *KTpT = mb + 6 * CL, *VT = mb + 7 * CL,
        *Tb = mb + 8 * CL, *MkT = mb + 9 * CL, *ZT = mb + 10 * CL, *Na = mb + 11 * CL, *Nk = mb + 12 * CL;
    float* PC = (float*)(mb + 13 * CL);
    u16 *Gm = (u16*)cum, *KKhT = (u16*)cum + CL;
    const size_t dofs = (size_t)d * MROWS * GROUP_W;
    BLOCK_FOR(idx, C * N) { const int t = idx / N, k = idx % N, R = b * TOK + seq_s(d, n * C + t); cum[idx] = p.rw_ew[dofs + (size_t)R * GROUP_W + hh * N + k]; }
    BLOCK_SYNC();
    BLOCK_FOR(k, N) { float acc = 0.f; for (int t = 0; t < C; ++t) { acc += cum[t * N + k]; cum[t * N + k] = acc; } PC[k] = expf(acc); }
    BLOCK_SYNC();
    BLOCK_FOR(idx, CN) { const int t = idx / N, k = idx % N, R = b * TOK + seq_s(d, n * C + t); const size_t o = (size_t)R * GROUP_W + hh * N + k;
        const float cu = cum[idx], cp = cu - p.rw_ew[dofs + o], cC = cum[(C - 1) * N + k];
        const float kkv = p.rw_kk[o], kav = p.rw_kka[dofs + o], ktv = p.rw_kt[dofs + o];
        const float e_m = expf(-cu), e_c = expf(cC - cu);
        const u16 kkt = f2bf(kkv * expf(cp));
        KKt[t * LD + k] = kkt; KKtT[k * LD + t] = kkt; At[t * LD + k] = f2bf(kav * e_m); KTt[t * LD + k] = f2bf(ktv * e_m); Rt[t * LD + k] = f2bf(p.rw_r[o] * expf(cu));
        ApT[k * LD + t] = f2bf(kav * e_c); KTpT[k * LD + t] = f2bf(ktv * e_c); VT[k * LD + t] = f2bf(p.rw_v[o]); }
    BLOCK_FOR(idx, C * C) Tb[(idx / C) * LD + idx % C] = f2bf(p.rw_T[(size_t)cn * C * C + idx]);
    BLOCK_SYNC();
    constexpr int TC = C / 32, TN = N / 32;
    WAVE_FOR(w, 3 * TC * TC) { const int which = w / (TC * TC), tm = (w / TC) % TC, tn = w % TC;
        const u16* Am = which == 0 ? KTt : Rt; const u16* Bm = which == 0 ? KKt : (which == 1 ? At : KTt); u16* Om = which == 0 ? MkT : (which == 1 ? Na : Nk);
        wave_mma32<N>(LANE, [&](int m, int k0, Frag& o) { o.ld_bf(Am + (tm * 32 + m) * LD + k0); },
                            [&](int nn, int k0, Frag& o) { o.ld_bf(Bm + (tn * 32 + nn) * LD + k0); },
                            [&](int m, int nn, float acc, int) { const int r = tm * 32 + m, cc = tn * 32 + nn; const bool keep = which == 0 ? (cc > r) : (cc <= r);
                                Om[r * LD + cc] = f2bf(keep ? acc : 0.f); }); }
    BLOCK_SYNC();
    WAVE_FOR(w, TC * TC + TN * TC) {
        if (w < TC * TC) { const int tm = w / TC, tn = w % TC;
            wave_mma32<C>(LANE, [&](int m, int k0, Frag& o) { o.ld_bf(Tb + (tm * 32 + m) * LD + k0); },
                                [&](int nn, int k0, Frag& o) { o.ld_bf(MkT + (tn * 32 + nn) * LD + k0); },
                                [&](int m, int nn, float acc, int) { Gm[(tm * 32 + m) * LD + tn * 32 + nn] = f2bf(acc); }); }
        else { const int q = w - TC * TC, tm = q / TC, tn = q % TC;
            wave_mma32<C>(LANE, [&](int m, int k0, Frag& o) { o.ld_bf(KKtT + (tm * 32 + m) * LD + k0); },
                                [&](int nn, int k0, Frag& o) { o.ld_bf(Tb + (tn * 32 + nn) * LD + k0); },
                                [&](int m, int nn, float acc, int) { KKhT[(tm * 32 + m) * LD + tn * 32 + nn] = f2bf(acc); }); } }
    BLOCK_SYNC();
    u16* RhG = p.rw_Rh + (size_t)cn * CN; u16* PhiTG = p.rw_PhiT + (size_t)cn * N * N;
    WAVE_FOR(w, TN * TC + TC * TN + TN * TN) {
        if (w < TN * TC) { const int tm = w / TC, tn = w % TC;
            wave_mma32<C>(LANE, [&](int m, int k0, Frag& o) { o.ld_bf(VT + (tm * 32 + m) * LD + k0); },
                                [&](int nn, int k0, Frag& o) { o.ld_bf(Gm + (tn * 32 + nn) * LD + k0); },
                                [&](int m, int nn, float acc, int) { ZT[(tm * 32 + m) * LD + tn * 32 + nn] = f2bf(acc); }); }
        else if (w < TN * TC + TC * TN) { const int q = w - TN * TC, tm = q / TN, tn = q % TN;
            wave_mma32<C>(LANE, [&](int m, int k0, Frag& o) { o.ld_bf(Na + (tm * 32 + m) * LD + k0); },
                                [&](int nn, int k0, Frag& o) { o.ld_bf(KKhT + (tn * 32 + nn) * LD + k0); },
                                [&](int m, int nn, float acc, int) { const int t = tm * 32 + m, k = tn * 32 + nn; RhG[t * N + k] = f2bf(bf2f(Rt[t * LD + k]) - acc); }); }
        else { const int q = w - TN * TC - TC * TN, tm = q / TN, tn = q % TN;
            wave_mma32<C>(LANE, [&](int m, int k0, Frag& o) { o.ld_bf(ApT + (tm * 32 + m) * LD + k0); },
                                [&](int nn, int k0, Frag& o) { o.ld_bf(KKhT + (tn * 32 + nn) * LD + k0); },
                                [&](int m, int nn, float acc, int) { const int k = tm * 32 + m, k2 = tn * 32 + nn; PhiTG[k * N + k2] = f2bf((k == k2 ? PC[k] : 0.f) - acc); }); } }
    BLOCK_SYNC();
    float* Y0G = p.rw_Y0 + (size_t)cn * CN; float* PsiG = p.rw_Psi + (size_t)cn * N * N;
    WAVE_FOR(w, TC * TN + TN * TN) {
        if (w < TC * TN) { const int tm = w / TN, tn = w % TN;
            wave_mma32<2 * C>(LANE, [&](int m, int k0, Frag& o) { if (k0 < C) o.ld_bf(Nk + (tm * 32 + m) * LD + k0); else { o.ld_bf(Na + (tm * 32 + m) * LD + k0 - C); o.neg(); } },
                                    [&](int nn, int k0, Frag& o) { if (k0 < C) o.ld_bf(VT + (tn * 32 + nn) * LD + k0); else o.ld_bf(ZT + (tn * 32 + nn) * LD + k0 - C); },
                                    [&](int m, int nn, float acc, int) { Y0G[(tm * 32 + m) * N + tn * 32 + nn] = acc; }); }
        else { const int q = w - TC * TN, tm = q / TN, tn = q % TN;
            wave_mma32<2 * C>(LANE, [&](int m, int k0, Frag& o) { if (k0 < C) o.ld_bf(VT + (tm * 32 + m) * LD + k0); else { o.ld_bf(ZT + (tm * 32 + m) * LD + k0 - C); o.neg(); } },
                                    [&](int nn, int k0, Frag& o) { if (k0 < C) o.ld_bf(KTpT + (tn * 32 + nn) * LD + k0); else o.ld_bf(ApT + (tn * 32 + nn) * LD + k0 - C); },
                                    [&](int m, int nn, float acc, int) { PsiG[(tm * 32 + m) * N + tn * 32 + nn] = acc; }); } }
    BLOCK_SYNC();
}
constexpr int RW_S2_SMEM = (3 * RW_N + CHUNK) * (RW_N + LDPAD) * 2 + RW_N * RW_N * 4 + CHUNK * RW_N * 4;
HD void ph_rw_scan2_unit(const Params& p, int ch, int tid, int nthr, unsigned char* smem) {
    (void)tid; (void)nthr; OPAQUE_TID();
    constexpr int C = CHUNK, N = RW_N, TC = C / 32, TN = N / 32, LD = N + LDPAD;
    int b, hh, d; rw_chain(ch, b, hh, d);
    u16* Sb = (u16*)smem; u16* PhiT = Sb + 2 * N * LD; u16* Rh = PhiT + N * LD; float* Psi = (float*)(Rh + C * LD); float* Y0 = Psi + N * N;
    BLOCK_FOR(i, N * LD) Sb[i] = 0;
    auto tiles = [&](int n) {
        const u16* Sc = Sb + (n & 1) * N * LD; u16* Sn = Sb + ((n + 1) & 1) * N * LD;
        WAVE_FOR(w, TN * TN + TC * TN) {
            if (w < TN * TN) { const int tm = w / TN, tn = w % TN;
                wave_mma32<N>(LANE, [&](int m, int k0, Frag& o) { o.ld_bf(Sc + (tm * 32 + m) * LD + k0); },
                                    [&](int nn, int k0, Frag& o) { o.ld_bf(PhiT + (tn * 32 + nn) * LD + k0); },
                                    [&](int m, int nn, float acc, int) { const int i = tm * 32 + m, k = tn * 32 + nn; Sn[i * LD + k] = f2bf(acc + Psi[i * N + k]); }); }
            else { const int q = w - TN * TN, tm = q / TN, tn = q % TN;
                wave_mma32<N>(LANE, [&](int m, int k0, Frag& o) { o.ld_bf(Rh + (tm * 32 + m) * LD + k0); },
                                    [&](int nn, int k0, Frag& o) { o.ld_bf(Sc + (tn * 32 + nn) * LD + k0); },
                                    [&](int m, int nn, float acc, int) { const int t = tm * 32 + m, i = tn * 32 + nn, R = b * TOK + seq_s(d, n * C + t);
                                        p.rw_y[((size_t)d * MROWS + R) * GROUP_W + hh * N + i] = acc + Y0[t * N + i]; }); } } };
#ifdef CPU_TEST
    for (int n = 0; n < NCHUNK; ++n) { const int cn = ch * NCHUNK + n;
        BLOCK_FOR(i, N * N / 8) *(uint4*)(PhiT + (i / (N / 8)) * LD + (i % (N / 8)) * 8) = ((const uint4*)(p.rw_PhiT + (size_t)cn * N * N))[i];
        BLOCK_FOR(i, C * N / 8) *(uint4*)(Rh + (i / (N / 8)) * LD + (i % (N / 8)) * 8) = ((const uint4*)(p.rw_Rh + (size_t)cn * C * N))[i];
        BLOCK_FOR(i, N * N / 4) ((uint4*)Psi)[i] = ((const uint4*)(p.rw_Psi + (size_t)cn * N * N))[i];
        BLOCK_FOR(i, C * N / 4) ((uint4*)Y0)[i] = ((const uint4*)(p.rw_Y0 + (size_t)cn * C * N))[i];
        BLOCK_SYNC(); tiles(n); BLOCK_SYNC(); }
#else
    constexpr int NT = 512, Q_A = N * N / 8 / NT, Q_B = C * N / 8 / NT, Q_C = N * N / 4 / NT, Q_D = C * N / 4 / NT;
    static_assert(Q_A * NT * 8 == N * N && Q_B * NT * 8 == C * N && Q_C * NT * 4 == N * N && Q_D * NT * 4 == C * N && NCHUNK % 4 == 0, "prefetch split");
    pfv4 rA[4][Q_A], rB[4][Q_B], rC[4][Q_C], rD[4][Q_D];
#define RW_PF_LOAD(st, cn_) do { pf_ld_lin(rA[st], p.rw_PhiT + (size_t)(cn_) * N * N, tid); pf_ld_lin(rB[st], p.rw_Rh + (size_t)(cn_) * C * N, tid); \
    pf_ld_lin(rC[st], p.rw_Psi + (size_t)(cn_) * N * N, tid); pf_ld_lin(rD[st], p.rw_Y0 + (size_t)(cn_) * C * N, tid); } while (0)
#define RW_PF_STORE(st) do { pf_st_pad(rA[st], PhiT, N / 8, LD, tid); pf_st_pad(rB[st], Rh, N / 8, LD, tid); pf_st_lin(rC[st], Psi, tid); pf_st_lin(rD[st], Y0, tid); } while (0)
    const int cn0 = ch * NCHUNK;
    RW_PF_LOAD(0, cn0); RW_PF_LOAD(1, cn0 + 1); RW_PF_LOAD(2, cn0 + 2); RW_PF_LOAD(3, cn0 + 3); RW_PF_STORE(0);
    for (int n0 = 0; n0 < NCHUNK; n0 += 4) {
#pragma unroll
        for (int j = 0; j < 4; ++j) { const int n = n0 + j;
            BLOCK_SYNC();
            if (n + 4 < NCHUNK) RW_PF_LOAD(j, cn0 + n + 4);
            tiles(n);
            BLOCK_SYNC();
            if (n + 1 < NCHUNK) RW_PF_STORE((j + 1) & 3); } }
#undef RW_PF_LOAD
#undef RW_PF_STORE
#endif
}
template <int G> HD void ph_rw_post(const Params& p, int layer, Exec e) {
    constexpr int NI = RW_HEAD / 4 / G;
    static_assert(NI * 4 * G == RW_HEAD, "G");
    const float *lw = p.rw_ln_w + layer * GROUP_W, *lb = p.rw_ln_b + layer * GROUP_W, *rk = p.rw_r_k + layer * GROUP_W;
    for (int it = e.gid; it < MROWS * RW_HEADS; it += e.ngroups) {
        const int R = it / RW_HEADS, hh = it % RW_HEADS; const size_t o = (size_t)R * GROUP_W + hh * RW_HEAD, o2 = (size_t)MROWS * GROUP_W;
        F4 y[NI]; float s1 = 0.f, bon = 0.f;
#pragma unroll
        for (int i = 0; i < NI; ++i) { const int c4 = (e.gl + G * i) * 4; y[i] = ld4(p.rw_y + o + c4) + ld4(p.rw_y + o2 + o + c4); s1 += hsum(y[i]);
            bon += hsum(ld4(p.rw_r + o + c4) * (ld4(p.rw_kt + o + c4) + ld4(p.rw_kt + o2 + o + c4)) * ld4(rk + hh * RW_HEAD + c4)); }
        s1 = group_sum<G>(s1); bon = group_sum<G>(bon);
        const float mean = s1 / RW_HEAD;
        float s2 = 0.f;
#pragma unroll
        for (int i = 0; i < NI; ++i) { y[i] = y[i] + (-mean); s2 += hsum(y[i] * y[i]); }
        s2 = group_sum<G>(s2);
        const float rstd = 1.f / sqrtf(s2 / RW_HEAD + RW_GN_EPS);
#pragma unroll
        for (int i = 0; i < NI; ++i) { const int c4 = (e.gl + G * i) * 4;
            const F4 yn = y[i] * rstd * ld4(lw + hh * RW_HEAD + c4) + ld4(lb + hh * RW_HEAD + c4);
            st4bf(p.mix + (size_t)R * D_MODEL + hh * RW_HEAD + c4, (yn + ld4(p.rw_v + o + c4) * bon) * ld4(p.rw_g + o + c4)); }
    }
}

HD void ml_chain(int ch, int& b, int& hh, int& d) { d = ch % 2; hh = (ch / 2) % ML_HEADS; b = ch / (2 * ML_HEADS); }
template <int G> HD void ph_ml_g1(const Params& p, int layer, Exec e) {
    for (int it = e.gid; it < ML_CH * NCHUNK; it += e.ngroups) {
        const int ch = it / NCHUNK, n = it % NCHUNK; int b, hh, d; ml_chain(ch, b, hh, d);
        const float ib = p.ml_ib[(layer * 2 + d) * ML_HEADS + hh], fb = p.ml_fb[(layer * 2 + d) * ML_HEADS + hh];
        float cb = 0.f, cm = -1e30f;
        for (int t0 = 0; t0 < CHUNK; t0 += G) { const int t = t0 + e.gl, pos = n * CHUNK + t, R = b * TOK + seq_s(d, pos);
            const float* g = p.P + (size_t)R * LDP + ML_OFF + 4 * GROUP_W;
            const float li = g[d * ML_HEADS + hh] + ib, lf = logsigmoidf_(g[(2 + d) * ML_HEADS + hh] + fb);
            const float bc = cb + group_scan_sum<G>(lf, e.gl), gv = li - bc, gm = fmaxf(cm, group_scan_max<G>(gv, e.gl));
            p.ml_bcum[(size_t)ch * TOK + pos] = bc; p.ml_g[(size_t)ch * TOK + pos] = gv; p.ml_gmax[(size_t)ch * TOK + pos] = gm;
            cb = group_last<G>(bc); cm = group_last<G>(gm); }
        if (e.gl == 0) { p.ml_bl[ch * NCHUNK + n] = cb; p.ml_gm[ch * NCHUNK + n] = cm; }
    }
}
HD void ph_ml_g2(const Params& p, Exec e) {
    for (int ch = e.gid; ch < ML_CH; ch += e.ngroups) { float m = 0.f;
        for (int n = 0; n < NCHUNK; ++n) { const float bl = p.ml_bl[ch * NCHUNK + n], mnew = bl + fmaxf(m, p.ml_gm[ch * NCHUNK + n]);
            p.ml_min[ch * NCHUNK + n] = m; p.ml_dcv[ch * NCHUNK + n] = expf(bl + m - mnew); m = mnew; } }
}
HD void ph_ml_prefix(const Params& p, Exec e) {
    const int n1 = ML_CH * ML_HEAD * ML_HEAD, n2 = ML_CH * ML_HEAD;
    for (int it = e.gid; it < n1 + n2; it += e.ngroups) {
        const bool isn = it >= n1; const int q = isn ? it - n1 : it, per = isn ? ML_HEAD : ML_HEAD * ML_HEAD, ch = q / per, el = q % per;
        float* arr = (isn ? p.ml_dn : p.ml_dC) + (size_t)ch * NCHUNK * per + el; const float* dcv = p.ml_dcv + ch * NCHUNK; float st = 0.f;
        for (int n = 0; n < NCHUNK; n += 4) { float inc[4], dc[4];
#pragma unroll
            for (int j = 0; j < 4; ++j) if (n + j < NCHUNK) { inc[j] = arr[(size_t)(n + j) * per]; dc[j] = dcv[n + j]; }
#pragma unroll
            for (int j = 0; j < 4; ++j) if (n + j < NCHUNK) { arr[(size_t)(n + j) * per] = st; st = dc[j] * st + inc[j]; } }
    }
}

constexpr int ML_N = ML_HEAD, ML_CN = ML_CH * NCHUNK;
static_assert(ML_HEAD % 32 == 0, "tile");
constexpr int ML_C1_SMEM = 2 * ML_N * (CHUNK + LDPAD) * 2 + 4 * CHUNK * 4;
HD void ph_ml_c1_unit(const Params& p, int cn, int tid, int nthr, unsigned char* smem) {
    (void)tid; (void)nthr; OPAQUE_TID();
    constexpr int C = CHUNK, N = ML_N, TC = C / 32, TN = N / 32, LD = C + LDPAD;
    const float ksc = 1.f / sqrtf((float)ML_HEAD);
    const int ch = cn / NCHUNK, n = cn % NCHUNK; int b, hh, d; ml_chain(ch, b, hh, d);
    u16* VwT = (u16*)smem; u16* KT = VwT + N * LD; float* wk = (float*)(KT + N * LD); float* btv = wk + C; float* gv = btv + C; float* mtv = gv + C;
    const float min_ = p.ml_min[cn], bl = p.ml_bl[cn], mnew = bl + fmaxf(min_, p.ml_gm[cn]);
    BLOCK_FOR(sx, C) { const size_t o = (size_t)ch * TOK + n * C + sx; const float g = p.ml_g[o], bt = p.ml_bcum[o];
        wk[sx] = expf(bl + g - mnew); btv[sx] = bt; gv[sx] = g; mtv[sx] = bt + fmaxf(min_, p.ml_gmax[o]); }
    BLOCK_SYNC();
    BLOCK_FOR(idx, C * N) { const int sx = idx / N, dd = idx % N, R = b * TOK + seq_s(d, n * C + sx); const float* pr = p.P + (size_t)R * LDP + ML_OFF + hh * N;
        VwT[dd * LD + sx] = f2bf(wk[sx] * pr[2 * GROUP_W + dd]); KT[dd * LD + sx] = f2bf(pr[GROUP_W + dd] * ksc); }
    BLOCK_SYNC();
    WAVE_FOR(w, TN * TN + TN + TC * TC) {
        if (w < TN * TN) { const int tm = w / TN, tn = w % TN;
            wave_mma32<C>(LANE, [&](int m, int k0, Frag& o) { o.ld_bf(VwT + (tm * 32 + m) * LD + k0); },
                                [&](int nn, int k0, Frag& o) { o.ld_bf(KT + (tn * 32 + nn) * LD + k0); },
                                [&](int m, int nn, float acc, int) { p.ml_dC[((size_t)cn * N + tm * 32 + m) * N + tn * 32 + nn] = acc; }); }
        else if (w < TN * TN + TN) { const int tn = w - TN * TN;
            wave_mma32<C>(LANE, [&](int m, int k0, Frag& o) { if (m == 0) o.ld_f(wk + k0); else o.set1(0.f); },
                                [&](int nn, int k0, Frag& o) { o.ld_bf(KT + (tn * 32 + nn) * LD + k0); },
                                [&](int m, int nn, float acc, int) { if (m == 0) p.ml_dn[(size_t)cn * N + tn * 32 + nn] = acc; }); }
        else { const int q = w - TN * TN - TN, tm = q / TC, tn = q % TC;
            wave_mma32<N>(LANE, [&](int m, int k0, Frag& o) { const int R = b * TOK + seq_s(d, n * C + tm * 32 + m); o.ld_f(p.P + (size_t)R * LDP + ML_OFF + hh * N + k0); },
                                [&](int nn, int k0, Frag& o) { const int R = b * TOK + seq_s(d, n * C + tn * 32 + nn); o.ld_f(p.P + (size_t)R * LDP + ML_OFF + GROUP_W + hh * N + k0); },
                                [&](int m, int nn, float acc, int) { const int t = tm * 32 + m, sx = tn * 32 + nn;
                                    p.ml_S[((size_t)cn * C + t) * C + sx] = sx <= t ? acc * ksc * expf(btv[t] + gv[sx] - mtv[t]) : 0.f; }); } }
    BLOCK_SYNC();
}
constexpr int ML_C2_SMEM = ML_N * (CHUNK + LDPAD) * 2 + 3 * CHUNK * 4;
HD void ph_ml_c2_unit(const Params& p, int cn, int tid, int nthr, unsigned char* smem) {
    (void)tid; (void)nthr; OPAQUE_TID();
    constexpr int C = CHUNK, N = ML_N, TC = C / 32, TN = N / 32, LD = C + LDPAD;
    const int ch = cn / NCHUNK, n = cn % NCHUNK; int b, hh, d; ml_chain(ch, b, hh, d);
    u16* VT = (u16*)smem; float* wi = (float*)(VT + N * LD); float* den = wi + C; float* emt = den + C;
    const float min_ = p.ml_min[cn];
    BLOCK_FOR(t, C) { const size_t o = (size_t)ch * TOK + n * C + t; const float bt = p.ml_bcum[o], mt = bt + fmaxf(min_, p.ml_gmax[o]);
        wi[t] = expf(bt + min_ - mt); emt[t] = expf(-mt); }
    BLOCK_FOR(idx, C * N) { const int sx = idx / N, dd = idx % N, R = b * TOK + seq_s(d, n * C + sx);
        VT[dd * LD + sx] = f2bf(p.P[(size_t)R * LDP + ML_OFF + 2 * GROUP_W + hh * N + dd]); }
    BLOCK_SYNC();
    WAVE_FOR(w, TC) { const int tm = w;
        wave_mma32<C + N>(LANE, [&](int m, int k0, Frag& o) { const int t = tm * 32 + m;
                                    if (k0 < C) o.ld_f(p.ml_S + ((size_t)cn * C + t) * C + k0);
                                    else { const int R = b * TOK + seq_s(d, n * C + t); o.ld_f_scaled(p.P + (size_t)R * LDP + ML_OFF + hh * N + k0 - C, wi[t]); } },
                                [&](int nn, int k0, Frag& o) { if (nn != 0) o.set1(0.f); else if (k0 < C) o.set1(1.f); else o.ld_f(p.ml_dn + (size_t)cn * N + k0 - C); },
                                [&](int m, int nn, float acc, int) { if (nn == 0) den[tm * 32 + m] = acc; }); }
    BLOCK_SYNC();
    WAVE_FOR(w, TC * TN) { const int tm = w / TN, tn = w % TN;
        wave_mma32<C + N>(LANE, [&](int m, int k0, Frag& o) { const int t = tm * 32 + m;
                                    if (k0 < C) o.ld_f(p.ml_S + ((size_t)cn * C + t) * C + k0);
                                    else { const int R = b * TOK + seq_s(d, n * C + t); o.ld_f_scaled(p.P + (size_t)R * LDP + ML_OFF + hh * N + k0 - C, wi[t]); } },
                                [&](int nn, int k0, Frag& o) { const int ee = tn * 32 + nn;
                                    if (k0 < C) o.ld_bf(VT + ee * LD + k0); else o.ld_f(p.ml_dC + ((size_t)cn * N + ee) * N + k0 - C); },
                                [&](int m, int nn, float acc, int) { const int t = tm * 32 + m, ee = tn * 32 + nn, R = b * TOK + seq_s(d, n * C + t);
                                    p.ml_hh[((size_t)d * MROWS + R) * GROUP_W + hh * N + ee] = acc / fmaxf(fabsf(den[t]), emt[t]); }); }
    BLOCK_SYNC();
}
template <int G> HD void ph_ml_post(const Params& p, int layer, Exec e) {
    constexpr int NI = ML_HEAD / 4 / G;
    static_assert(NI * 4 * G == ML_HEAD, "G");
    const float* ng = p.ml_norm_g + layer * GROUP_W;
    for (int it = e.gid; it < MROWS * ML_HEADS; it += e.ngroups) {
        const int R = it / ML_HEADS, hh = it % ML_HEADS; const size_t o = (size_t)R * GROUP_W + hh * ML_HEAD, o2 = (size_t)MROWS * GROUP_W;
        F4 y[NI]; float s1 = 0.f;
#pragma unroll
        for (int i = 0; i < NI; ++i) { const int c4 = (e.gl + G * i) * 4; y[i] = ld4(p.ml_hh + o + c4) + ld4(p.ml_hh + o2 + o + c4); s1 += hsum(y[i]); }
        s1 = group_sum<G>(s1); const float mean = s1 / ML_HEAD;
        float s2 = 0.f;
#pragma unroll
        for (int i = 0; i < NI; ++i) { y[i] = y[i] + (-mean); s2 += hsum(y[i] * y[i]); }
        s2 = group_sum<G>(s2); const float rstd = 1.f / sqrtf(s2 / ML_HEAD + NORM_EPS);
#pragma unroll
        for (int i = 0; i < NI; ++i) { const int c4 = (e.gl + G * i) * 4; const F4 og = ld4(p.P + (size_t)R * LDP + ML_OFF + 3 * GROUP_W + hh * ML_HEAD + c4);
            const F4 sg = F4{sigmoidf_(og.x), sigmoidf_(og.y), sigmoidf_(og.z), sigmoidf_(og.w)};
            st4bf(p.mix + (size_t)R * D_MODEL + GROUP_W + hh * ML_HEAD + c4, y[i] * rstd * ld4(ng + hh * ML_HEAD + c4) * sg); }
    }
}

HD F4 gd_conv_silu4(const Params& p, int layer, int R, int c) {
    const int sx = row_s(R); const float* pr = p.P + (size_t)R * LDP + GD_OFF + c; const float* cw = p.gd_conv + (size_t)layer * 3 * 3 * GROUP_W + c;
    F4 v = ld4(pr) * ld4(cw + 3 * GROUP_W);
    if (sx != 0 && sx != CTX) v = v + ld4(pr - LDP) * ld4(cw);
    if (sx != CTX - 1 && sx != TOK - 1) v = v + ld4(pr + LDP) * ld4(cw + 2 * 3 * GROUP_W);
    return F4{siluf_(v.x), siluf_(v.y), siluf_(v.z), siluf_(v.w)};
}
template <int G> HD void ph_gd_prep(const Params& p, int layer, Exec e) {
    const float qsc = 1.f / sqrtf((float)GD_HEAD);
    constexpr int NI = GD_HEAD / 4 / G;
    static_assert(NI * 4 * G == GD_HEAD, "G");
    for (int it = e.gid; it < MROWS * GD_HEADS; it += e.ngroups) {
        int gl = e.gl; OPAQUE_I(gl);
        const int R = it / GD_HEADS, hh = it % GD_HEADS;
        F4 xq[NI], xk[NI], xv[NI]; float sq = 0.f, sk = 0.f;
#pragma unroll
        for (int i = 0; i < NI; ++i) { const int j = hh * GD_HEAD + (gl + G * i) * 4;
            xq[i] = gd_conv_silu4(p, layer, R, j); xk[i] = gd_conv_silu4(p, layer, R, GROUP_W + j); xv[i] = gd_conv_silu4(p, layer, R, 2 * GROUP_W + j);
            sq += hsum(xq[i] * xq[i]); sk += hsum(xk[i] * xk[i]); }
        sq = group_sum<G>(sq); sk = group_sum<G>(sk);
        const float rq = qsc / sqrtf(sq + 1e-6f), rk = 1.f / sqrtf(sk + 1e-6f);
#pragma unroll
        for (int i = 0; i < NI; ++i) { const size_t o = (size_t)R * GROUP_W + hh * GD_HEAD + (gl + G * i) * 4;
            st4(p.gd_q + o, xq[i] * rq); st4(p.gd_k + o, xk[i] * rk); st4(p.gd_v + o, xv[i]); }
    }
}
template <int G> HD void ph_gd_gates(const Params& p, int layer, Exec e) {
    for (int it = e.gid; it < GD_CH * NCHUNK; it += e.ngroups) {
        const int ch = it / NCHUNK, n = it % NCHUNK; int b, hh, d; ml_chain(ch, b, hh, d);
        const float al = expf(p.gd_a_log[(layer * 2 + d) * GD_HEADS + hh]), dtb = p.gd_dt_bias[(layer * 2 + d) * GD_HEADS + hh];
        float cg = 0.f;
        for (int t0 = 0; t0 < CHUNK; t0 += G) { const int t = t0 + e.gl, pos = n * CHUNK + t, R = b * TOK + seq_s(d, pos);
            const float* g = p.P + (size_t)R * LDP + GD_OFF + 4 * GROUP_W;
            const float gc = cg + group_scan_sum<G>(-al * softplusf_(g[d * GD_HEADS + hh] + dtb), e.gl);
            p.gd_gc[(size_t)ch * TOK + pos] = gc; p.gd_beta[(size_t)ch * TOK + pos] = sigmoidf_(g[(2 + d) * GD_HEADS + hh]);
            cg = group_last<G>(gc); }
    }
}

constexpr int GD_N = GD_HEAD, GD_CN = GD_CH * NCHUNK;
static_assert(GD_HEAD % 32 == 0, "tile");
HD void ph_gd_c1(const Params& p, Exec e) {
    constexpr int C = CHUNK, N = GD_N, TC = C / 32;
    for (int it = e.gid; it < GD_CN * TC * TC; it += e.ngroups) {
        const int cn = it / (TC * TC), tm = (it / TC) % TC, tn = it % TC, ch = cn / NCHUNK, n = cn % NCHUNK; int b, hh, d; ml_chain(ch, b, hh, d);
        wave_mma32<N>(e.gl, [&](int m, int k0, Frag& o) { const int R = b * TOK + seq_s(d, n * C + tm * 32 + m); o.ld_f(p.gd_k + (size_t)R * GROUP_W + hh * N + k0); },
                            [&](int nn, int k0, Frag& o) { const int R = b * TOK + seq_s(d, n * C + tn * 32 + nn); o.ld_f(p.gd_k + (size_t)R * GROUP_W + hh * N + k0); },
                            [&](int m, int nn, float acc, int) { const int i = tm * 32 + m, j = tn * 32 + nn; const size_t o = (size_t)ch * TOK + n * C;
                                p.gd_A[((size_t)cn * C + i) * C + j] = j < i ? p.gd_beta[o + i] * acc * expf(p.gd_gc[o + i] - p.gd_gc[o + j]) : 0.f; });
    }
}
constexpr int GD_C3_SMEM = (5 * GD_N + 2 * CHUNK) * (CHUNK + LDPAD) * 2 + 2 * CHUNK * 4;
HD void ph_gd_c3_unit(const Params& p, int cn, int tid, int nthr, unsigned char* smem) {
    (void)tid; (void)nthr; OPAQUE_TID();
    constexpr int C = CHUNK, N = GD_N, TC = C / 32, TN = N / 32, LD = C + LDPAD;
    const int ch = cn / NCHUNK, n = cn % NCHUNK; int b, hh, d; ml_chain(ch, b, hh, d);
    u16 *KbT = (u16*)smem, *VbT = KbT + N * LD, *KdT = VbT + N * LD, *uT = KdT + N * LD, *wT = uT + N * LD, *Tb = wT + N * LD, *attn = Tb + C * LD;
    float* gcs = (float*)(attn + C * LD); float* bet = gcs + C;
    BLOCK_FOR(t, C) { const size_t o = (size_t)ch * TOK + n * C + t; gcs[t] = p.gd_gc[o]; bet[t] = p.gd_beta[o]; }
    BLOCK_SYNC();
    BLOCK_FOR(idx, C * N) { const int t = idx / N, dd = idx % N, R = b * TOK + seq_s(d, n * C + t); const size_t o = (size_t)R * GROUP_W + hh * N + dd;
        const float kv = p.gd_k[o], vv = p.gd_v[o];
        KbT[dd * LD + t] = f2bf(kv * bet[t] * expf(gcs[t])); VbT[dd * LD + t] = f2bf(vv * bet[t]); KdT[dd * LD + t] = f2bf(kv * expf(gcs[C - 1] - gcs[t])); }
    BLOCK_FOR(idx, C * C) Tb[(idx / C) * LD + idx % C] = f2bf(p.gd_T[(size_t)cn * C * C + idx]);
    BLOCK_SYNC();
    WAVE_FOR(w, TC * TC + 2 * TN * TC) {
        if (w < TC * TC) { const int tm = w / TC, tn = w % TC;
            wave_mma32<N>(LANE, [&](int m, int k0, Frag& o) { const int R = b * TOK + seq_s(d, n * C + tm * 32 + m); o.ld_f(p.gd_q + (size_t)R * GROUP_W + hh * N + k0); },
                                [&](int nn, int k0, Frag& o) { const int R = b * TOK + seq_s(d, n * C + tn * 32 + nn); o.ld_f(p.gd_k + (size_t)R * GROUP_W + hh * N + k0); },
                                [&](int m, int nn, float acc, int) { const int i = tm * 32 + m, j = tn * 32 + nn; attn[i * LD + j] = f2bf(j <= i ? acc * expf(gcs[i] - gcs[j]) : 0.f); }); }
        else { const int q = w - TC * TC, which = q / (TN * TC), tm = (q / TC) % TN, tn = q % TC;
            const u16* Am = which ? KbT : VbT; u16* Om = which ? wT : uT;
            wave_mma32<C>(LANE, [&](int m, int k0, Frag& o) { o.ld_bf(Am + (tm * 32 + m) * LD + k0); },
                                [&](int nn, int k0, Frag& o) { o.ld_bf(Tb + (tn * 32 + nn) * LD + k0); },
                                [&](int m, int nn, float acc, int) { Om[(tm * 32 + m) * LD + tn * 32 + nn] = f2bf(acc); }); } }
    BLOCK_SYNC();
    WAVE_FOR(w, 2 * TC * TN + 2 * TN * TN) {
        if (w < 2 * TC * TN) { const int which = w / (TC * TN), tm = (w / TN) % TC, tn = w % TN;
            const u16* Bm = which ? uT : wT;
            wave_mma32<C>(LANE, [&](int m, int k0, Frag& o) { o.ld_bf(attn + (tm * 32 + m) * LD + k0); },
                                [&](int nn, int k0, Frag& o) { o.ld_bf(Bm + (tn * 32 + nn) * LD + k0); },
                                [&](int m, int nn, float acc, int) { const int i = tm * 32 + m, dd = tn * 32 + nn;
                                    if (which) p.gd_O0[((size_t)cn * C + i) * N + dd] = acc;
                                    else { const int R = b * TOK + seq_s(d, n * C + i); p.gd_Qh[((size_t)cn * C + i) * N + dd] = f2bf(p.gd_q[(size_t)R * GROUP_W + hh * N + dd] * expf(gcs[i]) - acc); } }); }
        else { const int q = w - 2 * TC * TN, which = q / (TN * TN), tm = (q / TN) % TN, tn = q % TN;
            const u16* Bm = which ? uT : wT;
            wave_mma32<C>(LANE, [&](int m, int k0, Frag& o) { o.ld_bf(KdT + (tm * 32 + m) * LD + k0); },
                                [&](int nn, int k0, Frag& o) { o.ld_bf(Bm + (tn * 32 + nn) * LD + k0); },
                                [&](int m, int nn, float acc, int) { const int d1 = tm * 32 + m, d2 = tn * 32 + nn;
                                    if (which) p.gd_Psi[((size_t)cn * N + d1) * N + d2] = acc;
                                    else p.gd_Phi[((size_t)cn * N + d1) * N + d2] = f2bf((d1 == d2 ? expf(gcs[C - 1]) : 0.f) - acc); }); } }
    BLOCK_SYNC();
}
constexpr int GD_EB = 32, GD_S2_UNITS = GD_CH * (GD_N / GD_EB);
constexpr int GD_S2_SMEM = (2 * GD_EB + GD_N + CHUNK) * (GD_N + LDPAD) * 2 + (GD_N * GD_EB + CHUNK * GD_EB) * 4;
HD void ph_gd_scan2_unit(const Params& p, int unit, int tid, int nthr, unsigned char* smem) {
    (void)tid; (void)nthr; OPAQUE_TID();
    constexpr int C = CHUNK, N = GD_N, EB = GD_EB, LD = N + LDPAD;
    const int eb = unit % (N / EB), ch = unit / (N / EB), e0 = eb * EB; int b, hh, d; ml_chain(ch, b, hh, d);
    u16* ST = (u16*)smem; u16* Phi = ST + 2 * EB * LD; u16* Qh = Phi + N * LD; float* Psi = (float*)(Qh + C * LD); float* O0 = Psi + N * EB;
    BLOCK_FOR(i, EB * LD) ST[i] = 0;
    auto tiles = [&](int n) {
        const u16* Sc = ST + (n & 1) * EB * LD; u16* Sn = ST + ((n + 1) & 1) * EB * LD;
        WAVE_FOR(w, N / 32 + C / 32) {
            if (w < N / 32) { const int tm = w;
                wave_mma32<N>(LANE, [&](int m, int k0, Frag& o) { o.ld_bf(Phi + (tm * 32 + m) * LD + k0); },
                                    [&](int nn, int k0, Frag& o) { o.ld_bf(Sc + nn * LD + k0); },
                                    [&](int m, int nn, float acc, int) { const int d1 = tm * 32 + m; Sn[nn * LD + d1] = f2bf(acc + Psi[d1 * EB + nn]); }); }
            else { const int tm = w - N / 32;
                wave_mma32<N>(LANE, [&](int m, int k0, Frag& o) { o.ld_bf(Qh + (tm * 32 + m) * LD + k0); },
                                    [&](int nn, int k0, Frag& o) { o.ld_bf(Sc + nn * LD + k0); },
                                    [&](int m, int nn, float acc, int) { const int t = tm * 32 + m, R = b * TOK + seq_s(d, n * C + t);
                                        p.gd_o[((size_t)d * MROWS + R) * GROUP_W + hh * N + e0 + nn] = acc + O0[t * EB + nn]; }); } } };
#ifdef CPU_TEST
    for (int n = 0; n < NCHUNK; ++n) { const int cn = ch * NCHUNK + n;
        BLOCK_FOR(i, N * N / 8) *(uint4*)(Phi + (i / (N / 8)) * LD + (i % (N / 8)) * 8) = ((const uint4*)(p.gd_Phi + (size_t)cn * N * N))[i];
        BLOCK_FOR(i, C * N / 8) *(uint4*)(Qh + (i / (N / 8)) * LD + (i % (N / 8)) * 8) = ((const uint4*)(p.gd_Qh + (size_t)cn * C * N))[i];
        BLOCK_FOR(i, N * EB / 4) ((uint4*)Psi)[i] = *(const uint4*)(p.gd_Psi + ((size_t)cn * N + i / (EB / 4)) * N + e0 + (i % (EB / 4)) * 4);
        BLOCK_FOR(i, C * EB / 4) ((uint4*)O0)[i] = *(const uint4*)(p.gd_O0 + ((size_t)cn * C + i / (EB / 4)) * N + e0 + (i % (EB / 4)) * 4);
        BLOCK_SYNC(); tiles(n); BLOCK_SYNC(); }
#else
    constexpr int NT = 512, Q_PHI = N * N / 8 / NT, Q_QH = C * N / 8 / NT, Q_PSI = N * EB / 4 / NT, Q_O0 = C * EB / 4 / NT;
    static_assert(Q_PHI * NT * 8 == N * N && Q_QH * NT * 8 == C * N && Q_PSI * NT * 4 == N * EB && Q_O0 * NT * 4 == C * EB && NCHUNK % 4 == 0, "prefetch split");
    pfv4 rA[4][Q_PHI], rB[4][Q_QH], rC[4][Q_PSI], rD[4][Q_O0];
#define GD_PF_LOAD(st, cn_) do { pf_ld_lin(rA[st], p.gd_Phi + (size_t)(cn_) * N * N, tid); pf_ld_lin(rB[st], p.gd_Qh + (size_t)(cn_) * C * N, tid); \
    pf_ld_rows(rC[st], p.gd_Psi + (size_t)(cn_) * N * N + e0, EB / 4, N, tid); pf_ld_rows(rD[st], p.gd_O0 + (size_t)(cn_) * C * N + e0, EB / 4, N, tid); } while (0)
#define GD_PF_STORE(st) do { pf_st_pad(rA[st], Phi, N / 8, LD, tid); pf_st_pad(rB[st], Qh, N / 8, LD, tid); pf_st_lin(rC[st], Psi, tid); pf_st_lin(rD[st], O0, tid); } while (0)
    const int cn0 = ch * NCHUNK;
    GD_PF_LOAD(0, cn0); GD_PF_LOAD(1, cn0 + 1); GD_PF_LOAD(2, cn0 + 2); GD_PF_LOAD(3, cn0 + 3); GD_PF_STORE(0);
    for (int n0 = 0; n0 < NCHUNK; n0 += 4) {
#pragma unroll
        for (int j = 0; j < 4; ++j) { const int n = n0 + j;
            BLOCK_SYNC();
            if (n + 4 < NCHUNK) GD_PF_LOAD(j, cn0 + n + 4);
            tiles(n);
            BLOCK_SYNC();
            if (n + 1 < NCHUNK) GD_PF_STORE((j + 1) & 3); } }
#undef GD_PF_LOAD
#undef GD_PF_STORE
#endif
}
template <int G> HD void ph_gd_post(const Params& p, int layer, Exec e) {
    constexpr int NI = GD_HEAD / 4 / G;
    static_assert(NI * 4 * G == GD_HEAD, "G");
    const float* ng = p.gd_norm_g + layer * GD_HEAD;
    for (int it = e.gid; it < MROWS * GD_HEADS; it += e.ngroups) {
        const int R = it / GD_HEADS, hh = it % GD_HEADS; const size_t o = (size_t)R * GROUP_W + hh * GD_HEAD, o2 = (size_t)MROWS * GROUP_W;
        F4 y[NI]; float ss = 0.f;
#pragma unroll
        for (int i = 0; i < NI; ++i) { const int c4 = (e.gl + G * i) * 4; y[i] = ld4(p.gd_o + o + c4) + ld4(p.gd_o + o2 + o + c4); ss += hsum(y[i] * y[i]); }
        ss = group_sum<G>(ss); const float rstd = 1.f / sqrtf(ss / GD_HEAD + NORM_EPS);
#pragma unroll
        for (int i = 0; i < NI; ++i) { const int c4 = (e.gl + G * i) * 4; const F4 gg = ld4(p.P + (size_t)R * LDP + GD_OFF + 3 * GROUP_W + hh * GD_HEAD + c4);
            const F4 sg = F4{siluf_(gg.x), siluf_(gg.y), siluf_(gg.z), siluf_(gg.w)};
            st4bf(p.mix + (size_t)R * D_MODEL + 2 * GROUP_W + hh * GD_HEAD + c4, y[i] * rstd * ld4(ng + c4) * sg); }
    }
}

template <int G> HD void ph_at_prep(const Params& p, int layer, Exec e) {
    constexpr int NHS = AT_QH + 2 * AT_KVH, HALF = AT_HEAD / 2, QTR = AT_HEAD / 4, NI = AT_HEAD / 4 / G;
    static_assert(NI * 4 * G == AT_HEAD && QTR % 4 == 0, "G");
    for (int it = e.gid; it < MROWS * NHS; it += e.ngroups) {
        int gl = e.gl; OPAQUE_I(gl);
        const int R = it / NHS, hs = it % NHS, b = row_b(R), sx = row_s(R);
        const float* pr = p.P + (size_t)R * LDP + AT_OFF + hs * AT_HEAD;
        u16* dst; const float* g = nullptr;
        if (hs < AT_QH) { dst = p.at_q + (((size_t)b * AT_QH + hs) * TOK + sx) * AT_HEAD; g = p.at_q_norm + layer * AT_HEAD; }
        else if (hs < AT_QH + AT_KVH) { dst = p.at_k + (((size_t)b * AT_KVH + hs - AT_QH) * TOK + sx) * AT_HEAD; g = p.at_k_norm + layer * AT_HEAD; }
        else dst = p.at_v + (((size_t)b * AT_KVH + hs - AT_QH - AT_KVH) * TOK + sx) * AT_HEAD;
        F4 x[NI]; float ss = 0.f;
#pragma unroll
        for (int i = 0; i < NI; ++i) { x[i] = ld4(pr + (gl + G * i) * 4); ss += hsum(x[i] * x[i]); }
        if (!g) {
#pragma unroll
            for (int i = 0; i < NI; ++i) st4bf(dst + (gl + G * i) * 4, x[i]);
            continue; }
        ss = group_sum<G>(ss); const float rstd = 1.f / sqrtf(ss / AT_HEAD + NORM_EPS);
        if (sx < CTX) {
#pragma unroll
            for (int i = 0; i < NI; ++i) { const int j = (gl + G * i) * 4; st4bf(dst + j, x[i] * rstd * ld4(g + j)); }
            continue; }
        const int t = sx - CTX; const float posr = (float)(t / GRID_W), posc = (float)(t % GRID_W);
#pragma unroll
        for (int i = 0; i < NI; ++i) { const int j = (gl + G * i) * 4, half = j / HALF, jj = j % HALF, fi = jj % QTR; const bool second = jj >= QTR;
            const int jp = second ? j - QTR : j + QTR; const float pos = half ? posc : posr;
            const F4 own = x[i] * rstd * ld4(g + j), oth = ld4(pr + jp) * rstd * ld4(g + jp);
            float cs[4], sn[4];
#pragma unroll
            for (int q = 0; q < 4; ++q) sincosf(pos * exp2f(-(float)(2 * (fi + q)) * (13.287712379549449f / (float)HALF)), &sn[q], &cs[q]);
            const F4 c4v = F4{cs[0], cs[1], cs[2], cs[3]}, s4v = F4{sn[0], sn[1], sn[2], sn[3]};
            st4bf(dst + j, second ? own * c4v + oth * s4v : own * c4v - oth * s4v); }
    }
}

#include <cstdio>
#include <cstddef>
static_assert(D_MODEL == 2048 && CTX == 256 && SEQ % 256 == 0 && AT_HEAD == 128, "GPU part is written for the full configuration");
static_assert(RW_C3_SMEM <= 147392 && TS_SMEM <= 147392 && RW_S2_SMEM <= 147392 && RW_C1_SMEM <= 147392 && GD_C3_SMEM <= 147392 && GD_S2_SMEM <= 147392 && ML_C1_SMEM <= 147392 && ML_C2_SMEM <= 147392, "LDS");
static_assert(CHUNK == RW_N && GD_N * CHUNK * 2 == CHUNK * CHUNK * 4, "buffer aliasing (Y0 on Ma, Qh on A)");

#define XB_TMO      128
#define XB_XCNT(j)  (256  + 64 * (j))
#define XB_XSUB(j)  (1280 + 64 * (j))
#define XB_XGEN(j)  (2304 + 64 * (j))
#define XB_TOP      3328
#define XB_TOPGEN   3392
#define XCD_BAR_WORDS 3456
#define XB_SPIN_CAP (1u << 24)
#define LAS __attribute__((address_space(3)))
__device__ __forceinline__ unsigned xb_ld(unsigned* p)              { return __hip_atomic_load(p, __ATOMIC_RELAXED, __HIP_MEMORY_SCOPE_AGENT); }
__device__ __forceinline__ unsigned xb_add(unsigned* p, unsigned v) { return __hip_atomic_fetch_add(p, v, __ATOMIC_RELAXED, __HIP_MEMORY_SCOPE_AGENT); }
__device__ __forceinline__ unsigned xb_xcc_id() { return (unsigned)__builtin_amdgcn_s_getreg((3 << 11) | 20) & 0xFu; }
#define XB_SPIN(cond, bar) do { unsigned _sp = 0; while (cond) { __builtin_amdgcn_s_sleep(1); \
    if ((++_sp & 255u) == 0u) { if (xb_ld(&(bar)[XB_TMO])) break; if (_sp > XB_SPIN_CAP) { atomicAdd(&(bar)[XB_TMO], 1u); break; } } } } while (0)
struct XcdBarrier { unsigned* bar; unsigned x; volatile LAS unsigned* st; };
__device__ __forceinline__ XcdBarrier xcd_barrier_post(unsigned* bar, volatile LAS unsigned* st) {
    XcdBarrier b; b.bar = bar; b.x = xb_xcc_id(); b.st = st;
    if (threadIdx.x == 0) (void)xb_add(&bar[XB_XCNT(b.x)], 1u);
    return b;
}
__device__ __forceinline__ void xcd_barrier_complete(unsigned* bar, unsigned x, unsigned& nloc, unsigned& nx) {
    const unsigned G = gridDim.x * gridDim.y * gridDim.z;
    unsigned sum, cnt, mine, sp = 0u;
    for (;;) {
        sum = 0u; cnt = 0u; mine = 0u;
#pragma unroll
        for (unsigned j = 0; j < 16; ++j) { const unsigned c = xb_ld(&bar[XB_XCNT(j)]); sum += c; cnt += (c > 0u) ? 1u : 0u; mine = (j == x) ? c : mine; }
        if (sum == G) break;
        __builtin_amdgcn_s_sleep(1);
        if ((++sp & 255u) == 0u) { if (xb_ld(&bar[XB_TMO])) break; if (sp > XB_SPIN_CAP) { atomicAdd(&bar[XB_TMO], 1u); break; } }
    }
    nloc = mine > 0u ? mine : 1u; nx = cnt > 0u ? cnt : 1u;
}
__device__ __forceinline__ void xcd_barrier(const XcdBarrier& b) {
    asm volatile("s_waitcnt vmcnt(0)" ::: "memory");
    __syncthreads();
    if (threadIdx.x == 0) {
        unsigned* bar = b.bar;
        __builtin_amdgcn_s_waitcnt(0);
        unsigned nloc = b.st[0], nx = b.st[1];
        if (nloc == 0u) { xcd_barrier_complete(bar, b.x, nloc, nx); b.st[0] = nloc; b.st[1] = nx; }
        const unsigned old = xb_add(&bar[XB_XSUB(b.x)], 1u);
        const unsigned gen = old / nloc;
        if (old + 1u == (gen + 1u) * nloc) {
            __builtin_amdgcn_fence(__ATOMIC_RELEASE, "agent");
            asm volatile("s_waitcnt vmcnt(0)" ::: "memory");
            const unsigned og = xb_add(&bar[XB_TOP], 1u);
            const unsigned tg = og / nx;
            if (og + 1u == (tg + 1u) * nx) xb_add(&bar[XB_TOPGEN], 1u);
            else XB_SPIN(xb_ld(&bar[XB_TOPGEN]) == tg, bar);
            __builtin_amdgcn_fence(__ATOMIC_ACQUIRE, "agent");
            xb_add(&bar[XB_XGEN(b.x)], 1u);
            asm volatile("s_waitcnt vmcnt(0)" ::: "memory");
        } else {
            XB_SPIN(xb_ld(&bar[XB_XGEN(b.x)]) == gen, bar);
            __builtin_amdgcn_fence(__ATOMIC_ACQUIRE, "agent");
            asm volatile("s_waitcnt vmcnt(0)" ::: "memory");
        }
    }
    __syncthreads();
}

namespace pg8 {
#define PG8_LAS __attribute__((address_space(3)))
typedef unsigned short bf16_t;
typedef short bf16x8 __attribute__((ext_vector_type(8)));
typedef float f32x4 __attribute__((ext_vector_type(4)));
typedef unsigned u32x4 __attribute__((ext_vector_type(4)));
constexpr int BM = 256, BK = 64, HALF = 128, HTB = HALF * BK * 2  , STAGE_BYTES = 8 * HTB, NXCD = 8, WGM = 8;

__host__ __device__ __forceinline__ int lds_byte(int r, int c) { const int st = (r >> 4) * 2 + (c >> 5), rr = r & 15, cc = c & 31, ob = rr * 64 + cc * 2; return st * 1024 + (ob ^ (((ob >> 9) & 1) << 5)); }
__host__ __device__ __forceinline__ void stage_rc(int b, int& R, int& C) { const int st = b / 1024, sb = b % 1024, swz = sb ^ (((sb >> 9) & 1) << 5); R = (st >> 1) * 16 + swz / 64; C = (st & 1) * 32 + (swz % 64) / 2; }
__host__ __device__ __forceinline__ int perm32(int rho) { const int n = rho >> 4, i = rho & 15; return 8 * (i >> 2) + 4 * n + (i & 3); }

struct Unit { int pm, pn; };
struct Gemm { const bf16_t* A; const bf16_t* Bt; int M, N, K; };

struct StaticOrder {
    int nM, nN, nwg, G, c;
    __host__ __device__ void init(int M, int N, int G_, int c_) { nM = M / BM; nN = N / BM; nwg = nM * nN; G = G_; c = c_; }
    __host__ __device__ bool next(int i, Unit& u) const {
        const long L = (long)i * G + c; if (L >= nwg) return false;
        int wgid = (int)L; { const int q = nwg / NXCD, r = nwg % NXCD, xcd = wgid % NXCD, off = wgid / NXCD; wgid = (xcd < r ? xcd * (q + 1) : r * (q + 1) + (xcd - r) * q) + off; }
        const int nig = WGM * nN, gid = wgid / nig, fm = gid * WGM, gsz = (nM - fm) < WGM ? (nM - fm) : WGM;
        u.pm = fm + ((wgid % nig) % gsz); u.pn = (wgid % nig) / gsz; return true;
    }
    __device__ __forceinline__ void a_ready(const Unit&) const {}
    __device__ __forceinline__ void done(const Unit&) const {}
};
__device__ __forceinline__ unsigned cvt_pk_bf16(float lo, float hi) { unsigned r; asm volatile("v_cvt_pk_bf16_f32 %0, %1, %2" : "=v"(r) : "v"(lo), "v"(hi)); return r; }
typedef unsigned u32x2v __attribute__((ext_vector_type(2)));

struct TileOrder {
    int nI, nJ, nwg, G, c, latent_only;
    __device__ void init(int nI_, int nJ_, int G_, int c_, int lat) { nI = nI_; nJ = nJ_; nwg = nI * nJ; G = G_; c = c_; latent_only = lat; }
    __device__ bool next(int i, Unit& u) const { const long L = (long)i * G + c; if (L >= nwg) return false;
        const int ii = (int)(L % nI), j = (int)(L / nI); u.pm = latent_only ? (ii / (SEQ / 256)) * (TOK / 256) + 1 + ii % (SEQ / 256) : ii; u.pn = j; return true; }
    __device__ __forceinline__ void a_ready(const Unit&) const {}
    __device__ __forceinline__ void done(const Unit&) const {}
};
struct GroupedOrder {
    int nI, nJ, tilesA, nwg, G, c;
    __device__ void init(int nI_, int nJ_, int tilesA_, int G_, int c_) { nI = nI_; nJ = nJ_; tilesA = tilesA_; nwg = NE * nI * nJ; G = G_; c = c_; }
    __device__ bool next(int i, Unit& u) const { const long L = (long)i * G + c; if (L >= nwg) return false;
        const int e = (int)(L / (nI * nJ)), r = (int)(L % (nI * nJ)), j = r / nI, ii = r % nI; u.pm = e * tilesA + ii; u.pn = e * nJ + j; return true; }
    __device__ __forceinline__ void a_ready(const Unit&) const {}
    __device__ __forceinline__ void done(const Unit&) const {}
};

struct EpiF32 {
    static constexpr bool PERM = false, AFTER_DRAIN = false;
    float* C; int ldc;
    __device__ __forceinline__ void operator()(const f32x4 (&acc)[2][2][4][2], const Unit& u, int wr, int wc, int fr, int fq) const {
        const int row0 = u.pm * BM + wr * 64 + fr, col0 = u.pn * BM + wc * 32 + 4 * fq;
#pragma unroll
        for (int ai = 0; ai < 2; ++ai)
#pragma unroll
            for (int m = 0; m < 4; ++m) { float* rowp = C + (size_t)(row0 + ai * HALF + m * 16) * ldc + col0;
#pragma unroll
                for (int bj = 0; bj < 2; ++bj)
#pragma unroll
                    for (int n = 0; n < 2; ++n) *(f32x4*)(rowp + bj * HALF + n * 16) = acc[ai][bj][m][n]; }
    }
};
struct EpiResid {
    static constexpr bool PERM = false, AFTER_DRAIN = false;
    float* X; const float* modl;
    __device__ __forceinline__ void operator()(const f32x4 (&acc)[2][2][4][2], const Unit& u, int wr, int wc, int fr, int fq) const {
        const int row0 = u.pm * BM + wr * 64 + fr, col0 = u.pn * BM + wc * 32 + 4 * fq;
        const int tb = TOK / 256, sel = (u.pm % tb == 0) ? 2 : u.pm / tb;
        const float* gate = modl + ((size_t)sel * 6 + 2) * D_MODEL + col0;
        f32x4 gv[2][2];
#pragma unroll
        for (int bj = 0; bj < 2; ++bj)
#pragma unroll
            for (int n = 0; n < 2; ++n) gv[bj][n] = *(const f32x4*)(gate + bj * HALF + n * 16);
#pragma unroll
        for (int ai = 0; ai < 2; ++ai)
#pragma unroll
            for (int m = 0; m < 4; ++m) { float* rowp = X + (size_t)(row0 + ai * HALF + m * 16) * D_MODEL + col0;
#pragma unroll
                for (int bj = 0; bj < 2; ++bj)
#pragma unroll
                    for (int n = 0; n < 2; ++n) { f32x4* q = (f32x4*)(rowp + bj * HALF + n * 16); *q = *q + gv[bj][n] * acc[ai][bj][m][n]; } }
    }
};
struct EpiSwiGLU {
    static constexpr bool PERM = false, AFTER_DRAIN = false;
    bf16_t* H; int nJ;
    __device__ __forceinline__ void operator()(const f32x4 (&acc)[2][2][4][2], const Unit& u, int wr, int wc, int fr, int fq) const {
        const int row0 = u.pm * BM + wr * 64 + fr, col0 = (u.pn % nJ) * HALF + wc * 32 + 4 * fq;
#pragma unroll
        for (int ai = 0; ai < 2; ++ai)
#pragma unroll
            for (int m = 0; m < 4; ++m) { bf16_t* rowp = H + (size_t)(row0 + ai * HALF + m * 16) * D_MODEL + col0;
#pragma unroll
                for (int n = 0; n < 2; ++n) { const f32x4 a = acc[ai][0][m][n], b = acc[ai][1][m][n]; float o[4];
#pragma unroll
                    for (int q = 0; q < 4; ++q) o[q] = a[q] / (1.f + __expf(-a[q])) * b[q];
                    u32x2v w; w.x = cvt_pk_bf16(o[0], o[1]); w.y = cvt_pk_bf16(o[2], o[3]); *(u32x2v*)(rowp + n * 16) = w; } }
    }
};
struct EpiGate {
    static constexpr bool PERM = false, AFTER_DRAIN = false;
    float* Y; const float* gate; int nJ;
    __device__ __forceinline__ void operator()(const f32x4 (&acc)[2][2][4][2], const Unit& u, int wr, int wc, int fr, int fq) const {
        const int row0 = u.pm * BM + wr * 64 + fr, col0 = (u.pn % nJ) * BM + wc * 32 + 4 * fq;
#pragma unroll
        for (int ai = 0; ai < 2; ++ai)
#pragma unroll
            for (int m = 0; m < 4; ++m) { const int r = row0 + ai * HALF + m * 16; const float gt = gate[r]; float* rowp = Y + (size_t)r * D_MODEL + col0;
#pragma unroll
                for (int bj = 0; bj < 2; ++bj)
#pragma unroll
                    for (int n = 0; n < 2; ++n) *(f32x4*)(rowp + bj * HALF + n * 16) = acc[ai][bj][m][n] * gt; }
    }
};
template <class Epi, class Sched>
__device__ __forceinline__ void gemm_phase(PG8_LAS unsigned char* lds, const Gemm g, const Sched& S, const Epi& E) {
    const int tid = threadIdx.x, wid = __builtin_amdgcn_readfirstlane(tid >> 6), lane = tid & 63, wr = wid >> 2, wc = wid & 3, fr = lane & 15, fq = lane >> 4;
    const int K = g.K, nt = K / BK;
    unsigned voffA[2], voffB[2];
#pragma unroll
    for (int i = 0; i < 2; ++i) { int R, C; stage_rc(tid * 16 + i * 8192, R, C); const int Rb = Epi::PERM ? ((R & ~31) + perm32(R & 31)) : R;
        voffA[i] = (unsigned)(R * K + C) * 2u; voffB[i] = (unsigned)(Rb * K + C) * 2u; }
    const size_t kstep = (size_t)(BK * 2);
    const size_t hstep = (size_t)HALF * K * 2;
    const size_t tstep = 2 * hstep;
    const unsigned ldsw = (unsigned)wid * 1024u;
    const int aoff = lds_byte(wr * 64 + fr, fq * 8), boff = lds_byte(wc * 32 + fr, fq * 8);
#define PG8_SA(b, h) (((b) * 2 + (h)) * HTB)
#define PG8_SB(b, h) ((4 + (b) * 2 + (h)) * HTB)
#define PG8_STAGE(bufoff, gbase, voff) do { _Pragma("unroll") for (int _i = 0; _i < 2; ++_i) \
        __builtin_amdgcn_global_load_lds((const unsigned*)((const char*)(gbase) + (voff)[_i]), (PG8_LAS unsigned*)(lds + (bufoff) + ldsw + _i * 8192), 16, 0, 0); } while (0)
#define PG8_LDA(dst, b, h) do { _Pragma("unroll") for (int m = 0; m < 4; ++m) _Pragma("unroll") for (int k = 0; k < 2; ++k) dst[m][k] = *(const PG8_LAS bf16x8*)(lds + PG8_SA(b, h) + aoff + m * 2048 + k * 1024); } while (0)
#define PG8_LDB(dst, b, h) do { _Pragma("unroll") for (int n = 0; n < 2; ++n) _Pragma("unroll") for (int k = 0; k < 2; ++k) dst[n][k] = *(const PG8_LAS bf16x8*)(lds + PG8_SB(b, h) + boff + n * 2048 + k * 1024); } while (0)
#define PG8_MMA(ai, bj, At, Bt) do { __builtin_amdgcn_s_setprio(1); _Pragma("unroll") for (int m = 0; m < 4; ++m) _Pragma("unroll") for (int n = 0; n < 2; ++n) _Pragma("unroll") for (int k = 0; k < 2; ++k) \
        acc[ai][bj][m][n] = __builtin_amdgcn_mfma_f32_16x16x32_bf16(Bt[n][k], At[m][k], acc[ai][bj][m][n], 0, 0, 0); __builtin_amdgcn_s_setprio(0); } while (0)
#define PG8_WAIT_V(n) asm volatile("s_waitcnt vmcnt(" #n ")" ::: "memory")
#define PG8_WAIT_L(n) asm volatile("s_waitcnt lgkmcnt(" #n ")" ::: "memory")
#define PG8_BAR __builtin_amdgcn_s_barrier()
#define PG8_SCHED __builtin_amdgcn_sched_barrier(0)
    Unit cur, nxt; int ui = 0;
    if (!S.next(0, cur)) return;
    f32x4 acc[2][2][4][2];
#pragma unroll
    for (int a = 0; a < 2; ++a)
#pragma unroll
        for (int b = 0; b < 2; ++b)
#pragma unroll
            for (int m = 0; m < 4; ++m)
#pragma unroll
                for (int n = 0; n < 2; ++n) acc[a][b][m][n] = (f32x4){0.f, 0.f, 0.f, 0.f};
    bf16x8 At[4][2], B0[2][2], B1[2][2];
    const char* cA = (const char*)g.A + (size_t)cur.pm * tstep; const char* cB = (const char*)g.Bt + (size_t)cur.pn * tstep;
    S.a_ready(cur);
    PG8_STAGE(PG8_SB(0, 0), cB, voffB); PG8_STAGE(PG8_SA(0, 0), cA, voffA); PG8_STAGE(PG8_SB(0, 1), cB + hstep, voffB); PG8_STAGE(PG8_SA(0, 1), cA + hstep, voffA);
    if (wr == 1) PG8_BAR;
    PG8_WAIT_V(4); PG8_BAR;
    PG8_STAGE(PG8_SB(1, 0), cB + kstep, voffB); PG8_STAGE(PG8_SA(1, 0), cA + kstep, voffA); PG8_STAGE(PG8_SB(1, 1), cB + hstep + kstep, voffB);
    PG8_WAIT_V(6); PG8_BAR;
    for (;;) {
        const bool has_next = S.next(ui + 1, nxt);
        const char* nA = has_next ? (const char*)g.A + (size_t)nxt.pm * tstep : cA; const char* nB = has_next ? (const char*)g.Bt + (size_t)nxt.pn * tstep : cB;
        for (int t = 0; t < nt; t += 2) {
            const bool last = (t == nt - 2);
            const char* a1 = cA + (size_t)(t + 1) * kstep;
            const char* a2 = last ? nA : cA + (size_t)(t + 2) * kstep; const char* b2 = last ? nB : cB + (size_t)(t + 2) * kstep;
            const char* a3 = a2 + kstep; const char* b3 = b2 + kstep;
            if (last && has_next) S.a_ready(nxt);
            PG8_LDB(B0, 0, 0); PG8_SCHED; PG8_LDA(At, 0, 0); PG8_STAGE(PG8_SA(1, 1), a1 + hstep, voffA);
            PG8_WAIT_L(8); PG8_BAR; PG8_WAIT_L(0); PG8_MMA(0, 0, At, B0); PG8_BAR; PG8_SCHED;
            PG8_LDB(B1, 0, 1); PG8_STAGE(PG8_SB(0, 0), b2, voffB);
            PG8_BAR; PG8_WAIT_L(0); PG8_MMA(0, 1, At, B1); PG8_BAR;
            PG8_LDA(At, 0, 1); PG8_STAGE(PG8_SA(0, 0), a2, voffA);
            PG8_BAR; PG8_WAIT_L(0); PG8_MMA(1, 0, At, B0); PG8_BAR; PG8_SCHED;
            PG8_STAGE(PG8_SB(0, 1), b2 + hstep, voffB);
            PG8_WAIT_V(6); PG8_BAR; PG8_MMA(1, 1, At, B1); PG8_BAR;
            PG8_LDB(B0, 1, 0); PG8_SCHED; PG8_LDA(At, 1, 0); PG8_STAGE(PG8_SA(0, 1), a2 + hstep, voffA);
            PG8_WAIT_L(8); PG8_BAR; PG8_WAIT_L(0); PG8_MMA(0, 0, At, B0); PG8_BAR; PG8_SCHED;
            PG8_LDB(B1, 1, 1); PG8_STAGE(PG8_SB(1, 0), b3, voffB);
            PG8_BAR; PG8_WAIT_L(0); PG8_MMA(0, 1, At, B1); PG8_BAR;
            PG8_LDA(At, 1, 1); PG8_STAGE(PG8_SA(1, 0), a3, voffA);
            PG8_BAR; PG8_WAIT_L(0); PG8_MMA(1, 0, At, B0); PG8_BAR; PG8_SCHED;
            PG8_STAGE(PG8_SB(1, 1), b3 + hstep, voffB);
            PG8_WAIT_V(6); PG8_BAR; PG8_MMA(1, 1, At, B1); PG8_BAR;
        }
        if constexpr (!Epi::AFTER_DRAIN) { E(acc, cur, wr, wc, fr, fq); S.done(cur); }
        if (!has_next) break;
#pragma unroll
        for (int a = 0; a < 2; ++a)
#pragma unroll
            for (int b = 0; b < 2; ++b)
#pragma unroll
                for (int m = 0; m < 4; ++m)
#pragma unroll
                    for (int n = 0; n < 2; ++n) acc[a][b][m][n] = (f32x4){0.f, 0.f, 0.f, 0.f};
        cur = nxt; cA = nA; cB = nB; ++ui;
    }
    PG8_WAIT_V(0);
    if (wr == 0) PG8_BAR;
    PG8_BAR;
    if constexpr (Epi::AFTER_DRAIN) { E.fused(acc, cur, wr, wc, fr, fq, lds, wid, lane); S.done(cur); }
#undef PG8_SA
#undef PG8_SB
#undef PG8_STAGE
#undef PG8_LDA
#undef PG8_LDB
#undef PG8_MMA
#undef PG8_WAIT_V
#undef PG8_WAIT_L
#undef PG8_BAR
#undef PG8_SCHED
}
}


namespace att {
using bf16 = unsigned short;
constexpr int   D = 128, NW = 8, QBLK = 32, KVBLK = 64;
constexpr float SCALE = 0.088388347648318440f;
constexpr float THR = 8.f;
constexpr int SDEPTH = 2;
constexpr int LDQ = 128, LDK = 128, LDO = D_MODEL;
constexpr size_t SHM_V = KVBLK * D * 2, SHM_K = KVBLK * D * 2, SHM_ATTN = 2 * SHM_V + 2 * SHM_K + NW * 64 * 4;
using bf16x8 = __attribute__((ext_vector_type(8))) short;
using s16x4  = __attribute__((ext_vector_type(4))) short;
using f32x16 = __attribute__((ext_vector_type(16))) float;
using f32x8  = __attribute__((ext_vector_type(8))) float;
using u32x4  = __attribute__((ext_vector_type(4))) unsigned;
#define KSWZ(row, colB) ((row) * 256 + ((colB) ^ (((row) & 7) << 4)))
#define SBAR() __builtin_amdgcn_sched_barrier(0)
__device__ __forceinline__ int crow(int r, int hi) { return (r & 3) + 8 * (r >> 2) + 4 * hi; }
__device__ __forceinline__ unsigned cvtpk(float lo, float hi) {
  unsigned r; asm volatile("v_cvt_pk_bf16_f32 %0, %1, %2" : "=v"(r) : "v"(lo), "v"(hi)); return r;
}
template <typename TIn> struct Stage;
template <> struct Stage<bf16>  { using T = bf16x8;
  __device__ static __forceinline__ T ld8(const bf16* p) { return *reinterpret_cast<const bf16x8*>(p); }
  __device__ static __forceinline__ bf16x8 tobf(T x) { return x; } };
template <> struct Stage<float> { using T = f32x8;
  __device__ static __forceinline__ T ld8(const float* p) { return *reinterpret_cast<const f32x8*>(p); }
  __device__ static __forceinline__ bf16x8 tobf(T x) {
    u32x4 w = {cvtpk(x[0], x[1]), cvtpk(x[2], x[3]), cvtpk(x[4], x[5]), cvtpk(x[6], x[7])}; return *reinterpret_cast<bf16x8*>(&w); } };

__device__ __forceinline__ void partialSM(f32x16& p0, f32x16& p1, float& m_reg, float& mn, float& alpha) {
  constexpr float C = SCALE * 1.4426950408889634f;
  float pmax = p0[0]; for (int r = 1; r < 16; ++r) pmax = fmaxf(pmax, p0[r]); for (int r = 0; r < 16; ++r) pmax = fmaxf(pmax, p1[r]);
  { auto rr = __builtin_amdgcn_permlane32_swap(__float_as_uint(pmax), __float_as_uint(pmax), false, false);
    pmax = fmaxf(__uint_as_float(rr[0]), __uint_as_float(rr[1])); }
  if (__builtin_expect(__all(pmax - m_reg <= THR / SCALE), 1)) { mn = m_reg; alpha = 1.f; }
  else { mn = fmaxf(m_reg, pmax); alpha = __builtin_amdgcn_exp2f((m_reg - mn) * C); m_reg = mn; }
  float mnC = -mn * C;
  for (int r = 0; r < 16; ++r) p0[r] = fmaf(p0[r], C, mnC); for (int r = 0; r < 16; ++r) p1[r] = fmaf(p1[r], C, mnC);
  for (int r = 0; r < 16; ++r) p0[r] = __builtin_amdgcn_exp2f(p0[r]);
}
__device__ __forceinline__ void finishSM(f32x16& p0, f32x16& p1, float alpha, float& l_reg, bf16x8& pa0, bf16x8& pa1, bf16x8& pa2, bf16x8& pa3) {
  for (int r = 0; r < 16; ++r) p1[r] = __builtin_amdgcn_exp2f(p1[r]);
  float ps = 0; for (int r = 0; r < 16; ++r) ps += p0[r]; for (int r = 0; r < 16; ++r) ps += p1[r];
  { auto rr = __builtin_amdgcn_permlane32_swap(__float_as_uint(ps), __float_as_uint(ps), false, false);
    ps = __uint_as_float(rr[0]) + __uint_as_float(rr[1]); }
  l_reg = l_reg * alpha + ps;
#define PK4(P, BASE, OUT) do { unsigned a0 = cvtpk(P[BASE + 0], P[BASE + 1]), a1 = cvtpk(P[BASE + 2], P[BASE + 3]);   \
    unsigned b0 = cvtpk(P[BASE + 4], P[BASE + 5]), b1 = cvtpk(P[BASE + 6], P[BASE + 7]);                              \
    auto r0 = __builtin_amdgcn_permlane32_swap(a0, b0, false, false); auto r1 = __builtin_amdgcn_permlane32_swap(a1, b1, false, false); \
    u32x4 w = {r0[0], r1[0], r0[1], r1[1]}; OUT = *reinterpret_cast<bf16x8*>(&w); } while (0)
  PK4(p0, 0, pa0); PK4(p0, 8, pa1); PK4(p1, 0, pa2); PK4(p1, 8, pa3);
#undef PK4
}
__device__ __forceinline__ void qkt(f32x16& p0, f32x16& p1, const bf16* Ks, const bf16x8* qr, int r32, int hi) {
  p0 = f32x16{}; p1 = f32x16{};
  for (int d0 = 0; d0 < 8; ++d0) { int cb = (d0 * 16 + hi * 8) * 2;
    bf16x8 b0 = *reinterpret_cast<const bf16x8*>((const char*)Ks + KSWZ(r32, cb));
    bf16x8 b1 = *reinterpret_cast<const bf16x8*>((const char*)Ks + KSWZ(32 + r32, cb));
    p0 = __builtin_amdgcn_mfma_f32_32x32x16_bf16(b0, qr[d0], p0, 0, 0, 0);
    p1 = __builtin_amdgcn_mfma_f32_32x32x16_bf16(b1, qr[d0], p1, 0, 0, 0); }
}
__device__ __forceinline__ int v_st(int k, int c) { const int kk = (k & ~0xC) | ((k & 4) << 1) | ((k & 8) >> 1); return ((kk >> 3) * 4 + (c >> 5)) * 512 + ((kk & 7) * 32 + (c & 31)) * 2; }
__device__ __forceinline__ int v_rd_base(int lane) { return ((lane & 3) << 3) | (((lane >> 2) & 3) << 6) | (((lane >> 4) & 1) << 5) | (((lane >> 5) & 1) << 8); }
constexpr int v_rd_off(int d0, int ks, int half) { return d0 * 512 + ks * 4096 + half * 2048; }
template <int OFF> __device__ __forceinline__ s16x4 tr_read(int vb) {
  s16x4 r; asm volatile("ds_read_b64_tr_b16 %0, %1 offset:%2" : "=&v"(r) : "v"(vb), "i"(OFF) : "memory"); return r;
}
template <int D0> __device__ __forceinline__ void pv_one(f32x16& od, int vb, bf16x8 pa0, bf16x8 pa1, bf16x8 pa2, bf16x8 pa3) {
  const s16x4 l0 = tr_read<v_rd_off(D0, 0, 0)>(vb), h0 = tr_read<v_rd_off(D0, 0, 1)>(vb), l1 = tr_read<v_rd_off(D0, 1, 0)>(vb), h1 = tr_read<v_rd_off(D0, 1, 1)>(vb);
  const s16x4 l2 = tr_read<v_rd_off(D0, 2, 0)>(vb), h2 = tr_read<v_rd_off(D0, 2, 1)>(vb), l3 = tr_read<v_rd_off(D0, 3, 0)>(vb), h3 = tr_read<v_rd_off(D0, 3, 1)>(vb);
  asm volatile("s_waitcnt lgkmcnt(0)" ::: "memory"); SBAR();
#define PK(L, H) (bf16x8){L[0], L[1], L[2], L[3], H[0], H[1], H[2], H[3]}
  od = __builtin_amdgcn_mfma_f32_32x32x16_bf16(pa0, PK(l0, h0), od, 0, 0, 0);
  od = __builtin_amdgcn_mfma_f32_32x32x16_bf16(pa1, PK(l1, h1), od, 0, 0, 0);
  od = __builtin_amdgcn_mfma_f32_32x32x16_bf16(pa2, PK(l2, h2), od, 0, 0, 0);
  od = __builtin_amdgcn_mfma_f32_32x32x16_bf16(pa3, PK(l3, h3), od, 0, 0, 0);
#undef PK
}
__device__ __forceinline__ void pv_d0(f32x16* o, int vb, bf16x8 pa0, bf16x8 pa1, bf16x8 pa2, bf16x8 pa3) {
  pv_one<0>(o[0], vb, pa0, pa1, pa2, pa3); pv_one<1>(o[1], vb, pa0, pa1, pa2, pa3); pv_one<2>(o[2], vb, pa0, pa1, pa2, pa3); pv_one<3>(o[3], vb, pa0, pa1, pa2, pa3);
}

__device__ __forceinline__ void attn_dense_body(const bf16* __restrict__ Qb, const bf16* __restrict__ Kh, const bf16* __restrict__ Vh,
                                                unsigned short* __restrict__ Ob, int seq, char* lds) {
  using St = Stage<bf16>; using SQ = Stage<bf16>; using TQ = bf16;
  const int tid = threadIdx.x, wid = tid >> 6, lane = tid & 63, r32 = lane & 31, hi = lane >> 5;
  bf16* V_lds = (bf16*)lds; bf16* K_lds = (bf16*)(lds + 2 * SHM_V);
  float* ws = (float*)(lds + 2 * SHM_V + 2 * SHM_K) + wid * 64; float* li_l = ws; float* al_l = ws + 32;
  float m_reg = -1e30f, l_reg = 0; f32x16 o[4] = {}; bf16x8 qr[8];
  const TQ* Qw = Qb + (long)(wid * QBLK + r32) * LDQ + hi * 8;
#pragma unroll
  for (int d0 = 0; d0 < 8; ++d0) qr[d0] = SQ::tobf(SQ::ld8(Qw + d0 * 16));
  const int sr = tid >> 4, sc = (tid & 15) * 8, vst0 = v_st(sr, sc), vst1 = v_st(32 + sr, sc);
  const int vb0 = (int)(uintptr_t)V_lds + v_rd_base(lane);
  struct { typename St::T vs0, vs1, ks0, ks1; } sr_[SDEPTH];
#define SLOAD(i, k0) do { sr_[i].vs0 = St::ld8(&Vh[(long)((k0) + sr) * LDK + sc]); sr_[i].vs1 = St::ld8(&Vh[(long)((k0) + 32 + sr) * LDK + sc]); \
    sr_[i].ks0 = St::ld8(&Kh[(long)((k0) + sr) * LDK + sc]); sr_[i].ks1 = St::ld8(&Kh[(long)((k0) + 32 + sr) * LDK + sc]); } while (0)
#define SWRITE(b, i) do { *(bf16x8*)((char*)V_lds + (b) * SHM_V + vst0) = St::tobf(sr_[i].vs0);          \
    *(bf16x8*)((char*)V_lds + (b) * SHM_V + vst1) = St::tobf(sr_[i].vs1); int kc = sc * 2;               \
    *(bf16x8*)((char*)K_lds + (b) * SHM_K + KSWZ(sr, kc)) = St::tobf(sr_[i].ks0);                       \
    *(bf16x8*)((char*)K_lds + (b) * SHM_K + KSWZ(32 + sr, kc)) = St::tobf(sr_[i].ks1); } while (0)
#define SWAIT() do { if constexpr (SDEPTH == 2) asm volatile("s_waitcnt vmcnt(4)" ::: "memory"); else asm volatile("s_waitcnt vmcnt(0)" ::: "memory"); } while (0)
#define RESC(a) do { if (__any((a) < 1.f)) { if (hi == 0) al_l[r32] = (a); asm volatile("s_waitcnt lgkmcnt(0)" ::: "memory"); \
    for (int d = 0; d < 4; ++d) for (int r = 0; r < 16; ++r) o[d][r] *= al_l[crow(r, hi)]; } } while (0)
  f32x16 pA0, pA1, pB0, pB1; float mnA, mnB, alA, alB; bf16x8 pa0, pa1, pa2, pa3; const int NT = seq / KVBLK;
  constexpr int SE = 0, SO = SDEPTH - 1;
  SLOAD(SE, 0); asm volatile("s_waitcnt vmcnt(0)" ::: "memory"); SWRITE(0, SE); __syncthreads();
  qkt(pA0, pA1, K_lds, qr, r32, hi); partialSM(pA0, pA1, m_reg, mnA, alA);
  SLOAD(SO, KVBLK); if constexpr (SDEPTH == 2) { if (2 < NT) SLOAD(SE, 2 * KVBLK); }
  SWAIT(); SWRITE(1, SO); __syncthreads();
  for (int j = 1; j + 1 < NT; j += 2) {
    SBAR(); qkt(pB0, pB1, (bf16*)((char*)K_lds + SHM_K), qr, r32, hi);
    finishSM(pA0, pA1, alA, l_reg, pa0, pa1, pa2, pa3); SBAR();
    SLOAD(SO, (j + SDEPTH) * KVBLK); SBAR();
    pv_d0(o, vb0, pa0, pa1, pa2, pa3); partialSM(pB0, pB1, m_reg, mnB, alB);
    __syncthreads(); SWAIT(); SWRITE(0, SE);
    RESC(alB); __syncthreads();
    SBAR(); qkt(pA0, pA1, K_lds, qr, r32, hi);
    finishSM(pB0, pB1, alB, l_reg, pa0, pa1, pa2, pa3); SBAR();
    if (SDEPTH == 1 || j + 3 < NT) SLOAD(SE, (j + 1 + SDEPTH) * KVBLK); SBAR();
    pv_d0(o, vb0 + (int)SHM_V, pa0, pa1, pa2, pa3); partialSM(pA0, pA1, m_reg, mnA, alA);
    __syncthreads(); SWAIT(); SWRITE(1, SO);
    RESC(alA); __syncthreads();
  }
  SBAR(); qkt(pB0, pB1, (bf16*)((char*)K_lds + SHM_K), qr, r32, hi);
  finishSM(pA0, pA1, alA, l_reg, pa0, pa1, pa2, pa3); SBAR();
  pv_d0(o, vb0, pa0, pa1, pa2, pa3); partialSM(pB0, pB1, m_reg, mnB, alB);
  __syncthreads(); RESC(alB);
  finishSM(pB0, pB1, alB, l_reg, pa0, pa1, pa2, pa3); SBAR();
  pv_d0(o, vb0 + (int)SHM_V, pa0, pa1, pa2, pa3);
  if (hi == 0) li_l[r32] = l_reg; asm volatile("s_waitcnt lgkmcnt(0)" ::: "memory");
  float rli[16];
#pragma unroll
  for (int r = 0; r < 16; ++r) rli[r] = __builtin_amdgcn_rcpf(li_l[crow(r, hi)]);
  unsigned short* Ow = Ob + (long)(wid * QBLK) * LDO;
#pragma unroll
  for (int r = 0; r < 16; ++r) { int orow = crow(r, hi);
    for (int d0 = 0; d0 < 4; ++d0) Ow[(long)orow * LDO + d0 * 32 + r32] = f2bf(o[d0][r] * rli[r]); }
#undef SLOAD
#undef SWRITE
#undef SWAIT
#undef RESC
}
}

__device__ __forceinline__ void cvt_tile(const float* __restrict__ W, int ldw, int nvalid, int k0, int n0, u16* __restrict__ Wt, int rmode, float* lds) {
    typedef float f4 __attribute__((ext_vector_type(4)));
    typedef unsigned u4 __attribute__((ext_vector_type(4)));
    const int tid = threadIdx.x, c4 = (tid & 31) * 4, r0 = tid >> 5;
    f4 v[8];
    const bool ok = (n0 + c4) < nvalid;
#pragma unroll
    for (int i = 0; i < 8; ++i) v[i] = ok ? *(const f4*)(W + (size_t)(k0 + r0 + 16 * i) * ldw + n0 + c4) : (f4){0.f, 0.f, 0.f, 0.f};
#pragma unroll
    for (int i = 0; i < 8; ++i) *(f4*)(lds + (r0 + 16 * i) * 132 + c4) = v[i];
    __syncthreads();
    const int nn = tid & 127, kq = tid >> 7, n = n0 + nn;
    int row = n;
    if (rmode) row = (n >> 7) * 256 + (n & 127) + (rmode == 2 ? 128 : 0);
    u16* dst = Wt + (size_t)row * D_MODEL + k0 + kq * 32;
#pragma unroll
    for (int j = 0; j < 4; ++j) { const float* s = lds + (kq * 32 + j * 8) * 132 + nn; u4 w;
        w.x = pg8::cvt_pk_bf16(s[0], s[132]); w.y = pg8::cvt_pk_bf16(s[2 * 132], s[3 * 132]); w.z = pg8::cvt_pk_bf16(s[4 * 132], s[5 * 132]); w.w = pg8::cvt_pk_bf16(s[6 * 132], s[7 * 132]);
        *(u4*)(dst + j * 8) = w; }
    __syncthreads();
}
__device__ __forceinline__ void ph_convert(const Params& p, float* lds) {
    constexpr int KT = D_MODEL / 128;
    constexpr int T_IN = KT * (LDP / 128), T_OUT = KT * (D_MODEL / 128), T_E = KT * (D_MODEL / 128);
    constexpr int PER_L = T_IN + T_OUT + NE * 3 * T_E, TOTAL = DEPTH * PER_L;
    static_assert(N_IN % 4 == 0 && LDP % 128 == 0, "conversion tiles");
    for (int t = blockIdx.x; t < TOTAL; t += gridDim.x) {
        const int l = t / PER_L; int r = t % PER_L;
        if (r < T_IN) { const int kt = r % KT, nt = r / KT;
            cvt_tile(p.w_in + (size_t)l * D_MODEL * N_IN, N_IN, N_IN, kt * 128, nt * 128, p.wt_in + (size_t)l * LDP * D_MODEL, 0, lds); continue; }
        r -= T_IN;
        if (r < T_OUT) { const int kt = r % KT, nt = r / KT;
            cvt_tile(p.w_out + (size_t)l * D_MODEL * D_MODEL, D_MODEL, D_MODEL, kt * 128, nt * 128, p.wt_out + (size_t)l * D_MODEL * D_MODEL, 0, lds); continue; }
        r -= T_OUT;
        const int e = r / (3 * T_E), which = (r / T_E) % 3, q = r % T_E, kt = q % KT, nt = q / KT;
        const size_t eo = ((size_t)l * NE + e) * D_MODEL * D_MODEL;
        if (which == 0) cvt_tile(p.w_exp1 + eo, D_MODEL, D_MODEL, kt * 128, nt * 128, p.w13t + 2 * eo, 1, lds);
        else if (which == 1) cvt_tile(p.w_exp3 + eo, D_MODEL, D_MODEL, kt * 128, nt * 128, p.w13t + 2 * eo, 2, lds);
        else cvt_tile(p.w_exp2 + eo, D_MODEL, D_MODEL, kt * 128, nt * 128, p.w2t + eo, 0, lds);
    }
}

constexpr int LDS_BYTES = 147456;
constexpr int LDS_MISC = 147392;
constexpr int NPL = 16;
constexpr int NPHASE = 2 + DEPTH * NPL + 1;

struct Args { Params p; int ph_lo, ph_hi, flags, pad; };

template <int G> __device__ __forceinline__ Exec mk_exec() { const int gt = blockIdx.x * 512 + threadIdx.x; return Exec{gt / G, (int)(gridDim.x * 512) / G, gt % G}; }
typedef const __attribute__((address_space(4))) unsigned long long* kq_t;
__device__ __forceinline__ void load_params(Params& p, const __attribute__((address_space(4))) unsigned char* ka) {
    kq_t s = (kq_t)ka; unsigned long long* d = (unsigned long long*)&p;
#pragma unroll
    for (int i = 0; i < (int)(sizeof(Params) / 8); ++i) d[i] = s[i];
}
#define LOADP() Params p; load_params(p, ka)
#define PH(k, ...) do { if (lo <= (k) && (k) < hi) { { LOADP(); __VA_ARGS__; } if ((k) + 1 < hi) xcd_barrier(bar); } } while (0)
#define e1 mk_exec<1>()
#define e16 mk_exec<16>()
#define e64 mk_exec<64>()
#define flds ((float*)lds)
#define glds ((PG8_LAS unsigned char*)lds)
#define G ((int)gridDim.x)
#define c ((int)blockIdx.x)
template <int L> __device__ __forceinline__ void layer_phases(const __attribute__((address_space(4))) unsigned char* ka, int lo, int hi, int flags, const XcdBarrier& bar, unsigned char* lds) {
    constexpr int l = L;
        const int b0 = 2 + l * NPL; const bool last = (l == DEPTH - 1);
        PH(b0 + 0, ph_norm1<64>(p, l, e64));
        PH(b0 + 1, { pg8::Gemm g{p.h, p.wt_in + (size_t)l * LDP * D_MODEL, MROWS, LDP, D_MODEL}; pg8::StaticOrder S; S.init(MROWS, LDP, G, c);
                     pg8::EpiF32 E{p.P, LDP}; pg8::gemm_phase<pg8::EpiF32, pg8::StaticOrder>(glds, g, S, E); });
        PH(b0 + 2, ph_rw_prep1<64>(p, l, e64); ph_ml_g1<64>(p, l, e64); ph_gd_prep<32>(p, l, mk_exec<32>()); ph_gd_gates<64>(p, l, e64); ph_at_prep<32>(p, l, mk_exec<32>()));
        PH(b0 + 3, ph_rw_prep2(p, l, e64); ph_ml_g2(p, e1); ph_gd_c1(p, e64));
        PH(b0 + 4, { for (int u = c; u < RW_CN; u += G) ph_rw_c1_unit(p, u, threadIdx.x, 512, lds); for (int u = G - 1 - c; u < ML_CN; u += G) ph_ml_c1_unit(p, u, threadIdx.x, 512, lds); });
        PH(b0 + 5, { constexpr int NU1 = (RW_CN + TS_G - 1) / TS_G, NU2 = (GD_CN + TS_G - 1) / TS_G;
            if (!(flags & 2)) for (int u = c; u < NU1 + NU2; u += G) { if (u < NU1) ph_tsolve_unit(p.rw_Ma, p.rw_T, RW_CN, u, threadIdx.x, 512, lds); else ph_tsolve_unit(p.gd_A, p.gd_T, GD_CN, u - NU1, threadIdx.x, 512, lds); }
            ph_ml_prefix(p, e1); });
        PH(b0 + 6, {
            const int nlat = BATCH * AT_QH * (SEQ / 256), nctx = last ? 0 : BATCH * AT_QH;
            if (flags & 1) {} else if (c < nlat) { const int u = c;
                const int qb = u % (SEQ / 256), hq = (u / (SEQ / 256)) % AT_QH, b = u / ((SEQ / 256) * AT_QH), s0 = CTX + qb * 256, kvh = hq / (AT_QH / AT_KVH);
                att::attn_dense_body((const att::bf16*)p.at_q + (((size_t)b * AT_QH + hq) * TOK + s0) * AT_HEAD,
                                     (const att::bf16*)p.at_k + ((size_t)b * AT_KVH + kvh) * TOK * AT_HEAD, (const att::bf16*)p.at_v + ((size_t)b * AT_KVH + kvh) * TOK * AT_HEAD,
                                     p.mix + ((size_t)b * TOK + s0) * D_MODEL + 3 * GROUP_W + hq * AT_HEAD, TOK, (char*)lds);
                __syncthreads(); }
            else if (c < nlat + nctx) { const int u = c - nlat;
                const int hq = u % AT_QH, b = u / AT_QH, kvh = hq / (AT_QH / AT_KVH);
                att::attn_dense_body((const att::bf16*)p.at_q + (((size_t)b * AT_QH + hq) * TOK) * AT_HEAD,
                                     (const att::bf16*)p.at_k + ((size_t)b * AT_KVH + kvh) * TOK * AT_HEAD, (const att::bf16*)p.at_v + ((size_t)b * AT_KVH + kvh) * TOK * AT_HEAD,
                                     p.mix + ((size_t)b * TOK) * D_MODEL + 3 * GROUP_W + hq * AT_HEAD, CTX, (char*)lds);
                __syncthreads(); } });
        PH(b0 + 7, { if (!(flags & 4)) for (int u = c; u < RW_CN; u += G) ph_rw_c3_unit(p, u, threadIdx.x, 512, lds);
                     if (!(flags & 8)) for (int u = G - 1 - c; u < GD_CN; u += G) ph_gd_c3_unit(p, u, threadIdx.x, 512, lds);
                     if (!(flags & 64)) for (int u = c; u < ML_CN; u += G) ph_ml_c2_unit(p, u, threadIdx.x, 512, lds); });
        PH(b0 + 8, { if (!(flags & 16)) for (int u = c; u < GD_S2_UNITS; u += G) ph_gd_scan2_unit(p, u, threadIdx.x, 512, lds); }
                   { if (!(flags & 32)) for (int u = G - 1 - c; u < RW_CH; u += G) ph_rw_scan2_unit(p, u, threadIdx.x, 512, lds); });
        PH(b0 + 9, ph_rw_post<16>(p, l, e16); ph_gd_post<16>(p, l, e16); ph_ml_post<16>(p, l, e16));
        PH(b0 + 10, { pg8::Gemm g{p.mix, p.wt_out + (size_t)l * D_MODEL * D_MODEL, MROWS, D_MODEL, D_MODEL}; pg8::TileOrder S;
                      S.init(last ? BATCH * SEQ / 256 : MROWS / 256, D_MODEL / 256, G, c, last ? 1 : 0);
                      pg8::EpiResid E{p.xres, p.mod + (size_t)l * 3 * 6 * D_MODEL}; pg8::gemm_phase<pg8::EpiResid, pg8::TileOrder>(glds, g, S, E); });
        PH(b0 + 11, ph_norm2<64>(p, l, e64));
        PH(b0 + 12, { for (int u = c; u < topk_units(l); u += G) ph_topk_unit(p, l, u, threadIdx.x, 512, lds); });
        PH(b0 + 13, ph_gather<64>(p, l, e64));
        PH(b0 + 14, { pg8::Gemm g{p.xs, p.w13t + (size_t)l * NE * 2 * D_MODEL * D_MODEL, NE * NSLOT, NE * 2 * D_MODEL, D_MODEL}; pg8::GroupedOrder S;
                      S.init(last ? NSLOT_L / 256 : NSLOT / 256, 2 * D_MODEL / 256, NSLOT / 256, G, c);
                      pg8::EpiSwiGLU E{p.hid, 2 * D_MODEL / 256}; pg8::gemm_phase<pg8::EpiSwiGLU, pg8::GroupedOrder>(glds, g, S, E); });
        PH(b0 + 15, { pg8::Gemm g{p.hid, p.w2t + (size_t)l * NE * D_MODEL * D_MODEL, NE * NSLOT, NE * D_MODEL, D_MODEL}; pg8::GroupedOrder S;
                      S.init(last ? NSLOT_L / 256 : NSLOT / 256, D_MODEL / 256, NSLOT / 256, G, c);
                      pg8::EpiGate E{p.yexp, p.sel_gate, D_MODEL / 256}; pg8::gemm_phase<pg8::EpiGate, pg8::GroupedOrder>(glds, g, S, E); });
    }
__global__ void __launch_bounds__(512, 2) mega(Args args) {
    extern __shared__ __attribute__((aligned(16))) unsigned char lds[];
    typedef const __attribute__((address_space(4))) unsigned char* kptr_t;
    const kptr_t ka = (kptr_t)__builtin_amdgcn_kernarg_segment_ptr();
    (void)args;
    const unsigned long long lohi = ((kq_t)ka)[sizeof(Params) / 8]; const int lo = (int)(unsigned)lohi, hi = (int)(unsigned)(lohi >> 32);
    const int flags = (int)(unsigned)((kq_t)ka)[sizeof(Params) / 8 + 1];
    unsigned* barw = (unsigned*)((kq_t)ka)[offsetof(Params, bar) / 8];
    volatile LAS unsigned* misc = (volatile LAS unsigned*)((LAS unsigned char*)lds + LDS_MISC);
    if (threadIdx.x < 4) misc[threadIdx.x] = 0u;
    __syncthreads();
    const bool use_bar = (hi - lo) > 1;
    XcdBarrier bar; bar.bar = barw; bar.x = 0; bar.st = misc;
    if (use_bar) bar = xcd_barrier_post(barw, misc);
    PH(0, ph_convert(p, flds); ph_mod_partial(p, e1); ph_rw_wpack(p, e1));
    PH(1, ph_mod_final(p, e1));
    layer_phases<0>(ka, lo, hi, flags, bar, lds);
    layer_phases<1>(ka, lo, hi, flags, bar, lds);
    static_assert(DEPTH == 2, "depth");
    PH(2 + DEPTH * NPL, ph_final<64>(p, e64));
}
#undef PH
#undef e1
#undef e16
#undef e64
#undef flds
#undef glds
#undef G
#undef c
#undef LOADP

static size_t ws_carve(Params& p, unsigned char* ws) {
    size_t off = 0;
    auto take = [&](size_t bytes) { size_t o = off; off += (bytes + 255) / 256 * 256; return ws ? ws + o : (unsigned char*)nullptr; };
    p.bar = (unsigned*)take(XCD_BAR_WORDS * 4);
    p.modp = (float*)take((size_t)DEPTH * MOD_KS * 3 * 6 * D_MODEL * 4); p.mod = (float*)take((size_t)DEPTH * 3 * 6 * D_MODEL * 4);
    p.wt_in = (u16*)take((size_t)DEPTH * LDP * D_MODEL * 2); p.wt_out = (u16*)take((size_t)DEPTH * D_MODEL * D_MODEL * 2);
    p.w13t = (u16*)take((size_t)DEPTH * NE * 2 * D_MODEL * D_MODEL * 2); p.w2t = (u16*)take((size_t)DEPTH * NE * D_MODEL * D_MODEL * 2);
    p.xres = (float*)take((size_t)MROWS * D_MODEL * 4); p.h = (u16*)take((size_t)MROWS * D_MODEL * 2); p.mix = (u16*)take((size_t)MROWS * D_MODEL * 2);
    p.aff = (float*)take((size_t)MROWS * NE * 4); p.inv = (int*)take((size_t)MROWS * NE * 4);
    p.sel_row = (int*)take((size_t)NE * NSLOT * 4); p.sel_gate = (float*)take((size_t)NE * NSLOT * 4);
    const size_t region = off;
    p.P = (float*)take((size_t)MROWS * LDP * 4);
    const size_t rg = (size_t)MROWS * GROUP_W * 4;
    p.rw_r = (float*)take(rg); p.rw_k = (float*)take(rg); p.rw_v = (float*)take(rg); p.rw_kk = (float*)take(rg); p.rw_g = (float*)take(rg);
    p.rw_lr = (float*)take((size_t)MROWS * RW_LR * 4);
    p.rw_ew = (float*)take(2 * rg); p.rw_kka = (float*)take(2 * rg); p.rw_kt = (float*)take(2 * rg); p.rw_y = (float*)take(2 * rg);
    p.rw_Ma = (float*)take((size_t)RW_CN * CHUNK * CHUNK * 4); p.rw_T = (float*)take((size_t)RW_CN * CHUNK * CHUNK * 4);
    p.rw_Psi = (float*)take((size_t)RW_CN * RW_N * RW_N * 4); p.rw_Y0 = p.rw_Ma;
    p.rw_PhiT = (u16*)take((size_t)RW_CN * RW_N * RW_N * 2); p.rw_Rh = (u16*)take((size_t)RW_CN * CHUNK * RW_N * 2);
    p.rw_W = (u16*)take((size_t)DEPTH * GROUP_W * RW_WK * 2);
    p.ml_bcum = (float*)take((size_t)ML_CH * TOK * 4); p.ml_g = (float*)take((size_t)ML_CH * TOK * 4); p.ml_gmax = (float*)take((size_t)ML_CH * TOK * 4);
    p.ml_bl = (float*)take((size_t)ML_CH * NCHUNK * 4); p.ml_gm = (float*)take((size_t)ML_CH * NCHUNK * 4); p.ml_min = (float*)take((size_t)ML_CH * NCHUNK * 4); p.ml_dcv = (float*)take((size_t)ML_CH * NCHUNK * 4);
    p.ml_dC = (float*)take((size_t)ML_CH * NCHUNK * ML_HEAD * ML_HEAD * 4); p.ml_dn = (float*)take((size_t)ML_CH * NCHUNK * ML_HEAD * 4);
    p.ml_S = (float*)take((size_t)ML_CH * NCHUNK * CHUNK * CHUNK * 4); p.ml_hh = (float*)take(2 * rg);
    p.gd_q = (float*)take(rg); p.gd_k = (float*)take(rg); p.gd_v = (float*)take(rg);
    p.gd_gc = (float*)take((size_t)GD_CH * TOK * 4); p.gd_beta = (float*)take((size_t)GD_CH * TOK * 4);
    p.gd_A = (float*)take((size_t)GD_CN * CHUNK * CHUNK * 4); p.gd_T = (float*)take((size_t)GD_CN * CHUNK * CHUNK * 4);
    p.gd_Psi = (float*)take((size_t)GD_CN * GD_N * GD_N * 4); p.gd_O0 = (float*)take((size_t)GD_CN * CHUNK * GD_N * 4);
    p.gd_Phi = (u16*)take((size_t)GD_CN * GD_N * GD_N * 2); p.gd_Qh = (u16*)p.gd_A;
    p.gd_o = (float*)take(2 * rg);
    p.at_q = (u16*)take((size_t)BATCH * AT_QH * TOK * AT_HEAD * 2); p.at_k = (u16*)take((size_t)BATCH * AT_KVH * TOK * AT_HEAD * 2); p.at_v = (u16*)take((size_t)BATCH * AT_KVH * TOK * AT_HEAD * 2);
    const size_t end1 = off;
    off = region;
    p.xs = (u16*)take((size_t)NE * NSLOT * D_MODEL * 2); p.hid = (u16*)take((size_t)NE * NSLOT * D_MODEL * 2); p.yexp = (float*)take((size_t)NE * NSLOT * D_MODEL * 4);
    return end1 > off ? end1 : off;
}

#ifndef MK_PER_PHASE
#define MK_PER_PHASE 0
#endif
extern "C" void kernel_launch(void* const* d_in, const int* in_sizes, int n_in, void* d_out, int out_size, void* d_ws, size_t ws_size, hipStream_t stream) {
    static int grid = 0;
    if (grid == 0) {
        Params q{}; const size_t need = ws_carve(q, nullptr);
        if (n_in != 35 || out_size != BATCH * SEQ * D_MODEL || ws_size < need) {
            fprintf(stderr, "kernel_launch: expected 35 inputs, out %d, ws >= %zu; got n_in %d out %d ws %zu\n", BATCH * SEQ * D_MODEL, need, n_in, out_size, ws_size); grid = -1; return; }
        int dev = 0, cus = 0, per_cu = 0;
        if (hipGetDevice(&dev) != hipSuccess || hipDeviceGetAttribute(&cus, hipDeviceAttributeMultiprocessorCount, dev) != hipSuccess) { grid = -1; return; }
        if (hipFuncSetAttribute((const void*)mega, hipFuncAttributeMaxDynamicSharedMemorySize, LDS_BYTES) != hipSuccess) { fprintf(stderr, "kernel_launch: hipFuncSetAttribute failed\n"); grid = -1; return; }
        if (hipOccupancyMaxActiveBlocksPerMultiprocessor(&per_cu, (const void*)mega, 512, LDS_BYTES) != hipSuccess || per_cu < 1)
            fprintf(stderr, "kernel_launch: occupancy query reports %d workgroups per CU\n", per_cu);
        (void)hipGetLastError();
        if (cus < 160) { fprintf(stderr, "kernel_launch: needs >= 160 CUs\n"); grid = -1; return; }
        grid = cus;
    }
    if (grid < 0) return;
    Args a{};
    Params& p = a.p;
    const float** in = (const float**)&p;
    for (int i = 0; i < 35; ++i) in[i] = (const float*)d_in[i];
    p.out = (float*)d_out;
    (void)ws_carve(p, (unsigned char*)d_ws);
    (void)hipMemsetAsync(p.bar, 0, XCD_BAR_WORDS * 4, stream);
#if MK_PER_PHASE
    for (int k = 0; k < NPHASE; ++k) { a.ph_lo = k; a.ph_hi = k + 1; hipLaunchKernelGGL(mega, dim3(grid), dim3(512), LDS_BYTES, stream, a); }
#else
#ifdef MK_PROBE_K
#ifdef MK_PROBE_FLAGS
    a.flags = MK_PROBE_FLAGS;
#endif
    a.ph_lo = 0; a.ph_hi = MK_PROBE_K;
    hipLaunchKernelGGL(mega, dim3(grid), dim3(512), LDS_BYTES, stream, a);
    (void)hipMemsetAsync(p.bar, 0, XCD_BAR_WORDS * 4, stream);
    a.flags = 0;
#endif
    a.ph_lo = 0; a.ph_hi = NPHASE;
    hipLaunchKernelGGL(mega, dim3(grid), dim3(512), LDS_BYTES, stream, a);
#endif
    const hipError_t le = hipPeekAtLastError();
    if (le != hipSuccess) fprintf(stderr, "kernel_launch: launch failed: %s\n", hipGetErrorName(le));
}
```
